# Optimizing an MI355X kernel written in HIP

```python
import jax, jax.numpy as jnp
from jax import lax
import numpy as np

D_MODEL = 1024
BATCH = 16
SEQ = 2048
DEPTH = 2

GRID_W = 64
CTX_LEN = 256
NORM_EPS = 1e-6
F32 = jnp.float32

A_HEAD_DIM = 64
A_WIDTH = D_MODEL // 4
A_HEADS = A_WIDTH // A_HEAD_DIM
A_DECAY_RANK = 32
A_ICLR_RANK = 32
A_GATE_RANK = 64
A_GN_EPS = A_HEAD_DIM * 1e-5
A_IN = 3 * A_WIDTH + 2 * A_DECAY_RANK + 2 * A_ICLR_RANK + A_GATE_RANK

B_HEAD_DIM = 128
B_WIDTH = D_MODEL // 2
B_HEADS = B_WIDTH // B_HEAD_DIM
B_CONV = 5
B_CHUNK = 64
B_IN = 4 * B_WIDTH + 4 * B_HEADS

C_HEAD_DIM = 64
C_WIDTH = D_MODEL - A_WIDTH - B_WIDTH
C_HEADS = C_WIDTH // C_HEAD_DIM
C_KV_HEADS = C_HEADS // 2
C_GROUP = C_HEADS // C_KV_HEADS
C_QBLOCK = 128
ROPE_THETA = 10000.0
C_IN = C_WIDTH + 2 * C_KV_HEADS * C_HEAD_DIM

MIX_WIDTH = A_WIDTH + B_WIDTH + C_WIDTH
IN_WIDTH = A_IN + B_IN + C_IN

N_EXPERTS = 32
TOP_K = 4
D_EXPERT = D_MODEL
SWIGLU_ALPHA = 1.702
SWIGLU_LIMIT = 7.0
MOE_BLOCK = 256

kernel_name = "hybrid_rwkv7_gdn_gqa_moe_dit"


def _split(x, sizes):
    return jnp.split(x, np.cumsum(sizes)[:-1].tolist(), axis=-1)


def _rms(x, eps=NORM_EPS):
    x32 = x.astype(F32)
    return (x32 * lax.rsqrt(jnp.mean(x32 * x32, axis=-1, keepdims=True) + eps)).astype(x.dtype)


def _l2norm(x, eps=1e-6):
    x32 = x.astype(F32)
    return (x32 * lax.rsqrt(jnp.sum(x32 * x32, axis=-1, keepdims=True) + eps)).astype(x.dtype)


def _centred_shift(u):
    p = jnp.pad(u, ((0, 0), (1, 1), (0, 0)))
    return 0.5 * (p[:, :-2] + p[:, 2:])


def _dwconv_centred(x, w):
    k = w.shape[0]
    return lax.conv_general_dilated(
        x, w[:, None, :].astype(x.dtype), window_strides=(1,), padding=[(k // 2, k // 2)],
        dimension_numbers=("NWC", "WIO", "NWC"), feature_group_count=x.shape[-1])


def _dirs_time_major(xf, xb):
    return jnp.moveaxis(jnp.stack([xf, jnp.flip(xb, 1)], 0), 2, 0).astype(F32)


def _merge_time_major(y):
    y = jnp.moveaxis(y, 0, 2)
    return y[0] + jnp.flip(y[1], 1)


def _rwkv7_prep(u, mu, w0, w2, a0, a2, k_k, k_a):
    bsz, L, _ = u.shape
    u = u + mu * (_centred_shift(u) - u)
    r, k, v, wd, ad, gd = _split(u, [A_WIDTH] * 3 + [2 * A_DECAY_RANK, 2 * A_ICLR_RANK, A_GATE_RANK])
    wd = wd.reshape(bsz, L, 2, A_DECAY_RANK)
    ad = ad.reshape(bsz, L, 2, A_ICLR_RANK)
    w = (w0 + jnp.einsum("bldr,drc->bldc", jnp.tanh(wd), w2)).astype(F32)
    decay = jnp.exp(-jnp.exp(-jax.nn.softplus(-w) - 0.5))
    iclr = jax.nn.sigmoid(a0 + jnp.einsum("bldr,drc->bldc", ad, a2))
    heads = lambda t: t.reshape(t.shape[:-1] + (A_HEADS, A_HEAD_DIM))
    rh, vh = heads(r), heads(v)
    kk = _l2norm(heads(k * k_k))
    kd = heads(k[:, :, None] * (1 + (iclr - 1) * k_a))
    dh, ah = heads(decay), heads(iclr)
    xs = (_dirs_time_major(rh, rh), _dirs_time_major(dh[:, :, 0], dh[:, :, 1]),
          _dirs_time_major(kd[:, :, 0], kd[:, :, 1]), _dirs_time_major(vh, vh),
          _dirs_time_major(kk, kk), _dirs_time_major(ah[:, :, 0], ah[:, :, 1]))
    return xs, (rh, kd, vh, gd)


def _rwkv7_step(S, inp):
    r, d, k, v, kk, a = inp
    sa = jnp.einsum("...vk,...k->...v", S, kk)
    S = S * d[..., None, :] - sa[..., :, None] * (kk * a)[..., None, :] + v[..., :, None] * k[..., None, :]
    return S, jnp.einsum("...vk,...k->...v", S, r)


def _rwkv7_out(y, rh, kd, vh, gd, r_k, ln_w, ln_b, g2):
    bsz, L = rh.shape[:2]
    mean = jnp.mean(y, -1, keepdims=True)
    var = jnp.mean(jnp.square(y - mean), -1, keepdims=True)
    yn = ((y - mean) * lax.rsqrt(var + A_GN_EPS)).astype(rh.dtype).reshape(bsz, L, A_WIDTH) * ln_w + ln_b
    bonus = (jnp.sum(rh * kd.sum(2) * r_k, -1, keepdims=True) * vh).reshape(bsz, L, A_WIDTH)
    gate = jax.nn.sigmoid(gd) @ g2
    return (yn + bonus) * gate


def _rwkv7_mixer(ux, uc, need_ctx, mu, w0, w2, a0, a2, g2, k_k, k_a, r_k, ln_w, ln_b):
    xs_c, aux_c = _rwkv7_prep(uc, mu, w0, w2, a0, a2, k_k, k_a)
    xs_x, aux_x = _rwkv7_prep(ux, mu, w0, w2, a0, a2, k_k, k_a)
    s0 = jnp.zeros((2, ux.shape[0], A_HEADS, A_HEAD_DIM, A_HEAD_DIM), F32)
    s_ctx, y_c = lax.scan(_rwkv7_step, s0, xs_c)
    _, y_x = lax.scan(_rwkv7_step, s_ctx, xs_x)
    out_x = _rwkv7_out(_merge_time_major(y_x), *aux_x, r_k, ln_w, ln_b, g2)
    out_c = _rwkv7_out(_merge_time_major(y_c), *aux_c, r_k, ln_w, ln_b, g2) if need_ctx else None
    return out_x, out_c


def _gdn_prep(u, conv_w, a_log, dt_bias):
    bsz, L, _ = u.shape
    q, k, v, z, a, b = _split(u, [B_WIDTH] * 4 + [2 * B_HEADS] * 2)
    qkv = jax.nn.silu(_dwconv_centred(jnp.concatenate([q, k, v], -1), conv_w))
    q, k, v = _split(qkv, [B_WIDTH] * 3)
    hd = lambda t: t.reshape(bsz, L, B_HEADS, B_HEAD_DIM)
    q = _l2norm(hd(q)) * (B_HEAD_DIM ** -0.5)
    k = _l2norm(hd(k))
    v = hd(v)
    a = a.reshape(bsz, L, 2, B_HEADS).astype(F32)
    b = b.reshape(bsz, L, 2, B_HEADS).astype(F32)
    g = -jnp.exp(a_log) * jax.nn.softplus(a + dt_bias)
    beta = jax.nn.sigmoid(b)

    def dirs(tf, tb):
        return jnp.moveaxis(jnp.stack([tf, jnp.flip(tb, 1)], 0), 3, 2).astype(F32)

    return (dirs(q, q), dirs(k, k), dirs(v, v), dirs(g[:, :, 0], g[:, :, 1]),
            dirs(beta[:, :, 0], beta[:, :, 1])), z


def _gated_delta_chunked(S0, q, k, v, g, beta):
    lead = k.shape[:-2]
    L, dv = k.shape[-2], v.shape[-1]
    nl = len(lead)
    n = L // B_CHUNK
    ch = lambda t: t.reshape(lead + (n, B_CHUNK) + t.shape[nl + 1:])
    q, k, v, g, beta = ch(q), ch(k), ch(v), ch(g), ch(beta)
    g = jnp.cumsum(g, axis=-1)
    idx = jnp.arange(B_CHUNK)
    lower = idx[:, None] >= idx[None, :]
    strict = idx[:, None] > idx[None, :]
    decay = jnp.exp(jnp.where(lower, g[..., :, None] - g[..., None, :], -jnp.inf))
    kb = k * beta[..., None]
    vb = v * beta[..., None]
    l_mat = jnp.where(strict, jnp.einsum("...ik,...jk->...ij", kb, k) * decay, 0.0)
    u = lax.linalg.triangular_solve(l_mat, vb, left_side=True, lower=True, unit_diagonal=True)
    w = lax.linalg.triangular_solve(l_mat, kb * jnp.exp(g)[..., None], left_side=True, lower=True,
                                    unit_diagonal=True)
    attn = jnp.where(lower, jnp.einsum("...ik,...jk->...ij", q, k) * decay, 0.0)
    q_s = q * jnp.exp(g)[..., None]
    k_s = k * jnp.exp(g[..., -1:] - g)[..., None]
    g_last = jnp.exp(g[..., -1])
    xs = tuple(jnp.moveaxis(t, nl, 0) for t in (q_s, k_s, u, w, attn, g_last))

    def step(S, inp):
        qs, ks, uc, wc, a_in, gl = inp
        v_new = uc - jnp.einsum("...ck,...kv->...cv", wc, S)
        o = jnp.einsum("...ck,...kv->...cv", qs, S) + jnp.einsum("...ij,...jv->...iv", a_in, v_new)
        S = S * gl[..., None, None] + jnp.einsum("...ck,...cv->...kv", ks, v_new)
        return S, o

    S, o = lax.scan(step, S0, xs)
    return jnp.moveaxis(o, 0, nl).reshape(lead + (L, dv)), S


def _gdn_out(o, z, norm_w):
    bsz, L = z.shape[:2]
    o = jnp.transpose(o[0] + jnp.flip(o[1], 2), (0, 2, 1, 3))
    zh = z.reshape(bsz, L, B_HEADS, B_HEAD_DIM).astype(F32)
    return (_rms(o) * norm_w * jax.nn.silu(zh)).reshape(bsz, L, B_WIDTH).astype(z.dtype)


def _gdn_mixer(ux, uc, need_ctx, conv_w, a_log, dt_bias, norm_w):
    pc, zc = _gdn_prep(uc, conv_w, a_log, dt_bias)
    px, zx = _gdn_prep(ux, conv_w, a_log, dt_bias)
    s0 = jnp.zeros((2, ux.shape[0], B_HEADS, B_HEAD_DIM, B_HEAD_DIM), F32)
    oc, s_ctx = _gated_delta_chunked(s0, *pc)
    ox, _ = _gated_delta_chunked(s_ctx, *px)
    out_x = _gdn_out(ox, zx, norm_w)
    out_c = _gdn_out(oc, zc, norm_w) if need_ctx else None
    return out_x, out_c


def _rope_tables(pos_row, pos_col):
    ax = C_HEAD_DIM // 2
    freqs = ROPE_THETA ** (-jnp.arange(0, ax, 2, dtype=F32) / ax)
    ar = pos_row[:, None] * freqs
    ac = pos_col[:, None] * freqs
    ang = jnp.concatenate([ar, ar, ac, ac], -1)
    return jnp.cos(ang), jnp.sin(ang)


def _rot_half_axes(x):
    x1, x2, x3, x4 = jnp.split(x, 4, axis=-1)
    return jnp.concatenate([-x2, x1, -x4, x3], -1)


def _apply_rope(x, cos, sin):
    shape = (1, cos.shape[0]) + (1,) * (x.ndim - 3) + (cos.shape[-1],)
    return x * cos.reshape(shape).astype(x.dtype) + _rot_half_axes(x) * sin.reshape(shape).astype(x.dtype)


def _gqa_qkv(u, q_norm, k_norm):
    bsz, L, _ = u.shape
    q, k, v = _split(u, [C_WIDTH, C_KV_HEADS * C_HEAD_DIM, C_KV_HEADS * C_HEAD_DIM])
    q = _rms(q.reshape(bsz, L, C_KV_HEADS, C_GROUP, C_HEAD_DIM)) * q_norm
    k = _rms(k.reshape(bsz, L, C_KV_HEADS, C_HEAD_DIM)) * k_norm
    return q, k, v.reshape(bsz, L, C_KV_HEADS, C_HEAD_DIM)


def _attend(q, k, v):
    s = jnp.einsum("bqhgd,bkhd->bhgqk", q, k).astype(F32) * (C_HEAD_DIM ** -0.5)
    p = jax.nn.softmax(s, axis=-1).astype(v.dtype)
    return jnp.einsum("bhgqk,bkhd->bqhgd", p, v)


def _gqa_mixer(ux, uc, need_ctx, q_norm, k_norm, cos, sin):
    bsz, n_lat, _ = ux.shape
    qx, kx, vx = _gqa_qkv(ux, q_norm, k_norm)
    qc, kc, vc = _gqa_qkv(uc, q_norm, k_norm)
    qx, kx = _apply_rope(qx, cos, sin), _apply_rope(kx, cos, sin)
    k_all = jnp.concatenate([kx, kc], 1)
    v_all = jnp.concatenate([vx, vc], 1)
    nb = n_lat // C_QBLOCK
    qb = jnp.moveaxis(qx.reshape(bsz, nb, C_QBLOCK, C_KV_HEADS, C_GROUP, C_HEAD_DIM), 1, 0)
    ox = lax.map(lambda qblk: _attend(qblk, k_all, v_all), qb)
    out_x = jnp.moveaxis(ox, 0, 1).reshape(bsz, n_lat, C_WIDTH)
    out_c = _attend(qc, kc, vc).reshape(bsz, uc.shape[1], C_WIDTH) if need_ctx else None
    return out_x, out_c


def _clamped_swiglu(h):
    h_glu, h_lin = h[..., ::2], h[..., 1::2]
    h_glu = jnp.minimum(h_glu, SWIGLU_LIMIT)
    h_lin = jnp.clip(h_lin, -SWIGLU_LIMIT, SWIGLU_LIMIT)
    return h_glu * jax.nn.sigmoid(SWIGLU_ALPHA * h_glu) * (h_lin + 1)


def _moe(xt, w_r, b_r, w_gu, b_gu, w_dn, b_dn):
    T, D = xt.shape
    logits = (xt @ w_r + b_r).astype(F32)
    top_val, top_idx = lax.top_k(logits, TOP_K)
    gate = jax.nn.softmax(top_val, axis=-1).astype(xt.dtype)
    e_flat = top_idx.reshape(-1)
    order = jnp.argsort(e_flat)
    e_sorted = e_flat[order]
    tok_sorted = (order // TOP_K).astype(jnp.int32)
    counts = jnp.bincount(e_flat, length=N_EXPERTS)
    padded = (counts + MOE_BLOCK - 1) // MOE_BLOCK * MOE_BLOCK
    start = jnp.cumsum(counts) - counts
    pend = jnp.cumsum(padded)
    pstart = pend - padded
    slot = (jnp.arange(T * TOP_K) - start[e_sorted] + pstart[e_sorted]).astype(jnp.int32)
    n_blocks = -(-(T * TOP_K) // MOE_BLOCK) + N_EXPERTS
    n_slots = n_blocks * MOE_BLOCK
    slot_tok = jnp.full((n_slots,), T, jnp.int32).at[slot].set(tok_sorted)
    block_e = jnp.minimum(jnp.searchsorted(pend, jnp.arange(n_blocks) * MOE_BLOCK, side="right"),
                          N_EXPERTS - 1)
    xb = jnp.concatenate([xt, jnp.zeros((1, D), xt.dtype)], 0)[slot_tok].reshape(n_blocks, MOE_BLOCK, D)

    def expert_block(args):
        xblk, e = args
        h = _clamped_swiglu(xblk @ w_gu[e] + b_gu[e])
        return h @ w_dn[e] + b_dn[e]

    yb = lax.map(expert_block, (xb, block_e)).reshape(n_slots, D)
    slot_flat = jnp.zeros((T * TOP_K,), jnp.int32).at[order].set(slot)
    y = yb[slot_flat].reshape(T, TOP_K, D)
    return jnp.einsum("tk,tkd->td", gate, y)


def setup_inputs(seed: int = 0) -> dict:
    key = jax.random.key(seed)
    ks = iter(jax.random.split(key, 64))
    nrm = lambda shape, s: jax.random.normal(next(ks), shape, F32) * s
    uni = lambda shape, lo, hi: jax.random.uniform(next(ks), shape, F32, lo, hi)
    D = D_MODEL
    x = nrm((BATCH, SEQ, D), 1.0)
    c = nrm((BATCH, D), 1.0)
    ctx = nrm((BATCH, CTX_LEN, D), 1.0)
    c_ctx = nrm((D,), 1.0)
    ada_w = nrm((DEPTH, D, 6 * D), 0.5 * D ** -0.5)
    ada_b = nrm((DEPTH, 6 * D), 0.02)
    pre_norm = 1.0 + nrm((DEPTH, 2, D), 0.05)
    post_norm = 1.0 + nrm((DEPTH, 2, D), 0.05)
    w_in = nrm((DEPTH, D, IN_WIDTH), D ** -0.5)
    w_out = nrm((DEPTH, MIX_WIDTH, D), MIX_WIDTH ** -0.5)
    rw_mu = uni((DEPTH, A_IN), 0.0, 1.0)
    rw_w0 = uni((DEPTH, 2, A_WIDTH), -6.0, -1.0)
    rw_w2 = nrm((DEPTH, 2, A_DECAY_RANK, A_WIDTH), 0.1)
    rw_a0 = nrm((DEPTH, 2, A_WIDTH), 0.5)
    rw_a2 = nrm((DEPTH, 2, A_ICLR_RANK, A_WIDTH), A_ICLR_RANK ** -0.5)
    rw_g2 = nrm((DEPTH, A_GATE_RANK, A_WIDTH), A_GATE_RANK ** -0.5)
    rw_k_k = 0.85 + nrm((DEPTH, A_WIDTH), 0.05)
    rw_k_a = 1.0 + nrm((DEPTH, A_WIDTH), 0.05)
    rw_r_k = nrm((DEPTH, A_HEADS, A_HEAD_DIM), 0.1)
    rw_ln_w = 1.0 + nrm((DEPTH, A_WIDTH), 0.05)
    rw_ln_b = nrm((DEPTH, A_WIDTH), 0.02)
    gdn_conv = nrm((DEPTH, B_CONV, 3 * B_WIDTH), B_CONV ** -0.5)
    gdn_a_log = jnp.log(uni((DEPTH, 2, B_HEADS), 1.0, 16.0))
    dt = jnp.exp(uni((DEPTH, 2, B_HEADS), float(np.log(1e-3)), float(np.log(1e-1))))
    gdn_dt_bias = dt + jnp.log(-jnp.expm1(-dt))
    gdn_norm = 1.0 + nrm((DEPTH, B_HEAD_DIM), 0.05)
    attn_q_norm = 1.0 + nrm((DEPTH, C_HEAD_DIM), 0.05)
    attn_k_norm = 1.0 + nrm((DEPTH, C_HEAD_DIM), 0.05)
    router_w = nrm((DEPTH, D, N_EXPERTS), D ** -0.5)
    router_b = nrm((DEPTH, N_EXPERTS), 0.01)
    exp_w_gu = nrm((DEPTH, N_EXPERTS, D, 2 * D_EXPERT), D ** -0.5)
    exp_b_gu = nrm((DEPTH, N_EXPERTS, 2 * D_EXPERT), 0.01)
    exp_w_dn = nrm((DEPTH, N_EXPERTS, D_EXPERT, D), D_EXPERT ** -0.5)
    exp_b_dn = nrm((DEPTH, N_EXPERTS, D), 0.01)
    return {"x": x, "c": c, "ctx": ctx, "c_ctx": c_ctx, "ada_w": ada_w, "ada_b": ada_b,
            "pre_norm": pre_norm, "post_norm": post_norm, "w_in": w_in, "w_out": w_out,
            "rw_mu": rw_mu, "rw_w0": rw_w0, "rw_w2": rw_w2, "rw_a0": rw_a0, "rw_a2": rw_a2,
            "rw_g2": rw_g2, "rw_k_k": rw_k_k, "rw_k_a": rw_k_a, "rw_r_k": rw_r_k,
            "rw_ln_w": rw_ln_w, "rw_ln_b": rw_ln_b, "gdn_conv": gdn_conv, "gdn_a_log": gdn_a_log,
            "gdn_dt_bias": gdn_dt_bias, "gdn_norm": gdn_norm, "attn_q_norm": attn_q_norm,
            "attn_k_norm": attn_k_norm, "router_w": router_w, "router_b": router_b,
            "exp_w_gu": exp_w_gu, "exp_b_gu": exp_b_gu, "exp_w_dn": exp_w_dn, "exp_b_dn": exp_b_dn}


def reference(x, c, ctx, c_ctx, ada_w, ada_b, pre_norm, post_norm, w_in, w_out,
              rw_mu, rw_w0, rw_w2, rw_a0, rw_a2, rw_g2, rw_k_k, rw_k_a, rw_r_k, rw_ln_w, rw_ln_b,
              gdn_conv, gdn_a_log, gdn_dt_bias, gdn_norm, attn_q_norm, attn_k_norm,
              router_w, router_b, exp_w_gu, exp_b_gu, exp_w_dn, exp_b_dn):
    bsz, n_lat, d = x.shape
    n_ctx = ctx.shape[1]
    rows = n_lat // GRID_W
    pos_row = jnp.repeat(jnp.arange(rows), GRID_W).astype(F32)
    pos_col = jnp.tile(jnp.arange(GRID_W), rows).astype(F32)
    cos, sin = _rope_tables(pos_row, pos_col)
    for l in range(DEPTH):
        need_ctx = l < DEPTH - 1
        mod = jax.nn.silu(jnp.concatenate([c, c_ctx[None].astype(c.dtype)], 0)) @ ada_w[l] + ada_b[l]
        sh1, sc1, g1, sh2, sc2, g2 = jnp.split(mod[:bsz, None], 6, axis=-1)
        csh1, csc1, cg1, csh2, csc2, cg2 = jnp.split(mod[bsz:], 6, axis=-1)
        hx = _rms(x) * pre_norm[l, 0] * (1 + sc1) + sh1
        hc = _rms(ctx) * pre_norm[l, 0] * (1 + csc1) + csh1
        ax, bx, cx = _split(hx @ w_in[l], [A_IN, B_IN, C_IN])
        ac, bc, cc = _split(hc @ w_in[l], [A_IN, B_IN, C_IN])
        ya_x, ya_c = _rwkv7_mixer(ax, ac, need_ctx, rw_mu[l], rw_w0[l], rw_w2[l], rw_a0[l], rw_a2[l],
                                  rw_g2[l], rw_k_k[l], rw_k_a[l], rw_r_k[l], rw_ln_w[l], rw_ln_b[l])
        yb_x, yb_c = _gdn_mixer(bx, bc, need_ctx, gdn_conv[l], gdn_a_log[l], gdn_dt_bias[l], gdn_norm[l])
        yc_x, yc_c = _gqa_mixer(cx, cc, need_ctx, attn_q_norm[l], attn_k_norm[l], cos, sin)
        mix_x = jnp.concatenate([ya_x, yb_x, yc_x], -1) @ w_out[l]
        x = x + g1 * _rms(mix_x) * post_norm[l, 0]
        if need_ctx:
            mix_c = jnp.concatenate([ya_c, yb_c, yc_c], -1) @ w_out[l]
            ctx = ctx + cg1 * _rms(mix_c) * post_norm[l, 0]
        tokens = (_rms(x) * pre_norm[l, 1] * (1 + sc2) + sh2).reshape(bsz * n_lat, d)
        if need_ctx:
            hc = (_rms(ctx) * pre_norm[l, 1] * (1 + csc2) + csh2).reshape(bsz * n_ctx, d)
            tokens = jnp.concatenate([tokens, hc], 0)
        f = _moe(tokens, router_w[l], router_b[l], exp_w_gu[l], exp_b_gu[l], exp_w_dn[l], exp_b_dn[l])
        x = x + g2 * _rms(f[: bsz * n_lat].reshape(bsz, n_lat, d)) * post_norm[l, 1]
        if need_ctx:
            ctx = ctx + cg2 * _rms(f[bsz * n_lat:].reshape(bsz, n_ctx, d)) * post_norm[l, 1]
    return x
```

```cpp
#ifndef HOST_TEST
#include <hip/hip_runtime.h>
#else
struct uint4 { unsigned x, y, z, w; };
#endif
#include <cstdio>
#include <cstdint>
#include <cmath>

#ifndef CFG_BATCH
#define CFG_BATCH 16
#define CFG_SEQ 2048
#define CFG_CTX 256
#define CFG_NEXP 32
#define CFG_DEXP 1024
#endif
constexpr int D = 1024, BATCH = CFG_BATCH, SEQ = CFG_SEQ, CTXL = CFG_CTX, DEPTH = 2, GRID_W = 64;
constexpr int NLAT = BATCH * SEQ, NCTX = BATCH * CTXL, NTOK = NLAT + NCTX;
constexpr int A_W = 256, A_H = 4, A_IN = 960;
constexpr int B_W = 512, B_H = 4, B_IN = 2064, B_OFF = 960;
constexpr int C_W = 256, C_IN = 512, C_OFF = 3024;
constexpr int INW = 3536, INP = 3584;
constexpr int NEXP = CFG_NEXP, TOPK = 4, DEXP = CFG_DEXP;
constexpr int NBLK_MAX = (NTOK * TOPK + 255) / 256 + NEXP, NSLOT = NBLK_MAX * 256;
constexpr int ZROW = NTOK;
constexpr int SLEN = CTXL + SEQ;

#ifdef HOST_TEST
#define DEVFN static inline
#define GLOBAL_ATOMIC_ADD(p, v) ((*(p)) += (v), (*(p)) - (v))
#else
#define DEVFN __device__ __forceinline__
#define GLOBAL_ATOMIC_ADD(p, v) atomicAdd((p), (v))
#endif
#ifdef HOST_TEST
#define UNIFORM(x) (x)
#define LOADFENCE()
#else
#define UNIFORM(x) __builtin_amdgcn_readfirstlane(x)
#define LOADFENCE() asm volatile("" ::: "memory")
#endif
typedef unsigned short bf16_t;
DEVFN bf16_t f2bf(float f) { unsigned u = __builtin_bit_cast(unsigned, f); return (bf16_t)((u + 0x7fffu + ((u >> 16) & 1u)) >> 16); }
DEVFN float bf2f(bf16_t b) { unsigned u = ((unsigned)b) << 16; return __builtin_bit_cast(float, u); }
DEVFN float sigmoidf_(float x) { return 1.0f / (1.0f + expf(-x)); }
DEVFN float siluf_(float x) { return x / (1.0f + expf(-x)); }
DEVFN float softplusf_(float x) { return x > 20.f ? x : log1pf(expf(x)); }

struct P {
    const float *x, *c, *ctx, *c_ctx, *ada_w, *ada_b, *pre_norm, *post_norm, *w_in, *w_out;
    const float *rw_mu, *rw_w0, *rw_w2, *rw_a0, *rw_a2, *rw_g2, *rw_k_k, *rw_k_a, *rw_r_k, *rw_ln_w, *rw_ln_b;
    const float *gdn_conv, *gdn_a_log, *gdn_dt_bias, *gdn_norm, *attn_q_norm, *attn_k_norm;
    const float *router_w, *router_b, *exp_w_gu, *exp_b_gu, *exp_w_dn, *exp_b_dn;
    float* out;
    unsigned* ctl;
    int* cnt;
    float* MOD;
    float* X;
    bf16_t* HB;
    float* TOKF;
    float* U;
    float* LR;
    float *RW_R, *RW_V, *RW_KK, *RW_D, *RW_KD, *RW_KKA, *RW_GATE, *RW_BON, *YA;
    float *GQ, *GK, *GV, *GG, *GBETA, *OB;
    float *CQ, *CK, *CV;
    bf16_t* MIX;
    float* MO;
    int *TOPI, *POS, *TSLOT, *SLOT_TOK, *BLOCK_E, *NBLK;
    float* TOPG;
    bf16_t *XG, *HH, *YB;
    bf16_t *WIN_T, *WOUT_T, *WGU_T, *WDN_T;
};

DEVFN void row_info(int m, int& b, int& t, int& len, int& base) {
    if (m < NLAT) { b = m / SEQ; t = m % SEQ; len = SEQ; base = b * SEQ; }
    else { const int mc = m - NLAT; b = mc / CTXL; t = mc % CTXL; len = CTXL; base = NLAT + b * CTXL; }
}
DEVFN int mod_row(int m) { return m < NLAT ? m / SEQ : BATCH; }
DEVFN int scan_row(int dir, int b, int s) {
    if (s < CTXL) { const int ts = dir ? (CTXL - 1 - s) : s; return NLAT + b * CTXL + ts; }
    const int s2 = s - CTXL; const int ts = dir ? (SEQ - 1 - s2) : s2; return b * SEQ + ts;
}

DEVFN void task_mod(const P& p, long task) {
    const int j = (int)(task % (6 * D)); const int r = (int)((task / (6 * D)) % (BATCH + 1)); const int l = (int)(task / ((long)(6 * D) * (BATCH + 1)));
    const float* cv = (r < BATCH) ? p.c + (size_t)r * D : p.c_ctx;
    const float* w = p.ada_w + (size_t)l * D * 6 * D + j;
    float acc = 0.f;
    for (int k = 0; k < D; ++k) acc += siluf_(cv[k]) * w[(size_t)k * 6 * D];
    p.MOD[((size_t)l * (BATCH + 1) + r) * 6 * D + j] = acc + p.ada_b[(size_t)l * 6 * D + j];
}
DEVFN void task_copyx(const P& p, long task) {
    const long n_lat = (long)NLAT * D;
    p.X[task] = task < n_lat ? p.x[task] : p.ctx[task - n_lat];
}
DEVFN void task_norm1(const P& p, int l, long task) {
    const int m = (int)task; const float* xr = p.X + (size_t)m * D;
    float ss = 0.f; for (int k = 0; k < D; ++k) ss += xr[k] * xr[k];
    const float rstd = 1.0f / sqrtf(ss / D + 1e-6f);
    const float* md = p.MOD + ((size_t)l * (BATCH + 1) + mod_row(m)) * 6 * D; const float* pn = p.pre_norm + (size_t)(l * 2 + 0) * D;
    bf16_t* o = p.HB + (size_t)m * D;
    for (int k = 0; k < D; ++k) o[k] = f2bf(xr[k] * rstd * pn[k] * (1.0f + md[D + k]) + md[k]);
}
DEVFN float lerpA(const P& p, int l, int m, int col) {
    int b, t, len, base; row_info(m, b, t, len, base);
    const float u = p.U[(size_t)m * INP + col];
    const float up = t > 0 ? p.U[(size_t)(m - 1) * INP + col] : 0.f, un = t + 1 < len ? p.U[(size_t)(m + 1) * INP + col] : 0.f;
    return u + p.rw_mu[l * A_IN + col] * (0.5f * (up + un) - u);
}
DEVFN void task_prepA0(const P& p, int l, long task) {
    const int m = (int)(task / 192), j = (int)(task % 192);
    const float v = lerpA(p, l, m, 768 + j);
    p.LR[(size_t)m * 192 + j] = j < 64 ? tanhf(v) : (j < 128 ? v : sigmoidf_(v));
}
DEVFN void task_prepA1(const P& p, int l, long task) {
    const int m = (int)(task / A_H), h = (int)(task % A_H);
    const float* lr = p.LR + (size_t)m * 192;
    float ss = 0.f;
    for (int c = 0; c < 64; ++c) { const int ch = h * 64 + c; const float kx = lerpA(p, l, m, 256 + ch) * p.rw_k_k[l * A_W + ch]; ss += kx * kx; }
    const float rn = 1.0f / sqrtf(ss + 1e-6f);
    float bon = 0.f;
    for (int c = 0; c < 64; ++c) {
        const int ch = h * 64 + c;
        const float r = lerpA(p, l, m, ch), k = lerpA(p, l, m, 256 + ch), v = lerpA(p, l, m, 512 + ch);
        const float kk = k * p.rw_k_k[l * A_W + ch] * rn;
        float kdsum = 0.f;
        for (int dir = 0; dir < 2; ++dir) {
            float w = p.rw_w0[(l * 2 + dir) * A_W + ch], a = p.rw_a0[(l * 2 + dir) * A_W + ch];
            const float* w2 = p.rw_w2 + ((size_t)(l * 2 + dir) * 32) * A_W + ch; const float* a2 = p.rw_a2 + ((size_t)(l * 2 + dir) * 32) * A_W + ch;
            for (int r2 = 0; r2 < 32; ++r2) { w += lr[dir * 32 + r2] * w2[(size_t)r2 * A_W]; a += lr[64 + dir * 32 + r2] * a2[(size_t)r2 * A_W]; }
            const float decay = expf(-expf(-softplusf_(-w) - 0.5f));
            const float iclr = sigmoidf_(a);
            const float kd = k * (1.0f + (iclr - 1.0f) * p.rw_k_a[l * A_W + ch]);
            const size_t o = ((size_t)dir * NTOK + m) * A_W + ch;
            p.RW_D[o] = decay; p.RW_KD[o] = kd; p.RW_KKA[o] = kk * iclr; kdsum += kd;
        }
        float g = 0.f; const float* g2 = p.rw_g2 + (size_t)l * 64 * A_W + ch;
        for (int r2 = 0; r2 < 64; ++r2) g += lr[128 + r2] * g2[(size_t)r2 * A_W];
        const size_t o = (size_t)m * A_W + ch;
        p.RW_R[o] = r; p.RW_V[o] = v; p.RW_KK[o] = kk; p.RW_GATE[o] = g;
        bon += r * kdsum * p.rw_r_k[l * A_W + ch];
    }
    p.RW_BON[(size_t)m * A_H + h] = bon;
}
DEVFN void task_prepB(const P& p, int l, long task) {
    const int which = (int)(task % 4), h = (int)((task / 4) % B_H), m = (int)(task / (4 * B_H));
    int b, t, len, base; row_info(m, b, t, len, base);
    if (which == 3) {
        for (int dir = 0; dir < 2; ++dir) {
            const float a = p.U[(size_t)m * INP + B_OFF + 2048 + dir * 4 + h], bb = p.U[(size_t)m * INP + B_OFF + 2056 + dir * 4 + h];
            const float g = -expf(p.gdn_a_log[(l * 2 + dir) * B_H + h]) * softplusf_(a + p.gdn_dt_bias[(l * 2 + dir) * B_H + h]);
            p.GG[(size_t)m * 8 + dir * 4 + h] = g; p.GBETA[(size_t)m * 8 + dir * 4 + h] = sigmoidf_(bb);
        }
        return;
    }
    float* dst = (which == 0 ? p.GQ : which == 1 ? p.GK : p.GV) + (size_t)m * B_W + h * 128;
    float ss = 0.f;
    for (int c = 0; c < 128; ++c) {
        const int cc = which * B_W + h * 128 + c; const int col = B_OFF + cc;
        float acc = 0.f;
        for (int j = 0; j < 5; ++j) { const int tt = t + j - 2; if (tt >= 0 && tt < len) acc += p.U[(size_t)(base + tt) * INP + col] * p.gdn_conv[((size_t)l * 5 + j) * (3 * B_W) + cc]; }
        const float s = siluf_(acc); dst[c] = s; ss += s * s;
    }
    if (which < 2) { const float rn = (1.0f / sqrtf(ss + 1e-6f)) * (which == 0 ? 0.08838834764831845f : 1.0f); for (int c = 0; c < 128; ++c) dst[c] *= rn; }
}
DEVFN void task_prepC(const P& p, int l, long task) {
    const int m = (int)(task / 8), hs = (int)(task % 8);
    const float* src = p.U + (size_t)m * INP + C_OFF + hs * 64;
    if (hs >= 6) { float* dst = p.CV + (size_t)m * 128 + (hs - 6) * 64; for (int d = 0; d < 64; ++d) dst[d] = src[d]; return; }
    float ss = 0.f; for (int d = 0; d < 64; ++d) ss += src[d] * src[d];
    const float rstd = 1.0f / sqrtf(ss / 64.f + 1e-6f);
    const float* nw = (hs < 4 ? p.attn_q_norm : p.attn_k_norm) + l * 64;
    float* dst = hs < 4 ? p.CQ + (size_t)m * 256 + hs * 64 : p.CK + (size_t)m * 128 + (hs - 4) * 64;
    if (m >= NLAT) { for (int d = 0; d < 64; ++d) dst[d] = src[d] * rstd * nw[d]; return; }
    const int t = m % SEQ; const float pr = (float)(t / GRID_W), pc = (float)(t % GRID_W);
    for (int d = 0; d < 16; ++d) {
        const float fr = powf(10000.0f, -(float)d / 16.0f);
        const float ar = pr * fr, ac = pc * fr; const float cr = cosf(ar), sr = sinf(ar), cc = cosf(ac), sc = sinf(ac);
        const float x1 = src[d] * rstd * nw[d], x2 = src[16 + d] * rstd * nw[16 + d], x3 = src[32 + d] * rstd * nw[32 + d], x4 = src[48 + d] * rstd * nw[48 + d];
        dst[d] = x1 * cr - x2 * sr; dst[16 + d] = x2 * cr + x1 * sr; dst[32 + d] = x3 * cc - x4 * sc; dst[48 + d] = x4 * cc + x3 * sc;
    }
}
DEVFN void task_scanA(const P& p, long task) {
    const int v = (int)(task % 64), chain = UNIFORM((int)(task / 64)); const int h = chain % A_H, b = (chain / A_H) % BATCH, dir = chain / (A_H * BATCH);
    float s[64];
#pragma unroll
    for (int k = 0; k < 64; ++k) s[k] = 0.f;
    for (int st = 0; st < SLEN; ++st) {
        const int m = scan_row(dir, b, st);
        const float* kk = p.RW_KK + (size_t)m * A_W + h * 64; const float* rr = p.RW_R + (size_t)m * A_W + h * 64;
        const size_t od = ((size_t)dir * NTOK + m) * A_W + h * 64;
        const float* dd = p.RW_D + od; const float* kd = p.RW_KD + od; const float* ka = p.RW_KKA + od;
        const float vv = p.RW_V[(size_t)m * A_W + h * 64 + v];
        float sa = 0.f;
#pragma unroll
        for (int k = 0; k < 64; ++k) { sa += s[k] * kk[k]; if ((k & 15) == 15) LOADFENCE(); }
        float y = 0.f;
#pragma unroll
        for (int k = 0; k < 64; ++k) { s[k] = s[k] * dd[k] - sa * ka[k] + vv * kd[k]; y += s[k] * rr[k]; if ((k & 7) == 7) LOADFENCE(); }
        p.YA[((size_t)dir * NTOK + m) * A_W + h * 64 + v] = y;
    }
}
DEVFN void task_scanB(const P& p, long task) {
    const int j = (int)(task % 128), chain = UNIFORM((int)(task / 128)); const int h = chain % B_H, b = (chain / B_H) % BATCH, dir = chain / (B_H * BATCH);
    float s[128];
#pragma unroll
    for (int k = 0; k < 128; ++k) s[k] = 0.f;
    for (int st = 0; st < SLEN; ++st) {
        const int m = scan_row(dir, b, st);
        const float* kv = p.GK + (size_t)m * B_W + h * 128; const float* qv = p.GQ + (size_t)m * B_W + h * 128;
        const float vj = p.GV[(size_t)m * B_W + h * 128 + j];
        const float eg = expf(p.GG[(size_t)m * 8 + dir * 4 + h]), beta = p.GBETA[(size_t)m * 8 + dir * 4 + h];
        float pk = 0.f;
#pragma unroll
        for (int k = 0; k < 128; ++k) { pk += s[k] * kv[k]; if ((k & 15) == 15) LOADFENCE(); }
        const float cf = beta * (vj - eg * pk);
        float o = 0.f;
#pragma unroll
        for (int k = 0; k < 128; ++k) { s[k] = eg * s[k] + cf * kv[k]; o += s[k] * qv[k]; if ((k & 7) == 7) LOADFENCE(); }
        p.OB[((size_t)dir * NTOK + m) * B_W + h * 128 + j] = o;
    }
}
DEVFN void task_attn(const P& p, int need_ctx, long task) {
    const int t = (int)(task % SLEN), hq = UNIFORM((int)((task / SLEN) % 4)), b = UNIFORM((int)(task / ((long)SLEN * 4)));
    const bool is_lat = UNIFORM((int)(t < SEQ)) != 0; if (!is_lat && !need_ctx) return;
    const int m = is_lat ? b * SEQ + t : NLAT + b * CTXL + (t - SEQ);
    const int kvh = hq >> 1;
    float q[64], o[64];
#pragma unroll
    for (int d = 0; d < 64; ++d) { q[d] = p.CQ[(size_t)m * 256 + hq * 64 + d] * 0.125f; o[d] = 0.f; }
    float mx = -1e30f, lsum = 0.f;
    const int nk = is_lat ? SLEN : CTXL;
    for (int kI = 0; kI < nk; ++kI) {
        int km; if (is_lat) km = kI < SEQ ? b * SEQ + kI : NLAT + b * CTXL + (kI - SEQ); else km = NLAT + b * CTXL + kI;
        const float* kr = p.CK + (size_t)km * 128 + kvh * 64; const float* vr = p.CV + (size_t)km * 128 + kvh * 64;
        float sc = 0.f;
#pragma unroll
        for (int d = 0; d < 64; ++d) { sc += q[d] * kr[d]; if ((d & 15) == 15) LOADFENCE(); }
        const float mn = sc > mx ? sc : mx; const float f = expf(mx - mn), pe = expf(sc - mn);
        lsum = lsum * f + pe; mx = mn;
#pragma unroll
        for (int d = 0; d < 64; ++d) { o[d] = o[d] * f + pe * vr[d]; if ((d & 15) == 15) LOADFENCE(); }
    }
    const float inv = 1.0f / lsum;
#pragma unroll
    for (int d = 0; d < 64; ++d) p.MIX[(size_t)m * D + 768 + hq * 64 + d] = f2bf(o[d] * inv);
}
DEVFN void task_post(const P& p, int l, long task) {
    const int m = (int)(task / 8), g = (int)(task % 8);
    if (g < 4) {
        const int h = g; const float* y0 = p.YA + (size_t)m * A_W + h * 64; const float* y1 = p.YA + ((size_t)NTOK + m) * A_W + h * 64;
        float mean = 0.f; for (int c = 0; c < 64; ++c) mean += y0[c] + y1[c]; mean *= (1.0f / 64.f);
        float var = 0.f; for (int c = 0; c < 64; ++c) { const float d0 = y0[c] + y1[c] - mean; var += d0 * d0; } var *= (1.0f / 64.f);
        const float rs = 1.0f / sqrtf(var + 64e-5f); const float bon = p.RW_BON[(size_t)m * A_H + h];
        for (int c = 0; c < 64; ++c) { const int ch = h * 64 + c;
            const float yn = (y0[c] + y1[c] - mean) * rs * p.rw_ln_w[l * A_W + ch] + p.rw_ln_b[l * A_W + ch];
            p.MIX[(size_t)m * D + ch] = f2bf((yn + bon * p.RW_V[(size_t)m * A_W + ch]) * p.RW_GATE[(size_t)m * A_W + ch]); }
    } else {
        const int h = g - 4; const float* o0 = p.OB + (size_t)m * B_W + h * 128; const float* o1 = p.OB + ((size_t)NTOK + m) * B_W + h * 128;
        float ss = 0.f; for (int c = 0; c < 128; ++c) { const float o = o0[c] + o1[c]; ss += o * o; }
        const float rs = 1.0f / sqrtf(ss / 128.f + 1e-6f);
        for (int c = 0; c < 128; ++c) { const float z = p.U[(size_t)m * INP + B_OFF + 1536 + h * 128 + c];
            p.MIX[(size_t)m * D + 256 + h * 128 + c] = f2bf((o0[c] + o1[c]) * rs * p.gdn_norm[l * 128 + c] * siluf_(z)); }
    }
}
DEVFN void task_resid1(const P& p, int l, long task) {
    const int m = (int)task; const float* mo = p.MO + (size_t)m * D; float* xr = p.X + (size_t)m * D;
    const float* md = p.MOD + ((size_t)l * (BATCH + 1) + mod_row(m)) * 6 * D;
    float ss = 0.f; for (int k = 0; k < D; ++k) ss += mo[k] * mo[k];
    const float rstd = 1.0f / sqrtf(ss / D + 1e-6f); const float* pn = p.post_norm + (size_t)(l * 2 + 0) * D;
    float s2 = 0.f;
    for (int k = 0; k < D; ++k) { const float xv = xr[k] + md[2 * D + k] * (mo[k] * rstd) * pn[k]; xr[k] = xv; s2 += xv * xv; }
    const float r2 = 1.0f / sqrtf(s2 / D + 1e-6f); const float* pn2 = p.pre_norm + (size_t)(l * 2 + 1) * D;
    for (int k = 0; k < D; ++k) { const float tv = xr[k] * r2 * pn2[k] * (1.0f + md[4 * D + k]) + md[3 * D + k]; p.TOKF[(size_t)m * D + k] = tv; p.HB[(size_t)m * D + k] = f2bf(tv); }
}
DEVFN void task_router(const P& p, int l, long task) {
    const int m = (int)task; const float* tk = p.TOKF + (size_t)m * D; const float* rw = p.router_w + (size_t)l * D * NEXP;
    float lg[NEXP];
#pragma unroll
    for (int e = 0; e < NEXP; ++e) lg[e] = p.router_b[l * NEXP + e];
    for (int k = 0; k < D; ++k) { const float tv = tk[k];
#pragma unroll
        for (int e = 0; e < NEXP; ++e) lg[e] += tv * rw[(size_t)k * NEXP + e]; }
    int idx[TOPK]; float val[TOPK];
#pragma unroll
    for (int j = 0; j < TOPK; ++j) { float best = -3.0e38f; int bi = 0;
#pragma unroll
        for (int e = 0; e < NEXP; ++e) { if (lg[e] > best) { best = lg[e]; bi = e; } }
        idx[j] = bi; val[j] = best;
#pragma unroll
        for (int e = 0; e < NEXP; ++e) if (e == bi) lg[e] = -3.0e38f; }
    float sum = 0.f, ex[TOPK];
#pragma unroll
    for (int j = 0; j < TOPK; ++j) { ex[j] = expf(val[j] - val[0]); sum += ex[j]; }
#pragma unroll
    for (int j = 0; j < TOPK; ++j) { p.TOPI[(size_t)m * TOPK + j] = idx[j]; p.TOPG[(size_t)m * TOPK + j] = ex[j] / sum; p.POS[(size_t)m * TOPK + j] = GLOBAL_ATOMIC_ADD(&p.cnt[l * NEXP + idx[j]], 1); }
}
DEVFN int moe_pstart(const P& p, int l, int e, int* nblk) {
    int acc = 0, ps = 0;
    for (int i = 0; i < NEXP; ++i) { if (i == e) ps = acc; acc += (p.cnt[l * NEXP + i] + 255) / 256 * 256; }
    if (nblk) *nblk = acc / 256; return ps;
}
DEVFN void task_slots(const P& p, int l, long task) {
    const int e = p.TOPI[task]; const int slot = moe_pstart(p, l, e, nullptr) + p.POS[task];
    p.TSLOT[task] = slot; p.SLOT_TOK[slot] = (int)(task / TOPK);
}
DEVFN void task_blocke(const P& p, int l, long task) {
    int acc = 0, e_of = NEXP - 1, nb = 0;
    for (int i = 0; i < NEXP; ++i) { const int nbk = (p.cnt[l * NEXP + i] + 255) / 256; if ((int)task >= acc && (int)task < acc + nbk) e_of = i; acc += nbk; }
    nb = acc; p.BLOCK_E[task] = e_of; if (task == 0) p.NBLK[0] = nb;
}
DEVFN void task_gather(const P& p, long task) {
    const long slot = task / 128; const int ch = (int)(task % 128); const int tok = p.SLOT_TOK[slot];
    const uint4* s = (const uint4*)(p.HB + (size_t)tok * D) + ch; ((uint4*)(p.XG + (size_t)slot * D))[ch] = *s;
}
DEVFN void task_combine(const P& p, int l, long task) {
    const int m = (int)task; float* xr = p.X + (size_t)m * D; const float* md = p.MOD + ((size_t)l * (BATCH + 1) + mod_row(m)) * 6 * D;
    const bf16_t* y0 = p.YB + (size_t)p.TSLOT[(size_t)m * 4 + 0] * D; const bf16_t* y1 = p.YB + (size_t)p.TSLOT[(size_t)m * 4 + 1] * D;
    const bf16_t* y2 = p.YB + (size_t)p.TSLOT[(size_t)m * 4 + 2] * D; const bf16_t* y3 = p.YB + (size_t)p.TSLOT[(size_t)m * 4 + 3] * D;
    const float g0 = p.TOPG[(size_t)m * 4 + 0], g1 = p.TOPG[(size_t)m * 4 + 1], g2 = p.TOPG[(size_t)m * 4 + 2], g3 = p.TOPG[(size_t)m * 4 + 3];
    float ss = 0.f;
    for (int k = 0; k < D; ++k) { const float f = g0 * bf2f(y0[k]) + g1 * bf2f(y1[k]) + g2 * bf2f(y2[k]) + g3 * bf2f(y3[k]); ss += f * f; }
    const float rstd = 1.0f / sqrtf(ss / D + 1e-6f); const float* pn = p.post_norm + (size_t)(l * 2 + 1) * D;
    const bool last = (l == DEPTH - 1);
    for (int k = 0; k < D; ++k) { const float f = g0 * bf2f(y0[k]) + g1 * bf2f(y1[k]) + g2 * bf2f(y2[k]) + g3 * bf2f(y3[k]);
        const float xv = xr[k] + md[5 * D + k] * (f * rstd) * pn[k]; xr[k] = xv; if (last) p.out[(size_t)m * D + k] = xv; }
}

#ifndef HOST_TEST
namespace pg8 {
#define PG8_LAS __attribute__((address_space(3)))
typedef short bf16x8 __attribute__((ext_vector_type(8)));
typedef float f32x4 __attribute__((ext_vector_type(4)));
typedef unsigned u32x4 __attribute__((ext_vector_type(4)));
typedef unsigned u32x2 __attribute__((ext_vector_type(2)));
constexpr int BM = 256, BK = 64, HALF = 128, HTB = HALF * BK * 2, STAGE_BYTES = 8 * HTB, NXCD = 8, WGM = 8;
__host__ __device__ __forceinline__ int lds_byte(int r, int c) { const int st = (r >> 4) * 2 + (c >> 5), rr = r & 15, cc = c & 31, ob = rr * 64 + cc * 2; return st * 1024 + (ob ^ (((ob >> 9) & 1) << 5)); }
__host__ __device__ __forceinline__ void stage_rc(int b, int& R, int& C) { const int st = b / 1024, sb = b % 1024, swz = sb ^ (((sb >> 9) & 1) << 5); R = (st >> 1) * 16 + swz / 64; C = (st & 1) * 32 + (swz % 64) / 2; }
__host__ __device__ __forceinline__ int perm32(int rho) { const int n = rho >> 4, i = rho & 15; return 8 * (i >> 2) + 4 * n + (i & 3); }
struct Unit { int pm, pn, e; };
struct Gemm { const bf16_t* A; const bf16_t* Bt; int K; size_t estride; };
struct StaticOrder {
    int nM, nN, nwg, G, c;
    __device__ void init(int M, int N, int G_, int c_) { nM = M / BM; nN = N / BM; nwg = nM * nN; G = G_; c = c_; }
    __device__ bool next(int i, Unit& u) const {
        const long L = (long)i * G + c; if (L >= nwg) return false;
        int wgid = (int)L; { const int q = nwg / NXCD, r = nwg % NXCD, xcd = wgid % NXCD, off = wgid / NXCD; wgid = (xcd < r ? xcd * (q + 1) : r * (q + 1) + (xcd - r) * q) + off; }
        const int nig = WGM * nN, gid = wgid / nig, fm = gid * WGM, gsz = (nM - fm) < WGM ? (nM - fm) : WGM;
        u.pm = fm + ((wgid % nig) % gsz); u.pn = (wgid % nig) / gsz; u.e = 0; return true;
    }
};
struct MoeOrder {
    int nblk, nN, G, c; const int* block_e;
    __device__ bool next(int i, Unit& u) const {
        const long L = (long)i * G + c; if (L >= (long)nblk * nN) return false;
        u.pm = (int)(L / nN); u.pn = (int)(L % nN); u.e = block_e[u.pm]; return true;
    }
};
__device__ __forceinline__ unsigned cvt_pk_bf16(float lo, float hi) { unsigned r; asm volatile("v_cvt_pk_bf16_f32 %0, %1, %2" : "=v"(r) : "v"(lo), "v"(hi)); return r; }
struct EpiF32 {
    static constexpr bool PERM = false;
    float* C; int ldc;
    __device__ __forceinline__ void operator()(const f32x4 (&acc)[2][2][4][2], const Unit& u, int wr, int wc, int fr, int fq) const {
        const int row0 = u.pm * BM + wr * 64 + fr, col0 = u.pn * BM + wc * 32 + 4 * fq;
#pragma unroll
        for (int ai = 0; ai < 2; ++ai)
#pragma unroll
            for (int m = 0; m < 4; ++m) { float* rowp = C + (size_t)(row0 + ai * HALF + m * 16) * ldc + col0;
#pragma unroll
                for (int bj = 0; bj < 2; ++bj)
#pragma unroll
                    for (int n = 0; n < 2; ++n) *(f32x4*)(rowp + bj * HALF + n * 16) = acc[ai][bj][m][n]; }
    }
};
struct EpiBf16Bias {
    static constexpr bool PERM = true;
    bf16_t* O; int ldc; const float* bias; int bias_estride;
    __device__ __forceinline__ void operator()(const f32x4 (&acc)[2][2][4][2], const Unit& u, int wr, int wc, int fr, int fq) const {
        const int row0 = u.pm * BM + wr * 64 + fr, col0 = u.pn * BM + wc * 32 + 8 * fq; const float* bp = bias + (size_t)u.e * bias_estride + col0;
        f32x4 bv[2][2];
#pragma unroll
        for (int bj = 0; bj < 2; ++bj)
#pragma unroll
            for (int n = 0; n < 2; ++n) bv[bj][n] = *(const f32x4*)(bp + bj * HALF + 4 * n);
#pragma unroll
        for (int ai = 0; ai < 2; ++ai)
#pragma unroll
            for (int m = 0; m < 4; ++m) { bf16_t* rowp = O + (size_t)(row0 + ai * HALF + m * 16) * ldc + col0;
#pragma unroll
                for (int bj = 0; bj < 2; ++bj) { const f32x4 v0 = acc[ai][bj][m][0] + bv[bj][0], v1 = acc[ai][bj][m][1] + bv[bj][1];
                    u32x4 w; w.x = cvt_pk_bf16(v0[0], v0[1]); w.y = cvt_pk_bf16(v0[2], v0[3]); w.z = cvt_pk_bf16(v1[0], v1[1]); w.w = cvt_pk_bf16(v1[2], v1[3]);
                    *(u32x4*)(rowp + bj * HALF) = w; } }
    }
};
__device__ __forceinline__ float swiglu1(float g, float lin) { g = fminf(g, 7.0f); lin = fminf(fmaxf(lin, -7.0f), 7.0f); return g / (1.0f + __expf(-1.702f * g)) * (lin + 1.0f); }
struct EpiSwiglu {
    static constexpr bool PERM = true;
    bf16_t* O; int ldc; const float* bias; int bias_estride;
    __device__ __forceinline__ void operator()(const f32x4 (&acc)[2][2][4][2], const Unit& u, int wr, int wc, int fr, int fq) const {
        const int row0 = u.pm * BM + wr * 64 + fr, col0 = u.pn * BM + wc * 32 + 8 * fq; const float* bp = bias + (size_t)u.e * bias_estride + col0;
        f32x4 bv[2][2];
#pragma unroll
        for (int bj = 0; bj < 2; ++bj)
#pragma unroll
            for (int n = 0; n < 2; ++n) bv[bj][n] = *(const f32x4*)(bp + bj * HALF + 4 * n);
#pragma unroll
        for (int ai = 0; ai < 2; ++ai)
#pragma unroll
            for (int m = 0; m < 4; ++m) { bf16_t* rowp = O + (size_t)(row0 + ai * HALF + m * 16) * ldc + (col0 >> 1);
#pragma unroll
                for (int bj = 0; bj < 2; ++bj) { const f32x4 v0 = acc[ai][bj][m][0] + bv[bj][0], v1 = acc[ai][bj][m][1] + bv[bj][1];
                    u32x2 w; w.x = cvt_pk_bf16(swiglu1(v0[0], v0[1]), swiglu1(v0[2], v0[3])); w.y = cvt_pk_bf16(swiglu1(v1[0], v1[1]), swiglu1(v1[2], v1[3]));
                    *(u32x2*)(rowp + bj * (HALF / 2)) = w; } }
    }
};

template <class Epi, class Sched>
__device__ __forceinline__ void gemm_phase(PG8_LAS unsigned char* lds, const Gemm g, const Sched& S, const Epi& E) {
    int tid = threadIdx.x; asm volatile("" : "+v"(tid));
    const int wid = __builtin_amdgcn_readfirstlane(tid >> 6), lane = tid & 63, wr = wid >> 2, wc = wid & 3, fr = lane & 15, fq = lane >> 4;
    const int K = g.K, nt = K / BK;
    unsigned voffA[2], voffB[2];
#pragma unroll
    for (int i = 0; i < 2; ++i) { int R, C; stage_rc(tid * 16 + i * 8192, R, C); const int Rb = Epi::PERM ? ((R & ~31) + perm32(R & 31)) : R;
        voffA[i] = (unsigned)(R * K + C) * 2u; voffB[i] = (unsigned)(Rb * K + C) * 2u; }
    const size_t kstep = (size_t)(BK * 2);
    const size_t hstep = (size_t)HALF * K * 2;
    const size_t tstep = 2 * hstep;
    const unsigned ldsw = (unsigned)wid * 1024u;
    const int aoff = lds_byte(wr * 64 + fr, fq * 8), boff = lds_byte(wc * 32 + fr, fq * 8);
#define PG8_SA(b, h) (((b) * 2 + (h)) * HTB)
#define PG8_SB(b, h) ((4 + (b) * 2 + (h)) * HTB)
#define PG8_STAGE(bufoff, gbase, voff) do { _Pragma("unroll") for (int _i = 0; _i < 2; ++_i) \
        __builtin_amdgcn_global_load_lds((const unsigned*)((const char*)(gbase) + (voff)[_i]), (PG8_LAS unsigned*)(lds + (bufoff) + ldsw + _i * 8192), 16, 0, 0); } while (0)
#define PG8_LDA(dst, b, h) do { _Pragma("unroll") for (int m = 0; m < 4; ++m) _Pragma("unroll") for (int k = 0; k < 2; ++k) dst[m][k] = *(const PG8_LAS bf16x8*)(lds + PG8_SA(b, h) + aoff + m * 2048 + k * 1024); } while (0)
#define PG8_LDB(dst, b, h) do { _Pragma("unroll") for (int n = 0; n < 2; ++n) _Pragma("unroll") for (int k = 0; k < 2; ++k) dst[n][k] = *(const PG8_LAS bf16x8*)(lds + PG8_SB(b, h) + boff + n * 2048 + k * 1024); } while (0)
#define PG8_MMA(ai, bj, At, Bt) do { __builtin_amdgcn_s_setprio(1); _Pragma("unroll") for (int m = 0; m < 4; ++m) _Pragma("unroll") for (int n = 0; n < 2; ++n) _Pragma("unroll") for (int k = 0; k < 2; ++k) \
        acc[ai][bj][m][n] = __builtin_amdgcn_mfma_f32_16x16x32_bf16(Bt[n][k], At[m][k], acc[ai][bj][m][n], 0, 0, 0); __builtin_amdgcn_s_setprio(0); } while (0)
#define PG8_WAIT_V(n) asm volatile("s_waitcnt vmcnt(" #n ")" ::: "memory")
#define PG8_WAIT_L(n) asm volatile("s_waitcnt lgkmcnt(" #n ")" ::: "memory")
#define PG8_BAR __builtin_amdgcn_s_barrier()
#define PG8_SCHED __builtin_amdgcn_sched_barrier(0)
    Unit cur, nxt; int ui = 0;
    if (!S.next(0, cur)) return;
    f32x4 acc[2][2][4][2];
#pragma unroll
    for (int a = 0; a < 2; ++a)
#pragma unroll
        for (int b = 0; b < 2; ++b)
#pragma unroll
            for (int m = 0; m < 4; ++m)
#pragma unroll
                for (int n = 0; n < 2; ++n) acc[a][b][m][n] = (f32x4){0.f, 0.f, 0.f, 0.f};
    bf16x8 At[4][2], B0[2][2], B1[2][2];
    const char* cA = (const char*)g.A + (size_t)cur.pm * tstep; const char* cB = (const char*)(g.Bt + (size_t)cur.e * g.estride) + (size_t)cur.pn * tstep;
    PG8_STAGE(PG8_SB(0, 0), cB, voffB); PG8_STAGE(PG8_SB(0, 1), cB + hstep, voffB); PG8_STAGE(PG8_SA(0, 0), cA, voffA); PG8_STAGE(PG8_SA(0, 1), cA + hstep, voffA);
    if (wr == 1) PG8_BAR;
    PG8_WAIT_V(2); PG8_BAR;
    PG8_STAGE(PG8_SB(1, 0), cB + kstep, voffB); PG8_STAGE(PG8_SA(1, 0), cA + kstep, voffA); PG8_STAGE(PG8_SB(1, 1), cB + hstep + kstep, voffB);
    PG8_WAIT_V(6); PG8_BAR;
    for (;;) {
        const bool has_next = S.next(ui + 1, nxt);
        const char* nA = has_next ? (const char*)g.A + (size_t)nxt.pm * tstep : cA; const char* nB = has_next ? (const char*)(g.Bt + (size_t)nxt.e * g.estride) + (size_t)nxt.pn * tstep : cB;
        for (int t = 0; t < nt; t += 2) {
            const bool last = (t == nt - 2);
            const char* a1 = cA + (size_t)(t + 1) * kstep;
            const char* a2 = last ? nA : cA + (size_t)(t + 2) * kstep; const char* b2 = last ? nB : cB + (size_t)(t + 2) * kstep;
            const char* a3 = a2 + kstep; const char* b3 = b2 + kstep;
            PG8_LDB(B0, 0, 0); PG8_LDB(B1, 0, 1); PG8_SCHED; PG8_LDA(At, 0, 0); PG8_STAGE(PG8_SA(1, 1), a1 + hstep, voffA);
            PG8_WAIT_V(8); PG8_WAIT_L(0); PG8_BAR; PG8_MMA(0, 0, At, B0); PG8_MMA(0, 1, At, B1); PG8_BAR; PG8_SCHED;
            PG8_LDA(At, 0, 1); PG8_STAGE(PG8_SB(0, 0), b2, voffB); PG8_STAGE(PG8_SB(0, 1), b2 + hstep, voffB); PG8_STAGE(PG8_SA(0, 0), a2, voffA);
            PG8_WAIT_V(8); PG8_WAIT_L(0); PG8_BAR; PG8_MMA(1, 0, At, B0); PG8_MMA(1, 1, At, B1); PG8_BAR; PG8_SCHED;
            PG8_LDB(B0, 1, 0); PG8_LDB(B1, 1, 1); PG8_SCHED; PG8_LDA(At, 1, 0); PG8_STAGE(PG8_SA(0, 1), a2 + hstep, voffA);
            PG8_WAIT_V(8); PG8_WAIT_L(0); PG8_BAR; PG8_MMA(0, 0, At, B0); PG8_MMA(0, 1, At, B1); PG8_BAR; PG8_SCHED;
            PG8_LDA(At, 1, 1); PG8_STAGE(PG8_SB(1, 0), b3, voffB); PG8_STAGE(PG8_SB(1, 1), b3 + hstep, voffB); PG8_STAGE(PG8_SA(1, 0), a3, voffA);
            PG8_WAIT_V(8); PG8_WAIT_L(0); PG8_BAR; PG8_MMA(1, 0, At, B0); PG8_MMA(1, 1, At, B1); PG8_BAR; PG8_SCHED;
        }
        if (wr == 0) PG8_BAR;
        E(acc, cur, wr, wc, fr, fq);
        if (!has_next) break;
#pragma unroll
        for (int a = 0; a < 2; ++a)
#pragma unroll
            for (int b = 0; b < 2; ++b)
#pragma unroll
                for (int m = 0; m < 4; ++m)
#pragma unroll
                    for (int n = 0; n < 2; ++n) acc[a][b][m][n] = (f32x4){0.f, 0.f, 0.f, 0.f};
        cur = nxt; cA = nA; cB = nB; ++ui;
        if (wr == 1) PG8_BAR;
    }
    PG8_WAIT_V(0);
    PG8_BAR;
#undef PG8_SA
#undef PG8_SB
#undef PG8_STAGE
#undef PG8_LDA
#undef PG8_LDB
#undef PG8_MMA
#undef PG8_WAIT_V
#undef PG8_WAIT_L
#undef PG8_BAR
#undef PG8_SCHED
}
}

#define XB_TMO      128
#define XB_XCNT(j)  (256  + 64 * (j))
#define XB_XSUB(j)  (1280 + 64 * (j))
#define XB_XGEN(j)  (2304 + 64 * (j))
#define XB_TOP      3328
#define XB_TOPGEN   3392
#define XCD_BAR_WORDS 3456
#define XB_SPIN_CAP (1u << 22)
#define LAS __attribute__((address_space(3)))
__device__ __forceinline__ unsigned xb_ld(unsigned* p)              { return __hip_atomic_load(p, __ATOMIC_RELAXED, __HIP_MEMORY_SCOPE_AGENT); }
__device__ __forceinline__ unsigned xb_add(unsigned* p, unsigned v) { return __hip_atomic_fetch_add(p, v, __ATOMIC_RELAXED, __HIP_MEMORY_SCOPE_AGENT); }
__device__ __forceinline__ unsigned xb_xcc_id() { return (unsigned)__builtin_amdgcn_s_getreg((3 << 11) | 20) & 0xFu; }
#define XB_SPIN(cond, bar) do { unsigned _sp = 0; while (cond) { __builtin_amdgcn_s_sleep(1); \
    if ((++_sp & 255u) == 0u) { if (xb_ld(&(bar)[XB_TMO])) break; if (_sp > XB_SPIN_CAP) { atomicAdd(&(bar)[XB_TMO], 1u); break; } } } } while (0)
struct XcdBarrier { unsigned* bar; unsigned x; volatile LAS unsigned* st; };
__device__ __forceinline__ XcdBarrier xcd_barrier_post(unsigned* bar, volatile LAS unsigned* st) {
    XcdBarrier b; b.bar = bar; b.x = xb_xcc_id(); b.st = st;
    if (threadIdx.x == 0) (void)xb_add(&bar[XB_XCNT(b.x)], 1u);
    return b;
}
__device__ __forceinline__ void xcd_barrier_complete(unsigned* bar, unsigned x, unsigned& nloc, unsigned& nx) {
    const unsigned G = gridDim.x * gridDim.y * gridDim.z;
    unsigned sum, cnt, mine, sp = 0u;
    for (;;) {
        sum = 0u; cnt = 0u; mine = 0u;
#pragma unroll
        for (unsigned j = 0; j < 16; ++j) { const unsigned c = xb_ld(&bar[XB_XCNT(j)]); sum += c; cnt += (c > 0u) ? 1u : 0u; mine = (j == x) ? c : mine; }
        if (sum == G) break;
        __builtin_amdgcn_s_sleep(1);
        if ((++sp & 255u) == 0u) { if (xb_ld(&bar[XB_TMO])) break; if (sp > XB_SPIN_CAP) { atomicAdd(&bar[XB_TMO], 1u); break; } }
    }
    nloc = mine > 0u ? mine : 1u; nx = cnt > 0u ? cnt : 1u;
}
__device__ __forceinline__ void xcd_barrier(const XcdBarrier& b) {
    asm volatile("s_waitcnt vmcnt(0)" ::: "memory");
    __syncthreads();
    if (threadIdx.x == 0) {
        unsigned* bar = b.bar;
        __builtin_amdgcn_s_waitcnt(0);
        unsigned nloc = b.st[0], nx = b.st[1];
        if (nloc == 0u) { xcd_barrier_complete(bar, b.x, nloc, nx); b.st[0] = nloc; b.st[1] = nx; }
        const unsigned old = xb_add(&bar[XB_XSUB(b.x)], 1u);
        const unsigned gen = old / nloc;
        if (old + 1u == (gen + 1u) * nloc) {
            __builtin_amdgcn_fence(__ATOMIC_RELEASE, "agent");
            asm volatile("s_waitcnt vmcnt(0)" ::: "memory");
            const unsigned og = xb_add(&bar[XB_TOP], 1u);
            const unsigned tg = og / nx;
            if (og + 1u == (tg + 1u) * nx) xb_add(&bar[XB_TOPGEN], 1u);
            else XB_SPIN(xb_ld(&bar[XB_TOPGEN]) == tg, bar);
            __builtin_amdgcn_fence(__ATOMIC_ACQUIRE, "agent");
            xb_add(&bar[XB_XGEN(b.x)], 1u);
            asm volatile("s_waitcnt vmcnt(0)" ::: "memory");
        } else {
            XB_SPIN(xb_ld(&bar[XB_XGEN(b.x)]) == gen, bar);
            __builtin_amdgcn_fence(__ATOMIC_ACQUIRE, "agent");
            asm volatile("s_waitcnt vmcnt(0)" ::: "memory");
        }
    }
    __syncthreads();
}

constexpr int NWAVES = 8, NTHR = 512;
constexpr int RING_BYTES = 131072, MISC_OFF = RING_BYTES + 320, LDS_BYTES = 147456;
constexpr size_t MiB = 1u << 20;
constexpr int CW_BAR = 4096, CW_CNT = 8192;
constexpr size_t CTL_BYTES = 64 * 1024;

__device__ __forceinline__ void transpose_item(const float* W, int K, int N, bf16_t* WT, LAS float* scr, int item, int lane) {
    const int nblk_k = K / 64; const int nb = item / nblk_k, kb = item % nblk_k, k0 = 64 * kb, n0 = 32 * nb;
    const int ncol = n0 + (lane & 31);
#pragma unroll 8
    for (int i = 0; i < 32; ++i) { const int kk = 2 * i + (lane >> 5); scr[kk * 33 + (lane & 31)] = ncol < N ? W[(size_t)(k0 + kk) * N + ncol] : 0.f; }
    asm volatile("s_waitcnt lgkmcnt(0)" ::: "memory");
    const int c = lane & 7;
#pragma unroll
    for (int j = 0; j < 4; ++j) { const int n = (lane >> 3) + 8 * j; const LAS float* s = scr + (8 * c) * 33 + n;
        pg8::u32x4 o; o.x = pg8::cvt_pk_bf16(s[0 * 33], s[1 * 33]); o.y = pg8::cvt_pk_bf16(s[2 * 33], s[3 * 33]); o.z = pg8::cvt_pk_bf16(s[4 * 33], s[5 * 33]); o.w = pg8::cvt_pk_bf16(s[6 * 33], s[7 * 33]);
        *(pg8::u32x4*)(WT + (size_t)(n0 + n) * K + k0 + 8 * c) = o; }
    asm volatile("s_waitcnt lgkmcnt(0)" ::: "memory");
}

struct Args { P p; int ph_lo, ph_hi; };

#define RUN_TASKS(ntasks, call) do { const long _n = (long)(ntasks); for (long task = gtid; task < _n; task += nthr) { call; } } while (0)

constexpr int NPH = 14;
__global__ void __launch_bounds__(NTHR, 2) fwd_kernel(Args args) {
    extern __shared__ __attribute__((aligned(16))) unsigned char lds[];
    const P& p = args.p;
    LAS unsigned char* ldsp = (LAS unsigned char*)lds;
    volatile LAS unsigned* MISC = (volatile LAS unsigned*)(ldsp + MISC_OFF);
    const int G = gridDim.x;
#define PHASE_VARS int tid_ = threadIdx.x; asm volatile("" : "+v"(tid_)); const int lane = tid_ & 63, wave = __builtin_amdgcn_readfirstlane(tid_ >> 6); \
    const long gtid = ((long)wave * G + blockIdx.x) * 64 + lane, nthr = (long)G * NTHR; const int gw = wave * G + blockIdx.x, ngw = G * NWAVES; (void)gw; (void)ngw; (void)gtid; (void)nthr; (void)lane;
    if (threadIdx.x < 32) MISC[threadIdx.x] = 0u;
    __syncthreads();
    XcdBarrier bar = xcd_barrier_post(p.ctl + CW_BAR, MISC + 8);
    const int lo = args.ph_lo, hi = args.ph_hi;
#ifndef DBG_PH
#define DBG_PH -1
#endif
#define PHON(j) (DBG_PH < 0 || DBG_PH == (j))
#define IN(k) (lo <= (k) && (k) < hi)
#define SEAM(k) do { if (IN((k) + 1)) xcd_barrier(bar); } while (0)

    if (PHON(100) && IN(0)) { PHASE_VARS;
        RUN_TASKS((long)DEPTH * (BATCH + 1) * 6 * D, task_mod(p, task));
        RUN_TASKS((long)NTOK * D, task_copyx(p, task));
        RUN_TASKS(D, p.HB[(size_t)ZROW * D + task] = 0);
        SEAM(0);
    }
    for (int l = 0; l < DEPTH; ++l) {
        const int pb = 1 + l * NPH;
        const bool need_ctx = l < DEPTH - 1;
        const int ntok_l = need_ctx ? NTOK : NLAT;
        if (PHON(0) && IN(pb + 0)) { PHASE_VARS;
            LAS float* scr = (LAS float*)(ldsp + wave * 16384);
            const int I_IN = (D / 64) * (INP / 32), I_OUT = (D / 64) * (D / 32), I_GU = (D / 64) * (2 * DEXP / 32), I_DN = (DEXP / 64) * (D / 32);
            const int total = I_IN + I_OUT + NEXP * (I_GU + I_DN);
            for (int it = gw; it < total; it += ngw) {
                int r = it;
                if (r < I_IN) { transpose_item(p.w_in + (size_t)l * D * INW, D, INW, p.WIN_T, scr, r, lane); continue; } r -= I_IN;
                if (r < I_OUT) { transpose_item(p.w_out + (size_t)l * D * D, D, D, p.WOUT_T, scr, r, lane); continue; } r -= I_OUT;
                if (r < NEXP * I_GU) { const int e = r / I_GU; transpose_item(p.exp_w_gu + ((size_t)l * NEXP + e) * D * 2 * DEXP, D, 2 * DEXP, p.WGU_T + (size_t)e * 2 * DEXP * D, scr, r % I_GU, lane); continue; } r -= NEXP * I_GU;
                { const int e = r / I_DN; transpose_item(p.exp_w_dn + ((size_t)l * NEXP + e) * DEXP * D, DEXP, D, p.WDN_T + (size_t)e * D * DEXP, scr, r % I_DN, lane); }
            }
            RUN_TASKS(NTOK, task_norm1(p, l, task));
            SEAM(pb + 0);
        }
        if (PHON(1) && IN(pb + 1)) { PHASE_VARS;
            pg8::Gemm g{p.HB, p.WIN_T, D, 0}; pg8::StaticOrder S; S.init(NTOK, INP, G, (int)blockIdx.x);
            pg8::EpiF32 E{p.U, INP};
            pg8::gemm_phase(ldsp, g, S, E);
            SEAM(pb + 1);
        }
        if (PHON(2) && IN(pb + 2)) { PHASE_VARS;
            RUN_TASKS((long)NTOK * 192, task_prepA0(p, l, task));
            RUN_TASKS((long)NTOK * B_H * 4, task_prepB(p, l, task));
            RUN_TASKS((long)NTOK * 8, task_prepC(p, l, task));
            SEAM(pb + 2);
        }
        if (PHON(3) && IN(pb + 3)) { PHASE_VARS; RUN_TASKS((long)NTOK * A_H, task_prepA1(p, l, task)); SEAM(pb + 3); }
        if (PHON(4) && IN(pb + 4)) { PHASE_VARS;
            const long nA = 2L * BATCH * A_H * 64, nB = 2L * BATCH * B_H * 128, nC = (long)BATCH * 4 * SLEN;
            for (long task = gtid; task < nA; task += nthr) task_scanA(p, task);
            for (long task = gtid - nA; task < nB; task += nthr) { if (task >= 0) task_scanB(p, task); }
            for (long task = gtid - nA - nB; task < nC; task += nthr) { if (task >= 0) task_attn(p, need_ctx ? 1 : 0, task); }
            SEAM(pb + 4);
        }
        if (PHON(5) && IN(pb + 5)) { PHASE_VARS; RUN_TASKS((long)ntok_l * 8, task_post(p, l, task)); SEAM(pb + 5); }
        if (PHON(6) && IN(pb + 6)) { PHASE_VARS;
            pg8::Gemm g{p.MIX, p.WOUT_T, D, 0}; pg8::StaticOrder S; S.init(ntok_l, D, G, (int)blockIdx.x);
            pg8::EpiF32 E{p.MO, D};
            pg8::gemm_phase(ldsp, g, S, E);
            SEAM(pb + 6);
        }
        if (PHON(7) && IN(pb + 7)) { PHASE_VARS;
            RUN_TASKS(ntok_l, task_resid1(p, l, task));
            RUN_TASKS(NSLOT, p.SLOT_TOK[task] = ZROW);
            SEAM(pb + 7);
        }
        if (PHON(8) && IN(pb + 8)) { PHASE_VARS; RUN_TASKS(ntok_l, task_router(p, l, task)); SEAM(pb + 8); }
        if (PHON(9) && IN(pb + 9)) { PHASE_VARS;
            RUN_TASKS((long)ntok_l * TOPK, task_slots(p, l, task));
            RUN_TASKS(NBLK_MAX, task_blocke(p, l, task));
            SEAM(pb + 9);
        }
        if (PHON(10) && IN(pb + 10)) { PHASE_VARS; const long nb = p.NBLK[0]; RUN_TASKS(nb * 256 * 128, task_gather(p, task)); SEAM(pb + 10); }
        if (PHON(11) && IN(pb + 11)) { PHASE_VARS;
            pg8::Gemm g{p.XG, p.WGU_T, D, (size_t)2 * DEXP * D}; pg8::MoeOrder S{p.NBLK[0], 2 * DEXP / 256, G, (int)blockIdx.x, p.BLOCK_E};
            pg8::EpiSwiglu E{p.HH, DEXP, p.exp_b_gu + (size_t)l * NEXP * 2 * DEXP, 2 * DEXP};
            pg8::gemm_phase(ldsp, g, S, E);
            SEAM(pb + 11);
        }
        if (PHON(12) && IN(pb + 12)) { PHASE_VARS;
            pg8::Gemm g{p.HH, p.WDN_T, DEXP, (size_t)D * DEXP}; pg8::MoeOrder S{p.NBLK[0], D / 256, G, (int)blockIdx.x, p.BLOCK_E};
            pg8::EpiBf16Bias E{p.YB, D, p.exp_b_dn + (size_t)l * NEXP * D, D};
            pg8::gemm_phase(ldsp, g, S, E);
            SEAM(pb + 12);
        }
        if (PHON(13) && IN(pb + 13)) { PHASE_VARS; RUN_TASKS(ntok_l, task_combine(p, l, task)); if (l + 1 < DEPTH) SEAM(pb + 13); }
    }
#undef IN
#undef SEAM
}

#ifndef N_LAUNCH_MODE
#define N_LAUNCH_MODE 1
#endif
extern "C" void kernel_launch(void* const* d_in, const int* in_sizes, int n_in, void* d_out, int out_size, void* d_ws, size_t ws_size, hipStream_t stream) {
    static int grid = 0;
    if (grid == 0) {
        int dev = 0, cus = 0;
        if (hipGetDevice(&dev) != hipSuccess || hipDeviceGetAttribute(&cus, hipDeviceAttributeMultiprocessorCount, dev) != hipSuccess) { grid = -1; return; }
        if (hipFuncSetAttribute((const void*)fwd_kernel, hipFuncAttributeMaxDynamicSharedMemorySize, LDS_BYTES) != hipSuccess) { fprintf(stderr, "hipFuncSetAttribute failed\n"); grid = -1; return; }
        int per_cu = 0;
        if (hipOccupancyMaxActiveBlocksPerMultiprocessor(&per_cu, (const void*)fwd_kernel, NTHR, LDS_BYTES) != hipSuccess || per_cu < 1) fprintf(stderr, "occupancy query: %d\n", per_cu);
        (void)hipGetLastError();
        grid = cus;
    }
    if (grid < 0) return;
    unsigned char* ws = (unsigned char*)d_ws;
    (void)hipMemsetAsync(ws, 0, CTL_BYTES, stream);
    Args a{};
    P& p = a.p;
    const float* const* in = (const float* const*)d_in;
    p.x = in[0]; p.c = in[1]; p.ctx = in[2]; p.c_ctx = in[3]; p.ada_w = in[4]; p.ada_b = in[5]; p.pre_norm = in[6]; p.post_norm = in[7]; p.w_in = in[8]; p.w_out = in[9];
    p.rw_mu = in[10]; p.rw_w0 = in[11]; p.rw_w2 = in[12]; p.rw_a0 = in[13]; p.rw_a2 = in[14]; p.rw_g2 = in[15]; p.rw_k_k = in[16]; p.rw_k_a = in[17]; p.rw_r_k = in[18]; p.rw_ln_w = in[19]; p.rw_ln_b = in[20];
    p.gdn_conv = in[21]; p.gdn_a_log = in[22]; p.gdn_dt_bias = in[23]; p.gdn_norm = in[24]; p.attn_q_norm = in[25]; p.attn_k_norm = in[26];
    p.router_w = in[27]; p.router_b = in[28]; p.exp_w_gu = in[29]; p.exp_b_gu = in[30]; p.exp_w_dn = in[31]; p.exp_b_dn = in[32];
    p.out = (float*)d_out;
    size_t off = 0;
    auto carve = [&](size_t bytes) { void* r = ws + off; off += (bytes + 255) & ~(size_t)255; return r; };
    p.ctl = (unsigned*)carve(CTL_BYTES); p.cnt = (int*)(p.ctl + CW_CNT);
    p.MOD = (float*)carve((size_t)DEPTH * (BATCH + 1) * 6 * D * 4);
    p.X = (float*)carve((size_t)(NTOK + 1) * D * 4);
    p.HB = (bf16_t*)carve((size_t)(NTOK + 1) * D * 2);
    p.WIN_T = (bf16_t*)carve((size_t)INP * D * 2); p.WOUT_T = (bf16_t*)carve((size_t)D * D * 2);
    p.WGU_T = (bf16_t*)carve((size_t)NEXP * 2 * DEXP * D * 2); p.WDN_T = (bf16_t*)carve((size_t)NEXP * D * DEXP * 2);
    p.TOPI = (int*)carve((size_t)NTOK * 4 * 4); p.POS = (int*)carve((size_t)NTOK * 4 * 4); p.TSLOT = (int*)carve((size_t)NTOK * 4 * 4); p.TOPG = (float*)carve((size_t)NTOK * 4 * 4);
    p.SLOT_TOK = (int*)carve((size_t)NSLOT * 4); p.BLOCK_E = (int*)carve((size_t)NBLK_MAX * 4); p.NBLK = (int*)carve(256);
    const size_t ovl = off;
    p.U = (float*)carve((size_t)NTOK * INP * 4);
    p.LR = (float*)carve((size_t)NTOK * 192 * 4);
    p.RW_R = (float*)carve((size_t)NTOK * A_W * 4); p.RW_V = (float*)carve((size_t)NTOK * A_W * 4); p.RW_KK = (float*)carve((size_t)NTOK * A_W * 4);
    p.RW_D = (float*)carve((size_t)2 * NTOK * A_W * 4); p.RW_KD = (float*)carve((size_t)2 * NTOK * A_W * 4); p.RW_KKA = (float*)carve((size_t)2 * NTOK * A_W * 4);
    p.RW_GATE = (float*)carve((size_t)NTOK * A_W * 4); p.RW_BON = (float*)carve((size_t)NTOK * A_H * 4); p.YA = (float*)carve((size_t)2 * NTOK * A_W * 4);
    p.GQ = (float*)carve((size_t)NTOK * B_W * 4); p.GK = (float*)carve((size_t)NTOK * B_W * 4); p.GV = (float*)carve((size_t)NTOK * B_W * 4);
    p.GG = (float*)carve((size_t)NTOK * 8 * 4); p.GBETA = (float*)carve((size_t)NTOK * 8 * 4); p.OB = (float*)carve((size_t)2 * NTOK * B_W * 4);
    p.CQ = (float*)carve((size_t)NTOK * 256 * 4); p.CK = (float*)carve((size_t)NTOK * 128 * 4); p.CV = (float*)carve((size_t)NTOK * 128 * 4);
    p.MIX = (bf16_t*)carve((size_t)NTOK * D * 2);
    const size_t end1 = off;
    p.MO = p.U;
    p.TOKF = p.U + (size_t)NTOK * D;
    off = ovl + (size_t)NTOK * INP * 4;
    p.XG = (bf16_t*)carve((size_t)NSLOT * D * 2); p.HH = (bf16_t*)carve((size_t)NSLOT * DEXP * 2); p.YB = (bf16_t*)carve((size_t)NSLOT * D * 2);
    const size_t end2 = off;
    const size_t need = end1 > end2 ? end1 : end2;
    if (need > ws_size) { fprintf(stderr, "kernel_launch: workspace too small: need %zu have %zu\n", need, ws_size); return; }
    const int nph = 1 + DEPTH * NPH;
#if N_LAUNCH_MODE == 1
    a.ph_lo = 0; a.ph_hi = nph;
    hipLaunchKernelGGL(fwd_kernel, dim3(grid), dim3(NTHR), LDS_BYTES, stream, a);
#else
    for (int ph = 0; ph < nph; ++ph) { a.ph_lo = ph; a.ph_hi = ph + 1; hipLaunchKernelGGL(fwd_kernel, dim3(grid), dim3(NTHR), LDS_BYTES, stream, a); }
#endif
}
#endif
```

```cpp
#ifndef HOST_TEST
#include <hip/hip_runtime.h>
#else
struct uint4 { unsigned x, y, z, w; };
#endif
#include <cstdio>
#include <cstdint>
#include <cmath>

#ifndef CFG_BATCH
#define CFG_BATCH 16
#define CFG_SEQ 2048
#define CFG_CTX 256
#define CFG_NEXP 32
#define CFG_DEXP 1024
#endif
constexpr int D = 1024, BATCH = CFG_BATCH, SEQ = CFG_SEQ, CTXL = CFG_CTX, DEPTH = 2, GRID_W = 64;
constexpr int NLAT = BATCH * SEQ, NCTX = BATCH * CTXL, NTOK = NLAT + NCTX;
constexpr int A_W = 256, A_H = 4, A_IN = 960;
constexpr int B_W = 512, B_H = 4, B_IN = 2064, B_OFF = 960;
constexpr int C_W = 256, C_IN = 512, C_OFF = 3024;
constexpr int INW = 3536, INP = 3584;
constexpr int NEXP = CFG_NEXP, TOPK = 4, DEXP = CFG_DEXP;
constexpr int NBLK_MAX = (NTOK * TOPK + 255) / 256 + NEXP, NSLOT = NBLK_MAX * 256;
constexpr int ZROW = NTOK;
constexpr int SLEN = CTXL + SEQ;

#ifdef HOST_TEST
#define DEVFN static inline
#define GLOBAL_ATOMIC_ADD(p, v) ((*(p)) += (v), (*(p)) - (v))
#else
#define DEVFN __device__ __forceinline__
#define GLOBAL_ATOMIC_ADD(p, v) atomicAdd((p), (v))
#endif
#ifdef HOST_TEST
#define UNIFORM(x) (x)
#define LOADFENCE()
#else
#define UNIFORM(x) __builtin_amdgcn_readfirstlane(x)
#define LOADFENCE() asm volatile("" ::: "memory")
#endif
typedef unsigned short bf16_t;
DEVFN bf16_t f2bf(float f) { unsigned u = __builtin_bit_cast(unsigned, f); return (bf16_t)((u + 0x7fffu + ((u >> 16) & 1u)) >> 16); }
DEVFN float bf2f(bf16_t b) { unsigned u = ((unsigned)b) << 16; return __builtin_bit_cast(float, u); }
DEVFN float sigmoidf_(float x) { return 1.0f / (1.0f + expf(-x)); }
DEVFN float siluf_(float x) { return x / (1.0f + expf(-x)); }
DEVFN float softplusf_(float x) { return x > 20.f ? x : log1pf(expf(x)); }

#ifdef HOST_TEST
#define WSACC inline
#else
#define WSACC __device__ __host__ __forceinline__
#endif
constexpr size_t CTL_BYTES = 64 * 1024;
constexpr size_t al256(size_t x) { return (x + 255) & ~(size_t)255; }
constexpr size_t WSO_ctl = 0;
constexpr size_t WSE_ctl = WSO_ctl + al256(CTL_BYTES);
constexpr size_t WSO_MOD = WSE_ctl;
constexpr size_t WSE_MOD = WSO_MOD + al256((size_t)DEPTH * (BATCH + 1) * 6 * D * 4);
constexpr size_t WSO_X = WSE_MOD;
constexpr size_t WSE_X = WSO_X + al256((size_t)(NTOK + 1) * D * 4);
constexpr size_t WSO_HB = WSE_X;
constexpr size_t WSE_HB = WSO_HB + al256((size_t)(NTOK + 1) * D * 2);
constexpr size_t WSO_WIN_T = WSE_HB;
constexpr size_t WSE_WIN_T = WSO_WIN_T + al256((size_t)INP * D * 2);
constexpr size_t WSO_WOUT_T = WSE_WIN_T;
constexpr size_t WSE_WOUT_T = WSO_WOUT_T + al256((size_t)D * D * 2);
constexpr size_t WSO_WR_T = WSE_WOUT_T;
constexpr size_t WSE_WR_T = WSO_WR_T + al256((size_t)32 * D * 2);
constexpr size_t WSO_WGU_T = WSE_WR_T;
constexpr size_t WSE_WGU_T = WSO_WGU_T + al256((size_t)NEXP * 2 * DEXP * D * 2);
constexpr size_t WSO_WDN_T = WSE_WGU_T;
constexpr size_t WSE_WDN_T = WSO_WDN_T + al256((size_t)NEXP * D * DEXP * 2);
constexpr size_t WSO_TOPI = WSE_WDN_T;
constexpr size_t WSE_TOPI = WSO_TOPI + al256((size_t)NTOK * 4 * 4);
constexpr size_t WSO_POS = WSE_TOPI;
constexpr size_t WSE_POS = WSO_POS + al256((size_t)NTOK * 4 * 4);
constexpr size_t WSO_TSLOT = WSE_POS;
constexpr size_t WSE_TSLOT = WSO_TSLOT + al256((size_t)NTOK * 4 * 4);
constexpr size_t WSO_TOPG = WSE_TSLOT;
constexpr size_t WSE_TOPG = WSO_TOPG + al256((size_t)NTOK * 4 * 4);
constexpr size_t WSO_SLOT_TOK = WSE_TOPG;
constexpr size_t WSE_SLOT_TOK = WSO_SLOT_TOK + al256((size_t)NSLOT * 4);
constexpr size_t WSO_BLOCK_E = WSE_SLOT_TOK;
constexpr size_t WSE_BLOCK_E = WSO_BLOCK_E + al256((size_t)NBLK_MAX * 4);
constexpr size_t WSO_NBLK = WSE_BLOCK_E;
constexpr size_t WSE_NBLK = WSO_NBLK + al256(256);
constexpr size_t WSO_U = WSE_NBLK;
constexpr size_t WSE_U = WSO_U + al256((size_t)NTOK * INP * 2);
constexpr size_t WSO_MO = WSE_U;
constexpr size_t WSE_MO = WSO_MO + al256((size_t)NTOK * D * 4);
constexpr size_t WSO_END_P = WSE_MO;
constexpr size_t WSO_LR = WSO_END_P;
constexpr size_t WSE_LR = WSO_LR + al256((size_t)NTOK * 192 * 4);
constexpr size_t WSO_RW_R = WSE_LR;
constexpr size_t WSE_RW_R = WSO_RW_R + al256((size_t)NTOK * A_W * 4);
constexpr size_t WSO_RW_V = WSE_RW_R;
constexpr size_t WSE_RW_V = WSO_RW_V + al256((size_t)NTOK * A_W * 4);
constexpr size_t WSO_RW_KK = WSE_RW_V;
constexpr size_t WSE_RW_KK = WSO_RW_KK + al256((size_t)NTOK * A_W * 4);
constexpr size_t WSO_RW_D = WSE_RW_KK;
constexpr size_t WSE_RW_D = WSO_RW_D + al256((size_t)2 * NTOK * A_W * 4);
constexpr size_t WSO_RW_KD = WSE_RW_D;
constexpr size_t WSE_RW_KD = WSO_RW_KD + al256((size_t)2 * NTOK * A_W * 4);
constexpr size_t WSO_RW_KKA = WSE_RW_KD;
constexpr size_t WSE_RW_KKA = WSO_RW_KKA + al256((size_t)2 * NTOK * A_W * 4);
constexpr size_t WSO_RW_GATE = WSE_RW_KKA;
constexpr size_t WSE_RW_GATE = WSO_RW_GATE + al256((size_t)NTOK * A_W * 4);
constexpr size_t WSO_RW_BON = WSE_RW_GATE;
constexpr size_t WSE_RW_BON = WSO_RW_BON + al256((size_t)NTOK * A_H * 4);
constexpr size_t WSO_YA = WSE_RW_BON;
constexpr size_t WSE_YA = WSO_YA + al256((size_t)2 * NTOK * A_W * 4);
constexpr size_t WSO_GQ = WSE_YA;
constexpr size_t WSE_GQ = WSO_GQ + al256((size_t)NTOK * B_W * 4);
constexpr size_t WSO_GK = WSE_GQ;
constexpr size_t WSE_GK = WSO_GK + al256((size_t)NTOK * B_W * 4);
constexpr size_t WSO_GV = WSE_GK;
constexpr size_t WSE_GV = WSO_GV + al256((size_t)NTOK * B_W * 4);
constexpr size_t WSO_GG = WSE_GV;
constexpr size_t WSE_GG = WSO_GG + al256((size_t)NTOK * 8 * 4);
constexpr size_t WSO_GBETA = WSE_GG;
constexpr size_t WSE_GBETA = WSO_GBETA + al256((size_t)NTOK * 8 * 4);
constexpr size_t WSO_OB = WSE_GBETA;
constexpr size_t WSE_OB = WSO_OB + al256((size_t)2 * NTOK * B_W * 4);
constexpr size_t WSO_CQ = WSE_OB;
constexpr size_t WSE_CQ = WSO_CQ + al256((size_t)NTOK * 256 * 4);
constexpr size_t WSO_CK = WSE_CQ;
constexpr size_t WSE_CK = WSO_CK + al256((size_t)NTOK * 128 * 4);
constexpr size_t WSO_CV = WSE_CK;
constexpr size_t WSE_CV = WSO_CV + al256((size_t)NTOK * 128 * 4);
constexpr size_t WSO_MIX = WSE_CV;
constexpr size_t WSE_MIX = WSO_MIX + al256((size_t)NTOK * D * 2);
constexpr size_t WSO_XG = WSO_END_P;
constexpr size_t WSE_XG = WSO_XG + al256((size_t)NSLOT * D * 2);
constexpr size_t WSO_HH = WSE_XG;
constexpr size_t WSE_HH = WSO_HH + al256((size_t)NSLOT * DEXP * 2);
constexpr size_t WSO_YB = WSE_HH;
constexpr size_t WSE_YB = WSO_YB + al256((size_t)NSLOT * D * 2);
constexpr size_t WS_TOTAL = (WSE_MIX > WSE_YB ? WSE_MIX : WSE_YB);
struct P {
    const float *x, *c, *ctx, *c_ctx, *ada_w, *ada_b, *pre_norm, *post_norm, *w_in, *w_out;
    const float *rw_mu, *rw_w0, *rw_w2, *rw_a0, *rw_a2, *rw_g2, *rw_k_k, *rw_k_a, *rw_r_k, *rw_ln_w, *rw_ln_b;
    const float *gdn_conv, *gdn_a_log, *gdn_dt_bias, *gdn_norm, *attn_q_norm, *attn_k_norm;
    const float *router_w, *router_b, *exp_w_gu, *exp_b_gu, *exp_w_dn, *exp_b_dn;
    float* out;
    unsigned char* ws;
    WSACC unsigned* ctl() const { return (unsigned*)(ws + WSO_ctl); }
    WSACC float* MOD() const { return (float*)(ws + WSO_MOD); }
    WSACC float* X() const { return (float*)(ws + WSO_X); }
    WSACC bf16_t* HB() const { return (bf16_t*)(ws + WSO_HB); }
    WSACC bf16_t* WIN_T() const { return (bf16_t*)(ws + WSO_WIN_T); }
    WSACC bf16_t* WOUT_T() const { return (bf16_t*)(ws + WSO_WOUT_T); }
    WSACC bf16_t* WR_T() const { return (bf16_t*)(ws + WSO_WR_T); }
    WSACC bf16_t* WGU_T() const { return (bf16_t*)(ws + WSO_WGU_T); }
    WSACC bf16_t* WDN_T() const { return (bf16_t*)(ws + WSO_WDN_T); }
    WSACC int* TOPI() const { return (int*)(ws + WSO_TOPI); }
    WSACC int* POS() const { return (int*)(ws + WSO_POS); }
    WSACC int* TSLOT() const { return (int*)(ws + WSO_TSLOT); }
    WSACC float* TOPG() const { return (float*)(ws + WSO_TOPG); }
    WSACC int* SLOT_TOK() const { return (int*)(ws + WSO_SLOT_TOK); }
    WSACC int* BLOCK_E() const { return (int*)(ws + WSO_BLOCK_E); }
    WSACC int* NBLK() const { return (int*)(ws + WSO_NBLK); }
    WSACC bf16_t* U() const { return (bf16_t*)(ws + WSO_U); }
    WSACC float* MO() const { return (float*)(ws + WSO_MO); }
    WSACC float* LR() const { return (float*)(ws + WSO_LR); }
    WSACC float* RW_R() const { return (float*)(ws + WSO_RW_R); }
    WSACC float* RW_V() const { return (float*)(ws + WSO_RW_V); }
    WSACC float* RW_KK() const { return (float*)(ws + WSO_RW_KK); }
    WSACC float* RW_D() const { return (float*)(ws + WSO_RW_D); }
    WSACC float* RW_KD() const { return (float*)(ws + WSO_RW_KD); }
    WSACC float* RW_KKA() const { return (float*)(ws + WSO_RW_KKA); }
    WSACC float* RW_GATE() const { return (float*)(ws + WSO_RW_GATE); }
    WSACC float* RW_BON() const { return (float*)(ws + WSO_RW_BON); }
    WSACC float* YA() const { return (float*)(ws + WSO_YA); }
    WSACC float* GQ() const { return (float*)(ws + WSO_GQ); }
    WSACC float* GK() const { return (float*)(ws + WSO_GK); }
    WSACC float* GV() const { return (float*)(ws + WSO_GV); }
    WSACC float* GG() const { return (float*)(ws + WSO_GG); }
    WSACC float* GBETA() const { return (float*)(ws + WSO_GBETA); }
    WSACC float* OB() const { return (float*)(ws + WSO_OB); }
    WSACC float* CQ() const { return (float*)(ws + WSO_CQ); }
    WSACC float* CK() const { return (float*)(ws + WSO_CK); }
    WSACC float* CV() const { return (float*)(ws + WSO_CV); }
    WSACC bf16_t* MIX() const { return (bf16_t*)(ws + WSO_MIX); }
    WSACC bf16_t* XG() const { return (bf16_t*)(ws + WSO_XG); }
    WSACC bf16_t* HH() const { return (bf16_t*)(ws + WSO_HH); }
    WSACC bf16_t* YB() const { return (bf16_t*)(ws + WSO_YB); }
    WSACC int* cnt() const { return (int*)(ws + WSO_ctl) + 8192; }
    WSACC float* TOKF() const { return tokf; }
    float* tokf;
};

DEVFN void row_info(int m, int& b, int& t, int& len, int& base) {
    if (m < NLAT) { b = m / SEQ; t = m % SEQ; len = SEQ; base = b * SEQ; }
    else { const int mc = m - NLAT; b = mc / CTXL; t = mc % CTXL; len = CTXL; base = NLAT + b * CTXL; }
}
DEVFN float ldU(const P& p, size_t idx) { return bf2f(p.U()[idx]); }
DEVFN int mod_row(int m) { return m < NLAT ? m / SEQ : BATCH; }
DEVFN int scan_row(int dir, int b, int s) {
    if (s < CTXL) { const int ts = dir ? (CTXL - 1 - s) : s; return NLAT + b * CTXL + ts; }
    const int s2 = s - CTXL; const int ts = dir ? (SEQ - 1 - s2) : s2; return b * SEQ + ts;
}

DEVFN void task_mod(const P& p, long task) {
    const int j = (int)(task % (6 * D)); const int r = (int)((task / (6 * D)) % (BATCH + 1)); const int l = (int)(task / ((long)(6 * D) * (BATCH + 1)));
    const float* cv = (r < BATCH) ? p.c + (size_t)r * D : p.c_ctx;
    const float* w = p.ada_w + (size_t)l * D * 6 * D + j;
    float acc = 0.f;
    for (int k = 0; k < D; ++k) acc += siluf_(cv[k]) * w[(size_t)k * 6 * D];
    p.MOD()[((size_t)l * (BATCH + 1) + r) * 6 * D + j] = acc + p.ada_b[(size_t)l * 6 * D + j];
}
DEVFN void task_copyx(const P& p, long task) {
    const long n_lat = (long)NLAT * D;
    p.X()[task] = task < n_lat ? p.x[task] : p.ctx[task - n_lat];
}
DEVFN void task_norm1(const P& p, int l, long task) {
    const int m = (int)task; const float* xr = p.X() + (size_t)m * D;
    float ss = 0.f; for (int k = 0; k < D; ++k) ss += xr[k] * xr[k];
    const float rstd = 1.0f / sqrtf(ss / D + 1e-6f);
    const float* md = p.MOD() + ((size_t)l * (BATCH + 1) + mod_row(m)) * 6 * D; const float* pn = p.pre_norm + (size_t)(l * 2 + 0) * D;
    bf16_t* o = p.HB() + (size_t)m * D;
    for (int k = 0; k < D; ++k) o[k] = f2bf(xr[k] * rstd * pn[k] * (1.0f + md[D + k]) + md[k]);
}
DEVFN float lerpA(const P& p, int l, int m, int col) {
    int b, t, len, base; row_info(m, b, t, len, base);
    const float u = ldU(p, (size_t)m * INP + col);
    const float up = t > 0 ? ldU(p, (size_t)(m - 1) * INP + col) : 0.f, un = t + 1 < len ? ldU(p, (size_t)(m + 1) * INP + col) : 0.f;
    return u + p.rw_mu[l * A_IN + col] * (0.5f * (up + un) - u);
}
DEVFN void task_prepA0(const P& p, int l, long task) {
    const int m = (int)(task / 192), j = (int)(task % 192);
    const float v = lerpA(p, l, m, 768 + j);
    p.LR()[(size_t)m * 192 + j] = j < 64 ? tanhf(v) : (j < 128 ? v : sigmoidf_(v));
}
DEVFN void task_prepA1(const P& p, int l, long task) {
    const int m = (int)(task / A_H), h = (int)(task % A_H);
    const float* lr = p.LR() + (size_t)m * 192;
    float ss = 0.f;
    for (int c = 0; c < 64; ++c) { const int ch = h * 64 + c; const float kx = lerpA(p, l, m, 256 + ch) * p.rw_k_k[l * A_W + ch]; ss += kx * kx; }
    const float rn = 1.0f / sqrtf(ss + 1e-6f);
    float bon = 0.f;
    for (int c = 0; c < 64; ++c) {
        const int ch = h * 64 + c;
        const float r = lerpA(p, l, m, ch), k = lerpA(p, l, m, 256 + ch), v = lerpA(p, l, m, 512 + ch);
        const float kk = k * p.rw_k_k[l * A_W + ch] * rn;
        float kdsum = 0.f;
        for (int dir = 0; dir < 2; ++dir) {
            float w = p.rw_w0[(l * 2 + dir) * A_W + ch], a = p.rw_a0[(l * 2 + dir) * A_W + ch];
            const float* w2 = p.rw_w2 + ((size_t)(l * 2 + dir) * 32) * A_W + ch; const float* a2 = p.rw_a2 + ((size_t)(l * 2 + dir) * 32) * A_W + ch;
            for (int r2 = 0; r2 < 32; ++r2) { w += lr[dir * 32 + r2] * w2[(size_t)r2 * A_W]; a += lr[64 + dir * 32 + r2] * a2[(size_t)r2 * A_W]; }
            const float decay = expf(-expf(-softplusf_(-w) - 0.5f));
            const float iclr = sigmoidf_(a);
            const float kd = k * (1.0f + (iclr - 1.0f) * p.rw_k_a[l * A_W + ch]);
            const size_t o = ((size_t)dir * NTOK + m) * A_W + ch;
            p.RW_D()[o] = decay; p.RW_KD()[o] = kd; p.RW_KKA()[o] = kk * iclr; kdsum += kd;
        }
        float g = 0.f; const float* g2 = p.rw_g2 + (size_t)l * 64 * A_W + ch;
        for (int r2 = 0; r2 < 64; ++r2) g += lr[128 + r2] * g2[(size_t)r2 * A_W];
        const size_t o = (size_t)m * A_W + ch;
        p.RW_R()[o] = r; p.RW_V()[o] = v; p.RW_KK()[o] = kk; p.RW_GATE()[o] = g;
        bon += r * kdsum * p.rw_r_k[l * A_W + ch];
    }
    p.RW_BON()[(size_t)m * A_H + h] = bon;
}
DEVFN void task_prepB(const P& p, int l, long task) {
    const int which = (int)(task % 4), h = (int)((task / 4) % B_H), m = (int)(task / (4 * B_H));
    int b, t, len, base; row_info(m, b, t, len, base);
    if (which == 3) {
        for (int dir = 0; dir < 2; ++dir) {
            const float a = ldU(p, (size_t)m * INP + B_OFF + 2048 + dir * 4 + h), bb = ldU(p, (size_t)m * INP + B_OFF + 2056 + dir * 4 + h);
            const float g = -expf(p.gdn_a_log[(l * 2 + dir) * B_H + h]) * softplusf_(a + p.gdn_dt_bias[(l * 2 + dir) * B_H + h]);
            p.GG()[(size_t)m * 8 + dir * 4 + h] = g; p.GBETA()[(size_t)m * 8 + dir * 4 + h] = sigmoidf_(bb);
        }
        return;
    }
    float* dst = (which == 0 ? p.GQ() : which == 1 ? p.GK() : p.GV()) + (size_t)m * B_W + h * 128;
    float ss = 0.f;
    for (int c = 0; c < 128; ++c) {
        const int cc = which * B_W + h * 128 + c; const int col = B_OFF + cc;
        float acc = 0.f;
        for (int j = 0; j < 5; ++j) { const int tt = t + j - 2; if (tt >= 0 && tt < len) acc += ldU(p, (size_t)(base + tt) * INP + col) * p.gdn_conv[((size_t)l * 5 + j) * (3 * B_W) + cc]; }
        const float s = siluf_(acc); dst[c] = s; ss += s * s;
    }
    if (which < 2) { const float rn = (1.0f / sqrtf(ss + 1e-6f)) * (which == 0 ? 0.08838834764831845f : 1.0f); for (int c = 0; c < 128; ++c) dst[c] *= rn; }
}
DEVFN void task_prepC(const P& p, int l, long task) {
    const int m = (int)(task / 8), hs = (int)(task % 8);
    const size_t sb = (size_t)m * INP + C_OFF + hs * 64;
    if (hs >= 6) { float* dst = p.CV() + (size_t)m * 128 + (hs - 6) * 64; for (int d = 0; d < 64; ++d) dst[d] = ldU(p, sb + d); return; }
    float ss = 0.f; for (int d = 0; d < 64; ++d) { const float x = ldU(p, sb + d); ss += x * x; }
    const float rstd = 1.0f / sqrtf(ss / 64.f + 1e-6f);
    const float* nw = (hs < 4 ? p.attn_q_norm : p.attn_k_norm) + l * 64;
    float* dst = hs < 4 ? p.CQ() + (size_t)m * 256 + hs * 64 : p.CK() + (size_t)m * 128 + (hs - 4) * 64;
    if (m >= NLAT) { for (int d = 0; d < 64; ++d) dst[d] = ldU(p, sb + d) * rstd * nw[d]; return; }
    const int t = m % SEQ; const float pr = (float)(t / GRID_W), pc = (float)(t % GRID_W);
    for (int d = 0; d < 16; ++d) {
        const float fr = powf(10000.0f, -(float)d / 16.0f);
        const float ar = pr * fr, ac = pc * fr; const float cr = cosf(ar), sr = sinf(ar), cc = cosf(ac), sc = sinf(ac);
        const float x1 = ldU(p, sb + d) * rstd * nw[d], x2 = ldU(p, sb + 16 + d) * rstd * nw[16 + d], x3 = ldU(p, sb + 32 + d) * rstd * nw[32 + d], x4 = ldU(p, sb + 48 + d) * rstd * nw[48 + d];
        dst[d] = x1 * cr - x2 * sr; dst[16 + d] = x2 * cr + x1 * sr; dst[32 + d] = x3 * cc - x4 * sc; dst[48 + d] = x4 * cc + x3 * sc;
    }
}
DEVFN void task_scanA(const P& p, long task) {
    const int v = (int)(task % 64), chain = UNIFORM((int)(task / 64)); const int h = chain % A_H, b = (chain / A_H) % BATCH, dir = chain / (A_H * BATCH);
    float s[64];
#pragma unroll
    for (int k = 0; k < 64; ++k) s[k] = 0.f;
    for (int st = 0; st < SLEN; ++st) {
        const int m = scan_row(dir, b, st);
        const float* kk = p.RW_KK() + (size_t)m * A_W + h * 64; const float* rr = p.RW_R() + (size_t)m * A_W + h * 64;
        const size_t od = ((size_t)dir * NTOK + m) * A_W + h * 64;
        const float* dd = p.RW_D() + od; const float* kd = p.RW_KD() + od; const float* ka = p.RW_KKA() + od;
        const float vv = p.RW_V()[(size_t)m * A_W + h * 64 + v];
        float sa = 0.f;
#pragma unroll
        for (int k = 0; k < 64; ++k) { sa += s[k] * kk[k]; if ((k & 15) == 15) LOADFENCE(); }
        float y = 0.f;
#pragma unroll
        for (int k = 0; k < 64; ++k) { s[k] = s[k] * dd[k] - sa * ka[k] + vv * kd[k]; y += s[k] * rr[k]; if ((k & 7) == 7) LOADFENCE(); }
        p.YA()[((size_t)dir * NTOK + m) * A_W + h * 64 + v] = y;
    }
}
DEVFN void task_scanB(const P& p, long task) {
    const int j = (int)(task % 128), chain = UNIFORM((int)(task / 128)); const int h = chain % B_H, b = (chain / B_H) % BATCH, dir = chain / (B_H * BATCH);
    float s[128];
#pragma unroll
    for (int k = 0; k < 128; ++k) s[k] = 0.f;
    for (int st = 0; st < SLEN; ++st) {
        const int m = scan_row(dir, b, st);
        const float* kv = p.GK() + (size_t)m * B_W + h * 128; const float* qv = p.GQ() + (size_t)m * B_W + h * 128;
        const float vj = p.GV()[(size_t)m * B_W + h * 128 + j];
        const float eg = expf(p.GG()[(size_t)m * 8 + dir * 4 + h]), beta = p.GBETA()[(size_t)m * 8 + dir * 4 + h];
        float pk = 0.f;
#pragma unroll
        for (int k = 0; k < 128; ++k) { pk += s[k] * kv[k]; if ((k & 15) == 15) LOADFENCE(); }
        const float cf = beta * (vj - eg * pk);
        float o = 0.f;
#pragma unroll
        for (int k = 0; k < 128; ++k) { s[k] = eg * s[k] + cf * kv[k]; o += s[k] * qv[k]; if ((k & 7) == 7) LOADFENCE(); }
        p.OB()[((size_t)dir * NTOK + m) * B_W + h * 128 + j] = o;
    }
}
DEVFN void task_attn(const P& p, int need_ctx, long task) {
    const int t = (int)(task % SLEN), hq = UNIFORM((int)((task / SLEN) % 4)), b = UNIFORM((int)(task / ((long)SLEN * 4)));
    const bool is_lat = UNIFORM((int)(t < SEQ)) != 0; if (!is_lat && !need_ctx) return;
    const int m = is_lat ? b * SEQ + t : NLAT + b * CTXL + (t - SEQ);
    const int kvh = hq >> 1;
    float q[64], o[64];
#pragma unroll
    for (int d = 0; d < 64; ++d) { q[d] = p.CQ()[(size_t)m * 256 + hq * 64 + d] * 0.125f; o[d] = 0.f; }
    float mx = -1e30f, lsum = 0.f;
    const int nk = is_lat ? SLEN : CTXL;
    for (int kI = 0; kI < nk; ++kI) {
        int km; if (is_lat) km = kI < SEQ ? b * SEQ + kI : NLAT + b * CTXL + (kI - SEQ); else km = NLAT + b * CTXL + kI;
        const float* kr = p.CK() + (size_t)km * 128 + kvh * 64; const float* vr = p.CV() + (size_t)km * 128 + kvh * 64;
        float sc = 0.f;
#pragma unroll
        for (int d = 0; d < 64; ++d) { sc += q[d] * kr[d]; if ((d & 15) == 15) LOADFENCE(); }
        const float mn = sc > mx ? sc : mx; const float f = expf(mx - mn), pe = expf(sc - mn);
        lsum = lsum * f + pe; mx = mn;
#pragma unroll
        for (int d = 0; d < 64; ++d) { o[d] = o[d] * f + pe * vr[d]; if ((d & 15) == 15) LOADFENCE(); }
    }
    const float inv = 1.0f / lsum;
#pragma unroll
    for (int d = 0; d < 64; ++d) p.MIX()[(size_t)m * D + 768 + hq * 64 + d] = f2bf(o[d] * inv);
}
DEVFN void task_post(const P& p, int l, long task) {
    const int m = (int)(task / 8), g = (int)(task % 8);
    if (g < 4) {
        const int h = g; const float* y0 = p.YA() + (size_t)m * A_W + h * 64; const float* y1 = p.YA() + ((size_t)NTOK + m) * A_W + h * 64;
        float mean = 0.f; for (int c = 0; c < 64; ++c) mean += y0[c] + y1[c]; mean *= (1.0f / 64.f);
        float var = 0.f; for (int c = 0; c < 64; ++c) { const float d0 = y0[c] + y1[c] - mean; var += d0 * d0; } var *= (1.0f / 64.f);
        const float rs = 1.0f / sqrtf(var + 64e-5f); const float bon = p.RW_BON()[(size_t)m * A_H + h];
        for (int c = 0; c < 64; ++c) { const int ch = h * 64 + c;
            const float yn = (y0[c] + y1[c] - mean) * rs * p.rw_ln_w[l * A_W + ch] + p.rw_ln_b[l * A_W + ch];
            p.MIX()[(size_t)m * D + ch] = f2bf((yn + bon * p.RW_V()[(size_t)m * A_W + ch]) * p.RW_GATE()[(size_t)m * A_W + ch]); }
    } else {
        const int h = g - 4; const float* o0 = p.OB() + (size_t)m * B_W + h * 128; const float* o1 = p.OB() + ((size_t)NTOK + m) * B_W + h * 128;
        float ss = 0.f; for (int c = 0; c < 128; ++c) { const float o = o0[c] + o1[c]; ss += o * o; }
        const float rs = 1.0f / sqrtf(ss / 128.f + 1e-6f);
        for (int c = 0; c < 128; ++c) { const float z = ldU(p, (size_t)m * INP + B_OFF + 1536 + h * 128 + c);
            p.MIX()[(size_t)m * D + 256 + h * 128 + c] = f2bf((o0[c] + o1[c]) * rs * p.gdn_norm[l * 128 + c] * siluf_(z)); }
    }
}
DEVFN void task_resid1(const P& p, int l, long task) {
    const int m = (int)task; const float* mo = p.MO() + (size_t)m * D; float* xr = p.X() + (size_t)m * D;
    const float* md = p.MOD() + ((size_t)l * (BATCH + 1) + mod_row(m)) * 6 * D;
    float ss = 0.f; for (int k = 0; k < D; ++k) ss += mo[k] * mo[k];
    const float rstd = 1.0f / sqrtf(ss / D + 1e-6f); const float* pn = p.post_norm + (size_t)(l * 2 + 0) * D;
    float s2 = 0.f;
    for (int k = 0; k < D; ++k) { const float xv = xr[k] + md[2 * D + k] * (mo[k] * rstd) * pn[k]; xr[k] = xv; s2 += xv * xv; }
    const float r2 = 1.0f / sqrtf(s2 / D + 1e-6f); const float* pn2 = p.pre_norm + (size_t)(l * 2 + 1) * D;
    for (int k = 0; k < D; ++k) { const float tv = xr[k] * r2 * pn2[k] * (1.0f + md[4 * D + k]) + md[3 * D + k]; p.TOKF()[(size_t)m * D + k] = tv; p.HB()[(size_t)m * D + k] = f2bf(tv); }
}
DEVFN void task_router(const P& p, int l, long task) {
    const int m = (int)task; const float* tk = p.TOKF() + (size_t)m * D; const float* rw = p.router_w + (size_t)l * D * NEXP;
    float lg[NEXP];
#pragma unroll
    for (int e = 0; e < NEXP; ++e) lg[e] = p.router_b[l * NEXP + e];
    for (int k = 0; k < D; ++k) { const float tv = tk[k];
#pragma unroll
        for (int e = 0; e < NEXP; ++e) lg[e] += tv * rw[(size_t)k * NEXP + e]; }
    int idx[TOPK]; float val[TOPK];
#pragma unroll
    for (int j = 0; j < TOPK; ++j) { float best = -3.0e38f; int bi = 0;
#pragma unroll
        for (int e = 0; e < NEXP; ++e) { if (lg[e] > best) { best = lg[e]; bi = e; } }
        idx[j] = bi; val[j] = best;
#pragma unroll
        for (int e = 0; e < NEXP; ++e) if (e == bi) lg[e] = -3.0e38f; }
    float sum = 0.f, ex[TOPK];
#pragma unroll
    for (int j = 0; j < TOPK; ++j) { ex[j] = expf(val[j] - val[0]); sum += ex[j]; }
#pragma unroll
    for (int j = 0; j < TOPK; ++j) { p.TOPI()[(size_t)m * TOPK + j] = idx[j]; p.TOPG()[(size_t)m * TOPK + j] = ex[j] / sum; p.POS()[(size_t)m * TOPK + j] = GLOBAL_ATOMIC_ADD(&p.cnt()[l * NEXP + idx[j]], 1); }
}
DEVFN int moe_pstart(const P& p, int l, int e, int* nblk) {
    int acc = 0, ps = 0;
    for (int i = 0; i < NEXP; ++i) { if (i == e) ps = acc; acc += (p.cnt()[l * NEXP + i] + 255) / 256 * 256; }
    if (nblk) *nblk = acc / 256; return ps;
}
DEVFN void task_slots(const P& p, int l, long task) {
    const int e = p.TOPI()[task]; const int slot = moe_pstart(p, l, e, nullptr) + p.POS()[task];
    p.TSLOT()[task] = slot; p.SLOT_TOK()[slot] = (int)(task / TOPK);
}
DEVFN void task_blocke(const P& p, int l, long task) {
    int acc = 0, e_of = NEXP - 1, nb = 0;
    for (int i = 0; i < NEXP; ++i) { const int nbk = (p.cnt()[l * NEXP + i] + 255) / 256; if ((int)task >= acc && (int)task < acc + nbk) e_of = i; acc += nbk; }
    nb = acc; p.BLOCK_E()[task] = e_of; if (task == 0) p.NBLK()[0] = nb;
}
DEVFN void task_gather(const P& p, long task) {
    const long slot = task / 128; const int ch = (int)(task % 128); const int tok = p.SLOT_TOK()[slot];
    const uint4* s = (const uint4*)(p.HB() + (size_t)tok * D) + ch; ((uint4*)(p.XG() + (size_t)slot * D))[ch] = *s;
}
DEVFN void task_combine(const P& p, int l, long task) {
    const int m = (int)task; float* xr = p.X() + (size_t)m * D; const float* md = p.MOD() + ((size_t)l * (BATCH + 1) + mod_row(m)) * 6 * D;
    const bf16_t* y0 = p.YB() + (size_t)p.TSLOT()[(size_t)m * 4 + 0] * D; const bf16_t* y1 = p.YB() + (size_t)p.TSLOT()[(size_t)m * 4 + 1] * D;
    const bf16_t* y2 = p.YB() + (size_t)p.TSLOT()[(size_t)m * 4 + 2] * D; const bf16_t* y3 = p.YB() + (size_t)p.TSLOT()[(size_t)m * 4 + 3] * D;
    const float g0 = p.TOPG()[(size_t)m * 4 + 0], g1 = p.TOPG()[(size_t)m * 4 + 1], g2 = p.TOPG()[(size_t)m * 4 + 2], g3 = p.TOPG()[(size_t)m * 4 + 3];
    float ss = 0.f;
    for (int k = 0; k < D; ++k) { const float f = g0 * bf2f(y0[k]) + g1 * bf2f(y1[k]) + g2 * bf2f(y2[k]) + g3 * bf2f(y3[k]); ss += f * f; }
    const float rstd = 1.0f / sqrtf(ss / D + 1e-6f); const float* pn = p.post_norm + (size_t)(l * 2 + 1) * D;
    const bool last = (l == DEPTH - 1);
    for (int k = 0; k < D; ++k) { const float f = g0 * bf2f(y0[k]) + g1 * bf2f(y1[k]) + g2 * bf2f(y2[k]) + g3 * bf2f(y3[k]);
        const float xv = xr[k] + md[5 * D + k] * (f * rstd) * pn[k]; xr[k] = xv; if (last) p.out[(size_t)m * D + k] = xv; }
}

#ifndef HOST_TEST
namespace pg8 {
#define PG8_LAS __attribute__((address_space(3)))
typedef short bf16x8 __attribute__((ext_vector_type(8)));
typedef float f32x4 __attribute__((ext_vector_type(4)));
typedef unsigned u32x4 __attribute__((ext_vector_type(4)));
typedef unsigned u32x2 __attribute__((ext_vector_type(2)));
constexpr int BM = 256, BK = 64, HALF = 128, HTB = HALF * BK * 2, STAGE_BYTES = 8 * HTB, NXCD = 8, WGM = 8;
__host__ __device__ __forceinline__ int lds_byte(int r, int c) { const int st = (r >> 4) * 2 + (c >> 5), rr = r & 15, cc = c & 31, ob = rr * 64 + cc * 2; return st * 1024 + (ob ^ (((ob >> 9) & 1) << 5)); }
__host__ __device__ __forceinline__ void stage_rc(int b, int& R, int& C) { const int st = b / 1024, sb = b % 1024, swz = sb ^ (((sb >> 9) & 1) << 5); R = (st >> 1) * 16 + swz / 64; C = (st & 1) * 32 + (swz % 64) / 2; }
__host__ __device__ __forceinline__ int perm32(int rho) { const int n = rho >> 4, i = rho & 15; return 8 * (i >> 2) + 4 * n + (i & 3); }
struct Unit { int pm, pn, e; };
struct Gemm { const bf16_t* A; const bf16_t* Bt; int K; size_t estride; };
struct StaticOrder {
    int nM, nN, nwg, G, c;
    __device__ void init(int M, int N, int G_, int c_) { nM = M / BM; nN = N / BM; nwg = nM * nN; G = G_; c = c_; }
    __device__ bool next(int i, Unit& u) const {
        const long L = (long)i * G + c; if (L >= nwg) return false;
        int wgid = (int)L; { const int q = nwg / NXCD, r = nwg % NXCD, xcd = wgid % NXCD, off = wgid / NXCD; wgid = (xcd < r ? xcd * (q + 1) : r * (q + 1) + (xcd - r) * q) + off; }
        const int nig = WGM * nN, gid = wgid / nig, fm = gid * WGM, gsz = (nM - fm) < WGM ? (nM - fm) : WGM;
        u.pm = fm + ((wgid % nig) % gsz); u.pn = (wgid % nig) / gsz; u.e = 0; return true;
    }
};
struct MoeOrder {
    int nblk, nN, G, c; const int* block_e;
    __device__ bool next(int i, Unit& u) const {
        const long L = (long)i * G + c; if (L >= (long)nblk * nN) return false;
        u.pm = (int)(L / nN); u.pn = (int)(L % nN); u.e = block_e[u.pm]; return true;
    }
};
__device__ __forceinline__ unsigned cvt_pk_bf16(float lo, float hi) { unsigned r; asm volatile("v_cvt_pk_bf16_f32 %0, %1, %2" : "=v"(r) : "v"(lo), "v"(hi)); return r; }
struct EpiF32 {
    static constexpr bool PERM = false;
    float* C; int ldc;
    __device__ __forceinline__ void operator()(const f32x4 (&acc)[2][2][4][2], const Unit& u, int wr, int wc, int fr, int fq) const {
        const int row0 = u.pm * BM + wr * 64 + fr, col0 = u.pn * BM + wc * 32 + 4 * fq;
#pragma unroll
        for (int ai = 0; ai < 2; ++ai)
#pragma unroll
            for (int m = 0; m < 4; ++m) { float* rowp = C + (size_t)(row0 + ai * HALF + m * 16) * ldc + col0;
#pragma unroll
                for (int bj = 0; bj < 2; ++bj)
#pragma unroll
                    for (int n = 0; n < 2; ++n) *(f32x4*)(rowp + bj * HALF + n * 16) = acc[ai][bj][m][n]; }
    }
};
struct EpiBf16Bias {
    static constexpr bool PERM = true;
    bf16_t* O; int ldc; const float* bias; int bias_estride;
    __device__ __forceinline__ void operator()(const f32x4 (&acc)[2][2][4][2], const Unit& u, int wr, int wc, int fr, int fq) const {
        const int row0 = u.pm * BM + wr * 64 + fr, col0 = u.pn * BM + wc * 32 + 8 * fq; const float* bp = bias + (size_t)u.e * bias_estride + col0;
        f32x4 bv[2][2];
#pragma unroll
        for (int bj = 0; bj < 2; ++bj)
#pragma unroll
            for (int n = 0; n < 2; ++n) bv[bj][n] = bias ? *(const f32x4*)(bp + bj * HALF + 4 * n) : (f32x4){0.f, 0.f, 0.f, 0.f};
#pragma unroll
        for (int ai = 0; ai < 2; ++ai)
#pragma unroll
            for (int m = 0; m < 4; ++m) { bf16_t* rowp = O + (size_t)(row0 + ai * HALF + m * 16) * ldc + col0;
#pragma unroll
                for (int bj = 0; bj < 2; ++bj) { const f32x4 v0 = acc[ai][bj][m][0] + bv[bj][0], v1 = acc[ai][bj][m][1] + bv[bj][1];
                    u32x4 w; w.x = cvt_pk_bf16(v0[0], v0[1]); w.y = cvt_pk_bf16(v0[2], v0[3]); w.z = cvt_pk_bf16(v1[0], v1[1]); w.w = cvt_pk_bf16(v1[2], v1[3]);
                    *(u32x4*)(rowp + bj * HALF) = w; } }
    }
};
__device__ __forceinline__ float swiglu1(float g, float lin) { g = fminf(g, 7.0f); lin = fminf(fmaxf(lin, -7.0f), 7.0f); return g / (1.0f + __expf(-1.702f * g)) * (lin + 1.0f); }
struct EpiSwiglu {
    static constexpr bool PERM = true;
    bf16_t* O; int ldc; const float* bias; int bias_estride;
    __device__ __forceinline__ void operator()(const f32x4 (&acc)[2][2][4][2], const Unit& u, int wr, int wc, int fr, int fq) const {
        const int row0 = u.pm * BM + wr * 64 + fr, col0 = u.pn * BM + wc * 32 + 8 * fq; const float* bp = bias + (size_t)u.e * bias_estride + col0;
        f32x4 bv[2][2];
#pragma unroll
        for (int bj = 0; bj < 2; ++bj)
#pragma unroll
            for (int n = 0; n < 2; ++n) bv[bj][n] = *(const f32x4*)(bp + bj * HALF + 4 * n);
#pragma unroll
        for (int ai = 0; ai < 2; ++ai)
#pragma unroll
            for (int m = 0; m < 4; ++m) { bf16_t* rowp = O + (size_t)(row0 + ai * HALF + m * 16) * ldc + (col0 >> 1);
#pragma unroll
                for (int bj = 0; bj < 2; ++bj) { const f32x4 v0 = acc[ai][bj][m][0] + bv[bj][0], v1 = acc[ai][bj][m][1] + bv[bj][1];
                    u32x2 w; w.x = cvt_pk_bf16(swiglu1(v0[0], v0[1]), swiglu1(v0[2], v0[3])); w.y = cvt_pk_bf16(swiglu1(v1[0], v1[1]), swiglu1(v1[2], v1[3]));
                    *(u32x2*)(rowp + bj * (HALF / 2)) = w; } }
    }
};

template <class Epi, class Sched>
__device__ __forceinline__ void gemm_phase(PG8_LAS unsigned char* lds, const Gemm g, const Sched& S, const Epi& E) {
    int tid = threadIdx.x; asm volatile("" : "+v"(tid));
    const int wid = __builtin_amdgcn_readfirstlane(tid >> 6), lane = tid & 63, wr = wid >> 2, wc = wid & 3, fr = lane & 15, fq = lane >> 4;
    const int K = g.K, nt = K / BK;
    unsigned voffA[2], voffB[2];
#pragma unroll
    for (int i = 0; i < 2; ++i) { int R, C; stage_rc(tid * 16 + i * 8192, R, C); const int Rb = Epi::PERM ? ((R & ~31) + perm32(R & 31)) : R;
        voffA[i] = (unsigned)(R * K + C) * 2u; voffB[i] = (unsigned)(Rb * K + C) * 2u; }
    const size_t kstep = (size_t)(BK * 2);
    const size_t hstep = (size_t)HALF * K * 2;
    const size_t tstep = 2 * hstep;
    const unsigned ldsw = (unsigned)wid * 1024u;
    const int aoff = lds_byte(wr * 64 + fr, fq * 8), boff = lds_byte(wc * 32 + fr, fq * 8);
#define PG8_SA(b, h) (((b) * 2 + (h)) * HTB)
#define PG8_SB(b, h) ((4 + (b) * 2 + (h)) * HTB)
#define PG8_STAGE(bufoff, gbase, voff) do { _Pragma("unroll") for (int _i = 0; _i < 2; ++_i) \
        __builtin_amdgcn_global_load_lds((const unsigned*)((const char*)(gbase) + (voff)[_i]), (PG8_LAS unsigned*)(lds + (bufoff) + ldsw + _i * 8192), 16, 0, 0); } while (0)
#define PG8_LDA(dst, b, h) do { _Pragma("unroll") for (int m = 0; m < 4; ++m) _Pragma("unroll") for (int k = 0; k < 2; ++k) dst[m][k] = *(const PG8_LAS bf16x8*)(lds + PG8_SA(b, h) + aoff + m * 2048 + k * 1024); } while (0)
#define PG8_LDB(dst, b, h) do { _Pragma("unroll") for (int n = 0; n < 2; ++n) _Pragma("unroll") for (int k = 0; k < 2; ++k) dst[n][k] = *(const PG8_LAS bf16x8*)(lds + PG8_SB(b, h) + boff + n * 2048 + k * 1024); } while (0)
#define PG8_MMA(ai, bj, At, Bt) do { __builtin_amdgcn_s_setprio(1); _Pragma("unroll") for (int m = 0; m < 4; ++m) _Pragma("unroll") for (int n = 0; n < 2; ++n) _Pragma("unroll") for (int k = 0; k < 2; ++k) \
        acc[ai][bj][m][n] = __builtin_amdgcn_mfma_f32_16x16x32_bf16(Bt[n][k], At[m][k], acc[ai][bj][m][n], 0, 0, 0); __builtin_amdgcn_s_setprio(0); } while (0)
#define PG8_WAIT_V(n) asm volatile("s_waitcnt vmcnt(" #n ")" ::: "memory")
#define PG8_WAIT_L(n) asm volatile("s_waitcnt lgkmcnt(" #n ")" ::: "memory")
#define PG8_BAR __builtin_amdgcn_s_barrier()
#define PG8_SCHED __builtin_amdgcn_sched_barrier(0)
    Unit cur, nxt; int ui = 0;
    if (!S.next(0, cur)) return;
    f32x4 acc[2][2][4][2];
#pragma unroll
    for (int a = 0; a < 2; ++a)
#pragma unroll
        for (int b = 0; b < 2; ++b)
#pragma unroll
            for (int m = 0; m < 4; ++m)
#pragma unroll
                for (int n = 0; n < 2; ++n) acc[a][b][m][n] = (f32x4){0.f, 0.f, 0.f, 0.f};
    bf16x8 At[4][2], B0[2][2], B1[2][2];
    const char* cA = (const char*)g.A + (size_t)cur.pm * tstep; const char* cB = (const char*)(g.Bt + (size_t)cur.e * g.estride) + (size_t)cur.pn * tstep;
    PG8_STAGE(PG8_SB(0, 0), cB, voffB); PG8_STAGE(PG8_SB(0, 1), cB + hstep, voffB); PG8_STAGE(PG8_SA(0, 0), cA, voffA); PG8_STAGE(PG8_SA(0, 1), cA + hstep, voffA);
    if (wr == 1) PG8_BAR;
    PG8_WAIT_V(2); PG8_BAR;
    PG8_STAGE(PG8_SB(1, 0), cB + kstep, voffB); PG8_STAGE(PG8_SA(1, 0), cA + kstep, voffA); PG8_STAGE(PG8_SB(1, 1), cB + hstep + kstep, voffB);
    PG8_WAIT_V(6); PG8_BAR;
    for (;;) {
        const bool has_next = S.next(ui + 1, nxt);
        const char* nA = has_next ? (const char*)g.A + (size_t)nxt.pm * tstep : cA; const char* nB = has_next ? (const char*)(g.Bt + (size_t)nxt.e * g.estride) + (size_t)nxt.pn * tstep : cB;
        for (int t = 0; t < nt; t += 2) {
            const bool last = (t == nt - 2);
            const char* a1 = cA + (size_t)(t + 1) * kstep;
            const char* a2 = last ? nA : cA + (size_t)(t + 2) * kstep; const char* b2 = last ? nB : cB + (size_t)(t + 2) * kstep;
            const char* a3 = a2 + kstep; const char* b3 = b2 + kstep;
            PG8_LDB(B0, 0, 0); PG8_LDB(B1, 0, 1); PG8_SCHED; PG8_LDA(At, 0, 0); PG8_STAGE(PG8_SA(1, 1), a1 + hstep, voffA);
            PG8_WAIT_V(8); PG8_WAIT_L(0); PG8_BAR; PG8_MMA(0, 0, At, B0); PG8_MMA(0, 1, At, B1); PG8_BAR; PG8_SCHED;
            PG8_LDA(At, 0, 1); PG8_STAGE(PG8_SB(0, 0), b2, voffB); PG8_STAGE(PG8_SB(0, 1), b2 + hstep, voffB); PG8_STAGE(PG8_SA(0, 0), a2, voffA);
            PG8_WAIT_V(8); PG8_WAIT_L(0); PG8_BAR; PG8_MMA(1, 0, At, B0); PG8_MMA(1, 1, At, B1); PG8_BAR; PG8_SCHED;
            PG8_LDB(B0, 1, 0); PG8_LDB(B1, 1, 1); PG8_SCHED; PG8_LDA(At, 1, 0); PG8_STAGE(PG8_SA(0, 1), a2 + hstep, voffA);
            PG8_WAIT_V(8); PG8_WAIT_L(0); PG8_BAR; PG8_MMA(0, 0, At, B0); PG8_MMA(0, 1, At, B1); PG8_BAR; PG8_SCHED;
            PG8_LDA(At, 1, 1); PG8_STAGE(PG8_SB(1, 0), b3, voffB); PG8_STAGE(PG8_SB(1, 1), b3 + hstep, voffB); PG8_STAGE(PG8_SA(1, 0), a3, voffA);
            PG8_WAIT_V(8); PG8_WAIT_L(0); PG8_BAR; PG8_MMA(1, 0, At, B0); PG8_MMA(1, 1, At, B1); PG8_BAR; PG8_SCHED;
        }
        if (wr == 0) PG8_BAR;
        E(acc, cur, wr, wc, fr, fq);
        if (!has_next) break;
#pragma unroll
        for (int a = 0; a < 2; ++a)
#pragma unroll
            for (int b = 0; b < 2; ++b)
#pragma unroll
                for (int m = 0; m < 4; ++m)
#pragma unroll
                    for (int n = 0; n < 2; ++n) acc[a][b][m][n] = (f32x4){0.f, 0.f, 0.f, 0.f};
        cur = nxt; cA = nA; cB = nB; ++ui;
        if (wr == 1) PG8_BAR;
    }
    PG8_WAIT_V(0);
    PG8_BAR;
#undef PG8_SA
#undef PG8_SB
#undef PG8_STAGE
#undef PG8_LDA
#undef PG8_LDB
#undef PG8_MMA
#undef PG8_WAIT_V
#undef PG8_WAIT_L
#undef PG8_BAR
#undef PG8_SCHED
}
}

#define XB_TMO      128
#define XB_XCNT(j)  (256  + 64 * (j))
#define XB_XSUB(j)  (1280 + 64 * (j))
#define XB_XGEN(j)  (2304 + 64 * (j))
#define XB_TOP      3328
#define XB_TOPGEN   3392
#define XCD_BAR_WORDS 3456
#define XB_SPIN_CAP (1u << 22)
#define LAS __attribute__((address_space(3)))
__device__ __forceinline__ unsigned xb_ld(unsigned* p)              { return __hip_atomic_load(p, __ATOMIC_RELAXED, __HIP_MEMORY_SCOPE_AGENT); }
__device__ __forceinline__ unsigned xb_add(unsigned* p, unsigned v) { return __hip_atomic_fetch_add(p, v, __ATOMIC_RELAXED, __HIP_MEMORY_SCOPE_AGENT); }
__device__ __forceinline__ unsigned xb_xcc_id() { return (unsigned)__builtin_amdgcn_s_getreg((3 << 11) | 20) & 0xFu; }
#define XB_SPIN(cond, bar) do { unsigned _sp = 0; while (cond) { __builtin_amdgcn_s_sleep(1); \
    if ((++_sp & 255u) == 0u) { if (xb_ld(&(bar)[XB_TMO])) break; if (_sp > XB_SPIN_CAP) { atomicAdd(&(bar)[XB_TMO], 1u); break; } } } } while (0)
struct XcdBarrier { unsigned* bar; unsigned x; volatile LAS unsigned* st; };
__device__ __forceinline__ XcdBarrier xcd_barrier_post(unsigned* bar, volatile LAS unsigned* st) {
    XcdBarrier b; b.bar = bar; b.x = xb_xcc_id(); b.st = st;
    if (threadIdx.x == 0) (void)xb_add(&bar[XB_XCNT(b.x)], 1u);
    return b;
}
__device__ __forceinline__ void xcd_barrier_complete(unsigned* bar, unsigned x, unsigned& nloc, unsigned& nx) {
    const unsigned G = gridDim.x * gridDim.y * gridDim.z;
    unsigned sum, cnt, mine, sp = 0u;
    for (;;) {
        sum = 0u; cnt = 0u; mine = 0u;
#pragma unroll
        for (unsigned j = 0; j < 16; ++j) { const unsigned c = xb_ld(&bar[XB_XCNT(j)]); sum += c; cnt += (c > 0u) ? 1u : 0u; mine = (j == x) ? c : mine; }
        if (sum == G) break;
        __builtin_amdgcn_s_sleep(1);
        if ((++sp & 255u) == 0u) { if (xb_ld(&bar[XB_TMO])) break; if (sp > XB_SPIN_CAP) { atomicAdd(&bar[XB_TMO], 1u); break; } }
    }
    nloc = mine > 0u ? mine : 1u; nx = cnt > 0u ? cnt : 1u;
}
__device__ __forceinline__ void xcd_barrier(const XcdBarrier& b) {
    asm volatile("s_waitcnt vmcnt(0)" ::: "memory");
    __syncthreads();
    if (threadIdx.x == 0) {
        unsigned* bar = b.bar;
        __builtin_amdgcn_s_waitcnt(0);
        unsigned nloc = b.st[0], nx = b.st[1];
        if (nloc == 0u) { xcd_barrier_complete(bar, b.x, nloc, nx); b.st[0] = nloc; b.st[1] = nx; }
        const unsigned old = xb_add(&bar[XB_XSUB(b.x)], 1u);
        const unsigned gen = old / nloc;
        if (old + 1u == (gen + 1u) * nloc) {
            __builtin_amdgcn_fence(__ATOMIC_RELEASE, "agent");
            asm volatile("s_waitcnt vmcnt(0)" ::: "memory");
            const unsigned og = xb_add(&bar[XB_TOP], 1u);
            const unsigned tg = og / nx;
            if (og + 1u == (tg + 1u) * nx) xb_add(&bar[XB_TOPGEN], 1u);
            else XB_SPIN(xb_ld(&bar[XB_TOPGEN]) == tg, bar);
            __builtin_amdgcn_fence(__ATOMIC_ACQUIRE, "agent");
            xb_add(&bar[XB_XGEN(b.x)], 1u);
            asm volatile("s_waitcnt vmcnt(0)" ::: "memory");
        } else {
            XB_SPIN(xb_ld(&bar[XB_XGEN(b.x)]) == gen, bar);
            __builtin_amdgcn_fence(__ATOMIC_ACQUIRE, "agent");
            asm volatile("s_waitcnt vmcnt(0)" ::: "memory");
        }
    }
    __syncthreads();
}


constexpr int NWAVES = 8, NTHR = 512;
typedef float f32x4_t __attribute__((ext_vector_type(4)));
typedef unsigned u32x2_t __attribute__((ext_vector_type(2)));
typedef unsigned u32x4_t __attribute__((ext_vector_type(4)));
typedef short bf16x8_t __attribute__((ext_vector_type(8)));
__device__ __forceinline__ float wave_sum(float v) {
#pragma unroll
    for (int o = 1; o < 64; o <<= 1) v += __shfl_xor(v, o);
    return v;
}
__device__ __forceinline__ float grp16_sum(float v) {
#pragma unroll
    for (int o = 1; o < 16; o <<= 1) v += __shfl_xor(v, o);
    return v;
}
__device__ __forceinline__ float hsum4(f32x4_t a) { return (a.x + a.y) + (a.z + a.w); }
__device__ __forceinline__ float hsq4(f32x4_t a) { return (a.x * a.x + a.y * a.y) + (a.z * a.z + a.w * a.w); }
__device__ __forceinline__ u32x2_t pk4(f32x4_t t) { u32x2_t w; w.x = pg8::cvt_pk_bf16(t.x, t.y); w.y = pg8::cvt_pk_bf16(t.z, t.w); return w; }
__device__ __forceinline__ float bflo(unsigned w) { return __builtin_bit_cast(float, w << 16); }
__device__ __forceinline__ float bfhi(unsigned w) { return __builtin_bit_cast(float, w & 0xffff0000u); }
template <bool TO_LDS> __device__ __forceinline__ void norm_mod_store(const f32x4_t (&v)[4], float rstd, const float* pn, const float* sh, const float* sc, bf16_t* orow, LAS unsigned char* lrow, int lane) {
#pragma unroll
    for (int j = 0; j < 4; ++j) { const int k = 4 * lane + 256 * j;
        const f32x4_t pv = *(const f32x4_t*)(pn + k), sv = *(const f32x4_t*)(sc + k), hv = *(const f32x4_t*)(sh + k);
        const f32x4_t t = v[j] * rstd * pv * (1.0f + sv) + hv; const u32x2_t w = pk4(t);
        *(u32x2_t*)(orow + k) = w; if (TO_LDS) *(LAS u32x2_t*)(lrow + 2 * k) = w; }
}
__device__ __forceinline__ void dev_norm1_l0(const P& p, int gw, int ngw, int lane) {
    const float* md0 = p.MOD(); const float* pn = p.pre_norm;
    for (int m = gw; m < NTOK; m += ngw) {
        const float* src = m < NLAT ? p.x + (size_t)m * D : p.ctx + (size_t)(m - NLAT) * D;
        f32x4_t v[4]; float ss = 0.f;
#pragma unroll
        for (int j = 0; j < 4; ++j) { v[j] = *(const f32x4_t*)(src + 4 * lane + 256 * j); ss += hsq4(v[j]); *(f32x4_t*)(p.X() + (size_t)m * D + 4 * lane + 256 * j) = v[j]; }
        const float rstd = 1.0f / sqrtf(wave_sum(ss) * (1.0f / D) + 1e-6f);
        const float* md = md0 + (size_t)mod_row(m) * 6 * D;
        norm_mod_store<false>(v, rstd, pn, md, md + D, p.HB() + (size_t)m * D, (LAS unsigned char*)0, lane);
    }
}
__device__ __forceinline__ void dev_post(const P& p, int l, int ntok_l, int gw, int ngw, int lane) {
    const int h = lane >> 4;
    for (int m = gw; m < ntok_l; m += ngw) {
        {
            const f32x4_t y = *(const f32x4_t*)(p.YA() + (size_t)m * A_W + 4 * lane) + *(const f32x4_t*)(p.YA() + ((size_t)NTOK + m) * A_W + 4 * lane);
            const float mean = grp16_sum(hsum4(y)) * (1.0f / 64.f); const f32x4_t d = y - mean;
            const float var = grp16_sum(hsq4(d)) * (1.0f / 64.f); const float rs = 1.0f / sqrtf(var + 64e-5f);
            const f32x4_t lw = *(const f32x4_t*)(p.rw_ln_w + l * A_W + 4 * lane), lb = *(const f32x4_t*)(p.rw_ln_b + l * A_W + 4 * lane);
            const f32x4_t vv = *(const f32x4_t*)(p.RW_V() + (size_t)m * A_W + 4 * lane), gt = *(const f32x4_t*)(p.RW_GATE() + (size_t)m * A_W + 4 * lane);
            const float bon = p.RW_BON()[(size_t)m * A_H + h];
            const f32x4_t o = (d * rs * lw + lb + bon * vv) * gt;
            *(u32x2_t*)(p.MIX() + (size_t)m * D + 4 * lane) = pk4(o);
        }
        {
            const float* o0 = p.OB() + (size_t)m * B_W + 8 * lane; const float* o1 = p.OB() + ((size_t)NTOK + m) * B_W + 8 * lane;
            const f32x4_t a = *(const f32x4_t*)o0 + *(const f32x4_t*)o1, b = *(const f32x4_t*)(o0 + 4) + *(const f32x4_t*)(o1 + 4);
            const float rs = 1.0f / sqrtf(grp16_sum(hsq4(a) + hsq4(b)) * (1.0f / 128.f) + 1e-6f);
            const u32x4_t zr = *(const u32x4_t*)(p.U() + (size_t)m * INP + B_OFF + 1536 + 8 * lane);
            const float* nw = p.gdn_norm + l * 128 + ((8 * lane) & 127);
            const f32x4_t n0 = *(const f32x4_t*)nw, n1 = *(const f32x4_t*)(nw + 4);
            const f32x4_t z0 = {bflo(zr.x), bfhi(zr.x), bflo(zr.y), bfhi(zr.y)}, z1 = {bflo(zr.z), bfhi(zr.z), bflo(zr.w), bfhi(zr.w)};
            f32x4_t s0, s1;
#pragma unroll
            for (int c = 0; c < 4; ++c) { s0[c] = z0[c] / (1.0f + __expf(-z0[c])); s1[c] = z1[c] / (1.0f + __expf(-z1[c])); }
            const f32x4_t r0 = a * rs * n0 * s0, r1 = b * rs * n1 * s1;
            u32x4_t w; const u32x2_t w0 = pk4(r0), w1 = pk4(r1); w.x = w0.x; w.y = w0.y; w.z = w1.x; w.w = w1.y;
            *(u32x4_t*)(p.MIX() + (size_t)m * D + 256 + 8 * lane) = w;
        }
    }
}
constexpr int RT_TK = 0, RT_TKS = 2064, RT_PL = 34816, RT_LG = RT_PL + 16384, RT_CNT = RT_LG + 2304, RT_BASE = RT_CNT + 128, RT_ASG = RT_BASE + 128, RT_ASG_MAX = 4096;
__device__ __forceinline__ void dev_resid_router(const P& p, int l, int ntok_l, LAS unsigned char* lds, int G, int tid) {
    const int lane = tid & 63, wave = tid >> 6;
    LAS int* LCNT = (LAS int*)(lds + RT_CNT); LAS int* LBASE = (LAS int*)(lds + RT_BASE); LAS int* ASG = (LAS int*)(lds + RT_ASG);
    LAS float* PL = (LAS float*)(lds + RT_PL); LAS float* LG = (LAS float*)(lds + RT_LG);
    if (tid < 32) LCNT[tid] = 0;
    __syncthreads();
    const float* pn = p.post_norm + (size_t)(l * 2 + 0) * D; const float* pn2 = p.pre_norm + (size_t)(l * 2 + 1) * D;
    const int ngrp = ntok_l / 16; int it = 0;
    for (int grp = blockIdx.x; grp < ngrp; grp += G, ++it) {
#pragma unroll 1
        for (int rr = 0; rr < 2; ++rr) {
            const int ri = wave * 2 + rr, m = grp * 16 + ri;
            const float* mo = p.MO() + (size_t)m * D; float* xr = p.X() + (size_t)m * D; const float* md = p.MOD() + ((size_t)l * (BATCH + 1) + mod_row(m)) * 6 * D;
            f32x4_t v[4], x[4]; float ss = 0.f;
#pragma unroll
            for (int j = 0; j < 4; ++j) { v[j] = *(const f32x4_t*)(mo + 4 * lane + 256 * j); x[j] = *(const f32x4_t*)(xr + 4 * lane + 256 * j); ss += hsq4(v[j]); }
            const float rstd = 1.0f / sqrtf(wave_sum(ss) * (1.0f / D) + 1e-6f); float s2 = 0.f;
#pragma unroll
            for (int j = 0; j < 4; ++j) { const int k = 4 * lane + 256 * j; const f32x4_t g1 = *(const f32x4_t*)(md + 2 * D + k), pv = *(const f32x4_t*)(pn + k);
                x[j] = x[j] + g1 * (v[j] * rstd) * pv; s2 += hsq4(x[j]); *(f32x4_t*)(xr + k) = x[j]; }
            const float r2 = 1.0f / sqrtf(wave_sum(s2) * (1.0f / D) + 1e-6f);
            norm_mod_store<true>(x, r2, pn2, md + 3 * D, md + 4 * D, p.HB() + (size_t)m * D, lds + RT_TK + ri * RT_TKS, lane);
        }
        __syncthreads();
        {
            const int i = lane & 15, q = lane >> 4; pg8::f32x4 acc0 = {0.f, 0.f, 0.f, 0.f}, acc1 = {0.f, 0.f, 0.f, 0.f};
#pragma unroll
            for (int ks = 0; ks < 4; ++ks) { const int k0 = 128 * wave + 32 * ks + 8 * q;
                const bf16x8_t a = *(const LAS bf16x8_t*)(lds + RT_TK + i * RT_TKS + 2 * k0);
                const bf16x8_t b0 = *(const bf16x8_t*)(p.WR_T() + (size_t)i * D + k0), b1 = *(const bf16x8_t*)(p.WR_T() + (size_t)(16 + i) * D + k0);
                acc0 = __builtin_amdgcn_mfma_f32_16x16x32_bf16(a, b0, acc0, 0, 0, 0); acc1 = __builtin_amdgcn_mfma_f32_16x16x32_bf16(a, b1, acc1, 0, 0, 0); }
#pragma unroll
            for (int r = 0; r < 4; ++r) { PL[(wave * 16 + 4 * q + r) * 32 + i] = acc0[r]; PL[(wave * 16 + 4 * q + r) * 32 + 16 + i] = acc1[r]; }
        }
        __syncthreads();
        {
            const int ri = tid >> 5, e = tid & 31; float sacc = p.router_b[l * NEXP + e];
#pragma unroll
            for (int w = 0; w < 8; ++w) sacc += PL[(w * 16 + ri) * 32 + e];
            LG[ri * 33 + e] = sacc;
        }
        __syncthreads();
        if (tid < 16) {
            const int m = grp * 16 + tid; float lg[NEXP];
#pragma unroll
            for (int e = 0; e < NEXP; ++e) lg[e] = LG[tid * 33 + e];
            int idx[TOPK]; float val[TOPK];
#pragma unroll
            for (int j = 0; j < TOPK; ++j) { float best = -3.0e38f; int bi = 0;
#pragma unroll
                for (int e = 0; e < NEXP; ++e) { if (lg[e] > best) { best = lg[e]; bi = e; } }
                idx[j] = bi; val[j] = best;
#pragma unroll
                for (int e = 0; e < NEXP; ++e) if (e == bi) lg[e] = -3.0e38f; }
            float sum = 0.f, ex[TOPK];
#pragma unroll
            for (int j = 0; j < TOPK; ++j) { ex[j] = __expf(val[j] - val[0]); sum += ex[j]; }
            const float inv = 1.0f / sum;
#pragma unroll
            for (int j = 0; j < TOPK; ++j) { p.TOPI()[(size_t)m * TOPK + j] = idx[j]; p.TOPG()[(size_t)m * TOPK + j] = ex[j] * inv;
                const int lp = __hip_atomic_fetch_add(&LCNT[idx[j]], 1, __ATOMIC_RELAXED, __HIP_MEMORY_SCOPE_WORKGROUP);
                const int ai = (it * 16 + tid) * 4 + j; if (ai < RT_ASG_MAX) ASG[ai] = (idx[j] << 20) | lp; }
        }
        __syncthreads();
    }
    if (tid < 32) LBASE[tid] = LCNT[tid] > 0 ? atomicAdd(&p.cnt()[l * NEXP + tid], LCNT[tid]) : 0;
    __syncthreads();
    for (int a = tid; a < it * 64 && a < RT_ASG_MAX; a += NTHR) { const int w = ASG[a]; const int e = w >> 20, lp = w & 0xfffff; const int itx = a / 64, ri = (a % 64) / 4, j = a % 4;
        const int m = (blockIdx.x + itx * G) * 16 + ri; p.POS()[(size_t)m * TOPK + j] = LBASE[e] + lp; }
    __syncthreads();
}
__device__ __forceinline__ void dev_slots(const P& p, int l, int ntok_l, LAS unsigned char* lds, long gtid, long nthr, int tid) {
    LAS int* PST = (LAS int*)lds; LAS int* CN = (LAS int*)(lds + 256);
    if (tid == 0) { int acc = 0; for (int e = 0; e < NEXP; ++e) { const int c = p.cnt()[l * NEXP + e]; PST[e] = acc; CN[e] = c; acc += (c + 255) / 256 * 256; } PST[NEXP] = acc; }
    __syncthreads();
    for (long t = gtid; t < (long)ntok_l * TOPK; t += nthr) { const int e = p.TOPI()[t]; const int slot = PST[e] + p.POS()[t]; p.TSLOT()[t] = slot; p.SLOT_TOK()[slot] = (int)(t / TOPK); }
    for (long t = gtid; t < NEXP * 256; t += nthr) { const int e = (int)(t >> 8), i = (int)(t & 255); const int c = CN[e]; const int pads = (c + 255) / 256 * 256 - c; if (i < pads) p.SLOT_TOK()[PST[e] + c + i] = ZROW; }
    for (long t = gtid; t < NBLK_MAX; t += nthr) { int e_of = NEXP - 1;
        for (int e = 0; e < NEXP; ++e) { if ((int)t * 256 >= PST[e] && (int)t * 256 < PST[e + 1]) e_of = e; }
        p.BLOCK_E()[t] = e_of; if (t == 0) p.NBLK()[0] = PST[NEXP] / 256; }
    __syncthreads();
}
__device__ __forceinline__ void dev_combine(const P& p, int l, int ntok_l, int gw, int ngw, int lane) {
    const bool last = (l == DEPTH - 1); const float* pn = p.post_norm + (size_t)(l * 2 + 1) * D;
    for (int m = gw; m < ntok_l; m += ngw) {
        const int4 sl = *(const int4*)(p.TSLOT() + (size_t)m * 4); const f32x4_t gt = *(const f32x4_t*)(p.TOPG() + (size_t)m * 4);
        const bf16_t* y0 = p.YB() + (size_t)sl.x * D; const bf16_t* y1 = p.YB() + (size_t)sl.y * D; const bf16_t* y2 = p.YB() + (size_t)sl.z * D; const bf16_t* y3 = p.YB() + (size_t)sl.w * D;
        float* xr = p.X() + (size_t)m * D; const float* md = p.MOD() + ((size_t)l * (BATCH + 1) + mod_row(m)) * 6 * D;
        f32x4_t f[4], x[4]; float ss = 0.f;
#pragma unroll
        for (int j = 0; j < 4; ++j) { const int k = 4 * lane + 256 * j;
            const u32x2_t a = *(const u32x2_t*)(y0 + k), b = *(const u32x2_t*)(y1 + k), c = *(const u32x2_t*)(y2 + k), d = *(const u32x2_t*)(y3 + k);
            f[j].x = gt.x * bflo(a.x) + gt.y * bflo(b.x) + gt.z * bflo(c.x) + gt.w * bflo(d.x); f[j].y = gt.x * bfhi(a.x) + gt.y * bfhi(b.x) + gt.z * bfhi(c.x) + gt.w * bfhi(d.x);
            f[j].z = gt.x * bflo(a.y) + gt.y * bflo(b.y) + gt.z * bflo(c.y) + gt.w * bflo(d.y); f[j].w = gt.x * bfhi(a.y) + gt.y * bfhi(b.y) + gt.z * bfhi(c.y) + gt.w * bfhi(d.y);
            ss += hsq4(f[j]); x[j] = *(const f32x4_t*)(xr + k); }
        const float rstd = 1.0f / sqrtf(wave_sum(ss) * (1.0f / D) + 1e-6f); float s2 = 0.f;
#pragma unroll
        for (int j = 0; j < 4; ++j) { const int k = 4 * lane + 256 * j; const f32x4_t g2 = *(const f32x4_t*)(md + 5 * D + k), pv = *(const f32x4_t*)(pn + k);
            x[j] = x[j] + g2 * (f[j] * rstd) * pv; s2 += hsq4(x[j]);
            if (last) *(f32x4_t*)(p.out + (size_t)m * D + k) = x[j]; else *(f32x4_t*)(xr + k) = x[j]; }
        if (!last) { const float r2 = 1.0f / sqrtf(wave_sum(s2) * (1.0f / D) + 1e-6f); const float* md1 = p.MOD() + ((size_t)(l + 1) * (BATCH + 1) + mod_row(m)) * 6 * D;
            norm_mod_store<false>(x, r2, p.pre_norm + (size_t)((l + 1) * 2 + 0) * D, md1, md1 + D, p.HB() + (size_t)m * D, (LAS unsigned char*)0, lane); }
    }
}

constexpr int RING_BYTES = 131072, MISC_OFF = RING_BYTES + 320, LDS_BYTES = 147456;
constexpr size_t MiB = 1u << 20;
constexpr int CW_BAR = 4096, CW_CNT = 8192;

__device__ __forceinline__ void transpose_item(const float* W, int K, int N, bf16_t* WT, LAS float* scr, int item, int lane) {
    const int nblk_k = K / 64; const int nb = item / nblk_k, kb = item % nblk_k, k0 = 64 * kb, n0 = 32 * nb;
    const int ncol = n0 + (lane & 31);
#pragma unroll 8
    for (int i = 0; i < 32; ++i) { const int kk = 2 * i + (lane >> 5); scr[kk * 33 + (lane & 31)] = ncol < N ? W[(size_t)(k0 + kk) * N + ncol] : 0.f; }
    asm volatile("s_waitcnt lgkmcnt(0)" ::: "memory");
    const int c = lane & 7;
#pragma unroll
    for (int j = 0; j < 4; ++j) { const int n = (lane >> 3) + 8 * j; const LAS float* s = scr + (8 * c) * 33 + n;
        pg8::u32x4 o; o.x = pg8::cvt_pk_bf16(s[0 * 33], s[1 * 33]); o.y = pg8::cvt_pk_bf16(s[2 * 33], s[3 * 33]); o.z = pg8::cvt_pk_bf16(s[4 * 33], s[5 * 33]); o.w = pg8::cvt_pk_bf16(s[6 * 33], s[7 * 33]);
        *(pg8::u32x4*)(WT + (size_t)(n0 + n) * K + k0 + 8 * c) = o; }
    asm volatile("s_waitcnt lgkmcnt(0)" ::: "memory");
}

struct Args { P p; int ph_lo, ph_hi; };

#define RUN_TASKS(ntasks, call) do { const long _n = (long)(ntasks); for (long task = gtid; task < _n; task += nthr) { call; } } while (0)

constexpr int NPH = 13;
__global__ void __launch_bounds__(NTHR, 2) fwd_kernel(Args args) {
    extern __shared__ __attribute__((aligned(16))) unsigned char lds[];
    const P& p = args.p;
    LAS unsigned char* ldsp = (LAS unsigned char*)lds;
    volatile LAS unsigned* MISC = (volatile LAS unsigned*)(ldsp + MISC_OFF);
    const int G = gridDim.x;
#define PHASE_VARS int tid_ = threadIdx.x; asm volatile("" : "+v"(tid_)); const int lane = tid_ & 63, wave = __builtin_amdgcn_readfirstlane(tid_ >> 6); \
    const long gtid = ((long)wave * G + blockIdx.x) * 64 + lane, nthr = (long)G * NTHR; const int gw = wave * G + blockIdx.x, ngw = G * NWAVES; (void)gw; (void)ngw; (void)gtid; (void)nthr; (void)lane;
    if (threadIdx.x < 32) MISC[threadIdx.x] = 0u;
    __syncthreads();
    XcdBarrier bar = xcd_barrier_post(p.ctl() + CW_BAR, MISC + 8);
    const int lo = args.ph_lo, hi = args.ph_hi;
#ifndef DBG_PH
#define DBG_PH -1
#endif
#define PHON(j) (DBG_PH < 0 || DBG_PH == (j))
#define IN(k) (lo <= (k) && (k) < hi)
#define SEAM(k) do { if (IN((k) + 1)) xcd_barrier(bar); } while (0)

    if (PHON(100) && IN(0)) { PHASE_VARS;
        RUN_TASKS((long)DEPTH * (BATCH + 1) * 6 * D, task_mod(p, task));
        RUN_TASKS(D, p.HB()[(size_t)ZROW * D + task] = 0);
        SEAM(0);
    }
    for (int l = 0; l < DEPTH; ++l) {
        const int pb = 1 + l * NPH;
        const bool need_ctx = l < DEPTH - 1;
        const int ntok_l = need_ctx ? NTOK : NLAT;
        if (PHON(0) && IN(pb + 0)) { PHASE_VARS;
            LAS float* scr = (LAS float*)(ldsp + wave * 16384);
            const int I_IN = (D / 64) * (INP / 32), I_OUT = (D / 64) * (D / 32), I_R = (D / 64) * (NEXP / 32 > 0 ? NEXP / 32 : 1), I_GU = (D / 64) * (2 * DEXP / 32), I_DN = (DEXP / 64) * (D / 32);
            const int total = I_IN + I_OUT + I_R + NEXP * (I_GU + I_DN);
            for (int it = gw; it < total; it += ngw) {
                int r = it;
                if (r < I_IN) { transpose_item(p.w_in + (size_t)l * D * INW, D, INW, p.WIN_T(), scr, r, lane); continue; } r -= I_IN;
                if (r < I_OUT) { transpose_item(p.w_out + (size_t)l * D * D, D, D, p.WOUT_T(), scr, r, lane); continue; } r -= I_OUT;
                if (r < I_R) { transpose_item(p.router_w + (size_t)l * D * NEXP, D, NEXP, p.WR_T(), scr, r, lane); continue; } r -= I_R;
                if (r < NEXP * I_GU) { const int e = r / I_GU; transpose_item(p.exp_w_gu + ((size_t)l * NEXP + e) * D * 2 * DEXP, D, 2 * DEXP, p.WGU_T() + (size_t)e * 2 * DEXP * D, scr, r % I_GU, lane); continue; } r -= NEXP * I_GU;
                { const int e = r / I_DN; transpose_item(p.exp_w_dn + ((size_t)l * NEXP + e) * DEXP * D, DEXP, D, p.WDN_T() + (size_t)e * D * DEXP, scr, r % I_DN, lane); }
            }
            if (l == 0) dev_norm1_l0(p, gw, ngw, lane);
            SEAM(pb + 0);
        }
        if (PHON(1) && IN(pb + 1)) {
            pg8::Gemm g{p.HB(), p.WIN_T(), D, 0}; pg8::StaticOrder S; S.init(NTOK, INP, G, (int)blockIdx.x);
            pg8::EpiBf16Bias E{p.U(), INP, nullptr, 0};
            pg8::gemm_phase(ldsp, g, S, E);
            SEAM(pb + 1);
        }
        if (PHON(2) && IN(pb + 2)) { PHASE_VARS;
            RUN_TASKS((long)NTOK * 192, task_prepA0(p, l, task));
            RUN_TASKS((long)NTOK * B_H * 4, task_prepB(p, l, task));
            RUN_TASKS((long)NTOK * 8, task_prepC(p, l, task));
            SEAM(pb + 2);
        }
        if (PHON(3) && IN(pb + 3)) { PHASE_VARS; RUN_TASKS((long)NTOK * A_H, task_prepA1(p, l, task)); SEAM(pb + 3); }
        if (PHON(4) && IN(pb + 4)) { PHASE_VARS;
            const long nA = 2L * BATCH * A_H * 64, nB = 2L * BATCH * B_H * 128, nC = (long)BATCH * 4 * SLEN;
            for (long task = gtid; task < nA; task += nthr) task_scanA(p, task);
            for (long task = gtid - nA; task < nB; task += nthr) { if (task >= 0) task_scanB(p, task); }
            for (long task = gtid - nA - nB; task < nC; task += nthr) { if (task >= 0) task_attn(p, need_ctx ? 1 : 0, task); }
            SEAM(pb + 4);
        }
        if (PHON(5) && IN(pb + 5)) { PHASE_VARS; dev_post(p, l, ntok_l, gw, ngw, lane); SEAM(pb + 5); }
        if (PHON(6) && IN(pb + 6)) {
            pg8::Gemm g{p.MIX(), p.WOUT_T(), D, 0}; pg8::StaticOrder S; S.init(ntok_l, D, G, (int)blockIdx.x);
            pg8::EpiF32 E{p.MO(), D};
            pg8::gemm_phase(ldsp, g, S, E);
            SEAM(pb + 6);
        }
        if (PHON(7) && IN(pb + 7)) { PHASE_VARS; dev_resid_router(p, l, ntok_l, ldsp, G, tid_); SEAM(pb + 7); }
        if (PHON(8) && IN(pb + 8)) { PHASE_VARS; dev_slots(p, l, ntok_l, ldsp, gtid, nthr, tid_); SEAM(pb + 8); }
        if (PHON(9) && IN(pb + 9)) { PHASE_VARS; const long nb = p.NBLK()[0]; RUN_TASKS(nb * 256 * 128, task_gather(p, task)); SEAM(pb + 9); }
        if (PHON(10) && IN(pb + 10)) {
            pg8::Gemm g{p.XG(), p.WGU_T(), D, (size_t)2 * DEXP * D}; pg8::MoeOrder S{p.NBLK()[0], 2 * DEXP / 256, G, (int)blockIdx.x, p.BLOCK_E()};
            pg8::EpiSwiglu E{p.HH(), DEXP, p.exp_b_gu + (size_t)l * NEXP * 2 * DEXP, 2 * DEXP};
            pg8::gemm_phase(ldsp, g, S, E);
            SEAM(pb + 10);
        }
        if (PHON(11) && IN(pb + 11)) {
            pg8::Gemm g{p.HH(), p.WDN_T(), DEXP, (size_t)D * DEXP}; pg8::MoeOrder S{p.NBLK()[0], D / 256, G, (int)blockIdx.x, p.BLOCK_E()};
            pg8::EpiBf16Bias E{p.YB(), D, p.exp_b_dn + (size_t)l * NEXP * D, D};
            pg8::gemm_phase(ldsp, g, S, E);
            SEAM(pb + 11);
        }
        if (PHON(12) && IN(pb + 12)) { PHASE_VARS; dev_combine(p, l, ntok_l, gw, ngw, lane); if (l + 1 < DEPTH) SEAM(pb + 12); }
    }
#undef IN
#undef SEAM
}

#ifndef N_LAUNCH_MODE
#define N_LAUNCH_MODE 1
#endif
extern "C" void kernel_launch(void* const* d_in, const int* in_sizes, int n_in, void* d_out, int out_size, void* d_ws, size_t ws_size, hipStream_t stream) {
    static int grid = 0;
    if (grid == 0) {
        int dev = 0, cus = 0;
        if (hipGetDevice(&dev) != hipSuccess || hipDeviceGetAttribute(&cus, hipDeviceAttributeMultiprocessorCount, dev) != hipSuccess) { grid = -1; return; }
        if (hipFuncSetAttribute((const void*)fwd_kernel, hipFuncAttributeMaxDynamicSharedMemorySize, LDS_BYTES) != hipSuccess) { fprintf(stderr, "hipFuncSetAttribute failed\n"); grid = -1; return; }
        int per_cu = 0;
        if (hipOccupancyMaxActiveBlocksPerMultiprocessor(&per_cu, (const void*)fwd_kernel, NTHR, LDS_BYTES) != hipSuccess || per_cu < 1) fprintf(stderr, "occupancy query: %d\n", per_cu);
        (void)hipGetLastError();
        grid = cus;
    }
    if (grid < 0) return;
    unsigned char* ws = (unsigned char*)d_ws;
    (void)hipMemsetAsync(ws, 0, CTL_BYTES, stream);
    Args a{};
    P& p = a.p;
    const float* const* in = (const float* const*)d_in;
    p.x = in[0]; p.c = in[1]; p.ctx = in[2]; p.c_ctx = in[3]; p.ada_w = in[4]; p.ada_b = in[5]; p.pre_norm = in[6]; p.post_norm = in[7]; p.w_in = in[8]; p.w_out = in[9];
    p.rw_mu = in[10]; p.rw_w0 = in[11]; p.rw_w2 = in[12]; p.rw_a0 = in[13]; p.rw_a2 = in[14]; p.rw_g2 = in[15]; p.rw_k_k = in[16]; p.rw_k_a = in[17]; p.rw_r_k = in[18]; p.rw_ln_w = in[19]; p.rw_ln_b = in[20];
    p.gdn_conv = in[21]; p.gdn_a_log = in[22]; p.gdn_dt_bias = in[23]; p.gdn_norm = in[24]; p.attn_q_norm = in[25]; p.attn_k_norm = in[26];
    p.router_w = in[27]; p.router_b = in[28]; p.exp_w_gu = in[29]; p.exp_b_gu = in[30]; p.exp_w_dn = in[31]; p.exp_b_dn = in[32];
    p.out = (float*)d_out;
    p.ws = ws; p.tokf = nullptr;
    if (WS_TOTAL > ws_size) { fprintf(stderr, "kernel_launch: workspace too small: need %zu have %zu\n", (size_t)WS_TOTAL, ws_size); return; }
    const int nph = 1 + DEPTH * NPH;
#if N_LAUNCH_MODE == 1
    a.ph_lo = 0; a.ph_hi = nph;
    hipLaunchKernelGGL(fwd_kernel, dim3(grid), dim3(NTHR), LDS_BYTES, stream, a);
#else
    for (int ph = 0; ph < nph; ++ph) { a.ph_lo = ph; a.ph_hi = ph + 1; hipLaunchKernelGGL(fwd_kernel, dim3(grid), dim3(NTHR), LDS_BYTES, stream, a); }
#endif
}
#endif
```

```cpp
#ifndef HOST_TEST
#include <hip/hip_runtime.h>
#else
struct uint4 { unsigned x, y, z, w; };
#endif
#include <cstdio>
#include <cstdint>
#include <cmath>

#ifndef CFG_BATCH
#define CFG_BATCH 16
#define CFG_SEQ 2048
#define CFG_CTX 256
#define CFG_NEXP 32
#define CFG_DEXP 1024
#endif
constexpr int D = 1024, BATCH = CFG_BATCH, SEQ = CFG_SEQ, CTXL = CFG_CTX, DEPTH = 2, GRID_W = 64;
constexpr int NLAT = BATCH * SEQ, NCTX = BATCH * CTXL, NTOK = NLAT + NCTX;
constexpr int A_W = 256, A_H = 4, A_IN = 960;
constexpr int B_W = 512, B_H = 4, B_IN = 2064, B_OFF = 960;
constexpr int C_W = 256, C_IN = 512, C_OFF = 3024;
constexpr int INW = 3536, INP = 3584;
constexpr int NEXP = CFG_NEXP, TOPK = 4, DEXP = CFG_DEXP;
constexpr int NBLK_MAX = (NTOK * TOPK + 255) / 256 + NEXP, NSLOT = NBLK_MAX * 256;
constexpr int ZROW = NTOK;
constexpr int SLEN = CTXL + SEQ;

#ifdef HOST_TEST
#define DEVFN static inline
#define GLOBAL_ATOMIC_ADD(p, v) ((*(p)) += (v), (*(p)) - (v))
#else
#define DEVFN __device__ __forceinline__
#define GLOBAL_ATOMIC_ADD(p, v) atomicAdd((p), (v))
#endif
#ifdef HOST_TEST
#define UNIFORM(x) (x)
#define LOADFENCE()
#else
#define UNIFORM(x) __builtin_amdgcn_readfirstlane(x)
#define LOADFENCE() asm volatile("" ::: "memory")
#endif
typedef unsigned short bf16_t;
DEVFN bf16_t f2bf(float f) { unsigned u = __builtin_bit_cast(unsigned, f); return (bf16_t)((u + 0x7fffu + ((u >> 16) & 1u)) >> 16); }
DEVFN float bf2f(bf16_t b) { unsigned u = ((unsigned)b) << 16; return __builtin_bit_cast(float, u); }
DEVFN float sigmoidf_(float x) { return 1.0f / (1.0f + expf(-x)); }
DEVFN float siluf_(float x) { return x / (1.0f + expf(-x)); }
DEVFN float softplusf_(float x) { return x > 20.f ? x : log1pf(expf(x)); }

#ifdef HOST_TEST
#define WSACC inline
#else
#define WSACC __device__ __host__ __forceinline__
#endif
constexpr size_t CTL_BYTES = 64 * 1024;
constexpr size_t al256(size_t x) { return (x + 255) & ~(size_t)255; }
constexpr size_t WSO_ctl = 0;
constexpr size_t WSE_ctl = WSO_ctl + al256(CTL_BYTES);
constexpr size_t WSO_MOD = WSE_ctl;
constexpr size_t WSE_MOD = WSO_MOD + al256((size_t)DEPTH * (BATCH + 1) * 6 * D * 4);
constexpr size_t WSO_X = WSE_MOD;
constexpr size_t WSE_X = WSO_X + al256((size_t)(NTOK + 1) * D * 4);
constexpr size_t WSO_HB = WSE_X;
constexpr size_t WSE_HB = WSO_HB + al256((size_t)(NTOK + 1) * D * 2);
constexpr size_t WSO_WIN_T = WSE_HB;
constexpr size_t WSE_WIN_T = WSO_WIN_T + al256((size_t)INP * D * 2);
constexpr size_t WSO_WOUT_T = WSE_WIN_T;
constexpr size_t WSE_WOUT_T = WSO_WOUT_T + al256((size_t)D * D * 2);
constexpr size_t WSO_WR_T = WSE_WOUT_T;
constexpr size_t WSE_WR_T = WSO_WR_T + al256((size_t)32 * D * 2);
constexpr size_t WSO_WGU_T = WSE_WR_T;
constexpr size_t WSE_WGU_T = WSO_WGU_T + al256((size_t)NEXP * 2 * DEXP * D * 2);
constexpr size_t WSO_WDN_T = WSE_WGU_T;
constexpr size_t WSE_WDN_T = WSO_WDN_T + al256((size_t)NEXP * D * DEXP * 2);
constexpr size_t WSO_TOPI = WSE_WDN_T;
constexpr size_t WSE_TOPI = WSO_TOPI + al256((size_t)NTOK * 4 * 4);
constexpr size_t WSO_POS = WSE_TOPI;
constexpr size_t WSE_POS = WSO_POS + al256((size_t)NTOK * 4 * 4);
constexpr size_t WSO_TSLOT = WSE_POS;
constexpr size_t WSE_TSLOT = WSO_TSLOT + al256((size_t)NTOK * 4 * 4);
constexpr size_t WSO_TOPG = WSE_TSLOT;
constexpr size_t WSE_TOPG = WSO_TOPG + al256((size_t)NTOK * 4 * 4);
constexpr size_t WSO_SLOT_TOK = WSE_TOPG;
constexpr size_t WSE_SLOT_TOK = WSO_SLOT_TOK + al256((size_t)NSLOT * 4);
constexpr size_t WSO_BLOCK_E = WSE_SLOT_TOK;
constexpr size_t WSE_BLOCK_E = WSO_BLOCK_E + al256((size_t)NBLK_MAX * 4);
constexpr size_t WSO_NBLK = WSE_BLOCK_E;
constexpr size_t WSE_NBLK = WSO_NBLK + al256(256);
constexpr size_t WSO_U = WSE_NBLK;
constexpr size_t WSE_U = WSO_U + al256((size_t)NTOK * INP * 2);
constexpr size_t WSO_MO = WSE_U;
constexpr size_t WSE_MO = WSO_MO + al256((size_t)NTOK * D * 4);
constexpr size_t WSO_END_P = WSE_MO;
constexpr size_t WSO_LR = WSO_END_P;
constexpr size_t WSE_LR = WSO_LR + al256((size_t)NTOK * 192 * 4);
constexpr size_t WSO_RW_R = WSE_LR;
constexpr size_t WSE_RW_R = WSO_RW_R + al256((size_t)NTOK * A_W * 4);
constexpr size_t WSO_RW_V = WSE_RW_R;
constexpr size_t WSE_RW_V = WSO_RW_V + al256((size_t)NTOK * A_W * 4);
constexpr size_t WSO_RW_KK = WSE_RW_V;
constexpr size_t WSE_RW_KK = WSO_RW_KK + al256((size_t)NTOK * A_W * 4);
constexpr size_t WSO_RW_D = WSE_RW_KK;
constexpr size_t WSE_RW_D = WSO_RW_D + al256((size_t)2 * NTOK * A_W * 4);
constexpr size_t WSO_RW_KD = WSE_RW_D;
constexpr size_t WSE_RW_KD = WSO_RW_KD + al256((size_t)2 * NTOK * A_W * 4);
constexpr size_t WSO_RW_KKA = WSE_RW_KD;
constexpr size_t WSE_RW_KKA = WSO_RW_KKA + al256((size_t)2 * NTOK * A_W * 4);
constexpr size_t WSO_RW_GATE = WSE_RW_KKA;
constexpr size_t WSE_RW_GATE = WSO_RW_GATE + al256((size_t)NTOK * A_W * 4);
constexpr size_t WSO_RW_BON = WSE_RW_GATE;
constexpr size_t WSE_RW_BON = WSO_RW_BON + al256((size_t)NTOK * A_H * 4);
constexpr size_t WSO_YA = WSE_RW_BON;
constexpr size_t WSE_YA = WSO_YA + al256((size_t)2 * NTOK * A_W * 4);
constexpr size_t WSO_GQ = WSE_YA;
constexpr size_t WSE_GQ = WSO_GQ + al256((size_t)NTOK * B_W * 2);
constexpr size_t WSO_GK = WSE_GQ;
constexpr size_t WSE_GK = WSO_GK + al256((size_t)NTOK * B_W * 2);
constexpr size_t WSO_GV = WSE_GK;
constexpr size_t WSE_GV = WSO_GV + al256((size_t)NTOK * B_W * 2);
constexpr size_t WSO_GG = WSE_GV;
constexpr size_t WSE_GG = WSO_GG + al256((size_t)NTOK * 8 * 4);
constexpr size_t WSO_GBETA = WSE_GG;
constexpr size_t WSE_GBETA = WSO_GBETA + al256((size_t)NTOK * 8 * 4);
constexpr size_t WSO_OB = WSE_GBETA;
constexpr size_t WSE_OB = WSO_OB + al256((size_t)2 * NTOK * B_W * 4);
constexpr size_t WSO_CQ = WSE_OB;
constexpr size_t WSE_CQ = WSO_CQ + al256((size_t)NTOK * 256 * 2);
constexpr size_t WSO_CK = WSE_CQ;
constexpr size_t WSE_CK = WSO_CK + al256((size_t)NTOK * 128 * 2);
constexpr size_t WSO_CV = WSE_CK;
constexpr size_t WSE_CV = WSO_CV + al256((size_t)NTOK * 128 * 2);
constexpr size_t WSO_RWC = WSE_CV;
constexpr size_t WSE_RWC = WSO_RWC + al256((size_t)2 * BATCH * A_H * (SLEN / 64) * 5 * 4096 * 2);
constexpr size_t WSO_MIX = WSE_RWC;
constexpr size_t WSE_MIX = WSO_MIX + al256((size_t)NTOK * D * 2);
constexpr size_t WSO_XG = WSO_END_P;
constexpr size_t WSE_XG = WSO_XG + al256((size_t)NSLOT * D * 2);
constexpr size_t WSO_HH = WSE_XG;
constexpr size_t WSE_HH = WSO_HH + al256((size_t)NSLOT * DEXP * 2);
constexpr size_t WSO_YB = WSE_HH;
constexpr size_t WSE_YB = WSO_YB + al256((size_t)NSLOT * D * 2);
constexpr size_t WS_TOTAL = (WSE_MIX > WSE_YB ? WSE_MIX : WSE_YB);
struct P {
    const float *x, *c, *ctx, *c_ctx, *ada_w, *ada_b, *pre_norm, *post_norm, *w_in, *w_out;
    const float *rw_mu, *rw_w0, *rw_w2, *rw_a0, *rw_a2, *rw_g2, *rw_k_k, *rw_k_a, *rw_r_k, *rw_ln_w, *rw_ln_b;
    const float *gdn_conv, *gdn_a_log, *gdn_dt_bias, *gdn_norm, *attn_q_norm, *attn_k_norm;
    const float *router_w, *router_b, *exp_w_gu, *exp_b_gu, *exp_w_dn, *exp_b_dn;
    float* out;
    unsigned char* ws;
    WSACC unsigned* ctl() const { return (unsigned*)(ws + WSO_ctl); }
    WSACC float* MOD() const { return (float*)(ws + WSO_MOD); }
    WSACC float* X() const { return (float*)(ws + WSO_X); }
    WSACC bf16_t* HB() const { return (bf16_t*)(ws + WSO_HB); }
    WSACC bf16_t* WIN_T() const { return (bf16_t*)(ws + WSO_WIN_T); }
    WSACC bf16_t* WOUT_T() const { return (bf16_t*)(ws + WSO_WOUT_T); }
    WSACC bf16_t* WR_T() const { return (bf16_t*)(ws + WSO_WR_T); }
    WSACC bf16_t* WGU_T() const { return (bf16_t*)(ws + WSO_WGU_T); }
    WSACC bf16_t* WDN_T() const { return (bf16_t*)(ws + WSO_WDN_T); }
    WSACC int* TOPI() const { return (int*)(ws + WSO_TOPI); }
    WSACC int* POS() const { return (int*)(ws + WSO_POS); }
    WSACC int* TSLOT() const { return (int*)(ws + WSO_TSLOT); }
    WSACC float* TOPG() const { return (float*)(ws + WSO_TOPG); }
    WSACC int* SLOT_TOK() const { return (int*)(ws + WSO_SLOT_TOK); }
    WSACC int* BLOCK_E() const { return (int*)(ws + WSO_BLOCK_E); }
    WSACC int* NBLK() const { return (int*)(ws + WSO_NBLK); }
    WSACC bf16_t* U() const { return (bf16_t*)(ws + WSO_U); }
    WSACC float* MO() const { return (float*)(ws + WSO_MO); }
    WSACC float* LR() const { return (float*)(ws + WSO_LR); }
    WSACC float* RW_R() const { return (float*)(ws + WSO_RW_R); }
    WSACC float* RW_V() const { return (float*)(ws + WSO_RW_V); }
    WSACC float* RW_KK() const { return (float*)(ws + WSO_RW_KK); }
    WSACC float* RW_D() const { return (float*)(ws + WSO_RW_D); }
    WSACC float* RW_KD() const { return (float*)(ws + WSO_RW_KD); }
    WSACC float* RW_KKA() const { return (float*)(ws + WSO_RW_KKA); }
    WSACC float* RW_GATE() const { return (float*)(ws + WSO_RW_GATE); }
    WSACC float* RW_BON() const { return (float*)(ws + WSO_RW_BON); }
    WSACC float* YA() const { return (float*)(ws + WSO_YA); }
    WSACC bf16_t* GQ() const { return (bf16_t*)(ws + WSO_GQ); }
    WSACC bf16_t* GK() const { return (bf16_t*)(ws + WSO_GK); }
    WSACC bf16_t* GV() const { return (bf16_t*)(ws + WSO_GV); }
    WSACC float* GG() const { return (float*)(ws + WSO_GG); }
    WSACC float* GBETA() const { return (float*)(ws + WSO_GBETA); }
    WSACC float* OB() const { return (float*)(ws + WSO_OB); }
    WSACC bf16_t* CQ() const { return (bf16_t*)(ws + WSO_CQ); }
    WSACC bf16_t* CK() const { return (bf16_t*)(ws + WSO_CK); }
    WSACC bf16_t* CV() const { return (bf16_t*)(ws + WSO_CV); }
    WSACC bf16_t* MIX() const { return (bf16_t*)(ws + WSO_MIX); }
    WSACC bf16_t* RWC() const { return (bf16_t*)(ws + WSO_RWC); }
    WSACC bf16_t* XG() const { return (bf16_t*)(ws + WSO_XG); }
    WSACC bf16_t* HH() const { return (bf16_t*)(ws + WSO_HH); }
    WSACC bf16_t* YB() const { return (bf16_t*)(ws + WSO_YB); }
    WSACC int* cnt() const { return (int*)(ws + WSO_ctl) + 8192; }
    WSACC float* TOKF() const { return tokf; }
    float* tokf;
};

DEVFN void row_info(int m, int& b, int& t, int& len, int& base) {
    if (m < NLAT) { b = m / SEQ; t = m % SEQ; len = SEQ; base = b * SEQ; }
    else { const int mc = m - NLAT; b = mc / CTXL; t = mc % CTXL; len = CTXL; base = NLAT + b * CTXL; }
}
DEVFN float ldU(const P& p, size_t idx) { return bf2f(p.U()[idx]); }
DEVFN int mod_row(int m) { return m < NLAT ? m / SEQ : BATCH; }
DEVFN int scan_row(int dir, int b, int s) {
    if (s < CTXL) { const int ts = dir ? (CTXL - 1 - s) : s; return NLAT + b * CTXL + ts; }
    const int s2 = s - CTXL; const int ts = dir ? (SEQ - 1 - s2) : s2; return b * SEQ + ts;
}

DEVFN void task_mod(const P& p, long task) {
    const int j = (int)(task % (6 * D)); const int r = (int)((task / (6 * D)) % (BATCH + 1)); const int l = (int)(task / ((long)(6 * D) * (BATCH + 1)));
    const float* cv = (r < BATCH) ? p.c + (size_t)r * D : p.c_ctx;
    const float* w = p.ada_w + (size_t)l * D * 6 * D + j;
    float acc = 0.f;
    for (int k = 0; k < D; ++k) acc += siluf_(cv[k]) * w[(size_t)k * 6 * D];
    p.MOD()[((size_t)l * (BATCH + 1) + r) * 6 * D + j] = acc + p.ada_b[(size_t)l * 6 * D + j];
}
DEVFN void task_copyx(const P& p, long task) {
    const long n_lat = (long)NLAT * D;
    p.X()[task] = task < n_lat ? p.x[task] : p.ctx[task - n_lat];
}
DEVFN void task_norm1(const P& p, int l, long task) {
    const int m = (int)task; const float* xr = p.X() + (size_t)m * D;
    float ss = 0.f; for (int k = 0; k < D; ++k) ss += xr[k] * xr[k];
    const float rstd = 1.0f / sqrtf(ss / D + 1e-6f);
    const float* md = p.MOD() + ((size_t)l * (BATCH + 1) + mod_row(m)) * 6 * D; const float* pn = p.pre_norm + (size_t)(l * 2 + 0) * D;
    bf16_t* o = p.HB() + (size_t)m * D;
    for (int k = 0; k < D; ++k) o[k] = f2bf(xr[k] * rstd * pn[k] * (1.0f + md[D + k]) + md[k]);
}
DEVFN float lerpA(const P& p, int l, int m, int col) {
    int b, t, len, base; row_info(m, b, t, len, base);
    const float u = ldU(p, (size_t)m * INP + col);
    const float up = t > 0 ? ldU(p, (size_t)(m - 1) * INP + col) : 0.f, un = t + 1 < len ? ldU(p, (size_t)(m + 1) * INP + col) : 0.f;
    return u + p.rw_mu[l * A_IN + col] * (0.5f * (up + un) - u);
}
DEVFN void task_prepA0(const P& p, int l, long task) {
    const int m = (int)(task / 192), j = (int)(task % 192);
    const float v = lerpA(p, l, m, 768 + j);
    p.LR()[(size_t)m * 192 + j] = j < 64 ? tanhf(v) : (j < 128 ? v : sigmoidf_(v));
}
DEVFN void task_prepA1(const P& p, int l, long task) {
    const int m = (int)(task / A_H), h = (int)(task % A_H);
    const float* lr = p.LR() + (size_t)m * 192;
    float ss = 0.f;
    for (int c = 0; c < 64; ++c) { const int ch = h * 64 + c; const float kx = lerpA(p, l, m, 256 + ch) * p.rw_k_k[l * A_W + ch]; ss += kx * kx; }
    const float rn = 1.0f / sqrtf(ss + 1e-6f);
    float bon = 0.f;
    for (int c = 0; c < 64; ++c) {
        const int ch = h * 64 + c;
        const float r = lerpA(p, l, m, ch), k = lerpA(p, l, m, 256 + ch), v = lerpA(p, l, m, 512 + ch);
        const float kk = k * p.rw_k_k[l * A_W + ch] * rn;
        float kdsum = 0.f;
        for (int dir = 0; dir < 2; ++dir) {
            float w = p.rw_w0[(l * 2 + dir) * A_W + ch], a = p.rw_a0[(l * 2 + dir) * A_W + ch];
            const float* w2 = p.rw_w2 + ((size_t)(l * 2 + dir) * 32) * A_W + ch; const float* a2 = p.rw_a2 + ((size_t)(l * 2 + dir) * 32) * A_W + ch;
            for (int r2 = 0; r2 < 32; ++r2) { w += lr[dir * 32 + r2] * w2[(size_t)r2 * A_W]; a += lr[64 + dir * 32 + r2] * a2[(size_t)r2 * A_W]; }
            const float decay = -expf(-softplusf_(-w) - 0.5f);
            const float iclr = sigmoidf_(a);
            const float kd = k * (1.0f + (iclr - 1.0f) * p.rw_k_a[l * A_W + ch]);
            const size_t o = ((size_t)dir * NTOK + m) * A_W + ch;
            p.RW_D()[o] = decay; p.RW_KD()[o] = kd; p.RW_KKA()[o] = kk * iclr; kdsum += kd;
        }
        float g = 0.f; const float* g2 = p.rw_g2 + (size_t)l * 64 * A_W + ch;
        for (int r2 = 0; r2 < 64; ++r2) g += lr[128 + r2] * g2[(size_t)r2 * A_W];
        const size_t o = (size_t)m * A_W + ch;
        p.RW_R()[o] = r; p.RW_V()[o] = v; p.RW_KK()[o] = kk; p.RW_GATE()[o] = g;
        bon += r * kdsum * p.rw_r_k[l * A_W + ch];
    }
    p.RW_BON()[(size_t)m * A_H + h] = bon;
}
DEVFN void task_prepB(const P& p, int l, long task) {
    const int which = (int)(task % 4), h = (int)((task / 4) % B_H), m = (int)(task / (4 * B_H));
    int b, t, len, base; row_info(m, b, t, len, base);
    if (which == 3) {
        for (int dir = 0; dir < 2; ++dir) {
            const float a = ldU(p, (size_t)m * INP + B_OFF + 2048 + dir * 4 + h), bb = ldU(p, (size_t)m * INP + B_OFF + 2056 + dir * 4 + h);
            const float g = -expf(p.gdn_a_log[(l * 2 + dir) * B_H + h]) * softplusf_(a + p.gdn_dt_bias[(l * 2 + dir) * B_H + h]);
            p.GG()[(size_t)m * 8 + dir * 4 + h] = g; p.GBETA()[(size_t)m * 8 + dir * 4 + h] = sigmoidf_(bb);
        }
        return;
    }
    bf16_t* dst = (which == 0 ? p.GQ() : which == 1 ? p.GK() : p.GV()) + (size_t)m * B_W + h * 128;
    float ss = 0.f;
    for (int c = 0; c < 128; ++c) {
        const int cc = which * B_W + h * 128 + c; const int col = B_OFF + cc;
        float acc = 0.f;
        for (int j = 0; j < 5; ++j) { const int tt = t + j - 2; if (tt >= 0 && tt < len) acc += ldU(p, (size_t)(base + tt) * INP + col) * p.gdn_conv[((size_t)l * 5 + j) * (3 * B_W) + cc]; }
        const float s = siluf_(acc); if (which == 2) dst[c] = f2bf(s); ss += s * s;
    }
    if (which < 2) { const float rn = (1.0f / sqrtf(ss + 1e-6f)) * (which == 0 ? 0.08838834764831845f : 1.0f);
        for (int c = 0; c < 128; ++c) { const int cc = which * B_W + h * 128 + c; const int col = B_OFF + cc; float acc = 0.f;
            for (int j = 0; j < 5; ++j) { const int tt = t + j - 2; if (tt >= 0 && tt < len) acc += ldU(p, (size_t)(base + tt) * INP + col) * p.gdn_conv[((size_t)l * 5 + j) * (3 * B_W) + cc]; }
            dst[c] = f2bf(siluf_(acc) * rn); } }
}
DEVFN void task_prepC(const P& p, int l, long task) {
    const int m = (int)(task / 8), hs = (int)(task % 8);
    const size_t sb = (size_t)m * INP + C_OFF + hs * 64;
    if (hs >= 6) { bf16_t* dst = p.CV() + (size_t)m * 128 + (hs - 6) * 64; for (int d = 0; d < 64; ++d) dst[d] = p.U()[sb + d]; return; }
    float ss = 0.f; for (int d = 0; d < 64; ++d) { const float x = ldU(p, sb + d); ss += x * x; }
    const float qs = hs < 4 ? 0.18033688011112042f : 1.0f;
    const float rstd = (1.0f / sqrtf(ss / 64.f + 1e-6f)) * qs;
    const float* nw = (hs < 4 ? p.attn_q_norm : p.attn_k_norm) + l * 64;
    bf16_t* dst = hs < 4 ? p.CQ() + (size_t)m * 256 + hs * 64 : p.CK() + (size_t)m * 128 + (hs - 4) * 64;
    if (m >= NLAT) { for (int d = 0; d < 64; ++d) dst[d] = f2bf(ldU(p, sb + d) * rstd * nw[d]); return; }
    const int t = m % SEQ; const float pr = (float)(t / GRID_W), pc = (float)(t % GRID_W);
    for (int d = 0; d < 16; ++d) {
        const float fr = powf(10000.0f, -(float)d / 16.0f);
        const float ar = pr * fr, ac = pc * fr; const float cr = cosf(ar), sr = sinf(ar), cc = cosf(ac), sc = sinf(ac);
        const float x1 = ldU(p, sb + d) * rstd * nw[d], x2 = ldU(p, sb + 16 + d) * rstd * nw[16 + d], x3 = ldU(p, sb + 32 + d) * rstd * nw[32 + d], x4 = ldU(p, sb + 48 + d) * rstd * nw[48 + d];
        dst[d] = f2bf(x1 * cr - x2 * sr); dst[16 + d] = f2bf(x2 * cr + x1 * sr); dst[32 + d] = f2bf(x3 * cc - x4 * sc); dst[48 + d] = f2bf(x4 * cc + x3 * sc);
    }
}
DEVFN void task_scanA(const P& p, long task) {
    const int v = (int)(task % 64), chain = UNIFORM((int)(task / 64)); const int h = chain % A_H, b = (chain / A_H) % BATCH, dir = chain / (A_H * BATCH);
    float s[64];
#pragma unroll
    for (int k = 0; k < 64; ++k) s[k] = 0.f;
    for (int st = 0; st < SLEN; ++st) {
        const int m = scan_row(dir, b, st);
        const float* kk = p.RW_KK() + (size_t)m * A_W + h * 64; const float* rr = p.RW_R() + (size_t)m * A_W + h * 64;
        const size_t od = ((size_t)dir * NTOK + m) * A_W + h * 64;
        const float* dd = p.RW_D() + od; const float* kd = p.RW_KD() + od; const float* ka = p.RW_KKA() + od;
        const float vv = p.RW_V()[(size_t)m * A_W + h * 64 + v];
        float sa = 0.f;
#pragma unroll
        for (int k = 0; k < 64; ++k) { sa += s[k] * kk[k]; if ((k & 15) == 15) LOADFENCE(); }
        float y = 0.f;
#pragma unroll
        for (int k = 0; k < 64; ++k) { s[k] = s[k] * expf(dd[k]) - sa * ka[k] + vv * kd[k]; y += s[k] * rr[k]; if ((k & 7) == 7) LOADFENCE(); }
        p.YA()[((size_t)dir * NTOK + m) * A_W + h * 64 + v] = y;
    }
}
DEVFN void task_scanB(const P& p, long task) {
    const int j = (int)(task % 128), chain = UNIFORM((int)(task / 128)); const int h = chain % B_H, b = (chain / B_H) % BATCH, dir = chain / (B_H * BATCH);
    float s[128];
#pragma unroll
    for (int k = 0; k < 128; ++k) s[k] = 0.f;
    for (int st = 0; st < SLEN; ++st) {
        const int m = scan_row(dir, b, st);
        const bf16_t* kv = p.GK() + (size_t)m * B_W + h * 128; const bf16_t* qv = p.GQ() + (size_t)m * B_W + h * 128;
        const float vj = bf2f(p.GV()[(size_t)m * B_W + h * 128 + j]);
        const float eg = expf(p.GG()[(size_t)m * 8 + dir * 4 + h]), beta = p.GBETA()[(size_t)m * 8 + dir * 4 + h];
        float pk = 0.f;
#pragma unroll
        for (int k = 0; k < 128; ++k) { pk += s[k] * bf2f(kv[k]); if ((k & 15) == 15) LOADFENCE(); }
        const float cf = beta * (vj - eg * pk);
        float o = 0.f;
#pragma unroll
        for (int k = 0; k < 128; ++k) { s[k] = eg * s[k] + cf * bf2f(kv[k]); o += s[k] * bf2f(qv[k]); if ((k & 7) == 7) LOADFENCE(); }
        p.OB()[((size_t)dir * NTOK + m) * B_W + h * 128 + j] = o;
    }
}
DEVFN void task_attn(const P& p, int need_ctx, long task) {
    const int t = (int)(task % SLEN), hq = UNIFORM((int)((task / SLEN) % 4)), b = UNIFORM((int)(task / ((long)SLEN * 4)));
    const bool is_lat = UNIFORM((int)(t < SEQ)) != 0; if (!is_lat && !need_ctx) return;
    const int m = is_lat ? b * SEQ + t : NLAT + b * CTXL + (t - SEQ);
    const int kvh = hq >> 1;
    float q[64], o[64];
#pragma unroll
    for (int d = 0; d < 64; ++d) { q[d] = bf2f(p.CQ()[(size_t)m * 256 + hq * 64 + d]); o[d] = 0.f; }
    float mx = -1e30f, lsum = 0.f;
    const int nk = is_lat ? SLEN : CTXL;
    for (int kI = 0; kI < nk; ++kI) {
        int km; if (is_lat) km = kI < SEQ ? b * SEQ + kI : NLAT + b * CTXL + (kI - SEQ); else km = NLAT + b * CTXL + kI;
        const bf16_t* kr = p.CK() + (size_t)km * 128 + kvh * 64; const bf16_t* vr = p.CV() + (size_t)km * 128 + kvh * 64;
        float sc = 0.f;
#pragma unroll
        for (int d = 0; d < 64; ++d) { sc += q[d] * bf2f(kr[d]); if ((d & 15) == 15) LOADFENCE(); }
        const float mn = sc > mx ? sc : mx; const float f = exp2f(mx - mn), pe = exp2f(sc - mn);
        lsum = lsum * f + pe; mx = mn;
#pragma unroll
        for (int d = 0; d < 64; ++d) { o[d] = o[d] * f + pe * bf2f(vr[d]); if ((d & 15) == 15) LOADFENCE(); }
    }
    const float inv = 1.0f / lsum;
#pragma unroll
    for (int d = 0; d < 64; ++d) p.MIX()[(size_t)m * D + 768 + hq * 64 + d] = f2bf(o[d] * inv);
}
DEVFN void task_post(const P& p, int l, long task) {
    const int m = (int)(task / 8), g = (int)(task % 8);
    if (g < 4) {
        const int h = g; const float* y0 = p.YA() + (size_t)m * A_W + h * 64; const float* y1 = p.YA() + ((size_t)NTOK + m) * A_W + h * 64;
        float mean = 0.f; for (int c = 0; c < 64; ++c) mean += y0[c] + y1[c]; mean *= (1.0f / 64.f);
        float var = 0.f; for (int c = 0; c < 64; ++c) { const float d0 = y0[c] + y1[c] - mean; var += d0 * d0; } var *= (1.0f / 64.f);
        const float rs = 1.0f / sqrtf(var + 64e-5f); const float bon = p.RW_BON()[(size_t)m * A_H + h];
        for (int c = 0; c < 64; ++c) { const int ch = h * 64 + c;
            const float yn = (y0[c] + y1[c] - mean) * rs * p.rw_ln_w[l * A_W + ch] + p.rw_ln_b[l * A_W + ch];
            p.MIX()[(size_t)m * D + ch] = f2bf((yn + bon * p.RW_V()[(size_t)m * A_W + ch]) * p.RW_GATE()[(size_t)m * A_W + ch]); }
    } else {
        const int h = g - 4; const float* o0 = p.OB() + (size_t)m * B_W + h * 128; const float* o1 = p.OB() + ((size_t)NTOK + m) * B_W + h * 128;
        float ss = 0.f; for (int c = 0; c < 128; ++c) { const float o = o0[c] + o1[c]; ss += o * o; }
        const float rs = 1.0f / sqrtf(ss / 128.f + 1e-6f);
        for (int c = 0; c < 128; ++c) { const float z = ldU(p, (size_t)m * INP + B_OFF + 1536 + h * 128 + c);
            p.MIX()[(size_t)m * D + 256 + h * 128 + c] = f2bf((o0[c] + o1[c]) * rs * p.gdn_norm[l * 128 + c] * siluf_(z)); }
    }
}
DEVFN void task_resid1(const P& p, int l, long task) {
    const int m = (int)task; const float* mo = p.MO() + (size_t)m * D; float* xr = p.X() + (size_t)m * D;
    const float* md = p.MOD() + ((size_t)l * (BATCH + 1) + mod_row(m)) * 6 * D;
    float ss = 0.f; for (int k = 0; k < D; ++k) ss += mo[k] * mo[k];
    const float rstd = 1.0f / sqrtf(ss / D + 1e-6f); const float* pn = p.post_norm + (size_t)(l * 2 + 0) * D;
    float s2 = 0.f;
    for (int k = 0; k < D; ++k) { const float xv = xr[k] + md[2 * D + k] * (mo[k] * rstd) * pn[k]; xr[k] = xv; s2 += xv * xv; }
    const float r2 = 1.0f / sqrtf(s2 / D + 1e-6f); const float* pn2 = p.pre_norm + (size_t)(l * 2 + 1) * D;
    for (int k = 0; k < D; ++k) { const float tv = xr[k] * r2 * pn2[k] * (1.0f + md[4 * D + k]) + md[3 * D + k]; p.TOKF()[(size_t)m * D + k] = tv; p.HB()[(size_t)m * D + k] = f2bf(tv); }
}
DEVFN void task_router(const P& p, int l, long task) {
    const int m = (int)task; const float* tk = p.TOKF() + (size_t)m * D; const float* rw = p.router_w + (size_t)l * D * NEXP;
    float lg[NEXP];
#pragma unroll
    for (int e = 0; e < NEXP; ++e) lg[e] = p.router_b[l * NEXP + e];
    for (int k = 0; k < D; ++k) { const float tv = tk[k];
#pragma unroll
        for (int e = 0; e < NEXP; ++e) lg[e] += tv * rw[(size_t)k * NEXP + e]; }
    int idx[TOPK]; float val[TOPK];
#pragma unroll
    for (int j = 0; j < TOPK; ++j) { float best = -3.0e38f; int bi = 0;
#pragma unroll
        for (int e = 0; e < NEXP; ++e) { if (lg[e] > best) { best = lg[e]; bi = e; } }
        idx[j] = bi; val[j] = best;
#pragma unroll
        for (int e = 0; e < NEXP; ++e) if (e == bi) lg[e] = -3.0e38f; }
    float sum = 0.f, ex[TOPK];
#pragma unroll
    for (int j = 0; j < TOPK; ++j) { ex[j] = expf(val[j] - val[0]); sum += ex[j]; }
#pragma unroll
    for (int j = 0; j < TOPK; ++j) { p.TOPI()[(size_t)m * TOPK + j] = idx[j]; p.TOPG()[(size_t)m * TOPK + j] = ex[j] / sum; p.POS()[(size_t)m * TOPK + j] = GLOBAL_ATOMIC_ADD(&p.cnt()[l * NEXP + idx[j]], 1); }
}
DEVFN int moe_pstart(const P& p, int l, int e, int* nblk) {
    int acc = 0, ps = 0;
    for (int i = 0; i < NEXP; ++i) { if (i == e) ps = acc; acc += (p.cnt()[l * NEXP + i] + 255) / 256 * 256; }
    if (nblk) *nblk = acc / 256; return ps;
}
DEVFN void task_slots(const P& p, int l, long task) {
    const int e = p.TOPI()[task]; const int slot = moe_pstart(p, l, e, nullptr) + p.POS()[task];
    p.TSLOT()[task] = slot; p.SLOT_TOK()[slot] = (int)(task / TOPK);
}
DEVFN void task_blocke(const P& p, int l, long task) {
    int acc = 0, e_of = NEXP - 1, nb = 0;
    for (int i = 0; i < NEXP; ++i) { const int nbk = (p.cnt()[l * NEXP + i] + 255) / 256; if ((int)task >= acc && (int)task < acc + nbk) e_of = i; acc += nbk; }
    nb = acc; p.BLOCK_E()[task] = e_of; if (task == 0) p.NBLK()[0] = nb;
}
DEVFN void task_gather(const P& p, long task) {
    const long slot = task / 128; const int ch = (int)(task % 128); const int tok = p.SLOT_TOK()[slot];
    const uint4* s = (const uint4*)(p.HB() + (size_t)tok * D) + ch; ((uint4*)(p.XG() + (size_t)slot * D))[ch] = *s;
}
DEVFN void task_combine(const P& p, int l, long task) {
    const int m = (int)task; float* xr = p.X() + (size_t)m * D; const float* md = p.MOD() + ((size_t)l * (BATCH + 1) + mod_row(m)) * 6 * D;
    const bf16_t* y0 = p.YB() + (size_t)p.TSLOT()[(size_t)m * 4 + 0] * D; const bf16_t* y1 = p.YB() + (size_t)p.TSLOT()[(size_t)m * 4 + 1] * D;
    const bf16_t* y2 = p.YB() + (size_t)p.TSLOT()[(size_t)m * 4 + 2] * D; const bf16_t* y3 = p.YB() + (size_t)p.TSLOT()[(size_t)m * 4 + 3] * D;
    const float g0 = p.TOPG()[(size_t)m * 4 + 0], g1 = p.TOPG()[(size_t)m * 4 + 1], g2 = p.TOPG()[(size_t)m * 4 + 2], g3 = p.TOPG()[(size_t)m * 4 + 3];
    float ss = 0.f;
    for (int k = 0; k < D; ++k) { const float f = g0 * bf2f(y0[k]) + g1 * bf2f(y1[k]) + g2 * bf2f(y2[k]) + g3 * bf2f(y3[k]); ss += f * f; }
    const float rstd = 1.0f / sqrtf(ss / D + 1e-6f); const float* pn = p.post_norm + (size_t)(l * 2 + 1) * D;
    const bool last = (l == DEPTH - 1);
    for (int k = 0; k < D; ++k) { const float f = g0 * bf2f(y0[k]) + g1 * bf2f(y1[k]) + g2 * bf2f(y2[k]) + g3 * bf2f(y3[k]);
        const float xv = xr[k] + md[5 * D + k] * (f * rstd) * pn[k]; xr[k] = xv; if (last) p.out[(size_t)m * D + k] = xv; }
}

#ifndef HOST_TEST
namespace pg8 {
#define PG8_LAS __attribute__((address_space(3)))
typedef short bf16x8 __attribute__((ext_vector_type(8)));
typedef float f32x4 __attribute__((ext_vector_type(4)));
typedef unsigned u32x4 __attribute__((ext_vector_type(4)));
typedef unsigned u32x2 __attribute__((ext_vector_type(2)));
constexpr int BM = 256, BK = 64, HALF = 128, HTB = HALF * BK * 2, STAGE_BYTES = 8 * HTB, NXCD = 8, WGM = 8;
__host__ __device__ __forceinline__ int lds_byte(int r, int c) { const int st = (r >> 4) * 2 + (c >> 5), rr = r & 15, cc = c & 31, ob = rr * 64 + cc * 2; return st * 1024 + (ob ^ (((ob >> 9) & 1) << 5)); }
__host__ __device__ __forceinline__ void stage_rc(int b, int& R, int& C) { const int st = b / 1024, sb = b % 1024, swz = sb ^ (((sb >> 9) & 1) << 5); R = (st >> 1) * 16 + swz / 64; C = (st & 1) * 32 + (swz % 64) / 2; }
__host__ __device__ __forceinline__ int perm32(int rho) { const int n = rho >> 4, i = rho & 15; return 8 * (i >> 2) + 4 * n + (i & 3); }
struct Unit { int pm, pn, e; };
struct Gemm { const bf16_t* A; const bf16_t* Bt; int K; size_t estride; };
struct StaticOrder {
    int nM, nN, nwg, G, c;
    __device__ void init(int M, int N, int G_, int c_) { nM = M / BM; nN = N / BM; nwg = nM * nN; G = G_; c = c_; }
    __device__ bool next(int i, Unit& u) const {
        const long L = (long)i * G + c; if (L >= nwg) return false;
        int wgid = (int)L; { const int q = nwg / NXCD, r = nwg % NXCD, xcd = wgid % NXCD, off = wgid / NXCD; wgid = (xcd < r ? xcd * (q + 1) : r * (q + 1) + (xcd - r) * q) + off; }
        const int nig = WGM * nN, gid = wgid / nig, fm = gid * WGM, gsz = (nM - fm) < WGM ? (nM - fm) : WGM;
        u.pm = fm + ((wgid % nig) % gsz); u.pn = (wgid % nig) / gsz; u.e = 0; return true;
    }
};
struct MoeOrder {
    int nblk, nN, G, c; const int* block_e;
    __device__ bool next(int i, Unit& u) const {
        const long L = (long)i * G + c; if (L >= (long)nblk * nN) return false;
        u.pm = (int)(L / nN); u.pn = (int)(L % nN); u.e = __builtin_amdgcn_readfirstlane(block_e[u.pm]); return true;
    }
};
__device__ __forceinline__ unsigned cvt_pk_bf16(float lo, float hi) { unsigned r; asm volatile("v_cvt_pk_bf16_f32 %0, %1, %2" : "=v"(r) : "v"(lo), "v"(hi)); return r; }
struct EpiF32 {
    static constexpr bool PERM = false;
    float* C; int ldc;
    __device__ __forceinline__ void operator()(const f32x4 (&acc)[2][2][4][2], const Unit& u, int wr, int wc, int fr, int fq) const {
        const int row0 = u.pm * BM + wr * 64 + fr, col0 = u.pn * BM + wc * 32 + 4 * fq;
#pragma unroll
        for (int ai = 0; ai < 2; ++ai)
#pragma unroll
            for (int m = 0; m < 4; ++m) { float* rowp = C + (size_t)(row0 + ai * HALF + m * 16) * ldc + col0;
#pragma unroll
                for (int bj = 0; bj < 2; ++bj)
#pragma unroll
                    for (int n = 0; n < 2; ++n) *(f32x4*)(rowp + bj * HALF + n * 16) = acc[ai][bj][m][n]; }
    }
};
struct EpiBf16Bias {
    static constexpr bool PERM = true;
    bf16_t* O; int ldc; const float* bias; int bias_estride;
    __device__ __forceinline__ void operator()(const f32x4 (&acc)[2][2][4][2], const Unit& u, int wr, int wc, int fr, int fq) const {
        const int row0 = u.pm * BM + wr * 64 + fr, col0 = u.pn * BM + wc * 32 + 8 * fq; const float* bp = bias + (size_t)u.e * bias_estride + col0;
        f32x4 bv[2][2];
#pragma unroll
        for (int bj = 0; bj < 2; ++bj)
#pragma unroll
            for (int n = 0; n < 2; ++n) bv[bj][n] = bias ? *(const f32x4*)(bp + bj * HALF + 4 * n) : (f32x4){0.f, 0.f, 0.f, 0.f};
#pragma unroll
        for (int ai = 0; ai < 2; ++ai)
#pragma unroll
            for (int m = 0; m < 4; ++m) { bf16_t* rowp = O + (size_t)(row0 + ai * HALF + m * 16) * ldc + col0;
#pragma unroll
                for (int bj = 0; bj < 2; ++bj) { const f32x4 v0 = acc[ai][bj][m][0] + bv[bj][0], v1 = acc[ai][bj][m][1] + bv[bj][1];
                    u32x4 w; w.x = cvt_pk_bf16(v0[0], v0[1]); w.y = cvt_pk_bf16(v0[2], v0[3]); w.z = cvt_pk_bf16(v1[0], v1[1]); w.w = cvt_pk_bf16(v1[2], v1[3]);
                    *(u32x4*)(rowp + bj * HALF) = w; } }
    }
};
__device__ __forceinline__ float swiglu1(float g, float lin) { g = fminf(g, 7.0f); lin = fminf(fmaxf(lin, -7.0f), 7.0f); return g / (1.0f + __expf(-1.702f * g)) * (lin + 1.0f); }
struct EpiSwiglu {
    static constexpr bool PERM = true;
    bf16_t* O; int ldc; const float* bias; int bias_estride;
    __device__ __forceinline__ void operator()(const f32x4 (&acc)[2][2][4][2], const Unit& u, int wr, int wc, int fr, int fq) const {
        const int row0 = u.pm * BM + wr * 64 + fr, col0 = u.pn * BM + wc * 32 + 8 * fq; const float* bp = bias + (size_t)u.e * bias_estride + col0;
        f32x4 bv[2][2];
#pragma unroll
        for (int bj = 0; bj < 2; ++bj)
#pragma unroll
            for (int n = 0; n < 2; ++n) bv[bj][n] = *(const f32x4*)(bp + bj * HALF + 4 * n);
#pragma unroll
        for (int ai = 0; ai < 2; ++ai)
#pragma unroll
            for (int m = 0; m < 4; ++m) { bf16_t* rowp = O + (size_t)(row0 + ai * HALF + m * 16) * ldc + (col0 >> 1);
#pragma unroll
                for (int bj = 0; bj < 2; ++bj) { const f32x4 v0 = acc[ai][bj][m][0] + bv[bj][0], v1 = acc[ai][bj][m][1] + bv[bj][1];
                    u32x2 w; w.x = cvt_pk_bf16(swiglu1(v0[0], v0[1]), swiglu1(v0[2], v0[3])); w.y = cvt_pk_bf16(swiglu1(v1[0], v1[1]), swiglu1(v1[2], v1[3]));
                    *(u32x2*)(rowp + bj * (HALF / 2)) = w; } }
    }
};

template <class Epi, class Sched>
__device__ __forceinline__ void gemm_phase(PG8_LAS unsigned char* lds, const Gemm g, const Sched& S, const Epi& E) {
    int tid = threadIdx.x; asm volatile("" : "+v"(tid));
    const int wid = __builtin_amdgcn_readfirstlane(tid >> 6), lane = tid & 63, wr = wid >> 2, wc = wid & 3, fr = lane & 15, fq = lane >> 4;
    const int K = g.K, nt = K / BK;
    unsigned voffA[2], voffB[2];
#pragma unroll
    for (int i = 0; i < 2; ++i) { int R, C; stage_rc(tid * 16 + i * 8192, R, C); const int Rb = Epi::PERM ? ((R & ~31) + perm32(R & 31)) : R;
        voffA[i] = (unsigned)(R * K + C) * 2u; voffB[i] = (unsigned)(Rb * K + C) * 2u; }
    const size_t kstep = (size_t)(BK * 2);
    const size_t hstep = (size_t)HALF * K * 2;
    const size_t tstep = 2 * hstep;
    const unsigned ldsw = (unsigned)wid * 1024u;
    const int aoff = lds_byte(wr * 64 + fr, fq * 8), boff = lds_byte(wc * 32 + fr, fq * 8);
#define PG8_SA(b, h) (((b) * 2 + (h)) * HTB)
#define PG8_SB(b, h) ((4 + (b) * 2 + (h)) * HTB)
#define PG8_STAGE(bufoff, gbase, voff) do { _Pragma("unroll") for (int _i = 0; _i < 2; ++_i) \
        __builtin_amdgcn_global_load_lds((const unsigned*)((const char*)(gbase) + (voff)[_i]), (PG8_LAS unsigned*)(lds + (bufoff) + ldsw + _i * 8192), 16, 0, 0); } while (0)
#define PG8_LDA(dst, b, h) do { _Pragma("unroll") for (int m = 0; m < 4; ++m) _Pragma("unroll") for (int k = 0; k < 2; ++k) dst[m][k] = *(const PG8_LAS bf16x8*)(lds + PG8_SA(b, h) + aoff + m * 2048 + k * 1024); } while (0)
#define PG8_LDB(dst, b, h) do { _Pragma("unroll") for (int n = 0; n < 2; ++n) _Pragma("unroll") for (int k = 0; k < 2; ++k) dst[n][k] = *(const PG8_LAS bf16x8*)(lds + PG8_SB(b, h) + boff + n * 2048 + k * 1024); } while (0)
#define PG8_MMA(ai, bj, At, Bt) do { __builtin_amdgcn_s_setprio(1); _Pragma("unroll") for (int m = 0; m < 4; ++m) _Pragma("unroll") for (int n = 0; n < 2; ++n) _Pragma("unroll") for (int k = 0; k < 2; ++k) \
        acc[ai][bj][m][n] = __builtin_amdgcn_mfma_f32_16x16x32_bf16(Bt[n][k], At[m][k], acc[ai][bj][m][n], 0, 0, 0); __builtin_amdgcn_s_setprio(0); } while (0)
#define PG8_WAIT_V(n) asm volatile("s_waitcnt vmcnt(" #n ")" ::: "memory")
#define PG8_WAIT_L(n) asm volatile("s_waitcnt lgkmcnt(" #n ")" ::: "memory")
#define PG8_BAR __builtin_amdgcn_s_barrier()
#define PG8_SCHED __builtin_amdgcn_sched_barrier(0)
    Unit cur, nxt; int ui = 0;
    if (!S.next(0, cur)) return;
    f32x4 acc[2][2][4][2];
#pragma unroll
    for (int a = 0; a < 2; ++a)
#pragma unroll
        for (int b = 0; b < 2; ++b)
#pragma unroll
            for (int m = 0; m < 4; ++m)
#pragma unroll
                for (int n = 0; n < 2; ++n) acc[a][b][m][n] = (f32x4){0.f, 0.f, 0.f, 0.f};
    bf16x8 At[4][2], B0[2][2], B1[2][2];
    const char* cA = (const char*)g.A + (size_t)cur.pm * tstep; const char* cB = (const char*)(g.Bt + (size_t)cur.e * g.estride) + (size_t)cur.pn * tstep;
    PG8_STAGE(PG8_SB(0, 0), cB, voffB); PG8_STAGE(PG8_SB(0, 1), cB + hstep, voffB); PG8_STAGE(PG8_SA(0, 0), cA, voffA); PG8_STAGE(PG8_SA(0, 1), cA + hstep, voffA);
    if (wr == 1) PG8_BAR;
    PG8_WAIT_V(2); PG8_BAR;
    PG8_STAGE(PG8_SB(1, 0), cB + kstep, voffB); PG8_STAGE(PG8_SA(1, 0), cA + kstep, voffA); PG8_STAGE(PG8_SB(1, 1), cB + hstep + kstep, voffB);
    PG8_WAIT_V(6); PG8_BAR;
    for (;;) {
        const bool has_next = S.next(ui + 1, nxt);
        const char* nA = has_next ? (const char*)g.A + (size_t)nxt.pm * tstep : cA; const char* nB = has_next ? (const char*)(g.Bt + (size_t)nxt.e * g.estride) + (size_t)nxt.pn * tstep : cB;
        for (int t = 0; t < nt; t += 2) {
            const bool last = (t == nt - 2);
            const char* a1 = cA + (size_t)(t + 1) * kstep;
            const char* a2 = last ? nA : cA + (size_t)(t + 2) * kstep; const char* b2 = last ? nB : cB + (size_t)(t + 2) * kstep;
            const char* a3 = a2 + kstep; const char* b3 = b2 + kstep;
            PG8_LDB(B0, 0, 0); PG8_LDB(B1, 0, 1); PG8_SCHED; PG8_LDA(At, 0, 0); PG8_STAGE(PG8_SA(1, 1), a1 + hstep, voffA);
            PG8_WAIT_V(8); PG8_WAIT_L(0); PG8_BAR; PG8_MMA(0, 0, At, B0); PG8_MMA(0, 1, At, B1); PG8_BAR; PG8_SCHED;
            PG8_LDA(At, 0, 1); PG8_STAGE(PG8_SB(0, 0), b2, voffB); PG8_STAGE(PG8_SB(0, 1), b2 + hstep, voffB); PG8_STAGE(PG8_SA(0, 0), a2, voffA);
            PG8_WAIT_V(8); PG8_WAIT_L(0); PG8_BAR; PG8_MMA(1, 0, At, B0); PG8_MMA(1, 1, At, B1); PG8_BAR; PG8_SCHED;
            PG8_LDB(B0, 1, 0); PG8_LDB(B1, 1, 1); PG8_SCHED; PG8_LDA(At, 1, 0); PG8_STAGE(PG8_SA(0, 1), a2 + hstep, voffA);
            PG8_WAIT_V(8); PG8_WAIT_L(0); PG8_BAR; PG8_MMA(0, 0, At, B0); PG8_MMA(0, 1, At, B1); PG8_BAR; PG8_SCHED;
            PG8_LDA(At, 1, 1); PG8_STAGE(PG8_SB(1, 0), b3, voffB); PG8_STAGE(PG8_SB(1, 1), b3 + hstep, voffB); PG8_STAGE(PG8_SA(1, 0), a3, voffA);
            PG8_WAIT_V(8); PG8_WAIT_L(0); PG8_BAR; PG8_MMA(1, 0, At, B0); PG8_MMA(1, 1, At, B1); PG8_BAR; PG8_SCHED;
        }
        if (wr == 0) PG8_BAR;
        E(acc, cur, wr, wc, fr, fq);
        if (!has_next) break;
#pragma unroll
        for (int a = 0; a < 2; ++a)
#pragma unroll
            for (int b = 0; b < 2; ++b)
#pragma unroll
                for (int m = 0; m < 4; ++m)
#pragma unroll
                    for (int n = 0; n < 2; ++n) acc[a][b][m][n] = (f32x4){0.f, 0.f, 0.f, 0.f};
        cur = nxt; cA = nA; cB = nB; ++ui;
        if (wr == 1) PG8_BAR;
    }
    PG8_WAIT_V(0);
    PG8_BAR;
#undef PG8_SA
#undef PG8_SB
#undef PG8_STAGE
#undef PG8_LDA
#undef PG8_LDB
#undef PG8_MMA
#undef PG8_WAIT_V
#undef PG8_WAIT_L
#undef PG8_BAR
#undef PG8_SCHED
}
}

#define XB_TMO      128
#define XB_XCNT(j)  (256  + 64 * (j))
#define XB_XSUB(j)  (1280 + 64 * (j))
#define XB_XGEN(j)  (2304 + 64 * (j))
#define XB_TOP      3328
#define XB_TOPGEN   3392
#define XCD_BAR_WORDS 3456
#define XB_SPIN_CAP (1u << 22)
#define LAS __attribute__((address_space(3)))
__device__ __forceinline__ unsigned xb_ld(unsigned* p)              { return __hip_atomic_load(p, __ATOMIC_RELAXED, __HIP_MEMORY_SCOPE_AGENT); }
__device__ __forceinline__ unsigned xb_add(unsigned* p, unsigned v) { return __hip_atomic_fetch_add(p, v, __ATOMIC_RELAXED, __HIP_MEMORY_SCOPE_AGENT); }
__device__ __forceinline__ unsigned xb_xcc_id() { return (unsigned)__builtin_amdgcn_s_getreg((3 << 11) | 20) & 0xFu; }
#define XB_SPIN(cond, bar) do { unsigned _sp = 0; while (cond) { __builtin_amdgcn_s_sleep(1); \
    if ((++_sp & 255u) == 0u) { if (xb_ld(&(bar)[XB_TMO])) break; if (_sp > XB_SPIN_CAP) { atomicAdd(&(bar)[XB_TMO], 1u); break; } } } } while (0)
struct XcdBarrier { unsigned* bar; unsigned x; volatile LAS unsigned* st; };
__device__ __forceinline__ XcdBarrier xcd_barrier_post(unsigned* bar, volatile LAS unsigned* st) {
    XcdBarrier b; b.bar = bar; b.x = xb_xcc_id(); b.st = st;
    if (threadIdx.x == 0) (void)xb_add(&bar[XB_XCNT(b.x)], 1u);
    return b;
}
__device__ __forceinline__ void xcd_barrier_complete(unsigned* bar, unsigned x, unsigned& nloc, unsigned& nx) {
    const unsigned G = gridDim.x * gridDim.y * gridDim.z;
    unsigned sum, cnt, mine, sp = 0u;
    for (;;) {
        sum = 0u; cnt = 0u; mine = 0u;
#pragma unroll
        for (unsigned j = 0; j < 16; ++j) { const unsigned c = xb_ld(&bar[XB_XCNT(j)]); sum += c; cnt += (c > 0u) ? 1u : 0u; mine = (j == x) ? c : mine; }
        if (sum == G) break;
        __builtin_amdgcn_s_sleep(1);
        if ((++sp & 255u) == 0u) { if (xb_ld(&bar[XB_TMO])) break; if (sp > XB_SPIN_CAP) { atomicAdd(&bar[XB_TMO], 1u); break; } }
    }
    nloc = mine > 0u ? mine : 1u; nx = cnt > 0u ? cnt : 1u;
}
__device__ __forceinline__ void xcd_barrier(const XcdBarrier& b) {
    asm volatile("s_waitcnt vmcnt(0)" ::: "memory");
    __syncthreads();
    if (threadIdx.x == 0) {
        unsigned* bar = b.bar;
        __builtin_amdgcn_s_waitcnt(0);
        unsigned nloc = b.st[0], nx = b.st[1];
        if (nloc == 0u) { xcd_barrier_complete(bar, b.x, nloc, nx); b.st[0] = nloc; b.st[1] = nx; }
        const unsigned old = xb_add(&bar[XB_XSUB(b.x)], 1u);
        const unsigned gen = old / nloc;
        if (old + 1u == (gen + 1u) * nloc) {
            __builtin_amdgcn_fence(__ATOMIC_RELEASE, "agent");
            asm volatile("s_waitcnt vmcnt(0)" ::: "memory");
            const unsigned og = xb_add(&bar[XB_TOP], 1u);
            const unsigned tg = og / nx;
            if (og + 1u == (tg + 1u) * nx) xb_add(&bar[XB_TOPGEN], 1u);
            else XB_SPIN(xb_ld(&bar[XB_TOPGEN]) == tg, bar);
            __builtin_amdgcn_fence(__ATOMIC_ACQUIRE, "agent");
            xb_add(&bar[XB_XGEN(b.x)], 1u);
            asm volatile("s_waitcnt vmcnt(0)" ::: "memory");
        } else {
            XB_SPIN(xb_ld(&bar[XB_XGEN(b.x)]) == gen, bar);
            __builtin_amdgcn_fence(__ATOMIC_ACQUIRE, "agent");
            asm volatile("s_waitcnt vmcnt(0)" ::: "memory");
        }
    }
    __syncthreads();
}


constexpr int NWAVES = 8, NTHR = 512;
typedef float f32x4_t __attribute__((ext_vector_type(4)));
typedef unsigned u32x2_t __attribute__((ext_vector_type(2)));
typedef unsigned u32x4_t __attribute__((ext_vector_type(4)));
typedef short bf16x8_t __attribute__((ext_vector_type(8)));
__device__ __forceinline__ float wave_sum(float v) {
#pragma unroll
    for (int o = 1; o < 64; o <<= 1) v += __shfl_xor(v, o);
    return v;
}
__device__ __forceinline__ float grp16_sum(float v) {
#pragma unroll
    for (int o = 1; o < 16; o <<= 1) v += __shfl_xor(v, o);
    return v;
}
__device__ __forceinline__ float hsum4(f32x4_t a) { return (a.x + a.y) + (a.z + a.w); }
__device__ __forceinline__ float hsq4(f32x4_t a) { return (a.x * a.x + a.y * a.y) + (a.z * a.z + a.w * a.w); }
__device__ __forceinline__ u32x2_t pk4(f32x4_t t) { u32x2_t w; w.x = pg8::cvt_pk_bf16(t.x, t.y); w.y = pg8::cvt_pk_bf16(t.z, t.w); return w; }
__device__ __forceinline__ float bflo(unsigned w) { return __builtin_bit_cast(float, w << 16); }
__device__ __forceinline__ float bfhi(unsigned w) { return __builtin_bit_cast(float, w & 0xffff0000u); }
template <bool TO_LDS> __device__ __forceinline__ void norm_mod_store(const f32x4_t (&v)[4], float rstd, const float* pn, const float* sh, const float* sc, bf16_t* orow, LAS unsigned char* lrow, int lane) {
#pragma unroll
    for (int j = 0; j < 4; ++j) { const int k = 4 * lane + 256 * j;
        const f32x4_t pv = *(const f32x4_t*)(pn + k), sv = *(const f32x4_t*)(sc + k), hv = *(const f32x4_t*)(sh + k);
        const f32x4_t t = v[j] * rstd * pv * (1.0f + sv) + hv; const u32x2_t w = pk4(t);
        *(u32x2_t*)(orow + k) = w; if (TO_LDS) *(LAS u32x2_t*)(lrow + 2 * k) = w; }
}
__device__ __forceinline__ void dev_norm1_l0(const P& p, int gw, int ngw, int lane) {
    const float* md0 = p.MOD(); const float* pn = p.pre_norm;
    for (int m = gw; m < NTOK; m += ngw) {
        const float* src = m < NLAT ? p.x + (size_t)m * D : p.ctx + (size_t)(m - NLAT) * D;
        f32x4_t v[4]; float ss = 0.f;
#pragma unroll
        for (int j = 0; j < 4; ++j) { v[j] = *(const f32x4_t*)(src + 4 * lane + 256 * j); ss += hsq4(v[j]); *(f32x4_t*)(p.X() + (size_t)m * D + 4 * lane + 256 * j) = v[j]; }
        const float rstd = 1.0f / sqrtf(wave_sum(ss) * (1.0f / D) + 1e-6f);
        const float* md = md0 + (size_t)mod_row(m) * 6 * D;
        norm_mod_store<false>(v, rstd, pn, md, md + D, p.HB() + (size_t)m * D, (LAS unsigned char*)0, lane);
    }
}
__device__ __forceinline__ void dev_post(const P& p, int l, int ntok_l, int gw, int ngw, int lane) {
    const int h = lane >> 4;
    for (int m = gw; m < ntok_l; m += ngw) {
        {
            const f32x4_t y = *(const f32x4_t*)(p.YA() + (size_t)m * A_W + 4 * lane) + *(const f32x4_t*)(p.YA() + ((size_t)NTOK + m) * A_W + 4 * lane);
            const float mean = grp16_sum(hsum4(y)) * (1.0f / 64.f); const f32x4_t d = y - mean;
            const float var = grp16_sum(hsq4(d)) * (1.0f / 64.f); const float rs = 1.0f / sqrtf(var + 64e-5f);
            const f32x4_t lw = *(const f32x4_t*)(p.rw_ln_w + l * A_W + 4 * lane), lb = *(const f32x4_t*)(p.rw_ln_b + l * A_W + 4 * lane);
            const f32x4_t vv = *(const f32x4_t*)(p.RW_V() + (size_t)m * A_W + 4 * lane), gt = *(const f32x4_t*)(p.RW_GATE() + (size_t)m * A_W + 4 * lane);
            const float bon = p.RW_BON()[(size_t)m * A_H + h];
            const f32x4_t o = (d * rs * lw + lb + bon * vv) * gt;
            *(u32x2_t*)(p.MIX() + (size_t)m * D + 4 * lane) = pk4(o);
        }
        {
            const float* o0 = p.OB() + (size_t)m * B_W + 8 * lane; const float* o1 = p.OB() + ((size_t)NTOK + m) * B_W + 8 * lane;
            const f32x4_t a = *(const f32x4_t*)o0 + *(const f32x4_t*)o1, b = *(const f32x4_t*)(o0 + 4) + *(const f32x4_t*)(o1 + 4);
            const float rs = 1.0f / sqrtf(grp16_sum(hsq4(a) + hsq4(b)) * (1.0f / 128.f) + 1e-6f);
            const u32x4_t zr = *(const u32x4_t*)(p.U() + (size_t)m * INP + B_OFF + 1536 + 8 * lane);
            const float* nw = p.gdn_norm + l * 128 + ((8 * lane) & 127);
            const f32x4_t n0 = *(const f32x4_t*)nw, n1 = *(const f32x4_t*)(nw + 4);
            const f32x4_t z0 = {bflo(zr.x), bfhi(zr.x), bflo(zr.y), bfhi(zr.y)}, z1 = {bflo(zr.z), bfhi(zr.z), bflo(zr.w), bfhi(zr.w)};
            f32x4_t s0, s1;
#pragma unroll
            for (int c = 0; c < 4; ++c) { s0[c] = z0[c] / (1.0f + __expf(-z0[c])); s1[c] = z1[c] / (1.0f + __expf(-z1[c])); }
            const f32x4_t r0 = a * rs * n0 * s0, r1 = b * rs * n1 * s1;
            u32x4_t w; const u32x2_t w0 = pk4(r0), w1 = pk4(r1); w.x = w0.x; w.y = w0.y; w.z = w1.x; w.w = w1.y;
            *(u32x4_t*)(p.MIX() + (size_t)m * D + 256 + 8 * lane) = w;
        }
    }
}
constexpr int RT_TK = 0, RT_TKS = 2064, RT_PL = 34816, RT_LG = RT_PL + 16384, RT_CNT = RT_LG + 2304, RT_BASE = RT_CNT + 128, RT_ASG = RT_BASE + 128, RT_ASG_MAX = 4096;
__device__ __forceinline__ void dev_resid_router(const P& p, int l, int ntok_l, LAS unsigned char* lds, int G, int tid) {
    const int lane = tid & 63, wave = tid >> 6;
    LAS int* LCNT = (LAS int*)(lds + RT_CNT); LAS int* LBASE = (LAS int*)(lds + RT_BASE); LAS int* ASG = (LAS int*)(lds + RT_ASG);
    LAS float* PL = (LAS float*)(lds + RT_PL); LAS float* LG = (LAS float*)(lds + RT_LG);
    if (tid < 32) LCNT[tid] = 0;
    __syncthreads();
    const float* pn = p.post_norm + (size_t)(l * 2 + 0) * D; const float* pn2 = p.pre_norm + (size_t)(l * 2 + 1) * D;
    const int ngrp = ntok_l / 16; int it = 0;
    for (int grp = blockIdx.x; grp < ngrp; grp += G, ++it) {
#pragma unroll 1
        for (int rr = 0; rr < 2; ++rr) {
            const int ri = wave * 2 + rr, m = grp * 16 + ri;
            const float* mo = p.MO() + (size_t)m * D; float* xr = p.X() + (size_t)m * D; const float* md = p.MOD() + ((size_t)l * (BATCH + 1) + mod_row(m)) * 6 * D;
            f32x4_t v[4], x[4]; float ss = 0.f;
#pragma unroll
            for (int j = 0; j < 4; ++j) { v[j] = *(const f32x4_t*)(mo + 4 * lane + 256 * j); x[j] = *(const f32x4_t*)(xr + 4 * lane + 256 * j); ss += hsq4(v[j]); }
            const float rstd = 1.0f / sqrtf(wave_sum(ss) * (1.0f / D) + 1e-6f); float s2 = 0.f;
#pragma unroll
            for (int j = 0; j < 4; ++j) { const int k = 4 * lane + 256 * j; const f32x4_t g1 = *(const f32x4_t*)(md + 2 * D + k), pv = *(const f32x4_t*)(pn + k);
                x[j] = x[j] + g1 * (v[j] * rstd) * pv; s2 += hsq4(x[j]); *(f32x4_t*)(xr + k) = x[j]; }
            const float r2 = 1.0f / sqrtf(wave_sum(s2) * (1.0f / D) + 1e-6f);
            norm_mod_store<true>(x, r2, pn2, md + 3 * D, md + 4 * D, p.HB() + (size_t)m * D, lds + RT_TK + ri * RT_TKS, lane);
        }
        __syncthreads();
        {
            const int i = lane & 15, q = lane >> 4; pg8::f32x4 acc0 = {0.f, 0.f, 0.f, 0.f}, acc1 = {0.f, 0.f, 0.f, 0.f};
#pragma unroll
            for (int ks = 0; ks < 4; ++ks) { const int k0 = 128 * wave + 32 * ks + 8 * q;
                const bf16x8_t a = *(const LAS bf16x8_t*)(lds + RT_TK + i * RT_TKS + 2 * k0);
                const bf16x8_t b0 = *(const bf16x8_t*)(p.WR_T() + (size_t)i * D + k0), b1 = *(const bf16x8_t*)(p.WR_T() + (size_t)(16 + i) * D + k0);
                acc0 = __builtin_amdgcn_mfma_f32_16x16x32_bf16(a, b0, acc0, 0, 0, 0); acc1 = __builtin_amdgcn_mfma_f32_16x16x32_bf16(a, b1, acc1, 0, 0, 0); }
#pragma unroll
            for (int r = 0; r < 4; ++r) { PL[(wave * 16 + 4 * q + r) * 32 + i] = acc0[r]; PL[(wave * 16 + 4 * q + r) * 32 + 16 + i] = acc1[r]; }
        }
        __syncthreads();
        {
            const int ri = tid >> 5, e = tid & 31; float sacc = p.router_b[l * NEXP + e];
#pragma unroll
            for (int w = 0; w < 8; ++w) sacc += PL[(w * 16 + ri) * 32 + e];
            LG[ri * 33 + e] = sacc;
        }
        __syncthreads();
        if (tid < 16) {
            const int m = grp * 16 + tid; float lg[NEXP];
#pragma unroll
            for (int e = 0; e < NEXP; ++e) lg[e] = LG[tid * 33 + e];
            int idx[TOPK]; float val[TOPK];
#pragma unroll
            for (int j = 0; j < TOPK; ++j) { float best = -3.0e38f; int bi = 0;
#pragma unroll
                for (int e = 0; e < NEXP; ++e) { if (lg[e] > best) { best = lg[e]; bi = e; } }
                idx[j] = bi; val[j] = best;
#pragma unroll
                for (int e = 0; e < NEXP; ++e) if (e == bi) lg[e] = -3.0e38f; }
            float sum = 0.f, ex[TOPK];
#pragma unroll
            for (int j = 0; j < TOPK; ++j) { ex[j] = __expf(val[j] - val[0]); sum += ex[j]; }
            const float inv = 1.0f / sum;
#pragma unroll
            for (int j = 0; j < TOPK; ++j) { p.TOPI()[(size_t)m * TOPK + j] = idx[j]; p.TOPG()[(size_t)m * TOPK + j] = ex[j] * inv;
                const int lp = __hip_atomic_fetch_add(&LCNT[idx[j]], 1, __ATOMIC_RELAXED, __HIP_MEMORY_SCOPE_WORKGROUP);
                const int ai = (it * 16 + tid) * 4 + j; if (ai < RT_ASG_MAX) ASG[ai] = (idx[j] << 20) | lp; }
        }
        __syncthreads();
    }
    if (tid < 32) LBASE[tid] = LCNT[tid] > 0 ? atomicAdd(&p.cnt()[l * NEXP + tid], LCNT[tid]) : 0;
    __syncthreads();
    for (int a = tid; a < it * 64 && a < RT_ASG_MAX; a += NTHR) { const int w = ASG[a]; const int e = w >> 20, lp = w & 0xfffff; const int itx = a / 64, ri = (a % 64) / 4, j = a % 4;
        const int m = (blockIdx.x + itx * G) * 16 + ri; p.POS()[(size_t)m * TOPK + j] = LBASE[e] + lp; }
    __syncthreads();
}
__device__ __forceinline__ void dev_slots(const P& p, int l, int ntok_l, LAS unsigned char* lds, long gtid, long nthr, int tid) {
    LAS int* PST = (LAS int*)lds; LAS int* CN = (LAS int*)(lds + 256);
    if (tid == 0) { int acc = 0; for (int e = 0; e < NEXP; ++e) { const int c = p.cnt()[l * NEXP + e]; PST[e] = acc; CN[e] = c; acc += (c + 255) / 256 * 256; } PST[NEXP] = acc; }
    __syncthreads();
    for (long t = gtid; t < (long)ntok_l * TOPK; t += nthr) { const int e = p.TOPI()[t]; const int slot = PST[e] + p.POS()[t]; p.TSLOT()[t] = slot; p.SLOT_TOK()[slot] = (int)(t / TOPK); }
    for (long t = gtid; t < NEXP * 256; t += nthr) { const int e = (int)(t >> 8), i = (int)(t & 255); const int c = CN[e]; const int pads = (c + 255) / 256 * 256 - c; if (i < pads) p.SLOT_TOK()[PST[e] + c + i] = ZROW; }
    for (long t = gtid; t < NBLK_MAX; t += nthr) { int e_of = NEXP - 1;
        for (int e = 0; e < NEXP; ++e) { if ((int)t * 256 >= PST[e] && (int)t * 256 < PST[e + 1]) e_of = e; }
        p.BLOCK_E()[t] = e_of; if (t == 0) p.NBLK()[0] = PST[NEXP] / 256; }
    __syncthreads();
}
__device__ __forceinline__ void dev_combine(const P& p, int l, int ntok_l, int gw, int ngw, int lane) {
    const bool last = (l == DEPTH - 1); const float* pn = p.post_norm + (size_t)(l * 2 + 1) * D;
    for (int m = gw; m < ntok_l; m += ngw) {
        const int4 sl = *(const int4*)(p.TSLOT() + (size_t)m * 4); const f32x4_t gt = *(const f32x4_t*)(p.TOPG() + (size_t)m * 4);
        const bf16_t* y0 = p.YB() + (size_t)sl.x * D; const bf16_t* y1 = p.YB() + (size_t)sl.y * D; const bf16_t* y2 = p.YB() + (size_t)sl.z * D; const bf16_t* y3 = p.YB() + (size_t)sl.w * D;
        float* xr = p.X() + (size_t)m * D; const float* md = p.MOD() + ((size_t)l * (BATCH + 1) + mod_row(m)) * 6 * D;
        f32x4_t f[4], x[4]; float ss = 0.f;
#pragma unroll
        for (int j = 0; j < 4; ++j) { const int k = 4 * lane + 256 * j;
            const u32x2_t a = *(const u32x2_t*)(y0 + k), b = *(const u32x2_t*)(y1 + k), c = *(const u32x2_t*)(y2 + k), d = *(const u32x2_t*)(y3 + k);
            f[j].x = gt.x * bflo(a.x) + gt.y * bflo(b.x) + gt.z * bflo(c.x) + gt.w * bflo(d.x); f[j].y = gt.x * bfhi(a.x) + gt.y * bfhi(b.x) + gt.z * bfhi(c.x) + gt.w * bfhi(d.x);
            f[j].z = gt.x * bflo(a.y) + gt.y * bflo(b.y) + gt.z * bflo(c.y) + gt.w * bflo(d.y); f[j].w = gt.x * bfhi(a.y) + gt.y * bfhi(b.y) + gt.z * bfhi(c.y) + gt.w * bfhi(d.y);
            ss += hsq4(f[j]); x[j] = *(const f32x4_t*)(xr + k); }
        const float rstd = 1.0f / sqrtf(wave_sum(ss) * (1.0f / D) + 1e-6f); float s2 = 0.f;
#pragma unroll
        for (int j = 0; j < 4; ++j) { const int k = 4 * lane + 256 * j; const f32x4_t g2 = *(const f32x4_t*)(md + 5 * D + k), pv = *(const f32x4_t*)(pn + k);
            x[j] = x[j] + g2 * (f[j] * rstd) * pv; s2 += hsq4(x[j]);
#if defined(PROBE_GDN) || defined(PROBE_RWKV)
            if (last) { const float e = ((const float*)(p.ctl() + 12000))[0], r = ((const float*)(p.ctl() + 12001))[0]; x[j] = x[j] * (1.0f + 10.0f * sqrtf(e / r)); }
#endif
            if (last) *(f32x4_t*)(p.out + (size_t)m * D + k) = x[j]; else *(f32x4_t*)(xr + k) = x[j]; }
        if (!last) { const float r2 = 1.0f / sqrtf(wave_sum(s2) * (1.0f / D) + 1e-6f); const float* md1 = p.MOD() + ((size_t)(l + 1) * (BATCH + 1) + mod_row(m)) * 6 * D;
            norm_mod_store<false>(x, r2, p.pre_norm + (size_t)((l + 1) * 2 + 0) * D, md1, md1 + D, p.HB() + (size_t)m * D, (LAS unsigned char*)0, lane); }
    }
}

#define MMA16(a, b, c) __builtin_amdgcn_mfma_f32_16x16x32_bf16((a), (b), (c), 0, 0, 0)
typedef pg8::f32x4 f32x4;
__device__ __forceinline__ bf16x8_t lfrag(LAS const unsigned char* lds, int off, int ld, int row0, int k0, int lane) {
    return *(LAS const bf16x8_t*)(lds + off + (row0 + (lane & 15)) * ld + (k0 + 8 * (lane >> 4)) * 2);
}
__device__ __forceinline__ bf16x8_t lfrag16(LAS const unsigned char* lds, int off, int ld, int row0, int k0, int lane) {
    bf16x8_t z = {0, 0, 0, 0, 0, 0, 0, 0}; return (lane >> 4) < 2 ? lfrag(lds, off, ld, row0, k0, lane) : z;
}
__device__ __forceinline__ bf16x8_t lfragT(LAS const unsigned char* lds, int off, int ld, int k0, int n0, int kvalid, int lane) {
    bf16x8_t v; const int n = n0 + (lane & 15), kb = 8 * (lane >> 4);
#pragma unroll
    for (int j = 0; j < 8; ++j) v[j] = (kb + j < kvalid) ? *(LAS const short*)(lds + off + (k0 + kb + j) * ld + n * 2) : (short)0;
    return v;
}
__device__ __forceinline__ void st_rm(LAS unsigned char* lds, int off, int ld, int m0, int n0, f32x4 acc, int lane) {
#pragma unroll
    for (int r = 0; r < 4; ++r) *(LAS bf16_t*)(lds + off + (m0 + 4 * (lane >> 4) + r) * ld + (n0 + (lane & 15)) * 2) = f2bf(acc[r]);
}
__device__ __forceinline__ void st_tr(LAS unsigned char* lds, int off, int ld, int m0, int n0, f32x4 acc, int lane) {
    u32x2_t w; w.x = pg8::cvt_pk_bf16(acc[0], acc[1]); w.y = pg8::cvt_pk_bf16(acc[2], acc[3]);
    *(LAS u32x2_t*)(lds + off + (n0 + (lane & 15)) * ld + (m0 + 4 * (lane >> 4)) * 2) = w;
}
__device__ __forceinline__ u32x4_t scale8(u32x4_t v, float s) {
    u32x4_t o; o.x = pg8::cvt_pk_bf16(bflo(v.x) * s, bfhi(v.x) * s); o.y = pg8::cvt_pk_bf16(bflo(v.y) * s, bfhi(v.y) * s);
    o.z = pg8::cvt_pk_bf16(bflo(v.z) * s, bfhi(v.z) * s); o.w = pg8::cvt_pk_bf16(bflo(v.w) * s, bfhi(v.w) * s); return o;
}

template <int LOFF, int TOFF, int SCOFF>
__device__ __forceinline__ void tri_inv64(LAS unsigned char* lds, int tid) {
    const int wave = __builtin_amdgcn_readfirstlane(tid >> 6); int lane = tid & 63, q4 = lane >> 4, l16 = lane & 15;
    if (wave == 0) {
        float x[16];
#pragma unroll
        for (int i = 0; i < 16; ++i) { float sacc = (i == l16) ? 1.f : 0.f;
#pragma unroll
            for (int j = 0; j < i; ++j) sacc -= bf2f(*(LAS const bf16_t*)(lds + LOFF + (16 * q4 + i) * 144 + (16 * q4 + j) * 2)) * x[j];
            x[i] = sacc; asm volatile("" ::: "memory"); }
#pragma unroll
        for (int i = 0; i < 16; ++i) *(LAS bf16_t*)(lds + TOFF + (16 * q4 + i) * 144 + (16 * q4 + l16) * 2) = f2bf(x[i]);
    }
    __syncthreads(); asm volatile("" : "+v"(tid)); lane = tid & 63;
    if (wave < 2) {
        const int I = 2 * wave + 1, J = 2 * wave; const f32x4 z = {0.f, 0.f, 0.f, 0.f};
        const f32x4 m1 = MMA16(lfrag16(lds, LOFF, 144, 16 * I, 16 * J, lane), lfragT(lds, TOFF, 144, 16 * J, 16 * J, 16, lane), z);
        st_rm(lds, SCOFF + wave * 1280, 80, 0, 0, m1, lane);
        asm volatile("s_waitcnt lgkmcnt(0)" ::: "memory");
        const f32x4 t1 = MMA16(lfrag16(lds, TOFF, 144, 16 * I, 16 * I, lane), lfragT(lds, SCOFF + wave * 1280, 80, 0, 0, 16, lane), z);
        st_rm(lds, TOFF, 144, 16 * I, 16 * J, -t1, lane);
    }
    __syncthreads(); asm volatile("" : "+v"(tid)); lane = tid & 63;
    {
        const int mt2 = (wave >> 1) & 1, nt2 = wave & 1; const f32x4 z = {0.f, 0.f, 0.f, 0.f};
        if (wave < 4) { const f32x4 m2 = MMA16(lfrag(lds, LOFF, 144, 32 + 16 * mt2, 0, lane), lfragT(lds, TOFF, 144, 0, 16 * nt2, 32, lane), z); st_rm(lds, SCOFF, 80, 16 * mt2, 16 * nt2, m2, lane); }
        __syncthreads();
        if (wave < 4) { const f32x4 t2 = MMA16(lfrag(lds, TOFF, 144, 32 + 16 * mt2, 32, lane), lfragT(lds, SCOFF, 80, 0, 16 * nt2, 32, lane), z); st_rm(lds, TOFF, 144, 32 + 16 * mt2, 16 * nt2, -t2, lane); }
    }
    __syncthreads();
}

constexpr int GQ_ = 0, GK_ = 17408, GV_ = 34816, GL_ = 53248, GT_ = 62464, GSC_ = 71680, GVB_ = 74240, GKB_ = 92672, GST_ = 111104, GF_ = 145920;
constexpr int LD128 = 272, LD64 = 144, LDSC = 80;
__device__ __forceinline__ void gdn_chain(const bf16_t* __restrict__ gq, const bf16_t* __restrict__ gk, const bf16_t* __restrict__ gv, const float* __restrict__ gg, const float* __restrict__ gbeta, int chain, float* __restrict__ OBout, LAS unsigned char* lds, int tid) {
    const int wave = __builtin_amdgcn_readfirstlane(tid >> 6); int lane = tid & 63, q4 = lane >> 4, l16 = lane & 15;
#define GDN_RELANE() do { asm volatile("" : "+v"(tid)); lane = tid & 63; q4 = lane >> 4; l16 = lane & 15; } while (0)
    const int h = chain % B_H, b = (chain / B_H) % BATCH, dir = chain / (B_H * BATCH);
    LAS float* GF = (LAS float*)(lds + GF_);
    for (int i = tid; i < 34816 / 16; i += NTHR) *(LAS u32x4_t*)(lds + GST_ + 16 * i) = (u32x4_t){0u, 0u, 0u, 0u};
    f32x4 Sacc[8];
#pragma unroll
    for (int nt = 0; nt < 8; ++nt) Sacc[nt] = (f32x4){0.f, 0.f, 0.f, 0.f};
    u32x4_t pq[2], pk[2], pv[2]; float pg = 0.f, pb = 0.f;
#define GDN_LOADS(cc) do { _Pragma("unroll") for (int u = 0; u < 2; ++u) { const int piece = tid + 512 * u, i = piece >> 4, c16 = piece & 15; \
        const size_t ro = (size_t)scan_row(dir, b, 64 * (cc) + i) * B_W + h * 128 + c16 * 8; \
        pq[u] = *(const u32x4_t*)(gq + ro); pk[u] = *(const u32x4_t*)(gk + ro); pv[u] = *(const u32x4_t*)(gv + ro); } \
        if (tid < 64) { const size_t ro = (size_t)scan_row(dir, b, 64 * (cc) + tid) * 8 + dir * 4 + h; pg = gg[ro]; pb = gbeta[ro]; } } while (0)
    constexpr int NCH = SLEN / 64;
#pragma unroll 1
    for (int c = 0; c < NCH; ++c) {
        GDN_RELANE();
        GDN_LOADS(c);
#pragma unroll
        for (int u = 0; u < 2; ++u) { const int piece = tid + 512 * u, i = piece >> 4, c16 = piece & 15;
            *(LAS u32x4_t*)(lds + GQ_ + i * LD128 + c16 * 16) = pq[u]; *(LAS u32x4_t*)(lds + GK_ + i * LD128 + c16 * 16) = pk[u]; *(LAS u32x4_t*)(lds + GV_ + i * LD128 + c16 * 16) = pv[u]; }
        for (int i2 = tid; i2 < 9216 / 16; i2 += NTHR) *(LAS u32x4_t*)(lds + GT_ + 16 * i2) = (u32x4_t){0u, 0u, 0u, 0u};
        if (wave == 0) {
            float x = pg;
#pragma unroll
            for (int o = 1; o < 64; o <<= 1) { const float y = __shfl_up(x, o); if (lane >= o) x += y; }
            const float gl = __shfl(x, 63);
            GF[lane] = x; GF[64 + lane] = pb; GF[128 + lane] = __expf(x); GF[192 + lane] = __expf(gl - x); if (lane == 0) GF[256] = __expf(gl);
        }
        __syncthreads(); __builtin_amdgcn_sched_barrier(0); GDN_RELANE();
        const int mt = wave >> 1;
        f32x4 qk[2];
        {
            f32x4 kk[2]; kk[0] = kk[1] = qk[0] = qk[1] = (f32x4){0.f, 0.f, 0.f, 0.f};
#pragma unroll
            for (int ks = 0; ks < 4; ++ks) { __builtin_amdgcn_sched_barrier(0); const bf16x8_t ak = lfrag(lds, GK_, LD128, 16 * mt, 32 * ks, lane), aq = lfrag(lds, GQ_, LD128, 16 * mt, 32 * ks, lane);
#pragma unroll
                for (int t = 0; t < 2; ++t) { const bf16x8_t bk = lfrag(lds, GK_, LD128, 16 * (2 * (wave & 1) + t), 32 * ks, lane); kk[t] = MMA16(ak, bk, kk[t]); qk[t] = MMA16(aq, bk, qk[t]); } }
#pragma unroll
            for (int t = 0; t < 2; ++t) { const int j = 16 * (2 * (wave & 1) + t) + l16; const float gcj = GF[j];
#pragma unroll
                for (int r = 0; r < 4; ++r) { const int i = 16 * mt + 4 * q4 + r; const float dec = i >= j ? __expf(GF[i] - gcj) : 0.f;
                    const float lv = i > j ? GF[64 + i] * kk[t][r] * dec : 0.f; *(LAS bf16_t*)(lds + GL_ + i * LD64 + j * 2) = f2bf(lv); qk[t][r] *= dec; } }
        }
        __syncthreads(); __builtin_amdgcn_sched_barrier(0); GDN_RELANE();
        tri_inv64<GL_, GT_, GSC_>(lds, tid); GDN_RELANE();
#pragma unroll
        for (int rep = 0; rep < 2; ++rep) { const int task = tid + 512 * rep, cidx = task & 127, jg = task >> 7; float vv[8], kv[8];
#pragma unroll
            for (int jj = 0; jj < 8; ++jj) { const int j = 8 * jg + jj; const float bj = GF[64 + j];
                vv[jj] = bf2f(*(LAS const bf16_t*)(lds + GV_ + j * LD128 + cidx * 2)) * bj; kv[jj] = bf2f(*(LAS const bf16_t*)(lds + GK_ + j * LD128 + cidx * 2)) * bj * GF[128 + j]; }
            u32x4_t wv, wk; wv.x = pg8::cvt_pk_bf16(vv[0], vv[1]); wv.y = pg8::cvt_pk_bf16(vv[2], vv[3]); wv.z = pg8::cvt_pk_bf16(vv[4], vv[5]); wv.w = pg8::cvt_pk_bf16(vv[6], vv[7]);
            wk.x = pg8::cvt_pk_bf16(kv[0], kv[1]); wk.y = pg8::cvt_pk_bf16(kv[2], kv[3]); wk.z = pg8::cvt_pk_bf16(kv[4], kv[5]); wk.w = pg8::cvt_pk_bf16(kv[6], kv[7]);
            *(LAS u32x4_t*)(lds + GVB_ + cidx * LD64 + jg * 16) = wv; *(LAS u32x4_t*)(lds + GKB_ + cidx * LD64 + jg * 16) = wk; }
#pragma unroll
        for (int t = 0; t < 2; ++t) st_rm(lds, GL_, LD64, 16 * mt, 16 * (2 * (wave & 1) + t), qk[t], lane);
#pragma unroll
        for (int u = 0; u < 2; ++u) { const int piece = tid + 512 * u, i = piece >> 4, c16 = piece & 15; LAS u32x4_t* qp = (LAS u32x4_t*)(lds + GQ_ + i * LD128 + c16 * 16); *qp = scale8(*qp, GF[128 + i]); }
        __syncthreads(); __builtin_amdgcn_sched_barrier(0); GDN_RELANE();
        f32x4 accu[4], o[4];
#pragma unroll
        for (int m = 0; m < 4; ++m) accu[m] = o[m] = (f32x4){0.f, 0.f, 0.f, 0.f};
#pragma unroll
        for (int ks = 0; ks < 2; ++ks) { __builtin_amdgcn_sched_barrier(0); const bf16x8_t bb = lfrag(lds, GVB_, LD64, 16 * wave, 32 * ks, lane);
#pragma unroll
            for (int m = 0; m < 4; ++m) accu[m] = MMA16(lfrag(lds, GT_, LD64, 16 * m, 32 * ks, lane), bb, accu[m]); }
        {
            f32x4 accw[4];
#pragma unroll
            for (int m = 0; m < 4; ++m) accw[m] = (f32x4){0.f, 0.f, 0.f, 0.f};
#pragma unroll
            for (int ks = 0; ks < 2; ++ks) { __builtin_amdgcn_sched_barrier(0); const bf16x8_t bb = lfrag(lds, GKB_, LD64, 16 * wave, 32 * ks, lane);
#pragma unroll
                for (int m = 0; m < 4; ++m) accw[m] = MMA16(lfrag(lds, GT_, LD64, 16 * m, 32 * ks, lane), bb, accw[m]); }
            __syncthreads();
#pragma unroll
            for (int m = 0; m < 4; ++m) st_rm(lds, GVB_, LD128, 16 * m, 16 * wave, -accw[m], lane);
        }
#pragma unroll
        for (int rep = 0; rep < 2; ++rep) { const int task = tid + 512 * rep, cidx = task & 127, jg = task >> 7; float kv[8];
#pragma unroll
            for (int jj = 0; jj < 8; ++jj) { const int j = 8 * jg + jj; kv[jj] = bf2f(*(LAS const bf16_t*)(lds + GK_ + j * LD128 + cidx * 2)) * GF[192 + j]; }
            u32x4_t wk; wk.x = pg8::cvt_pk_bf16(kv[0], kv[1]); wk.y = pg8::cvt_pk_bf16(kv[2], kv[3]); wk.z = pg8::cvt_pk_bf16(kv[4], kv[5]); wk.w = pg8::cvt_pk_bf16(kv[6], kv[7]);
            *(LAS u32x4_t*)(lds + GKB_ + cidx * LD64 + jg * 16) = wk; }
        __syncthreads(); __builtin_amdgcn_sched_barrier(0); GDN_RELANE();
#pragma unroll
        for (int ks = 0; ks < 4; ++ks) { __builtin_amdgcn_sched_barrier(0); const bf16x8_t bb = lfrag(lds, GST_, LD128, 16 * wave, 32 * ks, lane);
#pragma unroll
            for (int m = 0; m < 4; ++m) { accu[m] = MMA16(lfrag(lds, GVB_, LD128, 16 * m, 32 * ks, lane), bb, accu[m]); o[m] = MMA16(lfrag(lds, GQ_, LD128, 16 * m, 32 * ks, lane), bb, o[m]); } }
#pragma unroll
        for (int m = 0; m < 4; ++m) st_tr(lds, GV_, LD64, 16 * m, 16 * wave, accu[m], lane);
        __syncthreads(); __builtin_amdgcn_sched_barrier(0); GDN_RELANE();
        const int row0 = scan_row(dir, b, 64 * c), sgn = dir ? -1 : 1;
#pragma unroll
        for (int ks = 0; ks < 2; ++ks) { __builtin_amdgcn_sched_barrier(0); const bf16x8_t bb = lfrag(lds, GV_, LD64, 16 * wave, 32 * ks, lane);
#pragma unroll
            for (int m = 0; m < 4; ++m) o[m] = MMA16(lfrag(lds, GL_, LD64, 16 * m, 32 * ks, lane), bb, o[m]); }
#pragma unroll
        for (int m = 0; m < 4; ++m)
#pragma unroll
            for (int r = 0; r < 4; ++r) { const int i = 16 * m + 4 * q4 + r; const int row = row0 + sgn * i; OBout[(unsigned)((dir * NTOK + row) * B_W + h * 128 + 16 * wave + l16)] = o[m][r]; }
        {
            const float gl = GF[256];
#pragma unroll
            for (int nt = 0; nt < 8; ++nt) Sacc[nt] = Sacc[nt] * gl;
#pragma unroll
            for (int ks = 0; ks < 2; ++ks) { __builtin_amdgcn_sched_barrier(0); const bf16x8_t aa = lfrag(lds, GKB_, LD64, 16 * wave, 32 * ks, lane);
#pragma unroll
                for (int nt = 0; nt < 8; ++nt) Sacc[nt] = MMA16(aa, lfrag(lds, GV_, LD64, 16 * nt, 32 * ks, lane), Sacc[nt]); }
#pragma unroll
            for (int nt = 0; nt < 8; ++nt) st_tr(lds, GST_, LD128, 16 * wave, 16 * nt, Sacc[nt], lane);
        }
        __syncthreads(); __builtin_amdgcn_sched_barrier(0); GDN_RELANE();
    }
#undef GDN_LOADS
#undef GDN_RELANE
}

constexpr int SP_ = 0, SQ_ = 9216, SK_ = 18432, SR_ = 27648, SPT_ = 36864, SQT_ = 46080, SL_ = 55296, ST_ = 64512, SSC_ = 73728, SAT_ = 76288, SNB_ = 85504, SPH_ = 94720, SAH_ = 103936, SCS_ = 113152, SVT_ = 129792, SDC_ = 139008, SSEG_ = 139264;
constexpr int RW_NCH = SLEN / 64, RW_UNITS = 2 * BATCH * A_H * RW_NCH;
__device__ __forceinline__ void rwkv_stage1(const P& p, int unit, LAS unsigned char* lds, int tid) {
    const int wave = __builtin_amdgcn_readfirstlane(tid >> 6); int lane = tid & 63, q4 = lane >> 4, l16 = lane & 15;
#define RW_RELANE() do { asm volatile("" : "+v"(tid)); lane = tid & 63; q4 = lane >> 4; l16 = lane & 15; } while (0)
    const int c = unit % RW_NCH, chain = unit / RW_NCH; const int h = chain % A_H, b = (chain / A_H) % BATCH, dir = chain / (A_H * BATCH);
    LAS float* CS = (LAS float*)(lds + SCS_); LAS float* DCv = (LAS float*)(lds + SDC_); LAS float* SEG = (LAS float*)(lds + SSEG_);
    const int row0 = scan_row(dir, b, 64 * c), sgn = dir ? -1 : 1;
    {
        const int k = tid & 63, sg = tid >> 6; float x = 0.f, loc[8];
#pragma unroll
        for (int tt = 0; tt < 8; ++tt) { const int t = 8 * sg + tt; x += p.RW_D()[((size_t)dir * NTOK + (row0 + sgn * t)) * A_W + h * 64 + k]; loc[tt] = x; }
        SEG[sg * 64 + k] = x;
        for (int i2 = tid; i2 < 9216 / 16; i2 += NTHR) *(LAS u32x4_t*)(lds + ST_ + 16 * i2) = (u32x4_t){0u, 0u, 0u, 0u};
        __syncthreads();
        float pre = 0.f;
        for (int s2 = 0; s2 < sg; ++s2) pre += SEG[s2 * 64 + k];
#pragma unroll
        for (int tt = 0; tt < 8; ++tt) CS[(8 * sg + tt) * 65 + k] = loc[tt] + pre;
        if (sg == 7) DCv[k] = __expf(loc[7] + pre);
    }
    __syncthreads(); RW_RELANE();
    {
        const int t = tid >> 3, kg = tid & 7; const int row = row0 + sgn * t;
        const size_t o1 = (size_t)row * A_W + h * 64 + 8 * kg, o2 = ((size_t)dir * NTOK + row) * A_W + h * 64 + 8 * kg;
        float kk[8], ka[8], kd[8], rr[8], vv[8];
#pragma unroll
        for (int u = 0; u < 2; ++u) { const f32x4_t a = *(const f32x4_t*)(p.RW_KK() + o1 + 4 * u), b2 = *(const f32x4_t*)(p.RW_KKA() + o2 + 4 * u), c2 = *(const f32x4_t*)(p.RW_KD() + o2 + 4 * u), d2 = *(const f32x4_t*)(p.RW_R() + o1 + 4 * u), e2 = *(const f32x4_t*)(p.RW_V() + o1 + 4 * u);
#pragma unroll
            for (int j = 0; j < 4; ++j) { kk[4 * u + j] = a[j]; ka[4 * u + j] = b2[j]; kd[4 * u + j] = c2[j]; rr[4 * u + j] = d2[j]; vv[4 * u + j] = e2[j]; } }
        float pp[8], qq[8], kt[8], rh[8];
#pragma unroll
        for (int j = 0; j < 8; ++j) { const int k = 8 * kg + j; const float cs = CS[t * 65 + k], csm = t > 0 ? CS[(t - 1) * 65 + k] : 0.f; const float e = __expf(cs), ei = 1.0f / e;
            pp[j] = __expf(csm) * kk[j]; qq[j] = ka[j] * ei; kt[j] = kd[j] * ei; rh[j] = rr[j] * e; }
        u32x4_t w;
        w.x = pg8::cvt_pk_bf16(pp[0], pp[1]); w.y = pg8::cvt_pk_bf16(pp[2], pp[3]); w.z = pg8::cvt_pk_bf16(pp[4], pp[5]); w.w = pg8::cvt_pk_bf16(pp[6], pp[7]); *(LAS u32x4_t*)(lds + SP_ + t * 144 + kg * 16) = w;
        w.x = pg8::cvt_pk_bf16(qq[0], qq[1]); w.y = pg8::cvt_pk_bf16(qq[2], qq[3]); w.z = pg8::cvt_pk_bf16(qq[4], qq[5]); w.w = pg8::cvt_pk_bf16(qq[6], qq[7]); *(LAS u32x4_t*)(lds + SQ_ + t * 144 + kg * 16) = w;
        w.x = pg8::cvt_pk_bf16(kt[0], kt[1]); w.y = pg8::cvt_pk_bf16(kt[2], kt[3]); w.z = pg8::cvt_pk_bf16(kt[4], kt[5]); w.w = pg8::cvt_pk_bf16(kt[6], kt[7]); *(LAS u32x4_t*)(lds + SK_ + t * 144 + kg * 16) = w;
        w.x = pg8::cvt_pk_bf16(rh[0], rh[1]); w.y = pg8::cvt_pk_bf16(rh[2], rh[3]); w.z = pg8::cvt_pk_bf16(rh[4], rh[5]); w.w = pg8::cvt_pk_bf16(rh[6], rh[7]); *(LAS u32x4_t*)(lds + SR_ + t * 144 + kg * 16) = w;
#pragma unroll
        for (int j = 0; j < 8; ++j) { const int k = 8 * kg + j; *(LAS bf16_t*)(lds + SPT_ + k * 144 + t * 2) = f2bf(pp[j]); *(LAS bf16_t*)(lds + SQT_ + k * 144 + t * 2) = f2bf(qq[j]); *(LAS bf16_t*)(lds + SVT_ + k * 144 + t * 2) = f2bf(vv[j]); }
    }
    __syncthreads(); RW_RELANE();
    const int mt = wave >> 1, ntb = 2 * (wave & 1);
    f32x4 krm[2];
    {
        f32x4 qp[2], kp[2], qr[2];
#pragma unroll
        for (int t2 = 0; t2 < 2; ++t2) qp[t2] = kp[t2] = qr[t2] = krm[t2] = (f32x4){0.f, 0.f, 0.f, 0.f};
#pragma unroll
        for (int ks = 0; ks < 2; ++ks) { const bf16x8_t aP = lfrag(lds, SP_, 144, 16 * mt, 32 * ks, lane), aR = lfrag(lds, SR_, 144, 16 * mt, 32 * ks, lane);
#pragma unroll
            for (int t2 = 0; t2 < 2; ++t2) { const bf16x8_t bQ = lfrag(lds, SQ_, 144, 16 * (ntb + t2), 32 * ks, lane), bK = lfrag(lds, SK_, 144, 16 * (ntb + t2), 32 * ks, lane);
                qp[t2] = MMA16(aP, bQ, qp[t2]); kp[t2] = MMA16(aP, bK, kp[t2]); qr[t2] = MMA16(aR, bQ, qr[t2]); krm[t2] = MMA16(aR, bK, krm[t2]); } }
#pragma unroll
        for (int t2 = 0; t2 < 2; ++t2) { const int i = 16 * (ntb + t2) + l16;
#pragma unroll
            for (int r = 0; r < 4; ++r) { const int t = 16 * mt + 4 * q4 + r; const bool st = t > i, inc = t >= i;
                qp[t2][r] = st ? qp[t2][r] : 0.f; kp[t2][r] = st ? kp[t2][r] : 0.f; qr[t2][r] = inc ? -qr[t2][r] : 0.f; krm[t2][r] = inc ? krm[t2][r] : 0.f; }
            st_rm(lds, SL_, 144, 16 * mt, 16 * (ntb + t2), qp[t2], lane); st_tr(lds, SAT_, 144, 16 * mt, 16 * (ntb + t2), kp[t2], lane); st_rm(lds, SNB_, 144, 16 * mt, 16 * (ntb + t2), qr[t2], lane); }
    }
    __syncthreads(); RW_RELANE();
    tri_inv64<SL_, ST_, SSC_>(lds, tid);
    RW_RELANE();
    {
        f32x4 ph[2], ah[2];
#pragma unroll
        for (int t2 = 0; t2 < 2; ++t2) ph[t2] = ah[t2] = (f32x4){0.f, 0.f, 0.f, 0.f};
#pragma unroll
        for (int ks = 0; ks < 2; ++ks) { const bf16x8_t aT = lfrag(lds, ST_, 144, 16 * mt, 32 * ks, lane);
#pragma unroll
            for (int t2 = 0; t2 < 2; ++t2) { ph[t2] = MMA16(aT, lfrag(lds, SPT_, 144, 16 * (ntb + t2), 32 * ks, lane), ph[t2]); ah[t2] = MMA16(aT, lfrag(lds, SAT_, 144, 16 * (ntb + t2), 32 * ks, lane), ah[t2]); } }
#pragma unroll
        for (int t2 = 0; t2 < 2; ++t2) { st_tr(lds, SPH_, 144, 16 * mt, 16 * (ntb + t2), ph[t2], lane); st_tr(lds, SAH_, 144, 16 * mt, 16 * (ntb + t2), ah[t2], lane); }
    }
    __syncthreads(); RW_RELANE();
    {
        f32x4 rh[2], zz[2], kh[2];
#pragma unroll
        for (int t2 = 0; t2 < 2; ++t2) { zz[t2] = kh[t2] = (f32x4){0.f, 0.f, 0.f, 0.f};
#pragma unroll
            for (int r = 0; r < 4; ++r) rh[t2][r] = bf2f(*(LAS const bf16_t*)(lds + SR_ + (16 * mt + 4 * q4 + r) * 144 + (16 * (ntb + t2) + l16) * 2)); }
#pragma unroll
        for (int ks = 0; ks < 2; ++ks) { const bf16x8_t aB = lfrag(lds, SNB_, 144, 16 * mt, 32 * ks, lane), aPh = lfrag(lds, SPH_, 144, 16 * mt, 32 * ks, lane), aAh = lfrag(lds, SAH_, 144, 16 * mt, 32 * ks, lane);
#pragma unroll
            for (int t2 = 0; t2 < 2; ++t2) { const bf16x8_t bPh = lfrag(lds, SPH_, 144, 16 * (ntb + t2), 32 * ks, lane), bAh = lfrag(lds, SAH_, 144, 16 * (ntb + t2), 32 * ks, lane), bQt = lfrag(lds, SQT_, 144, 16 * (ntb + t2), 32 * ks, lane);
                rh[t2] = MMA16(aB, bPh, rh[t2]); krm[t2] = MMA16(aB, bAh, krm[t2]); zz[t2] = MMA16(aPh, bQt, zz[t2]); kh[t2] = MMA16(aAh, bQt, kh[t2]); } }
        __syncthreads();
#pragma unroll
        for (int t2 = 0; t2 < 2; ++t2) { const int n = 16 * (ntb + t2) + l16; const float dc = DCv[n];
#pragma unroll
            for (int r = 0; r < 4; ++r) { const int m = 16 * mt + 4 * q4 + r; zz[t2][r] = ((m == n ? 1.f : 0.f) - zz[t2][r]) * dc;
                kh[t2][r] = (bf2f(*(LAS const bf16_t*)(lds + SK_ + m * 144 + n * 2)) - kh[t2][r]) * dc; }
            st_rm(lds, SR_, 144, 16 * mt, 16 * (ntb + t2), rh[t2], lane); st_rm(lds, SL_, 144, 16 * mt, 16 * (ntb + t2), krm[t2], lane);
            st_tr(lds, SP_, 144, 16 * mt, 16 * (ntb + t2), zz[t2], lane); st_tr(lds, SQ_, 144, 16 * mt, 16 * (ntb + t2), kh[t2], lane); }
    }
    __syncthreads(); RW_RELANE();
    {
        const int row = tid >> 3, c16 = tid & 7; bf16_t* ob = p.RWC() + (size_t)unit * 5 * 4096 + row * 64 + c16 * 8;
        *(u32x4_t*)(ob) = *(LAS const u32x4_t*)(lds + SR_ + row * 144 + c16 * 16);
        *(u32x4_t*)(ob + 4096) = *(LAS const u32x4_t*)(lds + SL_ + row * 144 + c16 * 16);
        *(u32x4_t*)(ob + 2 * 4096) = *(LAS const u32x4_t*)(lds + SP_ + row * 144 + c16 * 16);
        *(u32x4_t*)(ob + 3 * 4096) = *(LAS const u32x4_t*)(lds + SQ_ + row * 144 + c16 * 16);
        *(u32x4_t*)(ob + 4 * 4096) = *(LAS const u32x4_t*)(lds + SVT_ + row * 144 + c16 * 16);
    }
    __syncthreads();
#undef RW_RELANE
}
constexpr int S2_M = 0  , S2_S = 46080;
__device__ __forceinline__ void rwkv_stage2(const P& p, int chain, float* YAout, LAS unsigned char* lds, int tid) {
    const int wave = __builtin_amdgcn_readfirstlane(tid >> 6); int lane = tid & 63, q4 = lane >> 4, l16 = lane & 15;
    const int h = chain % A_H, b = (chain / A_H) % BATCH, dir = chain / (A_H * BATCH);
    const int mt = wave >> 1, ntb = 2 * (wave & 1);
    for (int i = tid; i < 9216 / 16; i += NTHR) *(LAS u32x4_t*)(lds + S2_S + 16 * i) = (u32x4_t){0u, 0u, 0u, 0u};
    u32x4_t pre[5];
#define S2_LOADS(cc) do { const bf16_t* ib = p.RWC() + ((size_t)chain * RW_NCH + (cc)) * 5 * 4096 + (tid >> 3) * 64 + (tid & 7) * 8; \
        _Pragma("unroll") for (int u = 0; u < 5; ++u) pre[u] = *(const u32x4_t*)(ib + u * 4096); } while (0)
    S2_LOADS(0);
#pragma unroll 1
    for (int c = 0; c < RW_NCH; ++c) {
        asm volatile("" : "+v"(tid)); lane = tid & 63; q4 = lane >> 4; l16 = lane & 15;
#pragma unroll
        for (int u = 0; u < 5; ++u) *(LAS u32x4_t*)(lds + S2_M + u * 9216 + (tid >> 3) * 144 + (tid & 7) * 16) = pre[u];
        if (c + 1 < RW_NCH) S2_LOADS(c + 1);
        __syncthreads();
        f32x4 y[2], sn[2];
#pragma unroll
        for (int t2 = 0; t2 < 2; ++t2) y[t2] = sn[t2] = (f32x4){0.f, 0.f, 0.f, 0.f};
#pragma unroll
        for (int ks = 0; ks < 2; ++ks) {
            const bf16x8_t aR = lfrag(lds, S2_M, 144, 16 * mt, 32 * ks, lane), aM = lfrag(lds, S2_M + 9216, 144, 16 * mt, 32 * ks, lane);
            const bf16x8_t aS = lfrag(lds, S2_S, 144, 16 * mt, 32 * ks, lane), aV = lfrag(lds, S2_M + 4 * 9216, 144, 16 * mt, 32 * ks, lane);
#pragma unroll
            for (int t2 = 0; t2 < 2; ++t2) { const int n0 = 16 * (ntb + t2);
                y[t2] = MMA16(aR, lfrag(lds, S2_S, 144, n0, 32 * ks, lane), y[t2]); y[t2] = MMA16(aM, lfrag(lds, S2_M + 4 * 9216, 144, n0, 32 * ks, lane), y[t2]);
                sn[t2] = MMA16(aS, lfrag(lds, S2_M + 2 * 9216, 144, n0, 32 * ks, lane), sn[t2]); sn[t2] = MMA16(aV, lfrag(lds, S2_M + 3 * 9216, 144, n0, 32 * ks, lane), sn[t2]); } }
        const int row0 = scan_row(dir, b, 64 * c), sgn = dir ? -1 : 1;
#pragma unroll
        for (int t2 = 0; t2 < 2; ++t2)
#pragma unroll
            for (int r = 0; r < 4; ++r) { const int t = 16 * mt + 4 * q4 + r; YAout[(unsigned)((dir * NTOK + row0 + sgn * t) * A_W + h * 64 + 16 * (ntb + t2) + l16)] = y[t2][r]; }
        __syncthreads();
#pragma unroll
        for (int t2 = 0; t2 < 2; ++t2) st_rm(lds, S2_S, 144, 16 * mt, 16 * (ntb + t2), sn[t2], lane);
        __syncthreads();
    }
#undef S2_LOADS
}

constexpr int AT_K = 0  , AT_V = 18432  , ATT_NLAT = BATCH * 4 * (SEQ / 256), ATT_NCTX = BATCH * 4 * (CTXL / 256);
__device__ __forceinline__ void attn_unit(const P& p, int unit, LAS unsigned char* lds, int tid) {
    const int wave = __builtin_amdgcn_readfirstlane(tid >> 6); int lane = tid & 63, q4 = lane >> 4, l16 = lane & 15;
    int b, hq, qrow0, nt; bool lat;
    if (unit < ATT_NLAT) { lat = true; b = unit / (4 * (SEQ / 256)); hq = (unit / (SEQ / 256)) % 4; qrow0 = b * SEQ + 256 * (unit % (SEQ / 256)); nt = SLEN / 64; }
    else { const int u2 = unit - ATT_NLAT; lat = false; b = u2 / (4 * (CTXL / 256)); hq = (u2 / (CTXL / 256)) % 4; qrow0 = NLAT + b * CTXL + 256 * (u2 % (CTXL / 256)); nt = CTXL / 64; }
    const int kvh = hq >> 1; qrow0 += 32 * wave;
    bf16x8_t qf[2][2];
#pragma unroll
    for (int qt = 0; qt < 2; ++qt)
#pragma unroll
        for (int ks = 0; ks < 2; ++ks) qf[qt][ks] = *(const bf16x8_t*)(p.CQ() + (size_t)(qrow0 + 16 * qt + l16) * 256 + hq * 64 + 32 * ks + 8 * q4);
    f32x4 o[2][4]; float mrun[2], lrun[2];
#pragma unroll
    for (int qt = 0; qt < 2; ++qt) { mrun[qt] = -1e30f; lrun[qt] = 0.f;
#pragma unroll
        for (int dt = 0; dt < 4; ++dt) o[qt][dt] = (f32x4){0.f, 0.f, 0.f, 0.f}; }
    u32x4_t pk, pv;
#define AT_ROWBASE(t) ((lat && (t) < SEQ / 64) ? b * SEQ + 64 * (t) : NLAT + b * CTXL + 64 * ((t) - (lat ? SEQ / 64 : 0)))
#define AT_LOAD(t) do { const size_t ro = (size_t)(AT_ROWBASE(t) + (tid >> 3)) * 128 + kvh * 64 + (tid & 7) * 8; pk = *(const u32x4_t*)(p.CK() + ro); pv = *(const u32x4_t*)(p.CV() + ro); } while (0)
#define AT_STORE(buf) do { const int key = tid >> 3, c16 = tid & 7; *(LAS u32x4_t*)(lds + AT_K + (buf) * 9216 + key * 144 + c16 * 16) = pk; \
        LAS unsigned char* vb = lds + AT_V + (buf) * 9216 + (c16 * 8) * 144 + key * 2; \
        *(LAS bf16_t*)(vb) = (bf16_t)(pv.x & 0xffffu); *(LAS bf16_t*)(vb + 144) = (bf16_t)(pv.x >> 16); *(LAS bf16_t*)(vb + 288) = (bf16_t)(pv.y & 0xffffu); *(LAS bf16_t*)(vb + 432) = (bf16_t)(pv.y >> 16); \
        *(LAS bf16_t*)(vb + 576) = (bf16_t)(pv.z & 0xffffu); *(LAS bf16_t*)(vb + 720) = (bf16_t)(pv.z >> 16); *(LAS bf16_t*)(vb + 864) = (bf16_t)(pv.w & 0xffffu); *(LAS bf16_t*)(vb + 1008) = (bf16_t)(pv.w >> 16); } while (0)
    AT_LOAD(0); AT_STORE(0);
    __syncthreads();
#pragma unroll 1
    for (int t = 0; t < nt; ++t) {
        asm volatile("" : "+v"(tid)); lane = tid & 63; q4 = lane >> 4; l16 = lane & 15;
        const int buf = t & 1;
        if (t + 1 < nt) AT_LOAD(t + 1);
        f32x4 s[2][4];
#pragma unroll
        for (int qt = 0; qt < 2; ++qt)
#pragma unroll
            for (int kt = 0; kt < 4; ++kt) s[qt][kt] = (f32x4){0.f, 0.f, 0.f, 0.f};
#pragma unroll
        for (int ks = 0; ks < 2; ++ks)
#pragma unroll
            for (int kt = 0; kt < 4; ++kt) { const bf16x8_t ak = lfrag(lds, AT_K + buf * 9216, 144, 16 * kt, 32 * ks, lane);
                s[0][kt] = MMA16(ak, qf[0][ks], s[0][kt]); s[1][kt] = MMA16(ak, qf[1][ks], s[1][kt]); }
        bf16x8_t pb[2][2];
#pragma unroll
        for (int qt = 0; qt < 2; ++qt) {
            float mx = s[qt][0][0];
#pragma unroll
            for (int kt = 0; kt < 4; ++kt)
#pragma unroll
                for (int r = 0; r < 4; ++r) mx = fmaxf(mx, s[qt][kt][r]);
            mx = fmaxf(mx, __shfl_xor(mx, 16)); mx = fmaxf(mx, __shfl_xor(mx, 32));
            const float mn = fmaxf(mrun[qt], mx), alpha = exp2f(mrun[qt] - mn); mrun[qt] = mn;
            float ps = 0.f;
#pragma unroll
            for (int kt = 0; kt < 4; ++kt)
#pragma unroll
                for (int r = 0; r < 4; ++r) { const float e = exp2f(s[qt][kt][r] - mn); s[qt][kt][r] = e; ps += e; }
            lrun[qt] = lrun[qt] * alpha + ps;
#pragma unroll
            for (int dt = 0; dt < 4; ++dt) o[qt][dt] = o[qt][dt] * alpha;
#pragma unroll
            for (int k2 = 0; k2 < 2; ++k2) { u32x4_t w; w.x = pg8::cvt_pk_bf16(s[qt][2 * k2][0], s[qt][2 * k2][1]); w.y = pg8::cvt_pk_bf16(s[qt][2 * k2][2], s[qt][2 * k2][3]);
                w.z = pg8::cvt_pk_bf16(s[qt][2 * k2 + 1][0], s[qt][2 * k2 + 1][1]); w.w = pg8::cvt_pk_bf16(s[qt][2 * k2 + 1][2], s[qt][2 * k2 + 1][3]); pb[qt][k2] = __builtin_bit_cast(bf16x8_t, w); }
        }
#pragma unroll
        for (int k2 = 0; k2 < 2; ++k2)
#pragma unroll
            for (int dt = 0; dt < 4; ++dt) { LAS const unsigned char* vp = lds + AT_V + buf * 9216 + (16 * dt + l16) * 144 + (32 * k2 + 4 * q4) * 2;
                const u32x2_t lo = *(LAS const u32x2_t*)vp, hi = *(LAS const u32x2_t*)(vp + 32); u32x4_t w; w.x = lo.x; w.y = lo.y; w.z = hi.x; w.w = hi.y; const bf16x8_t av = __builtin_bit_cast(bf16x8_t, w);
                o[0][dt] = MMA16(av, pb[0][k2], o[0][dt]); o[1][dt] = MMA16(av, pb[1][k2], o[1][dt]); }
        if (t + 1 < nt) AT_STORE(buf ^ 1);
        __syncthreads();
    }
#pragma unroll
    for (int qt = 0; qt < 2; ++qt) { float l = lrun[qt]; l += __shfl_xor(l, 16); l += __shfl_xor(l, 32); const float inv = 1.0f / l;
        bf16_t* orow = p.MIX() + (size_t)(qrow0 + 16 * qt + l16) * D + 768 + hq * 64 + 4 * q4;
#pragma unroll
        for (int dt = 0; dt < 4; ++dt) { u32x2_t w; w.x = pg8::cvt_pk_bf16(o[qt][dt][0] * inv, o[qt][dt][1] * inv); w.y = pg8::cvt_pk_bf16(o[qt][dt][2] * inv, o[qt][dt][3] * inv); *(u32x2_t*)(orow + 16 * dt) = w; } }
#undef AT_ROWBASE
#undef AT_LOAD
#undef AT_STORE
}

constexpr int RING_BYTES = 131072, MISC_OFF = 147200, LDS_BYTES = 147456;
constexpr size_t MiB = 1u << 20;
constexpr int CW_BAR = 4096, CW_CNT = 8192;

__device__ __forceinline__ void transpose_item(const float* W, int K, int N, bf16_t* WT, LAS float* scr, int item, int lane) {
    const int nblk_k = K / 64; const int nb = item / nblk_k, kb = item % nblk_k, k0 = 64 * kb, n0 = 32 * nb;
    const int ncol = n0 + (lane & 31);
#pragma unroll 8
    for (int i = 0; i < 32; ++i) { const int kk = 2 * i + (lane >> 5); scr[kk * 33 + (lane & 31)] = ncol < N ? W[(size_t)(k0 + kk) * N + ncol] : 0.f; }
    asm volatile("s_waitcnt lgkmcnt(0)" ::: "memory");
    const int c = lane & 7;
#pragma unroll
    for (int j = 0; j < 4; ++j) { const int n = (lane >> 3) + 8 * j; const LAS float* s = scr + (8 * c) * 33 + n;
        pg8::u32x4 o; o.x = pg8::cvt_pk_bf16(s[0 * 33], s[1 * 33]); o.y = pg8::cvt_pk_bf16(s[2 * 33], s[3 * 33]); o.z = pg8::cvt_pk_bf16(s[4 * 33], s[5 * 33]); o.w = pg8::cvt_pk_bf16(s[6 * 33], s[7 * 33]);
        *(pg8::u32x4*)(WT + (size_t)(n0 + n) * K + k0 + 8 * c) = o; }
    asm volatile("s_waitcnt lgkmcnt(0)" ::: "memory");
}

struct Args { P p; int ph_lo, ph_hi; };

#define RUN_TASKS(ntasks, call) do { const long _n = (long)(ntasks); for (long task = gtid; task < _n; task += nthr) { call; } } while (0)

constexpr int NPH = 14;
__global__ void __launch_bounds__(NTHR, 2) fwd_kernel(Args args) {
    extern __shared__ __attribute__((aligned(16))) unsigned char lds[];
    const P& pk = args.p;
    LAS unsigned char* ldsp = (LAS unsigned char*)lds;
    volatile LAS unsigned* MISC = (volatile LAS unsigned*)(ldsp + MISC_OFF);
    const int G = gridDim.x;
#define PHASE_VARS P p = args.p; asm volatile("" : "+s"(p.ws)); int tid_ = threadIdx.x; asm volatile("" : "+v"(tid_)); const int lane = tid_ & 63, wave = __builtin_amdgcn_readfirstlane(tid_ >> 6); \
    const long gtid = ((long)wave * G + blockIdx.x) * 64 + lane, nthr = (long)G * NTHR; const int gw = wave * G + blockIdx.x, ngw = G * NWAVES; (void)gw; (void)ngw; (void)gtid; (void)nthr; (void)lane;
    if (threadIdx.x < 32) MISC[threadIdx.x] = 0u;
    __syncthreads();
    XcdBarrier bar = xcd_barrier_post(pk.ctl() + CW_BAR, MISC + 8);
    const int lo = args.ph_lo, hi = args.ph_hi;
#ifndef DBG_PH
#define DBG_PH -1
#endif
#define PHON(j) (DBG_PH < 0 || DBG_PH == (j))
#define IN(k) (lo <= (k) && (k) < hi)
#define SEAM(k) do { if (IN((k) + 1)) xcd_barrier(bar); } while (0)

    if (PHON(100) && IN(0)) { PHASE_VARS;
        RUN_TASKS((long)DEPTH * (BATCH + 1) * 6 * D, task_mod(p, task));
        RUN_TASKS(D, p.HB()[(size_t)ZROW * D + task] = 0);
        SEAM(0);
    }
    for (int l = 0; l < DEPTH; ++l) {
        const int pb = 1 + l * NPH;
        const bool need_ctx = l < DEPTH - 1;
        const int ntok_l = need_ctx ? NTOK : NLAT;
        if (PHON(0) && IN(pb + 0)) { PHASE_VARS;
            LAS float* scr = (LAS float*)(ldsp + wave * 16384);
            const int I_IN = (D / 64) * (INP / 32), I_OUT = (D / 64) * (D / 32), I_R = (D / 64) * (NEXP / 32 > 0 ? NEXP / 32 : 1), I_GU = (D / 64) * (2 * DEXP / 32), I_DN = (DEXP / 64) * (D / 32);
            const int total = I_IN + I_OUT + I_R + NEXP * (I_GU + I_DN);
            for (int it = gw; it < total; it += ngw) {
                int r = it;
                if (r < I_IN) { transpose_item(p.w_in + (size_t)l * D * INW, D, INW, p.WIN_T(), scr, r, lane); continue; } r -= I_IN;
                if (r < I_OUT) { transpose_item(p.w_out + (size_t)l * D * D, D, D, p.WOUT_T(), scr, r, lane); continue; } r -= I_OUT;
                if (r < I_R) { transpose_item(p.router_w + (size_t)l * D * NEXP, D, NEXP, p.WR_T(), scr, r, lane); continue; } r -= I_R;
                if (r < NEXP * I_GU) { const int e = r / I_GU; transpose_item(p.exp_w_gu + ((size_t)l * NEXP + e) * D * 2 * DEXP, D, 2 * DEXP, p.WGU_T() + (size_t)e * 2 * DEXP * D, scr, r % I_GU, lane); continue; } r -= NEXP * I_GU;
                { const int e = r / I_DN; transpose_item(p.exp_w_dn + ((size_t)l * NEXP + e) * DEXP * D, DEXP, D, p.WDN_T() + (size_t)e * D * DEXP, scr, r % I_DN, lane); }
            }
            if (l == 0) dev_norm1_l0(p, gw, ngw, lane);
            SEAM(pb + 0);
        }
        if (PHON(1) && IN(pb + 1)) { PHASE_VARS; (void)tid_; (void)wave;
            pg8::Gemm g{p.HB(), p.WIN_T(), D, 0}; pg8::StaticOrder S; S.init(NTOK, INP, G, (int)blockIdx.x);
            pg8::EpiBf16Bias E{p.U(), INP, nullptr, 0};
            pg8::gemm_phase(ldsp, g, S, E);
            SEAM(pb + 1);
        }
        if (PHON(2) && IN(pb + 2)) { PHASE_VARS;
            RUN_TASKS((long)NTOK * 192, task_prepA0(p, l, task));
            RUN_TASKS((long)NTOK * B_H * 4, task_prepB(p, l, task));
            RUN_TASKS((long)NTOK * 8, task_prepC(p, l, task));
            SEAM(pb + 2);
        }
        if (PHON(3) && IN(pb + 3)) { PHASE_VARS; RUN_TASKS((long)NTOK * A_H, task_prepA1(p, l, task)); SEAM(pb + 3); }
        if (PHON(4) && IN(pb + 4)) { PHASE_VARS;
            const int nchain = 2 * BATCH * B_H;
            if ((int)blockIdx.x >= G - nchain && G >= nchain) gdn_chain(p.GQ(), p.GK(), p.GV(), p.GG(), p.GBETA(), (int)blockIdx.x - (G - nchain),
#ifdef PROBE_GDN
                (float*)(p.ws + WS_TOTAL),
#else
                p.OB(),
#endif
                ldsp, tid_);
            else if (G < nchain) { for (int ch = blockIdx.x; ch < nchain; ch += G) gdn_chain(p.GQ(), p.GK(), p.GV(), p.GG(), p.GBETA(), ch, p.OB(), ldsp, tid_); }
#ifdef PROBE_GDN
            { const long nB = 2L * BATCH * B_H * 128; for (long task = gtid; task < nB; task += nthr) task_scanB(p, task); }
#endif
            {
                const int nfree = G > nchain ? G - nchain : 0; const int shares = 3 * nfree + (G - nfree);
                const int mys = (int)blockIdx.x < nfree ? 3 : 1, base = (int)blockIdx.x < nfree ? 3 * (int)blockIdx.x : 3 * nfree + ((int)blockIdx.x - nfree);
                for (int u0 = 0; u0 < RW_UNITS; u0 += shares) for (int q = 0; q < mys; ++q) { const int unit = u0 + base + q; if (unit < RW_UNITS) rwkv_stage1(p, unit, ldsp, tid_); }
            }
            SEAM(pb + 4);
        }
        if (PHON(5) && IN(pb + 5)) { PHASE_VARS;
            const long nA = 2L * BATCH * A_H * 64, nC = (long)BATCH * 4 * SLEN; (void)nA;
#ifdef PROBE_RWKV
            for (long task = gtid; task < nA; task += nthr) task_scanA(p, task);
            for (int ch = blockIdx.x; ch < 2 * BATCH * A_H; ch += G) rwkv_stage2(p, ch, (float*)(p.ws + WS_TOTAL), ldsp, tid_);
#else
            for (int ch = blockIdx.x; ch < 2 * BATCH * A_H; ch += G) rwkv_stage2(p, ch, p.YA(), ldsp, tid_);
#endif
            (void)nC;
            { const int nun = ATT_NLAT + (need_ctx ? ATT_NCTX : 0); for (int u = (G - 1 - (int)blockIdx.x); u < nun; u += G) attn_unit(p, u, ldsp, tid_); }
            SEAM(pb + 5);
        }
        if (PHON(6) && IN(pb + 6)) { PHASE_VARS;
#ifdef PROBE_GDN
            { float e2 = 0.f, r2 = 0.f; const float* cand = (const float*)(p.ws + WS_TOTAL); const float* ref = p.OB();
              for (long i = gtid; i < 2L * NTOK * B_W; i += nthr) { const float d = cand[i] - ref[i]; e2 += d * d; r2 += ref[i] * ref[i]; }
              e2 = wave_sum(e2); r2 = wave_sum(r2); if (lane == 0) { atomicAdd((float*)(p.ctl() + 12000), e2); atomicAdd((float*)(p.ctl() + 12001), r2); } }
#endif
#ifdef PROBE_RWKV
            { float e2 = 0.f, r2 = 0.f; const float* cand = (const float*)(p.ws + WS_TOTAL); const float* ref = p.YA();
              for (long i = gtid; i < 2L * NTOK * A_W; i += nthr) { const float d = cand[i] - ref[i]; e2 += d * d; r2 += ref[i] * ref[i]; }
              e2 = wave_sum(e2); r2 = wave_sum(r2); if (lane == 0) { atomicAdd((float*)(p.ctl() + 12000), e2); atomicAdd((float*)(p.ctl() + 12001), r2); } }
#endif
            dev_post(p, l, ntok_l, gw, ngw, lane); SEAM(pb + 6); }
        if (PHON(7) && IN(pb + 7)) { PHASE_VARS; (void)tid_; (void)wave;
            pg8::Gemm g{p.MIX(), p.WOUT_T(), D, 0}; pg8::StaticOrder S; S.init(ntok_l, D, G, (int)blockIdx.x);
            pg8::EpiF32 E{p.MO(), D};
            pg8::gemm_phase(ldsp, g, S, E);
            SEAM(pb + 7);
        }
        if (PHON(8) && IN(pb + 8)) { PHASE_VARS; dev_resid_router(p, l, ntok_l, ldsp, G, tid_); SEAM(pb + 8); }
        if (PHON(9) && IN(pb + 9)) { PHASE_VARS; dev_slots(p, l, ntok_l, ldsp, gtid, nthr, tid_); SEAM(pb + 9); }
        if (PHON(10) && IN(pb + 10)) { PHASE_VARS; const long nb = p.NBLK()[0]; RUN_TASKS(nb * 256 * 128, task_gather(p, task)); SEAM(pb + 10); }
        if (PHON(11) && IN(pb + 11)) { PHASE_VARS; (void)tid_; (void)wave;
            pg8::Gemm g{p.XG(), p.WGU_T(), D, (size_t)2 * DEXP * D}; pg8::MoeOrder S{__builtin_amdgcn_readfirstlane(p.NBLK()[0]), 2 * DEXP / 256, G, (int)blockIdx.x, p.BLOCK_E()};
            pg8::EpiSwiglu E{p.HH(), DEXP, p.exp_b_gu + (size_t)l * NEXP * 2 * DEXP, 2 * DEXP};
            pg8::gemm_phase(ldsp, g, S, E);
            SEAM(pb + 11);
        }
        if (PHON(12) && IN(pb + 12)) { PHASE_VARS; (void)tid_; (void)wave;
            pg8::Gemm g{p.HH(), p.WDN_T(), DEXP, (size_t)D * DEXP}; pg8::MoeOrder S{__builtin_amdgcn_readfirstlane(p.NBLK()[0]), D / 256, G, (int)blockIdx.x, p.BLOCK_E()};
            pg8::EpiBf16Bias E{p.YB(), D, p.exp_b_dn + (size_t)l * NEXP * D, D};
            pg8::gemm_phase(ldsp, g, S, E);
            SEAM(pb + 12);
        }
        if (PHON(13) && IN(pb + 13)) { PHASE_VARS; dev_combine(p, l, ntok_l, gw, ngw, lane); if (l + 1 < DEPTH) SEAM(pb + 13); }
    }
#undef IN
#undef SEAM
}

#ifndef N_LAUNCH_MODE
#define N_LAUNCH_MODE 1
#endif
extern "C" void kernel_launch(void* const* d_in, const int* in_sizes, int n_in, void* d_out, int out_size, void* d_ws, size_t ws_size, hipStream_t stream) {
    static int grid = 0;
    if (grid == 0) {
        int dev = 0, cus = 0;
        if (hipGetDevice(&dev) != hipSuccess || hipDeviceGetAttribute(&cus, hipDeviceAttributeMultiprocessorCount, dev) != hipSuccess) { grid = -1; return; }
        if (hipFuncSetAttribute((const void*)fwd_kernel, hipFuncAttributeMaxDynamicSharedMemorySize, LDS_BYTES) != hipSuccess) { fprintf(stderr, "hipFuncSetAttribute failed\n"); grid = -1; return; }
        int per_cu = 0;
        if (hipOccupancyMaxActiveBlocksPerMultiprocessor(&per_cu, (const void*)fwd_kernel, NTHR, LDS_BYTES) != hipSuccess || per_cu < 1) fprintf(stderr, "occupancy query: %d\n", per_cu);
        (void)hipGetLastError();
        grid = cus;
    }
    if (grid < 0) return;
    unsigned char* ws = (unsigned char*)d_ws;
    (void)hipMemsetAsync(ws, 0, CTL_BYTES, stream);
    Args a{};
    P& p = a.p;
    const float* const* in = (const float* const*)d_in;
    p.x = in[0]; p.c = in[1]; p.ctx = in[2]; p.c_ctx = in[3]; p.ada_w = in[4]; p.ada_b = in[5]; p.pre_norm = in[6]; p.post_norm = in[7]; p.w_in = in[8]; p.w_out = in[9];
    p.rw_mu = in[10]; p.rw_w0 = in[11]; p.rw_w2 = in[12]; p.rw_a0 = in[13]; p.rw_a2 = in[14]; p.rw_g2 = in[15]; p.rw_k_k = in[16]; p.rw_k_a = in[17]; p.rw_r_k = in[18]; p.rw_ln_w = in[19]; p.rw_ln_b = in[20];
    p.gdn_conv = in[21]; p.gdn_a_log = in[22]; p.gdn_dt_bias = in[23]; p.gdn_norm = in[24]; p.attn_q_norm = in[25]; p.attn_k_norm = in[26];
    p.router_w = in[27]; p.router_b = in[28]; p.exp_w_gu = in[29]; p.exp_b_gu = in[30]; p.exp_w_dn = in[31]; p.exp_b_dn = in[32];
    p.out = (float*)d_out;
    p.ws = ws; p.tokf = nullptr;
#ifdef PROBE_GDN
    if (WS_TOTAL + (size_t)2 * NTOK * B_W * 4 > ws_size) { fprintf(stderr, "probe: ws too small\n"); return; }
#endif
    if (WS_TOTAL > ws_size) { fprintf(stderr, "kernel_launch: workspace too small: need %zu have %zu\n", (size_t)WS_TOTAL, ws_size); return; }
    const int nph = 1 + DEPTH * NPH;
#if N_LAUNCH_MODE == 1
    a.ph_lo = 0; a.ph_hi = nph;
    hipLaunchKernelGGL(fwd_kernel, dim3(grid), dim3(NTHR), LDS_BYTES, stream, a);
#else
    for (int ph = 0; ph < nph; ++ph) { a.ph_lo = ph; a.ph_hi = ph + 1; hipLaunchKernelGGL(fwd_kernel, dim3(grid), dim3(NTHR), LDS_BYTES, stream, a); }
#endif
}
#endif
```

```cpp
#ifndef HOST_TEST
#include <hip/hip_runtime.h>
#else
struct uint4 { unsigned x, y, z, w; };
#endif
#include <cstdio>
#include <cstdint>
#include <cmath>

#ifndef CFG_BATCH
#define CFG_BATCH 16
#define CFG_SEQ 2048
#define CFG_CTX 256
#define CFG_NEXP 32
#define CFG_DEXP 1024
#endif
constexpr int D = 1024, BATCH = CFG_BATCH, SEQ = CFG_SEQ, CTXL = CFG_CTX, DEPTH = 2, GRID_W = 64;
constexpr int NLAT = BATCH * SEQ, NCTX = BATCH * CTXL, NTOK = NLAT + NCTX;
constexpr int A_W = 256, A_H = 4, A_IN = 960;
constexpr int B_W = 512, B_H = 4, B_IN = 2064, B_OFF = 960;
constexpr int C_W = 256, C_IN = 512, C_OFF = 3024;
constexpr int INW = 3536, INP = 3584;
constexpr int NEXP = CFG_NEXP, TOPK = 4, DEXP = CFG_DEXP;
constexpr int NBLK_MAX = (NTOK * TOPK + 255) / 256 + NEXP, NSLOT = NBLK_MAX * 256;
constexpr int ZROW = NTOK;
constexpr int SLEN = CTXL + SEQ;

#ifdef HOST_TEST
#define DEVFN static inline
#define GLOBAL_ATOMIC_ADD(p, v) ((*(p)) += (v), (*(p)) - (v))
#else
#define DEVFN __device__ __forceinline__
#define GLOBAL_ATOMIC_ADD(p, v) atomicAdd((p), (v))
#endif
#ifdef HOST_TEST
#define UNIFORM(x) (x)
#define LOADFENCE()
#else
#define UNIFORM(x) __builtin_amdgcn_readfirstlane(x)
#define LOADFENCE() asm volatile("" ::: "memory")
#endif
typedef unsigned short bf16_t;
DEVFN bf16_t f2bf(float f) { unsigned u = __builtin_bit_cast(unsigned, f); return (bf16_t)((u + 0x7fffu + ((u >> 16) & 1u)) >> 16); }
DEVFN float bf2f(bf16_t b) { unsigned u = ((unsigned)b) << 16; return __builtin_bit_cast(float, u); }
DEVFN float sigmoidf_(float x) { return 1.0f / (1.0f + expf(-x)); }
DEVFN float siluf_(float x) { return x / (1.0f + expf(-x)); }
DEVFN float softplusf_(float x) { return x > 20.f ? x : log1pf(expf(x)); }

#ifdef HOST_TEST
#define WSACC inline
#else
#define WSACC __device__ __host__ __forceinline__
#endif
constexpr size_t CTL_BYTES = 64 * 1024;
constexpr size_t al256(size_t x) { return (x + 255) & ~(size_t)255; }
constexpr size_t WSO_ctl = 0;
constexpr size_t WSE_ctl = WSO_ctl + al256(CTL_BYTES);
constexpr size_t WSO_MOD = WSE_ctl;
constexpr size_t WSE_MOD = WSO_MOD + al256((size_t)DEPTH * (BATCH + 1) * 6 * D * 4);
constexpr size_t WSO_X = WSE_MOD;
constexpr size_t WSE_X = WSO_X + al256((size_t)(NTOK + 1) * D * 4);
constexpr size_t WSO_HB = WSE_X;
constexpr size_t WSE_HB = WSO_HB + al256((size_t)(NTOK + 1) * D * 2);
constexpr size_t WSO_WIN_T = WSE_HB;
constexpr size_t WSE_WIN_T = WSO_WIN_T + al256((size_t)INP * D * 2);
constexpr size_t WSO_WOUT_T = WSE_WIN_T;
constexpr size_t WSE_WOUT_T = WSO_WOUT_T + al256((size_t)D * D * 2);
constexpr size_t WSO_WR_T = WSE_WOUT_T;
constexpr size_t WSE_WR_T = WSO_WR_T + al256((size_t)32 * D * 2);
constexpr size_t WSO_WGU_T = WSE_WR_T;
constexpr size_t WSE_WGU_T = WSO_WGU_T + al256((size_t)NEXP * 2 * DEXP * D * 2);
constexpr size_t WSO_WDN_T = WSE_WGU_T;
constexpr size_t WSE_WDN_T = WSO_WDN_T + al256((size_t)NEXP * D * DEXP * 2);
constexpr size_t WSO_TOPI = WSE_WDN_T;
constexpr size_t WSE_TOPI = WSO_TOPI + al256((size_t)NTOK * 4 * 4);
constexpr size_t WSO_POS = WSE_TOPI;
constexpr size_t WSE_POS = WSO_POS + al256((size_t)NTOK * 4 * 4);
constexpr size_t WSO_TSLOT = WSE_POS;
constexpr size_t WSE_TSLOT = WSO_TSLOT + al256((size_t)NTOK * 4 * 4);
constexpr size_t WSO_TOPG = WSE_TSLOT;
constexpr size_t WSE_TOPG = WSO_TOPG + al256((size_t)NTOK * 4 * 4);
constexpr size_t WSO_SLOT_TOK = WSE_TOPG;
constexpr size_t WSE_SLOT_TOK = WSO_SLOT_TOK + al256((size_t)NSLOT * 4);
constexpr size_t WSO_BLOCK_E = WSE_SLOT_TOK;
constexpr size_t WSE_BLOCK_E = WSO_BLOCK_E + al256((size_t)NBLK_MAX * 4);
constexpr size_t WSO_NBLK = WSE_BLOCK_E;
constexpr size_t WSE_NBLK = WSO_NBLK + al256(256);
constexpr size_t WSO_U = WSE_NBLK;
constexpr size_t WSE_U = WSO_U + al256((size_t)NTOK * INP * 2);
constexpr size_t WSO_MO = WSE_U;
constexpr size_t WSE_MO = WSO_MO + al256((size_t)NTOK * D * 4);
constexpr size_t WSO_END_P = WSE_MO;
constexpr size_t WSO_LR = WSO_END_P;
constexpr size_t WSE_LR = WSO_LR + al256((size_t)NTOK * 192 * 4);
constexpr size_t WSO_RW_R = WSE_LR;
constexpr size_t WSE_RW_R = WSO_RW_R + al256((size_t)NTOK * A_W * 4);
constexpr size_t WSO_RW_V = WSE_RW_R;
constexpr size_t WSE_RW_V = WSO_RW_V + al256((size_t)NTOK * A_W * 4);
constexpr size_t WSO_RW_KK = WSE_RW_V;
constexpr size_t WSE_RW_KK = WSO_RW_KK + al256((size_t)NTOK * A_W * 4);
constexpr size_t WSO_RW_D = WSE_RW_KK;
constexpr size_t WSE_RW_D = WSO_RW_D + al256((size_t)2 * NTOK * A_W * 4);
constexpr size_t WSO_RW_KD = WSE_RW_D;
constexpr size_t WSE_RW_KD = WSO_RW_KD + al256((size_t)2 * NTOK * A_W * 4);
constexpr size_t WSO_RW_KKA = WSE_RW_KD;
constexpr size_t WSE_RW_KKA = WSO_RW_KKA + al256((size_t)2 * NTOK * A_W * 4);
constexpr size_t WSO_RW_GATE = WSE_RW_KKA;
constexpr size_t WSE_RW_GATE = WSO_RW_GATE + al256((size_t)NTOK * A_W * 4);
constexpr size_t WSO_RW_BON = WSE_RW_GATE;
constexpr size_t WSE_RW_BON = WSO_RW_BON + al256((size_t)NTOK * A_H * 4);
constexpr size_t WSO_YA = WSE_RW_BON;
constexpr size_t WSE_YA = WSO_YA + al256((size_t)2 * NTOK * A_W * 4);
constexpr size_t WSO_GQ = WSE_YA;
constexpr size_t WSE_GQ = WSO_GQ + al256((size_t)NTOK * B_W * 2);
constexpr size_t WSO_GK = WSE_GQ;
constexpr size_t WSE_GK = WSO_GK + al256((size_t)NTOK * B_W * 2);
constexpr size_t WSO_GV = WSE_GK;
constexpr size_t WSE_GV = WSO_GV + al256((size_t)NTOK * B_W * 2);
constexpr size_t WSO_GG = WSE_GV;
constexpr size_t WSE_GG = WSO_GG + al256((size_t)NTOK * 8 * 4);
constexpr size_t WSO_GBETA = WSE_GG;
constexpr size_t WSE_GBETA = WSO_GBETA + al256((size_t)NTOK * 8 * 4);
constexpr size_t WSO_OB = WSE_GBETA;
constexpr size_t WSE_OB = WSO_OB + al256((size_t)2 * NTOK * B_W * 4);
constexpr size_t WSO_CQ = WSE_OB;
constexpr size_t WSE_CQ = WSO_CQ + al256((size_t)NTOK * 256 * 2);
constexpr size_t WSO_CK = WSE_CQ;
constexpr size_t WSE_CK = WSO_CK + al256((size_t)NTOK * 128 * 2);
constexpr size_t WSO_CV = WSE_CK;
constexpr size_t WSE_CV = WSO_CV + al256((size_t)NTOK * 128 * 2);
constexpr size_t WSO_RWC = WSE_CV;
constexpr size_t WSE_RWC = WSO_RWC + al256((size_t)2 * BATCH * A_H * (SLEN / 64) * 5 * 4096 * 2);
constexpr size_t WSO_LRT = WSE_RWC;
constexpr size_t WSE_LRT = WSO_LRT + al256((size_t)NTOK * 256 * 2);
constexpr size_t WSO_LRO = WSE_LRT;
constexpr size_t WSE_LRO = WSO_LRO + al256((size_t)NTOK * 1280 * 2);
constexpr size_t WSO_WLR_T = WSE_LRO;
constexpr size_t WSE_WLR_T = WSO_WLR_T + al256((size_t)1280 * 256 * 2);
constexpr size_t WSO_MIX = WSE_WLR_T;
constexpr size_t WSE_MIX = WSO_MIX + al256((size_t)NTOK * D * 2);
constexpr size_t WSO_XG = WSO_END_P;
constexpr size_t WSE_XG = WSO_XG + al256((size_t)NSLOT * D * 2);
constexpr size_t WSO_HH = WSE_XG;
constexpr size_t WSE_HH = WSO_HH + al256((size_t)NSLOT * DEXP * 2);
constexpr size_t WSO_YB = WSE_HH;
constexpr size_t WSE_YB = WSO_YB + al256((size_t)NSLOT * D * 2);
constexpr size_t WS_TOTAL = (WSE_MIX > WSE_YB ? WSE_MIX : WSE_YB);
struct P {
    const float *x, *c, *ctx, *c_ctx, *ada_w, *ada_b, *pre_norm, *post_norm, *w_in, *w_out;
    const float *rw_mu, *rw_w0, *rw_w2, *rw_a0, *rw_a2, *rw_g2, *rw_k_k, *rw_k_a, *rw_r_k, *rw_ln_w, *rw_ln_b;
    const float *gdn_conv, *gdn_a_log, *gdn_dt_bias, *gdn_norm, *attn_q_norm, *attn_k_norm;
    const float *router_w, *router_b, *exp_w_gu, *exp_b_gu, *exp_w_dn, *exp_b_dn;
    float* out;
    unsigned char* ws;
    WSACC unsigned* ctl() const { return (unsigned*)(ws + WSO_ctl); }
    WSACC float* MOD() const { return (float*)(ws + WSO_MOD); }
    WSACC float* X() const { return (float*)(ws + WSO_X); }
    WSACC bf16_t* HB() const { return (bf16_t*)(ws + WSO_HB); }
    WSACC bf16_t* WIN_T() const { return (bf16_t*)(ws + WSO_WIN_T); }
    WSACC bf16_t* WOUT_T() const { return (bf16_t*)(ws + WSO_WOUT_T); }
    WSACC bf16_t* WR_T() const { return (bf16_t*)(ws + WSO_WR_T); }
    WSACC bf16_t* WGU_T() const { return (bf16_t*)(ws + WSO_WGU_T); }
    WSACC bf16_t* WDN_T() const { return (bf16_t*)(ws + WSO_WDN_T); }
    WSACC int* TOPI() const { return (int*)(ws + WSO_TOPI); }
    WSACC int* POS() const { return (int*)(ws + WSO_POS); }
    WSACC int* TSLOT() const { return (int*)(ws + WSO_TSLOT); }
    WSACC float* TOPG() const { return (float*)(ws + WSO_TOPG); }
    WSACC int* SLOT_TOK() const { return (int*)(ws + WSO_SLOT_TOK); }
    WSACC int* BLOCK_E() const { return (int*)(ws + WSO_BLOCK_E); }
    WSACC int* NBLK() const { return (int*)(ws + WSO_NBLK); }
    WSACC bf16_t* U() const { return (bf16_t*)(ws + WSO_U); }
    WSACC float* MO() const { return (float*)(ws + WSO_MO); }
    WSACC float* LR() const { return (float*)(ws + WSO_LR); }
    WSACC float* RW_R() const { return (float*)(ws + WSO_RW_R); }
    WSACC float* RW_V() const { return (float*)(ws + WSO_RW_V); }
    WSACC float* RW_KK() const { return (float*)(ws + WSO_RW_KK); }
    WSACC float* RW_D() const { return (float*)(ws + WSO_RW_D); }
    WSACC float* RW_KD() const { return (float*)(ws + WSO_RW_KD); }
    WSACC float* RW_KKA() const { return (float*)(ws + WSO_RW_KKA); }
    WSACC float* RW_GATE() const { return (float*)(ws + WSO_RW_GATE); }
    WSACC float* RW_BON() const { return (float*)(ws + WSO_RW_BON); }
    WSACC float* YA() const { return (float*)(ws + WSO_YA); }
    WSACC bf16_t* GQ() const { return (bf16_t*)(ws + WSO_GQ); }
    WSACC bf16_t* GK() const { return (bf16_t*)(ws + WSO_GK); }
    WSACC bf16_t* GV() const { return (bf16_t*)(ws + WSO_GV); }
    WSACC float* GG() const { return (float*)(ws + WSO_GG); }
    WSACC float* GBETA() const { return (float*)(ws + WSO_GBETA); }
    WSACC float* OB() const { return (float*)(ws + WSO_OB); }
    WSACC bf16_t* CQ() const { return (bf16_t*)(ws + WSO_CQ); }
    WSACC bf16_t* CK() const { return (bf16_t*)(ws + WSO_CK); }
    WSACC bf16_t* CV() const { return (bf16_t*)(ws + WSO_CV); }
    WSACC bf16_t* MIX() const { return (bf16_t*)(ws + WSO_MIX); }
    WSACC bf16_t* RWC() const { return (bf16_t*)(ws + WSO_RWC); }
    WSACC bf16_t* LRT() const { return (bf16_t*)(ws + WSO_LRT); }
    WSACC bf16_t* LRO() const { return (bf16_t*)(ws + WSO_LRO); }
    WSACC bf16_t* WLR_T() const { return (bf16_t*)(ws + WSO_WLR_T); }
    WSACC bf16_t* XG() const { return (bf16_t*)(ws + WSO_XG); }
    WSACC bf16_t* HH() const { return (bf16_t*)(ws + WSO_HH); }
    WSACC bf16_t* YB() const { return (bf16_t*)(ws + WSO_YB); }
    WSACC int* cnt() const { return (int*)(ws + WSO_ctl) + 8192; }
    WSACC float* TOKF() const { return tokf; }
    float* tokf;
};

DEVFN void row_info(int m, int& b, int& t, int& len, int& base) {
    if (m < NLAT) { b = m / SEQ; t = m % SEQ; len = SEQ; base = b * SEQ; }
    else { const int mc = m - NLAT; b = mc / CTXL; t = mc % CTXL; len = CTXL; base = NLAT + b * CTXL; }
}
DEVFN float ldU(const P& p, size_t idx) { return bf2f(p.U()[idx]); }
DEVFN int mod_row(int m) { return m < NLAT ? m / SEQ : BATCH; }
DEVFN int scan_row(int dir, int b, int s) {
    if (s < CTXL) { const int ts = dir ? (CTXL - 1 - s) : s; return NLAT + b * CTXL + ts; }
    const int s2 = s - CTXL; const int ts = dir ? (SEQ - 1 - s2) : s2; return b * SEQ + ts;
}

DEVFN void task_mod(const P& p, long task) {
    const int j = (int)(task % (6 * D)); const int r = (int)((task / (6 * D)) % (BATCH + 1)); const int l = (int)(task / ((long)(6 * D) * (BATCH + 1)));
    const float* cv = (r < BATCH) ? p.c + (size_t)r * D : p.c_ctx;
    const float* w = p.ada_w + (size_t)l * D * 6 * D + j;
    float acc = 0.f;
    for (int k = 0; k < D; ++k) acc += siluf_(cv[k]) * w[(size_t)k * 6 * D];
    p.MOD()[((size_t)l * (BATCH + 1) + r) * 6 * D + j] = acc + p.ada_b[(size_t)l * 6 * D + j];
}
DEVFN void task_copyx(const P& p, long task) {
    const long n_lat = (long)NLAT * D;
    p.X()[task] = task < n_lat ? p.x[task] : p.ctx[task - n_lat];
}
DEVFN void task_norm1(const P& p, int l, long task) {
    const int m = (int)task; const float* xr = p.X() + (size_t)m * D;
    float ss = 0.f; for (int k = 0; k < D; ++k) ss += xr[k] * xr[k];
    const float rstd = 1.0f / sqrtf(ss / D + 1e-6f);
    const float* md = p.MOD() + ((size_t)l * (BATCH + 1) + mod_row(m)) * 6 * D; const float* pn = p.pre_norm + (size_t)(l * 2 + 0) * D;
    bf16_t* o = p.HB() + (size_t)m * D;
    for (int k = 0; k < D; ++k) o[k] = f2bf(xr[k] * rstd * pn[k] * (1.0f + md[D + k]) + md[k]);
}
DEVFN float lerpA(const P& p, int l, int m, int col) {
    int b, t, len, base; row_info(m, b, t, len, base);
    const float u = ldU(p, (size_t)m * INP + col);
    const float up = t > 0 ? ldU(p, (size_t)(m - 1) * INP + col) : 0.f, un = t + 1 < len ? ldU(p, (size_t)(m + 1) * INP + col) : 0.f;
    return u + p.rw_mu[l * A_IN + col] * (0.5f * (up + un) - u);
}
DEVFN void task_prepA0(const P& p, int l, long task) {
    const int m = (int)(task / 192), j = (int)(task % 192);
    const float v = lerpA(p, l, m, 768 + j);
    p.LR()[(size_t)m * 192 + j] = j < 64 ? tanhf(v) : (j < 128 ? v : sigmoidf_(v));
}
DEVFN void task_prepA1(const P& p, int l, long task) {
    const int m = (int)(task / A_H), h = (int)(task % A_H);
    const float* lr = p.LR() + (size_t)m * 192;
    float ss = 0.f;
    for (int c = 0; c < 64; ++c) { const int ch = h * 64 + c; const float kx = lerpA(p, l, m, 256 + ch) * p.rw_k_k[l * A_W + ch]; ss += kx * kx; }
    const float rn = 1.0f / sqrtf(ss + 1e-6f);
    float bon = 0.f;
    for (int c = 0; c < 64; ++c) {
        const int ch = h * 64 + c;
        const float r = lerpA(p, l, m, ch), k = lerpA(p, l, m, 256 + ch), v = lerpA(p, l, m, 512 + ch);
        const float kk = k * p.rw_k_k[l * A_W + ch] * rn;
        float kdsum = 0.f;
        for (int dir = 0; dir < 2; ++dir) {
            float w = p.rw_w0[(l * 2 + dir) * A_W + ch], a = p.rw_a0[(l * 2 + dir) * A_W + ch];
            const float* w2 = p.rw_w2 + ((size_t)(l * 2 + dir) * 32) * A_W + ch; const float* a2 = p.rw_a2 + ((size_t)(l * 2 + dir) * 32) * A_W + ch;
            for (int r2 = 0; r2 < 32; ++r2) { w += lr[dir * 32 + r2] * w2[(size_t)r2 * A_W]; a += lr[64 + dir * 32 + r2] * a2[(size_t)r2 * A_W]; }
            const float decay = -expf(-softplusf_(-w) - 0.5f);
            const float iclr = sigmoidf_(a);
            const float kd = k * (1.0f + (iclr - 1.0f) * p.rw_k_a[l * A_W + ch]);
            const size_t o = ((size_t)dir * NTOK + m) * A_W + ch;
            p.RW_D()[o] = decay; p.RW_KD()[o] = kd; p.RW_KKA()[o] = kk * iclr; kdsum += kd;
        }
        float g = 0.f; const float* g2 = p.rw_g2 + (size_t)l * 64 * A_W + ch;
        for (int r2 = 0; r2 < 64; ++r2) g += lr[128 + r2] * g2[(size_t)r2 * A_W];
        const size_t o = (size_t)m * A_W + ch;
        p.RW_R()[o] = r; p.RW_V()[o] = v; p.RW_KK()[o] = kk; p.RW_GATE()[o] = g;
        bon += r * kdsum * p.rw_r_k[l * A_W + ch];
    }
    p.RW_BON()[(size_t)m * A_H + h] = bon;
}
DEVFN void task_prepB(const P& p, int l, long task) {
    const int which = (int)(task % 4), h = (int)((task / 4) % B_H), m = (int)(task / (4 * B_H));
    int b, t, len, base; row_info(m, b, t, len, base);
    if (which == 3) {
        for (int dir = 0; dir < 2; ++dir) {
            const float a = ldU(p, (size_t)m * INP + B_OFF + 2048 + dir * 4 + h), bb = ldU(p, (size_t)m * INP + B_OFF + 2056 + dir * 4 + h);
            const float g = -expf(p.gdn_a_log[(l * 2 + dir) * B_H + h]) * softplusf_(a + p.gdn_dt_bias[(l * 2 + dir) * B_H + h]);
            p.GG()[(size_t)m * 8 + dir * 4 + h] = g; p.GBETA()[(size_t)m * 8 + dir * 4 + h] = sigmoidf_(bb);
        }
        return;
    }
    bf16_t* dst = (which == 0 ? p.GQ() : which == 1 ? p.GK() : p.GV()) + (size_t)m * B_W + h * 128;
    float ss = 0.f;
    for (int c = 0; c < 128; ++c) {
        const int cc = which * B_W + h * 128 + c; const int col = B_OFF + cc;
        float acc = 0.f;
        for (int j = 0; j < 5; ++j) { const int tt = t + j - 2; if (tt >= 0 && tt < len) acc += ldU(p, (size_t)(base + tt) * INP + col) * p.gdn_conv[((size_t)l * 5 + j) * (3 * B_W) + cc]; }
        const float s = siluf_(acc); if (which == 2) dst[c] = f2bf(s); ss += s * s;
    }
    if (which < 2) { const float rn = (1.0f / sqrtf(ss + 1e-6f)) * (which == 0 ? 0.08838834764831845f : 1.0f);
        for (int c = 0; c < 128; ++c) { const int cc = which * B_W + h * 128 + c; const int col = B_OFF + cc; float acc = 0.f;
            for (int j = 0; j < 5; ++j) { const int tt = t + j - 2; if (tt >= 0 && tt < len) acc += ldU(p, (size_t)(base + tt) * INP + col) * p.gdn_conv[((size_t)l * 5 + j) * (3 * B_W) + cc]; }
            dst[c] = f2bf(siluf_(acc) * rn); } }
}
DEVFN void task_prepC(const P& p, int l, long task) {
    const int m = (int)(task / 8), hs = (int)(task % 8);
    const size_t sb = (size_t)m * INP + C_OFF + hs * 64;
    if (hs >= 6) { bf16_t* dst = p.CV() + (size_t)m * 128 + (hs - 6) * 64; for (int d = 0; d < 64; ++d) dst[d] = p.U()[sb + d]; return; }
    float ss = 0.f; for (int d = 0; d < 64; ++d) { const float x = ldU(p, sb + d); ss += x * x; }
    const float qs = hs < 4 ? 0.18033688011112042f : 1.0f;
    const float rstd = (1.0f / sqrtf(ss / 64.f + 1e-6f)) * qs;
    const float* nw = (hs < 4 ? p.attn_q_norm : p.attn_k_norm) + l * 64;
    bf16_t* dst = hs < 4 ? p.CQ() + (size_t)m * 256 + hs * 64 : p.CK() + (size_t)m * 128 + (hs - 4) * 64;
    if (m >= NLAT) { for (int d = 0; d < 64; ++d) dst[d] = f2bf(ldU(p, sb + d) * rstd * nw[d]); return; }
    const int t = m % SEQ; const float pr = (float)(t / GRID_W), pc = (float)(t % GRID_W);
    for (int d = 0; d < 16; ++d) {
        const float fr = powf(10000.0f, -(float)d / 16.0f);
        const float ar = pr * fr, ac = pc * fr; const float cr = cosf(ar), sr = sinf(ar), cc = cosf(ac), sc = sinf(ac);
        const float x1 = ldU(p, sb + d) * rstd * nw[d], x2 = ldU(p, sb + 16 + d) * rstd * nw[16 + d], x3 = ldU(p, sb + 32 + d) * rstd * nw[32 + d], x4 = ldU(p, sb + 48 + d) * rstd * nw[48 + d];
        dst[d] = f2bf(x1 * cr - x2 * sr); dst[16 + d] = f2bf(x2 * cr + x1 * sr); dst[32 + d] = f2bf(x3 * cc - x4 * sc); dst[48 + d] = f2bf(x4 * cc + x3 * sc);
    }
}
DEVFN void task_scanA(const P& p, long task) {
    const int v = (int)(task % 64), chain = UNIFORM((int)(task / 64)); const int h = chain % A_H, b = (chain / A_H) % BATCH, dir = chain / (A_H * BATCH);
    float s[64];
#pragma unroll
    for (int k = 0; k < 64; ++k) s[k] = 0.f;
    for (int st = 0; st < SLEN; ++st) {
        const int m = scan_row(dir, b, st);
        const float* kk = p.RW_KK() + (size_t)m * A_W + h * 64; const float* rr = p.RW_R() + (size_t)m * A_W + h * 64;
        const size_t od = ((size_t)dir * NTOK + m) * A_W + h * 64;
        const float* dd = p.RW_D() + od; const float* kd = p.RW_KD() + od; const float* ka = p.RW_KKA() + od;
        const float vv = p.RW_V()[(size_t)m * A_W + h * 64 + v];
        float sa = 0.f;
#pragma unroll
        for (int k = 0; k < 64; ++k) { sa += s[k] * kk[k]; if ((k & 15) == 15) LOADFENCE(); }
        float y = 0.f;
#pragma unroll
        for (int k = 0; k < 64; ++k) { s[k] = s[k] * expf(dd[k]) - sa * ka[k] + vv * kd[k]; y += s[k] * rr[k]; if ((k & 7) == 7) LOADFENCE(); }
        p.YA()[((size_t)dir * NTOK + m) * A_W + h * 64 + v] = y;
    }
}
DEVFN void task_scanB(const P& p, long task) {
    const int j = (int)(task % 128), chain = UNIFORM((int)(task / 128)); const int h = chain % B_H, b = (chain / B_H) % BATCH, dir = chain / (B_H * BATCH);
    float s[128];
#pragma unroll
    for (int k = 0; k < 128; ++k) s[k] = 0.f;
    for (int st = 0; st < SLEN; ++st) {
        const int m = scan_row(dir, b, st);
        const bf16_t* kv = p.GK() + (size_t)m * B_W + h * 128; const bf16_t* qv = p.GQ() + (size_t)m * B_W + h * 128;
        const float vj = bf2f(p.GV()[(size_t)m * B_W + h * 128 + j]);
        const float eg = expf(p.GG()[(size_t)m * 8 + dir * 4 + h]), beta = p.GBETA()[(size_t)m * 8 + dir * 4 + h];
        float pk = 0.f;
#pragma unroll
        for (int k = 0; k < 128; ++k) { pk += s[k] * bf2f(kv[k]); if ((k & 15) == 15) LOADFENCE(); }
        const float cf = beta * (vj - eg * pk);
        float o = 0.f;
#pragma unroll
        for (int k = 0; k < 128; ++k) { s[k] = eg * s[k] + cf * bf2f(kv[k]); o += s[k] * bf2f(qv[k]); if ((k & 7) == 7) LOADFENCE(); }
        p.OB()[((size_t)dir * NTOK + m) * B_W + h * 128 + j] = o;
    }
}
DEVFN void task_attn(const P& p, int need_ctx, long task) {
    const int t = (int)(task % SLEN), hq = UNIFORM((int)((task / SLEN) % 4)), b = UNIFORM((int)(task / ((long)SLEN * 4)));
    const bool is_lat = UNIFORM((int)(t < SEQ)) != 0; if (!is_lat && !need_ctx) return;
    const int m = is_lat ? b * SEQ + t : NLAT + b * CTXL + (t - SEQ);
    const int kvh = hq >> 1;
    float q[64], o[64];
#pragma unroll
    for (int d = 0; d < 64; ++d) { q[d] = bf2f(p.CQ()[(size_t)m * 256 + hq * 64 + d]); o[d] = 0.f; }
    float mx = -1e30f, lsum = 0.f;
    const int nk = is_lat ? SLEN : CTXL;
    for (int kI = 0; kI < nk; ++kI) {
        int km; if (is_lat) km = kI < SEQ ? b * SEQ + kI : NLAT + b * CTXL + (kI - SEQ); else km = NLAT + b * CTXL + kI;
        const bf16_t* kr = p.CK() + (size_t)km * 128 + kvh * 64; const bf16_t* vr = p.CV() + (size_t)km * 128 + kvh * 64;
        float sc = 0.f;
#pragma unroll
        for (int d = 0; d < 64; ++d) { sc += q[d] * bf2f(kr[d]); if ((d & 15) == 15) LOADFENCE(); }
        const float mn = sc > mx ? sc : mx; const float f = exp2f(mx - mn), pe = exp2f(sc - mn);
        lsum = lsum * f + pe; mx = mn;
#pragma unroll
        for (int d = 0; d < 64; ++d) { o[d] = o[d] * f + pe * bf2f(vr[d]); if ((d & 15) == 15) LOADFENCE(); }
    }
    const float inv = 1.0f / lsum;
#pragma unroll
    for (int d = 0; d < 64; ++d) p.MIX()[(size_t)m * D + 768 + hq * 64 + d] = f2bf(o[d] * inv);
}
DEVFN void task_post(const P& p, int l, long task) {
    const int m = (int)(task / 8), g = (int)(task % 8);
    if (g < 4) {
        const int h = g; const float* y0 = p.YA() + (size_t)m * A_W + h * 64; const float* y1 = p.YA() + ((size_t)NTOK + m) * A_W + h * 64;
        float mean = 0.f; for (int c = 0; c < 64; ++c) mean += y0[c] + y1[c]; mean *= (1.0f / 64.f);
        float var = 0.f; for (int c = 0; c < 64; ++c) { const float d0 = y0[c] + y1[c] - mean; var += d0 * d0; } var *= (1.0f / 64.f);
        const float rs = 1.0f / sqrtf(var + 64e-5f); const float bon = p.RW_BON()[(size_t)m * A_H + h];
        for (int c = 0; c < 64; ++c) { const int ch = h * 64 + c;
            const float yn = (y0[c] + y1[c] - mean) * rs * p.rw_ln_w[l * A_W + ch] + p.rw_ln_b[l * A_W + ch];
            p.MIX()[(size_t)m * D + ch] = f2bf((yn + bon * p.RW_V()[(size_t)m * A_W + ch]) * p.RW_GATE()[(size_t)m * A_W + ch]); }
    } else {
        const int h = g - 4; const float* o0 = p.OB() + (size_t)m * B_W + h * 128; const float* o1 = p.OB() + ((size_t)NTOK + m) * B_W + h * 128;
        float ss = 0.f; for (int c = 0; c < 128; ++c) { const float o = o0[c] + o1[c]; ss += o * o; }
        const float rs = 1.0f / sqrtf(ss / 128.f + 1e-6f);
        for (int c = 0; c < 128; ++c) { const float z = ldU(p, (size_t)m * INP + B_OFF + 1536 + h * 128 + c);
            p.MIX()[(size_t)m * D + 256 + h * 128 + c] = f2bf((o0[c] + o1[c]) * rs * p.gdn_norm[l * 128 + c] * siluf_(z)); }
    }
}
DEVFN void task_resid1(const P& p, int l, long task) {
    const int m = (int)task; const float* mo = p.MO() + (size_t)m * D; float* xr = p.X() + (size_t)m * D;
    const float* md = p.MOD() + ((size_t)l * (BATCH + 1) + mod_row(m)) * 6 * D;
    float ss = 0.f; for (int k = 0; k < D; ++k) ss += mo[k] * mo[k];
    const float rstd = 1.0f / sqrtf(ss / D + 1e-6f); const float* pn = p.post_norm + (size_t)(l * 2 + 0) * D;
    float s2 = 0.f;
    for (int k = 0; k < D; ++k) { const float xv = xr[k] + md[2 * D + k] * (mo[k] * rstd) * pn[k]; xr[k] = xv; s2 += xv * xv; }
    const float r2 = 1.0f / sqrtf(s2 / D + 1e-6f); const float* pn2 = p.pre_norm + (size_t)(l * 2 + 1) * D;
    for (int k = 0; k < D; ++k) { const float tv = xr[k] * r2 * pn2[k] * (1.0f + md[4 * D + k]) + md[3 * D + k]; p.TOKF()[(size_t)m * D + k] = tv; p.HB()[(size_t)m * D + k] = f2bf(tv); }
}
DEVFN void task_router(const P& p, int l, long task) {
    const int m = (int)task; const float* tk = p.TOKF() + (size_t)m * D; const float* rw = p.router_w + (size_t)l * D * NEXP;
    float lg[NEXP];
#pragma unroll
    for (int e = 0; e < NEXP; ++e) lg[e] = p.router_b[l * NEXP + e];
    for (int k = 0; k < D; ++k) { const float tv = tk[k];
#pragma unroll
        for (int e = 0; e < NEXP; ++e) lg[e] += tv * rw[(size_t)k * NEXP + e]; }
    int idx[TOPK]; float val[TOPK];
#pragma unroll
    for (int j = 0; j < TOPK; ++j) { float best = -3.0e38f; int bi = 0;
#pragma unroll
        for (int e = 0; e < NEXP; ++e) { if (lg[e] > best) { best = lg[e]; bi = e; } }
        idx[j] = bi; val[j] = best;
#pragma unroll
        for (int e = 0; e < NEXP; ++e) if (e == bi) lg[e] = -3.0e38f; }
    float sum = 0.f, ex[TOPK];
#pragma unroll
    for (int j = 0; j < TOPK; ++j) { ex[j] = expf(val[j] - val[0]); sum += ex[j]; }
#pragma unroll
    for (int j = 0; j < TOPK; ++j) { p.TOPI()[(size_t)m * TOPK + j] = idx[j]; p.TOPG()[(size_t)m * TOPK + j] = ex[j] / sum; p.POS()[(size_t)m * TOPK + j] = GLOBAL_ATOMIC_ADD(&p.cnt()[l * NEXP + idx[j]], 1); }
}
DEVFN int moe_pstart(const P& p, int l, int e, int* nblk) {
    int acc = 0, ps = 0;
    for (int i = 0; i < NEXP; ++i) { if (i == e) ps = acc; acc += (p.cnt()[l * NEXP + i] + 255) / 256 * 256; }
    if (nblk) *nblk = acc / 256; return ps;
}
DEVFN void task_slots(const P& p, int l, long task) {
    const int e = p.TOPI()[task]; const int slot = moe_pstart(p, l, e, nullptr) + p.POS()[task];
    p.TSLOT()[task] = slot; p.SLOT_TOK()[slot] = (int)(task / TOPK);
}
DEVFN void task_blocke(const P& p, int l, long task) {
    int acc = 0, e_of = NEXP - 1, nb = 0;
    for (int i = 0; i < NEXP; ++i) { const int nbk = (p.cnt()[l * NEXP + i] + 255) / 256; if ((int)task >= acc && (int)task < acc + nbk) e_of = i; acc += nbk; }
    nb = acc; p.BLOCK_E()[task] = e_of; if (task == 0) p.NBLK()[0] = nb;
}
DEVFN void task_gather(const P& p, long task) {
    const long slot = task / 128; const int ch = (int)(task % 128); const int tok = p.SLOT_TOK()[slot];
    const uint4* s = (const uint4*)(p.HB() + (size_t)tok * D) + ch; ((uint4*)(p.XG() + (size_t)slot * D))[ch] = *s;
}
DEVFN void task_combine(const P& p, int l, long task) {
    const int m = (int)task; float* xr = p.X() + (size_t)m * D; const float* md = p.MOD() + ((size_t)l * (BATCH + 1) + mod_row(m)) * 6 * D;
    const bf16_t* y0 = p.YB() + (size_t)p.TSLOT()[(size_t)m * 4 + 0] * D; const bf16_t* y1 = p.YB() + (size_t)p.TSLOT()[(size_t)m * 4 + 1] * D;
    const bf16_t* y2 = p.YB() + (size_t)p.TSLOT()[(size_t)m * 4 + 2] * D; const bf16_t* y3 = p.YB() + (size_t)p.TSLOT()[(size_t)m * 4 + 3] * D;
    const float g0 = p.TOPG()[(size_t)m * 4 + 0], g1 = p.TOPG()[(size_t)m * 4 + 1], g2 = p.TOPG()[(size_t)m * 4 + 2], g3 = p.TOPG()[(size_t)m * 4 + 3];
    float ss = 0.f;
    for (int k = 0; k < D; ++k) { const float f = g0 * bf2f(y0[k]) + g1 * bf2f(y1[k]) + g2 * bf2f(y2[k]) + g3 * bf2f(y3[k]); ss += f * f; }
    const float rstd = 1.0f / sqrtf(ss / D + 1e-6f); const float* pn = p.post_norm + (size_t)(l * 2 + 1) * D;
    const bool last = (l == DEPTH - 1);
    for (int k = 0; k < D; ++k) { const float f = g0 * bf2f(y0[k]) + g1 * bf2f(y1[k]) + g2 * bf2f(y2[k]) + g3 * bf2f(y3[k]);
        const float xv = xr[k] + md[5 * D + k] * (f * rstd) * pn[k]; xr[k] = xv; if (last) p.out[(size_t)m * D + k] = xv; }
}

#ifndef HOST_TEST
namespace pg8 {
#define PG8_LAS __attribute__((address_space(3)))
typedef short bf16x8 __attribute__((ext_vector_type(8)));
typedef float f32x4 __attribute__((ext_vector_type(4)));
typedef unsigned u32x4 __attribute__((ext_vector_type(4)));
typedef unsigned u32x2 __attribute__((ext_vector_type(2)));
constexpr int BM = 256, BK = 64, HALF = 128, HTB = HALF * BK * 2, STAGE_BYTES = 8 * HTB, NXCD = 8, WGM = 8;
__host__ __device__ __forceinline__ int lds_byte(int r, int c) { const int st = (r >> 4) * 2 + (c >> 5), rr = r & 15, cc = c & 31, ob = rr * 64 + cc * 2; return st * 1024 + (ob ^ (((ob >> 9) & 1) << 5)); }
__host__ __device__ __forceinline__ void stage_rc(int b, int& R, int& C) { const int st = b / 1024, sb = b % 1024, swz = sb ^ (((sb >> 9) & 1) << 5); R = (st >> 1) * 16 + swz / 64; C = (st & 1) * 32 + (swz % 64) / 2; }
__host__ __device__ __forceinline__ int perm32(int rho) { const int n = rho >> 4, i = rho & 15; return 8 * (i >> 2) + 4 * n + (i & 3); }
struct Unit { int pm, pn, e; };
struct Gemm { const bf16_t* A; const bf16_t* Bt; int K; size_t estride; };
struct StaticOrder {
    int nM, nN, nwg, G, c;
    __device__ void init(int M, int N, int G_, int c_) { nM = M / BM; nN = N / BM; nwg = nM * nN; G = G_; c = c_; }
    __device__ bool next(int i, Unit& u) const {
        const long L = (long)i * G + c; if (L >= nwg) return false;
        int wgid = (int)L; { const int q = nwg / NXCD, r = nwg % NXCD, xcd = wgid % NXCD, off = wgid / NXCD; wgid = (xcd < r ? xcd * (q + 1) : r * (q + 1) + (xcd - r) * q) + off; }
        const int nig = WGM * nN, gid = wgid / nig, fm = gid * WGM, gsz = (nM - fm) < WGM ? (nM - fm) : WGM;
        u.pm = fm + ((wgid % nig) % gsz); u.pn = (wgid % nig) / gsz; u.e = 0; return true;
    }
};
struct MoeOrder {
    int nblk, nN, G, c; const int* block_e;
    __device__ bool next(int i, Unit& u) const {
        const long L = (long)i * G + c; if (L >= (long)nblk * nN) return false;
        u.pm = (int)(L / nN); u.pn = (int)(L % nN); u.e = __builtin_amdgcn_readfirstlane(block_e[u.pm]); return true;
    }
};
__device__ __forceinline__ unsigned cvt_pk_bf16(float lo, float hi) { unsigned r; asm volatile("v_cvt_pk_bf16_f32 %0, %1, %2" : "=v"(r) : "v"(lo), "v"(hi)); return r; }
struct EpiF32 {
    static constexpr bool PERM = false;
    float* C; int ldc;
    __device__ __forceinline__ void operator()(const f32x4 (&acc)[2][2][4][2], const Unit& u, int wr, int wc, int fr, int fq) const {
        const int row0 = u.pm * BM + wr * 64 + fr, col0 = u.pn * BM + wc * 32 + 4 * fq;
#pragma unroll
        for (int ai = 0; ai < 2; ++ai)
#pragma unroll
            for (int m = 0; m < 4; ++m) { float* rowp = C + (size_t)(row0 + ai * HALF + m * 16) * ldc + col0;
#pragma unroll
                for (int bj = 0; bj < 2; ++bj)
#pragma unroll
                    for (int n = 0; n < 2; ++n) *(f32x4*)(rowp + bj * HALF + n * 16) = acc[ai][bj][m][n]; }
    }
};
struct EpiBf16Bias {
    static constexpr bool PERM = true;
    bf16_t* O; int ldc; const float* bias; int bias_estride;
    __device__ __forceinline__ void operator()(const f32x4 (&acc)[2][2][4][2], const Unit& u, int wr, int wc, int fr, int fq) const {
        const int row0 = u.pm * BM + wr * 64 + fr, col0 = u.pn * BM + wc * 32 + 8 * fq; const float* bp = bias + (size_t)u.e * bias_estride + col0;
        f32x4 bv[2][2];
#pragma unroll
        for (int bj = 0; bj < 2; ++bj)
#pragma unroll
            for (int n = 0; n < 2; ++n) bv[bj][n] = bias ? *(const f32x4*)(bp + bj * HALF + 4 * n) : (f32x4){0.f, 0.f, 0.f, 0.f};
#pragma unroll
        for (int ai = 0; ai < 2; ++ai)
#pragma unroll
            for (int m = 0; m < 4; ++m) { bf16_t* rowp = O + (size_t)(row0 + ai * HALF + m * 16) * ldc + col0;
#pragma unroll
                for (int bj = 0; bj < 2; ++bj) { const f32x4 v0 = acc[ai][bj][m][0] + bv[bj][0], v1 = acc[ai][bj][m][1] + bv[bj][1];
                    u32x4 w; w.x = cvt_pk_bf16(v0[0], v0[1]); w.y = cvt_pk_bf16(v0[2], v0[3]); w.z = cvt_pk_bf16(v1[0], v1[1]); w.w = cvt_pk_bf16(v1[2], v1[3]);
                    *(u32x4*)(rowp + bj * HALF) = w; } }
    }
};
__device__ __forceinline__ float swiglu1(float g, float lin) { g = fminf(g, 7.0f); lin = fminf(fmaxf(lin, -7.0f), 7.0f); return g / (1.0f + __expf(-1.702f * g)) * (lin + 1.0f); }
struct EpiSwiglu {
    static constexpr bool PERM = true;
    bf16_t* O; int ldc; const float* bias; int bias_estride;
    __device__ __forceinline__ void operator()(const f32x4 (&acc)[2][2][4][2], const Unit& u, int wr, int wc, int fr, int fq) const {
        const int row0 = u.pm * BM + wr * 64 + fr, col0 = u.pn * BM + wc * 32 + 8 * fq; const float* bp = bias + (size_t)u.e * bias_estride + col0;
        f32x4 bv[2][2];
#pragma unroll
        for (int bj = 0; bj < 2; ++bj)
#pragma unroll
            for (int n = 0; n < 2; ++n) bv[bj][n] = *(const f32x4*)(bp + bj * HALF + 4 * n);
#pragma unroll
        for (int ai = 0; ai < 2; ++ai)
#pragma unroll
            for (int m = 0; m < 4; ++m) { bf16_t* rowp = O + (size_t)(row0 + ai * HALF + m * 16) * ldc + (col0 >> 1);
#pragma unroll
                for (int bj = 0; bj < 2; ++bj) { const f32x4 v0 = acc[ai][bj][m][0] + bv[bj][0], v1 = acc[ai][bj][m][1] + bv[bj][1];
                    u32x2 w; w.x = cvt_pk_bf16(swiglu1(v0[0], v0[1]), swiglu1(v0[2], v0[3])); w.y = cvt_pk_bf16(swiglu1(v1[0], v1[1]), swiglu1(v1[2], v1[3]));
                    *(u32x2*)(rowp + bj * (HALF / 2)) = w; } }
    }
};

template <class Epi, class Sched>
__device__ __forceinline__ void gemm_phase(PG8_LAS unsigned char* lds, const Gemm g, const Sched& S, const Epi& E) {
    int tid = threadIdx.x; asm volatile("" : "+v"(tid));
    const int wid = __builtin_amdgcn_readfirstlane(tid >> 6), lane = tid & 63, wr = wid >> 2, wc = wid & 3, fr = lane & 15, fq = lane >> 4;
    const int K = g.K, nt = K / BK;
    unsigned voffA[2], voffB[2];
#pragma unroll
    for (int i = 0; i < 2; ++i) { int R, C; stage_rc(tid * 16 + i * 8192, R, C); const int Rb = Epi::PERM ? ((R & ~31) + perm32(R & 31)) : R;
        voffA[i] = (unsigned)(R * K + C) * 2u; voffB[i] = (unsigned)(Rb * K + C) * 2u; }
    const size_t kstep = (size_t)(BK * 2);
    const size_t hstep = (size_t)HALF * K * 2;
    const size_t tstep = 2 * hstep;
    const unsigned ldsw = (unsigned)wid * 1024u;
    const int aoff = lds_byte(wr * 64 + fr, fq * 8), boff = lds_byte(wc * 32 + fr, fq * 8);
#define PG8_SA(b, h) (((b) * 2 + (h)) * HTB)
#define PG8_SB(b, h) ((4 + (b) * 2 + (h)) * HTB)
#define PG8_STAGE(bufoff, gbase, voff) do { _Pragma("unroll") for (int _i = 0; _i < 2; ++_i) \
        __builtin_amdgcn_global_load_lds((const unsigned*)((const char*)(gbase) + (voff)[_i]), (PG8_LAS unsigned*)(lds + (bufoff) + ldsw + _i * 8192), 16, 0, 0); } while (0)
#define PG8_LDA(dst, b, h) do { _Pragma("unroll") for (int m = 0; m < 4; ++m) _Pragma("unroll") for (int k = 0; k < 2; ++k) dst[m][k] = *(const PG8_LAS bf16x8*)(lds + PG8_SA(b, h) + aoff + m * 2048 + k * 1024); } while (0)
#define PG8_LDB(dst, b, h) do { _Pragma("unroll") for (int n = 0; n < 2; ++n) _Pragma("unroll") for (int k = 0; k < 2; ++k) dst[n][k] = *(const PG8_LAS bf16x8*)(lds + PG8_SB(b, h) + boff + n * 2048 + k * 1024); } while (0)
#define PG8_MMA(ai, bj, At, Bt) do { __builtin_amdgcn_s_setprio(1); _Pragma("unroll") for (int m = 0; m < 4; ++m) _Pragma("unroll") for (int n = 0; n < 2; ++n) _Pragma("unroll") for (int k = 0; k < 2; ++k) \
        acc[ai][bj][m][n] = __builtin_amdgcn_mfma_f32_16x16x32_bf16(Bt[n][k], At[m][k], acc[ai][bj][m][n], 0, 0, 0); __builtin_amdgcn_s_setprio(0); } while (0)
#define PG8_WAIT_V(n) asm volatile("s_waitcnt vmcnt(" #n ")" ::: "memory")
#define PG8_WAIT_L(n) asm volatile("s_waitcnt lgkmcnt(" #n ")" ::: "memory")
#define PG8_BAR __builtin_amdgcn_s_barrier()
#define PG8_SCHED __builtin_amdgcn_sched_barrier(0)
    Unit cur, nxt; int ui = 0;
    if (!S.next(0, cur)) return;
    f32x4 acc[2][2][4][2];
#pragma unroll
    for (int a = 0; a < 2; ++a)
#pragma unroll
        for (int b = 0; b < 2; ++b)
#pragma unroll
            for (int m = 0; m < 4; ++m)
#pragma unroll
                for (int n = 0; n < 2; ++n) acc[a][b][m][n] = (f32x4){0.f, 0.f, 0.f, 0.f};
    bf16x8 At[4][2], B0[2][2], B1[2][2];
    const char* cA = (const char*)g.A + (size_t)cur.pm * tstep; const char* cB = (const char*)(g.Bt + (size_t)cur.e * g.estride) + (size_t)cur.pn * tstep;
    PG8_STAGE(PG8_SB(0, 0), cB, voffB); PG8_STAGE(PG8_SB(0, 1), cB + hstep, voffB); PG8_STAGE(PG8_SA(0, 0), cA, voffA); PG8_STAGE(PG8_SA(0, 1), cA + hstep, voffA);
    if (wr == 1) PG8_BAR;
    PG8_WAIT_V(2); PG8_BAR;
    PG8_STAGE(PG8_SB(1, 0), cB + kstep, voffB); PG8_STAGE(PG8_SA(1, 0), cA + kstep, voffA); PG8_STAGE(PG8_SB(1, 1), cB + hstep + kstep, voffB);
    PG8_WAIT_V(6); PG8_BAR;
    for (;;) {
        const bool has_next = S.next(ui + 1, nxt);
        const char* nA = has_next ? (const char*)g.A + (size_t)nxt.pm * tstep : cA; const char* nB = has_next ? (const char*)(g.Bt + (size_t)nxt.e * g.estride) + (size_t)nxt.pn * tstep : cB;
        for (int t = 0; t < nt; t += 2) {
            const bool last = (t == nt - 2);
            const char* a1 = cA + (size_t)(t + 1) * kstep;
            const char* a2 = last ? nA : cA + (size_t)(t + 2) * kstep; const char* b2 = last ? nB : cB + (size_t)(t + 2) * kstep;
            const char* a3 = a2 + kstep; const char* b3 = b2 + kstep;
            PG8_LDB(B0, 0, 0); PG8_LDB(B1, 0, 1); PG8_SCHED; PG8_LDA(At, 0, 0); PG8_STAGE(PG8_SA(1, 1), a1 + hstep, voffA);
            PG8_WAIT_V(8); PG8_WAIT_L(0); PG8_BAR; PG8_MMA(0, 0, At, B0); PG8_MMA(0, 1, At, B1); PG8_BAR; PG8_SCHED;
            PG8_LDA(At, 0, 1); PG8_STAGE(PG8_SB(0, 0), b2, voffB); PG8_STAGE(PG8_SB(0, 1), b2 + hstep, voffB); PG8_STAGE(PG8_SA(0, 0), a2, voffA);
            PG8_WAIT_V(8); PG8_WAIT_L(0); PG8_BAR; PG8_MMA(1, 0, At, B0); PG8_MMA(1, 1, At, B1); PG8_BAR; PG8_SCHED;
            PG8_LDB(B0, 1, 0); PG8_LDB(B1, 1, 1); PG8_SCHED; PG8_LDA(At, 1, 0); PG8_STAGE(PG8_SA(0, 1), a2 + hstep, voffA);
            PG8_WAIT_V(8); PG8_WAIT_L(0); PG8_BAR; PG8_MMA(0, 0, At, B0); PG8_MMA(0, 1, At, B1); PG8_BAR; PG8_SCHED;
            PG8_LDA(At, 1, 1); PG8_STAGE(PG8_SB(1, 0), b3, voffB); PG8_STAGE(PG8_SB(1, 1), b3 + hstep, voffB); PG8_STAGE(PG8_SA(1, 0), a3, voffA);
            PG8_WAIT_V(8); PG8_WAIT_L(0); PG8_BAR; PG8_MMA(1, 0, At, B0); PG8_MMA(1, 1, At, B1); PG8_BAR; PG8_SCHED;
        }
        if (wr == 0) PG8_BAR;
        E(acc, cur, wr, wc, fr, fq);
        if (!has_next) break;
#pragma unroll
        for (int a = 0; a < 2; ++a)
#pragma unroll
            for (int b = 0; b < 2; ++b)
#pragma unroll
                for (int m = 0; m < 4; ++m)
#pragma unroll
                    for (int n = 0; n < 2; ++n) acc[a][b][m][n] = (f32x4){0.f, 0.f, 0.f, 0.f};
        cur = nxt; cA = nA; cB = nB; ++ui;
        if (wr == 1) PG8_BAR;
    }
    PG8_WAIT_V(0);
    PG8_BAR;
#undef PG8_SA
#undef PG8_SB
#undef PG8_STAGE
#undef PG8_LDA
#undef PG8_LDB
#undef PG8_MMA
#undef PG8_WAIT_V
#undef PG8_WAIT_L
#undef PG8_BAR
#undef PG8_SCHED
}
}

#define XB_TMO      128
#define XB_XCNT(j)  (256  + 64 * (j))
#define XB_XSUB(j)  (1280 + 64 * (j))
#define XB_XGEN(j)  (2304 + 64 * (j))
#define XB_TOP      3328
#define XB_TOPGEN   3392
#define XCD_BAR_WORDS 3456
#define XB_SPIN_CAP (1u << 22)
#define LAS __attribute__((address_space(3)))
__device__ __forceinline__ unsigned xb_ld(unsigned* p)              { return __hip_atomic_load(p, __ATOMIC_RELAXED, __HIP_MEMORY_SCOPE_AGENT); }
__device__ __forceinline__ unsigned xb_add(unsigned* p, unsigned v) { return __hip_atomic_fetch_add(p, v, __ATOMIC_RELAXED, __HIP_MEMORY_SCOPE_AGENT); }
__device__ __forceinline__ unsigned xb_xcc_id() { return (unsigned)__builtin_amdgcn_s_getreg((3 << 11) | 20) & 0xFu; }
#define XB_SPIN(cond, bar) do { unsigned _sp = 0; while (cond) { __builtin_amdgcn_s_sleep(1); \
    if ((++_sp & 255u) == 0u) { if (xb_ld(&(bar)[XB_TMO])) break; if (_sp > XB_SPIN_CAP) { atomicAdd(&(bar)[XB_TMO], 1u); break; } } } } while (0)
struct XcdBarrier { unsigned* bar; unsigned x; volatile LAS unsigned* st; };
__device__ __forceinline__ XcdBarrier xcd_barrier_post(unsigned* bar, volatile LAS unsigned* st) {
    XcdBarrier b; b.bar = bar; b.x = xb_xcc_id(); b.st = st;
    if (threadIdx.x == 0) (void)xb_add(&bar[XB_XCNT(b.x)], 1u);
    return b;
}
__device__ __forceinline__ void xcd_barrier_complete(unsigned* bar, unsigned x, unsigned& nloc, unsigned& nx) {
    const unsigned G = gridDim.x * gridDim.y * gridDim.z;
    unsigned sum, cnt, mine, sp = 0u;
    for (;;) {
        sum = 0u; cnt = 0u; mine = 0u;
#pragma unroll
        for (unsigned j = 0; j < 16; ++j) { const unsigned c = xb_ld(&bar[XB_XCNT(j)]); sum += c; cnt += (c > 0u) ? 1u : 0u; mine = (j == x) ? c : mine; }
        if (sum == G) break;
        __builtin_amdgcn_s_sleep(1);
        if ((++sp & 255u) == 0u) { if (xb_ld(&bar[XB_TMO])) break; if (sp > XB_SPIN_CAP) { atomicAdd(&bar[XB_TMO], 1u); break; } }
    }
    nloc = mine > 0u ? mine : 1u; nx = cnt > 0u ? cnt : 1u;
}
__device__ __forceinline__ void xcd_barrier(const XcdBarrier& b) {
    asm volatile("s_waitcnt vmcnt(0)" ::: "memory");
    __syncthreads();
    if (threadIdx.x == 0) {
        unsigned* bar = b.bar;
        __builtin_amdgcn_s_waitcnt(0);
        unsigned nloc = b.st[0], nx = b.st[1];
        if (nloc == 0u) { xcd_barrier_complete(bar, b.x, nloc, nx); b.st[0] = nloc; b.st[1] = nx; }
        const unsigned old = xb_add(&bar[XB_XSUB(b.x)], 1u);
        const unsigned gen = old / nloc;
        if (old + 1u == (gen + 1u) * nloc) {
            __builtin_amdgcn_fence(__ATOMIC_RELEASE, "agent");
            asm volatile("s_waitcnt vmcnt(0)" ::: "memory");
            const unsigned og = xb_add(&bar[XB_TOP], 1u);
            const unsigned tg = og / nx;
            if (og + 1u == (tg + 1u) * nx) xb_add(&bar[XB_TOPGEN], 1u);
            else XB_SPIN(xb_ld(&bar[XB_TOPGEN]) == tg, bar);
            __builtin_amdgcn_fence(__ATOMIC_ACQUIRE, "agent");
            xb_add(&bar[XB_XGEN(b.x)], 1u);
            asm volatile("s_waitcnt vmcnt(0)" ::: "memory");
        } else {
            XB_SPIN(xb_ld(&bar[XB_XGEN(b.x)]) == gen, bar);
            __builtin_amdgcn_fence(__ATOMIC_ACQUIRE, "agent");
            asm volatile("s_waitcnt vmcnt(0)" ::: "memory");
        }
    }
    __syncthreads();
}


constexpr int NWAVES = 8, NTHR = 512;
typedef float f32x4_t __attribute__((ext_vector_type(4)));
typedef unsigned u32x2_t __attribute__((ext_vector_type(2)));
typedef unsigned u32x4_t __attribute__((ext_vector_type(4)));
typedef short bf16x8_t __attribute__((ext_vector_type(8)));
__device__ __forceinline__ float wave_sum(float v) {
#pragma unroll
    for (int o = 1; o < 64; o <<= 1) v += __shfl_xor(v, o);
    return v;
}
__device__ __forceinline__ float grp16_sum(float v) {
#pragma unroll
    for (int o = 1; o < 16; o <<= 1) v += __shfl_xor(v, o);
    return v;
}
__device__ __forceinline__ float hsum4(f32x4_t a) { return (a.x + a.y) + (a.z + a.w); }
__device__ __forceinline__ float hsq4(f32x4_t a) { return (a.x * a.x + a.y * a.y) + (a.z * a.z + a.w * a.w); }
__device__ __forceinline__ u32x2_t pk4(f32x4_t t) { u32x2_t w; w.x = pg8::cvt_pk_bf16(t.x, t.y); w.y = pg8::cvt_pk_bf16(t.z, t.w); return w; }
__device__ __forceinline__ float bflo(unsigned w) { return __builtin_bit_cast(float, w << 16); }
__device__ __forceinline__ float bfhi(unsigned w) { return __builtin_bit_cast(float, w & 0xffff0000u); }
template <bool TO_LDS> __device__ __forceinline__ void norm_mod_store(const f32x4_t (&v)[4], float rstd, const float* pn, const float* sh, const float* sc, bf16_t* orow, LAS unsigned char* lrow, int lane) {
#pragma unroll
    for (int j = 0; j < 4; ++j) { const int k = 4 * lane + 256 * j;
        const f32x4_t pv = *(const f32x4_t*)(pn + k), sv = *(const f32x4_t*)(sc + k), hv = *(const f32x4_t*)(sh + k);
        const f32x4_t t = v[j] * rstd * pv * (1.0f + sv) + hv; const u32x2_t w = pk4(t);
        *(u32x2_t*)(orow + k) = w; if (TO_LDS) *(LAS u32x2_t*)(lrow + 2 * k) = w; }
}
__device__ __forceinline__ void dev_norm1_l0(const P& p, int gw, int ngw, int lane) {
    const float* md0 = p.MOD(); const float* pn = p.pre_norm;
    for (int m = gw; m < NTOK; m += ngw) {
        const float* src = m < NLAT ? p.x + (size_t)m * D : p.ctx + (size_t)(m - NLAT) * D;
        f32x4_t v[4]; float ss = 0.f;
#pragma unroll
        for (int j = 0; j < 4; ++j) { v[j] = *(const f32x4_t*)(src + 4 * lane + 256 * j); ss += hsq4(v[j]); *(f32x4_t*)(p.X() + (size_t)m * D + 4 * lane + 256 * j) = v[j]; }
        const float rstd = 1.0f / sqrtf(wave_sum(ss) * (1.0f / D) + 1e-6f);
        const float* md = md0 + (size_t)mod_row(m) * 6 * D;
        norm_mod_store<false>(v, rstd, pn, md, md + D, p.HB() + (size_t)m * D, (LAS unsigned char*)0, lane);
    }
}
__device__ __forceinline__ void dev_post(const P& p, int l, int ntok_l, int gw, int ngw, int lane) {
    const int h = lane >> 4;
    for (int m = gw; m < ntok_l; m += ngw) {
        {
            const f32x4_t y = *(const f32x4_t*)(p.YA() + (size_t)m * A_W + 4 * lane) + *(const f32x4_t*)(p.YA() + ((size_t)NTOK + m) * A_W + 4 * lane);
            const float mean = grp16_sum(hsum4(y)) * (1.0f / 64.f); const f32x4_t d = y - mean;
            const float var = grp16_sum(hsq4(d)) * (1.0f / 64.f); const float rs = 1.0f / sqrtf(var + 64e-5f);
            const f32x4_t lw = *(const f32x4_t*)(p.rw_ln_w + l * A_W + 4 * lane), lb = *(const f32x4_t*)(p.rw_ln_b + l * A_W + 4 * lane);
            const f32x4_t vv = *(const f32x4_t*)(p.RW_V() + (size_t)m * A_W + 4 * lane), gt = *(const f32x4_t*)(p.RW_GATE() + (size_t)m * A_W + 4 * lane);
            const float bon = p.RW_BON()[(size_t)m * A_H + h];
            const f32x4_t o = (d * rs * lw + lb + bon * vv) * gt;
            *(u32x2_t*)(p.MIX() + (size_t)m * D + 4 * lane) = pk4(o);
        }
        {
            const float* o0 = p.OB() + (size_t)m * B_W + 8 * lane; const float* o1 = p.OB() + ((size_t)NTOK + m) * B_W + 8 * lane;
            const f32x4_t a = *(const f32x4_t*)o0 + *(const f32x4_t*)o1, b = *(const f32x4_t*)(o0 + 4) + *(const f32x4_t*)(o1 + 4);
            const float rs = 1.0f / sqrtf(grp16_sum(hsq4(a) + hsq4(b)) * (1.0f / 128.f) + 1e-6f);
            const u32x4_t zr = *(const u32x4_t*)(p.U() + (size_t)m * INP + B_OFF + 1536 + 8 * lane);
            const float* nw = p.gdn_norm + l * 128 + ((8 * lane) & 127);
            const f32x4_t n0 = *(const f32x4_t*)nw, n1 = *(const f32x4_t*)(nw + 4);
            const f32x4_t z0 = {bflo(zr.x), bfhi(zr.x), bflo(zr.y), bfhi(zr.y)}, z1 = {bflo(zr.z), bfhi(zr.z), bflo(zr.w), bfhi(zr.w)};
            f32x4_t s0, s1;
#pragma unroll
            for (int c = 0; c < 4; ++c) { s0[c] = z0[c] / (1.0f + __expf(-z0[c])); s1[c] = z1[c] / (1.0f + __expf(-z1[c])); }
            const f32x4_t r0 = a * rs * n0 * s0, r1 = b * rs * n1 * s1;
            u32x4_t w; const u32x2_t w0 = pk4(r0), w1 = pk4(r1); w.x = w0.x; w.y = w0.y; w.z = w1.x; w.w = w1.y;
            *(u32x4_t*)(p.MIX() + (size_t)m * D + 256 + 8 * lane) = w;
        }
    }
}
constexpr int RT_TK = 0, RT_TKS = 2064, RT_PL = 34816, RT_LG = RT_PL + 16384, RT_CNT = RT_LG + 2304, RT_BASE = RT_CNT + 128, RT_ASG = RT_BASE + 128, RT_ASG_MAX = 4096;
__device__ __forceinline__ void dev_resid_router(const P& p, int l, int ntok_l, LAS unsigned char* lds, int G, int tid) {
    const int lane = tid & 63, wave = tid >> 6;
    LAS int* LCNT = (LAS int*)(lds + RT_CNT); LAS int* LBASE = (LAS int*)(lds + RT_BASE); LAS int* ASG = (LAS int*)(lds + RT_ASG);
    LAS float* PL = (LAS float*)(lds + RT_PL); LAS float* LG = (LAS float*)(lds + RT_LG);
    if (tid < 32) LCNT[tid] = 0;
    __syncthreads();
    const float* pn = p.post_norm + (size_t)(l * 2 + 0) * D; const float* pn2 = p.pre_norm + (size_t)(l * 2 + 1) * D;
    const int ngrp = ntok_l / 16; int it = 0;
    for (int grp = blockIdx.x; grp < ngrp; grp += G, ++it) {
#pragma unroll 1
        for (int rr = 0; rr < 2; ++rr) {
            const int ri = wave * 2 + rr, m = grp * 16 + ri;
            const float* mo = p.MO() + (size_t)m * D; float* xr = p.X() + (size_t)m * D; const float* md = p.MOD() + ((size_t)l * (BATCH + 1) + mod_row(m)) * 6 * D;
            f32x4_t v[4], x[4]; float ss = 0.f;
#pragma unroll
            for (int j = 0; j < 4; ++j) { v[j] = *(const f32x4_t*)(mo + 4 * lane + 256 * j); x[j] = *(const f32x4_t*)(xr + 4 * lane + 256 * j); ss += hsq4(v[j]); }
            const float rstd = 1.0f / sqrtf(wave_sum(ss) * (1.0f / D) + 1e-6f); float s2 = 0.f;
#pragma unroll
            for (int j = 0; j < 4; ++j) { const int k = 4 * lane + 256 * j; const f32x4_t g1 = *(const f32x4_t*)(md + 2 * D + k), pv = *(const f32x4_t*)(pn + k);
                x[j] = x[j] + g1 * (v[j] * rstd) * pv; s2 += hsq4(x[j]); *(f32x4_t*)(xr + k) = x[j]; }
            const float r2 = 1.0f / sqrtf(wave_sum(s2) * (1.0f / D) + 1e-6f);
            norm_mod_store<true>(x, r2, pn2, md + 3 * D, md + 4 * D, p.HB() + (size_t)m * D, lds + RT_TK + ri * RT_TKS, lane);
        }
        __syncthreads();
        {
            const int i = lane & 15, q = lane >> 4; pg8::f32x4 acc0 = {0.f, 0.f, 0.f, 0.f}, acc1 = {0.f, 0.f, 0.f, 0.f};
#pragma unroll
            for (int ks = 0; ks < 4; ++ks) { const int k0 = 128 * wave + 32 * ks + 8 * q;
                const bf16x8_t a = *(const LAS bf16x8_t*)(lds + RT_TK + i * RT_TKS + 2 * k0);
                const bf16x8_t b0 = *(const bf16x8_t*)(p.WR_T() + (size_t)i * D + k0), b1 = *(const bf16x8_t*)(p.WR_T() + (size_t)(16 + i) * D + k0);
                acc0 = __builtin_amdgcn_mfma_f32_16x16x32_bf16(a, b0, acc0, 0, 0, 0); acc1 = __builtin_amdgcn_mfma_f32_16x16x32_bf16(a, b1, acc1, 0, 0, 0); }
#pragma unroll
            for (int r = 0; r < 4; ++r) { PL[(wave * 16 + 4 * q + r) * 32 + i] = acc0[r]; PL[(wave * 16 + 4 * q + r) * 32 + 16 + i] = acc1[r]; }
        }
        __syncthreads();
        {
            const int ri = tid >> 5, e = tid & 31; float sacc = p.router_b[l * NEXP + e];
#pragma unroll
            for (int w = 0; w < 8; ++w) sacc += PL[(w * 16 + ri) * 32 + e];
            LG[ri * 33 + e] = sacc;
        }
        __syncthreads();
        if (tid < 16) {
            const int m = grp * 16 + tid; float lg[NEXP];
#pragma unroll
            for (int e = 0; e < NEXP; ++e) lg[e] = LG[tid * 33 + e];
            int idx[TOPK]; float val[TOPK];
#pragma unroll
            for (int j = 0; j < TOPK; ++j) { float best = -3.0e38f; int bi = 0;
#pragma unroll
                for (int e = 0; e < NEXP; ++e) { if (lg[e] > best) { best = lg[e]; bi = e; } }
                idx[j] = bi; val[j] = best;
#pragma unroll
                for (int e = 0; e < NEXP; ++e) if (e == bi) lg[e] = -3.0e38f; }
            float sum = 0.f, ex[TOPK];
#pragma unroll
            for (int j = 0; j < TOPK; ++j) { ex[j] = __expf(val[j] - val[0]); sum += ex[j]; }
            const float inv = 1.0f / sum;
#pragma unroll
            for (int j = 0; j < TOPK; ++j) { p.TOPI()[(size_t)m * TOPK + j] = idx[j]; p.TOPG()[(size_t)m * TOPK + j] = ex[j] * inv;
                const int lp = __hip_atomic_fetch_add(&LCNT[idx[j]], 1, __ATOMIC_RELAXED, __HIP_MEMORY_SCOPE_WORKGROUP);
                const int ai = (it * 16 + tid) * 4 + j; if (ai < RT_ASG_MAX) ASG[ai] = (idx[j] << 20) | lp; }
        }
        __syncthreads();
    }
    if (tid < 32) LBASE[tid] = LCNT[tid] > 0 ? atomicAdd(&p.cnt()[l * NEXP + tid], LCNT[tid]) : 0;
    __syncthreads();
    for (int a = tid; a < it * 64 && a < RT_ASG_MAX; a += NTHR) { const int w = ASG[a]; const int e = w >> 20, lp = w & 0xfffff; const int itx = a / 64, ri = (a % 64) / 4, j = a % 4;
        const int m = (blockIdx.x + itx * G) * 16 + ri; p.POS()[(size_t)m * TOPK + j] = LBASE[e] + lp; }
    __syncthreads();
}
__device__ __forceinline__ void dev_slots(const P& p, int l, int ntok_l, LAS unsigned char* lds, long gtid, long nthr, int tid) {
    LAS int* PST = (LAS int*)lds; LAS int* CN = (LAS int*)(lds + 256);
    if (tid == 0) { int acc = 0; for (int e = 0; e < NEXP; ++e) { const int c = p.cnt()[l * NEXP + e]; PST[e] = acc; CN[e] = c; acc += (c + 255) / 256 * 256; } PST[NEXP] = acc; }
    __syncthreads();
    for (long t = gtid; t < (long)ntok_l * TOPK; t += nthr) { const int e = p.TOPI()[t]; const int slot = PST[e] + p.POS()[t]; p.TSLOT()[t] = slot; p.SLOT_TOK()[slot] = (int)(t / TOPK); }
    for (long t = gtid; t < NEXP * 256; t += nthr) { const int e = (int)(t >> 8), i = (int)(t & 255); const int c = CN[e]; const int pads = (c + 255) / 256 * 256 - c; if (i < pads) p.SLOT_TOK()[PST[e] + c + i] = ZROW; }
    for (long t = gtid; t < NBLK_MAX; t += nthr) { int e_of = NEXP - 1;
        for (int e = 0; e < NEXP; ++e) { if ((int)t * 256 >= PST[e] && (int)t * 256 < PST[e + 1]) e_of = e; }
        p.BLOCK_E()[t] = e_of; if (t == 0) p.NBLK()[0] = PST[NEXP] / 256; }
    __syncthreads();
}
__device__ __forceinline__ void dev_combine(const P& p, int l, int ntok_l, int gw, int ngw, int lane) {
    const bool last = (l == DEPTH - 1); const float* pn = p.post_norm + (size_t)(l * 2 + 1) * D;
    for (int m = gw; m < ntok_l; m += ngw) {
        const int4 sl = *(const int4*)(p.TSLOT() + (size_t)m * 4); const f32x4_t gt = *(const f32x4_t*)(p.TOPG() + (size_t)m * 4);
        const bf16_t* y0 = p.YB() + (size_t)sl.x * D; const bf16_t* y1 = p.YB() + (size_t)sl.y * D; const bf16_t* y2 = p.YB() + (size_t)sl.z * D; const bf16_t* y3 = p.YB() + (size_t)sl.w * D;
        float* xr = p.X() + (size_t)m * D; const float* md = p.MOD() + ((size_t)l * (BATCH + 1) + mod_row(m)) * 6 * D;
        f32x4_t f[4], x[4]; float ss = 0.f;
#pragma unroll
        for (int j = 0; j < 4; ++j) { const int k = 4 * lane + 256 * j;
            const u32x2_t a = *(const u32x2_t*)(y0 + k), b = *(const u32x2_t*)(y1 + k), c = *(const u32x2_t*)(y2 + k), d = *(const u32x2_t*)(y3 + k);
            f[j].x = gt.x * bflo(a.x) + gt.y * bflo(b.x) + gt.z * bflo(c.x) + gt.w * bflo(d.x); f[j].y = gt.x * bfhi(a.x) + gt.y * bfhi(b.x) + gt.z * bfhi(c.x) + gt.w * bfhi(d.x);
            f[j].z = gt.x * bflo(a.y) + gt.y * bflo(b.y) + gt.z * bflo(c.y) + gt.w * bflo(d.y); f[j].w = gt.x * bfhi(a.y) + gt.y * bfhi(b.y) + gt.z * bfhi(c.y) + gt.w * bfhi(d.y);
            ss += hsq4(f[j]); x[j] = *(const f32x4_t*)(xr + k); }
        const float rstd = 1.0f / sqrtf(wave_sum(ss) * (1.0f / D) + 1e-6f); float s2 = 0.f;
#pragma unroll
        for (int j = 0; j < 4; ++j) { const int k = 4 * lane + 256 * j; const f32x4_t g2 = *(const f32x4_t*)(md + 5 * D + k), pv = *(const f32x4_t*)(pn + k);
            x[j] = x[j] + g2 * (f[j] * rstd) * pv; s2 += hsq4(x[j]);
#if defined(PROBE_GDN) || defined(PROBE_RWKV)
            if (last) { const float e = ((const float*)(p.ctl() + 12000))[0], r = ((const float*)(p.ctl() + 12001))[0]; x[j] = x[j] * (1.0f + 10.0f * sqrtf(e / r)); }
#endif
            if (last) *(f32x4_t*)(p.out + (size_t)m * D + k) = x[j]; else *(f32x4_t*)(xr + k) = x[j]; }
        if (!last) { const float r2 = 1.0f / sqrtf(wave_sum(s2) * (1.0f / D) + 1e-6f); const float* md1 = p.MOD() + ((size_t)(l + 1) * (BATCH + 1) + mod_row(m)) * 6 * D;
            norm_mod_store<false>(x, r2, p.pre_norm + (size_t)((l + 1) * 2 + 0) * D, md1, md1 + D, p.HB() + (size_t)m * D, (LAS unsigned char*)0, lane); }
    }
}

#define MMA16(a, b, c) __builtin_amdgcn_mfma_f32_16x16x32_bf16((a), (b), (c), 0, 0, 0)
typedef pg8::f32x4 f32x4;
__device__ __forceinline__ bf16x8_t lfrag(LAS const unsigned char* lds, int off, int ld, int row0, int k0, int lane) {
    return *(LAS const bf16x8_t*)(lds + off + (row0 + (lane & 15)) * ld + (k0 + 8 * (lane >> 4)) * 2);
}
__device__ __forceinline__ bf16x8_t lfrag16(LAS const unsigned char* lds, int off, int ld, int row0, int k0, int lane) {
    bf16x8_t z = {0, 0, 0, 0, 0, 0, 0, 0}; return (lane >> 4) < 2 ? lfrag(lds, off, ld, row0, k0, lane) : z;
}
__device__ __forceinline__ bf16x8_t lfragT(LAS const unsigned char* lds, int off, int ld, int k0, int n0, int kvalid, int lane) {
    bf16x8_t v; const int n = n0 + (lane & 15), kb = 8 * (lane >> 4);
#pragma unroll
    for (int j = 0; j < 8; ++j) v[j] = (kb + j < kvalid) ? *(LAS const short*)(lds + off + (k0 + kb + j) * ld + n * 2) : (short)0;
    return v;
}
__device__ __forceinline__ void st_rm(LAS unsigned char* lds, int off, int ld, int m0, int n0, f32x4 acc, int lane) {
#pragma unroll
    for (int r = 0; r < 4; ++r) *(LAS bf16_t*)(lds + off + (m0 + 4 * (lane >> 4) + r) * ld + (n0 + (lane & 15)) * 2) = f2bf(acc[r]);
}
__device__ __forceinline__ void st_tr(LAS unsigned char* lds, int off, int ld, int m0, int n0, f32x4 acc, int lane) {
    u32x2_t w; w.x = pg8::cvt_pk_bf16(acc[0], acc[1]); w.y = pg8::cvt_pk_bf16(acc[2], acc[3]);
    *(LAS u32x2_t*)(lds + off + (n0 + (lane & 15)) * ld + (m0 + 4 * (lane >> 4)) * 2) = w;
}
__device__ __forceinline__ u32x4_t scale8(u32x4_t v, float s) {
    u32x4_t o; o.x = pg8::cvt_pk_bf16(bflo(v.x) * s, bfhi(v.x) * s); o.y = pg8::cvt_pk_bf16(bflo(v.y) * s, bfhi(v.y) * s);
    o.z = pg8::cvt_pk_bf16(bflo(v.z) * s, bfhi(v.z) * s); o.w = pg8::cvt_pk_bf16(bflo(v.w) * s, bfhi(v.w) * s); return o;
}

template <int LOFF, int TOFF, int SCOFF>
__device__ __forceinline__ void tri_inv64(LAS unsigned char* lds, int tid) {
    const int wave = __builtin_amdgcn_readfirstlane(tid >> 6); int lane = tid & 63, q4 = lane >> 4, l16 = lane & 15;
    if (wave == 0) {
        float x[16];
#pragma unroll
        for (int i = 0; i < 16; ++i) { float sacc = (i == l16) ? 1.f : 0.f;
#pragma unroll
            for (int j = 0; j < i; ++j) sacc -= bf2f(*(LAS const bf16_t*)(lds + LOFF + (16 * q4 + i) * 144 + (16 * q4 + j) * 2)) * x[j];
            x[i] = sacc; asm volatile("" ::: "memory"); }
#pragma unroll
        for (int i = 0; i < 16; ++i) *(LAS bf16_t*)(lds + TOFF + (16 * q4 + i) * 144 + (16 * q4 + l16) * 2) = f2bf(x[i]);
    }
    __syncthreads(); asm volatile("" : "+v"(tid)); lane = tid & 63;
    if (wave < 2) {
        const int I = 2 * wave + 1, J = 2 * wave; const f32x4 z = {0.f, 0.f, 0.f, 0.f};
        const f32x4 m1 = MMA16(lfrag16(lds, LOFF, 144, 16 * I, 16 * J, lane), lfragT(lds, TOFF, 144, 16 * J, 16 * J, 16, lane), z);
        st_rm(lds, SCOFF + wave * 1280, 80, 0, 0, m1, lane);
        asm volatile("s_waitcnt lgkmcnt(0)" ::: "memory");
        const f32x4 t1 = MMA16(lfrag16(lds, TOFF, 144, 16 * I, 16 * I, lane), lfragT(lds, SCOFF + wave * 1280, 80, 0, 0, 16, lane), z);
        st_rm(lds, TOFF, 144, 16 * I, 16 * J, -t1, lane);
    }
    __syncthreads(); asm volatile("" : "+v"(tid)); lane = tid & 63;
    {
        const int mt2 = (wave >> 1) & 1, nt2 = wave & 1; const f32x4 z = {0.f, 0.f, 0.f, 0.f};
        if (wave < 4) { const f32x4 m2 = MMA16(lfrag(lds, LOFF, 144, 32 + 16 * mt2, 0, lane), lfragT(lds, TOFF, 144, 0, 16 * nt2, 32, lane), z); st_rm(lds, SCOFF, 80, 16 * mt2, 16 * nt2, m2, lane); }
        __syncthreads();
        if (wave < 4) { const f32x4 t2 = MMA16(lfrag(lds, TOFF, 144, 32 + 16 * mt2, 32, lane), lfragT(lds, SCOFF, 80, 0, 16 * nt2, 32, lane), z); st_rm(lds, TOFF, 144, 32 + 16 * mt2, 16 * nt2, -t2, lane); }
    }
    __syncthreads();
}

constexpr int GQ_ = 0, GK_ = 17408, GV_ = 34816, GL_ = 53248, GT_ = 62464, GSC_ = 71680, GVB_ = 74240, GKB_ = 92672, GST_ = 111104, GF_ = 145920;
constexpr int LD128 = 272, LD64 = 144, LDSC = 80;
__device__ __forceinline__ void gdn_chain(const bf16_t* __restrict__ gq, const bf16_t* __restrict__ gk, const bf16_t* __restrict__ gv, const float* __restrict__ gg, const float* __restrict__ gbeta, int chain, float* __restrict__ OBout, LAS unsigned char* lds, int tid) {
    const int wave = __builtin_amdgcn_readfirstlane(tid >> 6); int lane = tid & 63, q4 = lane >> 4, l16 = lane & 15;
#define GDN_RELANE() do { asm volatile("" : "+v"(tid)); lane = tid & 63; q4 = lane >> 4; l16 = lane & 15; } while (0)
    const int h = chain % B_H, b = (chain / B_H) % BATCH, dir = chain / (B_H * BATCH);
    LAS float* GF = (LAS float*)(lds + GF_);
    for (int i = tid; i < 34816 / 16; i += NTHR) *(LAS u32x4_t*)(lds + GST_ + 16 * i) = (u32x4_t){0u, 0u, 0u, 0u};
    f32x4 Sacc[8];
#pragma unroll
    for (int nt = 0; nt < 8; ++nt) Sacc[nt] = (f32x4){0.f, 0.f, 0.f, 0.f};
    u32x4_t pq[2], pk[2], pv[2]; float pg = 0.f, pb = 0.f;
#define GDN_LOADS(cc) do { _Pragma("unroll") for (int u = 0; u < 2; ++u) { const int piece = tid + 512 * u, i = piece >> 4, c16 = piece & 15; \
        const size_t ro = (size_t)scan_row(dir, b, 64 * (cc) + i) * B_W + h * 128 + c16 * 8; \
        pq[u] = *(const u32x4_t*)(gq + ro); pk[u] = *(const u32x4_t*)(gk + ro); pv[u] = *(const u32x4_t*)(gv + ro); } \
        if (tid < 64) { const size_t ro = (size_t)scan_row(dir, b, 64 * (cc) + tid) * 8 + dir * 4 + h; pg = gg[ro]; pb = gbeta[ro]; } } while (0)
    constexpr int NCH = SLEN / 64;
#pragma unroll 1
    for (int c = 0; c < NCH; ++c) {
        GDN_RELANE();
        GDN_LOADS(c);
#pragma unroll
        for (int u = 0; u < 2; ++u) { const int piece = tid + 512 * u, i = piece >> 4, c16 = piece & 15;
            *(LAS u32x4_t*)(lds + GQ_ + i * LD128 + c16 * 16) = pq[u]; *(LAS u32x4_t*)(lds + GK_ + i * LD128 + c16 * 16) = pk[u]; *(LAS u32x4_t*)(lds + GV_ + i * LD128 + c16 * 16) = pv[u]; }
        for (int i2 = tid; i2 < 9216 / 16; i2 += NTHR) *(LAS u32x4_t*)(lds + GT_ + 16 * i2) = (u32x4_t){0u, 0u, 0u, 0u};
        if (wave == 0) {
            float x = pg;
#pragma unroll
            for (int o = 1; o < 64; o <<= 1) { const float y = __shfl_up(x, o); if (lane >= o) x += y; }
            const float gl = __shfl(x, 63);
            GF[lane] = x; GF[64 + lane] = pb; GF[128 + lane] = __expf(x); GF[192 + lane] = __expf(gl - x); if (lane == 0) GF[256] = __expf(gl);
        }
        __syncthreads(); __builtin_amdgcn_sched_barrier(0); GDN_RELANE();
        const int mt = wave >> 1;
        f32x4 qk[2];
        {
            f32x4 kk[2]; kk[0] = kk[1] = qk[0] = qk[1] = (f32x4){0.f, 0.f, 0.f, 0.f};
#pragma unroll
            for (int ks = 0; ks < 4; ++ks) { __builtin_amdgcn_sched_barrier(0); const bf16x8_t ak = lfrag(lds, GK_, LD128, 16 * mt, 32 * ks, lane), aq = lfrag(lds, GQ_, LD128, 16 * mt, 32 * ks, lane);
#pragma unroll
                for (int t = 0; t < 2; ++t) { const bf16x8_t bk = lfrag(lds, GK_, LD128, 16 * (2 * (wave & 1) + t), 32 * ks, lane); kk[t] = MMA16(ak, bk, kk[t]); qk[t] = MMA16(aq, bk, qk[t]); } }
#pragma unroll
            for (int t = 0; t < 2; ++t) { const int j = 16 * (2 * (wave & 1) + t) + l16; const float gcj = GF[j];
#pragma unroll
                for (int r = 0; r < 4; ++r) { const int i = 16 * mt + 4 * q4 + r; const float dec = i >= j ? __expf(GF[i] - gcj) : 0.f;
                    const float lv = i > j ? GF[64 + i] * kk[t][r] * dec : 0.f; *(LAS bf16_t*)(lds + GL_ + i * LD64 + j * 2) = f2bf(lv); qk[t][r] *= dec; } }
        }
        __syncthreads(); __builtin_amdgcn_sched_barrier(0); GDN_RELANE();
        tri_inv64<GL_, GT_, GSC_>(lds, tid); GDN_RELANE();
#pragma unroll
        for (int rep = 0; rep < 2; ++rep) { const int task = tid + 512 * rep, cidx = task & 127, jg = task >> 7; float vv[8], kv[8];
#pragma unroll
            for (int jj = 0; jj < 8; ++jj) { const int j = 8 * jg + jj; const float bj = GF[64 + j];
                vv[jj] = bf2f(*(LAS const bf16_t*)(lds + GV_ + j * LD128 + cidx * 2)) * bj; kv[jj] = bf2f(*(LAS const bf16_t*)(lds + GK_ + j * LD128 + cidx * 2)) * bj * GF[128 + j]; }
            u32x4_t wv, wk; wv.x = pg8::cvt_pk_bf16(vv[0], vv[1]); wv.y = pg8::cvt_pk_bf16(vv[2], vv[3]); wv.z = pg8::cvt_pk_bf16(vv[4], vv[5]); wv.w = pg8::cvt_pk_bf16(vv[6], vv[7]);
            wk.x = pg8::cvt_pk_bf16(kv[0], kv[1]); wk.y = pg8::cvt_pk_bf16(kv[2], kv[3]); wk.z = pg8::cvt_pk_bf16(kv[4], kv[5]); wk.w = pg8::cvt_pk_bf16(kv[6], kv[7]);
            *(LAS u32x4_t*)(lds + GVB_ + cidx * LD64 + jg * 16) = wv; *(LAS u32x4_t*)(lds + GKB_ + cidx * LD64 + jg * 16) = wk; }
#pragma unroll
        for (int t = 0; t < 2; ++t) st_rm(lds, GL_, LD64, 16 * mt, 16 * (2 * (wave & 1) + t), qk[t], lane);
#pragma unroll
        for (int u = 0; u < 2; ++u) { const int piece = tid + 512 * u, i = piece >> 4, c16 = piece & 15; LAS u32x4_t* qp = (LAS u32x4_t*)(lds + GQ_ + i * LD128 + c16 * 16); *qp = scale8(*qp, GF[128 + i]); }
        __syncthreads(); __builtin_amdgcn_sched_barrier(0); GDN_RELANE();
        f32x4 accu[4], o[4];
#pragma unroll
        for (int m = 0; m < 4; ++m) accu[m] = o[m] = (f32x4){0.f, 0.f, 0.f, 0.f};
#pragma unroll
        for (int ks = 0; ks < 2; ++ks) { __builtin_amdgcn_sched_barrier(0); const bf16x8_t bb = lfrag(lds, GVB_, LD64, 16 * wave, 32 * ks, lane);
#pragma unroll
            for (int m = 0; m < 4; ++m) accu[m] = MMA16(lfrag(lds, GT_, LD64, 16 * m, 32 * ks, lane), bb, accu[m]); }
        {
            f32x4 accw[4];
#pragma unroll
            for (int m = 0; m < 4; ++m) accw[m] = (f32x4){0.f, 0.f, 0.f, 0.f};
#pragma unroll
            for (int ks = 0; ks < 2; ++ks) { __builtin_amdgcn_sched_barrier(0); const bf16x8_t bb = lfrag(lds, GKB_, LD64, 16 * wave, 32 * ks, lane);
#pragma unroll
                for (int m = 0; m < 4; ++m) accw[m] = MMA16(lfrag(lds, GT_, LD64, 16 * m, 32 * ks, lane), bb, accw[m]); }
            __syncthreads();
#pragma unroll
            for (int m = 0; m < 4; ++m) st_rm(lds, GVB_, LD128, 16 * m, 16 * wave, -accw[m], lane);
        }
#pragma unroll
        for (int rep = 0; rep < 2; ++rep) { const int task = tid + 512 * rep, cidx = task & 127, jg = task >> 7; float kv[8];
#pragma unroll
            for (int jj = 0; jj < 8; ++jj) { const int j = 8 * jg + jj; kv[jj] = bf2f(*(LAS const bf16_t*)(lds + GK_ + j * LD128 + cidx * 2)) * GF[192 + j]; }
            u32x4_t wk; wk.x = pg8::cvt_pk_bf16(kv[0], kv[1]); wk.y = pg8::cvt_pk_bf16(kv[2], kv[3]); wk.z = pg8::cvt_pk_bf16(kv[4], kv[5]); wk.w = pg8::cvt_pk_bf16(kv[6], kv[7]);
            *(LAS u32x4_t*)(lds + GKB_ + cidx * LD64 + jg * 16) = wk; }
        __syncthreads(); __builtin_amdgcn_sched_barrier(0); GDN_RELANE();
#pragma unroll
        for (int ks = 0; ks < 4; ++ks) { __builtin_amdgcn_sched_barrier(0); const bf16x8_t bb = lfrag(lds, GST_, LD128, 16 * wave, 32 * ks, lane);
#pragma unroll
            for (int m = 0; m < 4; ++m) { accu[m] = MMA16(lfrag(lds, GVB_, LD128, 16 * m, 32 * ks, lane), bb, accu[m]); o[m] = MMA16(lfrag(lds, GQ_, LD128, 16 * m, 32 * ks, lane), bb, o[m]); } }
#pragma unroll
        for (int m = 0; m < 4; ++m) st_tr(lds, GV_, LD64, 16 * m, 16 * wave, accu[m], lane);
        __syncthreads(); __builtin_amdgcn_sched_barrier(0); GDN_RELANE();
        const int row0 = scan_row(dir, b, 64 * c), sgn = dir ? -1 : 1;
#pragma unroll
        for (int ks = 0; ks < 2; ++ks) { __builtin_amdgcn_sched_barrier(0); const bf16x8_t bb = lfrag(lds, GV_, LD64, 16 * wave, 32 * ks, lane);
#pragma unroll
            for (int m = 0; m < 4; ++m) o[m] = MMA16(lfrag(lds, GL_, LD64, 16 * m, 32 * ks, lane), bb, o[m]); }
#pragma unroll
        for (int m = 0; m < 4; ++m)
#pragma unroll
            for (int r = 0; r < 4; ++r) { const int i = 16 * m + 4 * q4 + r; const int row = row0 + sgn * i; OBout[(unsigned)((dir * NTOK + row) * B_W + h * 128 + 16 * wave + l16)] = o[m][r]; }
        {
            const float gl = GF[256];
#pragma unroll
            for (int nt = 0; nt < 8; ++nt) Sacc[nt] = Sacc[nt] * gl;
#pragma unroll
            for (int ks = 0; ks < 2; ++ks) { __builtin_amdgcn_sched_barrier(0); const bf16x8_t aa = lfrag(lds, GKB_, LD64, 16 * wave, 32 * ks, lane);
#pragma unroll
                for (int nt = 0; nt < 8; ++nt) Sacc[nt] = MMA16(aa, lfrag(lds, GV_, LD64, 16 * nt, 32 * ks, lane), Sacc[nt]); }
#pragma unroll
            for (int nt = 0; nt < 8; ++nt) st_tr(lds, GST_, LD128, 16 * wave, 16 * nt, Sacc[nt], lane);
        }
        __syncthreads(); __builtin_amdgcn_sched_barrier(0); GDN_RELANE();
    }
#undef GDN_LOADS
#undef GDN_RELANE
}

constexpr int SP_ = 0, SQ_ = 9216, SK_ = 18432, SR_ = 27648, SPT_ = 36864, SQT_ = 46080, SL_ = 55296, ST_ = 64512, SSC_ = 73728, SAT_ = 76288, SNB_ = 85504, SPH_ = 94720, SAH_ = 103936, SCS_ = 113152, SVT_ = 129792, SDC_ = 139008, SSEG_ = 139264;
constexpr int RW_NCH = SLEN / 64, RW_UNITS = 2 * BATCH * A_H * RW_NCH;
__device__ __forceinline__ void rwkv_stage1(const P& p, int unit, LAS unsigned char* lds, int tid) {
    const int wave = __builtin_amdgcn_readfirstlane(tid >> 6); int lane = tid & 63, q4 = lane >> 4, l16 = lane & 15;
#define RW_RELANE() do { asm volatile("" : "+v"(tid)); lane = tid & 63; q4 = lane >> 4; l16 = lane & 15; } while (0)
    const int c = unit % RW_NCH, chain = unit / RW_NCH; const int h = chain % A_H, b = (chain / A_H) % BATCH, dir = chain / (A_H * BATCH);
    LAS float* CS = (LAS float*)(lds + SCS_); LAS float* DCv = (LAS float*)(lds + SDC_); LAS float* SEG = (LAS float*)(lds + SSEG_);
    const int row0 = scan_row(dir, b, 64 * c), sgn = dir ? -1 : 1;
    {
        const int k = tid & 63, sg = tid >> 6; float x = 0.f, loc[8];
#pragma unroll
        for (int tt = 0; tt < 8; ++tt) { const int t = 8 * sg + tt; x += p.RW_D()[((size_t)dir * NTOK + (row0 + sgn * t)) * A_W + h * 64 + k]; loc[tt] = x; }
        SEG[sg * 64 + k] = x;
        for (int i2 = tid; i2 < 9216 / 16; i2 += NTHR) *(LAS u32x4_t*)(lds + ST_ + 16 * i2) = (u32x4_t){0u, 0u, 0u, 0u};
        __syncthreads();
        float pre = 0.f;
        for (int s2 = 0; s2 < sg; ++s2) pre += SEG[s2 * 64 + k];
#pragma unroll
        for (int tt = 0; tt < 8; ++tt) CS[(8 * sg + tt) * 65 + k] = loc[tt] + pre;
        if (sg == 7) DCv[k] = __expf(loc[7] + pre);
    }
    __syncthreads(); RW_RELANE();
    {
        const int t = tid >> 3, kg = tid & 7; const int row = row0 + sgn * t;
        const size_t o1 = (size_t)row * A_W + h * 64 + 8 * kg, o2 = ((size_t)dir * NTOK + row) * A_W + h * 64 + 8 * kg;
        float kk[8], ka[8], kd[8], rr[8], vv[8];
#pragma unroll
        for (int u = 0; u < 2; ++u) { const f32x4_t a = *(const f32x4_t*)(p.RW_KK() + o1 + 4 * u), b2 = *(const f32x4_t*)(p.RW_KKA() + o2 + 4 * u), c2 = *(const f32x4_t*)(p.RW_KD() + o2 + 4 * u), d2 = *(const f32x4_t*)(p.RW_R() + o1 + 4 * u), e2 = *(const f32x4_t*)(p.RW_V() + o1 + 4 * u);
#pragma unroll
            for (int j = 0; j < 4; ++j) { kk[4 * u + j] = a[j]; ka[4 * u + j] = b2[j]; kd[4 * u + j] = c2[j]; rr[4 * u + j] = d2[j]; vv[4 * u + j] = e2[j]; } }
        float pp[8], qq[8], kt[8], rh[8];
#pragma unroll
        for (int j = 0; j < 8; ++j) { const int k = 8 * kg + j; const float cs = CS[t * 65 + k], csm = t > 0 ? CS[(t - 1) * 65 + k] : 0.f; const float e = __expf(cs), ei = 1.0f / e;
            pp[j] = __expf(csm) * kk[j]; qq[j] = ka[j] * ei; kt[j] = kd[j] * ei; rh[j] = rr[j] * e; }
        u32x4_t w;
        w.x = pg8::cvt_pk_bf16(pp[0], pp[1]); w.y = pg8::cvt_pk_bf16(pp[2], pp[3]); w.z = pg8::cvt_pk_bf16(pp[4], pp[5]); w.w = pg8::cvt_pk_bf16(pp[6], pp[7]); *(LAS u32x4_t*)(lds + SP_ + t * 144 + kg * 16) = w;
        w.x = pg8::cvt_pk_bf16(qq[0], qq[1]); w.y = pg8::cvt_pk_bf16(qq[2], qq[3]); w.z = pg8::cvt_pk_bf16(qq[4], qq[5]); w.w = pg8::cvt_pk_bf16(qq[6], qq[7]); *(LAS u32x4_t*)(lds + SQ_ + t * 144 + kg * 16) = w;
        w.x = pg8::cvt_pk_bf16(kt[0], kt[1]); w.y = pg8::cvt_pk_bf16(kt[2], kt[3]); w.z = pg8::cvt_pk_bf16(kt[4], kt[5]); w.w = pg8::cvt_pk_bf16(kt[6], kt[7]); *(LAS u32x4_t*)(lds + SK_ + t * 144 + kg * 16) = w;
        w.x = pg8::cvt_pk_bf16(rh[0], rh[1]); w.y = pg8::cvt_pk_bf16(rh[2], rh[3]); w.z = pg8::cvt_pk_bf16(rh[4], rh[5]); w.w = pg8::cvt_pk_bf16(rh[6], rh[7]); *(LAS u32x4_t*)(lds + SR_ + t * 144 + kg * 16) = w;
#pragma unroll
        for (int j = 0; j < 8; ++j) { const int k = 8 * kg + j; *(LAS bf16_t*)(lds + SPT_ + k * 144 + t * 2) = f2bf(pp[j]); *(LAS bf16_t*)(lds + SQT_ + k * 144 + t * 2) = f2bf(qq[j]); *(LAS bf16_t*)(lds + SVT_ + k * 144 + t * 2) = f2bf(vv[j]); }
    }
    __syncthreads(); RW_RELANE();
    const int mt = wave >> 1, ntb = 2 * (wave & 1);
    f32x4 krm[2];
    {
        f32x4 qp[2], kp[2], qr[2];
#pragma unroll
        for (int t2 = 0; t2 < 2; ++t2) qp[t2] = kp[t2] = qr[t2] = krm[t2] = (f32x4){0.f, 0.f, 0.f, 0.f};
#pragma unroll
        for (int ks = 0; ks < 2; ++ks) { const bf16x8_t aP = lfrag(lds, SP_, 144, 16 * mt, 32 * ks, lane), aR = lfrag(lds, SR_, 144, 16 * mt, 32 * ks, lane);
#pragma unroll
            for (int t2 = 0; t2 < 2; ++t2) { const bf16x8_t bQ = lfrag(lds, SQ_, 144, 16 * (ntb + t2), 32 * ks, lane), bK = lfrag(lds, SK_, 144, 16 * (ntb + t2), 32 * ks, lane);
                qp[t2] = MMA16(aP, bQ, qp[t2]); kp[t2] = MMA16(aP, bK, kp[t2]); qr[t2] = MMA16(aR, bQ, qr[t2]); krm[t2] = MMA16(aR, bK, krm[t2]); } }
#pragma unroll
        for (int t2 = 0; t2 < 2; ++t2) { const int i = 16 * (ntb + t2) + l16;
#pragma unroll
            for (int r = 0; r < 4; ++r) { const int t = 16 * mt + 4 * q4 + r; const bool st = t > i, inc = t >= i;
                qp[t2][r] = st ? qp[t2][r] : 0.f; kp[t2][r] = st ? kp[t2][r] : 0.f; qr[t2][r] = inc ? -qr[t2][r] : 0.f; krm[t2][r] = inc ? krm[t2][r] : 0.f; }
            st_rm(lds, SL_, 144, 16 * mt, 16 * (ntb + t2), qp[t2], lane); st_tr(lds, SAT_, 144, 16 * mt, 16 * (ntb + t2), kp[t2], lane); st_rm(lds, SNB_, 144, 16 * mt, 16 * (ntb + t2), qr[t2], lane); }
    }
    __syncthreads(); RW_RELANE();
    tri_inv64<SL_, ST_, SSC_>(lds, tid);
    RW_RELANE();
    {
        f32x4 ph[2], ah[2];
#pragma unroll
        for (int t2 = 0; t2 < 2; ++t2) ph[t2] = ah[t2] = (f32x4){0.f, 0.f, 0.f, 0.f};
#pragma unroll
        for (int ks = 0; ks < 2; ++ks) { const bf16x8_t aT = lfrag(lds, ST_, 144, 16 * mt, 32 * ks, lane);
#pragma unroll
            for (int t2 = 0; t2 < 2; ++t2) { ph[t2] = MMA16(aT, lfrag(lds, SPT_, 144, 16 * (ntb + t2), 32 * ks, lane), ph[t2]); ah[t2] = MMA16(aT, lfrag(lds, SAT_, 144, 16 * (ntb + t2), 32 * ks, lane), ah[t2]); } }
#pragma unroll
        for (int t2 = 0; t2 < 2; ++t2) { st_tr(lds, SPH_, 144, 16 * mt, 16 * (ntb + t2), ph[t2], lane); st_tr(lds, SAH_, 144, 16 * mt, 16 * (ntb + t2), ah[t2], lane); }
    }
    __syncthreads(); RW_RELANE();
    {
        f32x4 rh[2], zz[2], kh[2];
#pragma unroll
        for (int t2 = 0; t2 < 2; ++t2) { zz[t2] = kh[t2] = (f32x4){0.f, 0.f, 0.f, 0.f};
#pragma unroll
            for (int r = 0; r < 4; ++r) rh[t2][r] = bf2f(*(LAS const bf16_t*)(lds + SR_ + (16 * mt + 4 * q4 + r) * 144 + (16 * (ntb + t2) + l16) * 2)); }
#pragma unroll
        for (int ks = 0; ks < 2; ++ks) { const bf16x8_t aB = lfrag(lds, SNB_, 144, 16 * mt, 32 * ks, lane), aPh = lfrag(lds, SPH_, 144, 16 * mt, 32 * ks, lane), aAh = lfrag(lds, SAH_, 144, 16 * mt, 32 * ks, lane);
#pragma unroll
            for (int t2 = 0; t2 < 2; ++t2) { const bf16x8_t bPh = lfrag(lds, SPH_, 144, 16 * (ntb + t2), 32 * ks, lane), bAh = lfrag(lds, SAH_, 144, 16 * (ntb + t2), 32 * ks, lane), bQt = lfrag(lds, SQT_, 144, 16 * (ntb + t2), 32 * ks, lane);
                rh[t2] = MMA16(aB, bPh, rh[t2]); krm[t2] = MMA16(aB, bAh, krm[t2]); zz[t2] = MMA16(aPh, bQt, zz[t2]); kh[t2] = MMA16(aAh, bQt, kh[t2]); } }
        __syncthreads();
#pragma unroll
        for (int t2 = 0; t2 < 2; ++t2) { const int n = 16 * (ntb + t2) + l16; const float dc = DCv[n];
#pragma unroll
            for (int r = 0; r < 4; ++r) { const int m = 16 * mt + 4 * q4 + r; zz[t2][r] = ((m == n ? 1.f : 0.f) - zz[t2][r]) * dc;
                kh[t2][r] = (bf2f(*(LAS const bf16_t*)(lds + SK_ + m * 144 + n * 2)) - kh[t2][r]) * dc; }
            st_rm(lds, SR_, 144, 16 * mt, 16 * (ntb + t2), rh[t2], lane); st_rm(lds, SL_, 144, 16 * mt, 16 * (ntb + t2), krm[t2], lane);
            st_tr(lds, SP_, 144, 16 * mt, 16 * (ntb + t2), zz[t2], lane); st_tr(lds, SQ_, 144, 16 * mt, 16 * (ntb + t2), kh[t2], lane); }
    }
    __syncthreads(); RW_RELANE();
    {
        const int row = tid >> 3, c16 = tid & 7; bf16_t* ob = p.RWC() + (size_t)unit * 5 * 4096 + row * 64 + c16 * 8;
        *(u32x4_t*)(ob) = *(LAS const u32x4_t*)(lds + SR_ + row * 144 + c16 * 16);
        *(u32x4_t*)(ob + 4096) = *(LAS const u32x4_t*)(lds + SL_ + row * 144 + c16 * 16);
        *(u32x4_t*)(ob + 2 * 4096) = *(LAS const u32x4_t*)(lds + SP_ + row * 144 + c16 * 16);
        *(u32x4_t*)(ob + 3 * 4096) = *(LAS const u32x4_t*)(lds + SQ_ + row * 144 + c16 * 16);
        *(u32x4_t*)(ob + 4 * 4096) = *(LAS const u32x4_t*)(lds + SVT_ + row * 144 + c16 * 16);
    }
    __syncthreads();
#undef RW_RELANE
}
constexpr int S2_M = 0  , S2_S = 46080;
__device__ __forceinline__ void rwkv_stage2(const P& p, int chain, float* YAout, LAS unsigned char* lds, int tid) {
    const int wave = __builtin_amdgcn_readfirstlane(tid >> 6); int lane = tid & 63, q4 = lane >> 4, l16 = lane & 15;
    const int h = chain % A_H, b = (chain / A_H) % BATCH, dir = chain / (A_H * BATCH);
    const int mt = wave >> 1, ntb = 2 * (wave & 1);
    for (int i = tid; i < 9216 / 16; i += NTHR) *(LAS u32x4_t*)(lds + S2_S + 16 * i) = (u32x4_t){0u, 0u, 0u, 0u};
    u32x4_t pre[5];
#define S2_LOADS(cc) do { const bf16_t* ib = p.RWC() + ((size_t)chain * RW_NCH + (cc)) * 5 * 4096 + (tid >> 3) * 64 + (tid & 7) * 8; \
        _Pragma("unroll") for (int u = 0; u < 5; ++u) pre[u] = *(const u32x4_t*)(ib + u * 4096); } while (0)
    S2_LOADS(0);
#pragma unroll 1
    for (int c = 0; c < RW_NCH; ++c) {
        asm volatile("" : "+v"(tid)); lane = tid & 63; q4 = lane >> 4; l16 = lane & 15;
#pragma unroll
        for (int u = 0; u < 5; ++u) *(LAS u32x4_t*)(lds + S2_M + u * 9216 + (tid >> 3) * 144 + (tid & 7) * 16) = pre[u];
        if (c + 1 < RW_NCH) S2_LOADS(c + 1);
        __syncthreads();
        f32x4 y[2], sn[2];
#pragma unroll
        for (int t2 = 0; t2 < 2; ++t2) y[t2] = sn[t2] = (f32x4){0.f, 0.f, 0.f, 0.f};
#pragma unroll
        for (int ks = 0; ks < 2; ++ks) {
            const bf16x8_t aR = lfrag(lds, S2_M, 144, 16 * mt, 32 * ks, lane), aM = lfrag(lds, S2_M + 9216, 144, 16 * mt, 32 * ks, lane);
            const bf16x8_t aS = lfrag(lds, S2_S, 144, 16 * mt, 32 * ks, lane), aV = lfrag(lds, S2_M + 4 * 9216, 144, 16 * mt, 32 * ks, lane);
#pragma unroll
            for (int t2 = 0; t2 < 2; ++t2) { const int n0 = 16 * (ntb + t2);
                y[t2] = MMA16(aR, lfrag(lds, S2_S, 144, n0, 32 * ks, lane), y[t2]); y[t2] = MMA16(aM, lfrag(lds, S2_M + 4 * 9216, 144, n0, 32 * ks, lane), y[t2]);
                sn[t2] = MMA16(aS, lfrag(lds, S2_M + 2 * 9216, 144, n0, 32 * ks, lane), sn[t2]); sn[t2] = MMA16(aV, lfrag(lds, S2_M + 3 * 9216, 144, n0, 32 * ks, lane), sn[t2]); } }
        const int row0 = scan_row(dir, b, 64 * c), sgn = dir ? -1 : 1;
#pragma unroll
        for (int t2 = 0; t2 < 2; ++t2)
#pragma unroll
            for (int r = 0; r < 4; ++r) { const int t = 16 * mt + 4 * q4 + r; YAout[(unsigned)((dir * NTOK + row0 + sgn * t) * A_W + h * 64 + 16 * (ntb + t2) + l16)] = y[t2][r]; }
        __syncthreads();
#pragma unroll
        for (int t2 = 0; t2 < 2; ++t2) st_rm(lds, S2_S, 144, 16 * mt, 16 * (ntb + t2), sn[t2], lane);
        __syncthreads();
    }
#undef S2_LOADS
}

constexpr int AT_K = 0  , AT_V = 18432  , ATT_NLAT = BATCH * 4 * (SEQ / 256), ATT_NCTX = BATCH * 4 * (CTXL / 256);
__device__ __forceinline__ void attn_unit(const P& p, int unit, LAS unsigned char* lds, int tid) {
    const int wave = __builtin_amdgcn_readfirstlane(tid >> 6); int lane = tid & 63, q4 = lane >> 4, l16 = lane & 15;
    int b, hq, qrow0, nt; bool lat;
    if (unit < ATT_NLAT) { lat = true; b = unit / (4 * (SEQ / 256)); hq = (unit / (SEQ / 256)) % 4; qrow0 = b * SEQ + 256 * (unit % (SEQ / 256)); nt = SLEN / 64; }
    else { const int u2 = unit - ATT_NLAT; lat = false; b = u2 / (4 * (CTXL / 256)); hq = (u2 / (CTXL / 256)) % 4; qrow0 = NLAT + b * CTXL + 256 * (u2 % (CTXL / 256)); nt = CTXL / 64; }
    const int kvh = hq >> 1; qrow0 += 32 * wave;
    bf16x8_t qf[2][2];
#pragma unroll
    for (int qt = 0; qt < 2; ++qt)
#pragma unroll
        for (int ks = 0; ks < 2; ++ks) qf[qt][ks] = *(const bf16x8_t*)(p.CQ() + (size_t)(qrow0 + 16 * qt + l16) * 256 + hq * 64 + 32 * ks + 8 * q4);
    f32x4 o[2][4]; float mrun[2], lrun[2];
#pragma unroll
    for (int qt = 0; qt < 2; ++qt) { mrun[qt] = -1e30f; lrun[qt] = 0.f;
#pragma unroll
        for (int dt = 0; dt < 4; ++dt) o[qt][dt] = (f32x4){0.f, 0.f, 0.f, 0.f}; }
    u32x4_t pk, pv;
#define AT_ROWBASE(t) ((lat && (t) < SEQ / 64) ? b * SEQ + 64 * (t) : NLAT + b * CTXL + 64 * ((t) - (lat ? SEQ / 64 : 0)))
#define AT_LOAD(t) do { const size_t ro = (size_t)(AT_ROWBASE(t) + (tid >> 3)) * 128 + kvh * 64 + (tid & 7) * 8; pk = *(const u32x4_t*)(p.CK() + ro); pv = *(const u32x4_t*)(p.CV() + ro); } while (0)
#define AT_STORE(buf) do { const int key = tid >> 3, c16 = tid & 7; *(LAS u32x4_t*)(lds + AT_K + (buf) * 9216 + key * 144 + c16 * 16) = pk; \
        LAS unsigned char* vb = lds + AT_V + (buf) * 9216 + (c16 * 8) * 144 + key * 2; \
        *(LAS bf16_t*)(vb) = (bf16_t)(pv.x & 0xffffu); *(LAS bf16_t*)(vb + 144) = (bf16_t)(pv.x >> 16); *(LAS bf16_t*)(vb + 288) = (bf16_t)(pv.y & 0xffffu); *(LAS bf16_t*)(vb + 432) = (bf16_t)(pv.y >> 16); \
        *(LAS bf16_t*)(vb + 576) = (bf16_t)(pv.z & 0xffffu); *(LAS bf16_t*)(vb + 720) = (bf16_t)(pv.z >> 16); *(LAS bf16_t*)(vb + 864) = (bf16_t)(pv.w & 0xffffu); *(LAS bf16_t*)(vb + 1008) = (bf16_t)(pv.w >> 16); } while (0)
    AT_LOAD(0); AT_STORE(0);
    __syncthreads();
#pragma unroll 1
    for (int t = 0; t < nt; ++t) {
        asm volatile("" : "+v"(tid)); lane = tid & 63; q4 = lane >> 4; l16 = lane & 15;
        const int buf = t & 1;
        if (t + 1 < nt) AT_LOAD(t + 1);
        f32x4 s[2][4];
#pragma unroll
        for (int qt = 0; qt < 2; ++qt)
#pragma unroll
            for (int kt = 0; kt < 4; ++kt) s[qt][kt] = (f32x4){0.f, 0.f, 0.f, 0.f};
#pragma unroll
        for (int ks = 0; ks < 2; ++ks)
#pragma unroll
            for (int kt = 0; kt < 4; ++kt) { const bf16x8_t ak = lfrag(lds, AT_K + buf * 9216, 144, 16 * kt, 32 * ks, lane);
                s[0][kt] = MMA16(ak, qf[0][ks], s[0][kt]); s[1][kt] = MMA16(ak, qf[1][ks], s[1][kt]); }
        bf16x8_t pb[2][2];
#pragma unroll
        for (int qt = 0; qt < 2; ++qt) {
            float mx = s[qt][0][0];
#pragma unroll
            for (int kt = 0; kt < 4; ++kt)
#pragma unroll
                for (int r = 0; r < 4; ++r) mx = fmaxf(mx, s[qt][kt][r]);
            mx = fmaxf(mx, __shfl_xor(mx, 16)); mx = fmaxf(mx, __shfl_xor(mx, 32));
            const float mn = fmaxf(mrun[qt], mx), alpha = exp2f(mrun[qt] - mn); mrun[qt] = mn;
            float ps = 0.f;
#pragma unroll
            for (int kt = 0; kt < 4; ++kt)
#pragma unroll
                for (int r = 0; r < 4; ++r) { const float e = exp2f(s[qt][kt][r] - mn); s[qt][kt][r] = e; ps += e; }
            lrun[qt] = lrun[qt] * alpha + ps;
#pragma unroll
            for (int dt = 0; dt < 4; ++dt) o[qt][dt] = o[qt][dt] * alpha;
#pragma unroll
            for (int k2 = 0; k2 < 2; ++k2) { u32x4_t w; w.x = pg8::cvt_pk_bf16(s[qt][2 * k2][0], s[qt][2 * k2][1]); w.y = pg8::cvt_pk_bf16(s[qt][2 * k2][2], s[qt][2 * k2][3]);
                w.z = pg8::cvt_pk_bf16(s[qt][2 * k2 + 1][0], s[qt][2 * k2 + 1][1]); w.w = pg8::cvt_pk_bf16(s[qt][2 * k2 + 1][2], s[qt][2 * k2 + 1][3]); pb[qt][k2] = __builtin_bit_cast(bf16x8_t, w); }
        }
#pragma unroll
        for (int k2 = 0; k2 < 2; ++k2)
#pragma unroll
            for (int dt = 0; dt < 4; ++dt) { LAS const unsigned char* vp = lds + AT_V + buf * 9216 + (16 * dt + l16) * 144 + (32 * k2 + 4 * q4) * 2;
                const u32x2_t lo = *(LAS const u32x2_t*)vp, hi = *(LAS const u32x2_t*)(vp + 32); u32x4_t w; w.x = lo.x; w.y = lo.y; w.z = hi.x; w.w = hi.y; const bf16x8_t av = __builtin_bit_cast(bf16x8_t, w);
                o[0][dt] = MMA16(av, pb[0][k2], o[0][dt]); o[1][dt] = MMA16(av, pb[1][k2], o[1][dt]); }
        if (t + 1 < nt) AT_STORE(buf ^ 1);
        __syncthreads();
    }
#pragma unroll
    for (int qt = 0; qt < 2; ++qt) { float l = lrun[qt]; l += __shfl_xor(l, 16); l += __shfl_xor(l, 32); const float inv = 1.0f / l;
        bf16_t* orow = p.MIX() + (size_t)(qrow0 + 16 * qt + l16) * D + 768 + hq * 64 + 4 * q4;
#pragma unroll
        for (int dt = 0; dt < 4; ++dt) { u32x2_t w; w.x = pg8::cvt_pk_bf16(o[qt][dt][0] * inv, o[qt][dt][1] * inv); w.y = pg8::cvt_pk_bf16(o[qt][dt][2] * inv, o[qt][dt][3] * inv); *(u32x2_t*)(orow + 16 * dt) = w; } }
#undef AT_ROWBASE
#undef AT_LOAD
#undef AT_STORE
}

__device__ __forceinline__ f32x4_t bf4(u32x2_t w) { f32x4_t r; r.x = bflo(w.x); r.y = bfhi(w.x); r.z = bflo(w.y); r.w = bfhi(w.y); return r; }
__device__ __forceinline__ float sigm(float x) { return 1.0f / (1.0f + __expf(-x)); }
__device__ __forceinline__ void dev_prep0(const P& p, int l, int gw, int ngw, int lane) {
    const int i16 = lane & 15;
    for (int m = gw; m < NTOK; m += ngw) {
        int b, t, len, base; row_info(m, b, t, len, base);
        const bf16_t* ur = p.U() + (size_t)m * INP; const bool hp = t > 0, hn = t + 1 < len;
        {
            float val[3];
#pragma unroll
            for (int g = 0; g < 3; ++g) { const int c = 768 + 64 * g + lane; const float u = bf2f(ur[c]), up = hp ? bf2f(ur[c - INP]) : 0.f, un = hn ? bf2f(ur[c + INP]) : 0.f;
                val[g] = u + p.rw_mu[l * A_IN + c] * (0.5f * (up + un) - u); }
            const float e2 = __expf(2.0f * val[0]); const float th = 1.0f - 2.0f / (e2 + 1.0f);
            bf16_t* lr = p.LRT() + (size_t)m * 256;
            lr[lane] = f2bf(th); lr[64 + lane] = f2bf(val[1]); lr[128 + lane] = f2bf(sigm(val[2])); lr[192 + lane] = 0;
        }
#pragma unroll
        for (int which = 0; which < 3; ++which) {
            const int cc = which * B_W + 8 * lane; float acc[8];
#pragma unroll
            for (int c = 0; c < 8; ++c) acc[c] = 0.f;
#pragma unroll
            for (int j = 0; j < 5; ++j) { const int tt = t + j - 2;
                if (tt >= 0 && tt < len) { const u32x4_t uv = *(const u32x4_t*)(p.U() + (size_t)(base + tt) * INP + B_OFF + cc);
                    const float* cw = p.gdn_conv + ((size_t)l * 5 + j) * (3 * B_W) + cc; const f32x4_t w0 = *(const f32x4_t*)cw, w1 = *(const f32x4_t*)(cw + 4);
                    acc[0] += bflo(uv.x) * w0.x; acc[1] += bfhi(uv.x) * w0.y; acc[2] += bflo(uv.y) * w0.z; acc[3] += bfhi(uv.y) * w0.w;
                    acc[4] += bflo(uv.z) * w1.x; acc[5] += bfhi(uv.z) * w1.y; acc[6] += bflo(uv.w) * w1.z; acc[7] += bfhi(uv.w) * w1.w; } }
            float ss = 0.f;
#pragma unroll
            for (int c = 0; c < 8; ++c) { acc[c] = acc[c] * sigm(acc[c]); ss += acc[c] * acc[c]; }
            float rn = 1.0f;
            if (which < 2) rn = (1.0f / sqrtf(grp16_sum(ss) + 1e-6f)) * (which == 0 ? 0.08838834764831845f : 1.0f);
            u32x4_t w; w.x = pg8::cvt_pk_bf16(acc[0] * rn, acc[1] * rn); w.y = pg8::cvt_pk_bf16(acc[2] * rn, acc[3] * rn); w.z = pg8::cvt_pk_bf16(acc[4] * rn, acc[5] * rn); w.w = pg8::cvt_pk_bf16(acc[6] * rn, acc[7] * rn);
            *(u32x4_t*)((which == 0 ? p.GQ() : which == 1 ? p.GK() : p.GV()) + (size_t)m * B_W + 8 * lane) = w;
        }
        if (lane < 8) { const int dir = lane >> 2, h = lane & 3; const float a = bf2f(ur[B_OFF + 2048 + lane]), bb = bf2f(ur[B_OFF + 2056 + lane]);
            const float xs = a + p.gdn_dt_bias[(l * 2 + dir) * B_H + h]; const float sp = xs > 20.f ? xs : log1pf(__expf(xs));
            p.GG()[(size_t)m * 8 + lane] = -__expf(p.gdn_a_log[(l * 2 + dir) * B_H + h]) * sp; p.GBETA()[(size_t)m * 8 + lane] = sigm(bb); }
        {
            const int i = i16; float cs[4], sn[4];
            if (m < NLAT) { const float pos = (i < 8) ? (float)(t / GRID_W) : (float)(t % GRID_W);
#pragma unroll
                for (int c = 0; c < 4; ++c) { const float fr = exp2f(-0.8304820237218406f * (float)(4 * (i & 3) + c)); __sincosf(pos * fr, &sn[c], &cs[c]); } }
            else {
#pragma unroll
                for (int c = 0; c < 4; ++c) { cs[c] = 1.f; sn[c] = 0.f; } }
            const float sgn = (i & 4) ? 1.f : -1.f;
            {
                const f32x4_t x = bf4(*(const u32x2_t*)(ur + C_OFF + 4 * lane)); const float rstd = (1.0f / sqrtf(grp16_sum(hsq4(x)) * (1.0f / 64.f) + 1e-6f)) * 0.18033688011112042f;
                const f32x4_t nw = *(const f32x4_t*)(p.attn_q_norm + l * 64 + 4 * i); f32x4_t y = x * rstd * nw, o;
#pragma unroll
                for (int c = 0; c < 4; ++c) { const float pr = __shfl_xor(y[c], 4); o[c] = y[c] * cs[c] + sgn * pr * sn[c]; }
                *(u32x2_t*)(p.CQ() + (size_t)m * 256 + 4 * lane) = pk4(o);
            }
            {
                const int l2 = lane & 31; const f32x4_t x = bf4(*(const u32x2_t*)(ur + C_OFF + 256 + 4 * l2)); const float rstd = 1.0f / sqrtf(grp16_sum(hsq4(x)) * (1.0f / 64.f) + 1e-6f);
                const f32x4_t nw = *(const f32x4_t*)(p.attn_k_norm + l * 64 + 4 * i); f32x4_t y = x * rstd * nw, o;
#pragma unroll
                for (int c = 0; c < 4; ++c) { const float pr = __shfl_xor(y[c], 4); o[c] = y[c] * cs[c] + sgn * pr * sn[c]; }
                if (lane < 32) { *(u32x2_t*)(p.CK() + (size_t)m * 128 + 4 * lane) = pk4(o); *(u32x2_t*)(p.CV() + (size_t)m * 128 + 4 * lane) = *(const u32x2_t*)(ur + C_OFF + 384 + 4 * lane); }
            }
        }
    }
}
__device__ __forceinline__ void dev_prepA1(const P& p, int l, int gw, int ngw, int lane) {
    const int h = lane >> 4;
    const f32x4_t kkp = *(const f32x4_t*)(p.rw_k_k + l * A_W + 4 * lane), kap = *(const f32x4_t*)(p.rw_k_a + l * A_W + 4 * lane), rkp = *(const f32x4_t*)(p.rw_r_k + l * A_W + 4 * lane);
    for (int m = gw; m < NTOK; m += ngw) {
        int b, t, len, base; row_info(m, b, t, len, base);
        const bf16_t* ur = p.U() + (size_t)m * INP; const bool hp = t > 0, hn = t + 1 < len;
        f32x4_t rkv[3];
#pragma unroll
        for (int a = 0; a < 3; ++a) { const int c = 256 * a + 4 * lane; const f32x4_t u = bf4(*(const u32x2_t*)(ur + c));
            const f32x4_t up = hp ? bf4(*(const u32x2_t*)(ur + c - INP)) : (f32x4_t){0.f, 0.f, 0.f, 0.f}, un = hn ? bf4(*(const u32x2_t*)(ur + c + INP)) : (f32x4_t){0.f, 0.f, 0.f, 0.f};
            rkv[a] = u + *(const f32x4_t*)(p.rw_mu + l * A_IN + c) * (0.5f * (up + un) - u); }
        const f32x4_t r = rkv[0], k = rkv[1], v = rkv[2];
        const bf16_t* lo = p.LRO() + (size_t)m * 1280 + 4 * lane;
        const f32x4_t kx = k * kkp; const float rn = 1.0f / sqrtf(grp16_sum(hsq4(kx)) + 1e-6f); const f32x4_t kk = kx * rn;
        f32x4_t kdsum = {0.f, 0.f, 0.f, 0.f};
#pragma unroll
        for (int dir = 0; dir < 2; ++dir) {
            const f32x4_t w = *(const f32x4_t*)(p.rw_w0 + (l * 2 + dir) * A_W + 4 * lane) + bf4(*(const u32x2_t*)(lo + 256 * dir));
            const f32x4_t a = *(const f32x4_t*)(p.rw_a0 + (l * 2 + dir) * A_W + 4 * lane) + bf4(*(const u32x2_t*)(lo + 512 + 256 * dir));
            f32x4_t ld, ic;
#pragma unroll
            for (int c = 0; c < 4; ++c) { const float nw = -w[c]; const float sp = nw > 20.f ? nw : log1pf(__expf(nw)); ld[c] = -__expf(-sp - 0.5f); ic[c] = sigm(a[c]); }
            const f32x4_t kd = k * (1.0f + (ic - 1.0f) * kap); kdsum = kdsum + kd;
            const size_t o = ((size_t)dir * NTOK + m) * A_W + 4 * lane;
            *(f32x4_t*)(p.RW_D() + o) = ld; *(f32x4_t*)(p.RW_KD() + o) = kd; *(f32x4_t*)(p.RW_KKA() + o) = kk * ic;
        }
        const size_t o1 = (size_t)m * A_W + 4 * lane;
        *(f32x4_t*)(p.RW_R() + o1) = r; *(f32x4_t*)(p.RW_V() + o1) = v; *(f32x4_t*)(p.RW_KK() + o1) = kk; *(f32x4_t*)(p.RW_GATE() + o1) = bf4(*(const u32x2_t*)(lo + 1024));
        const float bon = grp16_sum(hsum4(r * kdsum * rkp));
        if ((lane & 15) == 0) p.RW_BON()[(size_t)m * A_H + h] = bon;
    }
}
__device__ __forceinline__ void dev_build_wlr(const P& p, int l, long gtid, long nthr) {
    for (long e = gtid; e < 1280L * 256; e += nthr) { const int n = (int)(e >> 8), k = (int)(e & 255), g = n >> 8, ch = n & 255; float v = 0.f;
        if (g < 2) { if ((k >> 5) == g) v = p.rw_w2[((size_t)(l * 2 + g) * 32 + (k & 31)) * A_W + ch]; }
        else if (g < 4) { if ((k >> 5) == g) v = p.rw_a2[((size_t)(l * 2 + (g - 2)) * 32 + (k & 31)) * A_W + ch]; }
        else { if (k >= 128 && k < 192) v = p.rw_g2[((size_t)l * 64 + (k - 128)) * A_W + ch]; }
        p.WLR_T()[e] = f2bf(v); }
}

constexpr int RING_BYTES = 131072, MISC_OFF = 147200, LDS_BYTES = 147456;
constexpr size_t MiB = 1u << 20;
constexpr int CW_BAR = 4096, CW_CNT = 8192;

__device__ __forceinline__ void transpose_item(const float* W, int K, int N, bf16_t* WT, LAS float* scr, int item, int lane) {
    const int nblk_k = K / 64; const int nb = item / nblk_k, kb = item % nblk_k, k0 = 64 * kb, n0 = 32 * nb;
    const int ncol = n0 + (lane & 31);
#pragma unroll 8
    for (int i = 0; i < 32; ++i) { const int kk = 2 * i + (lane >> 5); scr[kk * 33 + (lane & 31)] = ncol < N ? W[(size_t)(k0 + kk) * N + ncol] : 0.f; }
    asm volatile("s_waitcnt lgkmcnt(0)" ::: "memory");
    const int c = lane & 7;
#pragma unroll
    for (int j = 0; j < 4; ++j) { const int n = (lane >> 3) + 8 * j; const LAS float* s = scr + (8 * c) * 33 + n;
        pg8::u32x4 o; o.x = pg8::cvt_pk_bf16(s[0 * 33], s[1 * 33]); o.y = pg8::cvt_pk_bf16(s[2 * 33], s[3 * 33]); o.z = pg8::cvt_pk_bf16(s[4 * 33], s[5 * 33]); o.w = pg8::cvt_pk_bf16(s[6 * 33], s[7 * 33]);
        *(pg8::u32x4*)(WT + (size_t)(n0 + n) * K + k0 + 8 * c) = o; }
    asm volatile("s_waitcnt lgkmcnt(0)" ::: "memory");
}

struct Args { P p; int ph_lo, ph_hi; };

#define RUN_TASKS(ntasks, call) do { const long _n = (long)(ntasks); for (long task = gtid; task < _n; task += nthr) { call; } } while (0)

constexpr int NPH = 15;
__global__ void __launch_bounds__(NTHR, 2) fwd_kernel(Args args) {
    extern __shared__ __attribute__((aligned(16))) unsigned char lds[];
    const P& pk = args.p;
    LAS unsigned char* ldsp = (LAS unsigned char*)lds;
    volatile LAS unsigned* MISC = (volatile LAS unsigned*)(ldsp + MISC_OFF);
    const int G = gridDim.x;
#define PHASE_VARS P p = args.p; asm volatile("" : "+s"(p.ws)); int tid_ = threadIdx.x; asm volatile("" : "+v"(tid_)); const int lane = tid_ & 63, wave = __builtin_amdgcn_readfirstlane(tid_ >> 6); \
    const long gtid = ((long)wave * G + blockIdx.x) * 64 + lane, nthr = (long)G * NTHR; const int gw = wave * G + blockIdx.x, ngw = G * NWAVES; (void)gw; (void)ngw; (void)gtid; (void)nthr; (void)lane;
    if (threadIdx.x < 32) MISC[threadIdx.x] = 0u;
    __syncthreads();
    XcdBarrier bar = xcd_barrier_post(pk.ctl() + CW_BAR, MISC + 8);
    const int lo = args.ph_lo, hi = args.ph_hi;
#ifndef DBG_PH
#define DBG_PH -1
#endif
#define PHON(j) (DBG_PH < 0 || DBG_PH == (j))
#define IN(k) (lo <= (k) && (k) < hi)
#define SEAM(k) do { if (IN((k) + 1)) xcd_barrier(bar); } while (0)

    if (PHON(100) && IN(0)) { PHASE_VARS;
        RUN_TASKS((long)DEPTH * (BATCH + 1) * 6 * D, task_mod(p, task));
        RUN_TASKS(D, p.HB()[(size_t)ZROW * D + task] = 0);
        SEAM(0);
    }
    for (int l = 0; l < DEPTH; ++l) {
        const int pb = 1 + l * NPH;
        const bool need_ctx = l < DEPTH - 1;
        const int ntok_l = need_ctx ? NTOK : NLAT;
        if (PHON(0) && IN(pb + 0)) { PHASE_VARS;
            LAS float* scr = (LAS float*)(ldsp + wave * 16384);
            const int I_IN = (D / 64) * (INP / 32), I_OUT = (D / 64) * (D / 32), I_R = (D / 64) * (NEXP / 32 > 0 ? NEXP / 32 : 1), I_GU = (D / 64) * (2 * DEXP / 32), I_DN = (DEXP / 64) * (D / 32);
            const int total = I_IN + I_OUT + I_R + NEXP * (I_GU + I_DN);
            for (int it = gw; it < total; it += ngw) {
                int r = it;
                if (r < I_IN) { transpose_item(p.w_in + (size_t)l * D * INW, D, INW, p.WIN_T(), scr, r, lane); continue; } r -= I_IN;
                if (r < I_OUT) { transpose_item(p.w_out + (size_t)l * D * D, D, D, p.WOUT_T(), scr, r, lane); continue; } r -= I_OUT;
                if (r < I_R) { transpose_item(p.router_w + (size_t)l * D * NEXP, D, NEXP, p.WR_T(), scr, r, lane); continue; } r -= I_R;
                if (r < NEXP * I_GU) { const int e = r / I_GU; transpose_item(p.exp_w_gu + ((size_t)l * NEXP + e) * D * 2 * DEXP, D, 2 * DEXP, p.WGU_T() + (size_t)e * 2 * DEXP * D, scr, r % I_GU, lane); continue; } r -= NEXP * I_GU;
                { const int e = r / I_DN; transpose_item(p.exp_w_dn + ((size_t)l * NEXP + e) * DEXP * D, DEXP, D, p.WDN_T() + (size_t)e * D * DEXP, scr, r % I_DN, lane); }
            }
            dev_build_wlr(p, l, gtid, nthr);
            if (l == 0) dev_norm1_l0(p, gw, ngw, lane);
            SEAM(pb + 0);
        }
        if (PHON(1) && IN(pb + 1)) { PHASE_VARS; (void)tid_; (void)wave;
            pg8::Gemm g{p.HB(), p.WIN_T(), D, 0}; pg8::StaticOrder S; S.init(NTOK, INP, G, (int)blockIdx.x);
            pg8::EpiBf16Bias E{p.U(), INP, nullptr, 0};
            pg8::gemm_phase(ldsp, g, S, E);
            SEAM(pb + 1);
        }
        if (PHON(2) && IN(pb + 2)) { PHASE_VARS; dev_prep0(p, l, gw, ngw, lane); SEAM(pb + 2); }
        if (PHON(3) && IN(pb + 3)) { PHASE_VARS; (void)tid_; (void)wave;
            pg8::Gemm g{p.LRT(), p.WLR_T(), 256, 0}; pg8::StaticOrder S; S.init(NTOK, 1280, G, (int)blockIdx.x);
            pg8::EpiBf16Bias E{p.LRO(), 1280, nullptr, 0};
            pg8::gemm_phase(ldsp, g, S, E);
            SEAM(pb + 3);
        }
        if (PHON(4) && IN(pb + 4)) { PHASE_VARS; dev_prepA1(p, l, gw, ngw, lane); SEAM(pb + 4); }
        if (PHON(5) && IN(pb + 5)) { PHASE_VARS;
            const int nchain = 2 * BATCH * B_H;
            if ((int)blockIdx.x >= G - nchain && G >= nchain) gdn_chain(p.GQ(), p.GK(), p.GV(), p.GG(), p.GBETA(), (int)blockIdx.x - (G - nchain),
#ifdef PROBE_GDN
                (float*)(p.ws + WS_TOTAL),
#else
                p.OB(),
#endif
                ldsp, tid_);
            else if (G < nchain) { for (int ch = blockIdx.x; ch < nchain; ch += G) gdn_chain(p.GQ(), p.GK(), p.GV(), p.GG(), p.GBETA(), ch, p.OB(), ldsp, tid_); }
#ifdef PROBE_GDN
            { const long nB = 2L * BATCH * B_H * 128; for (long task = gtid; task < nB; task += nthr) task_scanB(p, task); }
#endif
            {
                const int nfree = G > nchain ? G - nchain : 0; const int shares = 3 * nfree + (G - nfree);
                const int mys = (int)blockIdx.x < nfree ? 3 : 1, base = (int)blockIdx.x < nfree ? 3 * (int)blockIdx.x : 3 * nfree + ((int)blockIdx.x - nfree);
                for (int u0 = 0; u0 < RW_UNITS; u0 += shares) for (int q = 0; q < mys; ++q) { const int unit = u0 + base + q; if (unit < RW_UNITS) rwkv_stage1(p, unit, ldsp, tid_); }
            }
            SEAM(pb + 5);
        }
        if (PHON(6) && IN(pb + 6)) { PHASE_VARS;
            const long nA = 2L * BATCH * A_H * 64, nC = (long)BATCH * 4 * SLEN; (void)nA;
#ifdef PROBE_RWKV
            for (long task = gtid; task < nA; task += nthr) task_scanA(p, task);
            for (int ch = blockIdx.x; ch < 2 * BATCH * A_H; ch += G) rwkv_stage2(p, ch, (float*)(p.ws + WS_TOTAL), ldsp, tid_);
#else
            for (int ch = blockIdx.x; ch < 2 * BATCH * A_H; ch += G) rwkv_stage2(p, ch, p.YA(), ldsp, tid_);
#endif
            (void)nC;
            { const int nun = ATT_NLAT + (need_ctx ? ATT_NCTX : 0); for (int u = (G - 1 - (int)blockIdx.x); u < nun; u += G) attn_unit(p, u, ldsp, tid_); }
            SEAM(pb + 6);
        }
        if (PHON(7) && IN(pb + 7)) { PHASE_VARS;
#ifdef PROBE_GDN
            { float e2 = 0.f, r2 = 0.f; const float* cand = (const float*)(p.ws + WS_TOTAL); const float* ref = p.OB();
              for (long i = gtid; i < 2L * NTOK * B_W; i += nthr) { const float d = cand[i] - ref[i]; e2 += d * d; r2 += ref[i] * ref[i]; }
              e2 = wave_sum(e2); r2 = wave_sum(r2); if (lane == 0) { atomicAdd((float*)(p.ctl() + 12000), e2); atomicAdd((float*)(p.ctl() + 12001), r2); } }
#endif
#ifdef PROBE_RWKV
            { float e2 = 0.f, r2 = 0.f; const float* cand = (const float*)(p.ws + WS_TOTAL); const float* ref = p.YA();
              for (long i = gtid; i < 2L * NTOK * A_W; i += nthr) { const float d = cand[i] - ref[i]; e2 += d * d; r2 += ref[i] * ref[i]; }
              e2 = wave_sum(e2); r2 = wave_sum(r2); if (lane == 0) { atomicAdd((float*)(p.ctl() + 12000), e2); atomicAdd((float*)(p.ctl() + 12001), r2); } }
#endif
            dev_post(p, l, ntok_l, gw, ngw, lane); SEAM(pb + 7); }
        if (PHON(8) && IN(pb + 8)) { PHASE_VARS; (void)tid_; (void)wave;
            pg8::Gemm g{p.MIX(), p.WOUT_T(), D, 0}; pg8::StaticOrder S; S.init(ntok_l, D, G, (int)blockIdx.x);
            pg8::EpiF32 E{p.MO(), D};
            pg8::gemm_phase(ldsp, g, S, E);
            SEAM(pb + 8);
        }
        if (PHON(9) && IN(pb + 9)) { PHASE_VARS; dev_resid_router(p, l, ntok_l, ldsp, G, tid_); SEAM(pb + 9); }
        if (PHON(10) && IN(pb + 10)) { PHASE_VARS; dev_slots(p, l, ntok_l, ldsp, gtid, nthr, tid_); SEAM(pb + 10); }
        if (PHON(11) && IN(pb + 11)) { PHASE_VARS; const long nb = p.NBLK()[0]; RUN_TASKS(nb * 256 * 128, task_gather(p, task)); SEAM(pb + 11); }
        if (PHON(12) && IN(pb + 12)) { PHASE_VARS; (void)tid_; (void)wave;
            pg8::Gemm g{p.XG(), p.WGU_T(), D, (size_t)2 * DEXP * D}; pg8::MoeOrder S{__builtin_amdgcn_readfirstlane(p.NBLK()[0]), 2 * DEXP / 256, G, (int)blockIdx.x, p.BLOCK_E()};
            pg8::EpiSwiglu E{p.HH(), DEXP, p.exp_b_gu + (size_t)l * NEXP * 2 * DEXP, 2 * DEXP};
            pg8::gemm_phase(ldsp, g, S, E);
            SEAM(pb + 12);
        }
        if (PHON(13) && IN(pb + 13)) { PHASE_VARS; (void)tid_; (void)wave;
            pg8::Gemm g{p.HH(), p.WDN_T(), DEXP, (size_t)D * DEXP}; pg8::MoeOrder S{__builtin_amdgcn_readfirstlane(p.NBLK()[0]), D / 256, G, (int)blockIdx.x, p.BLOCK_E()};
            pg8::EpiBf16Bias E{p.YB(), D, p.exp_b_dn + (size_t)l * NEXP * D, D};
            pg8::gemm_phase(ldsp, g, S, E);
            SEAM(pb + 13);
        }
        if (PHON(14) && IN(pb + 14)) { PHASE_VARS; dev_combine(p, l, ntok_l, gw, ngw, lane); if (l + 1 < DEPTH) SEAM(pb + 14); }
    }
#undef IN
#undef SEAM
}

#ifndef N_LAUNCH_MODE
#define N_LAUNCH_MODE 1
#endif
extern "C" void kernel_launch(void* const* d_in, const int* in_sizes, int n_in, void* d_out, int out_size, void* d_ws, size_t ws_size, hipStream_t stream) {
    static int grid = 0;
    if (grid == 0) {
        int dev = 0, cus = 0;
        if (hipGetDevice(&dev) != hipSuccess || hipDeviceGetAttribute(&cus, hipDeviceAttributeMultiprocessorCount, dev) != hipSuccess) { grid = -1; return; }
        if (hipFuncSetAttribute((const void*)fwd_kernel, hipFuncAttributeMaxDynamicSharedMemorySize, LDS_BYTES) != hipSuccess) { fprintf(stderr, "hipFuncSetAttribute failed\n"); grid = -1; return; }
        int per_cu = 0;
        if (hipOccupancyMaxActiveBlocksPerMultiprocessor(&per_cu, (const void*)fwd_kernel, NTHR, LDS_BYTES) != hipSuccess || per_cu < 1) fprintf(stderr, "occupancy query: %d\n", per_cu);
        (void)hipGetLastError();
        grid = cus;
    }
    if (grid < 0) return;
    unsigned char* ws = (unsigned char*)d_ws;
    (void)hipMemsetAsync(ws, 0, CTL_BYTES, stream);
    Args a{};
    P& p = a.p;
    const float* const* in = (const float* const*)d_in;
    p.x = in[0]; p.c = in[1]; p.ctx = in[2]; p.c_ctx = in[3]; p.ada_w = in[4]; p.ada_b = in[5]; p.pre_norm = in[6]; p.post_norm = in[7]; p.w_in = in[8]; p.w_out = in[9];
    p.rw_mu = in[10]; p.rw_w0 = in[11]; p.rw_w2 = in[12]; p.rw_a0 = in[13]; p.rw_a2 = in[14]; p.rw_g2 = in[15]; p.rw_k_k = in[16]; p.rw_k_a = in[17]; p.rw_r_k = in[18]; p.rw_ln_w = in[19]; p.rw_ln_b = in[20];
    p.gdn_conv = in[21]; p.gdn_a_log = in[22]; p.gdn_dt_bias = in[23]; p.gdn_norm = in[24]; p.attn_q_norm = in[25]; p.attn_k_norm = in[26];
    p.router_w = in[27]; p.router_b = in[28]; p.exp_w_gu = in[29]; p.exp_b_gu = in[30]; p.exp_w_dn = in[31]; p.exp_b_dn = in[32];
    p.out = (float*)d_out;
    p.ws = ws; p.tokf = nullptr;
#ifdef PROBE_GDN
    if (WS_TOTAL + (size_t)2 * NTOK * B_W * 4 > ws_size) { fprintf(stderr, "probe: ws too small\n"); return; }
#endif
    if (WS_TOTAL > ws_size) { fprintf(stderr, "kernel_launch: workspace too small: need %zu have %zu\n", (size_t)WS_TOTAL, ws_size); return; }
    const int nph = 1 + DEPTH * NPH;
#if N_LAUNCH_MODE == 1
    a.ph_lo = 0; a.ph_hi = nph;
    hipLaunchKernelGGL(fwd_kernel, dim3(grid), dim3(NTHR), LDS_BYTES, stream, a);
#else
    for (int ph = 0; ph < nph; ++ph) { a.ph_lo = ph; a.ph_hi = ph + 1; hipLaunchKernelGGL(fwd_kernel, dim3(grid), dim3(NTHR), LDS_BYTES, stream, a); }
#endif
}
#endif
```

```cpp
#ifndef HOST_TEST
#include <hip/hip_runtime.h>
#else
struct uint4 { unsigned x, y, z, w; };
#endif
#include <cstdio>
#include <cstdint>
#include <cmath>

#ifndef CFG_BATCH
#define CFG_BATCH 16
#define CFG_SEQ 2048
#define CFG_CTX 256
#define CFG_NEXP 32
#define CFG_DEXP 1024
#endif
constexpr int D = 1024, BATCH = CFG_BATCH, SEQ = CFG_SEQ, CTXL = CFG_CTX, DEPTH = 2, GRID_W = 64;
constexpr int NLAT = BATCH * SEQ, NCTX = BATCH * CTXL, NTOK = NLAT + NCTX;
constexpr int A_W = 256, A_H = 4, A_IN = 960;
constexpr int B_W = 512, B_H = 4, B_IN = 2064, B_OFF = 960;
constexpr int C_W = 256, C_IN = 512, C_OFF = 3024;
constexpr int INW = 3536, INP = 3584;
constexpr int NEXP = CFG_NEXP, TOPK = 4, DEXP = CFG_DEXP;
constexpr int NBLK_MAX = (NTOK * TOPK + 255) / 256 + NEXP, NSLOT = NBLK_MAX * 256;
constexpr int ZROW = NTOK;
constexpr int SLEN = CTXL + SEQ;

#ifdef HOST_TEST
#define DEVFN static inline
#define GLOBAL_ATOMIC_ADD(p, v) ((*(p)) += (v), (*(p)) - (v))
#else
#define DEVFN __device__ __forceinline__
#define GLOBAL_ATOMIC_ADD(p, v) atomicAdd((p), (v))
#endif
#ifdef HOST_TEST
#define UNIFORM(x) (x)
#define LOADFENCE()
#else
#define UNIFORM(x) __builtin_amdgcn_readfirstlane(x)
#define LOADFENCE() asm volatile("" ::: "memory")
#endif
typedef unsigned short bf16_t;
DEVFN bf16_t f2bf(float f) { unsigned u = __builtin_bit_cast(unsigned, f); return (bf16_t)((u + 0x7fffu + ((u >> 16) & 1u)) >> 16); }
DEVFN float bf2f(bf16_t b) { unsigned u = ((unsigned)b) << 16; return __builtin_bit_cast(float, u); }
DEVFN float sigmoidf_(float x) { return 1.0f / (1.0f + expf(-x)); }
DEVFN float siluf_(float x) { return x / (1.0f + expf(-x)); }
DEVFN float softplusf_(float x) { return x > 20.f ? x : log1pf(expf(x)); }

#ifdef HOST_TEST
#define WSACC inline
#else
#define WSACC __device__ __host__ __forceinline__
#endif
constexpr size_t CTL_BYTES = 64 * 1024;
constexpr size_t al256(size_t x) { return (x + 255) & ~(size_t)255; }
constexpr size_t WSO_ctl = 0;
constexpr size_t WSE_ctl = WSO_ctl + al256(CTL_BYTES);
constexpr size_t WSO_MOD = WSE_ctl;
constexpr size_t WSE_MOD = WSO_MOD + al256((size_t)DEPTH * (BATCH + 1) * 6 * D * 4);
constexpr size_t WSO_X = WSE_MOD;
constexpr size_t WSE_X = WSO_X + al256((size_t)(NTOK + 1) * D * 4);
constexpr size_t WSO_HB = WSE_X;
constexpr size_t WSE_HB = WSO_HB + al256((size_t)(NTOK + 1) * D * 2);
constexpr size_t WSO_WIN_T = WSE_HB;
constexpr size_t WSE_WIN_T = WSO_WIN_T + al256((size_t)INP * D * 2);
constexpr size_t WSO_WOUT_T = WSE_WIN_T;
constexpr size_t WSE_WOUT_T = WSO_WOUT_T + al256((size_t)D * D * 2);
constexpr size_t WSO_WR_T = WSE_WOUT_T;
constexpr size_t WSE_WR_T = WSO_WR_T + al256((size_t)64 * D * 2);
constexpr size_t WSO_WGU_T = WSE_WR_T;
constexpr size_t WSE_WGU_T = WSO_WGU_T + al256((size_t)NEXP * 2 * DEXP * D * 2);
constexpr size_t WSO_WDN_T = WSE_WGU_T;
constexpr size_t WSE_WDN_T = WSO_WDN_T + al256((size_t)NEXP * D * DEXP * 2);
constexpr size_t WSZ_WSET = WSE_WDN_T - WSO_WIN_T;
constexpr size_t WSO_TOPI = WSE_WDN_T + WSZ_WSET;
constexpr size_t WSE_TOPI = WSO_TOPI + al256((size_t)NTOK * 4 * 4);
constexpr size_t WSO_POS = WSE_TOPI;
constexpr size_t WSE_POS = WSO_POS + al256((size_t)NTOK * 4 * 4);
constexpr size_t WSO_TSLOT = WSE_POS;
constexpr size_t WSE_TSLOT = WSO_TSLOT + al256((size_t)NTOK * 4 * 4);
constexpr size_t WSO_TOPG = WSE_TSLOT;
constexpr size_t WSE_TOPG = WSO_TOPG + al256((size_t)NTOK * 4 * 4);
constexpr size_t WSO_SLOT_TOK = WSE_TOPG;
constexpr size_t WSE_SLOT_TOK = WSO_SLOT_TOK + al256((size_t)NSLOT * 4);
constexpr size_t WSO_BLOCK_E = WSE_SLOT_TOK;
constexpr size_t WSE_BLOCK_E = WSO_BLOCK_E + al256((size_t)NBLK_MAX * 4);
constexpr size_t WSO_NBLK = WSE_BLOCK_E;
constexpr size_t WSE_NBLK = WSO_NBLK + al256(256);
constexpr size_t WSO_U = WSE_NBLK;
constexpr size_t WSE_U = WSO_U + al256((size_t)NTOK * INP * 2);
constexpr size_t WSO_MO = WSE_U;
constexpr size_t WSE_MO = WSO_MO + al256((size_t)NTOK * D * 2);
constexpr size_t WSO_ROPE = WSE_MO;
constexpr size_t WSE_ROPE = WSO_ROPE + al256((size_t)SEQ * 128 * 4);
constexpr size_t WSO_WLR_T = WSE_ROPE;
constexpr size_t WSE_WLR_T = WSO_WLR_T + 2 * al256((size_t)1280 * 256 * 2);
constexpr size_t WSO_END_P = WSE_WLR_T;
constexpr size_t WSO_LR = WSO_END_P;
constexpr size_t WSE_LR = WSO_LR + al256((size_t)NTOK * 192 * 4);
#ifdef HOST_TEST
constexpr size_t WSO_RW_R = WSE_LR;
#else
constexpr size_t WSO_RW_R = WSO_LR;
#endif
constexpr size_t WSE_RW_R = WSO_RW_R + al256((size_t)NTOK * A_W * 2);
constexpr size_t WSO_RW_V = WSE_RW_R;
constexpr size_t WSE_RW_V = WSO_RW_V + al256((size_t)NTOK * A_W * 2);
constexpr size_t WSO_RW_KK = WSE_RW_V;
constexpr size_t WSE_RW_KK = WSO_RW_KK + al256((size_t)NTOK * A_W * 2);
constexpr size_t WSO_RW_D = WSE_RW_KK;
constexpr size_t WSE_RW_D = WSO_RW_D + al256((size_t)2 * NTOK * A_W * 4);
constexpr size_t WSO_RW_KD = WSE_RW_D;
constexpr size_t WSE_RW_KD = WSO_RW_KD + al256((size_t)2 * NTOK * A_W * 2);
constexpr size_t WSO_RW_KKA = WSE_RW_KD;
constexpr size_t WSE_RW_KKA = WSO_RW_KKA + al256((size_t)2 * NTOK * A_W * 2);
constexpr size_t WSO_RW_GATE = WSE_RW_KKA;
constexpr size_t WSE_RW_GATE = WSO_RW_GATE + al256((size_t)NTOK * A_W * 2);
constexpr size_t WSO_RW_BON = WSE_RW_GATE;
constexpr size_t WSE_RW_BON = WSO_RW_BON + al256((size_t)NTOK * A_H * 4);
constexpr size_t WSO_YA = WSE_RW_BON;
constexpr size_t WSE_YA = WSO_YA + al256((size_t)2 * NTOK * A_W * 2);
constexpr size_t WSO_GQ = WSE_YA;
constexpr size_t WSE_GQ = WSO_GQ + al256((size_t)NTOK * B_W * 2);
constexpr size_t WSO_GK = WSE_GQ;
constexpr size_t WSE_GK = WSO_GK + al256((size_t)NTOK * B_W * 2);
constexpr size_t WSO_GV = WSE_GK;
constexpr size_t WSE_GV = WSO_GV + al256((size_t)NTOK * B_W * 2);
constexpr size_t WSO_GG = WSE_GV;
constexpr size_t WSE_GG = WSO_GG + al256((size_t)NTOK * 8 * 4);
constexpr size_t WSO_GBETA = WSE_GG;
constexpr size_t WSE_GBETA = WSO_GBETA + al256((size_t)NTOK * 8 * 4);
constexpr size_t WSO_OB = WSE_GBETA;
constexpr size_t WSE_OB = WSO_OB + al256((size_t)2 * NTOK * B_W * 2);
constexpr size_t WSO_CQ = WSE_OB;
constexpr size_t WSE_CQ = WSO_CQ + al256((size_t)NTOK * 256 * 2);
constexpr size_t WSO_CK = WSE_CQ;
constexpr size_t WSE_CK = WSO_CK + al256((size_t)NTOK * 128 * 2);
constexpr size_t WSO_CV = WSE_CK;
constexpr size_t WSE_CV = WSO_CV + al256((size_t)NTOK * 128 * 2);
constexpr size_t WSO_RWC = WSE_CV;
constexpr size_t WSE_RWC = WSO_RWC + al256((size_t)2 * BATCH * A_H * (SLEN / 64) * 5 * 4096 * 2);
constexpr size_t WSO_LRT = WSE_RWC;
constexpr size_t WSE_LRT = WSO_LRT + al256((size_t)NTOK * 256 * 2);
constexpr size_t WSO_LRO = WSE_LRT;
constexpr size_t WSE_LRO = WSO_LRO + al256((size_t)NTOK * 1280 * 2);
constexpr size_t WSO_MIX = WSE_LRO;
constexpr size_t WSE_MIX = WSO_MIX + al256((size_t)NTOK * D * 2);
constexpr size_t WSO_XG = WSO_END_P;
constexpr size_t WSE_XG = WSO_XG + al256((size_t)NSLOT * D * 2);
constexpr size_t WSO_HH = WSE_XG;
constexpr size_t WSE_HH = WSO_HH + al256((size_t)NSLOT * DEXP * 2);
constexpr size_t WSO_YB = WSE_HH;
constexpr size_t WSE_YB = WSO_YB + al256((size_t)NSLOT * D * 2);
constexpr size_t WS_TOTAL = (WSE_MIX > WSE_YB ? WSE_MIX : WSE_YB);
struct P {
    const float *x, *c, *ctx, *c_ctx, *ada_w, *ada_b, *pre_norm, *post_norm, *w_in, *w_out;
    const float *rw_mu, *rw_w0, *rw_w2, *rw_a0, *rw_a2, *rw_g2, *rw_k_k, *rw_k_a, *rw_r_k, *rw_ln_w, *rw_ln_b;
    const float *gdn_conv, *gdn_a_log, *gdn_dt_bias, *gdn_norm, *attn_q_norm, *attn_k_norm;
    const float *router_w, *router_b, *exp_w_gu, *exp_b_gu, *exp_w_dn, *exp_b_dn;
    float* out;
    unsigned char* ws;
    WSACC unsigned* ctl() const { return (unsigned*)(ws + WSO_ctl); }
    WSACC float* MOD() const { return (float*)(ws + WSO_MOD); }
    WSACC float* X() const { return (float*)(ws + WSO_X); }
    WSACC bf16_t* HB() const { return (bf16_t*)(ws + WSO_HB); }
    WSACC bf16_t* WIN_T(int l) const { return (bf16_t*)(ws + WSO_WIN_T + (size_t)l * WSZ_WSET); }
    WSACC bf16_t* WOUT_T(int l) const { return (bf16_t*)(ws + WSO_WOUT_T + (size_t)l * WSZ_WSET); }
    WSACC bf16_t* WR_T(int l) const { return (bf16_t*)(ws + WSO_WR_T + (size_t)l * WSZ_WSET); }
    WSACC bf16_t* WGU_T(int l) const { return (bf16_t*)(ws + WSO_WGU_T + (size_t)l * WSZ_WSET); }
    WSACC bf16_t* WDN_T(int l) const { return (bf16_t*)(ws + WSO_WDN_T + (size_t)l * WSZ_WSET); }
    WSACC int* TOPI() const { return (int*)(ws + WSO_TOPI); }
    WSACC int* POS() const { return (int*)(ws + WSO_POS); }
    WSACC int* TSLOT() const { return (int*)(ws + WSO_TSLOT); }
    WSACC float* TOPG() const { return (float*)(ws + WSO_TOPG); }
    WSACC int* SLOT_TOK() const { return (int*)(ws + WSO_SLOT_TOK); }
    WSACC int* BLOCK_E() const { return (int*)(ws + WSO_BLOCK_E); }
    WSACC int* NBLK() const { return (int*)(ws + WSO_NBLK); }
    WSACC bf16_t* U() const { return (bf16_t*)(ws + WSO_U); }
    WSACC bf16_t* MO() const { return (bf16_t*)(ws + WSO_MO); }
    WSACC float* LR() const { return (float*)(ws + WSO_LR); }
    WSACC bf16_t* RW_R() const { return (bf16_t*)(ws + WSO_RW_R); }
    WSACC bf16_t* RW_V() const { return (bf16_t*)(ws + WSO_RW_V); }
    WSACC bf16_t* RW_KK() const { return (bf16_t*)(ws + WSO_RW_KK); }
    WSACC float* RW_D() const { return (float*)(ws + WSO_RW_D); }
    WSACC bf16_t* RW_KD() const { return (bf16_t*)(ws + WSO_RW_KD); }
    WSACC bf16_t* RW_KKA() const { return (bf16_t*)(ws + WSO_RW_KKA); }
    WSACC bf16_t* RW_GATE() const { return (bf16_t*)(ws + WSO_RW_GATE); }
    WSACC float* RW_BON() const { return (float*)(ws + WSO_RW_BON); }
    WSACC bf16_t* YA() const { return (bf16_t*)(ws + WSO_YA); }
    WSACC bf16_t* GQ() const { return (bf16_t*)(ws + WSO_GQ); }
    WSACC bf16_t* GK() const { return (bf16_t*)(ws + WSO_GK); }
    WSACC bf16_t* GV() const { return (bf16_t*)(ws + WSO_GV); }
    WSACC float* GG() const { return (float*)(ws + WSO_GG); }
    WSACC float* GBETA() const { return (float*)(ws + WSO_GBETA); }
    WSACC bf16_t* OB() const { return (bf16_t*)(ws + WSO_OB); }
    WSACC bf16_t* CQ() const { return (bf16_t*)(ws + WSO_CQ); }
    WSACC bf16_t* CK() const { return (bf16_t*)(ws + WSO_CK); }
    WSACC bf16_t* CV() const { return (bf16_t*)(ws + WSO_CV); }
    WSACC bf16_t* MIX() const { return (bf16_t*)(ws + WSO_MIX); }
    WSACC bf16_t* RWC() const { return (bf16_t*)(ws + WSO_RWC); }
    WSACC float* ROPE() const { return (float*)(ws + WSO_ROPE); }
    WSACC bf16_t* LRT() const { return (bf16_t*)(ws + WSO_LRT); }
    WSACC bf16_t* LRO() const { return (bf16_t*)(ws + WSO_LRO); }
    WSACC bf16_t* WLR_T(int l) const { return (bf16_t*)(ws + WSO_WLR_T + (size_t)l * al256((size_t)1280 * 256 * 2)); }
    WSACC bf16_t* XG() const { return (bf16_t*)(ws + WSO_XG); }
    WSACC bf16_t* HH() const { return (bf16_t*)(ws + WSO_HH); }
    WSACC bf16_t* YB() const { return (bf16_t*)(ws + WSO_YB); }
    WSACC int* cnt() const { return (int*)(ws + WSO_ctl) + 8192; }
    WSACC float* TOKF() const { return tokf; }
    float* tokf;
};

DEVFN void row_info(int m, int& b, int& t, int& len, int& base) {
    if (m < NLAT) { b = m / SEQ; t = m % SEQ; len = SEQ; base = b * SEQ; }
    else { const int mc = m - NLAT; b = mc / CTXL; t = mc % CTXL; len = CTXL; base = NLAT + b * CTXL; }
}
DEVFN float ldU(const P& p, size_t idx) { return bf2f(p.U()[idx]); }
DEVFN int mod_row(int m) { return m < NLAT ? m / SEQ : BATCH; }
DEVFN int scan_row(int dir, int b, int s) {
    if (s < CTXL) { const int ts = dir ? (CTXL - 1 - s) : s; return NLAT + b * CTXL + ts; }
    const int s2 = s - CTXL; const int ts = dir ? (SEQ - 1 - s2) : s2; return b * SEQ + ts;
}

DEVFN void task_mod(const P& p, long task) {
    const int j = (int)(task % (6 * D)); const int r = (int)((task / (6 * D)) % (BATCH + 1)); const int l = (int)(task / ((long)(6 * D) * (BATCH + 1)));
    const float* cv = (r < BATCH) ? p.c + (size_t)r * D : p.c_ctx;
    const float* w = p.ada_w + (size_t)l * D * 6 * D + j;
    float acc = 0.f;
    for (int k = 0; k < D; ++k) acc += siluf_(cv[k]) * w[(size_t)k * 6 * D];
    p.MOD()[((size_t)l * (BATCH + 1) + r) * 6 * D + j] = acc + p.ada_b[(size_t)l * 6 * D + j];
}
DEVFN void task_copyx(const P& p, long task) {
    const long n_lat = (long)NLAT * D;
    p.X()[task] = task < n_lat ? p.x[task] : p.ctx[task - n_lat];
}
DEVFN void task_norm1(const P& p, int l, long task) {
    const int m = (int)task; const float* xr = p.X() + (size_t)m * D;
    float ss = 0.f; for (int k = 0; k < D; ++k) ss += xr[k] * xr[k];
    const float rstd = 1.0f / sqrtf(ss / D + 1e-6f);
    const float* md = p.MOD() + ((size_t)l * (BATCH + 1) + mod_row(m)) * 6 * D; const float* pn = p.pre_norm + (size_t)(l * 2 + 0) * D;
    bf16_t* o = p.HB() + (size_t)m * D;
    for (int k = 0; k < D; ++k) o[k] = f2bf(xr[k] * rstd * pn[k] * (1.0f + md[D + k]) + md[k]);
}
DEVFN float lerpA(const P& p, int l, int m, int col) {
    int b, t, len, base; row_info(m, b, t, len, base);
    const float u = ldU(p, (size_t)m * INP + col);
    const float up = t > 0 ? ldU(p, (size_t)(m - 1) * INP + col) : 0.f, un = t + 1 < len ? ldU(p, (size_t)(m + 1) * INP + col) : 0.f;
    return u + p.rw_mu[l * A_IN + col] * (0.5f * (up + un) - u);
}
DEVFN void task_prepA0(const P& p, int l, long task) {
    const int m = (int)(task / 192), j = (int)(task % 192);
    const float v = lerpA(p, l, m, 768 + j);
    p.LR()[(size_t)m * 192 + j] = j < 64 ? tanhf(v) : (j < 128 ? v : sigmoidf_(v));
}
DEVFN void task_prepA1(const P& p, int l, long task) {
    const int m = (int)(task / A_H), h = (int)(task % A_H);
    const float* lr = p.LR() + (size_t)m * 192;
    float ss = 0.f;
    for (int c = 0; c < 64; ++c) { const int ch = h * 64 + c; const float kx = lerpA(p, l, m, 256 + ch) * p.rw_k_k[l * A_W + ch]; ss += kx * kx; }
    const float rn = 1.0f / sqrtf(ss + 1e-6f);
    float bon = 0.f;
    for (int c = 0; c < 64; ++c) {
        const int ch = h * 64 + c;
        const float r = lerpA(p, l, m, ch), k = lerpA(p, l, m, 256 + ch), v = lerpA(p, l, m, 512 + ch);
        const float kk = k * p.rw_k_k[l * A_W + ch] * rn;
        float kdsum = 0.f;
        for (int dir = 0; dir < 2; ++dir) {
            float w = p.rw_w0[(l * 2 + dir) * A_W + ch], a = p.rw_a0[(l * 2 + dir) * A_W + ch];
            const float* w2 = p.rw_w2 + ((size_t)(l * 2 + dir) * 32) * A_W + ch; const float* a2 = p.rw_a2 + ((size_t)(l * 2 + dir) * 32) * A_W + ch;
            for (int r2 = 0; r2 < 32; ++r2) { w += lr[dir * 32 + r2] * w2[(size_t)r2 * A_W]; a += lr[64 + dir * 32 + r2] * a2[(size_t)r2 * A_W]; }
            const float decay = -expf(-softplusf_(-w) - 0.5f);
            const float iclr = sigmoidf_(a);
            const float kd = k * (1.0f + (iclr - 1.0f) * p.rw_k_a[l * A_W + ch]);
            const size_t o = ((size_t)dir * NTOK + m) * A_W + ch;
            p.RW_D()[o] = decay; p.RW_KD()[o] = f2bf(kd); p.RW_KKA()[o] = f2bf(kk * iclr); kdsum += kd;
        }
        float g = 0.f; const float* g2 = p.rw_g2 + (size_t)l * 64 * A_W + ch;
        for (int r2 = 0; r2 < 64; ++r2) g += lr[128 + r2] * g2[(size_t)r2 * A_W];
        const size_t o = (size_t)m * A_W + ch;
        p.RW_R()[o] = f2bf(r); p.RW_V()[o] = f2bf(v); p.RW_KK()[o] = f2bf(kk); p.RW_GATE()[o] = f2bf(g);
        bon += r * kdsum * p.rw_r_k[l * A_W + ch];
    }
    p.RW_BON()[(size_t)m * A_H + h] = bon;
}
DEVFN void task_prepB(const P& p, int l, long task) {
    const int which = (int)(task % 4), h = (int)((task / 4) % B_H), m = (int)(task / (4 * B_H));
    int b, t, len, base; row_info(m, b, t, len, base);
    if (which == 3) {
        for (int dir = 0; dir < 2; ++dir) {
            const float a = ldU(p, (size_t)m * INP + B_OFF + 2048 + dir * 4 + h), bb = ldU(p, (size_t)m * INP + B_OFF + 2056 + dir * 4 + h);
            const float g = -expf(p.gdn_a_log[(l * 2 + dir) * B_H + h]) * softplusf_(a + p.gdn_dt_bias[(l * 2 + dir) * B_H + h]);
            p.GG()[(size_t)m * 8 + dir * 4 + h] = g; p.GBETA()[(size_t)m * 8 + dir * 4 + h] = sigmoidf_(bb);
        }
        return;
    }
    bf16_t* dst = (which == 0 ? p.GQ() : which == 1 ? p.GK() : p.GV()) + (size_t)m * B_W + h * 128;
    float ss = 0.f;
    for (int c = 0; c < 128; ++c) {
        const int cc = which * B_W + h * 128 + c; const int col = B_OFF + cc;
        float acc = 0.f;
        for (int j = 0; j < 5; ++j) { const int tt = t + j - 2; if (tt >= 0 && tt < len) acc += ldU(p, (size_t)(base + tt) * INP + col) * p.gdn_conv[((size_t)l * 5 + j) * (3 * B_W) + cc]; }
        const float s = siluf_(acc); if (which == 2) dst[c] = f2bf(s); ss += s * s;
    }
    if (which < 2) { const float rn = (1.0f / sqrtf(ss + 1e-6f)) * (which == 0 ? 0.08838834764831845f : 1.0f);
        for (int c = 0; c < 128; ++c) { const int cc = which * B_W + h * 128 + c; const int col = B_OFF + cc; float acc = 0.f;
            for (int j = 0; j < 5; ++j) { const int tt = t + j - 2; if (tt >= 0 && tt < len) acc += ldU(p, (size_t)(base + tt) * INP + col) * p.gdn_conv[((size_t)l * 5 + j) * (3 * B_W) + cc]; }
            dst[c] = f2bf(siluf_(acc) * rn); } }
}
DEVFN void task_prepC(const P& p, int l, long task) {
    const int m = (int)(task / 8), hs = (int)(task % 8);
    const size_t sb = (size_t)m * INP + C_OFF + hs * 64;
    if (hs >= 6) { int b_, t_, len_, base_; row_info(m, b_, t_, len_, base_); const int key = m < NLAT ? t_ : SEQ + t_;
        for (int d = 0; d < 64; ++d) p.CV()[((size_t)(b_ * 2 + (hs - 6)) * 64 + d) * SLEN + key] = p.U()[sb + d]; return; }
    float ss = 0.f; for (int d = 0; d < 64; ++d) { const float x = ldU(p, sb + d); ss += x * x; }
    const float qs = hs < 4 ? 0.18033688011112042f : 1.0f;
    const float rstd = (1.0f / sqrtf(ss / 64.f + 1e-6f)) * qs;
    const float* nw = (hs < 4 ? p.attn_q_norm : p.attn_k_norm) + l * 64;
    bf16_t* dst = hs < 4 ? p.CQ() + (size_t)m * 256 + hs * 64 : p.CK() + (size_t)m * 128 + (hs - 4) * 64;
    if (m >= NLAT) { for (int d = 0; d < 64; ++d) dst[d] = f2bf(ldU(p, sb + d) * rstd * nw[d]); return; }
    const int t = m % SEQ; const float pr = (float)(t / GRID_W), pc = (float)(t % GRID_W);
    for (int d = 0; d < 16; ++d) {
        const float fr = powf(10000.0f, -(float)d / 16.0f);
        const float ar = pr * fr, ac = pc * fr; const float cr = cosf(ar), sr = sinf(ar), cc = cosf(ac), sc = sinf(ac);
        const float x1 = ldU(p, sb + d) * rstd * nw[d], x2 = ldU(p, sb + 16 + d) * rstd * nw[16 + d], x3 = ldU(p, sb + 32 + d) * rstd * nw[32 + d], x4 = ldU(p, sb + 48 + d) * rstd * nw[48 + d];
        dst[d] = f2bf(x1 * cr - x2 * sr); dst[16 + d] = f2bf(x2 * cr + x1 * sr); dst[32 + d] = f2bf(x3 * cc - x4 * sc); dst[48 + d] = f2bf(x4 * cc + x3 * sc);
    }
}
DEVFN void task_scanA(const P& p, long task) {
    const int v = (int)(task % 64), chain = UNIFORM((int)(task / 64)); const int h = chain % A_H, b = (chain / A_H) % BATCH, dir = chain / (A_H * BATCH);
    float s[64];
#pragma unroll
    for (int k = 0; k < 64; ++k) s[k] = 0.f;
    for (int st = 0; st < SLEN; ++st) {
        const int m = scan_row(dir, b, st);
        const bf16_t* kk = p.RW_KK() + (size_t)m * A_W + h * 64; const bf16_t* rr = p.RW_R() + (size_t)m * A_W + h * 64;
        const size_t od = ((size_t)dir * NTOK + m) * A_W + h * 64;
        const float* dd = p.RW_D() + od; const bf16_t* kd = p.RW_KD() + od; const bf16_t* ka = p.RW_KKA() + od;
        const float vv = bf2f(p.RW_V()[(size_t)m * A_W + h * 64 + v]);
        float sa = 0.f;
#pragma unroll
        for (int k = 0; k < 64; ++k) { sa += s[k] * bf2f(kk[k]); if ((k & 15) == 15) LOADFENCE(); }
        float y = 0.f;
#pragma unroll
        for (int k = 0; k < 64; ++k) { s[k] = s[k] * expf(dd[k]) - sa * bf2f(ka[k]) + vv * bf2f(kd[k]); y += s[k] * bf2f(rr[k]); if ((k & 7) == 7) LOADFENCE(); }
        p.YA()[((size_t)dir * NTOK + m) * A_W + h * 64 + v] = f2bf(y);
    }
}
DEVFN void task_scanB(const P& p, long task) {
    const int j = (int)(task % 128), chain = UNIFORM((int)(task / 128)); const int h = chain % B_H, b = (chain / B_H) % BATCH, dir = chain / (B_H * BATCH);
    float s[128];
#pragma unroll
    for (int k = 0; k < 128; ++k) s[k] = 0.f;
    for (int st = 0; st < SLEN; ++st) {
        const int m = scan_row(dir, b, st);
        const bf16_t* kv = p.GK() + (size_t)m * B_W + h * 128; const bf16_t* qv = p.GQ() + (size_t)m * B_W + h * 128;
        const float vj = bf2f(p.GV()[(size_t)m * B_W + h * 128 + j]);
        const float eg = expf(p.GG()[(size_t)m * 8 + dir * 4 + h]), beta = p.GBETA()[(size_t)m * 8 + dir * 4 + h];
        float pk = 0.f;
#pragma unroll
        for (int k = 0; k < 128; ++k) { pk += s[k] * bf2f(kv[k]); if ((k & 15) == 15) LOADFENCE(); }
        const float cf = beta * (vj - eg * pk);
        float o = 0.f;
#pragma unroll
        for (int k = 0; k < 128; ++k) { s[k] = eg * s[k] + cf * bf2f(kv[k]); o += s[k] * bf2f(qv[k]); if ((k & 7) == 7) LOADFENCE(); }
        p.OB()[((size_t)dir * NTOK + m) * B_W + h * 128 + j] = f2bf(o);
    }
}
DEVFN void task_attn(const P& p, int need_ctx, long task) {
    const int t = (int)(task % SLEN), hq = UNIFORM((int)((task / SLEN) % 4)), b = UNIFORM((int)(task / ((long)SLEN * 4)));
    const bool is_lat = UNIFORM((int)(t < SEQ)) != 0; if (!is_lat && !need_ctx) return;
    const int m = is_lat ? b * SEQ + t : NLAT + b * CTXL + (t - SEQ);
    const int kvh = hq >> 1;
    float q[64], o[64];
#pragma unroll
    for (int d = 0; d < 64; ++d) { q[d] = bf2f(p.CQ()[(size_t)m * 256 + hq * 64 + d]); o[d] = 0.f; }
    float mx = -1e30f, lsum = 0.f;
    const int nk = is_lat ? SLEN : CTXL;
    for (int kI = 0; kI < nk; ++kI) {
        int km; if (is_lat) km = kI < SEQ ? b * SEQ + kI : NLAT + b * CTXL + (kI - SEQ); else km = NLAT + b * CTXL + kI;
        const bf16_t* kr = p.CK() + (size_t)km * 128 + kvh * 64; const bf16_t* vr = p.CV() + ((size_t)(b * 2 + kvh) * 64) * SLEN + (is_lat ? kI : SEQ + kI);
        float sc = 0.f;
#pragma unroll
        for (int d = 0; d < 64; ++d) { sc += q[d] * bf2f(kr[d]); if ((d & 15) == 15) LOADFENCE(); }
        const float mn = sc > mx ? sc : mx; const float f = exp2f(mx - mn), pe = exp2f(sc - mn);
        lsum = lsum * f + pe; mx = mn;
#pragma unroll
        for (int d = 0; d < 64; ++d) { o[d] = o[d] * f + pe * bf2f(vr[(size_t)d * SLEN]); if ((d & 15) == 15) LOADFENCE(); }
    }
    const float inv = 1.0f / lsum;
#pragma unroll
    for (int d = 0; d < 64; ++d) p.MIX()[(size_t)m * D + 768 + hq * 64 + d] = f2bf(o[d] * inv);
}
DEVFN void task_post(const P& p, int l, long task) {
    const int m = (int)(task / 8), g = (int)(task % 8);
    if (g < 4) {
        const int h = g; const bf16_t* y0 = p.YA() + (size_t)m * A_W + h * 64; const bf16_t* y1 = p.YA() + ((size_t)NTOK + m) * A_W + h * 64;
        float mean = 0.f; for (int c = 0; c < 64; ++c) mean += bf2f(y0[c]) + bf2f(y1[c]); mean *= (1.0f / 64.f);
        float var = 0.f; for (int c = 0; c < 64; ++c) { const float d0 = bf2f(y0[c]) + bf2f(y1[c]) - mean; var += d0 * d0; } var *= (1.0f / 64.f);
        const float rs = 1.0f / sqrtf(var + 64e-5f); const float bon = p.RW_BON()[(size_t)m * A_H + h];
        for (int c = 0; c < 64; ++c) { const int ch = h * 64 + c;
            const float yn = (bf2f(y0[c]) + bf2f(y1[c]) - mean) * rs * p.rw_ln_w[l * A_W + ch] + p.rw_ln_b[l * A_W + ch];
            p.MIX()[(size_t)m * D + ch] = f2bf((yn + bon * bf2f(p.RW_V()[(size_t)m * A_W + ch])) * bf2f(p.RW_GATE()[(size_t)m * A_W + ch])); }
    } else {
        const int h = g - 4; const bf16_t* o0 = p.OB() + (size_t)m * B_W + h * 128; const bf16_t* o1 = p.OB() + ((size_t)NTOK + m) * B_W + h * 128;
        float ss = 0.f; for (int c = 0; c < 128; ++c) { const float o = bf2f(o0[c]) + bf2f(o1[c]); ss += o * o; }
        const float rs = 1.0f / sqrtf(ss / 128.f + 1e-6f);
        for (int c = 0; c < 128; ++c) { const float z = ldU(p, (size_t)m * INP + B_OFF + 1536 + h * 128 + c);
            p.MIX()[(size_t)m * D + 256 + h * 128 + c] = f2bf((bf2f(o0[c]) + bf2f(o1[c])) * rs * p.gdn_norm[l * 128 + c] * siluf_(z)); }
    }
}
DEVFN void task_resid1(const P& p, int l, long task) {
    const int m = (int)task; const bf16_t* mo = p.MO() + (size_t)m * D; float* xr = p.X() + (size_t)m * D;
    const float* md = p.MOD() + ((size_t)l * (BATCH + 1) + mod_row(m)) * 6 * D;
    float ss = 0.f; for (int k = 0; k < D; ++k) ss += bf2f(mo[k]) * bf2f(mo[k]);
    const float rstd = 1.0f / sqrtf(ss / D + 1e-6f); const float* pn = p.post_norm + (size_t)(l * 2 + 0) * D;
    float s2 = 0.f;
    for (int k = 0; k < D; ++k) { const float xv = xr[k] + md[2 * D + k] * (bf2f(mo[k]) * rstd) * pn[k]; xr[k] = xv; s2 += xv * xv; }
    const float r2 = 1.0f / sqrtf(s2 / D + 1e-6f); const float* pn2 = p.pre_norm + (size_t)(l * 2 + 1) * D;
    for (int k = 0; k < D; ++k) { const float tv = xr[k] * r2 * pn2[k] * (1.0f + md[4 * D + k]) + md[3 * D + k]; p.TOKF()[(size_t)m * D + k] = tv; p.HB()[(size_t)m * D + k] = f2bf(tv); }
}
DEVFN void task_router(const P& p, int l, long task) {
    const int m = (int)task; const float* tk = p.TOKF() + (size_t)m * D; const float* rw = p.router_w + (size_t)l * D * NEXP;
    float lg[NEXP];
#pragma unroll
    for (int e = 0; e < NEXP; ++e) lg[e] = p.router_b[l * NEXP + e];
    for (int k = 0; k < D; ++k) { const float tv = tk[k];
#pragma unroll
        for (int e = 0; e < NEXP; ++e) lg[e] += tv * rw[(size_t)k * NEXP + e]; }
    int idx[TOPK]; float val[TOPK];
#pragma unroll
    for (int j = 0; j < TOPK; ++j) { float best = -3.0e38f; int bi = 0;
#pragma unroll
        for (int e = 0; e < NEXP; ++e) { if (lg[e] > best) { best = lg[e]; bi = e; } }
        idx[j] = bi; val[j] = best;
#pragma unroll
        for (int e = 0; e < NEXP; ++e) if (e == bi) lg[e] = -3.0e38f; }
    float sum = 0.f, ex[TOPK];
#pragma unroll
    for (int j = 0; j < TOPK; ++j) { ex[j] = expf(val[j] - val[0]); sum += ex[j]; }
#pragma unroll
    for (int j = 0; j < TOPK; ++j) { p.TOPI()[(size_t)m * TOPK + j] = idx[j]; p.TOPG()[(size_t)m * TOPK + j] = ex[j] / sum; p.POS()[(size_t)m * TOPK + j] = GLOBAL_ATOMIC_ADD(&p.cnt()[l * NEXP + idx[j]], 1); }
}
DEVFN int moe_pstart(const P& p, int l, int e, int* nblk) {
    int acc = 0, ps = 0;
    for (int i = 0; i < NEXP; ++i) { if (i == e) ps = acc; acc += (p.cnt()[l * NEXP + i] + 255) / 256 * 256; }
    if (nblk) *nblk = acc / 256; return ps;
}
DEVFN void task_slots(const P& p, int l, long task) {
    const int e = p.TOPI()[task]; const int slot = moe_pstart(p, l, e, nullptr) + p.POS()[task];
    p.TSLOT()[task] = slot; p.SLOT_TOK()[slot] = (int)(task / TOPK);
}
DEVFN void task_blocke(const P& p, int l, long task) {
    int acc = 0, e_of = NEXP - 1, nb = 0;
    for (int i = 0; i < NEXP; ++i) { const int nbk = (p.cnt()[l * NEXP + i] + 255) / 256; if ((int)task >= acc && (int)task < acc + nbk) e_of = i; acc += nbk; }
    nb = acc; p.BLOCK_E()[task] = e_of; if (task == 0) p.NBLK()[0] = nb;
}
DEVFN void task_gather(const P& p, long task) {
    const long slot = task / 128; const int ch = (int)(task % 128); const int tok = p.SLOT_TOK()[slot];
    const uint4* s = (const uint4*)(p.HB() + (size_t)tok * D) + ch; ((uint4*)(p.XG() + (size_t)slot * D))[ch] = *s;
}
DEVFN void task_combine(const P& p, int l, long task) {
    const int m = (int)task; float* xr = p.X() + (size_t)m * D; const float* md = p.MOD() + ((size_t)l * (BATCH + 1) + mod_row(m)) * 6 * D;
    const bf16_t* y0 = p.YB() + (size_t)p.TSLOT()[(size_t)m * 4 + 0] * D; const bf16_t* y1 = p.YB() + (size_t)p.TSLOT()[(size_t)m * 4 + 1] * D;
    const bf16_t* y2 = p.YB() + (size_t)p.TSLOT()[(size_t)m * 4 + 2] * D; const bf16_t* y3 = p.YB() + (size_t)p.TSLOT()[(size_t)m * 4 + 3] * D;
    const float g0 = p.TOPG()[(size_t)m * 4 + 0], g1 = p.TOPG()[(size_t)m * 4 + 1], g2 = p.TOPG()[(size_t)m * 4 + 2], g3 = p.TOPG()[(size_t)m * 4 + 3];
    float ss = 0.f;
    for (int k = 0; k < D; ++k) { const float f = g0 * bf2f(y0[k]) + g1 * bf2f(y1[k]) + g2 * bf2f(y2[k]) + g3 * bf2f(y3[k]); ss += f * f; }
    const float rstd = 1.0f / sqrtf(ss / D + 1e-6f); const float* pn = p.post_norm + (size_t)(l * 2 + 1) * D;
    const bool last = (l == DEPTH - 1);
    for (int k = 0; k < D; ++k) { const float f = g0 * bf2f(y0[k]) + g1 * bf2f(y1[k]) + g2 * bf2f(y2[k]) + g3 * bf2f(y3[k]);
        const float xv = xr[k] + md[5 * D + k] * (f * rstd) * pn[k]; xr[k] = xv; if (last) p.out[(size_t)m * D + k] = xv; }
}

#ifndef HOST_TEST
namespace pg8 {
#define PG8_LAS __attribute__((address_space(3)))
typedef short bf16x8 __attribute__((ext_vector_type(8)));
typedef float f32x4 __attribute__((ext_vector_type(4)));
typedef unsigned u32x4 __attribute__((ext_vector_type(4)));
typedef unsigned u32x2 __attribute__((ext_vector_type(2)));
constexpr int BM = 256, BK = 64, HALF = 128, HTB = HALF * BK * 2, STAGE_BYTES = 8 * HTB, NXCD = 8, WGM = 8;
__host__ __device__ __forceinline__ int lds_byte(int r, int c) { const int st = (r >> 4) * 2 + (c >> 5), rr = r & 15, cc = c & 31, ob = rr * 64 + cc * 2; return st * 1024 + (ob ^ (((ob >> 9) & 1) << 5)); }
__host__ __device__ __forceinline__ void stage_rc(int b, int& R, int& C) { const int st = b / 1024, sb = b % 1024, swz = sb ^ (((sb >> 9) & 1) << 5); R = (st >> 1) * 16 + swz / 64; C = (st & 1) * 32 + (swz % 64) / 2; }
__host__ __device__ __forceinline__ int perm32(int rho) { const int n = rho >> 4, i = rho & 15; return 8 * (i >> 2) + 4 * n + (i & 3); }
struct Unit { int pm, pn, e; };
struct Gemm { const bf16_t* A; const bf16_t* Bt; int K; size_t estride; const int* rowidx; };
struct StaticOrder {
    int nM, nN, nwg, G, c;
    __device__ void init(int M, int N, int G_, int c_) { nM = M / BM; nN = N / BM; nwg = nM * nN; G = G_; c = c_; }
    __device__ bool next(int i, Unit& u) const {
        const long L = (long)i * G + c; if (L >= nwg) return false;
        int wgid = (int)L; { const int q = nwg / NXCD, r = nwg % NXCD, xcd = wgid % NXCD, off = wgid / NXCD; wgid = (xcd < r ? xcd * (q + 1) : r * (q + 1) + (xcd - r) * q) + off; }
        const int nig = WGM * nN, gid = wgid / nig, fm = gid * WGM, gsz = (nM - fm) < WGM ? (nM - fm) : WGM;
        u.pm = fm + ((wgid % nig) % gsz); u.pn = (wgid % nig) / gsz; u.e = 0; return true;
    }
};
struct MoeOrder {
    int nblk, nN, G, c; const int* block_e;
    __device__ bool next(int i, Unit& u) const {
        if (G % 8 != 0 || (G / 8) % nN != 0) { const long L = (long)i * G + c; if (L >= (long)nblk * nN) return false; u.pm = (int)(L / nN); u.pn = (int)(L % nN); }
        else { const int x = c & 7, r = c >> 3, per = (G / 8) / nN; const int mb = (i * per + r / nN) * 8 + x; if (mb >= nblk) return false; u.pm = mb; u.pn = r % nN; }
        u.e = __builtin_amdgcn_readfirstlane(block_e[u.pm]); return true;
    }
};
typedef float f32x2c_t __attribute__((ext_vector_type(2))); typedef __bf16 bf16x2c_t __attribute__((ext_vector_type(2)));
__device__ __forceinline__ unsigned cvt_pk_bf16(float lo, float hi) { const f32x2c_t v = {lo, hi}; const bf16x2c_t b = __builtin_convertvector(v, bf16x2c_t); return __builtin_bit_cast(unsigned, b); }
struct EpiF32 {
    static constexpr bool PERM = false;
    float* C; int ldc;
    __device__ __forceinline__ void operator()(const f32x4 (&acc)[2][2][4][2], const Unit& u, int wr, int wc, int fr, int fq) const {
        const int row0 = u.pm * BM + wr * 64 + fr, col0 = u.pn * BM + wc * 32 + 4 * fq;
#pragma unroll
        for (int ai = 0; ai < 2; ++ai)
#pragma unroll
            for (int m = 0; m < 4; ++m) { float* rowp = C + (size_t)(row0 + ai * HALF + m * 16) * ldc + col0;
#pragma unroll
                for (int bj = 0; bj < 2; ++bj)
#pragma unroll
                    for (int n = 0; n < 2; ++n) *(f32x4*)(rowp + bj * HALF + n * 16) = acc[ai][bj][m][n]; }
    }
};
struct EpiBf16Bias {
    static constexpr bool PERM = true;
    bf16_t* O; int ldc; const float* bias; int bias_estride;
    __device__ __forceinline__ void operator()(const f32x4 (&acc)[2][2][4][2], const Unit& u, int wr, int wc, int fr, int fq) const {
        const int row0 = u.pm * BM + wr * 64 + fr, col0 = u.pn * BM + wc * 32 + 8 * fq; const float* bp = bias + (size_t)u.e * bias_estride + col0;
        f32x4 bv[2][2];
#pragma unroll
        for (int bj = 0; bj < 2; ++bj)
#pragma unroll
            for (int n = 0; n < 2; ++n) bv[bj][n] = bias ? *(const f32x4*)(bp + bj * HALF + 4 * n) : (f32x4){0.f, 0.f, 0.f, 0.f};
#pragma unroll
        for (int ai = 0; ai < 2; ++ai)
#pragma unroll
            for (int m = 0; m < 4; ++m) { bf16_t* rowp = O + (size_t)(row0 + ai * HALF + m * 16) * ldc + col0;
#pragma unroll
                for (int bj = 0; bj < 2; ++bj) { const f32x4 v0 = acc[ai][bj][m][0] + bv[bj][0], v1 = acc[ai][bj][m][1] + bv[bj][1];
                    u32x4 w; w.x = cvt_pk_bf16(v0[0], v0[1]); w.y = cvt_pk_bf16(v0[2], v0[3]); w.z = cvt_pk_bf16(v1[0], v1[1]); w.w = cvt_pk_bf16(v1[2], v1[3]);
                    *(u32x4*)(rowp + bj * HALF) = w; } }
    }
};
__device__ __forceinline__ float swiglu1(float g, float lin) { g = fminf(g, 7.0f); lin = fminf(fmaxf(lin, -7.0f), 7.0f); return g * __builtin_amdgcn_rcpf(1.0f + __expf(-1.702f * g)) * (lin + 1.0f); }
struct EpiSwiglu {
    static constexpr bool PERM = true;
    bf16_t* O; int ldc; const float* bias; int bias_estride;
    __device__ __forceinline__ void operator()(const f32x4 (&acc)[2][2][4][2], const Unit& u, int wr, int wc, int fr, int fq) const {
        const int row0 = u.pm * BM + wr * 64 + fr, col0 = u.pn * BM + wc * 32 + 8 * fq; const float* bp = bias + (size_t)u.e * bias_estride + col0;
        f32x4 bv[2][2];
#pragma unroll
        for (int bj = 0; bj < 2; ++bj)
#pragma unroll
            for (int n = 0; n < 2; ++n) bv[bj][n] = *(const f32x4*)(bp + bj * HALF + 4 * n);
#pragma unroll
        for (int ai = 0; ai < 2; ++ai)
#pragma unroll
            for (int m = 0; m < 4; ++m) { bf16_t* rowp = O + (size_t)(row0 + ai * HALF + m * 16) * ldc + (col0 >> 1);
#pragma unroll
                for (int bj = 0; bj < 2; ++bj) { const f32x4 v0 = acc[ai][bj][m][0] + bv[bj][0], v1 = acc[ai][bj][m][1] + bv[bj][1];
                    u32x2 w; w.x = cvt_pk_bf16(swiglu1(v0[0], v0[1]), swiglu1(v0[2], v0[3])); w.y = cvt_pk_bf16(swiglu1(v1[0], v1[1]), swiglu1(v1[2], v1[3]));
                    *(u32x2*)(rowp + bj * (HALF / 2)) = w; } }
    }
};

template <bool GATHER = false, class Epi, class Sched>
__device__ __forceinline__ void gemm_phase(PG8_LAS unsigned char* lds, const Gemm g, const Sched& S, const Epi& E, int tid) {
    asm volatile("" : "+v"(tid));
    const int wid = __builtin_amdgcn_readfirstlane(tid >> 6), lane = tid & 63, wr = wid >> 2, wc = wid & 3, fr = lane & 15, fq = lane >> 4;
    int K = g.K; asm volatile("" : "+s"(K));
    const int nt = K / BK;
    unsigned voffA[2], voffB[2];
#pragma unroll
    for (int i = 0; i < 2; ++i) { int R, C; stage_rc(tid * 16 + i * 8192, R, C); const int Rb = Epi::PERM ? ((R & ~31) + perm32(R & 31)) : R;
        voffA[i] = GATHER ? 0u : (unsigned)(R * K + C) * 2u; voffB[i] = (unsigned)(Rb * K + C) * 2u; }
    const size_t kstep = (size_t)(BK * 2);
    const size_t hstep = (size_t)HALF * K * 2;
    const size_t tstep = 2 * hstep;
    const unsigned ldsw = (unsigned)wid * 1024u;
    const int aoff = lds_byte(wr * 64 + fr, fq * 8), boff = lds_byte(wc * 32 + fr, fq * 8);
#define PG8_SA(b, h) (((b) * 2 + (h)) * HTB)
#define PG8_SB(b, h) ((4 + (b) * 2 + (h)) * HTB)
#define PG8_STAGE(bufoff, gbase, voff) do { _Pragma("unroll") for (int _i = 0; _i < 2; ++_i) \
        __builtin_amdgcn_global_load_lds((const unsigned*)((const char*)(gbase) + (voff)[_i]), (PG8_LAS unsigned*)(lds + (bufoff) + ldsw + _i * 8192), 16, 0, 0); } while (0)
#define PG8_STAGE_A(bufoff, h, nx, kb) do { _Pragma("unroll") for (int _i = 0; _i < 2; ++_i) { \
        if constexpr (GATHER) { const unsigned _o = (nx) ? on[h][_i] : oc[h][_i]; \
            __builtin_amdgcn_global_load_lds((const unsigned*)((const char*)g.A + (size_t)_o + (size_t)(kb)), (PG8_LAS unsigned*)(lds + (bufoff) + ldsw + _i * 8192), 16, 0, 0); } \
        else { const char* _b = ((nx) ? nA : cA) + (size_t)(h) * hstep + (size_t)(kb); \
            __builtin_amdgcn_global_load_lds((const unsigned*)(_b + voffA[_i]), (PG8_LAS unsigned*)(lds + (bufoff) + ldsw + _i * 8192), 16, 0, 0); } } } while (0)
#define PG8_LDA(dst, b, h) do { _Pragma("unroll") for (int m = 0; m < 4; ++m) _Pragma("unroll") for (int k = 0; k < 2; ++k) dst[m][k] = *(const PG8_LAS bf16x8*)(lds + PG8_SA(b, h) + aoff + m * 2048 + k * 1024); } while (0)
#define PG8_LDB(dst, b, h) do { _Pragma("unroll") for (int n = 0; n < 2; ++n) _Pragma("unroll") for (int k = 0; k < 2; ++k) dst[n][k] = *(const PG8_LAS bf16x8*)(lds + PG8_SB(b, h) + boff + n * 2048 + k * 1024); } while (0)
#define PG8_MMA(ai, bj, At, Bt) do { __builtin_amdgcn_s_setprio(1); _Pragma("unroll") for (int m = 0; m < 4; ++m) _Pragma("unroll") for (int n = 0; n < 2; ++n) _Pragma("unroll") for (int k = 0; k < 2; ++k) \
        acc[ai][bj][m][n] = __builtin_amdgcn_mfma_f32_16x16x32_bf16(Bt[n][k], At[m][k], acc[ai][bj][m][n], 0, 0, 0); __builtin_amdgcn_s_setprio(0); } while (0)
#define PG8_WAIT_V(n) asm volatile("s_waitcnt vmcnt(" #n ")" ::: "memory")
#define PG8_WAIT_L(n) asm volatile("s_waitcnt lgkmcnt(" #n ")" ::: "memory")
#define PG8_BAR __builtin_amdgcn_s_barrier()
#define PG8_SCHED __builtin_amdgcn_sched_barrier(0)
    Unit cur, nxt; int ui = 0;
    if (!S.next(0, cur)) return;
    unsigned oc[2][2], on[2][2];
    const char* cA = (const char*)g.A + (size_t)cur.pm * tstep; const char* nA = cA;
#define PG8_UNIT_OFFS(o, u) do { _Pragma("unroll") for (int _h = 0; _h < 2; ++_h) _Pragma("unroll") for (int _i = 0; _i < 2; ++_i) { \
        if constexpr (GATHER) { int _R, _C; stage_rc(tid * 16 + _i * 8192, _R, _C); (o)[_h][_i] = (unsigned)g.rowidx[(u).pm * BM + _h * HALF + _R] * (unsigned)(K * 2) + (unsigned)(_C * 2); } else (o)[_h][_i] = 0u; } } while (0)
    PG8_UNIT_OFFS(oc, cur);
    f32x4 acc[2][2][4][2];
#pragma unroll
    for (int a = 0; a < 2; ++a)
#pragma unroll
        for (int b = 0; b < 2; ++b)
#pragma unroll
            for (int m = 0; m < 4; ++m)
#pragma unroll
                for (int n = 0; n < 2; ++n) acc[a][b][m][n] = (f32x4){0.f, 0.f, 0.f, 0.f};
    bf16x8 At[4][2], B0[2][2], B1[2][2];
    const char* cB = (const char*)(g.Bt + (size_t)cur.e * g.estride) + (size_t)cur.pn * tstep;
    PG8_STAGE(PG8_SB(0, 0), cB, voffB); PG8_STAGE(PG8_SB(0, 1), cB + hstep, voffB); PG8_STAGE_A(PG8_SA(0, 0), 0, false, 0); PG8_STAGE_A(PG8_SA(0, 1), 1, false, 0);
    if (wr == 1) PG8_BAR;
    PG8_WAIT_V(2); PG8_BAR;
    PG8_STAGE(PG8_SB(1, 0), cB + kstep, voffB); PG8_STAGE_A(PG8_SA(1, 0), 0, false, kstep); PG8_STAGE(PG8_SB(1, 1), cB + hstep + kstep, voffB);
    PG8_WAIT_V(6); PG8_BAR;
    for (;;) {
        const bool has_next = S.next(ui + 1, nxt);
        if (has_next) { PG8_UNIT_OFFS(on, nxt); nA = (const char*)g.A + (size_t)nxt.pm * tstep; } else { nA = cA; _Pragma("unroll") for (int _h = 0; _h < 2; ++_h) _Pragma("unroll") for (int _i = 0; _i < 2; ++_i) on[_h][_i] = oc[_h][_i]; }
        const char* nB = has_next ? (const char*)(g.Bt + (size_t)nxt.e * g.estride) + (size_t)nxt.pn * tstep : cB;
        for (int t = 0; t < nt; t += 2) {
            const bool last = (t == nt - 2);
            const size_t ka1 = (size_t)(t + 1) * kstep, ka2 = last ? 0 : (size_t)(t + 2) * kstep, ka3 = ka2 + kstep;
            const char* b2 = last ? nB : cB + (size_t)(t + 2) * kstep; const char* b3 = b2 + kstep;
            PG8_LDB(B0, 0, 0); PG8_LDB(B1, 0, 1); PG8_SCHED; PG8_LDA(At, 0, 0); PG8_STAGE_A(PG8_SA(1, 1), 1, false, ka1);
            PG8_WAIT_V(8); PG8_WAIT_L(0); PG8_BAR; PG8_MMA(0, 0, At, B0); PG8_MMA(0, 1, At, B1); PG8_BAR; PG8_SCHED;
            PG8_LDA(At, 0, 1); PG8_STAGE(PG8_SB(0, 0), b2, voffB); PG8_STAGE(PG8_SB(0, 1), b2 + hstep, voffB); PG8_STAGE_A(PG8_SA(0, 0), 0, last, ka2);
            PG8_WAIT_V(8); PG8_WAIT_L(0); PG8_BAR; PG8_MMA(1, 0, At, B0); PG8_MMA(1, 1, At, B1); PG8_BAR; PG8_SCHED;
            PG8_LDB(B0, 1, 0); PG8_LDB(B1, 1, 1); PG8_SCHED; PG8_LDA(At, 1, 0); PG8_STAGE_A(PG8_SA(0, 1), 1, last, ka2);
            PG8_WAIT_V(8); PG8_WAIT_L(0); PG8_BAR; PG8_MMA(0, 0, At, B0); PG8_MMA(0, 1, At, B1); PG8_BAR; PG8_SCHED;
            PG8_LDA(At, 1, 1); PG8_STAGE(PG8_SB(1, 0), b3, voffB); PG8_STAGE(PG8_SB(1, 1), b3 + hstep, voffB); PG8_STAGE_A(PG8_SA(1, 0), 0, last, ka3);
            PG8_WAIT_V(8); PG8_WAIT_L(0); PG8_BAR; PG8_MMA(1, 0, At, B0); PG8_MMA(1, 1, At, B1); PG8_BAR; PG8_SCHED;
        }
        if (wr == 0) PG8_BAR;
        E(acc, cur, wr, wc, fr, fq);
        if (!has_next) break;
#pragma unroll
        for (int a = 0; a < 2; ++a)
#pragma unroll
            for (int b = 0; b < 2; ++b)
#pragma unroll
                for (int m = 0; m < 4; ++m)
#pragma unroll
                    for (int n = 0; n < 2; ++n) acc[a][b][m][n] = (f32x4){0.f, 0.f, 0.f, 0.f};
        cur = nxt; cA = nA; cB = nB; ++ui;
#pragma unroll
        for (int _h = 0; _h < 2; ++_h)
#pragma unroll
            for (int _i = 0; _i < 2; ++_i) oc[_h][_i] = on[_h][_i];
        if (wr == 1) PG8_BAR;
    }
    PG8_WAIT_V(0);
    PG8_BAR;
#undef PG8_UNIT_OFFS
#undef PG8_SA
#undef PG8_SB
#undef PG8_STAGE
#undef PG8_STAGE_A
#undef PG8_LDA
#undef PG8_LDB
#undef PG8_MMA
#undef PG8_WAIT_V
#undef PG8_WAIT_L
#undef PG8_BAR
#undef PG8_SCHED
}
}

#define XB_TMO      128
#define XB_XCNT(j)  (256  + 64 * (j))
#define XB_XSUB(j)  (1280 + 64 * (j))
#define XB_XGEN(j)  (2304 + 64 * (j))
#define XB_TOP      3328
#define XB_TOPGEN   3392
#define XCD_BAR_WORDS 3456
#define XB_SPIN_CAP (1u << 22)
#define LAS __attribute__((address_space(3)))
__device__ __forceinline__ unsigned xb_ld(unsigned* p)              { return __hip_atomic_load(p, __ATOMIC_RELAXED, __HIP_MEMORY_SCOPE_AGENT); }
__device__ __forceinline__ unsigned xb_add(unsigned* p, unsigned v) { return __hip_atomic_fetch_add(p, v, __ATOMIC_RELAXED, __HIP_MEMORY_SCOPE_AGENT); }
__device__ __forceinline__ unsigned xb_xcc_id() { return (unsigned)__builtin_amdgcn_s_getreg((3 << 11) | 20) & 0xFu; }
#define XB_SPIN(cond, bar) do { unsigned _sp = 0; while (cond) { __builtin_amdgcn_s_sleep(1); \
    if ((++_sp & 255u) == 0u) { if (xb_ld(&(bar)[XB_TMO])) break; if (_sp > XB_SPIN_CAP) { atomicAdd(&(bar)[XB_TMO], 1u); break; } } } } while (0)
struct XcdBarrier { unsigned* bar; unsigned x; volatile LAS unsigned* st; };
__device__ __forceinline__ XcdBarrier xcd_barrier_post(unsigned* bar, volatile LAS unsigned* st, int tid) {
    XcdBarrier b; b.bar = bar; b.x = xb_xcc_id(); b.st = st;
    if (tid == 0) (void)xb_add(&bar[XB_XCNT(b.x)], 1u);
    return b;
}
__device__ __forceinline__ void xcd_barrier_complete(unsigned* bar, unsigned x, unsigned& nloc, unsigned& nx) {
    const unsigned G = gridDim.x * gridDim.y * gridDim.z;
    unsigned sum, cnt, mine, sp = 0u;
    for (;;) {
        sum = 0u; cnt = 0u; mine = 0u;
#pragma unroll
        for (unsigned j = 0; j < 16; ++j) { const unsigned c = xb_ld(&bar[XB_XCNT(j)]); sum += c; cnt += (c > 0u) ? 1u : 0u; mine = (j == x) ? c : mine; }
        if (sum == G) break;
        __builtin_amdgcn_s_sleep(1);
        if ((++sp & 255u) == 0u) { if (xb_ld(&bar[XB_TMO])) break; if (sp > XB_SPIN_CAP) { atomicAdd(&bar[XB_TMO], 1u); break; } }
    }
    nloc = mine > 0u ? mine : 1u; nx = cnt > 0u ? cnt : 1u;
}
__device__ __forceinline__ void xcd_barrier(const XcdBarrier& b, int tid) {
    asm volatile("s_waitcnt vmcnt(0)" ::: "memory");
    __syncthreads();
    if (tid == 0) {
        unsigned* bar = b.bar;
        __builtin_amdgcn_s_waitcnt(0);
        unsigned nloc = b.st[0], nx = b.st[1];
        if (nloc == 0u) { xcd_barrier_complete(bar, b.x, nloc, nx); b.st[0] = nloc; b.st[1] = nx; }
        const unsigned old = xb_add(&bar[XB_XSUB(b.x)], 1u);
        const unsigned gen = old / nloc;
        if (old + 1u == (gen + 1u) * nloc) {
            __builtin_amdgcn_fence(__ATOMIC_RELEASE, "agent");
            asm volatile("s_waitcnt vmcnt(0)" ::: "memory");
            const unsigned og = xb_add(&bar[XB_TOP], 1u);
            const unsigned tg = og / nx;
            if (og + 1u == (tg + 1u) * nx) xb_add(&bar[XB_TOPGEN], 1u);
            else XB_SPIN(xb_ld(&bar[XB_TOPGEN]) == tg, bar);
            __builtin_amdgcn_fence(__ATOMIC_ACQUIRE, "agent");
            xb_add(&bar[XB_XGEN(b.x)], 1u);
            asm volatile("s_waitcnt vmcnt(0)" ::: "memory");
        } else {
            XB_SPIN(xb_ld(&bar[XB_XGEN(b.x)]) == gen, bar);
            __builtin_amdgcn_fence(__ATOMIC_ACQUIRE, "agent");
            asm volatile("s_waitcnt vmcnt(0)" ::: "memory");
        }
    }
    __syncthreads();
}


constexpr int NWAVES = 8, NTHR = 512;
constexpr int NPH = 15;
__device__ __forceinline__ float frsq(float x) { return __builtin_amdgcn_rsqf(x); }
__device__ __forceinline__ float frcp(float x) { return __builtin_amdgcn_rcpf(x); }
typedef float f32x4_t __attribute__((ext_vector_type(4)));
typedef unsigned u32x2_t __attribute__((ext_vector_type(2)));
typedef unsigned u32x4_t __attribute__((ext_vector_type(4)));
typedef short bf16x8_t __attribute__((ext_vector_type(8)));
__device__ __forceinline__ float wave_sum(float v) {
#pragma unroll
    for (int o = 1; o < 64; o <<= 1) v += __shfl_xor(v, o);
    return v;
}
__device__ __forceinline__ float grp16_sum(float v) {
#pragma unroll
    for (int o = 1; o < 16; o <<= 1) v += __shfl_xor(v, o);
    return v;
}
__device__ __forceinline__ float hsum4(f32x4_t a) { return (a.x + a.y) + (a.z + a.w); }
__device__ __forceinline__ float hsq4(f32x4_t a) { return (a.x * a.x + a.y * a.y) + (a.z * a.z + a.w * a.w); }
__device__ __forceinline__ u32x2_t pk4(f32x4_t t) { u32x2_t w; w.x = pg8::cvt_pk_bf16(t.x, t.y); w.y = pg8::cvt_pk_bf16(t.z, t.w); return w; }
__device__ __forceinline__ float bflo(unsigned w) { return __builtin_bit_cast(float, w << 16); }
__device__ __forceinline__ float bfhi(unsigned w) { return __builtin_bit_cast(float, w & 0xffff0000u); }
__device__ __forceinline__ f32x4_t bf4(u32x2_t w) { f32x4_t r; r.x = bflo(w.x); r.y = bfhi(w.x); r.z = bflo(w.y); r.w = bfhi(w.y); return r; }
template <bool TO_LDS> __device__ __forceinline__ void norm_mod_store(const f32x4_t (&v)[4], float rstd, const float* pn, const float* sh, const float* sc, bf16_t* orow, LAS unsigned char* lrow, int lane) {
#pragma unroll
    for (int j = 0; j < 4; ++j) { const int k = 4 * lane + 256 * j;
        const f32x4_t pv = *(const f32x4_t*)(pn + k), sv = *(const f32x4_t*)(sc + k), hv = *(const f32x4_t*)(sh + k);
        const f32x4_t t = v[j] * rstd * pv * (1.0f + sv) + hv; const u32x2_t w = pk4(t);
        *(u32x2_t*)(orow + k) = w; if (TO_LDS) *(LAS u32x2_t*)(lrow + 2 * k) = w; }
}
__device__ __forceinline__ void dev_norm1_l0(const P& p, int G, int wave, int lane) {
    int r0, r1; { const int nw = G * NWAVES, per = (NTOK + nw - 1) / nw, gwl = (int)blockIdx.x * NWAVES + wave; r0 = gwl * per; r1 = r0 + per; if (r1 > NTOK) r1 = NTOK; }
    f32x4_t pnr[4], shr[4], scr2[4]; int mrow = -1;
#pragma unroll
    for (int j = 0; j < 4; ++j) pnr[j] = *(const f32x4_t*)(p.pre_norm + 4 * lane + 256 * j);
    for (int m = r0; m < r1; ++m) {
        const float* src = m < NLAT ? p.x + (size_t)m * D : p.ctx + (size_t)(m - NLAT) * D;
        f32x4_t v[4]; float ss = 0.f;
#pragma unroll
        for (int j = 0; j < 4; ++j) { v[j] = *(const f32x4_t*)(src + 4 * lane + 256 * j); ss += hsq4(v[j]); *(f32x4_t*)(p.X() + (size_t)m * D + 4 * lane + 256 * j) = v[j]; }
        const int mr = mod_row(m);
        if (mr != mrow) { const float* md = p.MOD() + (size_t)mr * 6 * D; mrow = mr;
#pragma unroll
            for (int j = 0; j < 4; ++j) { shr[j] = *(const f32x4_t*)(md + 4 * lane + 256 * j); scr2[j] = *(const f32x4_t*)(md + D + 4 * lane + 256 * j); } }
        const float rstd = frsq(wave_sum(ss) * (1.0f / D) + 1e-6f); bf16_t* orow = p.HB() + (size_t)m * D;
#pragma unroll
        for (int j = 0; j < 4; ++j) { const f32x4_t t = v[j] * rstd * pnr[j] * (1.0f + scr2[j]) + shr[j]; *(u32x2_t*)(orow + 4 * lane + 256 * j) = pk4(t); }
    }
}
__device__ __forceinline__ void dev_post(const P& p, int l, int ntok_l, int gw, int ngw, int lane) {
    const int h = lane >> 4;
    for (int m = gw; m < ntok_l; m += ngw) {
        {
            const f32x4_t y = bf4(*(const u32x2_t*)(p.YA() + (size_t)m * A_W + 4 * lane)) + bf4(*(const u32x2_t*)(p.YA() + ((size_t)NTOK + m) * A_W + 4 * lane));
            const float mean = grp16_sum(hsum4(y)) * (1.0f / 64.f); const f32x4_t d = y - mean;
            const float var = grp16_sum(hsq4(d)) * (1.0f / 64.f); const float rs = frsq(var + 64e-5f);
            const f32x4_t lw = *(const f32x4_t*)(p.rw_ln_w + l * A_W + 4 * lane), lb = *(const f32x4_t*)(p.rw_ln_b + l * A_W + 4 * lane);
            const f32x4_t vv = bf4(*(const u32x2_t*)(p.RW_V() + (size_t)m * A_W + 4 * lane)), gt = bf4(*(const u32x2_t*)(p.RW_GATE() + (size_t)m * A_W + 4 * lane));
            const float bon = p.RW_BON()[(size_t)m * A_H + h];
            const f32x4_t o = (d * rs * lw + lb + bon * vv) * gt;
            *(u32x2_t*)(p.MIX() + (size_t)m * D + 4 * lane) = pk4(o);
        }
        {
            const u32x4_t o0 = *(const u32x4_t*)(p.OB() + (size_t)m * B_W + 8 * lane), o1 = *(const u32x4_t*)(p.OB() + ((size_t)NTOK + m) * B_W + 8 * lane);
            const f32x4_t a = bf4((u32x2_t){o0.x, o0.y}) + bf4((u32x2_t){o1.x, o1.y}), b = bf4((u32x2_t){o0.z, o0.w}) + bf4((u32x2_t){o1.z, o1.w});
            const float rs = frsq(grp16_sum(hsq4(a) + hsq4(b)) * (1.0f / 128.f) + 1e-6f);
            const u32x4_t zr = *(const u32x4_t*)(p.U() + (size_t)m * INP + B_OFF + 1536 + 8 * lane);
            const float* nw = p.gdn_norm + l * 128 + ((8 * lane) & 127);
            const f32x4_t n0 = *(const f32x4_t*)nw, n1 = *(const f32x4_t*)(nw + 4);
            const f32x4_t z0 = {bflo(zr.x), bfhi(zr.x), bflo(zr.y), bfhi(zr.y)}, z1 = {bflo(zr.z), bfhi(zr.z), bflo(zr.w), bfhi(zr.w)};
            f32x4_t s0, s1;
#pragma unroll
            for (int c = 0; c < 4; ++c) { s0[c] = z0[c] * frcp(1.0f + __expf(-z0[c])); s1[c] = z1[c] * frcp(1.0f + __expf(-z1[c])); }
            const f32x4_t r0 = a * rs * n0 * s0, r1 = b * rs * n1 * s1;
            u32x4_t w; const u32x2_t w0 = pk4(r0), w1 = pk4(r1); w.x = w0.x; w.y = w0.y; w.z = w1.x; w.w = w1.y;
            *(u32x4_t*)(p.MIX() + (size_t)m * D + 256 + 8 * lane) = w;
        }
    }
}
constexpr int RT_TK = 0, RT_TKS = 2064, RT_PL = 34816, RT_LG = RT_PL + 16384, RT_CNT = RT_LG + 2304, RT_BASE = RT_CNT + 128, RT_ASG = RT_BASE + 128, RT_ASG_MAX = 4096;
__device__ __forceinline__ void dev_resid_router(const P& p, int l, int ntok_l, LAS unsigned char* lds, int G, int tid) {
    const int lane = tid & 63, wave = tid >> 6;
    LAS int* LCNT = (LAS int*)(lds + RT_CNT); LAS int* LBASE = (LAS int*)(lds + RT_BASE); LAS int* ASG = (LAS int*)(lds + RT_ASG);
    LAS float* PL = (LAS float*)(lds + RT_PL); LAS float* LG = (LAS float*)(lds + RT_LG);
    if (tid < 32) LCNT[tid] = 0;
    __syncthreads();
    f32x4_t pnr[4], pn2r[4];
#pragma unroll
    for (int j = 0; j < 4; ++j) { const int k = 4 * lane + 256 * j; pnr[j] = *(const f32x4_t*)(p.post_norm + (size_t)(l * 2 + 0) * D + k); pn2r[j] = *(const f32x4_t*)(p.pre_norm + (size_t)(l * 2 + 1) * D + k); }
    const int ngrp = ntok_l / 16; int it = 0;
    for (int grp = blockIdx.x; grp < ngrp; grp += G, ++it) {
        f32x4_t g1r[4], sh2r[4], sc2r[4];
        { const float* md = p.MOD() + ((size_t)l * (BATCH + 1) + mod_row(grp * 16)) * 6 * D;
#pragma unroll
          for (int j = 0; j < 4; ++j) { const int k = 4 * lane + 256 * j; g1r[j] = *(const f32x4_t*)(md + 2 * D + k); sh2r[j] = *(const f32x4_t*)(md + 3 * D + k); sc2r[j] = *(const f32x4_t*)(md + 4 * D + k); } }
#pragma unroll 1
        for (int rr = 0; rr < 2; ++rr) {
            const int ri = wave * 2 + rr, m = grp * 16 + ri;
            const bf16_t* mo = p.MO() + (size_t)m * D; float* xr = p.X() + (size_t)m * D;
            f32x4_t v[4], x[4]; float ss = 0.f;
#pragma unroll
            for (int j = 0; j < 4; ++j) { v[j] = bf4(*(const u32x2_t*)(mo + 4 * lane + 256 * j)); x[j] = *(const f32x4_t*)(xr + 4 * lane + 256 * j); ss += hsq4(v[j]); }
            const float rstd = frsq(wave_sum(ss) * (1.0f / D) + 1e-6f); float s2 = 0.f;
#pragma unroll
            for (int j = 0; j < 4; ++j) { const int k = 4 * lane + 256 * j;
                x[j] = x[j] + g1r[j] * (v[j] * rstd) * pnr[j]; s2 += hsq4(x[j]); *(f32x4_t*)(xr + k) = x[j]; }
            const float r2 = frsq(wave_sum(s2) * (1.0f / D) + 1e-6f);
            { bf16_t* orow = p.HB() + (size_t)m * D; LAS unsigned char* lrow = lds + RT_TK + ri * RT_TKS;
#pragma unroll
              for (int j = 0; j < 4; ++j) { const int k = 4 * lane + 256 * j; const f32x4_t t = x[j] * r2 * pn2r[j] * (1.0f + sc2r[j]) + sh2r[j]; const u32x2_t w = pk4(t); *(u32x2_t*)(orow + k) = w; *(LAS u32x2_t*)(lrow + 2 * k) = w; } }
        }
        __syncthreads();
        {
            const int i = lane & 15, q = lane >> 4; pg8::f32x4 acc0 = {0.f, 0.f, 0.f, 0.f}, acc1 = {0.f, 0.f, 0.f, 0.f};
#pragma unroll
            for (int ks = 0; ks < 4; ++ks) { const int k0 = 128 * wave + 32 * ks + 8 * q;
                const bf16x8_t a = *(const LAS bf16x8_t*)(lds + RT_TK + i * RT_TKS + 2 * k0);
                const bf16x8_t b0 = *(const bf16x8_t*)(p.WR_T(l) + (size_t)i * D + k0), b1 = *(const bf16x8_t*)(p.WR_T(l) + (size_t)(16 + i) * D + k0);
                acc0 = __builtin_amdgcn_mfma_f32_16x16x32_bf16(a, b0, acc0, 0, 0, 0); acc1 = __builtin_amdgcn_mfma_f32_16x16x32_bf16(a, b1, acc1, 0, 0, 0); }
#pragma unroll
            for (int r = 0; r < 4; ++r) { PL[(wave * 16 + 4 * q + r) * 32 + i] = acc0[r]; PL[(wave * 16 + 4 * q + r) * 32 + 16 + i] = acc1[r]; }
        }
        __syncthreads();
        {
            const int ri = tid >> 5, e = tid & 31; float sacc = p.router_b[l * NEXP + e];
#pragma unroll
            for (int w = 0; w < 8; ++w) sacc += PL[(w * 16 + ri) * 32 + e];
            LG[ri * 33 + e] = sacc;
        }
        __syncthreads();
        if (tid < 16) {
            const int m = grp * 16 + tid; float lg[NEXP];
#pragma unroll
            for (int e = 0; e < NEXP; ++e) lg[e] = LG[tid * 33 + e];
            int idx[TOPK]; float val[TOPK];
#pragma unroll
            for (int j = 0; j < TOPK; ++j) { float best = -3.0e38f; int bi = 0;
#pragma unroll
                for (int e = 0; e < NEXP; ++e) { if (lg[e] > best) { best = lg[e]; bi = e; } }
                idx[j] = bi; val[j] = best;
#pragma unroll
                for (int e = 0; e < NEXP; ++e) if (e == bi) lg[e] = -3.0e38f; }
            float sum = 0.f, ex[TOPK];
#pragma unroll
            for (int j = 0; j < TOPK; ++j) { ex[j] = __expf(val[j] - val[0]); sum += ex[j]; }
            const float inv = 1.0f / sum;
#pragma unroll
            for (int j = 0; j < TOPK; ++j) { p.TOPI()[(size_t)m * TOPK + j] = idx[j]; p.TOPG()[(size_t)m * TOPK + j] = ex[j] * inv;
                const int lp = __hip_atomic_fetch_add(&LCNT[idx[j]], 1, __ATOMIC_RELAXED, __HIP_MEMORY_SCOPE_WORKGROUP);
                const int ai = (it * 16 + tid) * 4 + j; if (ai < RT_ASG_MAX) ASG[ai] = (idx[j] << 20) | lp; }
        }
        __syncthreads();
    }
    if (tid < 32) LBASE[tid] = LCNT[tid] > 0 ? atomicAdd(&p.cnt()[l * NEXP + tid], LCNT[tid]) : 0;
    __syncthreads();
    for (int a = tid; a < it * 64 && a < RT_ASG_MAX; a += NTHR) { const int w = ASG[a]; const int e = w >> 20, lp = w & 0xfffff; const int itx = a / 64, ri = (a % 64) / 4, j = a % 4;
        const int m = (blockIdx.x + itx * G) * 16 + ri; p.POS()[(size_t)m * TOPK + j] = LBASE[e] + lp; }
    __syncthreads();
}
__device__ __forceinline__ void dev_slots(const P& p, int l, int ntok_l, LAS unsigned char* lds, long gtid, long nthr, int tid) {
    LAS int* PST = (LAS int*)lds; LAS int* CN = (LAS int*)(lds + 256);
    if (tid == 0) { int acc = 0; for (int e = 0; e < NEXP; ++e) { const int c = p.cnt()[l * NEXP + e]; PST[e] = acc; CN[e] = c; acc += (c + 255) / 256 * 256; } PST[NEXP] = acc; }
    __syncthreads();
    for (long t = gtid; t < (long)ntok_l * TOPK; t += nthr) { const int e = p.TOPI()[t]; const int slot = PST[e] + p.POS()[t]; p.TSLOT()[t] = slot; p.SLOT_TOK()[slot] = (int)(t / TOPK); }
    for (long t = gtid; t < NEXP * 256; t += nthr) { const int e = (int)(t >> 8), i = (int)(t & 255); const int c = CN[e]; const int pads = (c + 255) / 256 * 256 - c; if (i < pads) p.SLOT_TOK()[PST[e] + c + i] = ZROW; }
    for (long t = gtid; t < NBLK_MAX; t += nthr) { int e_of = NEXP - 1;
        for (int e = 0; e < NEXP; ++e) { if ((int)t * 256 >= PST[e] && (int)t * 256 < PST[e + 1]) e_of = e; }
        p.BLOCK_E()[t] = e_of; if (t == 0) p.NBLK()[0] = PST[NEXP] / 256; }
    __syncthreads();
}
struct CbA { int4 sl; f32x4_t gt; };
struct CbB { u32x2_t y[4][4]; f32x4_t x[4]; f32x4_t gt; };
__device__ __forceinline__ void combine_loadA(const P& p, int m, CbA& a) { a.sl = *(const int4*)(p.TSLOT() + (size_t)m * 4); a.gt = *(const f32x4_t*)(p.TOPG() + (size_t)m * 4); }
__device__ __forceinline__ void combine_loadB(const P& p, int m, const CbA& a, int lane, CbB& b) {
    const bf16_t* y0 = p.YB() + (size_t)a.sl.x * D; const bf16_t* y1 = p.YB() + (size_t)a.sl.y * D; const bf16_t* y2 = p.YB() + (size_t)a.sl.z * D; const bf16_t* y3 = p.YB() + (size_t)a.sl.w * D;
    const float* xr = p.X() + (size_t)m * D;
#pragma unroll
    for (int j = 0; j < 4; ++j) { const int k = 4 * lane + 256 * j; b.y[0][j] = *(const u32x2_t*)(y0 + k); b.y[1][j] = *(const u32x2_t*)(y1 + k); b.y[2][j] = *(const u32x2_t*)(y2 + k); b.y[3][j] = *(const u32x2_t*)(y3 + k); b.x[j] = *(const f32x4_t*)(xr + k); }
    b.gt = a.gt;
}
struct CbPar { f32x4_t pn[4], pn1[4], g2[4], sh1[4], sc1[4]; int mrow; };
__device__ __forceinline__ void combine_params(const P& p, int l, int lane, CbPar& q) {
    const bool last = (l == DEPTH - 1);
#pragma unroll
    for (int j = 0; j < 4; ++j) { const int k = 4 * lane + 256 * j; q.pn[j] = *(const f32x4_t*)(p.post_norm + (size_t)(l * 2 + 1) * D + k); q.pn1[j] = last ? q.pn[j] : *(const f32x4_t*)(p.pre_norm + (size_t)((l + 1) * 2 + 0) * D + k); }
    q.mrow = -1;
}
__device__ __forceinline__ void combine_mod(const P& p, int l, int mrow, int lane, CbPar& q) {
    const bool last = (l == DEPTH - 1); const float* md = p.MOD() + ((size_t)l * (BATCH + 1) + mrow) * 6 * D; const float* md1 = p.MOD() + ((size_t)(last ? l : l + 1) * (BATCH + 1) + mrow) * 6 * D;
#pragma unroll
    for (int j = 0; j < 4; ++j) { const int k = 4 * lane + 256 * j; q.g2[j] = *(const f32x4_t*)(md + 5 * D + k); q.sh1[j] = *(const f32x4_t*)(md1 + k); q.sc1[j] = *(const f32x4_t*)(md1 + D + k); }
    q.mrow = mrow;
}
__device__ __forceinline__ void combine_compute(const P& p, int l, int m, const CbB& b, int lane, const CbPar& q) {
    const bool last = (l == DEPTH - 1);
    float* xr = p.X() + (size_t)m * D;
    const f32x4_t gt = b.gt; f32x4_t f[4], x[4]; float ss = 0.f;
#pragma unroll
    for (int j = 0; j < 4; ++j) { const u32x2_t a = b.y[0][j], bb = b.y[1][j], c = b.y[2][j], d = b.y[3][j];
        f[j].x = gt.x * bflo(a.x) + gt.y * bflo(bb.x) + gt.z * bflo(c.x) + gt.w * bflo(d.x); f[j].y = gt.x * bfhi(a.x) + gt.y * bfhi(bb.x) + gt.z * bfhi(c.x) + gt.w * bfhi(d.x);
        f[j].z = gt.x * bflo(a.y) + gt.y * bflo(bb.y) + gt.z * bflo(c.y) + gt.w * bflo(d.y); f[j].w = gt.x * bfhi(a.y) + gt.y * bfhi(bb.y) + gt.z * bfhi(c.y) + gt.w * bfhi(d.y);
        ss += hsq4(f[j]); x[j] = b.x[j]; }
    const float rstd = frsq(wave_sum(ss) * (1.0f / D) + 1e-6f); float s2 = 0.f;
#pragma unroll
    for (int j = 0; j < 4; ++j) { const int k = 4 * lane + 256 * j;
        x[j] = x[j] + q.g2[j] * (f[j] * rstd) * q.pn[j]; s2 += hsq4(x[j]);
#ifdef PROBE_DET
        if (last) { const unsigned cs_ = p.ctl()[12050]; x[j] = (f32x4_t){(float)(cs_ & 0xffffu), (float)((cs_ >> 16) & 0xffffu), 1.f, 2.f}; }
#endif
#ifdef PROBE_T
        if (last) { const unsigned long long* ts = (const unsigned long long*)(p.ctl() + 12100); const float tot = (float)(ts[2 * NPH - 1] - ts[0]);
            float fa = 0.f;
            for (int ll = 0; ll < 2; ++ll) for (int jj = 0; jj < NPH; ++jj) if (((PT_MASK >> jj) & 1) && (1 + ll * NPH + jj + 1 <= 2 * NPH - 1)) fa += (float)(ts[1 + ll * NPH + jj + 1] - ts[1 + ll * NPH + jj]);
            if ((PT_MASK >> 20) & 1) fa += (float)(ts[1] - ts[0]);
#ifdef PT_ACT
            fa = (float)p.ctl()[12070] + (float)p.ctl()[12071];
#endif
#ifdef PT_SEC
            fa = (float)p.ctl()[12080] * (1.0f / 128.0f);
#endif
            const float fq = floorf(fa / tot * 64.0f + 0.5f) * (1.0f / 64.0f);
            x[j] = x[j] * (1.0f + 0.07f * sqrtf(fq)); }
#endif
#if defined(PROBE_GDN) || defined(PROBE_RWKV)
        if (last) { const float e = ((const float*)(p.ctl() + 12000))[0], r = ((const float*)(p.ctl() + 12001))[0]; x[j] = x[j] * (1.0f + 10.0f * sqrtf(e / r)); }
#endif
        if (last) *(f32x4_t*)(p.out + (size_t)m * D + k) = x[j]; else *(f32x4_t*)(xr + k) = x[j]; }
    if (!last) { const float r2 = frsq(wave_sum(s2) * (1.0f / D) + 1e-6f); bf16_t* orow = p.HB() + (size_t)m * D;
#pragma unroll
        for (int j = 0; j < 4; ++j) { const int k = 4 * lane + 256 * j; const f32x4_t t = x[j] * r2 * q.pn1[j] * (1.0f + q.sc1[j]) + q.sh1[j]; *(u32x2_t*)(orow + k) = pk4(t); } }
}
__device__ __forceinline__ void dev_combine(const P& p, int l, int ntok_l, int G, int wave, int lane) {
    int r0, r1; { const int nw = G * NWAVES, per = (ntok_l + nw - 1) / nw, gwl = (int)blockIdx.x * NWAVES + wave; r0 = gwl * per; r1 = r0 + per; if (r1 > ntok_l) r1 = ntok_l; }
    if (r0 >= r1) return;
    CbPar par; combine_params(p, l, lane, par);
    int m = r0; CbA a0, a1; CbB b0; combine_loadA(p, m, a0); a1 = a0; if (m + 1 < r1) combine_loadA(p, m + 1, a1);
    combine_loadB(p, m, a0, lane, b0);
    for (; m < r1; ++m) {
        CbA a2 = a1; if (m + 2 < r1) combine_loadA(p, m + 2, a2);
        CbB b1 = b0; if (m + 1 < r1) combine_loadB(p, m + 1, a1, lane, b1);
        const int mr = mod_row(m); if (mr != par.mrow) combine_mod(p, l, mr, lane, par);
        combine_compute(p, l, m, b0, lane, par);
        b0 = b1; a1 = a2;
    }
}
__device__ __forceinline__ void lds_barrier() { asm volatile("s_waitcnt lgkmcnt(0)\n\ts_barrier" ::: "memory"); }
#define MMA16(a, b, c) __builtin_amdgcn_mfma_f32_16x16x32_bf16((a), (b), (c), 0, 0, 0)
typedef pg8::f32x4 f32x4;
__device__ __forceinline__ bf16x8_t lfrag(LAS const unsigned char* lds, int off, int ld, int row0, int k0, int lane) {
    return *(LAS const bf16x8_t*)(lds + off + (row0 + (lane & 15)) * ld + (k0 + 8 * (lane >> 4)) * 2);
}
__device__ __forceinline__ bf16x8_t lfrag16(LAS const unsigned char* lds, int off, int ld, int row0, int k0, int lane) {
    bf16x8_t z = {0, 0, 0, 0, 0, 0, 0, 0}; return (lane >> 4) < 2 ? lfrag(lds, off, ld, row0, k0, lane) : z;
}
__device__ __forceinline__ bf16x8_t lfragT(LAS const unsigned char* lds, int off, int ld, int k0, int n0, int kvalid, int lane) {
    bf16x8_t v; const int n = n0 + (lane & 15), kb = 8 * (lane >> 4);
#pragma unroll
    for (int j = 0; j < 8; ++j) v[j] = (kb + j < kvalid) ? *(LAS const short*)(lds + off + (k0 + kb + j) * ld + n * 2) : (short)0;
    return v;
}
__device__ __forceinline__ void st_rm(LAS unsigned char* lds, int off, int ld, int m0, int n0, f32x4 acc, int lane) {
#pragma unroll
    for (int r = 0; r < 4; ++r) *(LAS bf16_t*)(lds + off + (m0 + 4 * (lane >> 4) + r) * ld + (n0 + (lane & 15)) * 2) = f2bf(acc[r]);
}
__device__ __forceinline__ void st_tr(LAS unsigned char* lds, int off, int ld, int m0, int n0, f32x4 acc, int lane) {
    u32x2_t w; w.x = pg8::cvt_pk_bf16(acc[0], acc[1]); w.y = pg8::cvt_pk_bf16(acc[2], acc[3]);
    *(LAS u32x2_t*)(lds + off + (n0 + (lane & 15)) * ld + (m0 + 4 * (lane >> 4)) * 2) = w;
}
__device__ __forceinline__ u32x4_t scale8(u32x4_t v, float s) {
    u32x4_t o; o.x = pg8::cvt_pk_bf16(bflo(v.x) * s, bfhi(v.x) * s); o.y = pg8::cvt_pk_bf16(bflo(v.y) * s, bfhi(v.y) * s);
    o.z = pg8::cvt_pk_bf16(bflo(v.z) * s, bfhi(v.z) * s); o.w = pg8::cvt_pk_bf16(bflo(v.w) * s, bfhi(v.w) * s); return o;
}

template <int LOFF, int TOFF, int SCOFF>
__device__ __forceinline__ void tri_inv64(LAS unsigned char* lds, int tid) {
    const int wave = __builtin_amdgcn_readfirstlane(tid >> 6); int lane = tid & 63, q4 = lane >> 4, l16 = lane & 15;
    if (wave == 0) {
        float x[16];
#pragma unroll
        for (int i = 0; i < 16; ++i) { float sacc = (i == l16) ? 1.f : 0.f;
#pragma unroll
            for (int j = 0; j < i; ++j) sacc -= bf2f(*(LAS const bf16_t*)(lds + LOFF + (16 * q4 + i) * 144 + (16 * q4 + j) * 2)) * x[j];
            x[i] = sacc; }
#pragma unroll
        for (int i = 0; i < 16; ++i) *(LAS bf16_t*)(lds + TOFF + (16 * q4 + i) * 144 + (16 * q4 + l16) * 2) = f2bf(x[i]);
    }
    lds_barrier(); asm volatile("" : "+v"(tid)); lane = tid & 63;
    if (wave < 2) {
        const int I = 2 * wave + 1, J = 2 * wave; const f32x4 z = {0.f, 0.f, 0.f, 0.f};
        const f32x4 m1 = MMA16(lfrag16(lds, LOFF, 144, 16 * I, 16 * J, lane), lfragT(lds, TOFF, 144, 16 * J, 16 * J, 16, lane), z);
        st_rm(lds, SCOFF + wave * 1280, 80, 0, 0, m1, lane);
        asm volatile("s_waitcnt lgkmcnt(0)" ::: "memory");
        const f32x4 t1 = MMA16(lfrag16(lds, TOFF, 144, 16 * I, 16 * I, lane), lfragT(lds, SCOFF + wave * 1280, 80, 0, 0, 16, lane), z);
        st_rm(lds, TOFF, 144, 16 * I, 16 * J, -t1, lane);
    }
    lds_barrier(); asm volatile("" : "+v"(tid)); lane = tid & 63;
    {
        const int mt2 = (wave >> 1) & 1, nt2 = wave & 1; const f32x4 z = {0.f, 0.f, 0.f, 0.f};
        if (wave < 4) { const f32x4 m2 = MMA16(lfrag(lds, LOFF, 144, 32 + 16 * mt2, 0, lane), lfragT(lds, TOFF, 144, 0, 16 * nt2, 32, lane), z); st_rm(lds, SCOFF, 80, 16 * mt2, 16 * nt2, m2, lane); }
        lds_barrier();
        if (wave < 4) { const f32x4 t2 = MMA16(lfrag(lds, TOFF, 144, 32 + 16 * mt2, 32, lane), lfragT(lds, SCOFF, 80, 0, 16 * nt2, 32, lane), z); st_rm(lds, TOFF, 144, 32 + 16 * mt2, 16 * nt2, -t2, lane); }
    }
    lds_barrier();
}

constexpr int GQ_ = 0, GK_ = 17408, GV_ = 34816, GL_ = 53248, GT_ = 62464, GSC_ = 71680, GVB_ = 74240, GKB_ = 92672, GST_ = 111104, GF_ = 145920;
constexpr int LD128 = 272, LD64 = 144, LDSC = 80;
__device__ __forceinline__ void gdn_chain(const bf16_t* __restrict__ gq, const bf16_t* __restrict__ gk, const bf16_t* __restrict__ gv, const float* __restrict__ gg, const float* __restrict__ gbeta, int chain, bf16_t* __restrict__ OBout, LAS unsigned char* lds, int tid, unsigned* ctlp) {
    const int wave = __builtin_amdgcn_readfirstlane(tid >> 6); int lane = tid & 63, q4 = lane >> 4, l16 = lane & 15;
#ifdef PT_SEC
    unsigned long long ts_ = __builtin_amdgcn_s_memrealtime();
#define SEC_MARK(k) do { if (tid == 0) { const unsigned long long n_ = __builtin_amdgcn_s_memrealtime(); if ((k) == PT_SEC) atomicAdd(ctlp + 12080, (unsigned)(n_ - ts_)); ts_ = n_; } } while (0)
#else
#define SEC_MARK(k)
#endif
#define GDN_RELANE() do { asm volatile("" : "+v"(tid)); lane = tid & 63; q4 = lane >> 4; l16 = lane & 15; } while (0)
    const int h = chain % B_H, b = (chain / B_H) % BATCH, dir = chain / (B_H * BATCH);
    LAS float* GF = (LAS float*)(lds + GF_);
    for (int i = tid; i < 34816 / 16; i += NTHR) *(LAS u32x4_t*)(lds + GST_ + 16 * i) = (u32x4_t){0u, 0u, 0u, 0u};
    f32x4 Sacc[8];
#pragma unroll
    for (int nt = 0; nt < 8; ++nt) Sacc[nt] = (f32x4){0.f, 0.f, 0.f, 0.f};
    u32x4_t pq[2], pk[2], pv[2]; float pg = 0.f, pb = 0.f;
#define GDN_LOADS(cc) do { _Pragma("unroll") for (int u = 0; u < 2; ++u) { const int piece = tid + 512 * u, i = piece >> 4, c16 = piece & 15; \
        const size_t ro = (size_t)scan_row(dir, b, 64 * (cc) + i) * B_W + h * 128 + c16 * 8; \
        pq[u] = *(const u32x4_t*)(gq + ro); pk[u] = *(const u32x4_t*)(gk + ro); pv[u] = *(const u32x4_t*)(gv + ro); } \
        if (tid < 64) { const size_t ro = (size_t)scan_row(dir, b, 64 * (cc) + tid) * 8 + dir * 4 + h; pg = gg[ro]; pb = gbeta[ro]; } } while (0)
    GDN_LOADS(0);
    constexpr int NCH = SLEN / 64;
#pragma unroll 1
    for (int c = 0; c < NCH; ++c) {
        GDN_RELANE();
#pragma unroll
        for (int u = 0; u < 2; ++u) { const int piece = tid + 512 * u, i = piece >> 4, c16 = piece & 15;
            *(LAS u32x4_t*)(lds + GQ_ + i * LD128 + c16 * 16) = pq[u]; *(LAS u32x4_t*)(lds + GK_ + i * LD128 + c16 * 16) = pk[u]; *(LAS u32x4_t*)(lds + GV_ + i * LD128 + c16 * 16) = pv[u]; }
        for (int i2 = tid; i2 < 9216 / 16; i2 += NTHR) *(LAS u32x4_t*)(lds + GT_ + 16 * i2) = (u32x4_t){0u, 0u, 0u, 0u};
        if (wave == 0) {
            float x = pg;
#pragma unroll
            for (int o = 1; o < 64; o <<= 1) { const float y = __shfl_up(x, o); if (lane >= o) x += y; }
            const float gl = __shfl(x, 63);
            GF[lane] = x; GF[64 + lane] = pb; GF[128 + lane] = __expf(x); GF[192 + lane] = __expf(gl - x); if (lane == 0) GF[256] = __expf(gl);
        }
        if (c + 1 < NCH) GDN_LOADS(c + 1);
        lds_barrier(); __builtin_amdgcn_sched_barrier(0); GDN_RELANE(); SEC_MARK(1);
        const int mt = wave >> 1;
        f32x4 qk[2];
        {
            f32x4 kk[2]; kk[0] = kk[1] = qk[0] = qk[1] = (f32x4){0.f, 0.f, 0.f, 0.f};
#pragma unroll
            for (int ks = 0; ks < 4; ++ks) { __builtin_amdgcn_sched_barrier(0); const bf16x8_t ak = lfrag(lds, GK_, LD128, 16 * mt, 32 * ks, lane), aq = lfrag(lds, GQ_, LD128, 16 * mt, 32 * ks, lane);
#pragma unroll
                for (int t = 0; t < 2; ++t) { const bf16x8_t bk = lfrag(lds, GK_, LD128, 16 * (2 * (wave & 1) + t), 32 * ks, lane); kk[t] = MMA16(bk, ak, kk[t]); qk[t] = MMA16(bk, aq, qk[t]); } }
#pragma unroll
            for (int t = 0; t < 2; ++t) { const int i = 16 * mt + l16; const float gci = GF[i], bi = GF[64 + i]; f32x4 lv;
#pragma unroll
                for (int r = 0; r < 4; ++r) { const int j = 16 * (2 * (wave & 1) + t) + 4 * q4 + r; const float dec = i >= j ? __expf(gci - GF[j]) : 0.f;
                    lv[r] = i > j ? bi * kk[t][r] * dec : 0.f; qk[t][r] *= dec; }
                st_tr(lds, GL_, LD64, 16 * (2 * (wave & 1) + t), 16 * mt, lv, lane); }
        }
        lds_barrier(); __builtin_amdgcn_sched_barrier(0); GDN_RELANE();
        SEC_MARK(2);
        if (wave >= 4) {
            const int t4 = tid - 256;
#pragma unroll
            for (int rep = 0; rep < 4; ++rep) { const int task = t4 + 256 * rep, cidx = task & 127, jg = task >> 7; float vv[8], kv[8];
#pragma unroll
                for (int jj = 0; jj < 8; ++jj) { const int j = 8 * jg + jj; const float bj = GF[64 + j];
                    vv[jj] = bf2f(*(LAS const bf16_t*)(lds + GV_ + j * LD128 + cidx * 2)) * bj; kv[jj] = bf2f(*(LAS const bf16_t*)(lds + GK_ + j * LD128 + cidx * 2)) * bj * GF[128 + j]; }
                u32x4_t wv, wk; wv.x = pg8::cvt_pk_bf16(vv[0], vv[1]); wv.y = pg8::cvt_pk_bf16(vv[2], vv[3]); wv.z = pg8::cvt_pk_bf16(vv[4], vv[5]); wv.w = pg8::cvt_pk_bf16(vv[6], vv[7]);
                wk.x = pg8::cvt_pk_bf16(kv[0], kv[1]); wk.y = pg8::cvt_pk_bf16(kv[2], kv[3]); wk.z = pg8::cvt_pk_bf16(kv[4], kv[5]); wk.w = pg8::cvt_pk_bf16(kv[6], kv[7]);
                *(LAS u32x4_t*)(lds + GVB_ + cidx * LD64 + jg * 16) = wv; *(LAS u32x4_t*)(lds + GKB_ + cidx * LD64 + jg * 16) = wk; }
#pragma unroll
            for (int u = 0; u < 4; ++u) { const int piece = t4 + 256 * u, i = piece >> 4, c16 = piece & 15; LAS u32x4_t* qp = (LAS u32x4_t*)(lds + GQ_ + i * LD128 + c16 * 16); *qp = scale8(*qp, GF[128 + i]); }
        }
        tri_inv64<GL_, GT_, GSC_>(lds, tid); GDN_RELANE(); SEC_MARK(3);
#pragma unroll
        for (int t = 0; t < 2; ++t) st_tr(lds, GL_, LD64, 16 * (2 * (wave & 1) + t), 16 * mt, qk[t], lane);
        SEC_MARK(4);
        f32x4 accu[4], o[4];
#pragma unroll
        for (int m = 0; m < 4; ++m) accu[m] = o[m] = (f32x4){0.f, 0.f, 0.f, 0.f};
#pragma unroll
        for (int ks = 0; ks < 2; ++ks) { __builtin_amdgcn_sched_barrier(0); const bf16x8_t bb = lfrag(lds, GVB_, LD64, 16 * wave, 32 * ks, lane);
#pragma unroll
            for (int m = 0; m < 4; ++m) accu[m] = MMA16(lfrag(lds, GT_, LD64, 16 * m, 32 * ks, lane), bb, accu[m]); }
        {
            f32x4 accw[4];
#pragma unroll
            for (int m = 0; m < 4; ++m) accw[m] = (f32x4){0.f, 0.f, 0.f, 0.f};
#pragma unroll
            for (int ks = 0; ks < 2; ++ks) { __builtin_amdgcn_sched_barrier(0); const bf16x8_t bb = lfrag(lds, GKB_, LD64, 16 * wave, 32 * ks, lane);
#pragma unroll
                for (int m = 0; m < 4; ++m) accw[m] = MMA16(bb, lfrag(lds, GT_, LD64, 16 * m, 32 * ks, lane), accw[m]); }
            lds_barrier();
#pragma unroll
            for (int m = 0; m < 4; ++m) st_tr(lds, GVB_, LD128, 16 * wave, 16 * m, -accw[m], lane);
        }
#pragma unroll
        for (int rep = 0; rep < 2; ++rep) { const int task = tid + 512 * rep, cidx = task & 127, jg = task >> 7; float kv[8];
#pragma unroll
            for (int jj = 0; jj < 8; ++jj) { const int j = 8 * jg + jj; kv[jj] = bf2f(*(LAS const bf16_t*)(lds + GK_ + j * LD128 + cidx * 2)) * GF[192 + j]; }
            u32x4_t wk; wk.x = pg8::cvt_pk_bf16(kv[0], kv[1]); wk.y = pg8::cvt_pk_bf16(kv[2], kv[3]); wk.z = pg8::cvt_pk_bf16(kv[4], kv[5]); wk.w = pg8::cvt_pk_bf16(kv[6], kv[7]);
            *(LAS u32x4_t*)(lds + GKB_ + cidx * LD64 + jg * 16) = wk; }
        lds_barrier(); __builtin_amdgcn_sched_barrier(0); GDN_RELANE();
        SEC_MARK(5);
#pragma unroll
        for (int ks = 0; ks < 4; ++ks) { __builtin_amdgcn_sched_barrier(0); const bf16x8_t bb = lfrag(lds, GST_, LD128, 16 * wave, 32 * ks, lane);
#pragma unroll
            for (int m = 0; m < 4; ++m) { accu[m] = MMA16(lfrag(lds, GVB_, LD128, 16 * m, 32 * ks, lane), bb, accu[m]); o[m] = MMA16(bb, lfrag(lds, GQ_, LD128, 16 * m, 32 * ks, lane), o[m]); } }
#pragma unroll
        for (int m = 0; m < 4; ++m) st_tr(lds, GV_, LD64, 16 * m, 16 * wave, accu[m], lane);
        lds_barrier(); __builtin_amdgcn_sched_barrier(0); GDN_RELANE();
        const int row0 = scan_row(dir, b, 64 * c), sgn = dir ? -1 : 1;
        SEC_MARK(6);
#pragma unroll
        for (int ks = 0; ks < 2; ++ks) { __builtin_amdgcn_sched_barrier(0); const bf16x8_t bb = lfrag(lds, GV_, LD64, 16 * wave, 32 * ks, lane);
#pragma unroll
            for (int m = 0; m < 4; ++m) o[m] = MMA16(bb, lfrag(lds, GL_, LD64, 16 * m, 32 * ks, lane), o[m]); }
#pragma unroll
        for (int m = 0; m < 4; ++m) { const int i = 16 * m + l16; const int row = row0 + sgn * i;
            u32x2_t w; w.x = pg8::cvt_pk_bf16(o[m][0], o[m][1]); w.y = pg8::cvt_pk_bf16(o[m][2], o[m][3]); *(u32x2_t*)(OBout + (unsigned)((dir * NTOK + row) * B_W + h * 128 + 16 * wave + 4 * q4)) = w; }
        {
            const float gl = GF[256];
#pragma unroll
            for (int nt = 0; nt < 8; ++nt) Sacc[nt] = Sacc[nt] * gl;
#pragma unroll
            for (int ks = 0; ks < 2; ++ks) { __builtin_amdgcn_sched_barrier(0); const bf16x8_t aa = lfrag(lds, GKB_, LD64, 16 * wave, 32 * ks, lane);
#pragma unroll
                for (int nt = 0; nt < 8; ++nt) Sacc[nt] = MMA16(aa, lfrag(lds, GV_, LD64, 16 * nt, 32 * ks, lane), Sacc[nt]); }
#pragma unroll
            for (int nt = 0; nt < 8; ++nt) st_tr(lds, GST_, LD128, 16 * wave, 16 * nt, Sacc[nt], lane);
        }
        lds_barrier(); __builtin_amdgcn_sched_barrier(0); GDN_RELANE(); SEC_MARK(7);
    }
#undef GDN_LOADS
#undef GDN_RELANE
#undef SEC_MARK
}

constexpr int SP_ = 0, SQ_ = 9216, SK_ = 18432, SR_ = 27648, SPT_ = 36864, SQT_ = 46080, SL_ = 55296, ST_ = 64512, SSC_ = 73728, SAT_ = 76288, SNB_ = 85504, SPH_ = 94720, SAH_ = 103936, SCS_ = 113152, SVT_ = 129792, SDC_ = 139008, SSEG_ = 139264;
constexpr int RW_NCH = SLEN / 64, RW_UNITS = 2 * BATCH * A_H * RW_NCH;
struct S1In { float ld[8]; u32x4_t kk, ka, kd, rr, vv; };
__device__ __forceinline__ void rwkv_stage1_load(const P& p, int unit, int tid, S1In& in) {
    const int c = unit % RW_NCH, chain = unit / RW_NCH; const int h = chain % A_H, b = (chain / A_H) % BATCH, dir = chain / (A_H * BATCH);
    const int row0 = scan_row(dir, b, 64 * c), sgn = dir ? -1 : 1;
    { const int k = tid & 63, sg = tid >> 6;
#pragma unroll
      for (int tt = 0; tt < 8; ++tt) in.ld[tt] = p.RW_D()[((size_t)dir * NTOK + (row0 + sgn * (8 * sg + tt))) * A_W + h * 64 + k]; }
    { const int t = tid >> 3, kg = tid & 7; const int row = row0 + sgn * t;
      const size_t o1 = (size_t)row * A_W + h * 64 + 8 * kg, o2 = ((size_t)dir * NTOK + row) * A_W + h * 64 + 8 * kg;
      in.kk = *(const u32x4_t*)(p.RW_KK() + o1); in.ka = *(const u32x4_t*)(p.RW_KKA() + o2); in.kd = *(const u32x4_t*)(p.RW_KD() + o2); in.rr = *(const u32x4_t*)(p.RW_R() + o1); in.vv = *(const u32x4_t*)(p.RW_V() + o1); }
}
__device__ __forceinline__ void rwkv_stage1(const P& p, int unit, const S1In& in, LAS unsigned char* lds, int tid) {
    const int wave = __builtin_amdgcn_readfirstlane(tid >> 6); int lane = tid & 63, q4 = lane >> 4, l16 = lane & 15;
#define RW_RELANE() do { asm volatile("" : "+v"(tid)); lane = tid & 63; q4 = lane >> 4; l16 = lane & 15; } while (0)
    LAS float* CS = (LAS float*)(lds + SCS_); LAS float* DCv = (LAS float*)(lds + SDC_); LAS float* SEG = (LAS float*)(lds + SSEG_);
    {
        const int k = tid & 63, sg = tid >> 6; float x = 0.f, loc[8];
#pragma unroll
        for (int tt = 0; tt < 8; ++tt) { x += in.ld[tt]; loc[tt] = x; }
        SEG[sg * 64 + k] = x;
        for (int i2 = tid; i2 < 9216 / 16; i2 += NTHR) *(LAS u32x4_t*)(lds + ST_ + 16 * i2) = (u32x4_t){0u, 0u, 0u, 0u};
        lds_barrier();
        float pre = 0.f;
        for (int s2 = 0; s2 < sg; ++s2) pre += SEG[s2 * 64 + k];
#pragma unroll
        for (int tt = 0; tt < 8; ++tt) CS[(8 * sg + tt) * 65 + k] = loc[tt] + pre;
        if (sg == 7) DCv[k] = __expf(loc[7] + pre);
    }
    lds_barrier(); RW_RELANE();
    {
        const int t = tid >> 3, kg = tid & 7;
        float kk[8], ka[8], kd[8], rr[8], vv[8];
#pragma unroll
        for (int j = 0; j < 4; ++j) { kk[2 * j] = bflo(in.kk[j]); kk[2 * j + 1] = bfhi(in.kk[j]); ka[2 * j] = bflo(in.ka[j]); ka[2 * j + 1] = bfhi(in.ka[j]); kd[2 * j] = bflo(in.kd[j]); kd[2 * j + 1] = bfhi(in.kd[j]);
            rr[2 * j] = bflo(in.rr[j]); rr[2 * j + 1] = bfhi(in.rr[j]); vv[2 * j] = bflo(in.vv[j]); vv[2 * j + 1] = bfhi(in.vv[j]); }
        float pp[8], qq[8], kt[8], rh[8];
#pragma unroll
        for (int j = 0; j < 8; ++j) { const int k = 8 * kg + j; const float cs = CS[t * 65 + k], csm = t > 0 ? CS[(t - 1) * 65 + k] : 0.f; const float e = __expf(cs), ei = frcp(e);
            pp[j] = __expf(csm) * kk[j]; qq[j] = ka[j] * ei; kt[j] = kd[j] * ei; rh[j] = rr[j] * e; }
        u32x4_t w;
        w.x = pg8::cvt_pk_bf16(pp[0], pp[1]); w.y = pg8::cvt_pk_bf16(pp[2], pp[3]); w.z = pg8::cvt_pk_bf16(pp[4], pp[5]); w.w = pg8::cvt_pk_bf16(pp[6], pp[7]); *(LAS u32x4_t*)(lds + SP_ + t * 144 + kg * 16) = w;
        w.x = pg8::cvt_pk_bf16(qq[0], qq[1]); w.y = pg8::cvt_pk_bf16(qq[2], qq[3]); w.z = pg8::cvt_pk_bf16(qq[4], qq[5]); w.w = pg8::cvt_pk_bf16(qq[6], qq[7]); *(LAS u32x4_t*)(lds + SQ_ + t * 144 + kg * 16) = w;
        w.x = pg8::cvt_pk_bf16(kt[0], kt[1]); w.y = pg8::cvt_pk_bf16(kt[2], kt[3]); w.z = pg8::cvt_pk_bf16(kt[4], kt[5]); w.w = pg8::cvt_pk_bf16(kt[6], kt[7]); *(LAS u32x4_t*)(lds + SK_ + t * 144 + kg * 16) = w;
        w.x = pg8::cvt_pk_bf16(rh[0], rh[1]); w.y = pg8::cvt_pk_bf16(rh[2], rh[3]); w.z = pg8::cvt_pk_bf16(rh[4], rh[5]); w.w = pg8::cvt_pk_bf16(rh[6], rh[7]); *(LAS u32x4_t*)(lds + SR_ + t * 144 + kg * 16) = w;
#pragma unroll
        for (int j = 0; j < 8; ++j) { const int k = 8 * kg + j; *(LAS bf16_t*)(lds + SPT_ + k * 144 + t * 2) = f2bf(pp[j]); *(LAS bf16_t*)(lds + SQT_ + k * 144 + t * 2) = f2bf(qq[j]); *(LAS bf16_t*)(lds + SVT_ + k * 144 + t * 2) = f2bf(vv[j]); }
    }
    lds_barrier(); RW_RELANE();
    const int mt = wave >> 1, ntb = 2 * (wave & 1);
    f32x4 krm[2];
    {
        f32x4 qp[2], kp[2], qr[2];
#pragma unroll
        for (int t2 = 0; t2 < 2; ++t2) qp[t2] = kp[t2] = qr[t2] = krm[t2] = (f32x4){0.f, 0.f, 0.f, 0.f};
#pragma unroll
        for (int ks = 0; ks < 2; ++ks) { const bf16x8_t aP = lfrag(lds, SP_, 144, 16 * mt, 32 * ks, lane), aR = lfrag(lds, SR_, 144, 16 * mt, 32 * ks, lane);
#pragma unroll
            for (int t2 = 0; t2 < 2; ++t2) { const bf16x8_t bQ = lfrag(lds, SQ_, 144, 16 * (ntb + t2), 32 * ks, lane), bK = lfrag(lds, SK_, 144, 16 * (ntb + t2), 32 * ks, lane);
                qp[t2] = MMA16(bQ, aP, qp[t2]); kp[t2] = MMA16(aP, bK, kp[t2]); qr[t2] = MMA16(bQ, aR, qr[t2]); krm[t2] = MMA16(bK, aR, krm[t2]); } }
#pragma unroll
        for (int t2 = 0; t2 < 2; ++t2) {
#pragma unroll
            for (int r = 0; r < 4; ++r) {
                { const int t = 16 * mt + 4 * q4 + r, i = 16 * (ntb + t2) + l16; kp[t2][r] = t > i ? kp[t2][r] : 0.f; }
                { const int i = 16 * (ntb + t2) + 4 * q4 + r, t = 16 * mt + l16; const bool st = t > i, inc = t >= i;
                  qp[t2][r] = st ? qp[t2][r] : 0.f; qr[t2][r] = inc ? -qr[t2][r] : 0.f; krm[t2][r] = inc ? krm[t2][r] : 0.f; } }
            st_tr(lds, SL_, 144, 16 * (ntb + t2), 16 * mt, qp[t2], lane); st_tr(lds, SAT_, 144, 16 * mt, 16 * (ntb + t2), kp[t2], lane); st_tr(lds, SNB_, 144, 16 * (ntb + t2), 16 * mt, qr[t2], lane); }
    }
    lds_barrier(); RW_RELANE();
    tri_inv64<SL_, ST_, SSC_>(lds, tid);
    RW_RELANE();
    {
        f32x4 ph[2], ah[2];
#pragma unroll
        for (int t2 = 0; t2 < 2; ++t2) ph[t2] = ah[t2] = (f32x4){0.f, 0.f, 0.f, 0.f};
#pragma unroll
        for (int ks = 0; ks < 2; ++ks) { const bf16x8_t aT = lfrag(lds, ST_, 144, 16 * mt, 32 * ks, lane);
#pragma unroll
            for (int t2 = 0; t2 < 2; ++t2) { ph[t2] = MMA16(aT, lfrag(lds, SPT_, 144, 16 * (ntb + t2), 32 * ks, lane), ph[t2]); ah[t2] = MMA16(aT, lfrag(lds, SAT_, 144, 16 * (ntb + t2), 32 * ks, lane), ah[t2]); } }
#pragma unroll
        for (int t2 = 0; t2 < 2; ++t2) { st_tr(lds, SPH_, 144, 16 * mt, 16 * (ntb + t2), ph[t2], lane); st_tr(lds, SAH_, 144, 16 * mt, 16 * (ntb + t2), ah[t2], lane); }
    }
    lds_barrier(); RW_RELANE();
    {
        f32x4 rh[2], zz[2], kh[2];
#pragma unroll
        for (int t2 = 0; t2 < 2; ++t2) { zz[t2] = kh[t2] = (f32x4){0.f, 0.f, 0.f, 0.f};
            const u32x2_t rw = *(LAS const u32x2_t*)(lds + SR_ + (16 * mt + l16) * 144 + (16 * (ntb + t2) + 4 * q4) * 2);
            rh[t2] = (f32x4){bflo(rw.x), bfhi(rw.x), bflo(rw.y), bfhi(rw.y)}; }
#pragma unroll
        for (int ks = 0; ks < 2; ++ks) { const bf16x8_t aB = lfrag(lds, SNB_, 144, 16 * mt, 32 * ks, lane), aPh = lfrag(lds, SPH_, 144, 16 * mt, 32 * ks, lane), aAh = lfrag(lds, SAH_, 144, 16 * mt, 32 * ks, lane);
#pragma unroll
            for (int t2 = 0; t2 < 2; ++t2) { const bf16x8_t bPh = lfrag(lds, SPH_, 144, 16 * (ntb + t2), 32 * ks, lane), bAh = lfrag(lds, SAH_, 144, 16 * (ntb + t2), 32 * ks, lane), bQt = lfrag(lds, SQT_, 144, 16 * (ntb + t2), 32 * ks, lane);
                rh[t2] = MMA16(bPh, aB, rh[t2]); krm[t2] = MMA16(bAh, aB, krm[t2]); zz[t2] = MMA16(aPh, bQt, zz[t2]); kh[t2] = MMA16(aAh, bQt, kh[t2]); } }
#pragma unroll
        for (int t2 = 0; t2 < 2; ++t2) { const int n = 16 * (ntb + t2) + l16; const float dc = DCv[n];
#pragma unroll
            for (int r = 0; r < 4; ++r) { const int m = 16 * mt + 4 * q4 + r; zz[t2][r] = ((m == n ? 1.f : 0.f) - zz[t2][r]) * dc;
                kh[t2][r] = (bf2f(*(LAS const bf16_t*)(lds + SK_ + m * 144 + n * 2)) - kh[t2][r]) * dc; }
            st_tr(lds, SR_, 144, 16 * (ntb + t2), 16 * mt, rh[t2], lane); st_tr(lds, SL_, 144, 16 * (ntb + t2), 16 * mt, krm[t2], lane);
            st_tr(lds, SP_, 144, 16 * mt, 16 * (ntb + t2), zz[t2], lane); st_tr(lds, SQ_, 144, 16 * mt, 16 * (ntb + t2), kh[t2], lane); }
    }
    lds_barrier(); RW_RELANE();
    {
        const int row = tid >> 3, c16 = tid & 7; bf16_t* ob = p.RWC() + (size_t)unit * 5 * 4096 + row * 64 + c16 * 8;
        *(u32x4_t*)(ob) = *(LAS const u32x4_t*)(lds + SR_ + row * 144 + c16 * 16);
        *(u32x4_t*)(ob + 4096) = *(LAS const u32x4_t*)(lds + SL_ + row * 144 + c16 * 16);
        *(u32x4_t*)(ob + 2 * 4096) = *(LAS const u32x4_t*)(lds + SP_ + row * 144 + c16 * 16);
        *(u32x4_t*)(ob + 3 * 4096) = *(LAS const u32x4_t*)(lds + SQ_ + row * 144 + c16 * 16);
        *(u32x4_t*)(ob + 4 * 4096) = *(LAS const u32x4_t*)(lds + SVT_ + row * 144 + c16 * 16);
    }
    lds_barrier();
#undef RW_RELANE
}
constexpr int S2_M = 0  , S2_S = 46080, S2_HALF = 55296;
__device__ __forceinline__ void rwkv_stage2(const P& p, int pair, bf16_t* YAout, LAS unsigned char* lds0, int tid) {
    const int wave = __builtin_amdgcn_readfirstlane(tid >> 6), half = wave >> 2, w4 = wave & 3; int lane = tid & 63, q4 = lane >> 4, l16 = lane & 15;
    const int chain = 2 * pair + half; const int h = chain % A_H, b = (chain / A_H) % BATCH, dir = chain / (A_H * BATCH);
    LAS unsigned char* lds = lds0 + half * S2_HALF; int t2 = tid & 255;
    for (int i = t2; i < 9216 / 16; i += 256) *(LAS u32x4_t*)(lds + S2_S + 16 * i) = (u32x4_t){0u, 0u, 0u, 0u};
    u32x4_t pre[10];
#define S2_LOADS(cc) do { const bf16_t* ib = p.RWC() + ((size_t)chain * RW_NCH + (cc)) * 5 * 4096; \
        _Pragma("unroll") for (int u = 0; u < 10; ++u) pre[u] = *(const u32x4_t*)(ib + (size_t)(t2 + 256 * u) * 8); } while (0)
    S2_LOADS(0);
#pragma unroll 1
    for (int c = 0; c < RW_NCH; ++c) {
        asm volatile("" : "+v"(tid)); lane = tid & 63; q4 = lane >> 4; l16 = lane & 15; t2 = tid & 255;
#pragma unroll
        for (int u = 0; u < 10; ++u) { const int piece = t2 + 256 * u, mat = piece >> 9, within = piece & 511; *(LAS u32x4_t*)(lds + S2_M + mat * 9216 + (within >> 3) * 144 + (within & 7) * 16) = pre[u]; }
        if (c + 1 < RW_NCH) S2_LOADS(c + 1);
        lds_barrier();
        f32x4 y[4], sn[4];
#pragma unroll
        for (int nt = 0; nt < 4; ++nt) y[nt] = sn[nt] = (f32x4){0.f, 0.f, 0.f, 0.f};
#pragma unroll
        for (int ks = 0; ks < 2; ++ks) {
            const bf16x8_t aR = lfrag(lds, S2_M, 144, 16 * w4, 32 * ks, lane), aM = lfrag(lds, S2_M + 9216, 144, 16 * w4, 32 * ks, lane);
            const bf16x8_t aS = lfrag(lds, S2_S, 144, 16 * w4, 32 * ks, lane), aV = lfrag(lds, S2_M + 4 * 9216, 144, 16 * w4, 32 * ks, lane);
#pragma unroll
            for (int nt = 0; nt < 4; ++nt) { const int n0 = 16 * nt;
                y[nt] = MMA16(lfrag(lds, S2_S, 144, n0, 32 * ks, lane), aR, y[nt]); y[nt] = MMA16(lfrag(lds, S2_M + 4 * 9216, 144, n0, 32 * ks, lane), aM, y[nt]);
                sn[nt] = MMA16(aS, lfrag(lds, S2_M + 2 * 9216, 144, n0, 32 * ks, lane), sn[nt]); sn[nt] = MMA16(aV, lfrag(lds, S2_M + 3 * 9216, 144, n0, 32 * ks, lane), sn[nt]); } }
        const int row0 = scan_row(dir, b, 64 * c), sgn = dir ? -1 : 1;
#pragma unroll
        for (int nt = 0; nt < 4; ++nt) { const int t = 16 * w4 + l16; u32x2_t w; w.x = pg8::cvt_pk_bf16(y[nt][0], y[nt][1]); w.y = pg8::cvt_pk_bf16(y[nt][2], y[nt][3]);
            *(u32x2_t*)(YAout + (unsigned)((dir * NTOK + row0 + sgn * t) * A_W + h * 64 + 16 * nt + 4 * q4)) = w; }
        lds_barrier();
#pragma unroll
        for (int nt = 0; nt < 4; ++nt) st_rm(lds, S2_S, 144, 16 * w4, 16 * nt, sn[nt], lane);
        lds_barrier();
    }
#undef S2_LOADS
}

constexpr int AT_K = 0  , AT_V = 18432  , ATT_NLAT = BATCH * 4 * (SEQ / 256), ATT_NCTX = BATCH * 4 * (CTXL / 256);
__device__ __forceinline__ void attn_unit(const P& p, int unit, LAS unsigned char* lds, int tid) {
    const int wave = __builtin_amdgcn_readfirstlane(tid >> 6); int lane = tid & 63, q4 = lane >> 4, l16 = lane & 15;
    int b, hq, qrow0, nt; bool lat;
    if (unit < ATT_NLAT) { lat = true; b = unit / (4 * (SEQ / 256)); hq = (unit / (SEQ / 256)) % 4; qrow0 = b * SEQ + 256 * (unit % (SEQ / 256)); nt = SLEN / 64; }
    else { const int u2 = unit - ATT_NLAT; lat = false; b = u2 / (4 * (CTXL / 256)); hq = (u2 / (CTXL / 256)) % 4; qrow0 = NLAT + b * CTXL + 256 * (u2 % (CTXL / 256)); nt = CTXL / 64; }
    const int kvh = hq >> 1; qrow0 += 32 * wave;
    bf16x8_t qf[2][2];
#pragma unroll
    for (int qt = 0; qt < 2; ++qt)
#pragma unroll
        for (int ks = 0; ks < 2; ++ks) qf[qt][ks] = *(const bf16x8_t*)(p.CQ() + (size_t)(qrow0 + 16 * qt + l16) * 256 + hq * 64 + 32 * ks + 8 * q4);
    f32x4 o[2][4]; float mrun[2], lrun[2];
#pragma unroll
    for (int qt = 0; qt < 2; ++qt) { mrun[qt] = 0.f; lrun[qt] = 0.f;
#pragma unroll
        for (int dt = 0; dt < 4; ++dt) o[qt][dt] = (f32x4){0.f, 0.f, 0.f, 0.f}; }
    u32x4_t pk, pv;
#define AT_ROWBASE(t) ((lat && (t) < SEQ / 64) ? b * SEQ + 64 * (t) : NLAT + b * CTXL + 64 * ((t) - (lat ? SEQ / 64 : 0)))
#define AT_LOAD(t) do { const size_t ro = (size_t)(AT_ROWBASE(t) + (tid >> 3)) * 128 + kvh * 64 + (tid & 7) * 8; pk = *(const u32x4_t*)(p.CK() + ro); \
        pv = *(const u32x4_t*)(p.CV() + ((size_t)(b * 2 + kvh) * 64 + (tid >> 3)) * SLEN + (lat ? 0 : SEQ) + 64 * (t) + (tid & 7) * 8); } while (0)
#define AT_STORE(buf) do { const int rw = tid >> 3, c16 = tid & 7; *(LAS u32x4_t*)(lds + AT_K + (buf) * 9216 + rw * 144 + c16 * 16) = pk; *(LAS u32x4_t*)(lds + AT_V + (buf) * 9216 + rw * 144 + c16 * 16) = pv; } while (0)
    AT_LOAD(0); AT_STORE(0);
    lds_barrier();
#pragma unroll 1
    for (int t = 0; t < nt; ++t) {
        asm volatile("" : "+v"(tid)); lane = tid & 63; q4 = lane >> 4; l16 = lane & 15;
        const int buf = t & 1;
        if (t + 1 < nt) AT_LOAD(t + 1);
        f32x4 s[2][4];
#pragma unroll
        for (int qt = 0; qt < 2; ++qt)
#pragma unroll
            for (int kt = 0; kt < 4; ++kt) s[qt][kt] = (f32x4){-mrun[qt], -mrun[qt], -mrun[qt], -mrun[qt]};
#pragma unroll
        for (int ks = 0; ks < 2; ++ks)
#pragma unroll
            for (int kt = 0; kt < 4; ++kt) { const bf16x8_t ak = lfrag(lds, AT_K + buf * 9216, 144, 16 * kt, 32 * ks, lane);
                s[0][kt] = MMA16(ak, qf[0][ks], s[0][kt]); s[1][kt] = MMA16(ak, qf[1][ks], s[1][kt]); }
        bf16x8_t pb[2][2];
#pragma unroll
        for (int qt = 0; qt < 2; ++qt) {
            float mx = s[qt][0][0];
#pragma unroll
            for (int kt = 0; kt < 4; ++kt)
#pragma unroll
                for (int r = 0; r < 4; ++r) mx = fmaxf(mx, s[qt][kt][r]);
            mx = fmaxf(mx, __shfl_xor(mx, 16)); mx = fmaxf(mx, __shfl_xor(mx, 32));
            if (__any(mx > 6.0f) || t == 0) { const float dl = (t == 0) ? mx : fmaxf(mx, 0.f), alpha = __builtin_amdgcn_exp2f(-dl); mrun[qt] += dl; lrun[qt] *= alpha;
#pragma unroll
                for (int kt = 0; kt < 4; ++kt) s[qt][kt] = s[qt][kt] - dl;
#pragma unroll
                for (int dt = 0; dt < 4; ++dt) o[qt][dt] = o[qt][dt] * alpha; }
            float ps = 0.f;
#pragma unroll
            for (int kt = 0; kt < 4; ++kt)
#pragma unroll
                for (int r = 0; r < 4; ++r) { const float e = __builtin_amdgcn_exp2f(s[qt][kt][r]); s[qt][kt][r] = e; ps += e; }
            lrun[qt] += ps;
#pragma unroll
            for (int k2 = 0; k2 < 2; ++k2) { u32x4_t w; w.x = pg8::cvt_pk_bf16(s[qt][2 * k2][0], s[qt][2 * k2][1]); w.y = pg8::cvt_pk_bf16(s[qt][2 * k2][2], s[qt][2 * k2][3]);
                w.z = pg8::cvt_pk_bf16(s[qt][2 * k2 + 1][0], s[qt][2 * k2 + 1][1]); w.w = pg8::cvt_pk_bf16(s[qt][2 * k2 + 1][2], s[qt][2 * k2 + 1][3]); pb[qt][k2] = __builtin_bit_cast(bf16x8_t, w); }
        }
#pragma unroll
        for (int k2 = 0; k2 < 2; ++k2)
#pragma unroll
            for (int dt = 0; dt < 4; ++dt) { LAS const unsigned char* vp = lds + AT_V + buf * 9216 + (16 * dt + l16) * 144 + (32 * k2 + 4 * q4) * 2;
                const u32x2_t lo = *(LAS const u32x2_t*)vp, hi = *(LAS const u32x2_t*)(vp + 32); u32x4_t w; w.x = lo.x; w.y = lo.y; w.z = hi.x; w.w = hi.y; const bf16x8_t av = __builtin_bit_cast(bf16x8_t, w);
                o[0][dt] = MMA16(av, pb[0][k2], o[0][dt]); o[1][dt] = MMA16(av, pb[1][k2], o[1][dt]); }
        if (t + 1 < nt) AT_STORE(buf ^ 1);
        lds_barrier();
    }
#pragma unroll
    for (int qt = 0; qt < 2; ++qt) { float l = lrun[qt]; l += __shfl_xor(l, 16); l += __shfl_xor(l, 32); const float inv = 1.0f / l;
        bf16_t* orow = p.MIX() + (size_t)(qrow0 + 16 * qt + l16) * D + 768 + hq * 64 + 4 * q4;
#pragma unroll
        for (int dt = 0; dt < 4; ++dt) { u32x2_t w; w.x = pg8::cvt_pk_bf16(o[qt][dt][0] * inv, o[qt][dt][1] * inv); w.y = pg8::cvt_pk_bf16(o[qt][dt][2] * inv, o[qt][dt][3] * inv); *(u32x2_t*)(orow + 16 * dt) = w; } }
#undef AT_ROWBASE
#undef AT_LOAD
#undef AT_STORE
}


__device__ __forceinline__ void wave_rows(int nrows, int nblk, int blk, int wave, int& r0, int& r1) {
    const int nw = nblk * NWAVES, per = (nrows + nw - 1) / nw, gwl = blk * NWAVES + wave; r0 = gwl * per; r1 = r0 + per; if (r1 > nrows) r1 = nrows; if (r0 > nrows) r0 = nrows;
}
__device__ __forceinline__ float sigm(float x) { return __builtin_amdgcn_rcpf(1.0f + __expf(-x)); }
struct P0Cv { u32x4_t cv[5]; };
struct P0Sm { u32x4_t lr[3]; u32x2_t aq, ak, av; float ga, gb; };
__device__ __forceinline__ void prep0_load_cv(const P& p, int m, int which, int lane, P0Cv& in) {
    int b, t, len, base; row_info(m, b, t, len, base);
#pragma unroll
    for (int j = 0; j < 5; ++j) { const int tt = t + j - 2; in.cv[j] = (tt >= 0 && tt < len) ? *(const u32x4_t*)(p.U() + (size_t)(base + tt) * INP + B_OFF + which * B_W + 8 * lane) : (u32x4_t){0u, 0u, 0u, 0u}; }
}
__device__ __forceinline__ void prep0_compute_cv(const P& p, int l, int m, int which, int lane, const P0Cv& in, const f32x4_t (&cwr)[5][2]) {
    float acc[8];
#pragma unroll
    for (int c = 0; c < 8; ++c) acc[c] = 0.f;
#pragma unroll
    for (int j = 0; j < 5; ++j) { const u32x4_t uv = in.cv[j];
        const f32x4_t w0 = cwr[j][0], w1 = cwr[j][1];
        acc[0] += bflo(uv.x) * w0.x; acc[1] += bfhi(uv.x) * w0.y; acc[2] += bflo(uv.y) * w0.z; acc[3] += bfhi(uv.y) * w0.w;
        acc[4] += bflo(uv.z) * w1.x; acc[5] += bfhi(uv.z) * w1.y; acc[6] += bflo(uv.w) * w1.z; acc[7] += bfhi(uv.w) * w1.w; }
    float ss = 0.f;
#pragma unroll
    for (int c = 0; c < 8; ++c) { acc[c] = acc[c] * sigm(acc[c]); ss += acc[c] * acc[c]; }
    float rn = 1.0f;
    if (which < 2) rn = (frsq(grp16_sum(ss) + 1e-6f)) * (which == 0 ? 0.08838834764831845f : 1.0f);
    u32x4_t w; w.x = pg8::cvt_pk_bf16(acc[0] * rn, acc[1] * rn); w.y = pg8::cvt_pk_bf16(acc[2] * rn, acc[3] * rn); w.z = pg8::cvt_pk_bf16(acc[4] * rn, acc[5] * rn); w.w = pg8::cvt_pk_bf16(acc[6] * rn, acc[7] * rn);
    *(u32x4_t*)((which == 0 ? p.GQ() : which == 1 ? p.GK() : p.GV()) + (size_t)m * B_W + 8 * lane) = w;
}
__device__ __forceinline__ void prep0_load_sm(const P& p, int m, int lane, P0Sm& in) {
    int b, t, len, base; row_info(m, b, t, len, base);
    const bf16_t* ur = p.U() + (size_t)m * INP; const bool hp = t > 0, hn = t + 1 < len;
    { const int c = 768 + 8 * (lane < 24 ? lane : 23); const u32x4_t z = {0u, 0u, 0u, 0u};
      in.lr[0] = *(const u32x4_t*)(ur + c); in.lr[1] = hp ? *(const u32x4_t*)(ur + c - INP) : z; in.lr[2] = hn ? *(const u32x4_t*)(ur + c + INP) : z; }
    in.aq = *(const u32x2_t*)(ur + C_OFF + 4 * lane); in.ak = *(const u32x2_t*)(ur + C_OFF + 256 + 4 * (lane & 31)); in.av = *(const u32x2_t*)(ur + C_OFF + 384 + 4 * (lane & 31));
    in.ga = bf2f(ur[B_OFF + 2048 + (lane & 7)]); in.gb = bf2f(ur[B_OFF + 2056 + (lane & 7)]);
}
struct P0Par { f32x4_t m0, m1, qn, kn; float dtb, alog; };
__device__ __forceinline__ void prep0_params(const P& p, int l, int lane, P0Par& q) {
    const float* mup = p.rw_mu + l * A_IN + 768 + 8 * (lane < 24 ? lane : 23); q.m0 = *(const f32x4_t*)mup; q.m1 = *(const f32x4_t*)(mup + 4);
    q.qn = *(const f32x4_t*)(p.attn_q_norm + l * 64 + 4 * (lane & 15)); q.kn = *(const f32x4_t*)(p.attn_k_norm + l * 64 + 4 * (lane & 15));
    q.dtb = p.gdn_dt_bias[(l * 2 + ((lane & 7) >> 2)) * B_H + (lane & 3)]; q.alog = p.gdn_a_log[(l * 2 + ((lane & 7) >> 2)) * B_H + (lane & 3)];
}
__device__ __forceinline__ void prep0_compute_sm(const P& p, int l, int m, int lane, const P0Sm& in, const P0Par& par) {
    const int i16 = lane & 15; int b, t, len, base; row_info(m, b, t, len, base);
    if (lane < 32) {
        u32x4_t w = {0u, 0u, 0u, 0u};
        if (lane < 24) {
            const f32x4_t m0 = par.m0, m1 = par.m1;
            float u[8], up[8], un[8], o[8];
#pragma unroll
            for (int j = 0; j < 4; ++j) { u[2 * j] = bflo(in.lr[0][j]); u[2 * j + 1] = bfhi(in.lr[0][j]); up[2 * j] = bflo(in.lr[1][j]); up[2 * j + 1] = bfhi(in.lr[1][j]); un[2 * j] = bflo(in.lr[2][j]); un[2 * j + 1] = bfhi(in.lr[2][j]); }
            const int grp = lane >> 3;
#pragma unroll
            for (int j = 0; j < 8; ++j) { const float mu = j < 4 ? m0[j & 3] : m1[j & 3]; const float v = u[j] + mu * (0.5f * (up[j] + un[j]) - u[j]);
                const float e = __expf(grp == 0 ? 2.0f * v : -v), rc = frcp(1.0f + e); o[j] = grp == 0 ? 1.0f - 2.0f * rc : (grp == 1 ? v : rc); }
            w.x = pg8::cvt_pk_bf16(o[0], o[1]); w.y = pg8::cvt_pk_bf16(o[2], o[3]); w.z = pg8::cvt_pk_bf16(o[4], o[5]); w.w = pg8::cvt_pk_bf16(o[6], o[7]);
        }
        *(u32x4_t*)(p.LRT() + (size_t)m * 256 + 8 * lane) = w;
    }
    if (lane < 8) {
        const float xs = in.ga + par.dtb; const float sp = xs > 20.f ? xs : __logf(1.0f + __expf(xs));
        p.GG()[(size_t)m * 8 + lane] = -__expf(par.alog) * sp; p.GBETA()[(size_t)m * 8 + lane] = sigm(in.gb); }
    {
        const int i = i16; f32x4_t cs = {1.f, 1.f, 1.f, 1.f}, sn = {0.f, 0.f, 0.f, 0.f};
        if (m < NLAT) { cs = *(const f32x4_t*)(p.ROPE() + (size_t)t * 128 + 4 * i); sn = *(const f32x4_t*)(p.ROPE() + (size_t)t * 128 + 64 + 4 * i); }
        const float sgn = (i & 4) ? 1.f : -1.f;
        {
            const f32x4_t x = bf4(in.aq); const float rstd = (frsq(grp16_sum(hsq4(x)) * (1.0f / 64.f) + 1e-6f)) * 0.18033688011112042f;
            const f32x4_t nw = par.qn; f32x4_t y = x * rstd * nw, o;
#pragma unroll
            for (int c = 0; c < 4; ++c) { const float pr = __shfl_xor(y[c], 4); o[c] = y[c] * cs[c] + sgn * pr * sn[c]; }
            *(u32x2_t*)(p.CQ() + (size_t)m * 256 + 4 * lane) = pk4(o);
        }
        {
            const f32x4_t x = bf4(in.ak); const float rstd = frsq(grp16_sum(hsq4(x)) * (1.0f / 64.f) + 1e-6f);
            const f32x4_t nw = par.kn; f32x4_t y = x * rstd * nw, o;
#pragma unroll
            for (int c = 0; c < 4; ++c) { const float pr = __shfl_xor(y[c], 4); o[c] = y[c] * cs[c] + sgn * pr * sn[c]; }
            if (lane < 32) { *(u32x2_t*)(p.CK() + (size_t)m * 128 + 4 * lane) = pk4(o);
                const u32x2_t vv = in.av; const int key = m < NLAT ? t : SEQ + t;
                bf16_t* vt = p.CV() + ((size_t)(b * 2 + (lane >> 4)) * 64 + 4 * (lane & 15)) * SLEN + key;
                vt[0] = (bf16_t)(vv.x & 0xffffu); vt[SLEN] = (bf16_t)(vv.x >> 16); vt[2 * SLEN] = (bf16_t)(vv.y & 0xffffu); vt[3 * SLEN] = (bf16_t)(vv.y >> 16); }
        }
    }
}
__device__ __forceinline__ u32x4_t prep0_row(const P& p, int row, int which, int lane) {
    return (row >= 0 && row < NTOK) ? *(const u32x4_t*)(p.U() + (size_t)row * INP + B_OFF + which * B_W + 8 * lane) : (u32x4_t){0u, 0u, 0u, 0u};
}
__device__ __forceinline__ void dev_prep0(const P& p, int l, int G, int wave, int lane) {
    const int per = (NTOK + G - 1) / G, t0 = (int)blockIdx.x * per, t1 = (t0 + per < NTOK) ? t0 + per : NTOK;
#ifdef PT_P0
    const unsigned long long tp0_ = __builtin_amdgcn_s_memrealtime();
#endif
    {
        const int pw = (per + NWAVES - 1) / NWAVES, r0 = t0 + wave * pw, r1 = (r0 + pw < t1) ? r0 + pw : t1;
#pragma unroll 1
        for (int which = 0; which < 3; ++which) {
            if (r0 >= r1) break;
            f32x4_t cwr[5][2];
#pragma unroll
            for (int j = 0; j < 5; ++j) { const float* cw = p.gdn_conv + ((size_t)l * 5 + j) * (3 * B_W) + which * B_W + 8 * lane; cwr[j][0] = *(const f32x4_t*)cw; cwr[j][1] = *(const f32x4_t*)(cw + 4); }
            u32x4_t w0 = prep0_row(p, r0 - 2, which, lane), w1 = prep0_row(p, r0 - 1, which, lane), w2 = prep0_row(p, r0, which, lane), w3 = prep0_row(p, r0 + 1, which, lane);
            u32x4_t n0 = prep0_row(p, r0 + 2, which, lane), n1 = prep0_row(p, r0 + 3, which, lane);
            for (int m = r0; m < r1; m += 2) {
                const u32x4_t w4 = n0, w5 = n1; n0 = prep0_row(p, m + 4, which, lane); n1 = prep0_row(p, m + 5, which, lane);
                {
                    int b, t, len, base; row_info(m, b, t, len, base); P0Cv use; use.cv[0] = w0; use.cv[1] = w1; use.cv[2] = w2; use.cv[3] = w3; use.cv[4] = w4;
#pragma unroll
                    for (int j = 0; j < 5; ++j) { const int tt = t + j - 2; if (tt < 0 || tt >= len) use.cv[j] = (u32x4_t){0u, 0u, 0u, 0u}; }
                    prep0_compute_cv(p, l, m, which, lane, use, cwr);
                }
                if (m + 1 < r1) {
                    int b, t, len, base; row_info(m + 1, b, t, len, base); P0Cv use; use.cv[0] = w1; use.cv[1] = w2; use.cv[2] = w3; use.cv[3] = w4; use.cv[4] = w5;
#pragma unroll
                    for (int j = 0; j < 5; ++j) { const int tt = t + j - 2; if (tt < 0 || tt >= len) use.cv[j] = (u32x4_t){0u, 0u, 0u, 0u}; }
                    prep0_compute_cv(p, l, m + 1, which, lane, use, cwr);
                }
                w0 = w2; w1 = w3; w2 = w4; w3 = w5;
            }
        }
    }
#ifdef PT_P0
    const unsigned long long tp1_ = __builtin_amdgcn_s_memrealtime();
#endif
    const int first = t0 + wave, ntk = first < t1 ? (t1 - first + NWAVES - 1) / NWAVES : 0;
    {
        P0Par par; prep0_params(p, l, lane, par);
        P0Sm cur; if (ntk > 0) prep0_load_sm(p, first, lane, cur);
        for (int i = 0; i < ntk; ++i) { const int m = first + i * NWAVES; P0Sm nxt = cur; if (i + 1 < ntk) prep0_load_sm(p, m + NWAVES, lane, nxt); prep0_compute_sm(p, l, m, lane, cur, par); cur = nxt; }
    }
#ifdef PT_P0
    { const unsigned long long tp2_ = __builtin_amdgcn_s_memrealtime(); const unsigned d_ = PT_P0 == 1 ? (unsigned)(tp1_ - tp0_) : (unsigned)(tp2_ - tp1_); if (lane == 0) atomicMax(p.ctl() + 12070 + l, d_); }
#endif
}
__device__ __forceinline__ void dev_build_rope(const P& p, long gtid, long nthr) {
    for (long e = gtid; e < (long)SEQ * 64; e += nthr) { const int t = (int)(e >> 6), d = (int)(e & 63); const float pos = d < 32 ? (float)(t / GRID_W) : (float)(t % GRID_W);
        const float ang = pos * exp2f(-0.8304820237218406f * (float)(d & 15)); p.ROPE()[(size_t)t * 128 + d] = cosf(ang); p.ROPE()[(size_t)t * 128 + 64 + d] = sinf(ang); }
}
struct A1In { u32x2_t u[3][3]; u32x2_t lro[5]; };
__device__ __forceinline__ void prepA1_load(const P& p, int m, int lane, A1In& in) {
    int b, t, len, base; row_info(m, b, t, len, base);
    const bf16_t* ur = p.U() + (size_t)m * INP; const bool hp = t > 0, hn = t + 1 < len; const u32x2_t z = {0u, 0u};
#pragma unroll
    for (int a = 0; a < 3; ++a) { const int c = 256 * a + 4 * lane; in.u[a][1] = *(const u32x2_t*)(ur + c); in.u[a][0] = hp ? *(const u32x2_t*)(ur + c - INP) : z; in.u[a][2] = hn ? *(const u32x2_t*)(ur + c + INP) : z; }
    const bf16_t* lo = p.LRO() + (size_t)m * 1280 + 4 * lane;
#pragma unroll
    for (int g = 0; g < 5; ++g) in.lro[g] = *(const u32x2_t*)(lo + 256 * g);
}
__device__ __forceinline__ void dev_prepA1(const P& p, int l, int gw, int ngw, int lane) {
    const int h = lane >> 4;
    const f32x4_t kkp = *(const f32x4_t*)(p.rw_k_k + l * A_W + 4 * lane), kap = *(const f32x4_t*)(p.rw_k_a + l * A_W + 4 * lane), rkp = *(const f32x4_t*)(p.rw_r_k + l * A_W + 4 * lane);
    f32x4_t mu3[3], w0p[2], a0p[2];
#pragma unroll
    for (int a = 0; a < 3; ++a) mu3[a] = *(const f32x4_t*)(p.rw_mu + l * A_IN + 256 * a + 4 * lane);
#pragma unroll
    for (int dir = 0; dir < 2; ++dir) { w0p[dir] = *(const f32x4_t*)(p.rw_w0 + (l * 2 + dir) * A_W + 4 * lane); a0p[dir] = *(const f32x4_t*)(p.rw_a0 + (l * 2 + dir) * A_W + 4 * lane); }
    int m = gw; if (m >= NTOK) return;
    A1In cur; prepA1_load(p, m, lane, cur);
    for (; m < NTOK; m += ngw) {
        A1In nxt = cur; if (m + ngw < NTOK) prepA1_load(p, m + ngw, lane, nxt);
        f32x4_t rkv[3];
#pragma unroll
        for (int a = 0; a < 3; ++a) { const f32x4_t u = bf4(cur.u[a][1]); rkv[a] = u + mu3[a] * (0.5f * (bf4(cur.u[a][0]) + bf4(cur.u[a][2])) - u); }
        const f32x4_t r = rkv[0], k = rkv[1], v = rkv[2];
        const f32x4_t kx = k * kkp; const float rn = frsq(grp16_sum(hsq4(kx)) + 1e-6f); const f32x4_t kk = kx * rn;
        f32x4_t kdsum = {0.f, 0.f, 0.f, 0.f};
#pragma unroll
        for (int dir = 0; dir < 2; ++dir) {
            const f32x4_t w = w0p[dir] + bf4(cur.lro[dir]);
            const f32x4_t a = a0p[dir] + bf4(cur.lro[2 + dir]);
            f32x4_t ld, ic;
#pragma unroll
            for (int c = 0; c < 4; ++c) { const float nw = -w[c]; const float sp = nw > 20.f ? nw : __logf(1.0f + __expf(nw)); ld[c] = -__expf(-sp - 0.5f); ic[c] = sigm(a[c]); }
            const f32x4_t kd = k * (1.0f + (ic - 1.0f) * kap); kdsum = kdsum + kd;
            const size_t o = ((size_t)dir * NTOK + m) * A_W + 4 * lane;
            *(f32x4_t*)(p.RW_D() + o) = ld; *(u32x2_t*)(p.RW_KD() + o) = pk4(kd); *(u32x2_t*)(p.RW_KKA() + o) = pk4(kk * ic);
        }
        const size_t o1 = (size_t)m * A_W + 4 * lane;
        *(u32x2_t*)(p.RW_R() + o1) = pk4(r); *(u32x2_t*)(p.RW_V() + o1) = pk4(v); *(u32x2_t*)(p.RW_KK() + o1) = pk4(kk); *(u32x2_t*)(p.RW_GATE() + o1) = cur.lro[4];
        const float bon = grp16_sum(hsum4(r * kdsum * rkp));
        if ((lane & 15) == 0) p.RW_BON()[(size_t)m * A_H + h] = bon;
        cur = nxt;
    }
}
__device__ __forceinline__ void dev_build_wlr(const P& p, int l, long gtid, long nthr) {
    for (long e = gtid; e < 1280L * 256; e += nthr) { const int n = (int)(e >> 8), k = (int)(e & 255), g = n >> 8, ch = n & 255; float v = 0.f;
        if (g < 2) { if ((k >> 5) == g) v = p.rw_w2[((size_t)(l * 2 + g) * 32 + (k & 31)) * A_W + ch]; }
        else if (g < 4) { if ((k >> 5) == g) v = p.rw_a2[((size_t)(l * 2 + (g - 2)) * 32 + (k & 31)) * A_W + ch]; }
        else { if (k >= 128 && k < 192) v = p.rw_g2[((size_t)l * 64 + (k - 128)) * A_W + ch]; }
        p.WLR_T(l)[e] = f2bf(v); }
}

constexpr int RING_BYTES = 131072, MISC_OFF = 147200, LDS_BYTES = 147456;
constexpr size_t MiB = 1u << 20;
constexpr int CW_BAR = 4096, CW_CNT = 8192;

__device__ __forceinline__ void transpose_item(const float* W, int K, int N, bf16_t* WT, LAS float* scr, int item, int lane) {
    const int nblk_k = K / 64; const int nb = item / nblk_k, kb = item % nblk_k, k0 = 64 * kb, n0 = 64 * nb;
    const int nl = 4 * (lane & 15), kq = lane >> 4;
    f32x4 v[16];
#pragma unroll
    for (int i = 0; i < 16; ++i) { const float* src = W + (size_t)(k0 + 4 * i + kq) * N + n0 + nl;
        if (n0 + nl + 3 < N) v[i] = *(const f32x4*)src;
        else { v[i] = (f32x4){0.f, 0.f, 0.f, 0.f}; if (n0 + nl < N) v[i][0] = src[0]; if (n0 + nl + 1 < N) v[i][1] = src[1]; if (n0 + nl + 2 < N) v[i][2] = src[2]; } }
#pragma unroll
    for (int i = 0; i < 16; ++i) { LAS float* d = scr + (4 * i + kq) * 65 + nl; d[0] = v[i][0]; d[1] = v[i][1]; d[2] = v[i][2]; d[3] = v[i][3]; }
    asm volatile("s_waitcnt lgkmcnt(0)" ::: "memory");
    const int c = lane & 7;
#pragma unroll
    for (int j = 0; j < 8; ++j) { const int n = (lane >> 3) + 8 * j; const LAS float* sp = scr + (8 * c) * 65 + n;
        pg8::u32x4 o; o.x = pg8::cvt_pk_bf16(sp[0 * 65], sp[1 * 65]); o.y = pg8::cvt_pk_bf16(sp[2 * 65], sp[3 * 65]); o.z = pg8::cvt_pk_bf16(sp[4 * 65], sp[5 * 65]); o.w = pg8::cvt_pk_bf16(sp[6 * 65], sp[7 * 65]);
        *(pg8::u32x4*)(WT + (size_t)(n0 + n) * K + k0 + 8 * c) = o; }
    asm volatile("s_waitcnt lgkmcnt(0)" ::: "memory");
}

struct Args { P p; int ph_lo, ph_hi; };

#define RUN_TASKS(ntasks, call) do { const long _n = (long)(ntasks); for (long task = gtid; task < _n; task += nthr) { call; } } while (0)


__device__ __forceinline__ void dev_mod(const P& p, int cg, LAS unsigned char* lds, int tid) {
    LAS float* STB = (LAS float*)lds; LAS float* PT = (LAS float*)(lds + 69632);
    const int lane = tid & 63, wave = tid >> 6; const int lyr = cg / 96, j0 = (cg % 96) * 64;
    for (int idx = tid; idx < (BATCH + 1) * D; idx += NTHR) { const int r = idx >> 10, k = idx & 1023; const float v = r < BATCH ? p.c[(size_t)r * D + k] : p.c_ctx[k]; STB[idx] = v / (1.0f + __expf(-v)); }
    __syncthreads();
    float acc[BATCH + 1];
#pragma unroll
    for (int r = 0; r <= BATCH; ++r) acc[r] = 0.f;
    const float* w = p.ada_w + ((size_t)lyr * D + 128 * wave) * 6 * D + j0 + lane;
#pragma unroll 4
    for (int k = 0; k < 128; ++k) { const float wv = w[(size_t)k * 6 * D];
#pragma unroll
        for (int r = 0; r <= BATCH; ++r) acc[r] += STB[r * D + 128 * wave + k] * wv; }
#pragma unroll
    for (int r = 0; r <= BATCH; ++r) PT[(wave * (BATCH + 1) + r) * 64 + lane] = acc[r];
    __syncthreads();
    for (int idx = tid; idx < (BATCH + 1) * 64; idx += NTHR) { const int r = idx >> 6, jj = idx & 63; float sacc = p.ada_b[(size_t)lyr * 6 * D + j0 + jj];
#pragma unroll
        for (int w2 = 0; w2 < 8; ++w2) sacc += PT[(w2 * (BATCH + 1) + r) * 64 + jj];
        p.MOD()[((size_t)lyr * (BATCH + 1) + r) * 6 * D + j0 + jj] = sacc; }
    __syncthreads();
}
constexpr int CV_I_IN = (D / 64) * (INP / 64), CV_I_OUT = (D / 64) * (D / 64), CV_I_R = (D / 64), CV_I_GU = (D / 64) * (2 * DEXP / 64), CV_I_DN = (DEXP / 64) * (D / 64);
constexpr int CV_SMALL = CV_I_IN + CV_I_OUT + CV_I_R, CV_TOTAL = CV_SMALL + NEXP * (CV_I_GU + CV_I_DN), CV_CHUNK = 8;
constexpr int CV_NCH_SMALL = (CV_SMALL + CV_CHUNK - 1) / CV_CHUNK, CV_NCH_MOE = (CV_TOTAL - CV_SMALL + CV_CHUNK - 1) / CV_CHUNK;
__device__ __forceinline__ void conv_chunk(const P& p, int l, bool moe, int chunk, LAS unsigned char* ldsp, int wave, int lane) {
    LAS float* scr = (LAS float*)(ldsp + wave * 16896);
    for (int i = 0; i < CV_CHUNK / NWAVES; ++i) {
        int r = chunk * CV_CHUNK + wave + NWAVES * i; if (moe) { r += CV_SMALL; if (r >= CV_TOTAL) break; } else if (r >= CV_SMALL) break;
        if (r < CV_I_IN) { transpose_item(p.w_in + (size_t)l * D * INW, D, INW, p.WIN_T(l), scr, r, lane); continue; } r -= CV_I_IN;
        if (r < CV_I_OUT) { transpose_item(p.w_out + (size_t)l * D * D, D, D, p.WOUT_T(l), scr, r, lane); continue; } r -= CV_I_OUT;
        if (r < CV_I_R) { transpose_item(p.router_w + (size_t)l * D * NEXP, D, NEXP, p.WR_T(l), scr, r, lane); continue; } r -= CV_I_R;
        if (r < NEXP * CV_I_GU) { const int e = r / CV_I_GU; transpose_item(p.exp_w_gu + ((size_t)l * NEXP + e) * D * 2 * DEXP, D, 2 * DEXP, p.WGU_T(l) + (size_t)e * 2 * DEXP * D, scr, r % CV_I_GU, lane); continue; } r -= NEXP * CV_I_GU;
        { const int e = r / CV_I_DN; transpose_item(p.exp_w_dn + ((size_t)l * NEXP + e) * DEXP * D, DEXP, D, p.WDN_T(l) + (size_t)e * D * DEXP, scr, r % CV_I_DN, lane); }
    }
}

__device__ __forceinline__ int q_next(unsigned* ctr, volatile LAS unsigned* slot, int tid) {
    if (tid == 0) *slot = __hip_atomic_fetch_add(ctr, 1u, __ATOMIC_RELAXED, __HIP_MEMORY_SCOPE_AGENT);
    __syncthreads(); const int v = (int)*slot; __syncthreads(); return v;
}

__device__ __forceinline__ int q_filler(unsigned* cctr, unsigned* dctr, unsigned nitems, volatile LAS unsigned* slot, int tid) {
    if (tid == 0) { const unsigned d = __hip_atomic_load(dctr, __ATOMIC_RELAXED, __HIP_MEMORY_SCOPE_AGENT); *slot = d >= nitems ? 0x7fffffffu : __hip_atomic_fetch_add(cctr, 1u, __ATOMIC_RELAXED, __HIP_MEMORY_SCOPE_AGENT); }
    __syncthreads(); const int v = (int)*slot; __syncthreads(); return v;
}

#ifndef DBG_PH
#define DBG_PH -1
#endif
#define PHON(j) (DBG_PH < 0 || DBG_PH == (j))
#define IN(k) (lo <= (k) && (k) < hi)
#define TID_NOW() (wave_s * 64 + (int)__builtin_amdgcn_mbcnt_hi(~0u, __builtin_amdgcn_mbcnt_lo(~0u, 0u)))
#define PHASE_VARS P p = args.p; asm volatile("" : "+s"(p.ws)); int tid_ = TID_NOW(); asm volatile("" : "+v"(tid_)); const int lane = tid_ & 63, wave = __builtin_amdgcn_readfirstlane(tid_ >> 6); \
    const long gtid = ((long)wave * G + blockIdx.x) * 64 + lane, nthr = (long)G * NTHR; const int gw = wave * G + blockIdx.x, ngw = G * NWAVES; (void)gw; (void)ngw; (void)gtid; (void)nthr; (void)lane;
#ifdef PROBE_T
#define SEAM(k) do { if (IN((k) + 1)) xcd_barrier(bar, TID_NOW()); if (blockIdx.x == 0 && TID_NOW() == 0) ((unsigned long long*)(args.p.ctl() + 12100))[(k) + 1] = __builtin_amdgcn_s_memrealtime(); } while (0)
#else
#define SEAM(k) do { if (IN((k) + 1)) xcd_barrier(bar, TID_NOW()); } while (0)
#endif
template <int l>
__device__ __forceinline__ void layer_body(const Args& args, const XcdBarrier& bar, LAS unsigned char* ldsp, const int G, const int wave_s, const int lo, const int hi) {
        const int pb = 1 + l * NPH;
        const bool need_ctx = l < DEPTH - 1;
        const int ntok_l = need_ctx ? NTOK : NLAT;
        if (l == 0 && PHON(0) && IN(pb + 0)) { PHASE_VARS;
            dev_norm1_l0(p, G, wave, lane);
            SEAM(pb + 0);
        }
        if (PHON(1) && IN(pb + 1)) { PHASE_VARS; (void)tid_; (void)wave;
            pg8::Gemm g{p.HB(), p.WIN_T(l), D, 0, nullptr}; pg8::StaticOrder S; S.init(NTOK, INP, G, (int)blockIdx.x);
            pg8::EpiBf16Bias E{p.U(), INP, nullptr, 0};
            pg8::gemm_phase(ldsp, g, S, E, tid_);
            SEAM(pb + 1);
        }
        if (PHON(2) && IN(pb + 2)) { PHASE_VARS; dev_prep0(p, l, G, wave, lane); SEAM(pb + 2); }
        if (PHON(3) && IN(pb + 3)) { PHASE_VARS; (void)tid_; (void)wave;
            pg8::Gemm g{p.LRT(), p.WLR_T(l), 256, 0, nullptr}; pg8::StaticOrder S; S.init(NTOK, 1280, G, (int)blockIdx.x);
            pg8::EpiBf16Bias E{p.LRO(), 1280, nullptr, 0};
            pg8::gemm_phase(ldsp, g, S, E, tid_);
            SEAM(pb + 3);
        }
        if (PHON(4) && IN(pb + 4)) { PHASE_VARS; dev_prepA1(p, l, gw, ngw, lane); SEAM(pb + 4); }
        if (PHON(5) && IN(pb + 5)) { PHASE_VARS;
            const int nchain = 2 * BATCH * B_H, nitems = nchain + RW_UNITS;
            unsigned* ctr = p.ctl() + 12200 + 64 * (2 * l); volatile LAS unsigned* slot = (volatile LAS unsigned*)(ldsp + MISC_OFF + 64);
#ifdef PROBE_GDN
            { const long nB = 2L * BATCH * B_H * 128; for (long task = gtid; task < nB; task += nthr) task_scanB(p, task); }
#endif
            unsigned long long tacc_ = 0ull, t0_ = 0ull; (void)tacc_; (void)t0_;
#ifdef PT_ACT
#define ACT_BEGIN(a) do { if (PT_ACT == (a)) t0_ = __builtin_amdgcn_s_memrealtime(); } while (0)
#define ACT_END(a) do { if (PT_ACT == (a)) tacc_ += __builtin_amdgcn_s_memrealtime() - t0_; } while (0)
#define ACT_FLUSH() do { if (tid_ == 0) atomicMax(p.ctl() + 12070 + l, (unsigned)tacc_); } while (0)
#else
#define ACT_BEGIN(a)
#define ACT_END(a)
#define ACT_FLUSH()
#endif
            int cur = q_next(ctr, slot, tid_);
            while (cur < nchain) {
                ACT_BEGIN(1); gdn_chain(p.GQ(), p.GK(), p.GV(), p.GG(), p.GBETA(), cur, p.OB(), ldsp, tid_, p.ctl()); ACT_END(1);
                if (tid_ == 0) __hip_atomic_fetch_add(ctr + 32, 1u, __ATOMIC_RELAXED, __HIP_MEMORY_SCOPE_AGENT);
                cur = q_next(ctr, slot, tid_); }
            if (cur < nitems) {
                S1In in; rwkv_stage1_load(p, cur - nchain, tid_, in);
                while (cur < nitems) {
                    const int nxt = q_next(ctr, slot, tid_);
                    S1In in2; const bool have2 = nxt < nitems;
                    if (have2) rwkv_stage1_load(p, nxt - nchain, tid_, in2); else in2 = in;
                    ACT_BEGIN(2); rwkv_stage1(p, cur - nchain, in, ldsp, tid_); ACT_END(2);
                    if (tid_ == 0) __hip_atomic_fetch_add(ctr + 32, 1u, __ATOMIC_RELAXED, __HIP_MEMORY_SCOPE_AGENT);
                    in = in2; cur = nxt;
                }
            }
            ACT_FLUSH();
            {
                unsigned* cctr = p.ctl() + 12200 + 64 * (8 + 2 * l);
                for (int ch = q_filler(cctr, ctr + 32, (unsigned)nitems, slot, tid_); ch < CV_NCH_MOE + (l + 1 < DEPTH ? CV_NCH_SMALL : 0); ch = q_filler(cctr, ctr + 32, (unsigned)nitems, slot, tid_)) {
                    if (ch < CV_NCH_MOE) conv_chunk(p, l, true, ch, ldsp, wave, lane); else conv_chunk(p, l + 1, false, ch - CV_NCH_MOE, ldsp, wave, lane); } }
            SEAM(pb + 5);
        }
        if (PHON(6) && IN(pb + 6)) { PHASE_VARS;
            const int ngb = 0, nch = ngb + BATCH * A_H, nun = ATT_NLAT + (need_ctx ? ATT_NCTX : 0);
            unsigned* ctr = p.ctl() + 12200 + 64 * (2 * l + 1); volatile LAS unsigned* slot = (volatile LAS unsigned*)(ldsp + MISC_OFF + 64);
#ifdef PROBE_RWKV
            { const long nA = 2L * BATCH * A_H * 64; for (long task = gtid; task < nA; task += nthr) task_scanA(p, task); }
#endif
            unsigned long long tacc_ = 0ull, t0_ = 0ull; (void)tacc_; (void)t0_;
            for (int cur = q_next(ctr, slot, tid_); cur < nch + nun; cur = q_next(ctr, slot, tid_)) {
                if (cur < nch) { ACT_BEGIN(3); rwkv_stage2(p, cur - ngb,
#ifdef PROBE_RWKV
                    (bf16_t*)(p.ws + WS_TOTAL),
#else
                    p.YA(),
#endif
                    ldsp, tid_); ACT_END(3); }
                else { ACT_BEGIN(4); attn_unit(p, cur - nch, ldsp, tid_); ACT_END(4); }
                if (tid_ == 0) __hip_atomic_fetch_add(ctr + 32, 1u, __ATOMIC_RELAXED, __HIP_MEMORY_SCOPE_AGENT);
            }
            ACT_FLUSH();
            {
                unsigned* cctr = p.ctl() + 12200 + 64 * (8 + 2 * l);
                for (int ch = q_filler(cctr, ctr + 32, (unsigned)(nch + nun), slot, tid_); ch < CV_NCH_MOE + (l + 1 < DEPTH ? CV_NCH_SMALL : 0); ch = q_filler(cctr, ctr + 32, (unsigned)(nch + nun), slot, tid_)) {
                    if (ch < CV_NCH_MOE) conv_chunk(p, l, true, ch, ldsp, wave, lane); else conv_chunk(p, l + 1, false, ch - CV_NCH_MOE, ldsp, wave, lane); } }
            SEAM(pb + 6);
        }
        if (PHON(7) && IN(pb + 7)) { PHASE_VARS;
#ifdef PROBE_GDN
            { float e2 = 0.f, r2 = 0.f; const bf16_t* cand = (const bf16_t*)(p.ws + WS_TOTAL); const bf16_t* ref = p.OB();
              for (long i = gtid; i < 2L * NTOK * B_W; i += nthr) { const float d = bf2f(cand[i]) - bf2f(ref[i]); e2 += d * d; r2 += bf2f(ref[i]) * bf2f(ref[i]); }
              e2 = wave_sum(e2); r2 = wave_sum(r2); if (lane == 0) { atomicAdd((float*)(p.ctl() + 12000), e2); atomicAdd((float*)(p.ctl() + 12001), r2); } }
#endif
#ifdef PROBE_RWKV
            { float e2 = 0.f, r2 = 0.f; const bf16_t* cand = (const bf16_t*)(p.ws + WS_TOTAL); const bf16_t* ref = p.YA();
              for (long i = gtid; i < 2L * NTOK * A_W; i += nthr) { const float d = bf2f(cand[i]) - bf2f(ref[i]); e2 += d * d; r2 += bf2f(ref[i]) * bf2f(ref[i]); }
              e2 = wave_sum(e2); r2 = wave_sum(r2); if (lane == 0) { atomicAdd((float*)(p.ctl() + 12000), e2); atomicAdd((float*)(p.ctl() + 12001), r2); } }
#endif
            dev_post(p, l, ntok_l, gw, ngw, lane); SEAM(pb + 7); }
        if (PHON(8) && IN(pb + 8)) { PHASE_VARS; (void)tid_; (void)wave;
            pg8::Gemm g{p.MIX(), p.WOUT_T(l), D, 0, nullptr}; pg8::StaticOrder S; S.init(ntok_l, D, G, (int)blockIdx.x);
            pg8::EpiBf16Bias E{p.MO(), D, nullptr, 0};
            pg8::gemm_phase(ldsp, g, S, E, tid_);
            SEAM(pb + 8);
        }
        if (PHON(9) && IN(pb + 9)) { PHASE_VARS; dev_resid_router(p, l, ntok_l, ldsp, G, tid_); SEAM(pb + 9); }
        if (PHON(10) && IN(pb + 10)) { PHASE_VARS; dev_slots(p, l, ntok_l, ldsp, gtid, nthr, tid_);
            {
                unsigned* cctr = p.ctl() + 12200 + 64 * (8 + 2 * l); volatile LAS unsigned* slot = (volatile LAS unsigned*)(ldsp + MISC_OFF + 64);
                for (int ch = q_next(cctr, slot, tid_); ch < CV_NCH_MOE + (l + 1 < DEPTH ? CV_NCH_SMALL : 0); ch = q_next(cctr, slot, tid_)) {
                    if (ch < CV_NCH_MOE) conv_chunk(p, l, true, ch, ldsp, wave, lane); else conv_chunk(p, l + 1, false, ch - CV_NCH_MOE, ldsp, wave, lane); } }
            SEAM(pb + 10); }
        if (PHON(12) && IN(pb + 12)) { PHASE_VARS; (void)tid_; (void)wave;
            pg8::Gemm g{p.HB(), p.WGU_T(l), D, (size_t)2 * DEXP * D, p.SLOT_TOK()}; pg8::MoeOrder S{__builtin_amdgcn_readfirstlane(p.NBLK()[0]), 2 * DEXP / 256, G, (int)blockIdx.x, p.BLOCK_E()};
            pg8::EpiSwiglu E{p.HH(), DEXP, p.exp_b_gu + (size_t)l * NEXP * 2 * DEXP, 2 * DEXP};
            pg8::gemm_phase<true>(ldsp, g, S, E, tid_);
            SEAM(pb + 12);
        }
        if (PHON(13) && IN(pb + 13)) { PHASE_VARS; (void)tid_; (void)wave;
            pg8::Gemm g{p.HH(), p.WDN_T(l), DEXP, (size_t)D * DEXP, nullptr}; pg8::MoeOrder S{__builtin_amdgcn_readfirstlane(p.NBLK()[0]), D / 256, G, (int)blockIdx.x, p.BLOCK_E()};
            pg8::EpiBf16Bias E{p.YB(), D, p.exp_b_dn + (size_t)l * NEXP * D, D};
            pg8::gemm_phase(ldsp, g, S, E, tid_);
            SEAM(pb + 13);
        }
        if (PHON(14) && IN(pb + 14)) { PHASE_VARS; dev_combine(p, l, ntok_l, G, wave, lane);
            if (l + 1 < DEPTH) SEAM(pb + 14); }
}

__global__ void __launch_bounds__(NTHR, 2) fwd_kernel(Args args) {
    extern __shared__ __attribute__((aligned(16))) unsigned char lds[];
    const P& pk = args.p;
    LAS unsigned char* ldsp = (LAS unsigned char*)lds;
    volatile LAS unsigned* MISC = (volatile LAS unsigned*)(ldsp + MISC_OFF);
    const int G = gridDim.x;
    const int wave_s = __builtin_amdgcn_readfirstlane((int)threadIdx.x >> 6);
    { const int t0 = TID_NOW(); if (t0 < 32) MISC[t0] = 0u; }
    __syncthreads();
    XcdBarrier bar = xcd_barrier_post(pk.ctl() + CW_BAR, MISC + 8, TID_NOW());
    const int lo = args.ph_lo, hi = args.ph_hi;
#ifdef PROBE_T
    if (blockIdx.x == 0 && TID_NOW() == 0) ((unsigned long long*)(pk.ctl() + 12100))[0] = __builtin_amdgcn_s_memrealtime();
#endif

    if (PHON(100) && IN(0)) { PHASE_VARS;
        for (int cg = blockIdx.x; cg < DEPTH * 96; cg += G) dev_mod(p, cg, ldsp, tid_);
        RUN_TASKS(D, p.HB()[(size_t)ZROW * D + task] = 0);
        dev_build_rope(p, gtid, nthr);
        for (int lw = 0; lw < DEPTH; ++lw) dev_build_wlr(p, lw, gtid, nthr);
        for (int ch = blockIdx.x; ch < CV_NCH_SMALL; ch += G) conv_chunk(p, 0, false, ch, ldsp, wave, lane);
        SEAM(0);
    }
    layer_body<0>(args, bar, ldsp, G, wave_s, lo, hi);
    layer_body<1>(args, bar, ldsp, G, wave_s, lo, hi);
#undef IN
#undef SEAM
}

#ifndef N_LAUNCH_MODE
#define N_LAUNCH_MODE 1
#endif
extern "C" void kernel_launch(void* const* d_in, const int* in_sizes, int n_in, void* d_out, int out_size, void* d_ws, size_t ws_size, hipStream_t stream) {
    static int grid = 0;
    if (grid == 0) {
        int dev = 0, cus = 0;
        if (hipGetDevice(&dev) != hipSuccess || hipDeviceGetAttribute(&cus, hipDeviceAttributeMultiprocessorCount, dev) != hipSuccess) { grid = -1; return; }
        if (hipFuncSetAttribute((const void*)fwd_kernel, hipFuncAttributeMaxDynamicSharedMemorySize, LDS_BYTES) != hipSuccess) { fprintf(stderr, "hipFuncSetAttribute failed\n"); grid = -1; return; }
        int per_cu = 0;
        if (hipOccupancyMaxActiveBlocksPerMultiprocessor(&per_cu, (const void*)fwd_kernel, NTHR, LDS_BYTES) != hipSuccess || per_cu < 1) fprintf(stderr, "occupancy query: %d\n", per_cu);
        (void)hipGetLastError();
        grid = cus;
    }
    if (grid < 0) return;
    unsigned char* ws = (unsigned char*)d_ws;
    (void)hipMemsetAsync(ws, 0, CTL_BYTES, stream);
    Args a{};
    P& p = a.p;
    const float* const* in = (const float* const*)d_in;
    p.x = in[0]; p.c = in[1]; p.ctx = in[2]; p.c_ctx = in[3]; p.ada_w = in[4]; p.ada_b = in[5]; p.pre_norm = in[6]; p.post_norm = in[7]; p.w_in = in[8]; p.w_out = in[9];
    p.rw_mu = in[10]; p.rw_w0 = in[11]; p.rw_w2 = in[12]; p.rw_a0 = in[13]; p.rw_a2 = in[14]; p.rw_g2 = in[15]; p.rw_k_k = in[16]; p.rw_k_a = in[17]; p.rw_r_k = in[18]; p.rw_ln_w = in[19]; p.rw_ln_b = in[20];
    p.gdn_conv = in[21]; p.gdn_a_log = in[22]; p.gdn_dt_bias = in[23]; p.gdn_norm = in[24]; p.attn_q_norm = in[25]; p.attn_k_norm = in[26];
    p.router_w = in[27]; p.router_b = in[28]; p.exp_w_gu = in[29]; p.exp_b_gu = in[30]; p.exp_w_dn = in[31]; p.exp_b_dn = in[32];
    p.out = (float*)d_out;
    p.ws = ws; p.tokf = nullptr;
#ifdef PROBE_GDN
    if (WS_TOTAL + (size_t)2 * NTOK * B_W * 4 > ws_size) { fprintf(stderr, "probe: ws too small\n"); return; }
#endif
    if (WS_TOTAL > ws_size) { fprintf(stderr, "kernel_launch: workspace too small: need %zu have %zu\n", (size_t)WS_TOTAL, ws_size); return; }
    const int nph = 1 + DEPTH * NPH;
#if N_LAUNCH_MODE == 1
    a.ph_lo = 0; a.ph_hi = nph;
    hipLaunchKernelGGL(fwd_kernel, dim3(grid), dim3(NTHR), LDS_BYTES, stream, a);
#else
    for (int ph = 0; ph < nph; ++ph) { a.ph_lo = ph; a.ph_hi = ph + 1; hipLaunchKernelGGL(fwd_kernel, dim3(grid), dim3(NTHR), LDS_BYTES, stream, a); }
#endif
}
#endif
```

```cpp
#ifndef HOST_TEST
#include <hip/hip_runtime.h>
#else
struct uint4 { unsigned x, y, z, w; };
#endif
#include <cstdio>
#include <cstdint>
#include <cmath>

#ifndef CFG_BATCH
#define CFG_BATCH 16
#define CFG_SEQ 2048
#define CFG_CTX 256
#define CFG_NEXP 32
#define CFG_DEXP 1024
#endif
constexpr int D = 1024, BATCH = CFG_BATCH, SEQ = CFG_SEQ, CTXL = CFG_CTX, DEPTH = 2, GRID_W = 64;
constexpr int NLAT = BATCH * SEQ, NCTX = BATCH * CTXL, NTOK = NLAT + NCTX;
constexpr int A_W = 256, A_H = 4, A_IN = 960;
constexpr int B_W = 512, B_H = 4, B_IN = 2064, B_OFF = 960;
constexpr int C_W = 256, C_IN = 512, C_OFF = 3024;
constexpr int INW = 3536, INP = 3584;
constexpr int NEXP = CFG_NEXP, TOPK = 4, DEXP = CFG_DEXP;
constexpr int NBLK_MAX = (NTOK * TOPK + 255) / 256 + NEXP, NSLOT = NBLK_MAX * 256;
constexpr int ZROW = NTOK;
constexpr int SLEN = CTXL + SEQ;

#ifdef HOST_TEST
#define DEVFN static inline
#define GLOBAL_ATOMIC_ADD(p, v) ((*(p)) += (v), (*(p)) - (v))
#else
#define DEVFN __device__ __forceinline__
#define GLOBAL_ATOMIC_ADD(p, v) atomicAdd((p), (v))
#endif
#ifdef HOST_TEST
#define UNIFORM(x) (x)
#define LOADFENCE()
#else
#define UNIFORM(x) __builtin_amdgcn_readfirstlane(x)
#define LOADFENCE() asm volatile("" ::: "memory")
#endif
typedef unsigned short bf16_t;
DEVFN bf16_t f2bf(float f) { unsigned u = __builtin_bit_cast(unsigned, f); return (bf16_t)((u + 0x7fffu + ((u >> 16) & 1u)) >> 16); }
DEVFN float bf2f(bf16_t b) { unsigned u = ((unsigned)b) << 16; return __builtin_bit_cast(float, u); }
DEVFN float sigmoidf_(float x) { return 1.0f / (1.0f + expf(-x)); }
DEVFN float siluf_(float x) { return x / (1.0f + expf(-x)); }
DEVFN float softplusf_(float x) { return x > 20.f ? x : log1pf(expf(x)); }

#ifdef HOST_TEST
#define WSACC inline
#else
#define WSACC __device__ __host__ __forceinline__
#endif
constexpr size_t CTL_BYTES = 64 * 1024;
constexpr size_t al256(size_t x) { return (x + 255) & ~(size_t)255; }
constexpr size_t WSO_ctl = 0;
constexpr size_t WSE_ctl = WSO_ctl + al256(CTL_BYTES);
constexpr size_t WSO_MOD = WSE_ctl;
constexpr size_t WSE_MOD = WSO_MOD + al256((size_t)DEPTH * (BATCH + 1) * 6 * D * 4);
constexpr size_t WSO_X = WSE_MOD;
constexpr size_t WSE_X = WSO_X + al256((size_t)(NTOK + 1) * D * 4);
constexpr size_t WSO_HB = WSE_X;
constexpr size_t WSE_HB = WSO_HB + al256((size_t)(NTOK + 1) * D * 2);
constexpr size_t WSO_WIN_T = WSE_HB;
constexpr size_t WSE_WIN_T = WSO_WIN_T + al256((size_t)INP * D * 2);
constexpr size_t WSO_WOUT_T = WSE_WIN_T;
constexpr size_t WSE_WOUT_T = WSO_WOUT_T + al256((size_t)D * D * 2);
constexpr size_t WSO_WR_T = WSE_WOUT_T;
constexpr size_t WSE_WR_T = WSO_WR_T + al256((size_t)64 * D * 2);
constexpr size_t WSO_WGU_T = WSE_WR_T;
constexpr size_t WSE_WGU_T = WSO_WGU_T + al256((size_t)NEXP * 2 * DEXP * D * 2);
constexpr size_t WSO_WDN_T = WSE_WGU_T;
constexpr size_t WSE_WDN_T = WSO_WDN_T + al256((size_t)NEXP * D * DEXP * 2);
constexpr size_t WSZ_WSET = WSE_WDN_T - WSO_WIN_T;
constexpr size_t WSO_TOPI = WSE_WDN_T + WSZ_WSET;
constexpr size_t WSE_TOPI = WSO_TOPI + al256((size_t)NTOK * 4 * 4);
constexpr size_t WSO_POS = WSE_TOPI;
constexpr size_t WSE_POS = WSO_POS + al256((size_t)NTOK * 4 * 4);
constexpr size_t WSO_TSLOT = WSE_POS;
constexpr size_t WSE_TSLOT = WSO_TSLOT + al256((size_t)NTOK * 4 * 4);
constexpr size_t WSO_TOPG = WSE_TSLOT;
constexpr size_t WSE_TOPG = WSO_TOPG + al256((size_t)NTOK * 4 * 4);
constexpr size_t WSO_SLOT_TOK = WSE_TOPG;
constexpr size_t WSE_SLOT_TOK = WSO_SLOT_TOK + al256((size_t)NSLOT * 4);
constexpr size_t WSO_BLOCK_E = WSE_SLOT_TOK;
constexpr size_t WSE_BLOCK_E = WSO_BLOCK_E + al256((size_t)NBLK_MAX * 4);
constexpr size_t WSO_NBLK = WSE_BLOCK_E;
constexpr size_t WSE_NBLK = WSO_NBLK + al256(256);
constexpr size_t WSO_U = WSE_NBLK;
constexpr size_t WSE_U = WSO_U + al256((size_t)NTOK * INP * 2);
constexpr size_t WSO_MO = WSE_U;
constexpr size_t WSE_MO = WSO_MO + al256((size_t)NTOK * D * 2);
constexpr size_t WSO_ROPE = WSE_MO;
constexpr size_t WSE_ROPE = WSO_ROPE + al256((size_t)SEQ * 128 * 4);
constexpr size_t WSO_WLR_T = WSE_ROPE;
constexpr size_t WSE_WLR_T = WSO_WLR_T + 2 * al256((size_t)1280 * 256 * 2);
constexpr size_t WSO_END_P = WSE_WLR_T;
constexpr size_t WSO_LR = WSO_END_P;
constexpr size_t WSE_LR = WSO_LR + al256((size_t)NTOK * 192 * 4);
#ifdef HOST_TEST
constexpr size_t WSO_RW_R = WSE_LR;
#else
constexpr size_t WSO_RW_R = WSO_LR;
#endif
constexpr size_t WSE_RW_R = WSO_RW_R + al256((size_t)NTOK * A_W * 2);
constexpr size_t WSO_RW_V = WSE_RW_R;
constexpr size_t WSE_RW_V = WSO_RW_V + al256((size_t)NTOK * A_W * 2);
constexpr size_t WSO_RW_KK = WSE_RW_V;
constexpr size_t WSE_RW_KK = WSO_RW_KK + al256((size_t)NTOK * A_W * 2);
constexpr size_t WSO_RW_D = WSE_RW_KK;
constexpr size_t WSE_RW_D = WSO_RW_D + al256((size_t)2 * NTOK * A_W * 4);
constexpr size_t WSO_RW_KD = WSE_RW_D;
constexpr size_t WSE_RW_KD = WSO_RW_KD + al256((size_t)2 * NTOK * A_W * 2);
constexpr size_t WSO_RW_KKA = WSE_RW_KD;
constexpr size_t WSE_RW_KKA = WSO_RW_KKA + al256((size_t)2 * NTOK * A_W * 2);
constexpr size_t WSO_RW_GATE = WSE_RW_KKA;
constexpr size_t WSE_RW_GATE = WSO_RW_GATE + al256((size_t)NTOK * A_W * 2);
constexpr size_t WSO_RW_BON = WSE_RW_GATE;
constexpr size_t WSE_RW_BON = WSO_RW_BON + al256((size_t)NTOK * A_H * 4);
constexpr size_t WSO_YA = WSE_RW_BON;
constexpr size_t WSE_YA = WSO_YA + al256((size_t)2 * NTOK * A_W * 2);
constexpr size_t WSO_GQ = WSE_YA;
constexpr size_t WSE_GQ = WSO_GQ + al256((size_t)NTOK * B_W * 2);
constexpr size_t WSO_GK = WSE_GQ;
constexpr size_t WSE_GK = WSO_GK + al256((size_t)NTOK * B_W * 2);
constexpr size_t WSO_GV = WSE_GK;
constexpr size_t WSE_GV = WSO_GV + al256((size_t)NTOK * B_W * 2);
constexpr size_t WSO_GG = WSE_GV;
constexpr size_t WSE_GG = WSO_GG + al256((size_t)NTOK * 8 * 4);
constexpr size_t WSO_GBETA = WSE_GG;
constexpr size_t WSE_GBETA = WSO_GBETA + al256((size_t)NTOK * 8 * 4);
constexpr size_t WSO_OB = WSE_GBETA;
constexpr size_t WSE_OB = WSO_OB + al256((size_t)2 * NTOK * B_W * 2);
constexpr size_t WSO_CQ = WSE_OB;
constexpr size_t WSE_CQ = WSO_CQ + al256((size_t)NTOK * 256 * 2);
constexpr size_t WSO_CK = WSE_CQ;
constexpr size_t WSE_CK = WSO_CK + al256((size_t)NTOK * 128 * 2);
constexpr size_t WSO_CV = WSE_CK;
constexpr size_t WSE_CV = WSO_CV + al256((size_t)NTOK * 128 * 2);
constexpr size_t WSO_RWC = WSE_CV;
constexpr size_t WSE_RWC = WSO_RWC + al256((size_t)2 * BATCH * A_H * (SLEN / 64) * 5 * 4096 * 2);
constexpr size_t WSO_LRT = WSE_RWC;
constexpr size_t WSE_LRT = WSO_LRT + al256((size_t)NTOK * 256 * 2);
constexpr size_t WSO_LRO = WSE_LRT;
constexpr size_t WSE_LRO = WSO_LRO + al256((size_t)NTOK * 1280 * 2);
constexpr size_t WSO_MIX = WSE_LRO;
constexpr size_t WSE_MIX = WSO_MIX + al256((size_t)NTOK * D * 2);
constexpr size_t WSO_XG = WSO_END_P;
constexpr size_t WSE_XG = WSO_XG + al256((size_t)NSLOT * D * 2);
constexpr size_t WSO_HH = WSE_XG;
constexpr size_t WSE_HH = WSO_HH + al256((size_t)NSLOT * DEXP * 2);
constexpr size_t WSO_YB = WSE_HH;
constexpr size_t WSE_YB = WSO_YB + al256((size_t)NSLOT * D * 2);
constexpr size_t WS_TOTAL = (WSE_MIX > WSE_YB ? WSE_MIX : WSE_YB);
struct P {
    const float *x, *c, *ctx, *c_ctx, *ada_w, *ada_b, *pre_norm, *post_norm, *w_in, *w_out;
    const float *rw_mu, *rw_w0, *rw_w2, *rw_a0, *rw_a2, *rw_g2, *rw_k_k, *rw_k_a, *rw_r_k, *rw_ln_w, *rw_ln_b;
    const float *gdn_conv, *gdn_a_log, *gdn_dt_bias, *gdn_norm, *attn_q_norm, *attn_k_norm;
    const float *router_w, *router_b, *exp_w_gu, *exp_b_gu, *exp_w_dn, *exp_b_dn;
    float* out;
    unsigned char* ws;
    WSACC unsigned* ctl() const { return (unsigned*)(ws + WSO_ctl); }
    WSACC float* MOD() const { return (float*)(ws + WSO_MOD); }
    WSACC float* X() const { return (float*)(ws + WSO_X); }
    WSACC bf16_t* HB() const { return (bf16_t*)(ws + WSO_HB); }
    WSACC bf16_t* WIN_T(int l) const { return (bf16_t*)(ws + WSO_WIN_T + (size_t)l * WSZ_WSET); }
    WSACC bf16_t* WOUT_T(int l) const { return (bf16_t*)(ws + WSO_WOUT_T + (size_t)l * WSZ_WSET); }
    WSACC bf16_t* WR_T(int l) const { return (bf16_t*)(ws + WSO_WR_T + (size_t)l * WSZ_WSET); }
    WSACC bf16_t* WGU_T(int l) const { return (bf16_t*)(ws + WSO_WGU_T + (size_t)l * WSZ_WSET); }
    WSACC bf16_t* WDN_T(int l) const { return (bf16_t*)(ws + WSO_WDN_T + (size_t)l * WSZ_WSET); }
    WSACC int* TOPI() const { return (int*)(ws + WSO_TOPI); }
    WSACC int* POS() const { return (int*)(ws + WSO_POS); }
    WSACC int* TSLOT() const { return (int*)(ws + WSO_TSLOT); }
    WSACC float* TOPG() const { return (float*)(ws + WSO_TOPG); }
    WSACC int* SLOT_TOK() const { return (int*)(ws + WSO_SLOT_TOK); }
    WSACC int* BLOCK_E() const { return (int*)(ws + WSO_BLOCK_E); }
    WSACC int* NBLK() const { return (int*)(ws + WSO_NBLK); }
    WSACC bf16_t* U() const { return (bf16_t*)(ws + WSO_U); }
    WSACC bf16_t* MO() const { return (bf16_t*)(ws + WSO_MO); }
    WSACC float* LR() const { return (float*)(ws + WSO_LR); }
    WSACC bf16_t* RW_R() const { return (bf16_t*)(ws + WSO_RW_R); }
    WSACC bf16_t* RW_V() const { return (bf16_t*)(ws + WSO_RW_V); }
    WSACC bf16_t* RW_KK() const { return (bf16_t*)(ws + WSO_RW_KK); }
    WSACC float* RW_D() const { return (float*)(ws + WSO_RW_D); }
    WSACC bf16_t* RW_KD() const { return (bf16_t*)(ws + WSO_RW_KD); }
    WSACC bf16_t* RW_KKA() const { return (bf16_t*)(ws + WSO_RW_KKA); }
    WSACC bf16_t* RW_GATE() const { return (bf16_t*)(ws + WSO_RW_GATE); }
    WSACC float* RW_BON() const { return (float*)(ws + WSO_RW_BON); }
    WSACC bf16_t* YA() const { return (bf16_t*)(ws + WSO_YA); }
    WSACC bf16_t* GQ() const { return (bf16_t*)(ws + WSO_GQ); }
    WSACC bf16_t* GK() const { return (bf16_t*)(ws + WSO_GK); }
    WSACC bf16_t* GV() const { return (bf16_t*)(ws + WSO_GV); }
    WSACC float* GG() const { return (float*)(ws + WSO_GG); }
    WSACC float* GBETA() const { return (float*)(ws + WSO_GBETA); }
    WSACC bf16_t* OB() const { return (bf16_t*)(ws + WSO_OB); }
    WSACC bf16_t* CQ() const { return (bf16_t*)(ws + WSO_CQ); }
    WSACC bf16_t* CK() const { return (bf16_t*)(ws + WSO_CK); }
    WSACC bf16_t* CV() const { return (bf16_t*)(ws + WSO_CV); }
    WSACC bf16_t* MIX() const { return (bf16_t*)(ws + WSO_MIX); }
    WSACC bf16_t* RWC() const { return (bf16_t*)(ws + WSO_RWC); }
    WSACC float* ROPE() const { return (float*)(ws + WSO_ROPE); }
    WSACC bf16_t* LRT() const { return (bf16_t*)(ws + WSO_LRT); }
    WSACC bf16_t* LRO() const { return (bf16_t*)(ws + WSO_LRO); }
    WSACC bf16_t* WLR_T(int l) const { return (bf16_t*)(ws + WSO_WLR_T + (size_t)l * al256((size_t)1280 * 256 * 2)); }
    WSACC bf16_t* XG() const { return (bf16_t*)(ws + WSO_XG); }
    WSACC bf16_t* HH() const { return (bf16_t*)(ws + WSO_HH); }
    WSACC bf16_t* YB() const { return (bf16_t*)(ws + WSO_YB); }
    WSACC int* cnt() const { return (int*)(ws + WSO_ctl) + 8192; }
    WSACC float* TOKF() const { return tokf; }
    float* tokf;
};

DEVFN void row_info(int m, int& b, int& t, int& len, int& base) {
    if (m < NLAT) { b = m / SEQ; t = m % SEQ; len = SEQ; base = b * SEQ; }
    else { const int mc = m - NLAT; b = mc / CTXL; t = mc % CTXL; len = CTXL; base = NLAT + b * CTXL; }
}
DEVFN float ldU(const P& p, size_t idx) { return bf2f(p.U()[idx]); }
DEVFN int mod_row(int m) { return m < NLAT ? m / SEQ : BATCH; }
DEVFN int scan_row(int dir, int b, int s) {
    if (s < CTXL) { const int ts = dir ? (CTXL - 1 - s) : s; return NLAT + b * CTXL + ts; }
    const int s2 = s - CTXL; const int ts = dir ? (SEQ - 1 - s2) : s2; return b * SEQ + ts;
}

DEVFN void task_mod(const P& p, long task) {
    const int j = (int)(task % (6 * D)); const int r = (int)((task / (6 * D)) % (BATCH + 1)); const int l = (int)(task / ((long)(6 * D) * (BATCH + 1)));
    const float* cv = (r < BATCH) ? p.c + (size_t)r * D : p.c_ctx;
    const float* w = p.ada_w + (size_t)l * D * 6 * D + j;
    float acc = 0.f;
    for (int k = 0; k < D; ++k) acc += siluf_(cv[k]) * w[(size_t)k * 6 * D];
    p.MOD()[((size_t)l * (BATCH + 1) + r) * 6 * D + j] = acc + p.ada_b[(size_t)l * 6 * D + j];
}
DEVFN void task_copyx(const P& p, long task) {
    const long n_lat = (long)NLAT * D;
    p.X()[task] = task < n_lat ? p.x[task] : p.ctx[task - n_lat];
}
DEVFN void task_norm1(const P& p, int l, long task) {
    const int m = (int)task; const float* xr = p.X() + (size_t)m * D;
    float ss = 0.f; for (int k = 0; k < D; ++k) ss += xr[k] * xr[k];
    const float rstd = 1.0f / sqrtf(ss / D + 1e-6f);
    const float* md = p.MOD() + ((size_t)l * (BATCH + 1) + mod_row(m)) * 6 * D; const float* pn = p.pre_norm + (size_t)(l * 2 + 0) * D;
    bf16_t* o = p.HB() + (size_t)m * D;
    for (int k = 0; k < D; ++k) o[k] = f2bf(xr[k] * rstd * pn[k] * (1.0f + md[D + k]) + md[k]);
}
DEVFN float lerpA(const P& p, int l, int m, int col) {
    int b, t, len, base; row_info(m, b, t, len, base);
    const float u = ldU(p, (size_t)m * INP + col);
    const float up = t > 0 ? ldU(p, (size_t)(m - 1) * INP + col) : 0.f, un = t + 1 < len ? ldU(p, (size_t)(m + 1) * INP + col) : 0.f;
    return u + p.rw_mu[l * A_IN + col] * (0.5f * (up + un) - u);
}
DEVFN void task_prepA0(const P& p, int l, long task) {
    const int m = (int)(task / 192), j = (int)(task % 192);
    const float v = lerpA(p, l, m, 768 + j);
    p.LR()[(size_t)m * 192 + j] = j < 64 ? tanhf(v) : (j < 128 ? v : sigmoidf_(v));
}
DEVFN void task_prepA1(const P& p, int l, long task) {
    const int m = (int)(task / A_H), h = (int)(task % A_H);
    const float* lr = p.LR() + (size_t)m * 192;
    float ss = 0.f;
    for (int c = 0; c < 64; ++c) { const int ch = h * 64 + c; const float kx = lerpA(p, l, m, 256 + ch) * p.rw_k_k[l * A_W + ch]; ss += kx * kx; }
    const float rn = 1.0f / sqrtf(ss + 1e-6f);
    float bon = 0.f;
    for (int c = 0; c < 64; ++c) {
        const int ch = h * 64 + c;
        const float r = lerpA(p, l, m, ch), k = lerpA(p, l, m, 256 + ch), v = lerpA(p, l, m, 512 + ch);
        const float kk = k * p.rw_k_k[l * A_W + ch] * rn;
        float kdsum = 0.f;
        for (int dir = 0; dir < 2; ++dir) {
            float w = p.rw_w0[(l * 2 + dir) * A_W + ch], a = p.rw_a0[(l * 2 + dir) * A_W + ch];
            const float* w2 = p.rw_w2 + ((size_t)(l * 2 + dir) * 32) * A_W + ch; const float* a2 = p.rw_a2 + ((size_t)(l * 2 + dir) * 32) * A_W + ch;
            for (int r2 = 0; r2 < 32; ++r2) { w += lr[dir * 32 + r2] * w2[(size_t)r2 * A_W]; a += lr[64 + dir * 32 + r2] * a2[(size_t)r2 * A_W]; }
            const float decay = -expf(-softplusf_(-w) - 0.5f);
            const float iclr = sigmoidf_(a);
            const float kd = k * (1.0f + (iclr - 1.0f) * p.rw_k_a[l * A_W + ch]);
            const size_t o = ((size_t)dir * NTOK + m) * A_W + ch;
            p.RW_D()[o] = decay; p.RW_KD()[o] = f2bf(kd); p.RW_KKA()[o] = f2bf(kk * iclr); kdsum += kd;
        }
        float g = 0.f; const float* g2 = p.rw_g2 + (size_t)l * 64 * A_W + ch;
        for (int r2 = 0; r2 < 64; ++r2) g += lr[128 + r2] * g2[(size_t)r2 * A_W];
        const size_t o = (size_t)m * A_W + ch;
        p.RW_R()[o] = f2bf(r); p.RW_V()[o] = f2bf(v); p.RW_KK()[o] = f2bf(kk); p.RW_GATE()[o] = f2bf(g);
        bon += r * kdsum * p.rw_r_k[l * A_W + ch];
    }
    p.RW_BON()[(size_t)m * A_H + h] = bon;
}
DEVFN void task_prepB(const P& p, int l, long task) {
    const int which = (int)(task % 4), h = (int)((task / 4) % B_H), m = (int)(task / (4 * B_H));
    int b, t, len, base; row_info(m, b, t, len, base);
    if (which == 3) {
        for (int dir = 0; dir < 2; ++dir) {
            const float a = ldU(p, (size_t)m * INP + B_OFF + 2048 + dir * 4 + h), bb = ldU(p, (size_t)m * INP + B_OFF + 2056 + dir * 4 + h);
            const float g = -expf(p.gdn_a_log[(l * 2 + dir) * B_H + h]) * softplusf_(a + p.gdn_dt_bias[(l * 2 + dir) * B_H + h]);
            p.GG()[(size_t)m * 8 + dir * 4 + h] = g; p.GBETA()[(size_t)m * 8 + dir * 4 + h] = sigmoidf_(bb);
        }
        return;
    }
    bf16_t* dst = (which == 0 ? p.GQ() : which == 1 ? p.GK() : p.GV()) + (size_t)m * B_W + h * 128;
    float ss = 0.f;
    for (int c = 0; c < 128; ++c) {
        const int cc = which * B_W + h * 128 + c; const int col = B_OFF + cc;
        float acc = 0.f;
        for (int j = 0; j < 5; ++j) { const int tt = t + j - 2; if (tt >= 0 && tt < len) acc += ldU(p, (size_t)(base + tt) * INP + col) * p.gdn_conv[((size_t)l * 5 + j) * (3 * B_W) + cc]; }
        const float s = siluf_(acc); if (which == 2) dst[c] = f2bf(s); ss += s * s;
    }
    if (which < 2) { const float rn = (1.0f / sqrtf(ss + 1e-6f)) * (which == 0 ? 0.08838834764831845f : 1.0f);
        for (int c = 0; c < 128; ++c) { const int cc = which * B_W + h * 128 + c; const int col = B_OFF + cc; float acc = 0.f;
            for (int j = 0; j < 5; ++j) { const int tt = t + j - 2; if (tt >= 0 && tt < len) acc += ldU(p, (size_t)(base + tt) * INP + col) * p.gdn_conv[((size_t)l * 5 + j) * (3 * B_W) + cc]; }
            dst[c] = f2bf(siluf_(acc) * rn); } }
}
DEVFN void task_prepC(const P& p, int l, long task) {
    const int m = (int)(task / 8), hs = (int)(task % 8);
    const size_t sb = (size_t)m * INP + C_OFF + hs * 64;
    if (hs >= 6) { int b_, t_, len_, base_; row_info(m, b_, t_, len_, base_); const int key = m < NLAT ? t_ : SEQ + t_;
        for (int d = 0; d < 64; ++d) p.CV()[((size_t)(b_ * 2 + (hs - 6)) * 64 + d) * SLEN + key] = p.U()[sb + d]; return; }
    float ss = 0.f; for (int d = 0; d < 64; ++d) { const float x = ldU(p, sb + d); ss += x * x; }
    const float qs = hs < 4 ? 0.18033688011112042f : 1.0f;
    const float rstd = (1.0f / sqrtf(ss / 64.f + 1e-6f)) * qs;
    const float* nw = (hs < 4 ? p.attn_q_norm : p.attn_k_norm) + l * 64;
    bf16_t* dst = hs < 4 ? p.CQ() + (size_t)m * 256 + hs * 64 : p.CK() + (size_t)m * 128 + (hs - 4) * 64;
    if (m >= NLAT) { for (int d = 0; d < 64; ++d) dst[d] = f2bf(ldU(p, sb + d) * rstd * nw[d]); return; }
    const int t = m % SEQ; const float pr = (float)(t / GRID_W), pc = (float)(t % GRID_W);
    for (int d = 0; d < 16; ++d) {
        const float fr = powf(10000.0f, -(float)d / 16.0f);
        const float ar = pr * fr, ac = pc * fr; const float cr = cosf(ar), sr = sinf(ar), cc = cosf(ac), sc = sinf(ac);
        const float x1 = ldU(p, sb + d) * rstd * nw[d], x2 = ldU(p, sb + 16 + d) * rstd * nw[16 + d], x3 = ldU(p, sb + 32 + d) * rstd * nw[32 + d], x4 = ldU(p, sb + 48 + d) * rstd * nw[48 + d];
        dst[d] = f2bf(x1 * cr - x2 * sr); dst[16 + d] = f2bf(x2 * cr + x1 * sr); dst[32 + d] = f2bf(x3 * cc - x4 * sc); dst[48 + d] = f2bf(x4 * cc + x3 * sc);
    }
}
DEVFN void task_scanA(const P& p, long task) {
    const int v = (int)(task % 64), chain = UNIFORM((int)(task / 64)); const int h = chain % A_H, b = (chain / A_H) % BATCH, dir = chain / (A_H * BATCH);
    float s[64];
#pragma unroll
    for (int k = 0; k < 64; ++k) s[k] = 0.f;
    for (int st = 0; st < SLEN; ++st) {
        const int m = scan_row(dir, b, st);
        const bf16_t* kk = p.RW_KK() + (size_t)m * A_W + h * 64; const bf16_t* rr = p.RW_R() + (size_t)m * A_W + h * 64;
        const size_t od = ((size_t)dir * NTOK + m) * A_W + h * 64;
        const float* dd = p.RW_D() + od; const bf16_t* kd = p.RW_KD() + od; const bf16_t* ka = p.RW_KKA() + od;
        const float vv = bf2f(p.RW_V()[(size_t)m * A_W + h * 64 + v]);
        float sa = 0.f;
#pragma unroll
        for (int k = 0; k < 64; ++k) { sa += s[k] * bf2f(kk[k]); if ((k & 15) == 15) LOADFENCE(); }
        float y = 0.f;
#pragma unroll
        for (int k = 0; k < 64; ++k) { s[k] = s[k] * expf(dd[k]) - sa * bf2f(ka[k]) + vv * bf2f(kd[k]); y += s[k] * bf2f(rr[k]); if ((k & 7) == 7) LOADFENCE(); }
        p.YA()[((size_t)dir * NTOK + m) * A_W + h * 64 + v] = f2bf(y);
    }
}
DEVFN void task_scanB(const P& p, long task) {
    const int j = (int)(task % 128), chain = UNIFORM((int)(task / 128)); const int h = chain % B_H, b = (chain / B_H) % BATCH, dir = chain / (B_H * BATCH);
    float s[128];
#pragma unroll
    for (int k = 0; k < 128; ++k) s[k] = 0.f;
    for (int st = 0; st < SLEN; ++st) {
        const int m = scan_row(dir, b, st);
        const bf16_t* kv = p.GK() + (size_t)m * B_W + h * 128; const bf16_t* qv = p.GQ() + (size_t)m * B_W + h * 128;
        const float vj = bf2f(p.GV()[(size_t)m * B_W + h * 128 + j]);
        const float eg = expf(p.GG()[(size_t)m * 8 + dir * 4 + h]), beta = p.GBETA()[(size_t)m * 8 + dir * 4 + h];
        float pk = 0.f;
#pragma unroll
        for (int k = 0; k < 128; ++k) { pk += s[k] * bf2f(kv[k]); if ((k & 15) == 15) LOADFENCE(); }
        const float cf = beta * (vj - eg * pk);
        float o = 0.f;
#pragma unroll
        for (int k = 0; k < 128; ++k) { s[k] = eg * s[k] + cf * bf2f(kv[k]); o += s[k] * bf2f(qv[k]); if ((k & 7) == 7) LOADFENCE(); }
        p.OB()[((size_t)dir * NTOK + m) * B_W + h * 128 + j] = f2bf(o);
    }
}
DEVFN void task_attn(const P& p, int need_ctx, long task) {
    const int t = (int)(task % SLEN), hq = UNIFORM((int)((task / SLEN) % 4)), b = UNIFORM((int)(task / ((long)SLEN * 4)));
    const bool is_lat = UNIFORM((int)(t < SEQ)) != 0; if (!is_lat && !need_ctx) return;
    const int m = is_lat ? b * SEQ + t : NLAT + b * CTXL + (t - SEQ);
    const int kvh = hq >> 1;
    float q[64], o[64];
#pragma unroll
    for (int d = 0; d < 64; ++d) { q[d] = bf2f(p.CQ()[(size_t)m * 256 + hq * 64 + d]); o[d] = 0.f; }
    float mx = -1e30f, lsum = 0.f;
    const int nk = is_lat ? SLEN : CTXL;
    for (int kI = 0; kI < nk; ++kI) {
        int km; if (is_lat) km = kI < SEQ ? b * SEQ + kI : NLAT + b * CTXL + (kI - SEQ); else km = NLAT + b * CTXL + kI;
        const bf16_t* kr = p.CK() + (size_t)km * 128 + kvh * 64; const bf16_t* vr = p.CV() + ((size_t)(b * 2 + kvh) * 64) * SLEN + (is_lat ? kI : SEQ + kI);
        float sc = 0.f;
#pragma unroll
        for (int d = 0; d < 64; ++d) { sc += q[d] * bf2f(kr[d]); if ((d & 15) == 15) LOADFENCE(); }
        const float mn = sc > mx ? sc : mx; const float f = exp2f(mx - mn), pe = exp2f(sc - mn);
        lsum = lsum * f + pe; mx = mn;
#pragma unroll
        for (int d = 0; d < 64; ++d) { o[d] = o[d] * f + pe * bf2f(vr[(size_t)d * SLEN]); if ((d & 15) == 15) LOADFENCE(); }
    }
    const float inv = 1.0f / lsum;
#pragma unroll
    for (int d = 0; d < 64; ++d) p.MIX()[(size_t)m * D + 768 + hq * 64 + d] = f2bf(o[d] * inv);
}
DEVFN void task_post(const P& p, int l, long task) {
    const int m = (int)(task / 8), g = (int)(task % 8);
    if (g < 4) {
        const int h = g; const bf16_t* y0 = p.YA() + (size_t)m * A_W + h * 64; const bf16_t* y1 = p.YA() + ((size_t)NTOK + m) * A_W + h * 64;
        float mean = 0.f; for (int c = 0; c < 64; ++c) mean += bf2f(y0[c]) + bf2f(y1[c]); mean *= (1.0f / 64.f);
        float var = 0.f; for (int c = 0; c < 64; ++c) { const float d0 = bf2f(y0[c]) + bf2f(y1[c]) - mean; var += d0 * d0; } var *= (1.0f / 64.f);
        const float rs = 1.0f / sqrtf(var + 64e-5f); const float bon = p.RW_BON()[(size_t)m * A_H + h];
        for (int c = 0; c < 64; ++c) { const int ch = h * 64 + c;
            const float yn = (bf2f(y0[c]) + bf2f(y1[c]) - mean) * rs * p.rw_ln_w[l * A_W + ch] + p.rw_ln_b[l * A_W + ch];
            p.MIX()[(size_t)m * D + ch] = f2bf((yn + bon * bf2f(p.RW_V()[(size_t)m * A_W + ch])) * bf2f(p.RW_GATE()[(size_t)m * A_W + ch])); }
    } else {
        const int h = g - 4; const bf16_t* o0 = p.OB() + (size_t)m * B_W + h * 128; const bf16_t* o1 = p.OB() + ((size_t)NTOK + m) * B_W + h * 128;
        float ss = 0.f; for (int c = 0; c < 128; ++c) { const float o = bf2f(o0[c]) + bf2f(o1[c]); ss += o * o; }
        const float rs = 1.0f / sqrtf(ss / 128.f + 1e-6f);
        for (int c = 0; c < 128; ++c) { const float z = ldU(p, (size_t)m * INP + B_OFF + 1536 + h * 128 + c);
            p.MIX()[(size_t)m * D + 256 + h * 128 + c] = f2bf((bf2f(o0[c]) + bf2f(o1[c])) * rs * p.gdn_norm[l * 128 + c] * siluf_(z)); }
    }
}
DEVFN void task_resid1(const P& p, int l, long task) {
    const int m = (int)task; const bf16_t* mo = p.MO() + (size_t)m * D; float* xr = p.X() + (size_t)m * D;
    const float* md = p.MOD() + ((size_t)l * (BATCH + 1) + mod_row(m)) * 6 * D;
    float ss = 0.f; for (int k = 0; k < D; ++k) ss += bf2f(mo[k]) * bf2f(mo[k]);
    const float rstd = 1.0f / sqrtf(ss / D + 1e-6f); const float* pn = p.post_norm + (size_t)(l * 2 + 0) * D;
    float s2 = 0.f;
    for (int k = 0; k < D; ++k) { const float xv = xr[k] + md[2 * D + k] * (bf2f(mo[k]) * rstd) * pn[k]; xr[k] = xv; s2 += xv * xv; }
    const float r2 = 1.0f / sqrtf(s2 / D + 1e-6f); const float* pn2 = p.pre_norm + (size_t)(l * 2 + 1) * D;
    for (int k = 0; k < D; ++k) { const float tv = xr[k] * r2 * pn2[k] * (1.0f + md[4 * D + k]) + md[3 * D + k]; p.TOKF()[(size_t)m * D + k] = tv; p.HB()[(size_t)m * D + k] = f2bf(tv); }
}
DEVFN void task_router(const P& p, int l, long task) {
    const int m = (int)task; const float* tk = p.TOKF() + (size_t)m * D; const float* rw = p.router_w + (size_t)l * D * NEXP;
    float lg[NEXP];
#pragma unroll
    for (int e = 0; e < NEXP; ++e) lg[e] = p.router_b[l * NEXP + e];
    for (int k = 0; k < D; ++k) { const float tv = tk[k];
#pragma unroll
        for (int e = 0; e < NEXP; ++e) lg[e] += tv * rw[(size_t)k * NEXP + e]; }
    int idx[TOPK]; float val[TOPK];
#pragma unroll
    for (int j = 0; j < TOPK; ++j) { float best = -3.0e38f; int bi = 0;
#pragma unroll
        for (int e = 0; e < NEXP; ++e) { if (lg[e] > best) { best = lg[e]; bi = e; } }
        idx[j] = bi; val[j] = best;
#pragma unroll
        for (int e = 0; e < NEXP; ++e) if (e == bi) lg[e] = -3.0e38f; }
    float sum = 0.f, ex[TOPK];
#pragma unroll
    for (int j = 0; j < TOPK; ++j) { ex[j] = expf(val[j] - val[0]); sum += ex[j]; }
#pragma unroll
    for (int j = 0; j < TOPK; ++j) { p.TOPI()[(size_t)m * TOPK + j] = idx[j]; p.TOPG()[(size_t)m * TOPK + j] = ex[j] / sum; p.POS()[(size_t)m * TOPK + j] = GLOBAL_ATOMIC_ADD(&p.cnt()[l * NEXP + idx[j]], 1); }
}
DEVFN int moe_pstart(const P& p, int l, int e, int* nblk) {
    int acc = 0, ps = 0;
    for (int i = 0; i < NEXP; ++i) { if (i == e) ps = acc; acc += (p.cnt()[l * NEXP + i] + 255) / 256 * 256; }
    if (nblk) *nblk = acc / 256; return ps;
}
DEVFN void task_slots(const P& p, int l, long task) {
    const int e = p.TOPI()[task]; const int slot = moe_pstart(p, l, e, nullptr) + p.POS()[task];
    p.TSLOT()[task] = slot; p.SLOT_TOK()[slot] = (int)(task / TOPK);
}
DEVFN void task_blocke(const P& p, int l, long task) {
    int acc = 0, e_of = NEXP - 1, nb = 0;
    for (int i = 0; i < NEXP; ++i) { const int nbk = (p.cnt()[l * NEXP + i] + 255) / 256; if ((int)task >= acc && (int)task < acc + nbk) e_of = i; acc += nbk; }
    nb = acc; p.BLOCK_E()[task] = e_of; if (task == 0) p.NBLK()[0] = nb;
}
DEVFN void task_gather(const P& p, long task) {
    const long slot = task / 128; const int ch = (int)(task % 128); const int tok = p.SLOT_TOK()[slot];
    const uint4* s = (const uint4*)(p.HB() + (size_t)tok * D) + ch; ((uint4*)(p.XG() + (size_t)slot * D))[ch] = *s;
}
DEVFN void task_combine(const P& p, int l, long task) {
    const int m = (int)task; float* xr = p.X() + (size_t)m * D; const float* md = p.MOD() + ((size_t)l * (BATCH + 1) + mod_row(m)) * 6 * D;
    const bf16_t* y0 = p.YB() + (size_t)p.TSLOT()[(size_t)m * 4 + 0] * D; const bf16_t* y1 = p.YB() + (size_t)p.TSLOT()[(size_t)m * 4 + 1] * D;
    const bf16_t* y2 = p.YB() + (size_t)p.TSLOT()[(size_t)m * 4 + 2] * D; const bf16_t* y3 = p.YB() + (size_t)p.TSLOT()[(size_t)m * 4 + 3] * D;
    const float g0 = p.TOPG()[(size_t)m * 4 + 0], g1 = p.TOPG()[(size_t)m * 4 + 1], g2 = p.TOPG()[(size_t)m * 4 + 2], g3 = p.TOPG()[(size_t)m * 4 + 3];
    float ss = 0.f;
    for (int k = 0; k < D; ++k) { const float f = g0 * bf2f(y0[k]) + g1 * bf2f(y1[k]) + g2 * bf2f(y2[k]) + g3 * bf2f(y3[k]); ss += f * f; }
    const float rstd = 1.0f / sqrtf(ss / D + 1e-6f); const float* pn = p.post_norm + (size_t)(l * 2 + 1) * D;
    const bool last = (l == DEPTH - 1);
    for (int k = 0; k < D; ++k) { const float f = g0 * bf2f(y0[k]) + g1 * bf2f(y1[k]) + g2 * bf2f(y2[k]) + g3 * bf2f(y3[k]);
        const float xv = xr[k] + md[5 * D + k] * (f * rstd) * pn[k]; xr[k] = xv; if (last) p.out[(size_t)m * D + k] = xv; }
}

#ifndef HOST_TEST
namespace pg8 {
#define PG8_LAS __attribute__((address_space(3)))
typedef short bf16x8 __attribute__((ext_vector_type(8)));
typedef float f32x4 __attribute__((ext_vector_type(4)));
typedef unsigned u32x4 __attribute__((ext_vector_type(4)));
typedef unsigned u32x2 __attribute__((ext_vector_type(2)));
constexpr int BM = 256, BK = 64, HALF = 128, HTB = HALF * BK * 2, STAGE_BYTES = 8 * HTB, NXCD = 8, WGM = 8;
__host__ __device__ __forceinline__ int lds_byte(int r, int c) { const int st = (r >> 4) * 2 + (c >> 5), rr = r & 15, cc = c & 31, ob = rr * 64 + cc * 2; return st * 1024 + (ob ^ (((ob >> 9) & 1) << 5)); }
__host__ __device__ __forceinline__ void stage_rc(int b, int& R, int& C) { const int st = b / 1024, sb = b % 1024, swz = sb ^ (((sb >> 9) & 1) << 5); R = (st >> 1) * 16 + swz / 64; C = (st & 1) * 32 + (swz % 64) / 2; }
__host__ __device__ __forceinline__ int perm32(int rho) { const int n = rho >> 4, i = rho & 15; return 8 * (i >> 2) + 4 * n + (i & 3); }
struct Unit { int pm, pn, e; };
struct Gemm { const bf16_t* A; const bf16_t* Bt; int K; size_t estride; const int* rowidx; };
struct StaticOrder {
    int nM, nN, nwg, G, c;
    __device__ void init(int M, int N, int G_, int c_) { nM = M / BM; nN = N / BM; nwg = nM * nN; G = G_; c = c_; }
    __device__ bool next(int i, Unit& u) const {
        const long L = (long)i * G + c; if (L >= nwg) return false;
        int wgid = (int)L; { const int q = nwg / NXCD, r = nwg % NXCD, xcd = wgid % NXCD, off = wgid / NXCD; wgid = (xcd < r ? xcd * (q + 1) : r * (q + 1) + (xcd - r) * q) + off; }
        const int nig = WGM * nN, gid = wgid / nig, fm = gid * WGM, gsz = (nM - fm) < WGM ? (nM - fm) : WGM;
        u.pm = fm + ((wgid % nig) % gsz); u.pn = (wgid % nig) / gsz; u.e = 0; return true;
    }
};
struct MoeOrder {
    int nblk, nN, G, c; const int* block_e;
    __device__ bool next(int i, Unit& u) const {
        if (G % 8 != 0 || (G / 8) % nN != 0) { const long L = (long)i * G + c; if (L >= (long)nblk * nN) return false; u.pm = (int)(L / nN); u.pn = (int)(L % nN); }
        else { const int x = c & 7, r = c >> 3, per = (G / 8) / nN; const int mb = (i * per + r / nN) * 8 + x; if (mb >= nblk) return false; u.pm = mb; u.pn = r % nN; }
        u.e = __builtin_amdgcn_readfirstlane(block_e[u.pm]); return true;
    }
};
typedef float f32x2c_t __attribute__((ext_vector_type(2))); typedef __bf16 bf16x2c_t __attribute__((ext_vector_type(2)));
__device__ __forceinline__ unsigned cvt_pk_bf16(float lo, float hi) { const f32x2c_t v = {lo, hi}; const bf16x2c_t b = __builtin_convertvector(v, bf16x2c_t); return __builtin_bit_cast(unsigned, b); }
struct EpiF32 {
    static constexpr bool PERM = false;
    float* C; int ldc;
    __device__ __forceinline__ void operator()(const f32x4 (&acc)[2][2][4][2], const Unit& u, int wr, int wc, int fr, int fq) const {
        const int row0 = u.pm * BM + wr * 64 + fr, col0 = u.pn * BM + wc * 32 + 4 * fq;
#pragma unroll
        for (int ai = 0; ai < 2; ++ai)
#pragma unroll
            for (int m = 0; m < 4; ++m) { float* rowp = C + (size_t)(row0 + ai * HALF + m * 16) * ldc + col0;
#pragma unroll
                for (int bj = 0; bj < 2; ++bj)
#pragma unroll
                    for (int n = 0; n < 2; ++n) *(f32x4*)(rowp + bj * HALF + n * 16) = acc[ai][bj][m][n]; }
    }
};
struct EpiBf16Bias {
    static constexpr bool PERM = true;
    bf16_t* O; int ldc; const float* bias; int bias_estride;
    __device__ __forceinline__ void operator()(const f32x4 (&acc)[2][2][4][2], const Unit& u, int wr, int wc, int fr, int fq) const {
        const int row0 = u.pm * BM + wr * 64 + fr, col0 = u.pn * BM + wc * 32 + 8 * fq; const float* bp = bias + (size_t)u.e * bias_estride + col0;
        f32x4 bv[2][2];
#pragma unroll
        for (int bj = 0; bj < 2; ++bj)
#pragma unroll
            for (int n = 0; n < 2; ++n) bv[bj][n] = bias ? *(const f32x4*)(bp + bj * HALF + 4 * n) : (f32x4){0.f, 0.f, 0.f, 0.f};
#pragma unroll
        for (int ai = 0; ai < 2; ++ai)
#pragma unroll
            for (int m = 0; m < 4; ++m) { bf16_t* rowp = O + (size_t)(row0 + ai * HALF + m * 16) * ldc + col0;
#pragma unroll
                for (int bj = 0; bj < 2; ++bj) { const f32x4 v0 = acc[ai][bj][m][0] + bv[bj][0], v1 = acc[ai][bj][m][1] + bv[bj][1];
                    u32x4 w; w.x = cvt_pk_bf16(v0[0], v0[1]); w.y = cvt_pk_bf16(v0[2], v0[3]); w.z = cvt_pk_bf16(v1[0], v1[1]); w.w = cvt_pk_bf16(v1[2], v1[3]);
                    *(u32x4*)(rowp + bj * HALF) = w; } }
    }
};
__device__ __forceinline__ float swiglu1(float g, float lin) { g = fminf(g, 7.0f); lin = fminf(fmaxf(lin, -7.0f), 7.0f); return g * __builtin_amdgcn_rcpf(1.0f + __expf(-1.702f * g)) * (lin + 1.0f); }
struct EpiSwiglu {
    static constexpr bool PERM = true;
    bf16_t* O; int ldc; const float* bias; int bias_estride;
    __device__ __forceinline__ void operator()(const f32x4 (&acc)[2][2][4][2], const Unit& u, int wr, int wc, int fr, int fq) const {
        const int row0 = u.pm * BM + wr * 64 + fr, col0 = u.pn * BM + wc * 32 + 8 * fq; const float* bp = bias + (size_t)u.e * bias_estride + col0;
        f32x4 bv[2][2];
#pragma unroll
        for (int bj = 0; bj < 2; ++bj)
#pragma unroll
            for (int n = 0; n < 2; ++n) bv[bj][n] = *(const f32x4*)(bp + bj * HALF + 4 * n);
#pragma unroll
        for (int ai = 0; ai < 2; ++ai)
#pragma unroll
            for (int m = 0; m < 4; ++m) { bf16_t* rowp = O + (size_t)(row0 + ai * HALF + m * 16) * ldc + (col0 >> 1);
#pragma unroll
                for (int bj = 0; bj < 2; ++bj) { const f32x4 v0 = acc[ai][bj][m][0] + bv[bj][0], v1 = acc[ai][bj][m][1] + bv[bj][1];
                    u32x2 w; w.x = cvt_pk_bf16(swiglu1(v0[0], v0[1]), swiglu1(v0[2], v0[3])); w.y = cvt_pk_bf16(swiglu1(v1[0], v1[1]), swiglu1(v1[2], v1[3]));
                    *(u32x2*)(rowp + bj * (HALF / 2)) = w; } }
    }
};

template <bool GATHER = false, class Epi, class Sched>
__device__ __forceinline__ void gemm_phase(PG8_LAS unsigned char* lds, const Gemm g, const Sched& S, const Epi& E, int tid) {
    asm volatile("" : "+v"(tid));
    const int wid = __builtin_amdgcn_readfirstlane(tid >> 6), lane = tid & 63, wr = wid >> 2, wc = wid & 3, fr = lane & 15, fq = lane >> 4;
    int K = g.K; asm volatile("" : "+s"(K));
    const int nt = K / BK;
    unsigned voffA[2], voffB[2];
#pragma unroll
    for (int i = 0; i < 2; ++i) { int R, C; stage_rc(tid * 16 + i * 8192, R, C); const int Rb = Epi::PERM ? ((R & ~31) + perm32(R & 31)) : R;
        voffA[i] = GATHER ? 0u : (unsigned)(R * K + C) * 2u; voffB[i] = (unsigned)(Rb * K + C) * 2u; }
    const size_t kstep = (size_t)(BK * 2);
    const size_t hstep = (size_t)HALF * K * 2;
    const size_t tstep = 2 * hstep;
    const unsigned ldsw = (unsigned)wid * 1024u;
    const int aoff = lds_byte(wr * 64 + fr, fq * 8), boff = lds_byte(wc * 32 + fr, fq * 8);
#define PG8_SA(b, h) (((b) * 2 + (h)) * HTB)
#define PG8_SB(b, h) ((4 + (b) * 2 + (h)) * HTB)
#define PG8_STAGE(bufoff, gbase, voff) do { _Pragma("unroll") for (int _i = 0; _i < 2; ++_i) \
        __builtin_amdgcn_global_load_lds((const unsigned*)((const char*)(gbase) + (voff)[_i]), (PG8_LAS unsigned*)(lds + (bufoff) + ldsw + _i * 8192), 16, 0, 0); } while (0)
#define PG8_STAGE_A(bufoff, h, nx, kb) do { _Pragma("unroll") for (int _i = 0; _i < 2; ++_i) { \
        if constexpr (GATHER) { const unsigned _o = (nx) ? on[h][_i] : oc[h][_i]; \
            __builtin_amdgcn_global_load_lds((const unsigned*)((const char*)g.A + (size_t)_o + (size_t)(kb)), (PG8_LAS unsigned*)(lds + (bufoff) + ldsw + _i * 8192), 16, 0, 0); } \
        else { const char* _b = ((nx) ? nA : cA) + (size_t)(h) * hstep + (size_t)(kb); \
            __builtin_amdgcn_global_load_lds((const unsigned*)(_b + voffA[_i]), (PG8_LAS unsigned*)(lds + (bufoff) + ldsw + _i * 8192), 16, 0, 0); } } } while (0)
#define PG8_LDA(dst, b, h) do { _Pragma("unroll") for (int m = 0; m < 4; ++m) _Pragma("unroll") for (int k = 0; k < 2; ++k) dst[m][k] = *(const PG8_LAS bf16x8*)(lds + PG8_SA(b, h) + aoff + m * 2048 + k * 1024); } while (0)
#define PG8_LDB(dst, b, h) do { _Pragma("unroll") for (int n = 0; n < 2; ++n) _Pragma("unroll") for (int k = 0; k < 2; ++k) dst[n][k] = *(const PG8_LAS bf16x8*)(lds + PG8_SB(b, h) + boff + n * 2048 + k * 1024); } while (0)
#define PG8_MMA(ai, bj, At, Bt) do { __builtin_amdgcn_s_setprio(1); _Pragma("unroll") for (int m = 0; m < 4; ++m) _Pragma("unroll") for (int n = 0; n < 2; ++n) _Pragma("unroll") for (int k = 0; k < 2; ++k) \
        acc[ai][bj][m][n] = __builtin_amdgcn_mfma_f32_16x16x32_bf16(Bt[n][k], At[m][k], acc[ai][bj][m][n], 0, 0, 0); __builtin_amdgcn_s_setprio(0); } while (0)
#define PG8_WAIT_V(n) asm volatile("s_waitcnt vmcnt(" #n ")" ::: "memory")
#define PG8_WAIT_L(n) asm volatile("s_waitcnt lgkmcnt(" #n ")" ::: "memory")
#define PG8_BAR __builtin_amdgcn_s_barrier()
#define PG8_SCHED __builtin_amdgcn_sched_barrier(0)
    Unit cur, nxt; int ui = 0;
    if (!S.next(0, cur)) return;
    unsigned oc[2][2], on[2][2];
    const char* cA = (const char*)g.A + (size_t)cur.pm * tstep; const char* nA = cA;
#define PG8_UNIT_OFFS(o, u) do { _Pragma("unroll") for (int _h = 0; _h < 2; ++_h) _Pragma("unroll") for (int _i = 0; _i < 2; ++_i) { \
        if constexpr (GATHER) { int _R, _C; stage_rc(tid * 16 + _i * 8192, _R, _C); (o)[_h][_i] = (unsigned)g.rowidx[(u).pm * BM + _h * HALF + _R] * (unsigned)(K * 2) + (unsigned)(_C * 2); } else (o)[_h][_i] = 0u; } } while (0)
    PG8_UNIT_OFFS(oc, cur);
    f32x4 acc[2][2][4][2];
#pragma unroll
    for (int a = 0; a < 2; ++a)
#pragma unroll
        for (int b = 0; b < 2; ++b)
#pragma unroll
            for (int m = 0; m < 4; ++m)
#pragma unroll
                for (int n = 0; n < 2; ++n) acc[a][b][m][n] = (f32x4){0.f, 0.f, 0.f, 0.f};
    bf16x8 At[4][2], B0[2][2], B1[2][2];
    const char* cB = (const char*)(g.Bt + (size_t)cur.e * g.estride) + (size_t)cur.pn * tstep;
    PG8_STAGE(PG8_SB(0, 0), cB, voffB); PG8_STAGE(PG8_SB(0, 1), cB + hstep, voffB); PG8_STAGE_A(PG8_SA(0, 0), 0, false, 0); PG8_STAGE_A(PG8_SA(0, 1), 1, false, 0);
    if (wr == 1) PG8_BAR;
    PG8_WAIT_V(2); PG8_BAR;
    PG8_STAGE(PG8_SB(1, 0), cB + kstep, voffB); PG8_STAGE_A(PG8_SA(1, 0), 0, false, kstep); PG8_STAGE(PG8_SB(1, 1), cB + hstep + kstep, voffB);
    PG8_WAIT_V(6); PG8_BAR;
    for (;;) {
        const bool has_next = S.next(ui + 1, nxt);
        if (has_next) { PG8_UNIT_OFFS(on, nxt); nA = (const char*)g.A + (size_t)nxt.pm * tstep; } else { nA = cA; _Pragma("unroll") for (int _h = 0; _h < 2; ++_h) _Pragma("unroll") for (int _i = 0; _i < 2; ++_i) on[_h][_i] = oc[_h][_i]; }
        const char* nB = has_next ? (const char*)(g.Bt + (size_t)nxt.e * g.estride) + (size_t)nxt.pn * tstep : cB;
        for (int t = 0; t < nt; t += 2) {
            const bool last = (t == nt - 2);
            const size_t ka1 = (size_t)(t + 1) * kstep, ka2 = last ? 0 : (size_t)(t + 2) * kstep, ka3 = ka2 + kstep;
            const char* b2 = last ? nB : cB + (size_t)(t + 2) * kstep; const char* b3 = b2 + kstep;
            PG8_LDB(B0, 0, 0); PG8_LDB(B1, 0, 1); PG8_SCHED; PG8_LDA(At, 0, 0); PG8_STAGE_A(PG8_SA(1, 1), 1, false, ka1);
            PG8_WAIT_V(8); PG8_WAIT_L(0); PG8_BAR; PG8_MMA(0, 0, At, B0); PG8_MMA(0, 1, At, B1); PG8_BAR; PG8_SCHED;
            PG8_LDA(At, 0, 1); PG8_STAGE(PG8_SB(0, 0), b2, voffB); PG8_STAGE(PG8_SB(0, 1), b2 + hstep, voffB); PG8_STAGE_A(PG8_SA(0, 0), 0, last, ka2);
            PG8_WAIT_V(8); PG8_WAIT_L(0); PG8_BAR; PG8_MMA(1, 0, At, B0); PG8_MMA(1, 1, At, B1); PG8_BAR; PG8_SCHED;
            PG8_LDB(B0, 1, 0); PG8_LDB(B1, 1, 1); PG8_SCHED; PG8_LDA(At, 1, 0); PG8_STAGE_A(PG8_SA(0, 1), 1, last, ka2);
            PG8_WAIT_V(8); PG8_WAIT_L(0); PG8_BAR; PG8_MMA(0, 0, At, B0); PG8_MMA(0, 1, At, B1); PG8_BAR; PG8_SCHED;
            PG8_LDA(At, 1, 1); PG8_STAGE(PG8_SB(1, 0), b3, voffB); PG8_STAGE(PG8_SB(1, 1), b3 + hstep, voffB); PG8_STAGE_A(PG8_SA(1, 0), 0, last, ka3);
            PG8_WAIT_V(8); PG8_WAIT_L(0); PG8_BAR; PG8_MMA(1, 0, At, B0); PG8_MMA(1, 1, At, B1); PG8_BAR; PG8_SCHED;
        }
        if (wr == 0) PG8_BAR;
        E(acc, cur, wr, wc, fr, fq);
        if (!has_next) break;
#pragma unroll
        for (int a = 0; a < 2; ++a)
#pragma unroll
            for (int b = 0; b < 2; ++b)
#pragma unroll
                for (int m = 0; m < 4; ++m)
#pragma unroll
                    for (int n = 0; n < 2; ++n) acc[a][b][m][n] = (f32x4){0.f, 0.f, 0.f, 0.f};
        cur = nxt; cA = nA; cB = nB; ++ui;
#pragma unroll
        for (int _h = 0; _h < 2; ++_h)
#pragma unroll
            for (int _i = 0; _i < 2; ++_i) oc[_h][_i] = on[_h][_i];
        if (wr == 1) PG8_BAR;
    }
    PG8_WAIT_V(0);
    PG8_BAR;
#undef PG8_UNIT_OFFS
#undef PG8_SA
#undef PG8_SB
#undef PG8_STAGE
#undef PG8_STAGE_A
#undef PG8_LDA
#undef PG8_LDB
#undef PG8_MMA
#undef PG8_WAIT_V
#undef PG8_WAIT_L
#undef PG8_BAR
#undef PG8_SCHED
}
}

#define XB_TMO      128
#define XB_XCNT(j)  (256  + 64 * (j))
#define XB_XSUB(j)  (1280 + 64 * (j))
#define XB_XGEN(j)  (2304 + 64 * (j))
#define XB_TOP      3328
#define XB_TOPGEN   3392
#define XCD_BAR_WORDS 3456
#define XB_SPIN_CAP (1u << 22)
#define LAS __attribute__((address_space(3)))
__device__ __forceinline__ unsigned xb_ld(unsigned* p)              { return __hip_atomic_load(p, __ATOMIC_RELAXED, __HIP_MEMORY_SCOPE_AGENT); }
__device__ __forceinline__ unsigned xb_add(unsigned* p, unsigned v) { return __hip_atomic_fetch_add(p, v, __ATOMIC_RELAXED, __HIP_MEMORY_SCOPE_AGENT); }
__device__ __forceinline__ unsigned xb_xcc_id() { return (unsigned)__builtin_amdgcn_s_getreg((3 << 11) | 20) & 0xFu; }
#define XB_SPIN(cond, bar) do { unsigned _sp = 0; while (cond) { __builtin_amdgcn_s_sleep(1); \
    if ((++_sp & 255u) == 0u) { if (xb_ld(&(bar)[XB_TMO])) break; if (_sp > XB_SPIN_CAP) { atomicAdd(&(bar)[XB_TMO], 1u); break; } } } } while (0)
struct XcdBarrier { unsigned* bar; unsigned x; volatile LAS unsigned* st; };
__device__ __forceinline__ XcdBarrier xcd_barrier_post(unsigned* bar, volatile LAS unsigned* st, int tid) {
    XcdBarrier b; b.bar = bar; b.x = xb_xcc_id(); b.st = st;
    if (tid == 0) (void)xb_add(&bar[XB_XCNT(b.x)], 1u);
    return b;
}
__device__ __forceinline__ void xcd_barrier_complete(unsigned* bar, unsigned x, unsigned& nloc, unsigned& nx) {
    const unsigned G = gridDim.x * gridDim.y * gridDim.z;
    unsigned sum, cnt, mine, sp = 0u;
    for (;;) {
        sum = 0u; cnt = 0u; mine = 0u;
#pragma unroll
        for (unsigned j = 0; j < 16; ++j) { const unsigned c = xb_ld(&bar[XB_XCNT(j)]); sum += c; cnt += (c > 0u) ? 1u : 0u; mine = (j == x) ? c : mine; }
        if (sum == G) break;
        __builtin_amdgcn_s_sleep(1);
        if ((++sp & 255u) == 0u) { if (xb_ld(&bar[XB_TMO])) break; if (sp > XB_SPIN_CAP) { atomicAdd(&bar[XB_TMO], 1u); break; } }
    }
    nloc = mine > 0u ? mine : 1u; nx = cnt > 0u ? cnt : 1u;
}
__device__ __forceinline__ void xcd_barrier(const XcdBarrier& b, int tid) {
    asm volatile("s_waitcnt vmcnt(0)" ::: "memory");
    __syncthreads();
    if (tid == 0) {
        unsigned* bar = b.bar;
        __builtin_amdgcn_s_waitcnt(0);
        unsigned nloc = b.st[0], nx = b.st[1];
        if (nloc == 0u) { xcd_barrier_complete(bar, b.x, nloc, nx); b.st[0] = nloc; b.st[1] = nx; }
        const unsigned old = xb_add(&bar[XB_XSUB(b.x)], 1u);
        const unsigned gen = old / nloc;
        if (old + 1u == (gen + 1u) * nloc) {
            __builtin_amdgcn_fence(__ATOMIC_RELEASE, "agent");
            asm volatile("s_waitcnt vmcnt(0)" ::: "memory");
            const unsigned og = xb_add(&bar[XB_TOP], 1u);
            const unsigned tg = og / nx;
            if (og + 1u == (tg + 1u) * nx) xb_add(&bar[XB_TOPGEN], 1u);
            else XB_SPIN(xb_ld(&bar[XB_TOPGEN]) == tg, bar);
            __builtin_amdgcn_fence(__ATOMIC_ACQUIRE, "agent");
            xb_add(&bar[XB_XGEN(b.x)], 1u);
            asm volatile("s_waitcnt vmcnt(0)" ::: "memory");
        } else {
            XB_SPIN(xb_ld(&bar[XB_XGEN(b.x)]) == gen, bar);
            __builtin_amdgcn_fence(__ATOMIC_ACQUIRE, "agent");
            asm volatile("s_waitcnt vmcnt(0)" ::: "memory");
        }
    }
    __syncthreads();
}


constexpr int NWAVES = 8, NTHR = 512;
constexpr int NPH = 15;
__device__ __forceinline__ float frsq(float x) { return __builtin_amdgcn_rsqf(x); }
__device__ __forceinline__ float frcp(float x) { return __builtin_amdgcn_rcpf(x); }
typedef float f32x4_t __attribute__((ext_vector_type(4)));
typedef unsigned u32x2_t __attribute__((ext_vector_type(2)));
typedef unsigned u32x4_t __attribute__((ext_vector_type(4)));
typedef short bf16x8_t __attribute__((ext_vector_type(8)));
__device__ __forceinline__ float wave_sum(float v) {
#pragma unroll
    for (int o = 1; o < 64; o <<= 1) v += __shfl_xor(v, o);
    return v;
}
__device__ __forceinline__ float grp16_sum(float v) {
#pragma unroll
    for (int o = 1; o < 16; o <<= 1) v += __shfl_xor(v, o);
    return v;
}
__device__ __forceinline__ float hsum4(f32x4_t a) { return (a.x + a.y) + (a.z + a.w); }
__device__ __forceinline__ float hsq4(f32x4_t a) { return (a.x * a.x + a.y * a.y) + (a.z * a.z + a.w * a.w); }
__device__ __forceinline__ u32x2_t pk4(f32x4_t t) { u32x2_t w; w.x = pg8::cvt_pk_bf16(t.x, t.y); w.y = pg8::cvt_pk_bf16(t.z, t.w); return w; }
__device__ __forceinline__ float bflo(unsigned w) { return __builtin_bit_cast(float, w << 16); }
__device__ __forceinline__ float bfhi(unsigned w) { return __builtin_bit_cast(float, w & 0xffff0000u); }
__device__ __forceinline__ f32x4_t bf4(u32x2_t w) { f32x4_t r; r.x = bflo(w.x); r.y = bfhi(w.x); r.z = bflo(w.y); r.w = bfhi(w.y); return r; }
template <bool TO_LDS> __device__ __forceinline__ void norm_mod_store(const f32x4_t (&v)[4], float rstd, const float* pn, const float* sh, const float* sc, bf16_t* orow, LAS unsigned char* lrow, int lane) {
#pragma unroll
    for (int j = 0; j < 4; ++j) { const int k = 4 * lane + 256 * j;
        const f32x4_t pv = *(const f32x4_t*)(pn + k), sv = *(const f32x4_t*)(sc + k), hv = *(const f32x4_t*)(sh + k);
        const f32x4_t t = v[j] * rstd * pv * (1.0f + sv) + hv; const u32x2_t w = pk4(t);
        *(u32x2_t*)(orow + k) = w; if (TO_LDS) *(LAS u32x2_t*)(lrow + 2 * k) = w; }
}
__device__ __forceinline__ void dev_norm1_l0(const P& p, int G, int wave, int lane) {
    int r0, r1; { const int nw = G * NWAVES, per = (NTOK + nw - 1) / nw, gwl = (int)blockIdx.x * NWAVES + wave; r0 = gwl * per; r1 = r0 + per; if (r1 > NTOK) r1 = NTOK; }
    f32x4_t pnr[4], shr[4], scr2[4]; int mrow = -1;
#pragma unroll
    for (int j = 0; j < 4; ++j) pnr[j] = *(const f32x4_t*)(p.pre_norm + 4 * lane + 256 * j);
    for (int m = r0; m < r1; ++m) {
        const float* src = m < NLAT ? p.x + (size_t)m * D : p.ctx + (size_t)(m - NLAT) * D;
        f32x4_t v[4]; float ss = 0.f;
#pragma unroll
        for (int j = 0; j < 4; ++j) { v[j] = *(const f32x4_t*)(src + 4 * lane + 256 * j); ss += hsq4(v[j]); *(f32x4_t*)(p.X() + (size_t)m * D + 4 * lane + 256 * j) = v[j]; }
        const int mr = mod_row(m);
        if (mr != mrow) { const float* md = p.MOD() + (size_t)mr * 6 * D; mrow = mr;
#pragma unroll
            for (int j = 0; j < 4; ++j) { shr[j] = *(const f32x4_t*)(md + 4 * lane + 256 * j); scr2[j] = *(const f32x4_t*)(md + D + 4 * lane + 256 * j); } }
        const float rstd = frsq(wave_sum(ss) * (1.0f / D) + 1e-6f); bf16_t* orow = p.HB() + (size_t)m * D;
#pragma unroll
        for (int j = 0; j < 4; ++j) { const f32x4_t t = v[j] * rstd * pnr[j] * (1.0f + scr2[j]) + shr[j]; *(u32x2_t*)(orow + 4 * lane + 256 * j) = pk4(t); }
    }
}
__device__ __forceinline__ void dev_post(const P& p, int l, int ntok_l, int gw, int ngw, int lane) {
    const int h = lane >> 4;
    for (int m = gw; m < ntok_l; m += ngw) {
        {
            const f32x4_t y = bf4(*(const u32x2_t*)(p.YA() + (size_t)m * A_W + 4 * lane)) + bf4(*(const u32x2_t*)(p.YA() + ((size_t)NTOK + m) * A_W + 4 * lane));
            const float mean = grp16_sum(hsum4(y)) * (1.0f / 64.f); const f32x4_t d = y - mean;
            const float var = grp16_sum(hsq4(d)) * (1.0f / 64.f); const float rs = frsq(var + 64e-5f);
            const f32x4_t lw = *(const f32x4_t*)(p.rw_ln_w + l * A_W + 4 * lane), lb = *(const f32x4_t*)(p.rw_ln_b + l * A_W + 4 * lane);
            const f32x4_t vv = bf4(*(const u32x2_t*)(p.RW_V() + (size_t)m * A_W + 4 * lane)), gt = bf4(*(const u32x2_t*)(p.RW_GATE() + (size_t)m * A_W + 4 * lane));
            const float bon = p.RW_BON()[(size_t)m * A_H + h];
            const f32x4_t o = (d * rs * lw + lb + bon * vv) * gt;
            *(u32x2_t*)(p.MIX() + (size_t)m * D + 4 * lane) = pk4(o);
        }
        {
            const u32x4_t o0 = *(const u32x4_t*)(p.OB() + (size_t)m * B_W + 8 * lane), o1 = *(const u32x4_t*)(p.OB() + ((size_t)NTOK + m) * B_W + 8 * lane);
            const f32x4_t a = bf4((u32x2_t){o0.x, o0.y}) + bf4((u32x2_t){o1.x, o1.y}), b = bf4((u32x2_t){o0.z, o0.w}) + bf4((u32x2_t){o1.z, o1.w});
            const float rs = frsq(grp16_sum(hsq4(a) + hsq4(b)) * (1.0f / 128.f) + 1e-6f);
            const u32x4_t zr = *(const u32x4_t*)(p.U() + (size_t)m * INP + B_OFF + 1536 + 8 * lane);
            const float* nw = p.gdn_norm + l * 128 + ((8 * lane) & 127);
            const f32x4_t n0 = *(const f32x4_t*)nw, n1 = *(const f32x4_t*)(nw + 4);
            const f32x4_t z0 = {bflo(zr.x), bfhi(zr.x), bflo(zr.y), bfhi(zr.y)}, z1 = {bflo(zr.z), bfhi(zr.z), bflo(zr.w), bfhi(zr.w)};
            f32x4_t s0, s1;
#pragma unroll
            for (int c = 0; c < 4; ++c) { s0[c] = z0[c] * frcp(1.0f + __expf(-z0[c])); s1[c] = z1[c] * frcp(1.0f + __expf(-z1[c])); }
            const f32x4_t r0 = a * rs * n0 * s0, r1 = b * rs * n1 * s1;
            u32x4_t w; const u32x2_t w0 = pk4(r0), w1 = pk4(r1); w.x = w0.x; w.y = w0.y; w.z = w1.x; w.w = w1.y;
            *(u32x4_t*)(p.MIX() + (size_t)m * D + 256 + 8 * lane) = w;
        }
    }
}
constexpr int RT_TK = 0, RT_TKS = 2064, RT_PL = 34816, RT_LG = RT_PL + 16384, RT_CNT = RT_LG + 2304, RT_BASE = RT_CNT + 128, RT_ASG = RT_BASE + 128, RT_ASG_MAX = 4096;
__device__ __forceinline__ void dev_resid_router(const P& p, int l, int ntok_l, LAS unsigned char* lds, int G, int tid) {
    const int lane = tid & 63, wave = tid >> 6;
    LAS int* LCNT = (LAS int*)(lds + RT_CNT); LAS int* LBASE = (LAS int*)(lds + RT_BASE); LAS int* ASG = (LAS int*)(lds + RT_ASG);
    LAS float* PL = (LAS float*)(lds + RT_PL); LAS float* LG = (LAS float*)(lds + RT_LG);
    if (tid < 32) LCNT[tid] = 0;
    __syncthreads();
    f32x4_t pnr[4], pn2r[4];
#pragma unroll
    for (int j = 0; j < 4; ++j) { const int k = 4 * lane + 256 * j; pnr[j] = *(const f32x4_t*)(p.post_norm + (size_t)(l * 2 + 0) * D + k); pn2r[j] = *(const f32x4_t*)(p.pre_norm + (size_t)(l * 2 + 1) * D + k); }
    const int ngrp = ntok_l / 16; int it = 0;
    for (int grp = blockIdx.x; grp < ngrp; grp += G, ++it) {
        f32x4_t g1r[4], sh2r[4], sc2r[4];
        { const float* md = p.MOD() + ((size_t)l * (BATCH + 1) + mod_row(grp * 16)) * 6 * D;
#pragma unroll
          for (int j = 0; j < 4; ++j) { const int k = 4 * lane + 256 * j; g1r[j] = *(const f32x4_t*)(md + 2 * D + k); sh2r[j] = *(const f32x4_t*)(md + 3 * D + k); sc2r[j] = *(const f32x4_t*)(md + 4 * D + k); } }
#pragma unroll 1
        for (int rr = 0; rr < 2; ++rr) {
            const int ri = wave * 2 + rr, m = grp * 16 + ri;
            const bf16_t* mo = p.MO() + (size_t)m * D; float* xr = p.X() + (size_t)m * D;
            f32x4_t v[4], x[4]; float ss = 0.f;
#pragma unroll
            for (int j = 0; j < 4; ++j) { v[j] = bf4(*(const u32x2_t*)(mo + 4 * lane + 256 * j)); x[j] = *(const f32x4_t*)(xr + 4 * lane + 256 * j); ss += hsq4(v[j]); }
            const float rstd = frsq(wave_sum(ss) * (1.0f / D) + 1e-6f); float s2 = 0.f;
#pragma unroll
            for (int j = 0; j < 4; ++j) { const int k = 4 * lane + 256 * j;
                x[j] = x[j] + g1r[j] * (v[j] * rstd) * pnr[j]; s2 += hsq4(x[j]); *(f32x4_t*)(xr + k) = x[j]; }
            const float r2 = frsq(wave_sum(s2) * (1.0f / D) + 1e-6f);
            { bf16_t* orow = p.HB() + (size_t)m * D; LAS unsigned char* lrow = lds + RT_TK + ri * RT_TKS;
#pragma unroll
              for (int j = 0; j < 4; ++j) { const int k = 4 * lane + 256 * j; const f32x4_t t = x[j] * r2 * pn2r[j] * (1.0f + sc2r[j]) + sh2r[j]; const u32x2_t w = pk4(t); *(u32x2_t*)(orow + k) = w; *(LAS u32x2_t*)(lrow + 2 * k) = w; } }
        }
        __syncthreads();
        {
            const int i = lane & 15, q = lane >> 4; pg8::f32x4 acc0 = {0.f, 0.f, 0.f, 0.f}, acc1 = {0.f, 0.f, 0.f, 0.f};
#pragma unroll
            for (int ks = 0; ks < 4; ++ks) { const int k0 = 128 * wave + 32 * ks + 8 * q;
                const bf16x8_t a = *(const LAS bf16x8_t*)(lds + RT_TK + i * RT_TKS + 2 * k0);
                const bf16x8_t b0 = *(const bf16x8_t*)(p.WR_T(l) + (size_t)i * D + k0), b1 = *(const bf16x8_t*)(p.WR_T(l) + (size_t)(16 + i) * D + k0);
                acc0 = __builtin_amdgcn_mfma_f32_16x16x32_bf16(a, b0, acc0, 0, 0, 0); acc1 = __builtin_amdgcn_mfma_f32_16x16x32_bf16(a, b1, acc1, 0, 0, 0); }
#pragma unroll
            for (int r = 0; r < 4; ++r) { PL[(wave * 16 + 4 * q + r) * 32 + i] = acc0[r]; PL[(wave * 16 + 4 * q + r) * 32 + 16 + i] = acc1[r]; }
        }
        __syncthreads();
        {
            const int ri = tid >> 5, e = tid & 31; float sacc = p.router_b[l * NEXP + e];
#pragma unroll
            for (int w = 0; w < 8; ++w) sacc += PL[(w * 16 + ri) * 32 + e];
            LG[ri * 33 + e] = sacc;
        }
        __syncthreads();
        if (tid < 16) {
            const int m = grp * 16 + tid; float lg[NEXP];
#pragma unroll
            for (int e = 0; e < NEXP; ++e) lg[e] = LG[tid * 33 + e];
            int idx[TOPK]; float val[TOPK];
#pragma unroll
            for (int j = 0; j < TOPK; ++j) { float best = -3.0e38f; int bi = 0;
#pragma unroll
                for (int e = 0; e < NEXP; ++e) { if (lg[e] > best) { best = lg[e]; bi = e; } }
                idx[j] = bi; val[j] = best;
#pragma unroll
                for (int e = 0; e < NEXP; ++e) if (e == bi) lg[e] = -3.0e38f; }
            float sum = 0.f, ex[TOPK];
#pragma unroll
            for (int j = 0; j < TOPK; ++j) { ex[j] = __expf(val[j] - val[0]); sum += ex[j]; }
            const float inv = 1.0f / sum;
#pragma unroll
            for (int j = 0; j < TOPK; ++j) { p.TOPI()[(size_t)m * TOPK + j] = idx[j]; p.TOPG()[(size_t)m * TOPK + j] = ex[j] * inv;
                const int lp = __hip_atomic_fetch_add(&LCNT[idx[j]], 1, __ATOMIC_RELAXED, __HIP_MEMORY_SCOPE_WORKGROUP);
                const int ai = (it * 16 + tid) * 4 + j; if (ai < RT_ASG_MAX) ASG[ai] = (idx[j] << 20) | lp; }
        }
        __syncthreads();
    }
    if (tid < 32) LBASE[tid] = LCNT[tid] > 0 ? atomicAdd(&p.cnt()[l * NEXP + tid], LCNT[tid]) : 0;
    __syncthreads();
    for (int a = tid; a < it * 64 && a < RT_ASG_MAX; a += NTHR) { const int w = ASG[a]; const int e = w >> 20, lp = w & 0xfffff; const int itx = a / 64, ri = (a % 64) / 4, j = a % 4;
        const int m = (blockIdx.x + itx * G) * 16 + ri; p.POS()[(size_t)m * TOPK + j] = LBASE[e] + lp; }
    __syncthreads();
}
__device__ __forceinline__ void dev_slots(const P& p, int l, int ntok_l, LAS unsigned char* lds, long gtid, long nthr, int tid) {
    LAS int* PST = (LAS int*)lds; LAS int* CN = (LAS int*)(lds + 256);
    if (tid == 0) { int acc = 0; for (int e = 0; e < NEXP; ++e) { const int c = p.cnt()[l * NEXP + e]; PST[e] = acc; CN[e] = c; acc += (c + 255) / 256 * 256; } PST[NEXP] = acc; }
    __syncthreads();
    for (long t = gtid; t < (long)ntok_l * TOPK; t += nthr) { const int e = p.TOPI()[t]; const int slot = PST[e] + p.POS()[t]; p.TSLOT()[t] = slot; p.SLOT_TOK()[slot] = (int)(t / TOPK); }
    for (long t = gtid; t < NEXP * 256; t += nthr) { const int e = (int)(t >> 8), i = (int)(t & 255); const int c = CN[e]; const int pads = (c + 255) / 256 * 256 - c; if (i < pads) p.SLOT_TOK()[PST[e] + c + i] = ZROW; }
    for (long t = gtid; t < NBLK_MAX; t += nthr) { int e_of = NEXP - 1;
        for (int e = 0; e < NEXP; ++e) { if ((int)t * 256 >= PST[e] && (int)t * 256 < PST[e + 1]) e_of = e; }
        p.BLOCK_E()[t] = e_of; if (t == 0) p.NBLK()[0] = PST[NEXP] / 256; }
    __syncthreads();
}
struct CbA { int4 sl; f32x4_t gt; };
struct CbB { u32x2_t y[4][4]; f32x4_t x[4]; f32x4_t gt; };
__device__ __forceinline__ void combine_loadA(const P& p, int m, CbA& a) { a.sl = *(const int4*)(p.TSLOT() + (size_t)m * 4); a.gt = *(const f32x4_t*)(p.TOPG() + (size_t)m * 4); }
__device__ __forceinline__ void combine_loadB(const P& p, int m, const CbA& a, int lane, CbB& b) {
    const bf16_t* y0 = p.YB() + (size_t)a.sl.x * D; const bf16_t* y1 = p.YB() + (size_t)a.sl.y * D; const bf16_t* y2 = p.YB() + (size_t)a.sl.z * D; const bf16_t* y3 = p.YB() + (size_t)a.sl.w * D;
    const float* xr = p.X() + (size_t)m * D;
#pragma unroll
    for (int j = 0; j < 4; ++j) { const int k = 4 * lane + 256 * j; b.y[0][j] = *(const u32x2_t*)(y0 + k); b.y[1][j] = *(const u32x2_t*)(y1 + k); b.y[2][j] = *(const u32x2_t*)(y2 + k); b.y[3][j] = *(const u32x2_t*)(y3 + k); b.x[j] = *(const f32x4_t*)(xr + k); }
    b.gt = a.gt;
}
struct CbPar { f32x4_t pn[4], pn1[4], g2[4], sh1[4], sc1[4]; int mrow; };
__device__ __forceinline__ void combine_params(const P& p, int l, int lane, CbPar& q) {
    const bool last = (l == DEPTH - 1);
#pragma unroll
    for (int j = 0; j < 4; ++j) { const int k = 4 * lane + 256 * j; q.pn[j] = *(const f32x4_t*)(p.post_norm + (size_t)(l * 2 + 1) * D + k); q.pn1[j] = last ? q.pn[j] : *(const f32x4_t*)(p.pre_norm + (size_t)((l + 1) * 2 + 0) * D + k); }
    q.mrow = -1;
}
__device__ __forceinline__ void combine_mod(const P& p, int l, int mrow, int lane, CbPar& q) {
    const bool last = (l == DEPTH - 1); const float* md = p.MOD() + ((size_t)l * (BATCH + 1) + mrow) * 6 * D; const float* md1 = p.MOD() + ((size_t)(last ? l : l + 1) * (BATCH + 1) + mrow) * 6 * D;
#pragma unroll
    for (int j = 0; j < 4; ++j) { const int k = 4 * lane + 256 * j; q.g2[j] = *(const f32x4_t*)(md + 5 * D + k); q.sh1[j] = *(const f32x4_t*)(md1 + k); q.sc1[j] = *(const f32x4_t*)(md1 + D + k); }
    q.mrow = mrow;
}
__device__ __forceinline__ void combine_compute(const P& p, int l, int m, const CbB& b, int lane, const CbPar& q) {
    const bool last = (l == DEPTH - 1);
    float* xr = p.X() + (size_t)m * D;
    const f32x4_t gt = b.gt; f32x4_t f[4], x[4]; float ss = 0.f;
#pragma unroll
    for (int j = 0; j < 4; ++j) { const u32x2_t a = b.y[0][j], bb = b.y[1][j], c = b.y[2][j], d = b.y[3][j];
        f[j].x = gt.x * bflo(a.x) + gt.y * bflo(bb.x) + gt.z * bflo(c.x) + gt.w * bflo(d.x); f[j].y = gt.x * bfhi(a.x) + gt.y * bfhi(bb.x) + gt.z * bfhi(c.x) + gt.w * bfhi(d.x);
        f[j].z = gt.x * bflo(a.y) + gt.y * bflo(bb.y) + gt.z * bflo(c.y) + gt.w * bflo(d.y); f[j].w = gt.x * bfhi(a.y) + gt.y * bfhi(bb.y) + gt.z * bfhi(c.y) + gt.w * bfhi(d.y);
        ss += hsq4(f[j]); x[j] = b.x[j]; }
    const float rstd = frsq(wave_sum(ss) * (1.0f / D) + 1e-6f); float s2 = 0.f;
#pragma unroll
    for (int j = 0; j < 4; ++j) { const int k = 4 * lane + 256 * j;
        x[j] = x[j] + q.g2[j] * (f[j] * rstd) * q.pn[j]; s2 += hsq4(x[j]);
#ifdef PROBE_DET
        if (last) { const unsigned cs_ = p.ctl()[12050]; x[j] = (f32x4_t){(float)(cs_ & 0xffffu), (float)((cs_ >> 16) & 0xffffu), 1.f, 2.f}; }
#endif
#ifdef PROBE_T
        if (last) { const unsigned long long* ts = (const unsigned long long*)(p.ctl() + 12100); const float tot = (float)(ts[2 * NPH - 1] - ts[0]);
            float fa = 0.f;
            for (int ll = 0; ll < 2; ++ll) for (int jj = 0; jj < NPH; ++jj) if (((PT_MASK >> jj) & 1) && (1 + ll * NPH + jj + 1 <= 2 * NPH - 1)) fa += (float)(ts[1 + ll * NPH + jj + 1] - ts[1 + ll * NPH + jj]);
            if ((PT_MASK >> 20) & 1) fa += (float)(ts[1] - ts[0]);
#ifdef PT_ACT
            fa = (float)p.ctl()[12070] + (float)p.ctl()[12071];
#endif
#ifdef PT_SEC
            fa = (float)p.ctl()[12080] * (1.0f / 128.0f);
#endif
            const float fq = floorf(fa / tot * 64.0f + 0.5f) * (1.0f / 64.0f);
            x[j] = x[j] * (1.0f + 0.07f * sqrtf(fq)); }
#endif
#if defined(PROBE_GDN) || defined(PROBE_RWKV)
        if (last) { const float e = ((const float*)(p.ctl() + 12000))[0], r = ((const float*)(p.ctl() + 12001))[0]; x[j] = x[j] * (1.0f + 10.0f * sqrtf(e / r)); }
#endif
        if (last) *(f32x4_t*)(p.out + (size_t)m * D + k) = x[j]; else *(f32x4_t*)(xr + k) = x[j]; }
    if (!last) { const float r2 = frsq(wave_sum(s2) * (1.0f / D) + 1e-6f); bf16_t* orow = p.HB() + (size_t)m * D;
#pragma unroll
        for (int j = 0; j < 4; ++j) { const int k = 4 * lane + 256 * j; const f32x4_t t = x[j] * r2 * q.pn1[j] * (1.0f + q.sc1[j]) + q.sh1[j]; *(u32x2_t*)(orow + k) = pk4(t); } }
}
__device__ __forceinline__ void dev_combine(const P& p, int l, int ntok_l, int G, int wave, int lane) {
    int r0, r1; { const int nw = G * NWAVES, per = (ntok_l + nw - 1) / nw, gwl = (int)blockIdx.x * NWAVES + wave; r0 = gwl * per; r1 = r0 + per; if (r1 > ntok_l) r1 = ntok_l; }
    if (r0 >= r1) return;
    CbPar par; combine_params(p, l, lane, par);
    int m = r0; CbA a0, a1; CbB b0; combine_loadA(p, m, a0); a1 = a0; if (m + 1 < r1) combine_loadA(p, m + 1, a1);
    combine_loadB(p, m, a0, lane, b0);
    for (; m < r1; ++m) {
        CbA a2 = a1; if (m + 2 < r1) combine_loadA(p, m + 2, a2);
        CbB b1 = b0; if (m + 1 < r1) combine_loadB(p, m + 1, a1, lane, b1);
        const int mr = mod_row(m); if (mr != par.mrow) combine_mod(p, l, mr, lane, par);
        combine_compute(p, l, m, b0, lane, par);
        b0 = b1; a1 = a2;
    }
}
__device__ __forceinline__ void lds_barrier() { asm volatile("s_waitcnt lgkmcnt(0)\n\ts_barrier" ::: "memory"); }
#define MMA16(a, b, c) __builtin_amdgcn_mfma_f32_16x16x32_bf16((a), (b), (c), 0, 0, 0)
typedef pg8::f32x4 f32x4;
__device__ __forceinline__ bf16x8_t lfrag(LAS const unsigned char* lds, int off, int ld, int row0, int k0, int lane) {
    return *(LAS const bf16x8_t*)(lds + off + (row0 + (lane & 15)) * ld + (k0 + 8 * (lane >> 4)) * 2);
}
__device__ __forceinline__ bf16x8_t lfrag16(LAS const unsigned char* lds, int off, int ld, int row0, int k0, int lane) {
    bf16x8_t z = {0, 0, 0, 0, 0, 0, 0, 0}; return (lane >> 4) < 2 ? lfrag(lds, off, ld, row0, k0, lane) : z;
}
__device__ __forceinline__ bf16x8_t lfragT(LAS const unsigned char* lds, int off, int ld, int k0, int n0, int kvalid, int lane) {
    bf16x8_t v; const int n = n0 + (lane & 15), kb = 8 * (lane >> 4);
#pragma unroll
    for (int j = 0; j < 8; ++j) v[j] = (kb + j < kvalid) ? *(LAS const short*)(lds + off + (k0 + kb + j) * ld + n * 2) : (short)0;
    return v;
}
__device__ __forceinline__ void st_rm(LAS unsigned char* lds, int off, int ld, int m0, int n0, f32x4 acc, int lane) {
#pragma unroll
    for (int r = 0; r < 4; ++r) *(LAS bf16_t*)(lds + off + (m0 + 4 * (lane >> 4) + r) * ld + (n0 + (lane & 15)) * 2) = f2bf(acc[r]);
}
__device__ __forceinline__ void st_tr(LAS unsigned char* lds, int off, int ld, int m0, int n0, f32x4 acc, int lane) {
    u32x2_t w; w.x = pg8::cvt_pk_bf16(acc[0], acc[1]); w.y = pg8::cvt_pk_bf16(acc[2], acc[3]);
    *(LAS u32x2_t*)(lds + off + (n0 + (lane & 15)) * ld + (m0 + 4 * (lane >> 4)) * 2) = w;
}
__device__ __forceinline__ u32x4_t scale8(u32x4_t v, float s) {
    u32x4_t o; o.x = pg8::cvt_pk_bf16(bflo(v.x) * s, bfhi(v.x) * s); o.y = pg8::cvt_pk_bf16(bflo(v.y) * s, bfhi(v.y) * s);
    o.z = pg8::cvt_pk_bf16(bflo(v.z) * s, bfhi(v.z) * s); o.w = pg8::cvt_pk_bf16(bflo(v.w) * s, bfhi(v.w) * s); return o;
}

template <int LOFF, int TOFF, int SCOFF>
__device__ __forceinline__ void tri_inv64(LAS unsigned char* lds, int tid) {
    const int wave = __builtin_amdgcn_readfirstlane(tid >> 6); int lane = tid & 63, q4 = lane >> 4, l16 = lane & 15;
    if (wave == 0) {
        float x[16];
#pragma unroll
        for (int i = 0; i < 16; ++i) { float sacc = (i == l16) ? 1.f : 0.f;
#pragma unroll
            for (int j = 0; j < i; ++j) sacc -= bf2f(*(LAS const bf16_t*)(lds + LOFF + (16 * q4 + i) * 144 + (16 * q4 + j) * 2)) * x[j];
            x[i] = sacc; }
#pragma unroll
        for (int i = 0; i < 16; ++i) *(LAS bf16_t*)(lds + TOFF + (16 * q4 + i) * 144 + (16 * q4 + l16) * 2) = f2bf(x[i]);
    }
    lds_barrier(); asm volatile("" : "+v"(tid)); lane = tid & 63;
    if (wave < 2) {
        const int I = 2 * wave + 1, J = 2 * wave; const f32x4 z = {0.f, 0.f, 0.f, 0.f};
        const f32x4 m1 = MMA16(lfrag16(lds, LOFF, 144, 16 * I, 16 * J, lane), lfragT(lds, TOFF, 144, 16 * J, 16 * J, 16, lane), z);
        st_rm(lds, SCOFF + wave * 1280, 80, 0, 0, m1, lane);
        asm volatile("s_waitcnt lgkmcnt(0)" ::: "memory");
        const f32x4 t1 = MMA16(lfrag16(lds, TOFF, 144, 16 * I, 16 * I, lane), lfragT(lds, SCOFF + wave * 1280, 80, 0, 0, 16, lane), z);
        st_rm(lds, TOFF, 144, 16 * I, 16 * J, -t1, lane);
    }
    lds_barrier(); asm volatile("" : "+v"(tid)); lane = tid & 63;
    {
        const int mt2 = (wave >> 1) & 1, nt2 = wave & 1; const f32x4 z = {0.f, 0.f, 0.f, 0.f};
        if (wave < 4) { const f32x4 m2 = MMA16(lfrag(lds, LOFF, 144, 32 + 16 * mt2, 0, lane), lfragT(lds, TOFF, 144, 0, 16 * nt2, 32, lane), z); st_rm(lds, SCOFF, 80, 16 * mt2, 16 * nt2, m2, lane); }
        lds_barrier();
        if (wave < 4) { const f32x4 t2 = MMA16(lfrag(lds, TOFF, 144, 32 + 16 * mt2, 32, lane), lfragT(lds, SCOFF, 80, 0, 16 * nt2, 32, lane), z); st_rm(lds, TOFF, 144, 32 + 16 * mt2, 16 * nt2, -t2, lane); }
    }
    lds_barrier();
}

constexpr int GQ_ = 0, GK_ = 17408, GV_ = 34816, GL_ = 53248, GT_ = 62464, GSC_ = 71680, GVB_ = 74240, GKB_ = 92672, GST_ = 111104, GF_ = 145920;
constexpr int LD128 = 272, LD64 = 144, LDSC = 80;
__device__ __forceinline__ void gdn_chain(const bf16_t* __restrict__ gq, const bf16_t* __restrict__ gk, const bf16_t* __restrict__ gv, const float* __restrict__ gg, const float* __restrict__ gbeta, int chain, bf16_t* __restrict__ OBout, LAS unsigned char* lds, int tid, unsigned* ctlp) {
    const int wave = __builtin_amdgcn_readfirstlane(tid >> 6); int lane = tid & 63, q4 = lane >> 4, l16 = lane & 15;
#ifdef PT_SEC
    unsigned long long ts_ = __builtin_amdgcn_s_memrealtime();
#define SEC_MARK(k) do { if (tid == 0) { const unsigned long long n_ = __builtin_amdgcn_s_memrealtime(); if ((k) == PT_SEC) atomicAdd(ctlp + 12080, (unsigned)(n_ - ts_)); ts_ = n_; } } while (0)
#else
#define SEC_MARK(k)
#endif
#define GDN_RELANE() do { asm volatile("" : "+v"(tid)); lane = tid & 63; q4 = lane >> 4; l16 = lane & 15; } while (0)
    const int h = chain % B_H, b = (chain / B_H) % BATCH, dir = chain / (B_H * BATCH);
    LAS float* GF = (LAS float*)(lds + GF_);
    for (int i = tid; i < 34816 / 16; i += NTHR) *(LAS u32x4_t*)(lds + GST_ + 16 * i) = (u32x4_t){0u, 0u, 0u, 0u};
    f32x4 Sacc[8];
#pragma unroll
    for (int nt = 0; nt < 8; ++nt) Sacc[nt] = (f32x4){0.f, 0.f, 0.f, 0.f};
    u32x4_t pq[2], pk[2], pv[2]; float pg = 0.f, pb = 0.f;
#define GDN_LOADS(cc) do { _Pragma("unroll") for (int u = 0; u < 2; ++u) { const int piece = tid + 512 * u, i = piece >> 4, c16 = piece & 15; \
        const size_t ro = (size_t)scan_row(dir, b, 64 * (cc) + i) * B_W + h * 128 + c16 * 8; \
        pq[u] = *(const u32x4_t*)(gq + ro); pk[u] = *(const u32x4_t*)(gk + ro); pv[u] = *(const u32x4_t*)(gv + ro); } \
        if (tid < 64) { const size_t ro = (size_t)scan_row(dir, b, 64 * (cc) + tid) * 8 + dir * 4 + h; pg = gg[ro]; pb = gbeta[ro]; } } while (0)
    GDN_LOADS(0);
    constexpr int NCH = SLEN / 64;
#pragma unroll 1
    for (int c = 0; c < NCH; ++c) {
        GDN_RELANE();
#pragma unroll
        for (int u = 0; u < 2; ++u) { const int piece = tid + 512 * u, i = piece >> 4, c16 = piece & 15;
            *(LAS u32x4_t*)(lds + GQ_ + i * LD128 + c16 * 16) = pq[u]; *(LAS u32x4_t*)(lds + GK_ + i * LD128 + c16 * 16) = pk[u]; *(LAS u32x4_t*)(lds + GV_ + i * LD128 + c16 * 16) = pv[u]; }
        for (int i2 = tid; i2 < 9216 / 16; i2 += NTHR) *(LAS u32x4_t*)(lds + GT_ + 16 * i2) = (u32x4_t){0u, 0u, 0u, 0u};
        if (wave == 0) {
            float x = pg;
#pragma unroll
            for (int o = 1; o < 64; o <<= 1) { const float y = __shfl_up(x, o); if (lane >= o) x += y; }
            const float gl = __shfl(x, 63);
            GF[lane] = x; GF[64 + lane] = pb; GF[128 + lane] = __expf(x); GF[192 + lane] = __expf(gl - x); if (lane == 0) GF[256] = __expf(gl);
        }
        if (c + 1 < NCH) GDN_LOADS(c + 1);
        lds_barrier(); __builtin_amdgcn_sched_barrier(0); GDN_RELANE(); SEC_MARK(1);
        const int mt = wave >> 1;
        f32x4 qk[2];
        {
            f32x4 kk[2]; kk[0] = kk[1] = qk[0] = qk[1] = (f32x4){0.f, 0.f, 0.f, 0.f};
#pragma unroll
            for (int ks = 0; ks < 4; ++ks) { __builtin_amdgcn_sched_barrier(0); const bf16x8_t ak = lfrag(lds, GK_, LD128, 16 * mt, 32 * ks, lane), aq = lfrag(lds, GQ_, LD128, 16 * mt, 32 * ks, lane);
#pragma unroll
                for (int t = 0; t < 2; ++t) { const bf16x8_t bk = lfrag(lds, GK_, LD128, 16 * (2 * (wave & 1) + t), 32 * ks, lane); kk[t] = MMA16(bk, ak, kk[t]); qk[t] = MMA16(bk, aq, qk[t]); } }
#pragma unroll
            for (int t = 0; t < 2; ++t) { const int i = 16 * mt + l16; const float gci = GF[i], bi = GF[64 + i]; f32x4 lv;
#pragma unroll
                for (int r = 0; r < 4; ++r) { const int j = 16 * (2 * (wave & 1) + t) + 4 * q4 + r; const float dec = i >= j ? __expf(gci - GF[j]) : 0.f;
                    lv[r] = i > j ? bi * kk[t][r] * dec : 0.f; qk[t][r] *= dec; }
                st_tr(lds, GL_, LD64, 16 * (2 * (wave & 1) + t), 16 * mt, lv, lane); }
        }
        lds_barrier(); __builtin_amdgcn_sched_barrier(0); GDN_RELANE();
        SEC_MARK(2);
        if (wave >= 4) {
            const int t4 = tid - 256;
#pragma unroll
            for (int rep = 0; rep < 4; ++rep) { const int task = t4 + 256 * rep, cidx = task & 127, jg = task >> 7; float vv[8], kv[8];
#pragma unroll
                for (int jj = 0; jj < 8; ++jj) { const int j = 8 * jg + jj; const float bj = GF[64 + j];
                    vv[jj] = bf2f(*(LAS const bf16_t*)(lds + GV_ + j * LD128 + cidx * 2)) * bj; kv[jj] = bf2f(*(LAS const bf16_t*)(lds + GK_ + j * LD128 + cidx * 2)) * bj * GF[128 + j]; }
                u32x4_t wv, wk; wv.x = pg8::cvt_pk_bf16(vv[0], vv[1]); wv.y = pg8::cvt_pk_bf16(vv[2], vv[3]); wv.z = pg8::cvt_pk_bf16(vv[4], vv[5]); wv.w = pg8::cvt_pk_bf16(vv[6], vv[7]);
                wk.x = pg8::cvt_pk_bf16(kv[0], kv[1]); wk.y = pg8::cvt_pk_bf16(kv[2], kv[3]); wk.z = pg8::cvt_pk_bf16(kv[4], kv[5]); wk.w = pg8::cvt_pk_bf16(kv[6], kv[7]);
                *(LAS u32x4_t*)(lds + GVB_ + cidx * LD64 + jg * 16) = wv; *(LAS u32x4_t*)(lds + GKB_ + cidx * LD64 + jg * 16) = wk; }
#pragma unroll
            for (int u = 0; u < 4; ++u) { const int piece = t4 + 256 * u, i = piece >> 4, c16 = piece & 15; LAS u32x4_t* qp = (LAS u32x4_t*)(lds + GQ_ + i * LD128 + c16 * 16); *qp = scale8(*qp, GF[128 + i]); }
        }
        tri_inv64<GL_, GT_, GSC_>(lds, tid); GDN_RELANE(); SEC_MARK(3);
#pragma unroll
        for (int t = 0; t < 2; ++t) st_tr(lds, GL_, LD64, 16 * (2 * (wave & 1) + t), 16 * mt, qk[t], lane);
        SEC_MARK(4);
        f32x4 accu[4], o[4];
#pragma unroll
        for (int m = 0; m < 4; ++m) accu[m] = o[m] = (f32x4){0.f, 0.f, 0.f, 0.f};
#pragma unroll
        for (int ks = 0; ks < 2; ++ks) { __builtin_amdgcn_sched_barrier(0); const bf16x8_t bb = lfrag(lds, GVB_, LD64, 16 * wave, 32 * ks, lane);
#pragma unroll
            for (int m = 0; m < 4; ++m) accu[m] = MMA16(lfrag(lds, GT_, LD64, 16 * m, 32 * ks, lane), bb, accu[m]); }
        {
            f32x4 accw[4];
#pragma unroll
            for (int m = 0; m < 4; ++m) accw[m] = (f32x4){0.f, 0.f, 0.f, 0.f};
#pragma unroll
            for (int ks = 0; ks < 2; ++ks) { __builtin_amdgcn_sched_barrier(0); const bf16x8_t bb = lfrag(lds, GKB_, LD64, 16 * wave, 32 * ks, lane);
#pragma unroll
                for (int m = 0; m < 4; ++m) accw[m] = MMA16(bb, lfrag(lds, GT_, LD64, 16 * m, 32 * ks, lane), accw[m]); }
            lds_barrier();
#pragma unroll
            for (int m = 0; m < 4; ++m) st_tr(lds, GVB_, LD128, 16 * wave, 16 * m, -accw[m], lane);
        }
#pragma unroll
        for (int rep = 0; rep < 2; ++rep) { const int task = tid + 512 * rep, cidx = task & 127, jg = task >> 7; float kv[8];
#pragma unroll
            for (int jj = 0; jj < 8; ++jj) { const int j = 8 * jg + jj; kv[jj] = bf2f(*(LAS const bf16_t*)(lds + GK_ + j * LD128 + cidx * 2)) * GF[192 + j]; }
            u32x4_t wk; wk.x = pg8::cvt_pk_bf16(kv[0], kv[1]); wk.y = pg8::cvt_pk_bf16(kv[2], kv[3]); wk.z = pg8::cvt_pk_bf16(kv[4], kv[5]); wk.w = pg8::cvt_pk_bf16(kv[6], kv[7]);
            *(LAS u32x4_t*)(lds + GKB_ + cidx * LD64 + jg * 16) = wk; }
        lds_barrier(); __builtin_amdgcn_sched_barrier(0); GDN_RELANE();
        SEC_MARK(5);
#pragma unroll
        for (int ks = 0; ks < 4; ++ks) { __builtin_amdgcn_sched_barrier(0); const bf16x8_t bb = lfrag(lds, GST_, LD128, 16 * wave, 32 * ks, lane);
#pragma unroll
            for (int m = 0; m < 4; ++m) { accu[m] = MMA16(lfrag(lds, GVB_, LD128, 16 * m, 32 * ks, lane), bb, accu[m]); o[m] = MMA16(bb, lfrag(lds, GQ_, LD128, 16 * m, 32 * ks, lane), o[m]); } }
#pragma unroll
        for (int m = 0; m < 4; ++m) st_tr(lds, GV_, LD64, 16 * m, 16 * wave, accu[m], lane);
        lds_barrier(); __builtin_amdgcn_sched_barrier(0); GDN_RELANE();
        const int row0 = scan_row(dir, b, 64 * c), sgn = dir ? -1 : 1;
        SEC_MARK(6);
#pragma unroll
        for (int ks = 0; ks < 2; ++ks) { __builtin_amdgcn_sched_barrier(0); const bf16x8_t bb = lfrag(lds, GV_, LD64, 16 * wave, 32 * ks, lane);
#pragma unroll
            for (int m = 0; m < 4; ++m) o[m] = MMA16(bb, lfrag(lds, GL_, LD64, 16 * m, 32 * ks, lane), o[m]); }
#pragma unroll
        for (int m = 0; m < 4; ++m) { const int i = 16 * m + l16; const int row = row0 + sgn * i;
            u32x2_t w; w.x = pg8::cvt_pk_bf16(o[m][0], o[m][1]); w.y = pg8::cvt_pk_bf16(o[m][2], o[m][3]); *(u32x2_t*)(OBout + (unsigned)((dir * NTOK + row) * B_W + h * 128 + 16 * wave + 4 * q4)) = w; }
        {
            const float gl = GF[256];
#pragma unroll
            for (int nt = 0; nt < 8; ++nt) Sacc[nt] = Sacc[nt] * gl;
#pragma unroll
            for (int ks = 0; ks < 2; ++ks) { __builtin_amdgcn_sched_barrier(0); const bf16x8_t aa = lfrag(lds, GKB_, LD64, 16 * wave, 32 * ks, lane);
#pragma unroll
                for (int nt = 0; nt < 8; ++nt) Sacc[nt] = MMA16(aa, lfrag(lds, GV_, LD64, 16 * nt, 32 * ks, lane), Sacc[nt]); }
#pragma unroll
            for (int nt = 0; nt < 8; ++nt) st_tr(lds, GST_, LD128, 16 * wave, 16 * nt, Sacc[nt], lane);
        }
        lds_barrier(); __builtin_amdgcn_sched_barrier(0); GDN_RELANE(); SEC_MARK(7);
    }
#undef GDN_LOADS
#undef GDN_RELANE
#undef SEC_MARK
}

constexpr int SP_ = 0, SQ_ = 9216, SK_ = 18432, SR_ = 27648, SPT_ = 36864, SQT_ = 46080, SL_ = 55296, ST_ = 64512, SSC_ = 73728, SAT_ = 76288, SNB_ = 85504, SPH_ = 94720, SAH_ = 103936, SCS_ = 113152, SVT_ = 129792, SDC_ = 139008, SSEG_ = 139264;
constexpr int RW_NCH = SLEN / 64, RW_UNITS = 2 * BATCH * A_H * RW_NCH;
struct S1In { float ld[8]; u32x4_t kk, ka, kd, rr, vv; };
__device__ __forceinline__ void rwkv_stage1_load(const P& p, int unit, int tid, S1In& in) {
    const int c = unit % RW_NCH, chain = unit / RW_NCH; const int h = chain % A_H, b = (chain / A_H) % BATCH, dir = chain / (A_H * BATCH);
    const int row0 = scan_row(dir, b, 64 * c), sgn = dir ? -1 : 1;
    { const int k = tid & 63, sg = tid >> 6;
#pragma unroll
      for (int tt = 0; tt < 8; ++tt) in.ld[tt] = p.RW_D()[((size_t)dir * NTOK + (row0 + sgn * (8 * sg + tt))) * A_W + h * 64 + k]; }
    { const int t = tid >> 3, kg = tid & 7; const int row = row0 + sgn * t;
      const size_t o1 = (size_t)row * A_W + h * 64 + 8 * kg, o2 = ((size_t)dir * NTOK + row) * A_W + h * 64 + 8 * kg;
      in.kk = *(const u32x4_t*)(p.RW_KK() + o1); in.ka = *(const u32x4_t*)(p.RW_KKA() + o2); in.kd = *(const u32x4_t*)(p.RW_KD() + o2); in.rr = *(const u32x4_t*)(p.RW_R() + o1); in.vv = *(const u32x4_t*)(p.RW_V() + o1); }
}
__device__ __forceinline__ void rwkv_stage1(const P& p, int unit, const S1In& in, LAS unsigned char* lds, int tid, unsigned* qctr, unsigned& qraw) {
    const int wave = __builtin_amdgcn_readfirstlane(tid >> 6); int lane = tid & 63, q4 = lane >> 4, l16 = lane & 15;
#define RW_RELANE() do { asm volatile("" : "+v"(tid)); lane = tid & 63; q4 = lane >> 4; l16 = lane & 15; } while (0)
    LAS float* CS = (LAS float*)(lds + SCS_); LAS float* DCv = (LAS float*)(lds + SDC_); LAS float* SEG = (LAS float*)(lds + SSEG_);
    {
        const int k = tid & 63, sg = tid >> 6; float x = 0.f, loc[8];
#pragma unroll
        for (int tt = 0; tt < 8; ++tt) { x += in.ld[tt]; loc[tt] = x; }
        SEG[sg * 64 + k] = x;
        for (int i2 = tid; i2 < 9216 / 16; i2 += NTHR) *(LAS u32x4_t*)(lds + ST_ + 16 * i2) = (u32x4_t){0u, 0u, 0u, 0u};
        lds_barrier();
        float pre = 0.f;
        for (int s2 = 0; s2 < sg; ++s2) pre += SEG[s2 * 64 + k];
#pragma unroll
        for (int tt = 0; tt < 8; ++tt) CS[(8 * sg + tt) * 65 + k] = loc[tt] + pre;
        if (sg == 7) DCv[k] = __expf(loc[7] + pre);
    }
    lds_barrier(); RW_RELANE();
    {
        const int t = tid >> 3, kg = tid & 7;
        float kk[8], ka[8], kd[8], rr[8], vv[8];
#pragma unroll
        for (int j = 0; j < 4; ++j) { kk[2 * j] = bflo(in.kk[j]); kk[2 * j + 1] = bfhi(in.kk[j]); ka[2 * j] = bflo(in.ka[j]); ka[2 * j + 1] = bfhi(in.ka[j]); kd[2 * j] = bflo(in.kd[j]); kd[2 * j + 1] = bfhi(in.kd[j]);
            rr[2 * j] = bflo(in.rr[j]); rr[2 * j + 1] = bfhi(in.rr[j]); vv[2 * j] = bflo(in.vv[j]); vv[2 * j + 1] = bfhi(in.vv[j]); }
        float pp[8], qq[8], kt[8], rh[8];
#pragma unroll
        for (int j = 0; j < 8; ++j) { const int k = 8 * kg + j; const float cs = CS[t * 65 + k], csm = t > 0 ? CS[(t - 1) * 65 + k] : 0.f; const float e = __expf(cs), ei = frcp(e);
            pp[j] = __expf(csm) * kk[j]; qq[j] = ka[j] * ei; kt[j] = kd[j] * ei; rh[j] = rr[j] * e; }
        u32x4_t w;
        w.x = pg8::cvt_pk_bf16(pp[0], pp[1]); w.y = pg8::cvt_pk_bf16(pp[2], pp[3]); w.z = pg8::cvt_pk_bf16(pp[4], pp[5]); w.w = pg8::cvt_pk_bf16(pp[6], pp[7]); *(LAS u32x4_t*)(lds + SP_ + t * 144 + kg * 16) = w;
        w.x = pg8::cvt_pk_bf16(qq[0], qq[1]); w.y = pg8::cvt_pk_bf16(qq[2], qq[3]); w.z = pg8::cvt_pk_bf16(qq[4], qq[5]); w.w = pg8::cvt_pk_bf16(qq[6], qq[7]); *(LAS u32x4_t*)(lds + SQ_ + t * 144 + kg * 16) = w;
        w.x = pg8::cvt_pk_bf16(kt[0], kt[1]); w.y = pg8::cvt_pk_bf16(kt[2], kt[3]); w.z = pg8::cvt_pk_bf16(kt[4], kt[5]); w.w = pg8::cvt_pk_bf16(kt[6], kt[7]); *(LAS u32x4_t*)(lds + SK_ + t * 144 + kg * 16) = w;
        w.x = pg8::cvt_pk_bf16(rh[0], rh[1]); w.y = pg8::cvt_pk_bf16(rh[2], rh[3]); w.z = pg8::cvt_pk_bf16(rh[4], rh[5]); w.w = pg8::cvt_pk_bf16(rh[6], rh[7]); *(LAS u32x4_t*)(lds + SR_ + t * 144 + kg * 16) = w;
#pragma unroll
        for (int j = 0; j < 8; ++j) { const int k = 8 * kg + j; *(LAS bf16_t*)(lds + SPT_ + k * 144 + t * 2) = f2bf(pp[j]); *(LAS bf16_t*)(lds + SQT_ + k * 144 + t * 2) = f2bf(qq[j]); *(LAS bf16_t*)(lds + SVT_ + k * 144 + t * 2) = f2bf(vv[j]); }
    }
    lds_barrier(); RW_RELANE();
    const int mt = wave >> 1, ntb = 2 * (wave & 1);
    f32x4 krm[2];
    {
        f32x4 qp[2], kp[2], qr[2];
#pragma unroll
        for (int t2 = 0; t2 < 2; ++t2) qp[t2] = kp[t2] = qr[t2] = krm[t2] = (f32x4){0.f, 0.f, 0.f, 0.f};
#pragma unroll
        for (int ks = 0; ks < 2; ++ks) { const bf16x8_t aP = lfrag(lds, SP_, 144, 16 * mt, 32 * ks, lane), aR = lfrag(lds, SR_, 144, 16 * mt, 32 * ks, lane);
#pragma unroll
            for (int t2 = 0; t2 < 2; ++t2) { const bf16x8_t bQ = lfrag(lds, SQ_, 144, 16 * (ntb + t2), 32 * ks, lane), bK = lfrag(lds, SK_, 144, 16 * (ntb + t2), 32 * ks, lane);
                qp[t2] = MMA16(bQ, aP, qp[t2]); kp[t2] = MMA16(aP, bK, kp[t2]); qr[t2] = MMA16(bQ, aR, qr[t2]); krm[t2] = MMA16(bK, aR, krm[t2]); } }
#pragma unroll
        for (int t2 = 0; t2 < 2; ++t2) {
#pragma unroll
            for (int r = 0; r < 4; ++r) {
                { const int t = 16 * mt + 4 * q4 + r, i = 16 * (ntb + t2) + l16; kp[t2][r] = t > i ? kp[t2][r] : 0.f; }
                { const int i = 16 * (ntb + t2) + 4 * q4 + r, t = 16 * mt + l16; const bool st = t > i, inc = t >= i;
                  qp[t2][r] = st ? qp[t2][r] : 0.f; qr[t2][r] = inc ? -qr[t2][r] : 0.f; krm[t2][r] = inc ? krm[t2][r] : 0.f; } }
            st_tr(lds, SL_, 144, 16 * (ntb + t2), 16 * mt, qp[t2], lane); st_tr(lds, SAT_, 144, 16 * mt, 16 * (ntb + t2), kp[t2], lane); st_tr(lds, SNB_, 144, 16 * (ntb + t2), 16 * mt, qr[t2], lane); }
    }
    lds_barrier(); RW_RELANE();
    tri_inv64<SL_, ST_, SSC_>(lds, tid);
    RW_RELANE();
    if (tid == 0) qraw = __hip_atomic_fetch_add(qctr, 1u, __ATOMIC_RELAXED, __HIP_MEMORY_SCOPE_AGENT);
    {
        f32x4 ph[2], ah[2];
#pragma unroll
        for (int t2 = 0; t2 < 2; ++t2) ph[t2] = ah[t2] = (f32x4){0.f, 0.f, 0.f, 0.f};
#pragma unroll
        for (int ks = 0; ks < 2; ++ks) { const bf16x8_t aT = lfrag(lds, ST_, 144, 16 * mt, 32 * ks, lane);
#pragma unroll
            for (int t2 = 0; t2 < 2; ++t2) { ph[t2] = MMA16(aT, lfrag(lds, SPT_, 144, 16 * (ntb + t2), 32 * ks, lane), ph[t2]); ah[t2] = MMA16(aT, lfrag(lds, SAT_, 144, 16 * (ntb + t2), 32 * ks, lane), ah[t2]); } }
#pragma unroll
        for (int t2 = 0; t2 < 2; ++t2) { st_tr(lds, SPH_, 144, 16 * mt, 16 * (ntb + t2), ph[t2], lane); st_tr(lds, SAH_, 144, 16 * mt, 16 * (ntb + t2), ah[t2], lane); }
    }
    lds_barrier(); RW_RELANE();
    {
        f32x4 rh[2], zz[2], kh[2];
#pragma unroll
        for (int t2 = 0; t2 < 2; ++t2) { zz[t2] = kh[t2] = (f32x4){0.f, 0.f, 0.f, 0.f};
            const u32x2_t rw = *(LAS const u32x2_t*)(lds + SR_ + (16 * mt + l16) * 144 + (16 * (ntb + t2) + 4 * q4) * 2);
            rh[t2] = (f32x4){bflo(rw.x), bfhi(rw.x), bflo(rw.y), bfhi(rw.y)}; }
#pragma unroll
        for (int ks = 0; ks < 2; ++ks) { const bf16x8_t aB = lfrag(lds, SNB_, 144, 16 * mt, 32 * ks, lane), aPh = lfrag(lds, SPH_, 144, 16 * mt, 32 * ks, lane), aAh = lfrag(lds, SAH_, 144, 16 * mt, 32 * ks, lane);
#pragma unroll
            for (int t2 = 0; t2 < 2; ++t2) { const bf16x8_t bPh = lfrag(lds, SPH_, 144, 16 * (ntb + t2), 32 * ks, lane), bAh = lfrag(lds, SAH_, 144, 16 * (ntb + t2), 32 * ks, lane), bQt = lfrag(lds, SQT_, 144, 16 * (ntb + t2), 32 * ks, lane);
                rh[t2] = MMA16(bPh, aB, rh[t2]); krm[t2] = MMA16(bAh, aB, krm[t2]); zz[t2] = MMA16(aPh, bQt, zz[t2]); kh[t2] = MMA16(aAh, bQt, kh[t2]); } }
#pragma unroll
        for (int t2 = 0; t2 < 2; ++t2) { const int n = 16 * (ntb + t2) + l16; const float dc = DCv[n];
#pragma unroll
            for (int r = 0; r < 4; ++r) { const int m = 16 * mt + 4 * q4 + r; zz[t2][r] = ((m == n ? 1.f : 0.f) - zz[t2][r]) * dc;
                kh[t2][r] = (bf2f(*(LAS const bf16_t*)(lds + SK_ + m * 144 + n * 2)) - kh[t2][r]) * dc; }
            st_tr(lds, SR_, 144, 16 * (ntb + t2), 16 * mt, rh[t2], lane); st_tr(lds, SL_, 144, 16 * (ntb + t2), 16 * mt, krm[t2], lane);
            st_tr(lds, SP_, 144, 16 * mt, 16 * (ntb + t2), zz[t2], lane); st_tr(lds, SQ_, 144, 16 * mt, 16 * (ntb + t2), kh[t2], lane); }
    }
    lds_barrier(); RW_RELANE();
    {
        const int row = tid >> 3, c16 = tid & 7; bf16_t* ob = p.RWC() + (size_t)unit * 5 * 4096 + row * 64 + c16 * 8;
        *(u32x4_t*)(ob) = *(LAS const u32x4_t*)(lds + SR_ + row * 144 + c16 * 16);
        *(u32x4_t*)(ob + 4096) = *(LAS const u32x4_t*)(lds + SL_ + row * 144 + c16 * 16);
        *(u32x4_t*)(ob + 2 * 4096) = *(LAS const u32x4_t*)(lds + SP_ + row * 144 + c16 * 16);
        *(u32x4_t*)(ob + 3 * 4096) = *(LAS const u32x4_t*)(lds + SQ_ + row * 144 + c16 * 16);
        *(u32x4_t*)(ob + 4 * 4096) = *(LAS const u32x4_t*)(lds + SVT_ + row * 144 + c16 * 16);
    }
    lds_barrier();
#undef RW_RELANE
}
constexpr int S2_M = 0  , S2_S = 46080, S2_HALF = 55296;
__device__ __forceinline__ void rwkv_stage2(const P& p, int pair, bf16_t* YAout, LAS unsigned char* lds0, int tid) {
    const int wave = __builtin_amdgcn_readfirstlane(tid >> 6), half = wave >> 2, w4 = wave & 3; int lane = tid & 63, q4 = lane >> 4, l16 = lane & 15;
    const int chain = 2 * pair + half; const int h = chain % A_H, b = (chain / A_H) % BATCH, dir = chain / (A_H * BATCH);
    LAS unsigned char* lds = lds0 + half * S2_HALF; int t2 = tid & 255;
    for (int i = t2; i < 9216 / 16; i += 256) *(LAS u32x4_t*)(lds + S2_S + 16 * i) = (u32x4_t){0u, 0u, 0u, 0u};
    u32x4_t pre[10];
#define S2_LOADS(cc) do { const bf16_t* ib = p.RWC() + ((size_t)chain * RW_NCH + (cc)) * 5 * 4096; \
        _Pragma("unroll") for (int u = 0; u < 10; ++u) pre[u] = *(const u32x4_t*)(ib + (size_t)(t2 + 256 * u) * 8); } while (0)
    S2_LOADS(0);
#pragma unroll 1
    for (int c = 0; c < RW_NCH; ++c) {
        asm volatile("" : "+v"(tid)); lane = tid & 63; q4 = lane >> 4; l16 = lane & 15; t2 = tid & 255;
#pragma unroll
        for (int u = 0; u < 10; ++u) { const int piece = t2 + 256 * u, mat = piece >> 9, within = piece & 511; *(LAS u32x4_t*)(lds + S2_M + mat * 9216 + (within >> 3) * 144 + (within & 7) * 16) = pre[u]; }
        if (c + 1 < RW_NCH) S2_LOADS(c + 1);
        lds_barrier();
        f32x4 y[4], sn[4];
#pragma unroll
        for (int nt = 0; nt < 4; ++nt) y[nt] = sn[nt] = (f32x4){0.f, 0.f, 0.f, 0.f};
#pragma unroll
        for (int ks = 0; ks < 2; ++ks) {
            const bf16x8_t aR = lfrag(lds, S2_M, 144, 16 * w4, 32 * ks, lane), aM = lfrag(lds, S2_M + 9216, 144, 16 * w4, 32 * ks, lane);
            const bf16x8_t aS = lfrag(lds, S2_S, 144, 16 * w4, 32 * ks, lane), aV = lfrag(lds, S2_M + 4 * 9216, 144, 16 * w4, 32 * ks, lane);
#pragma unroll
            for (int nt = 0; nt < 4; ++nt) { const int n0 = 16 * nt;
                y[nt] = MMA16(lfrag(lds, S2_S, 144, n0, 32 * ks, lane), aR, y[nt]); y[nt] = MMA16(lfrag(lds, S2_M + 4 * 9216, 144, n0, 32 * ks, lane), aM, y[nt]);
                sn[nt] = MMA16(aS, lfrag(lds, S2_M + 2 * 9216, 144, n0, 32 * ks, lane), sn[nt]); sn[nt] = MMA16(aV, lfrag(lds, S2_M + 3 * 9216, 144, n0, 32 * ks, lane), sn[nt]); } }
        const int row0 = scan_row(dir, b, 64 * c), sgn = dir ? -1 : 1;
#pragma unroll
        for (int nt = 0; nt < 4; ++nt) { const int t = 16 * w4 + l16; u32x2_t w; w.x = pg8::cvt_pk_bf16(y[nt][0], y[nt][1]); w.y = pg8::cvt_pk_bf16(y[nt][2], y[nt][3]);
            *(u32x2_t*)(YAout + (unsigned)((dir * NTOK + row0 + sgn * t) * A_W + h * 64 + 16 * nt + 4 * q4)) = w; }
        lds_barrier();
#pragma unroll
        for (int nt = 0; nt < 4; ++nt) st_rm(lds, S2_S, 144, 16 * w4, 16 * nt, sn[nt], lane);
        lds_barrier();
    }
#undef S2_LOADS
}

constexpr int AT_K = 0  , AT_V = 18432  , ATT_NLAT = BATCH * 4 * (SEQ / 256), ATT_NCTX = BATCH * 4 * (CTXL / 256);
__device__ __forceinline__ void attn_unit(const P& p, int unit, LAS unsigned char* lds, int tid) {
    const int wave = __builtin_amdgcn_readfirstlane(tid >> 6); int lane = tid & 63, q4 = lane >> 4, l16 = lane & 15;
    int b, hq, qrow0, nt; bool lat;
    if (unit < ATT_NLAT) { lat = true; b = unit / (4 * (SEQ / 256)); hq = (unit / (SEQ / 256)) % 4; qrow0 = b * SEQ + 256 * (unit % (SEQ / 256)); nt = SLEN / 64; }
    else { const int u2 = unit - ATT_NLAT; lat = false; b = u2 / (4 * (CTXL / 256)); hq = (u2 / (CTXL / 256)) % 4; qrow0 = NLAT + b * CTXL + 256 * (u2 % (CTXL / 256)); nt = CTXL / 64; }
    const int kvh = hq >> 1; qrow0 += 32 * wave;
    bf16x8_t qf[2][2];
#pragma unroll
    for (int qt = 0; qt < 2; ++qt)
#pragma unroll
        for (int ks = 0; ks < 2; ++ks) qf[qt][ks] = *(const bf16x8_t*)(p.CQ() + (size_t)(qrow0 + 16 * qt + l16) * 256 + hq * 64 + 32 * ks + 8 * q4);
    f32x4 o[2][4]; float mrun[2], lrun[2];
#pragma unroll
    for (int qt = 0; qt < 2; ++qt) { mrun[qt] = 0.f; lrun[qt] = 0.f;
#pragma unroll
        for (int dt = 0; dt < 4; ++dt) o[qt][dt] = (f32x4){0.f, 0.f, 0.f, 0.f}; }
    u32x4_t pk, pv;
#define AT_ROWBASE(t) ((lat && (t) < SEQ / 64) ? b * SEQ + 64 * (t) : NLAT + b * CTXL + 64 * ((t) - (lat ? SEQ / 64 : 0)))
#define AT_LOAD(t) do { const size_t ro = (size_t)(AT_ROWBASE(t) + (tid >> 3)) * 128 + kvh * 64 + (tid & 7) * 8; pk = *(const u32x4_t*)(p.CK() + ro); \
        pv = *(const u32x4_t*)(p.CV() + ((size_t)(b * 2 + kvh) * 64 + (tid >> 3)) * SLEN + (lat ? 0 : SEQ) + 64 * (t) + (tid & 7) * 8); } while (0)
#define AT_STORE(buf) do { const int rw = tid >> 3, c16 = tid & 7; *(LAS u32x4_t*)(lds + AT_K + (buf) * 9216 + rw * 144 + c16 * 16) = pk; *(LAS u32x4_t*)(lds + AT_V + (buf) * 9216 + rw * 144 + c16 * 16) = pv; } while (0)
    AT_LOAD(0); AT_STORE(0);
    lds_barrier();
#pragma unroll 1
    for (int t = 0; t < nt; ++t) {
        asm volatile("" : "+v"(tid)); lane = tid & 63; q4 = lane >> 4; l16 = lane & 15;
        const int buf = t & 1;
        if (t + 1 < nt) AT_LOAD(t + 1);
        f32x4 s[2][4];
#pragma unroll
        for (int qt = 0; qt < 2; ++qt)
#pragma unroll
            for (int kt = 0; kt < 4; ++kt) s[qt][kt] = (f32x4){-mrun[qt], -mrun[qt], -mrun[qt], -mrun[qt]};
#pragma unroll
        for (int ks = 0; ks < 2; ++ks)
#pragma unroll
            for (int kt = 0; kt < 4; ++kt) { const bf16x8_t ak = lfrag(lds, AT_K + buf * 9216, 144, 16 * kt, 32 * ks, lane);
                s[0][kt] = MMA16(ak, qf[0][ks], s[0][kt]); s[1][kt] = MMA16(ak, qf[1][ks], s[1][kt]); }
        bf16x8_t pb[2][2];
#pragma unroll
        for (int qt = 0; qt < 2; ++qt) {
            float mx = s[qt][0][0];
#pragma unroll
            for (int kt = 0; kt < 4; ++kt)
#pragma unroll
                for (int r = 0; r < 4; ++r) mx = fmaxf(mx, s[qt][kt][r]);
            mx = fmaxf(mx, __shfl_xor(mx, 16)); mx = fmaxf(mx, __shfl_xor(mx, 32));
            if (__any(mx > 6.0f) || t == 0) { const float dl = (t == 0) ? mx : fmaxf(mx, 0.f), alpha = __builtin_amdgcn_exp2f(-dl); mrun[qt] += dl; lrun[qt] *= alpha;
#pragma unroll
                for (int kt = 0; kt < 4; ++kt) s[qt][kt] = s[qt][kt] - dl;
#pragma unroll
                for (int dt = 0; dt < 4; ++dt) o[qt][dt] = o[qt][dt] * alpha; }
            float ps = 0.f;
#pragma unroll
            for (int kt = 0; kt < 4; ++kt)
#pragma unroll
                for (int r = 0; r < 4; ++r) { const float e = __builtin_amdgcn_exp2f(s[qt][kt][r]); s[qt][kt][r] = e; ps += e; }
            lrun[qt] += ps;
#pragma unroll
            for (int k2 = 0; k2 < 2; ++k2) { u32x4_t w; w.x = pg8::cvt_pk_bf16(s[qt][2 * k2][0], s[qt][2 * k2][1]); w.y = pg8::cvt_pk_bf16(s[qt][2 * k2][2], s[qt][2 * k2][3]);
                w.z = pg8::cvt_pk_bf16(s[qt][2 * k2 + 1][0], s[qt][2 * k2 + 1][1]); w.w = pg8::cvt_pk_bf16(s[qt][2 * k2 + 1][2], s[qt][2 * k2 + 1][3]); pb[qt][k2] = __builtin_bit_cast(bf16x8_t, w); }
        }
#pragma unroll
        for (int k2 = 0; k2 < 2; ++k2)
#pragma unroll
            for (int dt = 0; dt < 4; ++dt) { LAS const unsigned char* vp = lds + AT_V + buf * 9216 + (16 * dt + l16) * 144 + (32 * k2 + 4 * q4) * 2;
                const u32x2_t lo = *(LAS const u32x2_t*)vp, hi = *(LAS const u32x2_t*)(vp + 32); u32x4_t w; w.x = lo.x; w.y = lo.y; w.z = hi.x; w.w = hi.y; const bf16x8_t av = __builtin_bit_cast(bf16x8_t, w);
                o[0][dt] = MMA16(av, pb[0][k2], o[0][dt]); o[1][dt] = MMA16(av, pb[1][k2], o[1][dt]); }
        if (t + 1 < nt) AT_STORE(buf ^ 1);
        lds_barrier();
    }
#pragma unroll
    for (int qt = 0; qt < 2; ++qt) { float l = lrun[qt]; l += __shfl_xor(l, 16); l += __shfl_xor(l, 32); const float inv = 1.0f / l;
        bf16_t* orow = p.MIX() + (size_t)(qrow0 + 16 * qt + l16) * D + 768 + hq * 64 + 4 * q4;
#pragma unroll
        for (int dt = 0; dt < 4; ++dt) { u32x2_t w; w.x = pg8::cvt_pk_bf16(o[qt][dt][0] * inv, o[qt][dt][1] * inv); w.y = pg8::cvt_pk_bf16(o[qt][dt][2] * inv, o[qt][dt][3] * inv); *(u32x2_t*)(orow + 16 * dt) = w; } }
#undef AT_ROWBASE
#undef AT_LOAD
#undef AT_STORE
}


__device__ __forceinline__ void wave_rows(int nrows, int nblk, int blk, int wave, int& r0, int& r1) {
    const int nw = nblk * NWAVES, per = (nrows + nw - 1) / nw, gwl = blk * NWAVES + wave; r0 = gwl * per; r1 = r0 + per; if (r1 > nrows) r1 = nrows; if (r0 > nrows) r0 = nrows;
}
__device__ __forceinline__ float sigm(float x) { return __builtin_amdgcn_rcpf(1.0f + __expf(-x)); }
struct P0Cv { u32x4_t cv[5]; };
struct P0Sm { u32x4_t lr[3]; u32x2_t aq, ak, av; float ga, gb; };
__device__ __forceinline__ void prep0_load_cv(const P& p, int m, int which, int lane, P0Cv& in) {
    int b, t, len, base; row_info(m, b, t, len, base);
#pragma unroll
    for (int j = 0; j < 5; ++j) { const int tt = t + j - 2; in.cv[j] = (tt >= 0 && tt < len) ? *(const u32x4_t*)(p.U() + (size_t)(base + tt) * INP + B_OFF + which * B_W + 8 * lane) : (u32x4_t){0u, 0u, 0u, 0u}; }
}
__device__ __forceinline__ void prep0_compute_cv(const P& p, int l, int m, int which, int lane, const P0Cv& in, const f32x4_t (&cwr)[5][2]) {
    float acc[8];
#pragma unroll
    for (int c = 0; c < 8; ++c) acc[c] = 0.f;
#pragma unroll
    for (int j = 0; j < 5; ++j) { const u32x4_t uv = in.cv[j];
        const f32x4_t w0 = cwr[j][0], w1 = cwr[j][1];
        acc[0] += bflo(uv.x) * w0.x; acc[1] += bfhi(uv.x) * w0.y; acc[2] += bflo(uv.y) * w0.z; acc[3] += bfhi(uv.y) * w0.w;
        acc[4] += bflo(uv.z) * w1.x; acc[5] += bfhi(uv.z) * w1.y; acc[6] += bflo(uv.w) * w1.z; acc[7] += bfhi(uv.w) * w1.w; }
    float ss = 0.f;
#pragma unroll
    for (int c = 0; c < 8; ++c) { acc[c] = acc[c] * sigm(acc[c]); ss += acc[c] * acc[c]; }
    float rn = 1.0f;
    if (which < 2) rn = (frsq(grp16_sum(ss) + 1e-6f)) * (which == 0 ? 0.08838834764831845f : 1.0f);
    u32x4_t w; w.x = pg8::cvt_pk_bf16(acc[0] * rn, acc[1] * rn); w.y = pg8::cvt_pk_bf16(acc[2] * rn, acc[3] * rn); w.z = pg8::cvt_pk_bf16(acc[4] * rn, acc[5] * rn); w.w = pg8::cvt_pk_bf16(acc[6] * rn, acc[7] * rn);
    *(u32x4_t*)((which == 0 ? p.GQ() : which == 1 ? p.GK() : p.GV()) + (size_t)m * B_W + 8 * lane) = w;
}
__device__ __forceinline__ void prep0_load_sm(const P& p, int m, int lane, P0Sm& in) {
    int b, t, len, base; row_info(m, b, t, len, base);
    const bf16_t* ur = p.U() + (size_t)m * INP; const bool hp = t > 0, hn = t + 1 < len;
    { const int c = 768 + 8 * (lane < 24 ? lane : 23); const u32x4_t z = {0u, 0u, 0u, 0u};
      in.lr[0] = *(const u32x4_t*)(ur + c); in.lr[1] = hp ? *(const u32x4_t*)(ur + c - INP) : z; in.lr[2] = hn ? *(const u32x4_t*)(ur + c + INP) : z; }
    in.aq = *(const u32x2_t*)(ur + C_OFF + 4 * lane); in.ak = *(const u32x2_t*)(ur + C_OFF + 256 + 4 * (lane & 31)); in.av = *(const u32x2_t*)(ur + C_OFF + 384 + 4 * (lane & 31));
    in.ga = bf2f(ur[B_OFF + 2048 + (lane & 7)]); in.gb = bf2f(ur[B_OFF + 2056 + (lane & 7)]);
}
struct P0Par { f32x4_t m0, m1, qn, kn; float dtb, alog; };
__device__ __forceinline__ void prep0_params(const P& p, int l, int lane, P0Par& q) {
    const float* mup = p.rw_mu + l * A_IN + 768 + 8 * (lane < 24 ? lane : 23); q.m0 = *(const f32x4_t*)mup; q.m1 = *(const f32x4_t*)(mup + 4);
    q.qn = *(const f32x4_t*)(p.attn_q_norm + l * 64 + 4 * (lane & 15)); q.kn = *(const f32x4_t*)(p.attn_k_norm + l * 64 + 4 * (lane & 15));
    q.dtb = p.gdn_dt_bias[(l * 2 + ((lane & 7) >> 2)) * B_H + (lane & 3)]; q.alog = p.gdn_a_log[(l * 2 + ((lane & 7) >> 2)) * B_H + (lane & 3)];
}
__device__ __forceinline__ void prep0_compute_sm(const P& p, int l, int m, int lane, const P0Sm& in, const P0Par& par) {
    const int i16 = lane & 15; int b, t, len, base; row_info(m, b, t, len, base);
    if (lane < 32) {
        u32x4_t w = {0u, 0u, 0u, 0u};
        if (lane < 24) {
            const f32x4_t m0 = par.m0, m1 = par.m1;
            float u[8], up[8], un[8], o[8];
#pragma unroll
            for (int j = 0; j < 4; ++j) { u[2 * j] = bflo(in.lr[0][j]); u[2 * j + 1] = bfhi(in.lr[0][j]); up[2 * j] = bflo(in.lr[1][j]); up[2 * j + 1] = bfhi(in.lr[1][j]); un[2 * j] = bflo(in.lr[2][j]); un[2 * j + 1] = bfhi(in.lr[2][j]); }
            const int grp = lane >> 3;
#pragma unroll
            for (int j = 0; j < 8; ++j) { const float mu = j < 4 ? m0[j & 3] : m1[j & 3]; const float v = u[j] + mu * (0.5f * (up[j] + un[j]) - u[j]);
                const float e = __expf(grp == 0 ? 2.0f * v : -v), rc = frcp(1.0f + e); o[j] = grp == 0 ? 1.0f - 2.0f * rc : (grp == 1 ? v : rc); }
            w.x = pg8::cvt_pk_bf16(o[0], o[1]); w.y = pg8::cvt_pk_bf16(o[2], o[3]); w.z = pg8::cvt_pk_bf16(o[4], o[5]); w.w = pg8::cvt_pk_bf16(o[6], o[7]);
        }
        *(u32x4_t*)(p.LRT() + (size_t)m * 256 + 8 * lane) = w;
    }
    if (lane < 8) {
        const float xs = in.ga + par.dtb; const float sp = xs > 20.f ? xs : __logf(1.0f + __expf(xs));
        p.GG()[(size_t)m * 8 + lane] = -__expf(par.alog) * sp; p.GBETA()[(size_t)m * 8 + lane] = sigm(in.gb); }
    {
        const int i = i16; f32x4_t cs = {1.f, 1.f, 1.f, 1.f}, sn = {0.f, 0.f, 0.f, 0.f};
        if (m < NLAT) { cs = *(const f32x4_t*)(p.ROPE() + (size_t)t * 128 + 4 * i); sn = *(const f32x4_t*)(p.ROPE() + (size_t)t * 128 + 64 + 4 * i); }
        const float sgn = (i & 4) ? 1.f : -1.f;
        {
            const f32x4_t x = bf4(in.aq); const float rstd = (frsq(grp16_sum(hsq4(x)) * (1.0f / 64.f) + 1e-6f)) * 0.18033688011112042f;
            const f32x4_t nw = par.qn; f32x4_t y = x * rstd * nw, o;
#pragma unroll
            for (int c = 0; c < 4; ++c) { const float pr = __shfl_xor(y[c], 4); o[c] = y[c] * cs[c] + sgn * pr * sn[c]; }
            *(u32x2_t*)(p.CQ() + (size_t)m * 256 + 4 * lane) = pk4(o);
        }
        {
            const f32x4_t x = bf4(in.ak); const float rstd = frsq(grp16_sum(hsq4(x)) * (1.0f / 64.f) + 1e-6f);
            const f32x4_t nw = par.kn; f32x4_t y = x * rstd * nw, o;
#pragma unroll
            for (int c = 0; c < 4; ++c) { const float pr = __shfl_xor(y[c], 4); o[c] = y[c] * cs[c] + sgn * pr * sn[c]; }
            if (lane < 32) { *(u32x2_t*)(p.CK() + (size_t)m * 128 + 4 * lane) = pk4(o);
                const u32x2_t vv = in.av; const int key = m < NLAT ? t : SEQ + t;
                bf16_t* vt = p.CV() + ((size_t)(b * 2 + (lane >> 4)) * 64 + 4 * (lane & 15)) * SLEN + key;
                vt[0] = (bf16_t)(vv.x & 0xffffu); vt[SLEN] = (bf16_t)(vv.x >> 16); vt[2 * SLEN] = (bf16_t)(vv.y & 0xffffu); vt[3 * SLEN] = (bf16_t)(vv.y >> 16); }
        }
    }
}
__device__ __forceinline__ u32x4_t prep0_row(const P& p, int row, int which, int lane) {
    return (row >= 0 && row < NTOK) ? *(const u32x4_t*)(p.U() + (size_t)row * INP + B_OFF + which * B_W + 8 * lane) : (u32x4_t){0u, 0u, 0u, 0u};
}
__device__ __forceinline__ void dev_prep0(const P& p, int l, int G, int wave, int lane) {
    const int per = (NTOK + G - 1) / G, t0 = (int)blockIdx.x * per, t1 = (t0 + per < NTOK) ? t0 + per : NTOK;
#ifdef PT_P0
    const unsigned long long tp0_ = __builtin_amdgcn_s_memrealtime();
#endif
    {
        const int pw = (per + NWAVES - 1) / NWAVES, r0 = t0 + wave * pw, r1 = (r0 + pw < t1) ? r0 + pw : t1;
#pragma unroll 1
        for (int which = 0; which < 3; ++which) {
            if (r0 >= r1) break;
            f32x4_t cwr[5][2];
#pragma unroll
            for (int j = 0; j < 5; ++j) { const float* cw = p.gdn_conv + ((size_t)l * 5 + j) * (3 * B_W) + which * B_W + 8 * lane; cwr[j][0] = *(const f32x4_t*)cw; cwr[j][1] = *(const f32x4_t*)(cw + 4); }
            u32x4_t w0 = prep0_row(p, r0 - 2, which, lane), w1 = prep0_row(p, r0 - 1, which, lane), w2 = prep0_row(p, r0, which, lane), w3 = prep0_row(p, r0 + 1, which, lane);
            u32x4_t n0 = prep0_row(p, r0 + 2, which, lane), n1 = prep0_row(p, r0 + 3, which, lane);
            for (int m = r0; m < r1; m += 2) {
                const u32x4_t w4 = n0, w5 = n1; n0 = prep0_row(p, m + 4, which, lane); n1 = prep0_row(p, m + 5, which, lane);
                {
                    int b, t, len, base; row_info(m, b, t, len, base); P0Cv use; use.cv[0] = w0; use.cv[1] = w1; use.cv[2] = w2; use.cv[3] = w3; use.cv[4] = w4;
#pragma unroll
                    for (int j = 0; j < 5; ++j) { const int tt = t + j - 2; if (tt < 0 || tt >= len) use.cv[j] = (u32x4_t){0u, 0u, 0u, 0u}; }
                    prep0_compute_cv(p, l, m, which, lane, use, cwr);
                }
                if (m + 1 < r1) {
                    int b, t, len, base; row_info(m + 1, b, t, len, base); P0Cv use; use.cv[0] = w1; use.cv[1] = w2; use.cv[2] = w3; use.cv[3] = w4; use.cv[4] = w5;
#pragma unroll
                    for (int j = 0; j < 5; ++j) { const int tt = t + j - 2; if (tt < 0 || tt >= len) use.cv[j] = (u32x4_t){0u, 0u, 0u, 0u}; }
                    prep0_compute_cv(p, l, m + 1, which, lane, use, cwr);
                }
                w0 = w2; w1 = w3; w2 = w4; w3 = w5;
            }
        }
    }
#ifdef PT_P0
    const unsigned long long tp1_ = __builtin_amdgcn_s_memrealtime();
#endif
    const int first = t0 + wave, ntk = first < t1 ? (t1 - first + NWAVES - 1) / NWAVES : 0;
    {
        P0Par par; prep0_params(p, l, lane, par);
        P0Sm cur; if (ntk > 0) prep0_load_sm(p, first, lane, cur);
        for (int i = 0; i < ntk; ++i) { const int m = first + i * NWAVES; P0Sm nxt = cur; if (i + 1 < ntk) prep0_load_sm(p, m + NWAVES, lane, nxt); prep0_compute_sm(p, l, m, lane, cur, par); cur = nxt; }
    }
#ifdef PT_P0
    { const unsigned long long tp2_ = __builtin_amdgcn_s_memrealtime(); const unsigned d_ = PT_P0 == 1 ? (unsigned)(tp1_ - tp0_) : (unsigned)(tp2_ - tp1_); if (lane == 0) atomicMax(p.ctl() + 12070 + l, d_); }
#endif
}
__device__ __forceinline__ void dev_build_rope(const P& p, long gtid, long nthr) {
    for (long e = gtid; e < (long)SEQ * 64; e += nthr) { const int t = (int)(e >> 6), d = (int)(e & 63); const float pos = d < 32 ? (float)(t / GRID_W) : (float)(t % GRID_W);
        const float ang = pos * exp2f(-0.8304820237218406f * (float)(d & 15)); p.ROPE()[(size_t)t * 128 + d] = cosf(ang); p.ROPE()[(size_t)t * 128 + 64 + d] = sinf(ang); }
}
struct A1In { u32x2_t u[3][3]; u32x2_t lro[5]; };
__device__ __forceinline__ void prepA1_load(const P& p, int m, int lane, A1In& in) {
    int b, t, len, base; row_info(m, b, t, len, base);
    const bf16_t* ur = p.U() + (size_t)m * INP; const bool hp = t > 0, hn = t + 1 < len; const u32x2_t z = {0u, 0u};
#pragma unroll
    for (int a = 0; a < 3; ++a) { const int c = 256 * a + 4 * lane; in.u[a][1] = *(const u32x2_t*)(ur + c); in.u[a][0] = hp ? *(const u32x2_t*)(ur + c - INP) : z; in.u[a][2] = hn ? *(const u32x2_t*)(ur + c + INP) : z; }
    const bf16_t* lo = p.LRO() + (size_t)m * 1280 + 4 * lane;
#pragma unroll
    for (int g = 0; g < 5; ++g) in.lro[g] = *(const u32x2_t*)(lo + 256 * g);
}
__device__ __forceinline__ void dev_prepA1(const P& p, int l, int gw, int ngw, int lane) {
    const int h = lane >> 4;
    const f32x4_t kkp = *(const f32x4_t*)(p.rw_k_k + l * A_W + 4 * lane), kap = *(const f32x4_t*)(p.rw_k_a + l * A_W + 4 * lane), rkp = *(const f32x4_t*)(p.rw_r_k + l * A_W + 4 * lane);
    f32x4_t mu3[3], w0p[2], a0p[2];
#pragma unroll
    for (int a = 0; a < 3; ++a) mu3[a] = *(const f32x4_t*)(p.rw_mu + l * A_IN + 256 * a + 4 * lane);
#pragma unroll
    for (int dir = 0; dir < 2; ++dir) { w0p[dir] = *(const f32x4_t*)(p.rw_w0 + (l * 2 + dir) * A_W + 4 * lane); a0p[dir] = *(const f32x4_t*)(p.rw_a0 + (l * 2 + dir) * A_W + 4 * lane); }
    int m = gw; if (m >= NTOK) return;
    A1In cur; prepA1_load(p, m, lane, cur);
    for (; m < NTOK; m += ngw) {
        A1In nxt = cur; if (m + ngw < NTOK) prepA1_load(p, m + ngw, lane, nxt);
        f32x4_t rkv[3];
#pragma unroll
        for (int a = 0; a < 3; ++a) { const f32x4_t u = bf4(cur.u[a][1]); rkv[a] = u + mu3[a] * (0.5f * (bf4(cur.u[a][0]) + bf4(cur.u[a][2])) - u); }
        const f32x4_t r = rkv[0], k = rkv[1], v = rkv[2];
        const f32x4_t kx = k * kkp; const float rn = frsq(grp16_sum(hsq4(kx)) + 1e-6f); const f32x4_t kk = kx * rn;
        f32x4_t kdsum = {0.f, 0.f, 0.f, 0.f};
#pragma unroll
        for (int dir = 0; dir < 2; ++dir) {
            const f32x4_t w = w0p[dir] + bf4(cur.lro[dir]);
            const f32x4_t a = a0p[dir] + bf4(cur.lro[2 + dir]);
            f32x4_t ld, ic;
#pragma unroll
            for (int c = 0; c < 4; ++c) { const float nw = -w[c]; const float sp = nw > 20.f ? nw : __logf(1.0f + __expf(nw)); ld[c] = -__expf(-sp - 0.5f); ic[c] = sigm(a[c]); }
            const f32x4_t kd = k * (1.0f + (ic - 1.0f) * kap); kdsum = kdsum + kd;
            const size_t o = ((size_t)dir * NTOK + m) * A_W + 4 * lane;
            *(f32x4_t*)(p.RW_D() + o) = ld; *(u32x2_t*)(p.RW_KD() + o) = pk4(kd); *(u32x2_t*)(p.RW_KKA() + o) = pk4(kk * ic);
        }
        const size_t o1 = (size_t)m * A_W + 4 * lane;
        *(u32x2_t*)(p.RW_R() + o1) = pk4(r); *(u32x2_t*)(p.RW_V() + o1) = pk4(v); *(u32x2_t*)(p.RW_KK() + o1) = pk4(kk); *(u32x2_t*)(p.RW_GATE() + o1) = cur.lro[4];
        const float bon = grp16_sum(hsum4(r * kdsum * rkp));
        if ((lane & 15) == 0) p.RW_BON()[(size_t)m * A_H + h] = bon;
        cur = nxt;
    }
}
__device__ __forceinline__ void dev_build_wlr(const P& p, int l, long gtid, long nthr) {
    for (long e = gtid; e < 1280L * 256; e += nthr) { const int n = (int)(e >> 8), k = (int)(e & 255), g = n >> 8, ch = n & 255; float v = 0.f;
        if (g < 2) { if ((k >> 5) == g) v = p.rw_w2[((size_t)(l * 2 + g) * 32 + (k & 31)) * A_W + ch]; }
        else if (g < 4) { if ((k >> 5) == g) v = p.rw_a2[((size_t)(l * 2 + (g - 2)) * 32 + (k & 31)) * A_W + ch]; }
        else { if (k >= 128 && k < 192) v = p.rw_g2[((size_t)l * 64 + (k - 128)) * A_W + ch]; }
        p.WLR_T(l)[e] = f2bf(v); }
}

constexpr int RING_BYTES = 131072, MISC_OFF = 147200, LDS_BYTES = 147456;
constexpr size_t MiB = 1u << 20;
constexpr int CW_BAR = 4096, CW_CNT = 8192;

__device__ __forceinline__ void transpose_item(const float* W, int K, int N, bf16_t* WT, LAS float* scr, int item, int lane) {
    const int nblk_k = K / 64; const int nb = item / nblk_k, kb = item % nblk_k, k0 = 64 * kb, n0 = 64 * nb;
    const int nl = 4 * (lane & 15), kq = lane >> 4;
    f32x4 v[16];
#pragma unroll
    for (int i = 0; i < 16; ++i) { const float* src = W + (size_t)(k0 + 4 * i + kq) * N + n0 + nl;
        if (n0 + nl + 3 < N) v[i] = *(const f32x4*)src;
        else { v[i] = (f32x4){0.f, 0.f, 0.f, 0.f}; if (n0 + nl < N) v[i][0] = src[0]; if (n0 + nl + 1 < N) v[i][1] = src[1]; if (n0 + nl + 2 < N) v[i][2] = src[2]; } }
#pragma unroll
    for (int i = 0; i < 16; ++i) { LAS float* d = scr + (4 * i + kq) * 65 + nl; d[0] = v[i][0]; d[1] = v[i][1]; d[2] = v[i][2]; d[3] = v[i][3]; }
    asm volatile("s_waitcnt lgkmcnt(0)" ::: "memory");
    const int c = lane & 7;
#pragma unroll
    for (int j = 0; j < 8; ++j) { const int n = (lane >> 3) + 8 * j; const LAS float* sp = scr + (8 * c) * 65 + n;
        pg8::u32x4 o; o.x = pg8::cvt_pk_bf16(sp[0 * 65], sp[1 * 65]); o.y = pg8::cvt_pk_bf16(sp[2 * 65], sp[3 * 65]); o.z = pg8::cvt_pk_bf16(sp[4 * 65], sp[5 * 65]); o.w = pg8::cvt_pk_bf16(sp[6 * 65], sp[7 * 65]);
        *(pg8::u32x4*)(WT + (size_t)(n0 + n) * K + k0 + 8 * c) = o; }
    asm volatile("s_waitcnt lgkmcnt(0)" ::: "memory");
}

struct Args { P p; int ph_lo, ph_hi; };

#define RUN_TASKS(ntasks, call) do { const long _n = (long)(ntasks); for (long task = gtid; task < _n; task += nthr) { call; } } while (0)


__device__ __forceinline__ void dev_mod(const P& p, int cg, LAS unsigned char* lds, int tid) {
    LAS float* STB = (LAS float*)lds; LAS float* PT = (LAS float*)(lds + 69632);
    const int lane = tid & 63, wave = tid >> 6; const int lyr = cg / 96, j0 = (cg % 96) * 64;
    for (int idx = tid; idx < (BATCH + 1) * D; idx += NTHR) { const int r = idx >> 10, k = idx & 1023; const float v = r < BATCH ? p.c[(size_t)r * D + k] : p.c_ctx[k]; STB[idx] = v / (1.0f + __expf(-v)); }
    __syncthreads();
    float acc[BATCH + 1];
#pragma unroll
    for (int r = 0; r <= BATCH; ++r) acc[r] = 0.f;
    const float* w = p.ada_w + ((size_t)lyr * D + 128 * wave) * 6 * D + j0 + lane;
#pragma unroll 4
    for (int k = 0; k < 128; ++k) { const float wv = w[(size_t)k * 6 * D];
#pragma unroll
        for (int r = 0; r <= BATCH; ++r) acc[r] += STB[r * D + 128 * wave + k] * wv; }
#pragma unroll
    for (int r = 0; r <= BATCH; ++r) PT[(wave * (BATCH + 1) + r) * 64 + lane] = acc[r];
    __syncthreads();
    for (int idx = tid; idx < (BATCH + 1) * 64; idx += NTHR) { const int r = idx >> 6, jj = idx & 63; float sacc = p.ada_b[(size_t)lyr * 6 * D + j0 + jj];
#pragma unroll
        for (int w2 = 0; w2 < 8; ++w2) sacc += PT[(w2 * (BATCH + 1) + r) * 64 + jj];
        p.MOD()[((size_t)lyr * (BATCH + 1) + r) * 6 * D + j0 + jj] = sacc; }
    __syncthreads();
}
constexpr int CV_I_IN = (D / 64) * (INP / 64), CV_I_OUT = (D / 64) * (D / 64), CV_I_R = (D / 64), CV_I_GU = (D / 64) * (2 * DEXP / 64), CV_I_DN = (DEXP / 64) * (D / 64);
constexpr int CV_SMALL = CV_I_IN + CV_I_OUT + CV_I_R, CV_TOTAL = CV_SMALL + NEXP * (CV_I_GU + CV_I_DN), CV_CHUNK = 8;
constexpr int CV_NCH_SMALL = (CV_SMALL + CV_CHUNK - 1) / CV_CHUNK, CV_NCH_MOE = (CV_TOTAL - CV_SMALL + CV_CHUNK - 1) / CV_CHUNK;
__device__ __forceinline__ void conv_chunk(const P& p, int l, bool moe, int chunk, LAS unsigned char* ldsp, int wave, int lane) {
    LAS float* scr = (LAS float*)(ldsp + wave * 16896);
    for (int i = 0; i < CV_CHUNK / NWAVES; ++i) {
        int r = chunk * CV_CHUNK + wave + NWAVES * i; if (moe) { r += CV_SMALL; if (r >= CV_TOTAL) break; } else if (r >= CV_SMALL) break;
        if (r < CV_I_IN) { transpose_item(p.w_in + (size_t)l * D * INW, D, INW, p.WIN_T(l), scr, r, lane); continue; } r -= CV_I_IN;
        if (r < CV_I_OUT) { transpose_item(p.w_out + (size_t)l * D * D, D, D, p.WOUT_T(l), scr, r, lane); continue; } r -= CV_I_OUT;
        if (r < CV_I_R) { transpose_item(p.router_w + (size_t)l * D * NEXP, D, NEXP, p.WR_T(l), scr, r, lane); continue; } r -= CV_I_R;
        if (r < NEXP * CV_I_GU) { const int e = r / CV_I_GU; transpose_item(p.exp_w_gu + ((size_t)l * NEXP + e) * D * 2 * DEXP, D, 2 * DEXP, p.WGU_T(l) + (size_t)e * 2 * DEXP * D, scr, r % CV_I_GU, lane); continue; } r -= NEXP * CV_I_GU;
        { const int e = r / CV_I_DN; transpose_item(p.exp_w_dn + ((size_t)l * NEXP + e) * DEXP * D, DEXP, D, p.WDN_T(l) + (size_t)e * D * DEXP, scr, r % CV_I_DN, lane); }
    }
}

__device__ __forceinline__ int q_next(unsigned* ctr, volatile LAS unsigned* slot, int tid) {
    if (tid == 0) *slot = __hip_atomic_fetch_add(ctr, 1u, __ATOMIC_RELAXED, __HIP_MEMORY_SCOPE_AGENT);
    __syncthreads(); const int v = (int)*slot; __syncthreads(); return v;
}

__device__ __forceinline__ int q_filler(unsigned* cctr, unsigned* dctr, unsigned nitems, volatile LAS unsigned* slot, int tid) {
    if (tid == 0) { const unsigned d = __hip_atomic_load(dctr, __ATOMIC_RELAXED, __HIP_MEMORY_SCOPE_AGENT); *slot = d >= nitems ? 0x7fffffffu : __hip_atomic_fetch_add(cctr, 1u, __ATOMIC_RELAXED, __HIP_MEMORY_SCOPE_AGENT); }
    __syncthreads(); const int v = (int)*slot; __syncthreads(); return v;
}

#ifndef DBG_PH
#define DBG_PH -1
#endif
#define PHON(j) (DBG_PH < 0 || DBG_PH == (j))
#define IN(k) (lo <= (k) && (k) < hi)
#define TID_NOW() (wave_s * 64 + (int)__builtin_amdgcn_mbcnt_hi(~0u, __builtin_amdgcn_mbcnt_lo(~0u, 0u)))
#define PHASE_VARS P p = args.p; asm volatile("" : "+s"(p.ws)); int tid_ = TID_NOW(); asm volatile("" : "+v"(tid_)); const int lane = tid_ & 63, wave = __builtin_amdgcn_readfirstlane(tid_ >> 6); \
    const long gtid = ((long)wave * G + blockIdx.x) * 64 + lane, nthr = (long)G * NTHR; const int gw = wave * G + blockIdx.x, ngw = G * NWAVES; (void)gw; (void)ngw; (void)gtid; (void)nthr; (void)lane;
#ifdef PROBE_T
#define SEAM(k) do { if (IN((k) + 1)) xcd_barrier(bar, TID_NOW()); if (blockIdx.x == 0 && TID_NOW() == 0) ((unsigned long long*)(args.p.ctl() + 12100))[(k) + 1] = __builtin_amdgcn_s_memrealtime(); } while (0)
#else
#define SEAM(k) do { if (IN((k) + 1)) xcd_barrier(bar, TID_NOW()); } while (0)
#endif
template <int l>
__device__ __forceinline__ void layer_body(const Args& args, const XcdBarrier& bar, LAS unsigned char* ldsp, const int G, const int wave_s, const int lo, const int hi) {
        const int pb = 1 + l * NPH;
        const bool need_ctx = l < DEPTH - 1;
        const int ntok_l = need_ctx ? NTOK : NLAT;
        if (l == 0 && PHON(0) && IN(pb + 0)) { PHASE_VARS;
            dev_norm1_l0(p, G, wave, lane);
            SEAM(pb + 0);
        }
        if (PHON(1) && IN(pb + 1)) { PHASE_VARS; (void)tid_; (void)wave;
            pg8::Gemm g{p.HB(), p.WIN_T(l), D, 0, nullptr}; pg8::StaticOrder S; S.init(NTOK, INP, G, (int)blockIdx.x);
            pg8::EpiBf16Bias E{p.U(), INP, nullptr, 0};
            pg8::gemm_phase(ldsp, g, S, E, tid_);
            SEAM(pb + 1);
        }
        if (PHON(2) && IN(pb + 2)) { PHASE_VARS; dev_prep0(p, l, G, wave, lane); SEAM(pb + 2); }
        if (PHON(3) && IN(pb + 3)) { PHASE_VARS; (void)tid_; (void)wave;
            pg8::Gemm g{p.LRT(), p.WLR_T(l), 256, 0, nullptr}; pg8::StaticOrder S; S.init(NTOK, 1280, G, (int)blockIdx.x);
            pg8::EpiBf16Bias E{p.LRO(), 1280, nullptr, 0};
            pg8::gemm_phase(ldsp, g, S, E, tid_);
            SEAM(pb + 3);
        }
        if (PHON(4) && IN(pb + 4)) { PHASE_VARS; dev_prepA1(p, l, gw, ngw, lane); SEAM(pb + 4); }
        if (PHON(5) && IN(pb + 5)) { PHASE_VARS;
            const int nchain = 2 * BATCH * B_H, nitems = nchain + RW_UNITS;
            unsigned* ctr = p.ctl() + 12200 + 64 * (2 * l); volatile LAS unsigned* slot = (volatile LAS unsigned*)(ldsp + MISC_OFF + 64);
#ifdef PROBE_GDN
            { const long nB = 2L * BATCH * B_H * 128; for (long task = gtid; task < nB; task += nthr) task_scanB(p, task); }
#endif
            unsigned long long tacc_ = 0ull, t0_ = 0ull; (void)tacc_; (void)t0_;
#ifdef PT_ACT
#define ACT_BEGIN(a) do { if (PT_ACT == (a)) t0_ = __builtin_amdgcn_s_memrealtime(); } while (0)
#define ACT_END(a) do { if (PT_ACT == (a)) tacc_ += __builtin_amdgcn_s_memrealtime() - t0_; } while (0)
#define ACT_FLUSH() do { if (tid_ == 0) atomicMax(p.ctl() + 12070 + l, (unsigned)tacc_); } while (0)
#else
#define ACT_BEGIN(a)
#define ACT_END(a)
#define ACT_FLUSH()
#endif
            int cur = q_next(ctr, slot, tid_);
            while (cur < nchain) {
                ACT_BEGIN(1); gdn_chain(p.GQ(), p.GK(), p.GV(), p.GG(), p.GBETA(), cur, p.OB(), ldsp, tid_, p.ctl()); ACT_END(1);
                if (tid_ == 0) __hip_atomic_fetch_add(ctr + 32, 1u, __ATOMIC_RELAXED, __HIP_MEMORY_SCOPE_AGENT);
                cur = q_next(ctr, slot, tid_); }
            if (cur < nitems) {
                S1In in; rwkv_stage1_load(p, cur - nchain, tid_, in);
                int nxt = q_next(ctr, slot, tid_);
                while (cur < nitems) {
                    S1In in2; const bool have2 = nxt < nitems;
                    if (have2) rwkv_stage1_load(p, nxt - nchain, tid_, in2); else in2 = in;
                    unsigned qraw = 0u;
                    ACT_BEGIN(2); rwkv_stage1(p, cur - nchain, in, ldsp, tid_, ctr, qraw); ACT_END(2);
                    if (tid_ == 0) { __hip_atomic_fetch_add(ctr + 32, 1u, __ATOMIC_RELAXED, __HIP_MEMORY_SCOPE_AGENT); *slot = qraw; }
                    lds_barrier();
                    const int nn = (int)*slot;
                    in = in2; cur = nxt; nxt = nn;
                }
                __syncthreads();
            }
            ACT_FLUSH();
            {
                unsigned* cctr = p.ctl() + 12200 + 64 * (8 + 2 * l);
                for (int ch = q_filler(cctr, ctr + 32, (unsigned)nitems, slot, tid_); ch < CV_NCH_MOE + (l + 1 < DEPTH ? CV_NCH_SMALL : 0); ch = q_filler(cctr, ctr + 32, (unsigned)nitems, slot, tid_)) {
                    if (ch < CV_NCH_MOE) conv_chunk(p, l, true, ch, ldsp, wave, lane); else conv_chunk(p, l + 1, false, ch - CV_NCH_MOE, ldsp, wave, lane); } }
            SEAM(pb + 5);
        }
        if (PHON(6) && IN(pb + 6)) { PHASE_VARS;
            const int ngb = 0, nch = ngb + BATCH * A_H, nun = ATT_NLAT + (need_ctx ? ATT_NCTX : 0);
            unsigned* ctr = p.ctl() + 12200 + 64 * (2 * l + 1); volatile LAS unsigned* slot = (volatile LAS unsigned*)(ldsp + MISC_OFF + 64);
#ifdef PROBE_RWKV
            { const long nA = 2L * BATCH * A_H * 64; for (long task = gtid; task < nA; task += nthr) task_scanA(p, task); }
#endif
            unsigned long long tacc_ = 0ull, t0_ = 0ull; (void)tacc_; (void)t0_;
            for (int cur = q_next(ctr, slot, tid_); cur < nch + nun; cur = q_next(ctr, slot, tid_)) {
                if (cur < nch) { ACT_BEGIN(3); rwkv_stage2(p, cur - ngb,
#ifdef PROBE_RWKV
                    (bf16_t*)(p.ws + WS_TOTAL),
#else
                    p.YA(),
#endif
                    ldsp, tid_); ACT_END(3); }
                else { ACT_BEGIN(4); attn_unit(p, cur - nch, ldsp, tid_); ACT_END(4); }
                if (tid_ == 0) __hip_atomic_fetch_add(ctr + 32, 1u, __ATOMIC_RELAXED, __HIP_MEMORY_SCOPE_AGENT);
            }
            ACT_FLUSH();
            {
                unsigned* cctr = p.ctl() + 12200 + 64 * (8 + 2 * l);
                for (int ch = q_filler(cctr, ctr + 32, (unsigned)(nch + nun), slot, tid_); ch < CV_NCH_MOE + (l + 1 < DEPTH ? CV_NCH_SMALL : 0); ch = q_filler(cctr, ctr + 32, (unsigned)(nch + nun), slot, tid_)) {
                    if (ch < CV_NCH_MOE) conv_chunk(p, l, true, ch, ldsp, wave, lane); else conv_chunk(p, l + 1, false, ch - CV_NCH_MOE, ldsp, wave, lane); } }
            SEAM(pb + 6);
        }
        if (PHON(7) && IN(pb + 7)) { PHASE_VARS;
#ifdef PROBE_GDN
            { float e2 = 0.f, r2 = 0.f; const bf16_t* cand = (const bf16_t*)(p.ws + WS_TOTAL); const bf16_t* ref = p.OB();
              for (long i = gtid; i < 2L * NTOK * B_W; i += nthr) { const float d = bf2f(cand[i]) - bf2f(ref[i]); e2 += d * d; r2 += bf2f(ref[i]) * bf2f(ref[i]); }
              e2 = wave_sum(e2); r2 = wave_sum(r2); if (lane == 0) { atomicAdd((float*)(p.ctl() + 12000), e2); atomicAdd((float*)(p.ctl() + 12001), r2); } }
#endif
#ifdef PROBE_RWKV
            { float e2 = 0.f, r2 = 0.f; const bf16_t* cand = (const bf16_t*)(p.ws + WS_TOTAL); const bf16_t* ref = p.YA();
              for (long i = gtid; i < 2L * NTOK * A_W; i += nthr) { const float d = bf2f(cand[i]) - bf2f(ref[i]); e2 += d * d; r2 += bf2f(ref[i]) * bf2f(ref[i]); }
              e2 = wave_sum(e2); r2 = wave_sum(r2); if (lane == 0) { atomicAdd((float*)(p.ctl() + 12000), e2); atomicAdd((float*)(p.ctl() + 12001), r2); } }
#endif
            dev_post(p, l, ntok_l, gw, ngw, lane); SEAM(pb + 7); }
        if (PHON(8) && IN(pb + 8)) { PHASE_VARS; (void)tid_; (void)wave;
            pg8::Gemm g{p.MIX(), p.WOUT_T(l), D, 0, nullptr}; pg8::StaticOrder S; S.init(ntok_l, D, G, (int)blockIdx.x);
            pg8::EpiBf16Bias E{p.MO(), D, nullptr, 0};
            pg8::gemm_phase(ldsp, g, S, E, tid_);
            SEAM(pb + 8);
        }
        if (PHON(9) && IN(pb + 9)) { PHASE_VARS; dev_resid_router(p, l, ntok_l, ldsp, G, tid_); SEAM(pb + 9); }
        if (PHON(10) && IN(pb + 10)) { PHASE_VARS; dev_slots(p, l, ntok_l, ldsp, gtid, nthr, tid_);
            {
                unsigned* cctr = p.ctl() + 12200 + 64 * (8 + 2 * l); volatile LAS unsigned* slot = (volatile LAS unsigned*)(ldsp + MISC_OFF + 64);
                for (int ch = q_next(cctr, slot, tid_); ch < CV_NCH_MOE + (l + 1 < DEPTH ? CV_NCH_SMALL : 0); ch = q_next(cctr, slot, tid_)) {
                    if (ch < CV_NCH_MOE) conv_chunk(p, l, true, ch, ldsp, wave, lane); else conv_chunk(p, l + 1, false, ch - CV_NCH_MOE, ldsp, wave, lane); } }
            SEAM(pb + 10); }
        if (PHON(12) && IN(pb + 12)) { PHASE_VARS; (void)tid_; (void)wave;
            pg8::Gemm g{p.HB(), p.WGU_T(l), D, (size_t)2 * DEXP * D, p.SLOT_TOK()}; pg8::MoeOrder S{__builtin_amdgcn_readfirstlane(p.NBLK()[0]), 2 * DEXP / 256, G, (int)blockIdx.x, p.BLOCK_E()};
            pg8::EpiSwiglu E{p.HH(), DEXP, p.exp_b_gu + (size_t)l * NEXP * 2 * DEXP, 2 * DEXP};
            pg8::gemm_phase<true>(ldsp, g, S, E, tid_);
            SEAM(pb + 12);
        }
        if (PHON(13) && IN(pb + 13)) { PHASE_VARS; (void)tid_; (void)wave;
            pg8::Gemm g{p.HH(), p.WDN_T(l), DEXP, (size_t)D * DEXP, nullptr}; pg8::MoeOrder S{__builtin_amdgcn_readfirstlane(p.NBLK()[0]), D / 256, G, (int)blockIdx.x, p.BLOCK_E()};
            pg8::EpiBf16Bias E{p.YB(), D, p.exp_b_dn + (size_t)l * NEXP * D, D};
            pg8::gemm_phase(ldsp, g, S, E, tid_);
            SEAM(pb + 13);
        }
        if (PHON(14) && IN(pb + 14)) { PHASE_VARS; dev_combine(p, l, ntok_l, G, wave, lane);
            if (l + 1 < DEPTH) SEAM(pb + 14); }
}

__global__ void __launch_bounds__(NTHR, 2) fwd_kernel(Args args) {
    extern __shared__ __attribute__((aligned(16))) unsigned char lds[];
    const P& pk = args.p;
    LAS unsigned char* ldsp = (LAS unsigned char*)lds;
    volatile LAS unsigned* MISC = (volatile LAS unsigned*)(ldsp + MISC_OFF);
    const int G = gridDim.x;
    const int wave_s = __builtin_amdgcn_readfirstlane((int)threadIdx.x >> 6);
    { const int t0 = TID_NOW(); if (t0 < 32) MISC[t0] = 0u; }
    __syncthreads();
    XcdBarrier bar = xcd_barrier_post(pk.ctl() + CW_BAR, MISC + 8, TID_NOW());
    const int lo = args.ph_lo, hi = args.ph_hi;
#ifdef PROBE_T
    if (blockIdx.x == 0 && TID_NOW() == 0) ((unsigned long long*)(pk.ctl() + 12100))[0] = __builtin_amdgcn_s_memrealtime();
#endif

    if (PHON(100) && IN(0)) { PHASE_VARS;
        for (int cg = blockIdx.x; cg < DEPTH * 96; cg += G) dev_mod(p, cg, ldsp, tid_);
        RUN_TASKS(D, p.HB()[(size_t)ZROW * D + task] = 0);
        dev_build_rope(p, gtid, nthr);
        for (int lw = 0; lw < DEPTH; ++lw) dev_build_wlr(p, lw, gtid, nthr);
        for (int ch = blockIdx.x; ch < CV_NCH_SMALL; ch += G) conv_chunk(p, 0, false, ch, ldsp, wave, lane);
        SEAM(0);
    }
    layer_body<0>(args, bar, ldsp, G, wave_s, lo, hi);
    layer_body<1>(args, bar, ldsp, G, wave_s, lo, hi);
#undef IN
#undef SEAM
}

#ifndef N_LAUNCH_MODE
#define N_LAUNCH_MODE 1
#endif
extern "C" void kernel_launch(void* const* d_in, const int* in_sizes, int n_in, void* d_out, int out_size, void* d_ws, size_t ws_size, hipStream_t stream) {
    static int grid = 0;
    if (grid == 0) {
        int dev = 0, cus = 0;
        if (hipGetDevice(&dev) != hipSuccess || hipDeviceGetAttribute(&cus, hipDeviceAttributeMultiprocessorCount, dev) != hipSuccess) { grid = -1; return; }
        if (hipFuncSetAttribute((const void*)fwd_kernel, hipFuncAttributeMaxDynamicSharedMemorySize, LDS_BYTES) != hipSuccess) { fprintf(stderr, "hipFuncSetAttribute failed\n"); grid = -1; return; }
        int per_cu = 0;
        if (hipOccupancyMaxActiveBlocksPerMultiprocessor(&per_cu, (const void*)fwd_kernel, NTHR, LDS_BYTES) != hipSuccess || per_cu < 1) fprintf(stderr, "occupancy query: %d\n", per_cu);
        (void)hipGetLastError();
        grid = cus;
    }
    if (grid < 0) return;
    unsigned char* ws = (unsigned char*)d_ws;
    (void)hipMemsetAsync(ws, 0, CTL_BYTES, stream);
    Args a{};
    P& p = a.p;
    const float* const* in = (const float* const*)d_in;
    p.x = in[0]; p.c = in[1]; p.ctx = in[2]; p.c_ctx = in[3]; p.ada_w = in[4]; p.ada_b = in[5]; p.pre_norm = in[6]; p.post_norm = in[7]; p.w_in = in[8]; p.w_out = in[9];
    p.rw_mu = in[10]; p.rw_w0 = in[11]; p.rw_w2 = in[12]; p.rw_a0 = in[13]; p.rw_a2 = in[14]; p.rw_g2 = in[15]; p.rw_k_k = in[16]; p.rw_k_a = in[17]; p.rw_r_k = in[18]; p.rw_ln_w = in[19]; p.rw_ln_b = in[20];
    p.gdn_conv = in[21]; p.gdn_a_log = in[22]; p.gdn_dt_bias = in[23]; p.gdn_norm = in[24]; p.attn_q_norm = in[25]; p.attn_k_norm = in[26];
    p.router_w = in[27]; p.router_b = in[28]; p.exp_w_gu = in[29]; p.exp_b_gu = in[30]; p.exp_w_dn = in[31]; p.exp_b_dn = in[32];
    p.out = (float*)d_out;
    p.ws = ws; p.tokf = nullptr;
#ifdef PROBE_GDN
    if (WS_TOTAL + (size_t)2 * NTOK * B_W * 4 > ws_size) { fprintf(stderr, "probe: ws too small\n"); return; }
#endif
    if (WS_TOTAL > ws_size) { fprintf(stderr, "kernel_launch: workspace too small: need %zu have %zu\n", (size_t)WS_TOTAL, ws_size); return; }
    const int nph = 1 + DEPTH * NPH;
#if N_LAUNCH_MODE == 1
    a.ph_lo = 0; a.ph_hi = nph;
    hipLaunchKernelGGL(fwd_kernel, dim3(grid), dim3(NTHR), LDS_BYTES, stream, a);
#else
    for (int ph = 0; ph < nph; ++ph) { a.ph_lo = ph; a.ph_hi = ph + 1; hipLaunchKernelGGL(fwd_kernel, dim3(grid), dim3(NTHR), LDS_BYTES, stream, a); }
#endif
}
#endif
```

```cpp
#ifndef HOST_TEST
#include <hip/hip_runtime.h>
#else
struct uint4 { unsigned x, y, z, w; };
#endif
#include <cstdio>
#include <cstdint>
#include <cmath>

#ifndef CFG_BATCH
#define CFG_BATCH 16
#define CFG_SEQ 2048
#define CFG_CTX 256
#define CFG_NEXP 32
#define CFG_DEXP 1024
#endif
constexpr int D = 1024, BATCH = CFG_BATCH, SEQ = CFG_SEQ, CTXL = CFG_CTX, DEPTH = 2, GRID_W = 64;
constexpr int NLAT = BATCH * SEQ, NCTX = BATCH * CTXL, NTOK = NLAT + NCTX;
constexpr int A_W = 256, A_H = 4, A_IN = 960;
constexpr int B_W = 512, B_H = 4, B_IN = 2064, B_OFF = 960;
constexpr int C_W = 256, C_IN = 512, C_OFF = 3024;
constexpr int INW = 3536, INP = 3584;
constexpr int NEXP = CFG_NEXP, TOPK = 4, DEXP = CFG_DEXP;
constexpr int NBLK_MAX = (NTOK * TOPK + 255) / 256 + NEXP, NSLOT = NBLK_MAX * 256;
constexpr int ZROW = NTOK;
constexpr int SLEN = CTXL + SEQ;

#ifdef HOST_TEST
#define DEVFN static inline
#define GLOBAL_ATOMIC_ADD(p, v) ((*(p)) += (v), (*(p)) - (v))
#else
#define DEVFN __device__ __forceinline__
#define GLOBAL_ATOMIC_ADD(p, v) atomicAdd((p), (v))
#endif
#ifdef HOST_TEST
#define UNIFORM(x) (x)
#define LOADFENCE()
#else
#define UNIFORM(x) __builtin_amdgcn_readfirstlane(x)
#define LOADFENCE() asm volatile("" ::: "memory")
#endif
typedef unsigned short bf16_t;
DEVFN bf16_t f2bf(float f) { unsigned u = __builtin_bit_cast(unsigned, f); return (bf16_t)((u + 0x7fffu + ((u >> 16) & 1u)) >> 16); }
DEVFN float bf2f(bf16_t b) { unsigned u = ((unsigned)b) << 16; return __builtin_bit_cast(float, u); }
DEVFN float sigmoidf_(float x) { return 1.0f / (1.0f + expf(-x)); }
DEVFN float siluf_(float x) { return x / (1.0f + expf(-x)); }
DEVFN float softplusf_(float x) { return x > 20.f ? x : log1pf(expf(x)); }

#ifdef HOST_TEST
#define WSACC inline
#else
#define WSACC __device__ __host__ __forceinline__
#endif
constexpr size_t CTL_BYTES = 64 * 1024;
constexpr size_t al256(size_t x) { return (x + 255) & ~(size_t)255; }
constexpr size_t WSO_ctl = 0;
constexpr size_t WSE_ctl = WSO_ctl + al256(CTL_BYTES);
constexpr size_t WSO_MOD = WSE_ctl;
constexpr size_t WSE_MOD = WSO_MOD + al256((size_t)DEPTH * (BATCH + 1) * 6 * D * 4);
constexpr size_t WSO_X = WSE_MOD;
constexpr size_t WSE_X = WSO_X + al256((size_t)(NTOK + 1) * D * 4);
constexpr size_t WSO_HB = WSE_X;
constexpr size_t WSE_HB = WSO_HB + al256((size_t)(NTOK + 1) * D * 2);
constexpr size_t WSO_WIN_T = WSE_HB;
constexpr size_t WSE_WIN_T = WSO_WIN_T + al256((size_t)INP * D * 2);
constexpr size_t WSO_WOUT_T = WSE_WIN_T;
constexpr size_t WSE_WOUT_T = WSO_WOUT_T + al256((size_t)D * D * 2);
constexpr size_t WSO_WR_T = WSE_WOUT_T;
constexpr size_t WSE_WR_T = WSO_WR_T + al256((size_t)64 * D * 2);
constexpr size_t WSO_WGU_T = WSE_WR_T;
constexpr size_t WSE_WGU_T = WSO_WGU_T + al256((size_t)NEXP * 2 * DEXP * D * 2);
constexpr size_t WSO_WDN_T = WSE_WGU_T;
constexpr size_t WSE_WDN_T = WSO_WDN_T + al256((size_t)NEXP * D * DEXP * 2);
constexpr size_t WSZ_WSET = WSE_WDN_T - WSO_WIN_T;
constexpr size_t WSO_TOPI = WSE_WDN_T + WSZ_WSET;
constexpr size_t WSE_TOPI = WSO_TOPI + al256((size_t)NTOK * 4 * 4);
constexpr size_t WSO_POS = WSE_TOPI;
constexpr size_t WSE_POS = WSO_POS + al256((size_t)NTOK * 4 * 4);
constexpr size_t WSO_TSLOT = WSE_POS;
constexpr size_t WSE_TSLOT = WSO_TSLOT + al256((size_t)NTOK * 4 * 4);
constexpr size_t WSO_TOPG = WSE_TSLOT;
constexpr size_t WSE_TOPG = WSO_TOPG + al256((size_t)NTOK * 4 * 4);
constexpr size_t WSO_SLOT_TOK = WSE_TOPG;
constexpr size_t WSE_SLOT_TOK = WSO_SLOT_TOK + al256((size_t)NSLOT * 4);
constexpr size_t WSO_BLOCK_E = WSE_SLOT_TOK;
constexpr size_t WSE_BLOCK_E = WSO_BLOCK_E + al256((size_t)NBLK_MAX * 4);
constexpr size_t WSO_NBLK = WSE_BLOCK_E;
constexpr size_t WSE_NBLK = WSO_NBLK + al256(256);
constexpr size_t WSO_U = WSE_NBLK;
constexpr size_t WSE_U = WSO_U + al256((size_t)NTOK * INP * 2);
constexpr size_t WSO_MO = WSE_U;
constexpr size_t WSE_MO = WSO_MO + al256((size_t)NTOK * D * 2);
constexpr size_t WSO_ROPE = WSE_MO;
constexpr size_t WSE_ROPE = WSO_ROPE + al256((size_t)SEQ * 128 * 4);
constexpr size_t WSO_WLR_T = WSE_ROPE;
constexpr size_t WSE_WLR_T = WSO_WLR_T + 2 * al256((size_t)1280 * 256 * 2);
constexpr size_t WSO_END_P = WSE_WLR_T;
constexpr size_t WSO_LR = WSO_END_P;
constexpr size_t WSE_LR = WSO_LR + al256((size_t)NTOK * 192 * 4);
#ifdef HOST_TEST
constexpr size_t WSO_RW_R = WSE_LR;
#else
constexpr size_t WSO_RW_R = WSO_LR;
#endif
constexpr size_t WSE_RW_R = WSO_RW_R + al256((size_t)NTOK * A_W * 2);
constexpr size_t WSO_RW_V = WSE_RW_R;
constexpr size_t WSE_RW_V = WSO_RW_V + al256((size_t)NTOK * A_W * 2);
constexpr size_t WSO_RW_KK = WSE_RW_V;
constexpr size_t WSE_RW_KK = WSO_RW_KK + al256((size_t)NTOK * A_W * 2);
constexpr size_t WSO_RW_D = WSE_RW_KK;
constexpr size_t WSE_RW_D = WSO_RW_D + al256((size_t)2 * NTOK * A_W * 4);
constexpr size_t WSO_RW_KD = WSE_RW_D;
constexpr size_t WSE_RW_KD = WSO_RW_KD + al256((size_t)2 * NTOK * A_W * 2);
constexpr size_t WSO_RW_KKA = WSE_RW_KD;
constexpr size_t WSE_RW_KKA = WSO_RW_KKA + al256((size_t)2 * NTOK * A_W * 2);
constexpr size_t WSO_RW_GATE = WSE_RW_KKA;
constexpr size_t WSE_RW_GATE = WSO_RW_GATE + al256((size_t)NTOK * A_W * 2);
constexpr size_t WSO_RW_BON = WSE_RW_GATE;
constexpr size_t WSE_RW_BON = WSO_RW_BON + al256((size_t)NTOK * A_H * 4);
constexpr size_t WSO_YA = WSE_RW_BON;
constexpr size_t WSE_YA = WSO_YA + al256((size_t)2 * NTOK * A_W * 2);
constexpr size_t WSO_GQ = WSE_YA;
constexpr size_t WSE_GQ = WSO_GQ + al256((size_t)NTOK * B_W * 2);
constexpr size_t WSO_GK = WSE_GQ;
constexpr size_t WSE_GK = WSO_GK + al256((size_t)NTOK * B_W * 2);
constexpr size_t WSO_GV = WSE_GK;
constexpr size_t WSE_GV = WSO_GV + al256((size_t)NTOK * B_W * 2);
constexpr size_t WSO_GG = WSE_GV;
constexpr size_t WSE_GG = WSO_GG + al256((size_t)NTOK * 8 * 4);
constexpr size_t WSO_GBETA = WSE_GG;
constexpr size_t WSE_GBETA = WSO_GBETA + al256((size_t)NTOK * 8 * 4);
constexpr size_t WSO_OB = WSE_GBETA;
constexpr size_t WSE_OB = WSO_OB + al256((size_t)2 * NTOK * B_W * 2);
constexpr size_t WSO_CQ = WSE_OB;
constexpr size_t WSE_CQ = WSO_CQ + al256((size_t)NTOK * 256 * 2);
constexpr size_t WSO_CK = WSE_CQ;
constexpr size_t WSE_CK = WSO_CK + al256((size_t)NTOK * 128 * 2);
constexpr size_t WSO_CV = WSE_CK;
constexpr size_t WSE_CV = WSO_CV + al256((size_t)NTOK * 128 * 2);
constexpr size_t WSO_RWC = WSE_CV;
constexpr size_t WSE_RWC = WSO_RWC + al256((size_t)2 * BATCH * A_H * (SLEN / 64) * 5 * 4096 * 2);
constexpr size_t WSO_LRT = WSE_RWC;
constexpr size_t WSE_LRT = WSO_LRT + al256((size_t)NTOK * 256 * 2);
constexpr size_t WSO_LRO = WSE_LRT;
constexpr size_t WSE_LRO = WSO_LRO + al256((size_t)NTOK * 1280 * 2);
constexpr size_t WSO_MIX = WSE_LRO;
constexpr size_t WSE_MIX = WSO_MIX + al256((size_t)NTOK * D * 2);
constexpr size_t WSO_XG = WSO_END_P;
constexpr size_t WSE_XG = WSO_XG + al256((size_t)NSLOT * D * 2);
constexpr size_t WSO_HH = WSE_XG;
constexpr size_t WSE_HH = WSO_HH + al256((size_t)NSLOT * DEXP * 2);
constexpr size_t WSO_YB = WSE_HH;
constexpr size_t WSE_YB = WSO_YB + al256((size_t)NSLOT * D * 2);
constexpr size_t WS_TOTAL = (WSE_MIX > WSE_YB ? WSE_MIX : WSE_YB);
struct P {
    const float *x, *c, *ctx, *c_ctx, *ada_w, *ada_b, *pre_norm, *post_norm, *w_in, *w_out;
    const float *rw_mu, *rw_w0, *rw_w2, *rw_a0, *rw_a2, *rw_g2, *rw_k_k, *rw_k_a, *rw_r_k, *rw_ln_w, *rw_ln_b;
    const float *gdn_conv, *gdn_a_log, *gdn_dt_bias, *gdn_norm, *attn_q_norm, *attn_k_norm;
    const float *router_w, *router_b, *exp_w_gu, *exp_b_gu, *exp_w_dn, *exp_b_dn;
    float* out;
    unsigned char* ws;
    WSACC unsigned* ctl() const { return (unsigned*)(ws + WSO_ctl); }
    WSACC float* MOD() const { return (float*)(ws + WSO_MOD); }
    WSACC float* X() const { return (float*)(ws + WSO_X); }
    WSACC bf16_t* HB() const { return (bf16_t*)(ws + WSO_HB); }
    WSACC bf16_t* WIN_T(int l) const { return (bf16_t*)(ws + WSO_WIN_T + (size_t)l * WSZ_WSET); }
    WSACC bf16_t* WOUT_T(int l) const { return (bf16_t*)(ws + WSO_WOUT_T + (size_t)l * WSZ_WSET); }
    WSACC bf16_t* WR_T(int l) const { return (bf16_t*)(ws + WSO_WR_T + (size_t)l * WSZ_WSET); }
    WSACC bf16_t* WGU_T(int l) const { return (bf16_t*)(ws + WSO_WGU_T + (size_t)l * WSZ_WSET); }
    WSACC bf16_t* WDN_T(int l) const { return (bf16_t*)(ws + WSO_WDN_T + (size_t)l * WSZ_WSET); }
    WSACC int* TOPI() const { return (int*)(ws + WSO_TOPI); }
    WSACC int* POS() const { return (int*)(ws + WSO_POS); }
    WSACC int* TSLOT() const { return (int*)(ws + WSO_TSLOT); }
    WSACC float* TOPG() const { return (float*)(ws + WSO_TOPG); }
    WSACC int* SLOT_TOK() const { return (int*)(ws + WSO_SLOT_TOK); }
    WSACC int* BLOCK_E() const { return (int*)(ws + WSO_BLOCK_E); }
    WSACC int* NBLK() const { return (int*)(ws + WSO_NBLK); }
    WSACC bf16_t* U() const { return (bf16_t*)(ws + WSO_U); }
    WSACC bf16_t* MO() const { return (bf16_t*)(ws + WSO_MO); }
    WSACC float* LR() const { return (float*)(ws + WSO_LR); }
    WSACC bf16_t* RW_R() const { return (bf16_t*)(ws + WSO_RW_R); }
    WSACC bf16_t* RW_V() const { return (bf16_t*)(ws + WSO_RW_V); }
    WSACC bf16_t* RW_KK() const { return (bf16_t*)(ws + WSO_RW_KK); }
    WSACC float* RW_D() const { return (float*)(ws + WSO_RW_D); }
    WSACC bf16_t* RW_KD() const { return (bf16_t*)(ws + WSO_RW_KD); }
    WSACC bf16_t* RW_KKA() const { return (bf16_t*)(ws + WSO_RW_KKA); }
    WSACC bf16_t* RW_GATE() const { return (bf16_t*)(ws + WSO_RW_GATE); }
    WSACC float* RW_BON() const { return (float*)(ws + WSO_RW_BON); }
    WSACC bf16_t* YA() const { return (bf16_t*)(ws + WSO_YA); }
    WSACC bf16_t* GQ() const { return (bf16_t*)(ws + WSO_GQ); }
    WSACC bf16_t* GK() const { return (bf16_t*)(ws + WSO_GK); }
    WSACC bf16_t* GV() const { return (bf16_t*)(ws + WSO_GV); }
    WSACC float* GG() const { return (float*)(ws + WSO_GG); }
    WSACC float* GBETA() const { return (float*)(ws + WSO_GBETA); }
    WSACC bf16_t* OB() const { return (bf16_t*)(ws + WSO_OB); }
    WSACC bf16_t* CQ() const { return (bf16_t*)(ws + WSO_CQ); }
    WSACC bf16_t* CK() const { return (bf16_t*)(ws + WSO_CK); }
    WSACC bf16_t* CV() const { return (bf16_t*)(ws + WSO_CV); }
    WSACC bf16_t* MIX() const { return (bf16_t*)(ws + WSO_MIX); }
    WSACC bf16_t* RWC() const { return (bf16_t*)(ws + WSO_RWC); }
    WSACC float* ROPE() const { return (float*)(ws + WSO_ROPE); }
    WSACC bf16_t* LRT() const { return (bf16_t*)(ws + WSO_LRT); }
    WSACC bf16_t* LRO() const { return (bf16_t*)(ws + WSO_LRO); }
    WSACC bf16_t* WLR_T(int l) const { return (bf16_t*)(ws + WSO_WLR_T + (size_t)l * al256((size_t)1280 * 256 * 2)); }
    WSACC bf16_t* XG() const { return (bf16_t*)(ws + WSO_XG); }
    WSACC bf16_t* HH() const { return (bf16_t*)(ws + WSO_HH); }
    WSACC bf16_t* YB() const { return (bf16_t*)(ws + WSO_YB); }
    WSACC int* cnt() const { return (int*)(ws + WSO_ctl) + 8192; }
    WSACC float* TOKF() const { return tokf; }
    float* tokf;
};

DEVFN void row_info(int m, int& b, int& t, int& len, int& base) {
    if (m < NLAT) { b = m / SEQ; t = m % SEQ; len = SEQ; base = b * SEQ; }
    else { const int mc = m - NLAT; b = mc / CTXL; t = mc % CTXL; len = CTXL; base = NLAT + b * CTXL; }
}
DEVFN float ldU(const P& p, size_t idx) { return bf2f(p.U()[idx]); }
DEVFN int mod_row(int m) { return m < NLAT ? m / SEQ : BATCH; }
DEVFN int scan_row(int dir, int b, int s) {
    if (s < CTXL) { const int ts = dir ? (CTXL - 1 - s) : s; return NLAT + b * CTXL + ts; }
    const int s2 = s - CTXL; const int ts = dir ? (SEQ - 1 - s2) : s2; return b * SEQ + ts;
}

DEVFN void task_mod(const P& p, long task) {
    const int j = (int)(task % (6 * D)); const int r = (int)((task / (6 * D)) % (BATCH + 1)); const int l = (int)(task / ((long)(6 * D) * (BATCH + 1)));
    const float* cv = (r < BATCH) ? p.c + (size_t)r * D : p.c_ctx;
    const float* w = p.ada_w + (size_t)l * D * 6 * D + j;
    float acc = 0.f;
    for (int k = 0; k < D; ++k) acc += siluf_(cv[k]) * w[(size_t)k * 6 * D];
    p.MOD()[((size_t)l * (BATCH + 1) + r) * 6 * D + j] = acc + p.ada_b[(size_t)l * 6 * D + j];
}
DEVFN void task_copyx(const P& p, long task) {
    const long n_lat = (long)NLAT * D;
    p.X()[task] = task < n_lat ? p.x[task] : p.ctx[task - n_lat];
}
DEVFN void task_norm1(const P& p, int l, long task) {
    const int m = (int)task; const float* xr = p.X() + (size_t)m * D;
    float ss = 0.f; for (int k = 0; k < D; ++k) ss += xr[k] * xr[k];
    const float rstd = 1.0f / sqrtf(ss / D + 1e-6f);
    const float* md = p.MOD() + ((size_t)l * (BATCH + 1) + mod_row(m)) * 6 * D; const float* pn = p.pre_norm + (size_t)(l * 2 + 0) * D;
    bf16_t* o = p.HB() + (size_t)m * D;
    for (int k = 0; k < D; ++k) o[k] = f2bf(xr[k] * rstd * pn[k] * (1.0f + md[D + k]) + md[k]);
}
DEVFN float lerpA(const P& p, int l, int m, int col) {
    int b, t, len, base; row_info(m, b, t, len, base);
    const float u = ldU(p, (size_t)m * INP + col);
    const float up = t > 0 ? ldU(p, (size_t)(m - 1) * INP + col) : 0.f, un = t + 1 < len ? ldU(p, (size_t)(m + 1) * INP + col) : 0.f;
    return u + p.rw_mu[l * A_IN + col] * (0.5f * (up + un) - u);
}
DEVFN void task_prepA0(const P& p, int l, long task) {
    const int m = (int)(task / 192), j = (int)(task % 192);
    const float v = lerpA(p, l, m, 768 + j);
    p.LR()[(size_t)m * 192 + j] = j < 64 ? tanhf(v) : (j < 128 ? v : sigmoidf_(v));
}
DEVFN void task_prepA1(const P& p, int l, long task) {
    const int m = (int)(task / A_H), h = (int)(task % A_H);
    const float* lr = p.LR() + (size_t)m * 192;
    float ss = 0.f;
    for (int c = 0; c < 64; ++c) { const int ch = h * 64 + c; const float kx = lerpA(p, l, m, 256 + ch) * p.rw_k_k[l * A_W + ch]; ss += kx * kx; }
    const float rn = 1.0f / sqrtf(ss + 1e-6f);
    float bon = 0.f;
    for (int c = 0; c < 64; ++c) {
        const int ch = h * 64 + c;
        const float r = lerpA(p, l, m, ch), k = lerpA(p, l, m, 256 + ch), v = lerpA(p, l, m, 512 + ch);
        const float kk = k * p.rw_k_k[l * A_W + ch] * rn;
        float kdsum = 0.f;
        for (int dir = 0; dir < 2; ++dir) {
            float w = p.rw_w0[(l * 2 + dir) * A_W + ch], a = p.rw_a0[(l * 2 + dir) * A_W + ch];
            const float* w2 = p.rw_w2 + ((size_t)(l * 2 + dir) * 32) * A_W + ch; const float* a2 = p.rw_a2 + ((size_t)(l * 2 + dir) * 32) * A_W + ch;
            for (int r2 = 0; r2 < 32; ++r2) { w += lr[dir * 32 + r2] * w2[(size_t)r2 * A_W]; a += lr[64 + dir * 32 + r2] * a2[(size_t)r2 * A_W]; }
            const float decay = -expf(-softplusf_(-w) - 0.5f);
            const float iclr = sigmoidf_(a);
            const float kd = k * (1.0f + (iclr - 1.0f) * p.rw_k_a[l * A_W + ch]);
            const size_t o = ((size_t)dir * NTOK + m) * A_W + ch;
            p.RW_D()[o] = decay; p.RW_KD()[o] = f2bf(kd); p.RW_KKA()[o] = f2bf(kk * iclr); kdsum += kd;
        }
        float g = 0.f; const float* g2 = p.rw_g2 + (size_t)l * 64 * A_W + ch;
        for (int r2 = 0; r2 < 64; ++r2) g += lr[128 + r2] * g2[(size_t)r2 * A_W];
        const size_t o = (size_t)m * A_W + ch;
        p.RW_R()[o] = f2bf(r); p.RW_V()[o] = f2bf(v); p.RW_KK()[o] = f2bf(kk); p.RW_GATE()[o] = f2bf(g);
        bon += r * kdsum * p.rw_r_k[l * A_W + ch];
    }
    p.RW_BON()[(size_t)m * A_H + h] = bon;
}
DEVFN void task_prepB(const P& p, int l, long task) {
    const int which = (int)(task % 4), h = (int)((task / 4) % B_H), m = (int)(task / (4 * B_H));
    int b, t, len, base; row_info(m, b, t, len, base);
    if (which == 3) {
        for (int dir = 0; dir < 2; ++dir) {
            const float a = ldU(p, (size_t)m * INP + B_OFF + 2048 + dir * 4 + h), bb = ldU(p, (size_t)m * INP + B_OFF + 2056 + dir * 4 + h);
            const float g = -expf(p.gdn_a_log[(l * 2 + dir) * B_H + h]) * softplusf_(a + p.gdn_dt_bias[(l * 2 + dir) * B_H + h]);
            p.GG()[(size_t)m * 8 + dir * 4 + h] = g; p.GBETA()[(size_t)m * 8 + dir * 4 + h] = sigmoidf_(bb);
        }
        return;
    }
    bf16_t* dst = (which == 0 ? p.GQ() : which == 1 ? p.GK() : p.GV()) + (size_t)m * B_W + h * 128;
    float ss = 0.f;
    for (int c = 0; c < 128; ++c) {
        const int cc = which * B_W + h * 128 + c; const int col = B_OFF + cc;
        float acc = 0.f;
        for (int j = 0; j < 5; ++j) { const int tt = t + j - 2; if (tt >= 0 && tt < len) acc += ldU(p, (size_t)(base + tt) * INP + col) * p.gdn_conv[((size_t)l * 5 + j) * (3 * B_W) + cc]; }
        const float s = siluf_(acc); if (which == 2) dst[c] = f2bf(s); ss += s * s;
    }
    if (which < 2) { const float rn = (1.0f / sqrtf(ss + 1e-6f)) * (which == 0 ? 0.08838834764831845f : 1.0f);
        for (int c = 0; c < 128; ++c) { const int cc = which * B_W + h * 128 + c; const int col = B_OFF + cc; float acc = 0.f;
            for (int j = 0; j < 5; ++j) { const int tt = t + j - 2; if (tt >= 0 && tt < len) acc += ldU(p, (size_t)(base + tt) * INP + col) * p.gdn_conv[((size_t)l * 5 + j) * (3 * B_W) + cc]; }
            dst[c] = f2bf(siluf_(acc) * rn); } }
}
DEVFN void task_prepC(const P& p, int l, long task) {
    const int m = (int)(task / 8), hs = (int)(task % 8);
    const size_t sb = (size_t)m * INP + C_OFF + hs * 64;
    if (hs >= 6) { int b_, t_, len_, base_; row_info(m, b_, t_, len_, base_); const int key = m < NLAT ? t_ : SEQ + t_;
        for (int d = 0; d < 64; ++d) p.CV()[((size_t)(b_ * 2 + (hs - 6)) * 64 + d) * SLEN + key] = p.U()[sb + d]; return; }
    float ss = 0.f; for (int d = 0; d < 64; ++d) { const float x = ldU(p, sb + d); ss += x * x; }
    const float qs = hs < 4 ? 0.18033688011112042f : 1.0f;
    const float rstd = (1.0f / sqrtf(ss / 64.f + 1e-6f)) * qs;
    const float* nw = (hs < 4 ? p.attn_q_norm : p.attn_k_norm) + l * 64;
    bf16_t* dst = hs < 4 ? p.CQ() + (size_t)m * 256 + hs * 64 : p.CK() + (size_t)m * 128 + (hs - 4) * 64;
    if (m >= NLAT) { for (int d = 0; d < 64; ++d) dst[d] = f2bf(ldU(p, sb + d) * rstd * nw[d]); return; }
    const int t = m % SEQ; const float pr = (float)(t / GRID_W), pc = (float)(t % GRID_W);
    for (int d = 0; d < 16; ++d) {
        const float fr = powf(10000.0f, -(float)d / 16.0f);
        const float ar = pr * fr, ac = pc * fr; const float cr = cosf(ar), sr = sinf(ar), cc = cosf(ac), sc = sinf(ac);
        const float x1 = ldU(p, sb + d) * rstd * nw[d], x2 = ldU(p, sb + 16 + d) * rstd * nw[16 + d], x3 = ldU(p, sb + 32 + d) * rstd * nw[32 + d], x4 = ldU(p, sb + 48 + d) * rstd * nw[48 + d];
        dst[d] = f2bf(x1 * cr - x2 * sr); dst[16 + d] = f2bf(x2 * cr + x1 * sr); dst[32 + d] = f2bf(x3 * cc - x4 * sc); dst[48 + d] = f2bf(x4 * cc + x3 * sc);
    }
}
DEVFN void task_scanA(const P& p, long task) {
    const int v = (int)(task % 64), chain = UNIFORM((int)(task / 64)); const int h = chain % A_H, b = (chain / A_H) % BATCH, dir = chain / (A_H * BATCH);
    float s[64];
#pragma unroll
    for (int k = 0; k < 64; ++k) s[k] = 0.f;
    for (int st = 0; st < SLEN; ++st) {
        const int m = scan_row(dir, b, st);
        const bf16_t* kk = p.RW_KK() + (size_t)m * A_W + h * 64; const bf16_t* rr = p.RW_R() + (size_t)m * A_W + h * 64;
        const size_t od = ((size_t)dir * NTOK + m) * A_W + h * 64;
        const float* dd = p.RW_D() + od; const bf16_t* kd = p.RW_KD() + od; const bf16_t* ka = p.RW_KKA() + od;
        const float vv = bf2f(p.RW_V()[(size_t)m * A_W + h * 64 + v]);
        float sa = 0.f;
#pragma unroll
        for (int k = 0; k < 64; ++k) { sa += s[k] * bf2f(kk[k]); if ((k & 15) == 15) LOADFENCE(); }
        float y = 0.f;
#pragma unroll
        for (int k = 0; k < 64; ++k) { s[k] = s[k] * expf(dd[k]) - sa * bf2f(ka[k]) + vv * bf2f(kd[k]); y += s[k] * bf2f(rr[k]); if ((k & 7) == 7) LOADFENCE(); }
        p.YA()[((size_t)dir * NTOK + m) * A_W + h * 64 + v] = f2bf(y);
    }
}
DEVFN void task_scanB(const P& p, long task) {
    const int j = (int)(task % 128), chain = UNIFORM((int)(task / 128)); const int h = chain % B_H, b = (chain / B_H) % BATCH, dir = chain / (B_H * BATCH);
    float s[128];
#pragma unroll
    for (int k = 0; k < 128; ++k) s[k] = 0.f;
    for (int st = 0; st < SLEN; ++st) {
        const int m = scan_row(dir, b, st);
        const bf16_t* kv = p.GK() + (size_t)m * B_W + h * 128; const bf16_t* qv = p.GQ() + (size_t)m * B_W + h * 128;
        const float vj = bf2f(p.GV()[(size_t)m * B_W + h * 128 + j]);
        const float eg = expf(p.GG()[(size_t)m * 8 + dir * 4 + h]), beta = p.GBETA()[(size_t)m * 8 + dir * 4 + h];
        float pk = 0.f;
#pragma unroll
        for (int k = 0; k < 128; ++k) { pk += s[k] * bf2f(kv[k]); if ((k & 15) == 15) LOADFENCE(); }
        const float cf = beta * (vj - eg * pk);
        float o = 0.f;
#pragma unroll
        for (int k = 0; k < 128; ++k) { s[k] = eg * s[k] + cf * bf2f(kv[k]); o += s[k] * bf2f(qv[k]); if ((k & 7) == 7) LOADFENCE(); }
        p.OB()[((size_t)dir * NTOK + m) * B_W + h * 128 + j] = f2bf(o);
    }
}
DEVFN void task_attn(const P& p, int need_ctx, long task) {
    const int t = (int)(task % SLEN), hq = UNIFORM((int)((task / SLEN) % 4)), b = UNIFORM((int)(task / ((long)SLEN * 4)));
    const bool is_lat = UNIFORM((int)(t < SEQ)) != 0; if (!is_lat && !need_ctx) return;
    const int m = is_lat ? b * SEQ + t : NLAT + b * CTXL + (t - SEQ);
    const int kvh = hq >> 1;
    float q[64], o[64];
#pragma unroll
    for (int d = 0; d < 64; ++d) { q[d] = bf2f(p.CQ()[(size_t)m * 256 + hq * 64 + d]); o[d] = 0.f; }
    float mx = -1e30f, lsum = 0.f;
    const int nk = is_lat ? SLEN : CTXL;
    for (int kI = 0; kI < nk; ++kI) {
        int km; if (is_lat) km = kI < SEQ ? b * SEQ + kI : NLAT + b * CTXL + (kI - SEQ); else km = NLAT + b * CTXL + kI;
        const bf16_t* kr = p.CK() + (size_t)km * 128 + kvh * 64; const bf16_t* vr = p.CV() + ((size_t)(b * 2 + kvh) * 64) * SLEN + (is_lat ? kI : SEQ + kI);
        float sc = 0.f;
#pragma unroll
        for (int d = 0; d < 64; ++d) { sc += q[d] * bf2f(kr[d]); if ((d & 15) == 15) LOADFENCE(); }
        const float mn = sc > mx ? sc : mx; const float f = exp2f(mx - mn), pe = exp2f(sc - mn);
        lsum = lsum * f + pe; mx = mn;
#pragma unroll
        for (int d = 0; d < 64; ++d) { o[d] = o[d] * f + pe * bf2f(vr[(size_t)d * SLEN]); if ((d & 15) == 15) LOADFENCE(); }
    }
    const float inv = 1.0f / lsum;
#pragma unroll
    for (int d = 0; d < 64; ++d) p.MIX()[(size_t)m * D + 768 + hq * 64 + d] = f2bf(o[d] * inv);
}
DEVFN void task_post(const P& p, int l, long task) {
    const int m = (int)(task / 8), g = (int)(task % 8);
    if (g < 4) {
        const int h = g; const bf16_t* y0 = p.YA() + (size_t)m * A_W + h * 64; const bf16_t* y1 = p.YA() + ((size_t)NTOK + m) * A_W + h * 64;
        float mean = 0.f; for (int c = 0; c < 64; ++c) mean += bf2f(y0[c]) + bf2f(y1[c]); mean *= (1.0f / 64.f);
        float var = 0.f; for (int c = 0; c < 64; ++c) { const float d0 = bf2f(y0[c]) + bf2f(y1[c]) - mean; var += d0 * d0; } var *= (1.0f / 64.f);
        const float rs = 1.0f / sqrtf(var + 64e-5f); const float bon = p.RW_BON()[(size_t)m * A_H + h];
        for (int c = 0; c < 64; ++c) { const int ch = h * 64 + c;
            const float yn = (bf2f(y0[c]) + bf2f(y1[c]) - mean) * rs * p.rw_ln_w[l * A_W + ch] + p.rw_ln_b[l * A_W + ch];
            p.MIX()[(size_t)m * D + ch] = f2bf((yn + bon * bf2f(p.RW_V()[(size_t)m * A_W + ch])) * bf2f(p.RW_GATE()[(size_t)m * A_W + ch])); }
    } else {
        const int h = g - 4; const bf16_t* o0 = p.OB() + (size_t)m * B_W + h * 128; const bf16_t* o1 = p.OB() + ((size_t)NTOK + m) * B_W + h * 128;
        float ss = 0.f; for (int c = 0; c < 128; ++c) { const float o = bf2f(o0[c]) + bf2f(o1[c]); ss += o * o; }
        const float rs = 1.0f / sqrtf(ss / 128.f + 1e-6f);
        for (int c = 0; c < 128; ++c) { const float z = ldU(p, (size_t)m * INP + B_OFF + 1536 + h * 128 + c);
            p.MIX()[(size_t)m * D + 256 + h * 128 + c] = f2bf((bf2f(o0[c]) + bf2f(o1[c])) * rs * p.gdn_norm[l * 128 + c] * siluf_(z)); }
    }
}
DEVFN void task_resid1(const P& p, int l, long task) {
    const int m = (int)task; const bf16_t* mo = p.MO() + (size_t)m * D; float* xr = p.X() + (size_t)m * D;
    const float* md = p.MOD() + ((size_t)l * (BATCH + 1) + mod_row(m)) * 6 * D;
    float ss = 0.f; for (int k = 0; k < D; ++k) ss += bf2f(mo[k]) * bf2f(mo[k]);
    const float rstd = 1.0f / sqrtf(ss / D + 1e-6f); const float* pn = p.post_norm + (size_t)(l * 2 + 0) * D;
    float s2 = 0.f;
    for (int k = 0; k < D; ++k) { const float xv = xr[k] + md[2 * D + k] * (bf2f(mo[k]) * rstd) * pn[k]; xr[k] = xv; s2 += xv * xv; }
    const float r2 = 1.0f / sqrtf(s2 / D + 1e-6f); const float* pn2 = p.pre_norm + (size_t)(l * 2 + 1) * D;
    for (int k = 0; k < D; ++k) { const float tv = xr[k] * r2 * pn2[k] * (1.0f + md[4 * D + k]) + md[3 * D + k]; p.TOKF()[(size_t)m * D + k] = tv; p.HB()[(size_t)m * D + k] = f2bf(tv); }
}
DEVFN void task_router(const P& p, int l, long task) {
    const int m = (int)task; const float* tk = p.TOKF() + (size_t)m * D; const float* rw = p.router_w + (size_t)l * D * NEXP;
    float lg[NEXP];
#pragma unroll
    for (int e = 0; e < NEXP; ++e) lg[e] = p.router_b[l * NEXP + e];
    for (int k = 0; k < D; ++k) { const float tv = tk[k];
#pragma unroll
        for (int e = 0; e < NEXP; ++e) lg[e] += tv * rw[(size_t)k * NEXP + e]; }
    int idx[TOPK]; float val[TOPK];
#pragma unroll
    for (int j = 0; j < TOPK; ++j) { float best = -3.0e38f; int bi = 0;
#pragma unroll
        for (int e = 0; e < NEXP; ++e) { if (lg[e] > best) { best = lg[e]; bi = e; } }
        idx[j] = bi; val[j] = best;
#pragma unroll
        for (int e = 0; e < NEXP; ++e) if (e == bi) lg[e] = -3.0e38f; }
    float sum = 0.f, ex[TOPK];
#pragma unroll
    for (int j = 0; j < TOPK; ++j) { ex[j] = expf(val[j] - val[0]); sum += ex[j]; }
#pragma unroll
    for (int j = 0; j < TOPK; ++j) { p.TOPI()[(size_t)m * TOPK + j] = idx[j]; p.TOPG()[(size_t)m * TOPK + j] = ex[j] / sum; p.POS()[(size_t)m * TOPK + j] = GLOBAL_ATOMIC_ADD(&p.cnt()[l * NEXP + idx[j]], 1); }
}
DEVFN int moe_pstart(const P& p, int l, int e, int* nblk) {
    int acc = 0, ps = 0;
    for (int i = 0; i < NEXP; ++i) { if (i == e) ps = acc; acc += (p.cnt()[l * NEXP + i] + 255) / 256 * 256; }
    if (nblk) *nblk = acc / 256; return ps;
}
DEVFN void task_slots(const P& p, int l, long task) {
    const int e = p.TOPI()[task]; const int slot = moe_pstart(p, l, e, nullptr) + p.POS()[task];
    p.TSLOT()[task] = slot; p.SLOT_TOK()[slot] = (int)(task / TOPK);
}
DEVFN void task_blocke(const P& p, int l, long task) {
    int acc = 0, e_of = NEXP - 1, nb = 0;
    for (int i = 0; i < NEXP; ++i) { const int nbk = (p.cnt()[l * NEXP + i] + 255) / 256; if ((int)task >= acc && (int)task < acc + nbk) e_of = i; acc += nbk; }
    nb = acc; p.BLOCK_E()[task] = e_of; if (task == 0) p.NBLK()[0] = nb;
}
DEVFN void task_gather(const P& p, long task) {
    const long slot = task / 128; const int ch = (int)(task % 128); const int tok = p.SLOT_TOK()[slot];
    const uint4* s = (const uint4*)(p.HB() + (size_t)tok * D) + ch; ((uint4*)(p.XG() + (size_t)slot * D))[ch] = *s;
}
DEVFN void task_combine(const P& p, int l, long task) {
    const int m = (int)task; float* xr = p.X() + (size_t)m * D; const float* md = p.MOD() + ((size_t)l * (BATCH + 1) + mod_row(m)) * 6 * D;
    const bf16_t* y0 = p.YB() + (size_t)p.TSLOT()[(size_t)m * 4 + 0] * D; const bf16_t* y1 = p.YB() + (size_t)p.TSLOT()[(size_t)m * 4 + 1] * D;
    const bf16_t* y2 = p.YB() + (size_t)p.TSLOT()[(size_t)m * 4 + 2] * D; const bf16_t* y3 = p.YB() + (size_t)p.TSLOT()[(size_t)m * 4 + 3] * D;
    const float g0 = p.TOPG()[(size_t)m * 4 + 0], g1 = p.TOPG()[(size_t)m * 4 + 1], g2 = p.TOPG()[(size_t)m * 4 + 2], g3 = p.TOPG()[(size_t)m * 4 + 3];
    float ss = 0.f;
    for (int k = 0; k < D; ++k) { const float f = g0 * bf2f(y0[k]) + g1 * bf2f(y1[k]) + g2 * bf2f(y2[k]) + g3 * bf2f(y3[k]); ss += f * f; }
    const float rstd = 1.0f / sqrtf(ss / D + 1e-6f); const float* pn = p.post_norm + (size_t)(l * 2 + 1) * D;
    const bool last = (l == DEPTH - 1);
    for (int k = 0; k < D; ++k) { const float f = g0 * bf2f(y0[k]) + g1 * bf2f(y1[k]) + g2 * bf2f(y2[k]) + g3 * bf2f(y3[k]);
        const float xv = xr[k] + md[5 * D + k] * (f * rstd) * pn[k]; xr[k] = xv; if (last) p.out[(size_t)m * D + k] = xv; }
}

#ifndef HOST_TEST
namespace pg8 {
#define PG8_LAS __attribute__((address_space(3)))
typedef short bf16x8 __attribute__((ext_vector_type(8)));
typedef float f32x4 __attribute__((ext_vector_type(4)));
typedef unsigned u32x4 __attribute__((ext_vector_type(4)));
typedef unsigned u32x2 __attribute__((ext_vector_type(2)));
constexpr int BM = 256, BK = 64, HALF = 128, HTB = HALF * BK * 2, STAGE_BYTES = 8 * HTB, NXCD = 8, WGM = 8;
__host__ __device__ __forceinline__ int lds_byte(int r, int c) { const int st = (r >> 4) * 2 + (c >> 5), rr = r & 15, cc = c & 31, ob = rr * 64 + cc * 2; return st * 1024 + (ob ^ (((ob >> 9) & 1) << 5)); }
__host__ __device__ __forceinline__ void stage_rc(int b, int& R, int& C) { const int st = b / 1024, sb = b % 1024, swz = sb ^ (((sb >> 9) & 1) << 5); R = (st >> 1) * 16 + swz / 64; C = (st & 1) * 32 + (swz % 64) / 2; }
__host__ __device__ __forceinline__ int perm32(int rho) { const int n = rho >> 4, i = rho & 15; return 8 * (i >> 2) + 4 * n + (i & 3); }
struct Unit { int pm, pn, e; };
struct Gemm { const bf16_t* A; const bf16_t* Bt; int K; size_t estride; const int* rowidx; };
struct StaticOrder {
    int nM, nN, nwg, G, c;
    __device__ void init(int M, int N, int G_, int c_) { nM = M / BM; nN = N / BM; nwg = nM * nN; G = G_; c = c_; }
    __device__ bool next(int i, Unit& u) const {
        const long L = (long)i * G + c; if (L >= nwg) return false;
        int wgid = (int)L; { const int q = nwg / NXCD, r = nwg % NXCD, xcd = wgid % NXCD, off = wgid / NXCD; wgid = (xcd < r ? xcd * (q + 1) : r * (q + 1) + (xcd - r) * q) + off; }
        const int nig = WGM * nN, gid = wgid / nig, fm = gid * WGM, gsz = (nM - fm) < WGM ? (nM - fm) : WGM;
        u.pm = fm + ((wgid % nig) % gsz); u.pn = (wgid % nig) / gsz; u.e = 0; return true;
    }
};
struct MoeOrder {
    int nblk, nN, G, c; const int* block_e;
    __device__ bool next(int i, Unit& u) const {
        if (G % 8 != 0 || (G / 8) % nN != 0) { const long L = (long)i * G + c; if (L >= (long)nblk * nN) return false; u.pm = (int)(L / nN); u.pn = (int)(L % nN); }
        else { const int x = c & 7, r = c >> 3, per = (G / 8) / nN; const int mb = (i * per + r / nN) * 8 + x; if (mb >= nblk) return false; u.pm = mb; u.pn = r % nN; }
        u.e = __builtin_amdgcn_readfirstlane(block_e[u.pm]); return true;
    }
};
typedef float f32x2c_t __attribute__((ext_vector_type(2))); typedef __bf16 bf16x2c_t __attribute__((ext_vector_type(2)));
__device__ __forceinline__ unsigned cvt_pk_bf16(float lo, float hi) { const f32x2c_t v = {lo, hi}; const bf16x2c_t b = __builtin_convertvector(v, bf16x2c_t); return __builtin_bit_cast(unsigned, b); }
struct EpiF32 {
    static constexpr bool PERM = false;
    float* C; int ldc;
    __device__ __forceinline__ void operator()(const f32x4 (&acc)[2][2][4][2], const Unit& u, int wr, int wc, int fr, int fq) const {
        const int row0 = u.pm * BM + wr * 64 + fr, col0 = u.pn * BM + wc * 32 + 4 * fq;
#pragma unroll
        for (int ai = 0; ai < 2; ++ai)
#pragma unroll
            for (int m = 0; m < 4; ++m) { float* rowp = C + (size_t)(row0 + ai * HALF + m * 16) * ldc + col0;
#pragma unroll
                for (int bj = 0; bj < 2; ++bj)
#pragma unroll
                    for (int n = 0; n < 2; ++n) *(f32x4*)(rowp + bj * HALF + n * 16) = acc[ai][bj][m][n]; }
    }
};
struct EpiBf16Bias {
    static constexpr bool PERM = true;
    bf16_t* O; int ldc; const float* bias; int bias_estride;
    __device__ __forceinline__ void operator()(const f32x4 (&acc)[2][2][4][2], const Unit& u, int wr, int wc, int fr, int fq) const {
        const int row0 = u.pm * BM + wr * 64 + fr, col0 = u.pn * BM + wc * 32 + 8 * fq; const float* bp = bias + (size_t)u.e * bias_estride + col0;
        f32x4 bv[2][2];
#pragma unroll
        for (int bj = 0; bj < 2; ++bj)
#pragma unroll
            for (int n = 0; n < 2; ++n) bv[bj][n] = bias ? *(const f32x4*)(bp + bj * HALF + 4 * n) : (f32x4){0.f, 0.f, 0.f, 0.f};
#pragma unroll
        for (int ai = 0; ai < 2; ++ai)
#pragma unroll
            for (int m = 0; m < 4; ++m) { bf16_t* rowp = O + (size_t)(row0 + ai * HALF + m * 16) * ldc + col0;
#pragma unroll
                for (int bj = 0; bj < 2; ++bj) { const f32x4 v0 = acc[ai][bj][m][0] + bv[bj][0], v1 = acc[ai][bj][m][1] + bv[bj][1];
                    u32x4 w; w.x = cvt_pk_bf16(v0[0], v0[1]); w.y = cvt_pk_bf16(v0[2], v0[3]); w.z = cvt_pk_bf16(v1[0], v1[1]); w.w = cvt_pk_bf16(v1[2], v1[3]);
                    *(u32x4*)(rowp + bj * HALF) = w; } }
    }
};
__device__ __forceinline__ float swiglu1(float g, float lin) { g = fminf(g, 7.0f); lin = fminf(fmaxf(lin, -7.0f), 7.0f); return g * __builtin_amdgcn_rcpf(1.0f + __expf(-1.702f * g)) * (lin + 1.0f); }
struct EpiSwiglu {
    static constexpr bool PERM = true;
    bf16_t* O; int ldc; const float* bias; int bias_estride;
    __device__ __forceinline__ void operator()(const f32x4 (&acc)[2][2][4][2], const Unit& u, int wr, int wc, int fr, int fq) const {
        const int row0 = u.pm * BM + wr * 64 + fr, col0 = u.pn * BM + wc * 32 + 8 * fq; const float* bp = bias + (size_t)u.e * bias_estride + col0;
        f32x4 bv[2][2];
#pragma unroll
        for (int bj = 0; bj < 2; ++bj)
#pragma unroll
            for (int n = 0; n < 2; ++n) bv[bj][n] = *(const f32x4*)(bp + bj * HALF + 4 * n);
#pragma unroll
        for (int ai = 0; ai < 2; ++ai)
#pragma unroll
            for (int m = 0; m < 4; ++m) { bf16_t* rowp = O + (size_t)(row0 + ai * HALF + m * 16) * ldc + (col0 >> 1);
#pragma unroll
                for (int bj = 0; bj < 2; ++bj) { const f32x4 v0 = acc[ai][bj][m][0] + bv[bj][0], v1 = acc[ai][bj][m][1] + bv[bj][1];
                    u32x2 w; w.x = cvt_pk_bf16(swiglu1(v0[0], v0[1]), swiglu1(v0[2], v0[3])); w.y = cvt_pk_bf16(swiglu1(v1[0], v1[1]), swiglu1(v1[2], v1[3]));
                    *(u32x2*)(rowp + bj * (HALF / 2)) = w; } }
    }
};

template <bool GATHER = false, class Epi, class Sched>
__device__ __forceinline__ void gemm_phase(PG8_LAS unsigned char* lds, const Gemm g, const Sched& S, const Epi& E, int tid) {
    asm volatile("" : "+v"(tid));
    const int wid = __builtin_amdgcn_readfirstlane(tid >> 6), lane = tid & 63, wr = wid >> 2, wc = wid & 3, fr = lane & 15, fq = lane >> 4;
    int K = g.K; asm volatile("" : "+s"(K));
    const int nt = K / BK;
    unsigned voffA[2], voffB[2];
#pragma unroll
    for (int i = 0; i < 2; ++i) { int R, C; stage_rc(tid * 16 + i * 8192, R, C); const int Rb = Epi::PERM ? ((R & ~31) + perm32(R & 31)) : R;
        voffA[i] = GATHER ? 0u : (unsigned)(R * K + C) * 2u; voffB[i] = (unsigned)(Rb * K + C) * 2u; }
    const size_t kstep = (size_t)(BK * 2);
    const size_t hstep = (size_t)HALF * K * 2;
    const size_t tstep = 2 * hstep;
    const unsigned ldsw = (unsigned)wid * 1024u;
    const int aoff = lds_byte(wr * 64 + fr, fq * 8), boff = lds_byte(wc * 32 + fr, fq * 8);
#define PG8_SA(b, h) (((b) * 2 + (h)) * HTB)
#define PG8_SB(b, h) ((4 + (b) * 2 + (h)) * HTB)
#define PG8_STAGE(bufoff, gbase, voff) do { _Pragma("unroll") for (int _i = 0; _i < 2; ++_i) \
        __builtin_amdgcn_global_load_lds((const unsigned*)((const char*)(gbase) + (voff)[_i]), (PG8_LAS unsigned*)(lds + (bufoff) + ldsw + _i * 8192), 16, 0, 0); } while (0)
#define PG8_STAGE_A(bufoff, h, nx, kb) do { _Pragma("unroll") for (int _i = 0; _i < 2; ++_i) { \
        if constexpr (GATHER) { const unsigned _o = (nx) ? on[h][_i] : oc[h][_i]; \
            __builtin_amdgcn_global_load_lds((const unsigned*)((const char*)g.A + (size_t)_o + (size_t)(kb)), (PG8_LAS unsigned*)(lds + (bufoff) + ldsw + _i * 8192), 16, 0, 0); } \
        else { const char* _b = ((nx) ? nA : cA) + (size_t)(h) * hstep + (size_t)(kb); \
            __builtin_amdgcn_global_load_lds((const unsigned*)(_b + voffA[_i]), (PG8_LAS unsigned*)(lds + (bufoff) + ldsw + _i * 8192), 16, 0, 0); } } } while (0)
#define PG8_LDA(dst, b, h) do { _Pragma("unroll") for (int m = 0; m < 4; ++m) _Pragma("unroll") for (int k = 0; k < 2; ++k) dst[m][k] = *(const PG8_LAS bf16x8*)(lds + PG8_SA(b, h) + aoff + m * 2048 + k * 1024); } while (0)
#define PG8_LDB(dst, b, h) do { _Pragma("unroll") for (int n = 0; n < 2; ++n) _Pragma("unroll") for (int k = 0; k < 2; ++k) dst[n][k] = *(const PG8_LAS bf16x8*)(lds + PG8_SB(b, h) + boff + n * 2048 + k * 1024); } while (0)
#define PG8_MMA(ai, bj, At, Bt) do { __builtin_amdgcn_s_setprio(1); _Pragma("unroll") for (int m = 0; m < 4; ++m) _Pragma("unroll") for (int n = 0; n < 2; ++n) _Pragma("unroll") for (int k = 0; k < 2; ++k) \
        acc[ai][bj][m][n] = __builtin_amdgcn_mfma_f32_16x16x32_bf16(Bt[n][k], At[m][k], acc[ai][bj][m][n], 0, 0, 0); __builtin_amdgcn_s_setprio(0); } while (0)
#define PG8_WAIT_V(n) asm volatile("s_waitcnt vmcnt(" #n ")" ::: "memory")
#define PG8_WAIT_L(n) asm volatile("s_waitcnt lgkmcnt(" #n ")" ::: "memory")
#define PG8_BAR __builtin_amdgcn_s_barrier()
#define PG8_SCHED __builtin_amdgcn_sched_barrier(0)
    Unit cur, nxt; int ui = 0;
    if (!S.next(0, cur)) return;
    unsigned oc[2][2], on[2][2];
    const char* cA = (const char*)g.A + (size_t)cur.pm * tstep; const char* nA = cA;
#define PG8_UNIT_OFFS(o, u) do { _Pragma("unroll") for (int _h = 0; _h < 2; ++_h) _Pragma("unroll") for (int _i = 0; _i < 2; ++_i) { \
        if constexpr (GATHER) { int _R, _C; stage_rc(tid * 16 + _i * 8192, _R, _C); (o)[_h][_i] = (unsigned)g.rowidx[(u).pm * BM + _h * HALF + _R] * (unsigned)(K * 2) + (unsigned)(_C * 2); } else (o)[_h][_i] = 0u; } } while (0)
    PG8_UNIT_OFFS(oc, cur);
    f32x4 acc[2][2][4][2];
#pragma unroll
    for (int a = 0; a < 2; ++a)
#pragma unroll
        for (int b = 0; b < 2; ++b)
#pragma unroll
            for (int m = 0; m < 4; ++m)
#pragma unroll
                for (int n = 0; n < 2; ++n) acc[a][b][m][n] = (f32x4){0.f, 0.f, 0.f, 0.f};
    bf16x8 At[4][2], B0[2][2], B1[2][2];
    const char* cB = (const char*)(g.Bt + (size_t)cur.e * g.estride) + (size_t)cur.pn * tstep;
    PG8_STAGE(PG8_SB(0, 0), cB, voffB); PG8_STAGE(PG8_SB(0, 1), cB + hstep, voffB); PG8_STAGE_A(PG8_SA(0, 0), 0, false, 0); PG8_STAGE_A(PG8_SA(0, 1), 1, false, 0);
    if (wr == 1) PG8_BAR;
    PG8_WAIT_V(2); PG8_BAR;
    PG8_STAGE(PG8_SB(1, 0), cB + kstep, voffB); PG8_STAGE_A(PG8_SA(1, 0), 0, false, kstep); PG8_STAGE(PG8_SB(1, 1), cB + hstep + kstep, voffB);
    PG8_WAIT_V(6); PG8_BAR;
    for (;;) {
        const bool has_next = S.next(ui + 1, nxt);
        if (has_next) { PG8_UNIT_OFFS(on, nxt); nA = (const char*)g.A + (size_t)nxt.pm * tstep; } else { nA = cA; _Pragma("unroll") for (int _h = 0; _h < 2; ++_h) _Pragma("unroll") for (int _i = 0; _i < 2; ++_i) on[_h][_i] = oc[_h][_i]; }
        const char* nB = has_next ? (const char*)(g.Bt + (size_t)nxt.e * g.estride) + (size_t)nxt.pn * tstep : cB;
        for (int t = 0; t < nt; t += 2) {
            const bool last = (t == nt - 2);
            const size_t ka1 = (size_t)(t + 1) * kstep, ka2 = last ? 0 : (size_t)(t + 2) * kstep, ka3 = ka2 + kstep;
            const char* b2 = last ? nB : cB + (size_t)(t + 2) * kstep; const char* b3 = b2 + kstep;
            PG8_LDB(B0, 0, 0); PG8_LDB(B1, 0, 1); PG8_SCHED; PG8_LDA(At, 0, 0); PG8_STAGE_A(PG8_SA(1, 1), 1, false, ka1);
            PG8_WAIT_V(8); PG8_WAIT_L(0); PG8_BAR; PG8_MMA(0, 0, At, B0); PG8_MMA(0, 1, At, B1); PG8_BAR; PG8_SCHED;
            PG8_LDA(At, 0, 1); PG8_STAGE(PG8_SB(0, 0), b2, voffB); PG8_STAGE(PG8_SB(0, 1), b2 + hstep, voffB); PG8_STAGE_A(PG8_SA(0, 0), 0, last, ka2);
            PG8_WAIT_V(8); PG8_WAIT_L(0); PG8_BAR; PG8_MMA(1, 0, At, B0); PG8_MMA(1, 1, At, B1); PG8_BAR; PG8_SCHED;
            PG8_LDB(B0, 1, 0); PG8_LDB(B1, 1, 1); PG8_SCHED; PG8_LDA(At, 1, 0); PG8_STAGE_A(PG8_SA(0, 1), 1, last, ka2);
            PG8_WAIT_V(8); PG8_WAIT_L(0); PG8_BAR; PG8_MMA(0, 0, At, B0); PG8_MMA(0, 1, At, B1); PG8_BAR; PG8_SCHED;
            PG8_LDA(At, 1, 1); PG8_STAGE(PG8_SB(1, 0), b3, voffB); PG8_STAGE(PG8_SB(1, 1), b3 + hstep, voffB); PG8_STAGE_A(PG8_SA(1, 0), 0, last, ka3);
            PG8_WAIT_V(8); PG8_WAIT_L(0); PG8_BAR; PG8_MMA(1, 0, At, B0); PG8_MMA(1, 1, At, B1); PG8_BAR; PG8_SCHED;
        }
        if (wr == 0) PG8_BAR;
        E(acc, cur, wr, wc, fr, fq);
        if (!has_next) break;
#pragma unroll
        for (int a = 0; a < 2; ++a)
#pragma unroll
            for (int b = 0; b < 2; ++b)
#pragma unroll
                for (int m = 0; m < 4; ++m)
#pragma unroll
                    for (int n = 0; n < 2; ++n) acc[a][b][m][n] = (f32x4){0.f, 0.f, 0.f, 0.f};
        cur = nxt; cA = nA; cB = nB; ++ui;
#pragma unroll
        for (int _h = 0; _h < 2; ++_h)
#pragma unroll
            for (int _i = 0; _i < 2; ++_i) oc[_h][_i] = on[_h][_i];
        if (wr == 1) PG8_BAR;
    }
    PG8_WAIT_V(0);
    PG8_BAR;
#undef PG8_UNIT_OFFS
#undef PG8_SA
#undef PG8_SB
#undef PG8_STAGE
#undef PG8_STAGE_A
#undef PG8_LDA
#undef PG8_LDB
#undef PG8_MMA
#undef PG8_WAIT_V
#undef PG8_WAIT_L
#undef PG8_BAR
#undef PG8_SCHED
}
}

#define XB_TMO      128
#define XB_XCNT(j)  (256  + 64 * (j))
#define XB_XSUB(j)  (1280 + 64 * (j))
#define XB_XGEN(j)  (2304 + 64 * (j))
#define XB_TOP      3328
#define XB_TOPGEN   3392
#define XCD_BAR_WORDS 3456
#define XB_SPIN_CAP (1u << 22)
#define LAS __attribute__((address_space(3)))
__device__ __forceinline__ unsigned xb_ld(unsigned* p)              { return __hip_atomic_load(p, __ATOMIC_RELAXED, __HIP_MEMORY_SCOPE_AGENT); }
__device__ __forceinline__ unsigned xb_add(unsigned* p, unsigned v) { return __hip_atomic_fetch_add(p, v, __ATOMIC_RELAXED, __HIP_MEMORY_SCOPE_AGENT); }
__device__ __forceinline__ unsigned xb_xcc_id() { return (unsigned)__builtin_amdgcn_s_getreg((3 << 11) | 20) & 0xFu; }
#define XB_SPIN(cond, bar) do { unsigned _sp = 0; while (cond) { __builtin_amdgcn_s_sleep(1); \
    if ((++_sp & 255u) == 0u) { if (xb_ld(&(bar)[XB_TMO])) break; if (_sp > XB_SPIN_CAP) { atomicAdd(&(bar)[XB_TMO], 1u); break; } } } } while (0)
struct XcdBarrier { unsigned* bar; unsigned x; volatile LAS unsigned* st; };
__device__ __forceinline__ XcdBarrier xcd_barrier_post(unsigned* bar, volatile LAS unsigned* st, int tid) {
    XcdBarrier b; b.bar = bar; b.x = xb_xcc_id(); b.st = st;
    if (tid == 0) (void)xb_add(&bar[XB_XCNT(b.x)], 1u);
    return b;
}
__device__ __forceinline__ void xcd_barrier_complete(unsigned* bar, unsigned x, unsigned& nloc, unsigned& nx) {
    const unsigned G = gridDim.x * gridDim.y * gridDim.z;
    unsigned sum, cnt, mine, sp = 0u;
    for (;;) {
        sum = 0u; cnt = 0u; mine = 0u;
#pragma unroll
        for (unsigned j = 0; j < 16; ++j) { const unsigned c = xb_ld(&bar[XB_XCNT(j)]); sum += c; cnt += (c > 0u) ? 1u : 0u; mine = (j == x) ? c : mine; }
        if (sum == G) break;
        __builtin_amdgcn_s_sleep(1);
        if ((++sp & 255u) == 0u) { if (xb_ld(&bar[XB_TMO])) break; if (sp > XB_SPIN_CAP) { atomicAdd(&bar[XB_TMO], 1u); break; } }
    }
    nloc = mine > 0u ? mine : 1u; nx = cnt > 0u ? cnt : 1u;
}
__device__ __forceinline__ void xcd_barrier(const XcdBarrier& b, int tid) {
    asm volatile("s_waitcnt vmcnt(0)" ::: "memory");
    __syncthreads();
    if (tid == 0) {
        unsigned* bar = b.bar;
        __builtin_amdgcn_s_waitcnt(0);
        unsigned nloc = b.st[0], nx = b.st[1];
        if (nloc == 0u) { xcd_barrier_complete(bar, b.x, nloc, nx); b.st[0] = nloc; b.st[1] = nx; }
        const unsigned old = xb_add(&bar[XB_XSUB(b.x)], 1u);
        const unsigned gen = old / nloc;
        if (old + 1u == (gen + 1u) * nloc) {
            __builtin_amdgcn_fence(__ATOMIC_RELEASE, "agent");
            asm volatile("s_waitcnt vmcnt(0)" ::: "memory");
            const unsigned og = xb_add(&bar[XB_TOP], 1u);
            const unsigned tg = og / nx;
            if (og + 1u == (tg + 1u) * nx) xb_add(&bar[XB_TOPGEN], 1u);
            else XB_SPIN(xb_ld(&bar[XB_TOPGEN]) == tg, bar);
            __builtin_amdgcn_fence(__ATOMIC_ACQUIRE, "agent");
            xb_add(&bar[XB_XGEN(b.x)], 1u);
            asm volatile("s_waitcnt vmcnt(0)" ::: "memory");
        } else {
            XB_SPIN(xb_ld(&bar[XB_XGEN(b.x)]) == gen, bar);
            __builtin_amdgcn_fence(__ATOMIC_ACQUIRE, "agent");
            asm volatile("s_waitcnt vmcnt(0)" ::: "memory");
        }
    }
    __syncthreads();
}


constexpr int NWAVES = 8, NTHR = 512;
constexpr int NPH = 15;
__device__ __forceinline__ float frsq(float x) { return __builtin_amdgcn_rsqf(x); }
__device__ __forceinline__ float frcp(float x) { return __builtin_amdgcn_rcpf(x); }
typedef float f32x4_t __attribute__((ext_vector_type(4)));
typedef unsigned u32x2_t __attribute__((ext_vector_type(2)));
typedef unsigned u32x4_t __attribute__((ext_vector_type(4)));
typedef short bf16x8_t __attribute__((ext_vector_type(8)));
__device__ __forceinline__ float wave_sum(float v) {
#pragma unroll
    for (int o = 1; o < 64; o <<= 1) v += __shfl_xor(v, o);
    return v;
}
__device__ __forceinline__ float grp16_sum(float v) {
#pragma unroll
    for (int o = 1; o < 16; o <<= 1) v += __shfl_xor(v, o);
    return v;
}
__device__ __forceinline__ float hsum4(f32x4_t a) { return (a.x + a.y) + (a.z + a.w); }
__device__ __forceinline__ float hsq4(f32x4_t a) { return (a.x * a.x + a.y * a.y) + (a.z * a.z + a.w * a.w); }
__device__ __forceinline__ u32x2_t pk4(f32x4_t t) { u32x2_t w; w.x = pg8::cvt_pk_bf16(t.x, t.y); w.y = pg8::cvt_pk_bf16(t.z, t.w); return w; }
__device__ __forceinline__ float bflo(unsigned w) { return __builtin_bit_cast(float, w << 16); }
__device__ __forceinline__ float bfhi(unsigned w) { return __builtin_bit_cast(float, w & 0xffff0000u); }
__device__ __forceinline__ f32x4_t bf4(u32x2_t w) { f32x4_t r; r.x = bflo(w.x); r.y = bfhi(w.x); r.z = bflo(w.y); r.w = bfhi(w.y); return r; }
template <bool TO_LDS> __device__ __forceinline__ void norm_mod_store(const f32x4_t (&v)[4], float rstd, const float* pn, const float* sh, const float* sc, bf16_t* orow, LAS unsigned char* lrow, int lane) {
#pragma unroll
    for (int j = 0; j < 4; ++j) { const int k = 4 * lane + 256 * j;
        const f32x4_t pv = *(const f32x4_t*)(pn + k), sv = *(const f32x4_t*)(sc + k), hv = *(const f32x4_t*)(sh + k);
        const f32x4_t t = v[j] * rstd * pv * (1.0f + sv) + hv; const u32x2_t w = pk4(t);
        *(u32x2_t*)(orow + k) = w; if (TO_LDS) *(LAS u32x2_t*)(lrow + 2 * k) = w; }
}
__device__ __forceinline__ void dev_norm1_l0(const P& p, int G, int wave, int lane) {
    int r0, r1; { const int nw = G * NWAVES, per = (NTOK + nw - 1) / nw, gwl = (int)blockIdx.x * NWAVES + wave; r0 = gwl * per; r1 = r0 + per; if (r1 > NTOK) r1 = NTOK; }
    f32x4_t pnr[4], shr[4], scr2[4]; int mrow = -1;
#pragma unroll
    for (int j = 0; j < 4; ++j) pnr[j] = *(const f32x4_t*)(p.pre_norm + 4 * lane + 256 * j);
    for (int m = r0; m < r1; ++m) {
        const float* src = m < NLAT ? p.x + (size_t)m * D : p.ctx + (size_t)(m - NLAT) * D;
        f32x4_t v[4]; float ss = 0.f;
#pragma unroll
        for (int j = 0; j < 4; ++j) { v[j] = *(const f32x4_t*)(src + 4 * lane + 256 * j); ss += hsq4(v[j]); *(f32x4_t*)(p.X() + (size_t)m * D + 4 * lane + 256 * j) = v[j]; }
        const int mr = mod_row(m);
        if (mr != mrow) { const float* md = p.MOD() + (size_t)mr * 6 * D; mrow = mr;
#pragma unroll
            for (int j = 0; j < 4; ++j) { shr[j] = *(const f32x4_t*)(md + 4 * lane + 256 * j); scr2[j] = *(const f32x4_t*)(md + D + 4 * lane + 256 * j); } }
        const float rstd = frsq(wave_sum(ss) * (1.0f / D) + 1e-6f); bf16_t* orow = p.HB() + (size_t)m * D;
#pragma unroll
        for (int j = 0; j < 4; ++j) { const f32x4_t t = v[j] * rstd * pnr[j] * (1.0f + scr2[j]) + shr[j]; *(u32x2_t*)(orow + 4 * lane + 256 * j) = pk4(t); }
    }
}
__device__ __forceinline__ void dev_post(const P& p, int l, int ntok_l, int gw, int ngw, int lane) {
    const int h = lane >> 4;
    for (int m = gw; m < ntok_l; m += ngw) {
        {
            const f32x4_t y = bf4(*(const u32x2_t*)(p.YA() + (size_t)m * A_W + 4 * lane)) + bf4(*(const u32x2_t*)(p.YA() + ((size_t)NTOK + m) * A_W + 4 * lane));
            const float mean = grp16_sum(hsum4(y)) * (1.0f / 64.f); const f32x4_t d = y - mean;
            const float var = grp16_sum(hsq4(d)) * (1.0f / 64.f); const float rs = frsq(var + 64e-5f);
            const f32x4_t lw = *(const f32x4_t*)(p.rw_ln_w + l * A_W + 4 * lane), lb = *(const f32x4_t*)(p.rw_ln_b + l * A_W + 4 * lane);
            const f32x4_t vv = bf4(*(const u32x2_t*)(p.RW_V() + (size_t)m * A_W + 4 * lane)), gt = bf4(*(const u32x2_t*)(p.RW_GATE() + (size_t)m * A_W + 4 * lane));
            const float bon = p.RW_BON()[(size_t)m * A_H + h];
            const f32x4_t o = (d * rs * lw + lb + bon * vv) * gt;
            *(u32x2_t*)(p.MIX() + (size_t)m * D + 4 * lane) = pk4(o);
        }
        {
            const u32x4_t o0 = *(const u32x4_t*)(p.OB() + (size_t)m * B_W + 8 * lane), o1 = *(const u32x4_t*)(p.OB() + ((size_t)NTOK + m) * B_W + 8 * lane);
            const f32x4_t a = bf4((u32x2_t){o0.x, o0.y}) + bf4((u32x2_t){o1.x, o1.y}), b = bf4((u32x2_t){o0.z, o0.w}) + bf4((u32x2_t){o1.z, o1.w});
            const float rs = frsq(grp16_sum(hsq4(a) + hsq4(b)) * (1.0f / 128.f) + 1e-6f);
            const u32x4_t zr = *(const u32x4_t*)(p.U() + (size_t)m * INP + B_OFF + 1536 + 8 * lane);
            const float* nw = p.gdn_norm + l * 128 + ((8 * lane) & 127);
            const f32x4_t n0 = *(const f32x4_t*)nw, n1 = *(const f32x4_t*)(nw + 4);
            const f32x4_t z0 = {bflo(zr.x), bfhi(zr.x), bflo(zr.y), bfhi(zr.y)}, z1 = {bflo(zr.z), bfhi(zr.z), bflo(zr.w), bfhi(zr.w)};
            f32x4_t s0, s1;
#pragma unroll
            for (int c = 0; c < 4; ++c) { s0[c] = z0[c] * frcp(1.0f + __expf(-z0[c])); s1[c] = z1[c] * frcp(1.0f + __expf(-z1[c])); }
            const f32x4_t r0 = a * rs * n0 * s0, r1 = b * rs * n1 * s1;
            u32x4_t w; const u32x2_t w0 = pk4(r0), w1 = pk4(r1); w.x = w0.x; w.y = w0.y; w.z = w1.x; w.w = w1.y;
            *(u32x4_t*)(p.MIX() + (size_t)m * D + 256 + 8 * lane) = w;
        }
    }
}
constexpr int RT_TK = 0, RT_TKS = 2064, RT_PL = 34816, RT_LG = RT_PL + 16384, RT_CNT = RT_LG + 2304, RT_BASE = RT_CNT + 128, RT_ASG = RT_BASE + 128, RT_ASG_MAX = 4096;
__device__ __forceinline__ void dev_resid_router(const P& p, int l, int ntok_l, LAS unsigned char* lds, int G, int tid) {
    const int lane = tid & 63, wave = tid >> 6;
    LAS int* LCNT = (LAS int*)(lds + RT_CNT); LAS int* LBASE = (LAS int*)(lds + RT_BASE); LAS int* ASG = (LAS int*)(lds + RT_ASG);
    LAS float* PL = (LAS float*)(lds + RT_PL); LAS float* LG = (LAS float*)(lds + RT_LG);
    if (tid < 32) LCNT[tid] = 0;
    __syncthreads();
    f32x4_t pnr[4], pn2r[4];
#pragma unroll
    for (int j = 0; j < 4; ++j) { const int k = 4 * lane + 256 * j; pnr[j] = *(const f32x4_t*)(p.post_norm + (size_t)(l * 2 + 0) * D + k); pn2r[j] = *(const f32x4_t*)(p.pre_norm + (size_t)(l * 2 + 1) * D + k); }
    const int ngrp = ntok_l / 16; int it = 0;
    for (int grp = blockIdx.x; grp < ngrp; grp += G, ++it) {
        f32x4_t g1r[4], sh2r[4], sc2r[4];
        { const float* md = p.MOD() + ((size_t)l * (BATCH + 1) + mod_row(grp * 16)) * 6 * D;
#pragma unroll
          for (int j = 0; j < 4; ++j) { const int k = 4 * lane + 256 * j; g1r[j] = *(const f32x4_t*)(md + 2 * D + k); sh2r[j] = *(const f32x4_t*)(md + 3 * D + k); sc2r[j] = *(const f32x4_t*)(md + 4 * D + k); } }
#pragma unroll 1
        for (int rr = 0; rr < 2; ++rr) {
            const int ri = wave * 2 + rr, m = grp * 16 + ri;
            const bf16_t* mo = p.MO() + (size_t)m * D; float* xr = p.X() + (size_t)m * D;
            f32x4_t v[4], x[4]; float ss = 0.f;
#pragma unroll
            for (int j = 0; j < 4; ++j) { v[j] = bf4(*(const u32x2_t*)(mo + 4 * lane + 256 * j)); x[j] = *(const f32x4_t*)(xr + 4 * lane + 256 * j); ss += hsq4(v[j]); }
            const float rstd = frsq(wave_sum(ss) * (1.0f / D) + 1e-6f); float s2 = 0.f;
#pragma unroll
            for (int j = 0; j < 4; ++j) { const int k = 4 * lane + 256 * j;
                x[j] = x[j] + g1r[j] * (v[j] * rstd) * pnr[j]; s2 += hsq4(x[j]); *(f32x4_t*)(xr + k) = x[j]; }
            const float r2 = frsq(wave_sum(s2) * (1.0f / D) + 1e-6f);
            { bf16_t* orow = p.HB() + (size_t)m * D; LAS unsigned char* lrow = lds + RT_TK + ri * RT_TKS;
#pragma unroll
              for (int j = 0; j < 4; ++j) { const int k = 4 * lane + 256 * j; const f32x4_t t = x[j] * r2 * pn2r[j] * (1.0f + sc2r[j]) + sh2r[j]; const u32x2_t w = pk4(t); *(u32x2_t*)(orow + k) = w; *(LAS u32x2_t*)(lrow + 2 * k) = w; } }
        }
        __syncthreads();
        {
            const int i = lane & 15, q = lane >> 4; pg8::f32x4 acc0 = {0.f, 0.f, 0.f, 0.f}, acc1 = {0.f, 0.f, 0.f, 0.f};
#pragma unroll
            for (int ks = 0; ks < 4; ++ks) { const int k0 = 128 * wave + 32 * ks + 8 * q;
                const bf16x8_t a = *(const LAS bf16x8_t*)(lds + RT_TK + i * RT_TKS + 2 * k0);
                const bf16x8_t b0 = *(const bf16x8_t*)(p.WR_T(l) + (size_t)i * D + k0), b1 = *(const bf16x8_t*)(p.WR_T(l) + (size_t)(16 + i) * D + k0);
                acc0 = __builtin_amdgcn_mfma_f32_16x16x32_bf16(a, b0, acc0, 0, 0, 0); acc1 = __builtin_amdgcn_mfma_f32_16x16x32_bf16(a, b1, acc1, 0, 0, 0); }
#pragma unroll
            for (int r = 0; r < 4; ++r) { PL[(wave * 16 + 4 * q + r) * 32 + i] = acc0[r]; PL[(wave * 16 + 4 * q + r) * 32 + 16 + i] = acc1[r]; }
        }
        __syncthreads();
        {
            const int ri = tid >> 5, e = tid & 31; float sacc = p.router_b[l * NEXP + e];
#pragma unroll
            for (int w = 0; w < 8; ++w) sacc += PL[(w * 16 + ri) * 32 + e];
            LG[ri * 33 + e] = sacc;
        }
        __syncthreads();
        if (tid < 16) {
            const int m = grp * 16 + tid; float lg[NEXP];
#pragma unroll
            for (int e = 0; e < NEXP; ++e) lg[e] = LG[tid * 33 + e];
            int idx[TOPK]; float val[TOPK];
#pragma unroll
            for (int j = 0; j < TOPK; ++j) { float best = -3.0e38f; int bi = 0;
#pragma unroll
                for (int e = 0; e < NEXP; ++e) { if (lg[e] > best) { best = lg[e]; bi = e; } }
                idx[j] = bi; val[j] = best;
#pragma unroll
                for (int e = 0; e < NEXP; ++e) if (e == bi) lg[e] = -3.0e38f; }
            float sum = 0.f, ex[TOPK];
#pragma unroll
            for (int j = 0; j < TOPK; ++j) { ex[j] = __expf(val[j] - val[0]); sum += ex[j]; }
            const float inv = 1.0f / sum;
#pragma unroll
            for (int j = 0; j < TOPK; ++j) { p.TOPI()[(size_t)m * TOPK + j] = idx[j]; p.TOPG()[(size_t)m * TOPK + j] = ex[j] * inv;
                const int lp = __hip_atomic_fetch_add(&LCNT[idx[j]], 1, __ATOMIC_RELAXED, __HIP_MEMORY_SCOPE_WORKGROUP);
                const int ai = (it * 16 + tid) * 4 + j; if (ai < RT_ASG_MAX) ASG[ai] = (idx[j] << 20) | lp; }
        }
        __syncthreads();
    }
    if (tid < 32) LBASE[tid] = LCNT[tid] > 0 ? atomicAdd(&p.cnt()[l * NEXP + tid], LCNT[tid]) : 0;
    __syncthreads();
    for (int a = tid; a < it * 64 && a < RT_ASG_MAX; a += NTHR) { const int w = ASG[a]; const int e = w >> 20, lp = w & 0xfffff; const int itx = a / 64, ri = (a % 64) / 4, j = a % 4;
        const int m = (blockIdx.x + itx * G) * 16 + ri; p.POS()[(size_t)m * TOPK + j] = LBASE[e] + lp; }
    __syncthreads();
}
__device__ __forceinline__ void dev_slots(const P& p, int l, int ntok_l, LAS unsigned char* lds, long gtid, long nthr, int tid) {
    LAS int* PST = (LAS int*)lds; LAS int* CN = (LAS int*)(lds + 256);
    if (tid == 0) { int acc = 0; for (int e = 0; e < NEXP; ++e) { const int c = p.cnt()[l * NEXP + e]; PST[e] = acc; CN[e] = c; acc += (c + 255) / 256 * 256; } PST[NEXP] = acc; }
    __syncthreads();
    for (long t = gtid; t < (long)ntok_l * TOPK; t += nthr) { const int e = p.TOPI()[t]; const int slot = PST[e] + p.POS()[t]; p.TSLOT()[t] = slot; p.SLOT_TOK()[slot] = (int)(t / TOPK); }
    for (long t = gtid; t < NEXP * 256; t += nthr) { const int e = (int)(t >> 8), i = (int)(t & 255); const int c = CN[e]; const int pads = (c + 255) / 256 * 256 - c; if (i < pads) p.SLOT_TOK()[PST[e] + c + i] = ZROW; }
    for (long t = gtid; t < NBLK_MAX; t += nthr) { int e_of = NEXP - 1;
        for (int e = 0; e < NEXP; ++e) { if ((int)t * 256 >= PST[e] && (int)t * 256 < PST[e + 1]) e_of = e; }
        p.BLOCK_E()[t] = e_of; if (t == 0) p.NBLK()[0] = PST[NEXP] / 256; }
    __syncthreads();
}
struct CbA { int4 sl; f32x4_t gt; };
struct CbB { u32x2_t y[4][4]; f32x4_t x[4]; f32x4_t gt; };
__device__ __forceinline__ void combine_loadA(const P& p, int m, CbA& a) { a.sl = *(const int4*)(p.TSLOT() + (size_t)m * 4); a.gt = *(const f32x4_t*)(p.TOPG() + (size_t)m * 4); }
__device__ __forceinline__ void combine_loadB(const P& p, int m, const CbA& a, int lane, CbB& b) {
    const bf16_t* y0 = p.YB() + (size_t)a.sl.x * D; const bf16_t* y1 = p.YB() + (size_t)a.sl.y * D; const bf16_t* y2 = p.YB() + (size_t)a.sl.z * D; const bf16_t* y3 = p.YB() + (size_t)a.sl.w * D;
    const float* xr = p.X() + (size_t)m * D;
#pragma unroll
    for (int j = 0; j < 4; ++j) { const int k = 4 * lane + 256 * j; b.y[0][j] = *(const u32x2_t*)(y0 + k); b.y[1][j] = *(const u32x2_t*)(y1 + k); b.y[2][j] = *(const u32x2_t*)(y2 + k); b.y[3][j] = *(const u32x2_t*)(y3 + k); b.x[j] = *(const f32x4_t*)(xr + k); }
    b.gt = a.gt;
}
struct CbPar { f32x4_t pn[4], pn1[4], g2[4], sh1[4], sc1[4]; int mrow; };
__device__ __forceinline__ void combine_params(const P& p, int l, int lane, CbPar& q) {
    const bool last = (l == DEPTH - 1);
#pragma unroll
    for (int j = 0; j < 4; ++j) { const int k = 4 * lane + 256 * j; q.pn[j] = *(const f32x4_t*)(p.post_norm + (size_t)(l * 2 + 1) * D + k); q.pn1[j] = last ? q.pn[j] : *(const f32x4_t*)(p.pre_norm + (size_t)((l + 1) * 2 + 0) * D + k); }
    q.mrow = -1;
}
__device__ __forceinline__ void combine_mod(const P& p, int l, int mrow, int lane, CbPar& q) {
    const bool last = (l == DEPTH - 1); const float* md = p.MOD() + ((size_t)l * (BATCH + 1) + mrow) * 6 * D; const float* md1 = p.MOD() + ((size_t)(last ? l : l + 1) * (BATCH + 1) + mrow) * 6 * D;
#pragma unroll
    for (int j = 0; j < 4; ++j) { const int k = 4 * lane + 256 * j; q.g2[j] = *(const f32x4_t*)(md + 5 * D + k); q.sh1[j] = *(const f32x4_t*)(md1 + k); q.sc1[j] = *(const f32x4_t*)(md1 + D + k); }
    q.mrow = mrow;
}
__device__ __forceinline__ void combine_compute(const P& p, int l, int m, const CbB& b, int lane, const CbPar& q) {
    const bool last = (l == DEPTH - 1);
    float* xr = p.X() + (size_t)m * D;
    const f32x4_t gt = b.gt; f32x4_t f[4], x[4]; float ss = 0.f;
#pragma unroll
    for (int j = 0; j < 4; ++j) { const u32x2_t a = b.y[0][j], bb = b.y[1][j], c = b.y[2][j], d = b.y[3][j];
        f[j].x = gt.x * bflo(a.x) + gt.y * bflo(bb.x) + gt.z * bflo(c.x) + gt.w * bflo(d.x); f[j].y = gt.x * bfhi(a.x) + gt.y * bfhi(bb.x) + gt.z * bfhi(c.x) + gt.w * bfhi(d.x);
        f[j].z = gt.x * bflo(a.y) + gt.y * bflo(bb.y) + gt.z * bflo(c.y) + gt.w * bflo(d.y); f[j].w = gt.x * bfhi(a.y) + gt.y * bfhi(bb.y) + gt.z * bfhi(c.y) + gt.w * bfhi(d.y);
        ss += hsq4(f[j]); x[j] = b.x[j]; }
    const float rstd = frsq(wave_sum(ss) * (1.0f / D) + 1e-6f); float s2 = 0.f;
#pragma unroll
    for (int j = 0; j < 4; ++j) { const int k = 4 * lane + 256 * j;
        x[j] = x[j] + q.g2[j] * (f[j] * rstd) * q.pn[j]; s2 += hsq4(x[j]);
#ifdef PROBE_DET
        if (last) { const unsigned cs_ = p.ctl()[12050]; x[j] = (f32x4_t){(float)(cs_ & 0xffffu), (float)((cs_ >> 16) & 0xffffu), 1.f, 2.f}; }
#endif
#ifdef PROBE_T
        if (last) { const unsigned long long* ts = (const unsigned long long*)(p.ctl() + 12100); const float tot = (float)(ts[2 * NPH - 1] - ts[0]);
            float fa = 0.f;
            for (int ll = 0; ll < 2; ++ll) for (int jj = 0; jj < NPH; ++jj) if (((PT_MASK >> jj) & 1) && (1 + ll * NPH + jj + 1 <= 2 * NPH - 1)) fa += (float)(ts[1 + ll * NPH + jj + 1] - ts[1 + ll * NPH + jj]);
            if ((PT_MASK >> 20) & 1) fa += (float)(ts[1] - ts[0]);
#ifdef PT_ACT
            fa = (float)p.ctl()[12070] + (float)p.ctl()[12071];
#endif
#ifdef PT_SEC
#ifndef PT_SEC_SCALE
#define PT_SEC_SCALE 128.0f
#endif
            fa = (float)p.ctl()[12080] * (1.0f / PT_SEC_SCALE);
#endif
            const float fq = floorf(fa / tot * 64.0f + 0.5f) * (1.0f / 64.0f);
            x[j] = x[j] * (1.0f + 0.07f * sqrtf(fq)); }
#endif
#if defined(PROBE_GDN) || defined(PROBE_RWKV)
        if (last) { const float e = ((const float*)(p.ctl() + 12000))[0], r = ((const float*)(p.ctl() + 12001))[0]; x[j] = x[j] * (1.0f + 10.0f * sqrtf(e / r)); }
#endif
        if (last) *(f32x4_t*)(p.out + (size_t)m * D + k) = x[j]; else *(f32x4_t*)(xr + k) = x[j]; }
    if (!last) { const float r2 = frsq(wave_sum(s2) * (1.0f / D) + 1e-6f); bf16_t* orow = p.HB() + (size_t)m * D;
#pragma unroll
        for (int j = 0; j < 4; ++j) { const int k = 4 * lane + 256 * j; const f32x4_t t = x[j] * r2 * q.pn1[j] * (1.0f + q.sc1[j]) + q.sh1[j]; *(u32x2_t*)(orow + k) = pk4(t); } }
}
__device__ __forceinline__ void dev_combine(const P& p, int l, int ntok_l, int G, int wave, int lane) {
    int r0, r1; { const int nw = G * NWAVES, per = (ntok_l + nw - 1) / nw, gwl = (int)blockIdx.x * NWAVES + wave; r0 = gwl * per; r1 = r0 + per; if (r1 > ntok_l) r1 = ntok_l; }
    if (r0 >= r1) return;
    CbPar par; combine_params(p, l, lane, par);
    int m = r0; CbA a0, a1; CbB b0; combine_loadA(p, m, a0); a1 = a0; if (m + 1 < r1) combine_loadA(p, m + 1, a1);
    combine_loadB(p, m, a0, lane, b0);
    for (; m < r1; ++m) {
        CbA a2 = a1; if (m + 2 < r1) combine_loadA(p, m + 2, a2);
        CbB b1 = b0; if (m + 1 < r1) combine_loadB(p, m + 1, a1, lane, b1);
        const int mr = mod_row(m); if (mr != par.mrow) combine_mod(p, l, mr, lane, par);
        combine_compute(p, l, m, b0, lane, par);
        b0 = b1; a1 = a2;
    }
}
__device__ __forceinline__ void lds_barrier() { asm volatile("s_waitcnt lgkmcnt(0)\n\ts_barrier" ::: "memory"); }
#define MMA16(a, b, c) __builtin_amdgcn_mfma_f32_16x16x32_bf16((a), (b), (c), 0, 0, 0)
typedef pg8::f32x4 f32x4;
__device__ __forceinline__ bf16x8_t lfrag(LAS const unsigned char* lds, int off, int ld, int row0, int k0, int lane) {
    return *(LAS const bf16x8_t*)(lds + off + (row0 + (lane & 15)) * ld + (k0 + 8 * (lane >> 4)) * 2);
}
__device__ __forceinline__ bf16x8_t lfrag16(LAS const unsigned char* lds, int off, int ld, int row0, int k0, int lane) {
    bf16x8_t z = {0, 0, 0, 0, 0, 0, 0, 0}; return (lane >> 4) < 2 ? lfrag(lds, off, ld, row0, k0, lane) : z;
}
__device__ __forceinline__ bf16x8_t lfragT(LAS const unsigned char* lds, int off, int ld, int k0, int n0, int kvalid, int lane) {
    bf16x8_t v; const int n = n0 + (lane & 15), kb = 8 * (lane >> 4);
#pragma unroll
    for (int j = 0; j < 8; ++j) v[j] = (kb + j < kvalid) ? *(LAS const short*)(lds + off + (k0 + kb + j) * ld + n * 2) : (short)0;
    return v;
}
__device__ __forceinline__ void st_rm(LAS unsigned char* lds, int off, int ld, int m0, int n0, f32x4 acc, int lane) {
#pragma unroll
    for (int r = 0; r < 4; ++r) *(LAS bf16_t*)(lds + off + (m0 + 4 * (lane >> 4) + r) * ld + (n0 + (lane & 15)) * 2) = f2bf(acc[r]);
}
__device__ __forceinline__ void st_tr(LAS unsigned char* lds, int off, int ld, int m0, int n0, f32x4 acc, int lane) {
    u32x2_t w; w.x = pg8::cvt_pk_bf16(acc[0], acc[1]); w.y = pg8::cvt_pk_bf16(acc[2], acc[3]);
    *(LAS u32x2_t*)(lds + off + (n0 + (lane & 15)) * ld + (m0 + 4 * (lane >> 4)) * 2) = w;
}
__device__ __forceinline__ u32x4_t scale8(u32x4_t v, float s) {
    u32x4_t o; o.x = pg8::cvt_pk_bf16(bflo(v.x) * s, bfhi(v.x) * s); o.y = pg8::cvt_pk_bf16(bflo(v.y) * s, bfhi(v.y) * s);
    o.z = pg8::cvt_pk_bf16(bflo(v.z) * s, bfhi(v.z) * s); o.w = pg8::cvt_pk_bf16(bflo(v.w) * s, bfhi(v.w) * s); return o;
}

template <int LOFF, int TOFF, int SCOFF>
__device__ __forceinline__ void tri_inv64(LAS unsigned char* lds, int tid) {
    const int wave = __builtin_amdgcn_readfirstlane(tid >> 6); int lane = tid & 63, q4 = lane >> 4, l16 = lane & 15;
    if (wave == 0) {
        float x[16];
#pragma unroll
        for (int i = 0; i < 16; ++i) { float sacc = (i == l16) ? 1.f : 0.f;
#pragma unroll
            for (int j = 0; j < i; ++j) sacc -= bf2f(*(LAS const bf16_t*)(lds + LOFF + (16 * q4 + i) * 144 + (16 * q4 + j) * 2)) * x[j];
            x[i] = sacc; }
#pragma unroll
        for (int i = 0; i < 16; ++i) *(LAS bf16_t*)(lds + TOFF + (16 * q4 + i) * 144 + (16 * q4 + l16) * 2) = f2bf(x[i]);
    }
    lds_barrier(); asm volatile("" : "+v"(tid)); lane = tid & 63;
    if (wave < 2) {
        const int I = 2 * wave + 1, J = 2 * wave; const f32x4 z = {0.f, 0.f, 0.f, 0.f};
        const f32x4 m1 = MMA16(lfrag16(lds, LOFF, 144, 16 * I, 16 * J, lane), lfragT(lds, TOFF, 144, 16 * J, 16 * J, 16, lane), z);
        st_rm(lds, SCOFF + wave * 1280, 80, 0, 0, m1, lane);
        asm volatile("s_waitcnt lgkmcnt(0)" ::: "memory");
        const f32x4 t1 = MMA16(lfrag16(lds, TOFF, 144, 16 * I, 16 * I, lane), lfragT(lds, SCOFF + wave * 1280, 80, 0, 0, 16, lane), z);
        st_rm(lds, TOFF, 144, 16 * I, 16 * J, -t1, lane);
    }
    lds_barrier(); asm volatile("" : "+v"(tid)); lane = tid & 63;
    {
        const int mt2 = (wave >> 1) & 1, nt2 = wave & 1; const f32x4 z = {0.f, 0.f, 0.f, 0.f};
        if (wave < 4) { const f32x4 m2 = MMA16(lfrag(lds, LOFF, 144, 32 + 16 * mt2, 0, lane), lfragT(lds, TOFF, 144, 0, 16 * nt2, 32, lane), z); st_rm(lds, SCOFF, 80, 16 * mt2, 16 * nt2, m2, lane); }
        lds_barrier();
        if (wave < 4) { const f32x4 t2 = MMA16(lfrag(lds, TOFF, 144, 32 + 16 * mt2, 32, lane), lfragT(lds, SCOFF, 80, 0, 16 * nt2, 32, lane), z); st_rm(lds, TOFF, 144, 32 + 16 * mt2, 16 * nt2, -t2, lane); }
    }
    lds_barrier();
}

template <int LOFF, int TOFF, int SCOFF, int DGOFF, int TTOFF>
__device__ __forceinline__ void tri_inv64x(LAS unsigned char* lds, int tid) {
    const int wave = __builtin_amdgcn_readfirstlane(tid >> 6); int lane = tid & 63, q4 = lane >> 4, l16 = lane & 15;
    if (wave == 0) {
        LAS const unsigned char* dg = lds + DGOFF + q4 * 1040;
        float x[16];
#pragma unroll
        for (int i = 0; i < 16; ++i) { float s0 = (i == l16) ? 1.f : 0.f, s1 = 0.f;
#pragma unroll
            for (int pc = 0; pc < (i + 3) / 4; ++pc) { const f32x4 lv = *(LAS const f32x4*)(dg + i * 64 + pc * 16);
#pragma unroll
                for (int e = 0; e < 4; ++e) { const int j = 4 * pc + e; if (j < i) { if (j & 1) s1 -= lv[e] * x[j]; else s0 -= lv[e] * x[j]; } } }
            x[i] = s0 + s1; }
#pragma unroll
        for (int i = 0; i < 16; ++i) *(LAS bf16_t*)(lds + TOFF + (16 * q4 + i) * 144 + (16 * q4 + l16) * 2) = f2bf(x[i]);
        u32x4_t w0, w1; w0.x = pg8::cvt_pk_bf16(x[0], x[1]); w0.y = pg8::cvt_pk_bf16(x[2], x[3]); w0.z = pg8::cvt_pk_bf16(x[4], x[5]); w0.w = pg8::cvt_pk_bf16(x[6], x[7]);
        w1.x = pg8::cvt_pk_bf16(x[8], x[9]); w1.y = pg8::cvt_pk_bf16(x[10], x[11]); w1.z = pg8::cvt_pk_bf16(x[12], x[13]); w1.w = pg8::cvt_pk_bf16(x[14], x[15]);
        LAS unsigned char* tt = lds + TTOFF + (16 * q4 + l16) * 80;
        *(LAS u32x4_t*)(tt + (q4 & 1) * 32) = w0; *(LAS u32x4_t*)(tt + (q4 & 1) * 32 + 16) = w1;
        if (q4 & 1) { *(LAS u32x4_t*)tt = (u32x4_t){0u, 0u, 0u, 0u}; *(LAS u32x4_t*)(tt + 16) = (u32x4_t){0u, 0u, 0u, 0u}; }
    }
    lds_barrier(); asm volatile("" : "+v"(tid)); lane = tid & 63; q4 = lane >> 4; l16 = lane & 15;
    if (wave < 2) {
        const int I = 2 * wave + 1, J = 2 * wave; const f32x4 z = {0.f, 0.f, 0.f, 0.f}; const bf16x8_t zf = {0, 0, 0, 0, 0, 0, 0, 0};
        const bf16x8_t bT = q4 < 2 ? *(LAS const bf16x8_t*)(lds + TTOFF + (16 * J + l16) * 80 + (8 * q4) * 2) : zf;
        const f32x4 m1 = MMA16(lfrag16(lds, LOFF, 144, 16 * I, 16 * J, lane), bT, z);
        LAS unsigned char* sc = lds + SCOFF + wave * 1280;
        { u32x2_t w; w.x = pg8::cvt_pk_bf16(m1[0], m1[1]); w.y = pg8::cvt_pk_bf16(m1[2], m1[3]); *(LAS u32x2_t*)(sc + l16 * 48 + (4 * q4) * 2) = w; }
        asm volatile("s_waitcnt lgkmcnt(0)" ::: "memory");
        const bf16x8_t bM = q4 < 2 ? *(LAS const bf16x8_t*)(sc + l16 * 48 + (8 * q4) * 2) : zf;
        const f32x4 t1 = MMA16(lfrag16(lds, TOFF, 144, 16 * I, 16 * I, lane), bM, z);
        st_rm(lds, TOFF, 144, 16 * I, 16 * J, -t1, lane);
        st_tr(lds, TTOFF, 80, 16, 16 * J, -t1, lane);
    }
    lds_barrier(); asm volatile("" : "+v"(tid)); lane = tid & 63;
    {
        const int mt2 = (wave >> 1) & 1, nt2 = wave & 1; const f32x4 z = {0.f, 0.f, 0.f, 0.f};
        if (wave < 4) { const f32x4 m2 = MMA16(lfrag(lds, LOFF, 144, 32 + 16 * mt2, 0, lane), lfrag(lds, TTOFF, 80, 16 * nt2, 0, lane), z); st_tr(lds, SCOFF, 80, 16 * mt2, 16 * nt2, m2, lane); }
        lds_barrier();
        if (wave < 4) { const f32x4 t2 = MMA16(lfrag(lds, TOFF, 144, 32 + 16 * mt2, 32, lane), lfrag(lds, SCOFF, 80, 16 * nt2, 0, lane), z); st_rm(lds, TOFF, 144, 32 + 16 * mt2, 16 * nt2, -t2, lane); }
    }
    lds_barrier();
}

constexpr int GQ_ = 0, GK_ = 17408, GV_ = 34816, GL_ = 53248, GT_ = 62464, GSC_ = 71680, GVB_ = 74240, GKB_ = 92672, GST_ = 111104, GF_ = 145920;
constexpr int LD128 = 272, LD64 = 144, LDSC = 80;
__device__ __forceinline__ void gdn_chain(const bf16_t* __restrict__ gq, const bf16_t* __restrict__ gk, const bf16_t* __restrict__ gv, const float* __restrict__ gg, const float* __restrict__ gbeta, int chain, bf16_t* __restrict__ OBout, LAS unsigned char* lds, int tid, unsigned* ctlp) {
    const int wave = __builtin_amdgcn_readfirstlane(tid >> 6); int lane = tid & 63, q4 = lane >> 4, l16 = lane & 15;
#ifdef PT_SEC
    unsigned long long ts_ = __builtin_amdgcn_s_memrealtime();
#define SEC_MARK(k) do { if (tid == 0) { const unsigned long long n_ = __builtin_amdgcn_s_memrealtime(); if ((k) == PT_SEC) atomicAdd(ctlp + 12080, (unsigned)(n_ - ts_)); ts_ = n_; } } while (0)
#else
#define SEC_MARK(k)
#endif
#define GDN_RELANE() do { asm volatile("" : "+v"(tid)); lane = tid & 63; q4 = lane >> 4; l16 = lane & 15; } while (0)
    const int h = chain % B_H, b = (chain / B_H) % BATCH, dir = chain / (B_H * BATCH);
    LAS float* GF = (LAS float*)(lds + GF_);
    for (int i = tid; i < 34816 / 16; i += NTHR) *(LAS u32x4_t*)(lds + GST_ + 16 * i) = (u32x4_t){0u, 0u, 0u, 0u};
    f32x4 Sacc[8];
#pragma unroll
    for (int nt = 0; nt < 8; ++nt) Sacc[nt] = (f32x4){0.f, 0.f, 0.f, 0.f};
    u32x4_t pq[2], pk[2], pv[2]; float pg = 0.f, pb = 0.f;
#define GDN_LOADS(cc) do { _Pragma("unroll") for (int u = 0; u < 2; ++u) { const int piece = tid + 512 * u, i = piece >> 4, c16 = piece & 15; \
        const size_t ro = (size_t)scan_row(dir, b, 64 * (cc) + i) * B_W + h * 128 + c16 * 8; \
        pq[u] = *(const u32x4_t*)(gq + ro); pk[u] = *(const u32x4_t*)(gk + ro); pv[u] = *(const u32x4_t*)(gv + ro); } \
        if (tid < 64) { const size_t ro = (size_t)scan_row(dir, b, 64 * (cc) + tid) * 8 + dir * 4 + h; pg = gg[ro]; pb = gbeta[ro]; } } while (0)
    GDN_LOADS(0);
    constexpr int NCH = SLEN / 64;
#pragma unroll 1
    for (int c = 0; c < NCH; ++c) {
        GDN_RELANE();
#pragma unroll
        for (int u = 0; u < 2; ++u) { const int piece = tid + 512 * u, i = piece >> 4, c16 = piece & 15;
            *(LAS u32x4_t*)(lds + GQ_ + i * LD128 + c16 * 16) = pq[u]; *(LAS u32x4_t*)(lds + GK_ + i * LD128 + c16 * 16) = pk[u]; *(LAS u32x4_t*)(lds + GV_ + i * LD128 + c16 * 16) = pv[u]; }
        for (int i2 = tid; i2 < 9216 / 16; i2 += NTHR) *(LAS u32x4_t*)(lds + GT_ + 16 * i2) = (u32x4_t){0u, 0u, 0u, 0u};
        if (wave == 0) {
            float x = pg;
#pragma unroll
            for (int o = 1; o < 64; o <<= 1) { const float y = __shfl_up(x, o); if (lane >= o) x += y; }
            const float gl = __shfl(x, 63);
            GF[lane] = x; GF[64 + lane] = pb; GF[128 + lane] = __expf(x); GF[192 + lane] = __expf(gl - x); if (lane == 0) GF[256] = __expf(gl);
        }
        if (c + 1 < NCH) GDN_LOADS(c + 1);
        lds_barrier(); __builtin_amdgcn_sched_barrier(0); GDN_RELANE(); SEC_MARK(1);
        const int mt = wave >> 1;
        f32x4 qk[2];
        {
            f32x4 kk[2]; kk[0] = kk[1] = qk[0] = qk[1] = (f32x4){0.f, 0.f, 0.f, 0.f};
#pragma unroll
            for (int ks = 0; ks < 4; ++ks) { __builtin_amdgcn_sched_barrier(0); const bf16x8_t ak = lfrag(lds, GK_, LD128, 16 * mt, 32 * ks, lane), aq = lfrag(lds, GQ_, LD128, 16 * mt, 32 * ks, lane);
#pragma unroll
                for (int t = 0; t < 2; ++t) { const bf16x8_t bk = lfrag(lds, GK_, LD128, 16 * (2 * (wave & 1) + t), 32 * ks, lane); kk[t] = MMA16(bk, ak, kk[t]); qk[t] = MMA16(bk, aq, qk[t]); } }
#pragma unroll
            for (int t = 0; t < 2; ++t) { const int i = 16 * mt + l16; const float gci = GF[i], bi = GF[64 + i]; f32x4 lv;
#pragma unroll
                for (int r = 0; r < 4; ++r) { const int j = 16 * (2 * (wave & 1) + t) + 4 * q4 + r; const float dec = i >= j ? __expf(gci - GF[j]) : 0.f;
                    lv[r] = i > j ? bi * kk[t][r] * dec : 0.f; qk[t][r] *= dec; }
                st_tr(lds, GL_, LD64, 16 * (2 * (wave & 1) + t), 16 * mt, lv, lane); }
        }
        lds_barrier(); __builtin_amdgcn_sched_barrier(0); GDN_RELANE();
        SEC_MARK(2);
        if (wave >= 4) {
            const int t4 = tid - 256;
#pragma unroll
            for (int rep = 0; rep < 4; ++rep) { const int task = t4 + 256 * rep, cidx = task & 127, jg = task >> 7; float vv[8], kv[8];
#pragma unroll
                for (int jj = 0; jj < 8; ++jj) { const int j = 8 * jg + jj; const float bj = GF[64 + j];
                    vv[jj] = bf2f(*(LAS const bf16_t*)(lds + GV_ + j * LD128 + cidx * 2)) * bj; kv[jj] = bf2f(*(LAS const bf16_t*)(lds + GK_ + j * LD128 + cidx * 2)) * bj * GF[128 + j]; }
                u32x4_t wv, wk; wv.x = pg8::cvt_pk_bf16(vv[0], vv[1]); wv.y = pg8::cvt_pk_bf16(vv[2], vv[3]); wv.z = pg8::cvt_pk_bf16(vv[4], vv[5]); wv.w = pg8::cvt_pk_bf16(vv[6], vv[7]);
                wk.x = pg8::cvt_pk_bf16(kv[0], kv[1]); wk.y = pg8::cvt_pk_bf16(kv[2], kv[3]); wk.z = pg8::cvt_pk_bf16(kv[4], kv[5]); wk.w = pg8::cvt_pk_bf16(kv[6], kv[7]);
                *(LAS u32x4_t*)(lds + GVB_ + cidx * LD64 + jg * 16) = wv; *(LAS u32x4_t*)(lds + GKB_ + cidx * LD64 + jg * 16) = wk; }
#pragma unroll
            for (int u = 0; u < 4; ++u) { const int piece = t4 + 256 * u, i = piece >> 4, c16 = piece & 15; LAS u32x4_t* qp = (LAS u32x4_t*)(lds + GQ_ + i * LD128 + c16 * 16); *qp = scale8(*qp, GF[128 + i]); }
        }
        tri_inv64<GL_, GT_, GSC_>(lds, tid); GDN_RELANE(); SEC_MARK(3);
#pragma unroll
        for (int t = 0; t < 2; ++t) st_tr(lds, GL_, LD64, 16 * (2 * (wave & 1) + t), 16 * mt, qk[t], lane);
        SEC_MARK(4);
        f32x4 accu[4], o[4];
#pragma unroll
        for (int m = 0; m < 4; ++m) accu[m] = o[m] = (f32x4){0.f, 0.f, 0.f, 0.f};
#pragma unroll
        for (int ks = 0; ks < 2; ++ks) { __builtin_amdgcn_sched_barrier(0); const bf16x8_t bb = lfrag(lds, GVB_, LD64, 16 * wave, 32 * ks, lane);
#pragma unroll
            for (int m = 0; m < 4; ++m) accu[m] = MMA16(lfrag(lds, GT_, LD64, 16 * m, 32 * ks, lane), bb, accu[m]); }
        {
            f32x4 accw[4];
#pragma unroll
            for (int m = 0; m < 4; ++m) accw[m] = (f32x4){0.f, 0.f, 0.f, 0.f};
#pragma unroll
            for (int ks = 0; ks < 2; ++ks) { __builtin_amdgcn_sched_barrier(0); const bf16x8_t bb = lfrag(lds, GKB_, LD64, 16 * wave, 32 * ks, lane);
#pragma unroll
                for (int m = 0; m < 4; ++m) accw[m] = MMA16(bb, lfrag(lds, GT_, LD64, 16 * m, 32 * ks, lane), accw[m]); }
            lds_barrier();
#pragma unroll
            for (int m = 0; m < 4; ++m) st_tr(lds, GVB_, LD128, 16 * wave, 16 * m, -accw[m], lane);
        }
#pragma unroll
        for (int rep = 0; rep < 2; ++rep) { const int task = tid + 512 * rep, cidx = task & 127, jg = task >> 7; float kv[8];
#pragma unroll
            for (int jj = 0; jj < 8; ++jj) { const int j = 8 * jg + jj; kv[jj] = bf2f(*(LAS const bf16_t*)(lds + GK_ + j * LD128 + cidx * 2)) * GF[192 + j]; }
            u32x4_t wk; wk.x = pg8::cvt_pk_bf16(kv[0], kv[1]); wk.y = pg8::cvt_pk_bf16(kv[2], kv[3]); wk.z = pg8::cvt_pk_bf16(kv[4], kv[5]); wk.w = pg8::cvt_pk_bf16(kv[6], kv[7]);
            *(LAS u32x4_t*)(lds + GKB_ + cidx * LD64 + jg * 16) = wk; }
        lds_barrier(); __builtin_amdgcn_sched_barrier(0); GDN_RELANE();
        SEC_MARK(5);
#pragma unroll
        for (int ks = 0; ks < 4; ++ks) { __builtin_amdgcn_sched_barrier(0); const bf16x8_t bb = lfrag(lds, GST_, LD128, 16 * wave, 32 * ks, lane);
#pragma unroll
            for (int m = 0; m < 4; ++m) { accu[m] = MMA16(lfrag(lds, GVB_, LD128, 16 * m, 32 * ks, lane), bb, accu[m]); o[m] = MMA16(bb, lfrag(lds, GQ_, LD128, 16 * m, 32 * ks, lane), o[m]); } }
#pragma unroll
        for (int m = 0; m < 4; ++m) st_tr(lds, GV_, LD64, 16 * m, 16 * wave, accu[m], lane);
        lds_barrier(); __builtin_amdgcn_sched_barrier(0); GDN_RELANE();
        const int row0 = scan_row(dir, b, 64 * c), sgn = dir ? -1 : 1;
        SEC_MARK(6);
#pragma unroll
        for (int ks = 0; ks < 2; ++ks) { __builtin_amdgcn_sched_barrier(0); const bf16x8_t bb = lfrag(lds, GV_, LD64, 16 * wave, 32 * ks, lane);
#pragma unroll
            for (int m = 0; m < 4; ++m) o[m] = MMA16(bb, lfrag(lds, GL_, LD64, 16 * m, 32 * ks, lane), o[m]); }
#pragma unroll
        for (int m = 0; m < 4; ++m) { const int i = 16 * m + l16; const int row = row0 + sgn * i;
            u32x2_t w; w.x = pg8::cvt_pk_bf16(o[m][0], o[m][1]); w.y = pg8::cvt_pk_bf16(o[m][2], o[m][3]); *(u32x2_t*)(OBout + (unsigned)((dir * NTOK + row) * B_W + h * 128 + 16 * wave + 4 * q4)) = w; }
        {
            const float gl = GF[256];
#pragma unroll
            for (int nt = 0; nt < 8; ++nt) Sacc[nt] = Sacc[nt] * gl;
#pragma unroll
            for (int ks = 0; ks < 2; ++ks) { __builtin_amdgcn_sched_barrier(0); const bf16x8_t aa = lfrag(lds, GKB_, LD64, 16 * wave, 32 * ks, lane);
#pragma unroll
                for (int nt = 0; nt < 8; ++nt) Sacc[nt] = MMA16(aa, lfrag(lds, GV_, LD64, 16 * nt, 32 * ks, lane), Sacc[nt]); }
#pragma unroll
            for (int nt = 0; nt < 8; ++nt) st_tr(lds, GST_, LD128, 16 * wave, 16 * nt, Sacc[nt], lane);
        }
        lds_barrier(); __builtin_amdgcn_sched_barrier(0); GDN_RELANE(); SEC_MARK(7);
    }
#undef GDN_LOADS
#undef GDN_RELANE
#undef SEC_MARK
}

constexpr int SP_ = 0, SQ_ = 9216, SK_ = 18432, SR_ = 27648, SPT_ = 36864, SQT_ = 46080, SL_ = 55296, ST_ = 64512, SSC_ = 73728, SAT_ = 76288, SNB_ = 85504, SPH_ = 94720, SAH_ = 103936, SCS_ = 113152, SVT_ = 129792, SDC_ = 139008, SSEG_ = 139264;
constexpr int RW_NCH = SLEN / 64, RW_UNITS = 2 * BATCH * A_H * RW_NCH;
constexpr int SDG_ = SCS_  , STT_ = SCS_ + 4352;
struct S1In { float ld[8]; u32x4_t kk, ka, kd, rr, vv; };
__device__ __forceinline__ void rwkv_stage1_load(const P& p, int unit, int tid, S1In& in) {
    const int c = unit % RW_NCH, chain = unit / RW_NCH; const int h = chain % A_H, b = (chain / A_H) % BATCH, dir = chain / (A_H * BATCH);
    const int row0 = scan_row(dir, b, 64 * c), sgn = dir ? -1 : 1;
    { const int k = tid & 63, sg = tid >> 6;
#pragma unroll
      for (int tt = 0; tt < 8; ++tt) in.ld[tt] = p.RW_D()[((size_t)dir * NTOK + (row0 + sgn * (8 * sg + tt))) * A_W + h * 64 + k]; }
    { const int t = tid >> 3, kg = tid & 7; const int row = row0 + sgn * t;
      const size_t o1 = (size_t)row * A_W + h * 64 + 8 * kg, o2 = ((size_t)dir * NTOK + row) * A_W + h * 64 + 8 * kg;
      in.kk = *(const u32x4_t*)(p.RW_KK() + o1); in.ka = *(const u32x4_t*)(p.RW_KKA() + o2); in.kd = *(const u32x4_t*)(p.RW_KD() + o2); in.rr = *(const u32x4_t*)(p.RW_R() + o1); in.vv = *(const u32x4_t*)(p.RW_V() + o1); }
}
__device__ __forceinline__ void rwkv_stage1(const P& p, int unit, const S1In& in, LAS unsigned char* lds, int tid, unsigned* qctr, unsigned& qraw) {
    const int wave = __builtin_amdgcn_readfirstlane(tid >> 6); int lane = tid & 63, q4 = lane >> 4, l16 = lane & 15;
#define RW_RELANE() do { asm volatile("" : "+v"(tid)); lane = tid & 63; q4 = lane >> 4; l16 = lane & 15; } while (0)
#ifdef PT_SEC
    unsigned long long ts1_ = __builtin_amdgcn_s_memrealtime();
#define S1_MARK(k) do { if (tid == 0) { const unsigned long long n_ = __builtin_amdgcn_s_memrealtime(); if ((k) == PT_SEC) atomicAdd(p.ctl() + 12080, (unsigned)(n_ - ts1_)); ts1_ = n_; } } while (0)
#else
#define S1_MARK(k)
#endif
    LAS float* CS = (LAS float*)(lds + SCS_); LAS float* DCv = (LAS float*)(lds + SDC_); LAS float* SEG = (LAS float*)(lds + SSEG_);
    {
        const int k = tid & 63, sg = tid >> 6; float x = 0.f, loc[8];
#pragma unroll
        for (int tt = 0; tt < 8; ++tt) { x += in.ld[tt]; loc[tt] = x; }
        SEG[sg * 64 + k] = x;
        for (int i2 = tid; i2 < 9216 / 16; i2 += NTHR) *(LAS u32x4_t*)(lds + ST_ + 16 * i2) = (u32x4_t){0u, 0u, 0u, 0u};
        lds_barrier();
        float pre = 0.f;
        for (int s2 = 0; s2 < sg; ++s2) pre += SEG[s2 * 64 + k];
#pragma unroll
        for (int tt = 0; tt < 8; ++tt) CS[(8 * sg + tt) * 65 + k] = loc[tt] + pre;
        if (sg == 7) DCv[k] = __expf(loc[7] + pre);
    }
    lds_barrier(); RW_RELANE(); S1_MARK(11);
    {
        const int t = tid >> 3, kg = tid & 7;
        float kk[8], ka[8], kd[8], rr[8], vv[8];
#pragma unroll
        for (int j = 0; j < 4; ++j) { kk[2 * j] = bflo(in.kk[j]); kk[2 * j + 1] = bfhi(in.kk[j]); ka[2 * j] = bflo(in.ka[j]); ka[2 * j + 1] = bfhi(in.ka[j]); kd[2 * j] = bflo(in.kd[j]); kd[2 * j + 1] = bfhi(in.kd[j]);
            rr[2 * j] = bflo(in.rr[j]); rr[2 * j + 1] = bfhi(in.rr[j]); vv[2 * j] = bflo(in.vv[j]); vv[2 * j + 1] = bfhi(in.vv[j]); }
        float pp[8], qq[8], kt[8], rh[8];
#pragma unroll
        for (int j = 0; j < 8; ++j) { const int k = 8 * kg + j; const float cs = CS[t * 65 + k], csm = t > 0 ? CS[(t - 1) * 65 + k] : 0.f; const float e = __expf(cs), ei = frcp(e);
            pp[j] = __expf(csm) * kk[j]; qq[j] = ka[j] * ei; kt[j] = kd[j] * ei; rh[j] = rr[j] * e; }
        u32x4_t w;
        w.x = pg8::cvt_pk_bf16(pp[0], pp[1]); w.y = pg8::cvt_pk_bf16(pp[2], pp[3]); w.z = pg8::cvt_pk_bf16(pp[4], pp[5]); w.w = pg8::cvt_pk_bf16(pp[6], pp[7]); *(LAS u32x4_t*)(lds + SP_ + t * 144 + kg * 16) = w;
        w.x = pg8::cvt_pk_bf16(qq[0], qq[1]); w.y = pg8::cvt_pk_bf16(qq[2], qq[3]); w.z = pg8::cvt_pk_bf16(qq[4], qq[5]); w.w = pg8::cvt_pk_bf16(qq[6], qq[7]); *(LAS u32x4_t*)(lds + SQ_ + t * 144 + kg * 16) = w;
        w.x = pg8::cvt_pk_bf16(kt[0], kt[1]); w.y = pg8::cvt_pk_bf16(kt[2], kt[3]); w.z = pg8::cvt_pk_bf16(kt[4], kt[5]); w.w = pg8::cvt_pk_bf16(kt[6], kt[7]); *(LAS u32x4_t*)(lds + SK_ + t * 144 + kg * 16) = w;
        w.x = pg8::cvt_pk_bf16(rh[0], rh[1]); w.y = pg8::cvt_pk_bf16(rh[2], rh[3]); w.z = pg8::cvt_pk_bf16(rh[4], rh[5]); w.w = pg8::cvt_pk_bf16(rh[6], rh[7]); *(LAS u32x4_t*)(lds + SR_ + t * 144 + kg * 16) = w;
#pragma unroll
        for (int j = 0; j < 8; ++j) { const int k = 8 * kg + j; *(LAS bf16_t*)(lds + SPT_ + k * 144 + t * 2) = f2bf(pp[j]); *(LAS bf16_t*)(lds + SQT_ + k * 144 + t * 2) = f2bf(qq[j]); *(LAS bf16_t*)(lds + SVT_ + k * 144 + t * 2) = f2bf(vv[j]); }
    }
    lds_barrier(); RW_RELANE(); S1_MARK(12);
    const int mt = wave >> 1, ntb = 2 * (wave & 1);
    f32x4 krm[2];
    {
        f32x4 qp[2], kp[2], qr[2];
#pragma unroll
        for (int t2 = 0; t2 < 2; ++t2) qp[t2] = kp[t2] = qr[t2] = krm[t2] = (f32x4){0.f, 0.f, 0.f, 0.f};
#pragma unroll
        for (int ks = 0; ks < 2; ++ks) { const bf16x8_t aP = lfrag(lds, SP_, 144, 16 * mt, 32 * ks, lane), aR = lfrag(lds, SR_, 144, 16 * mt, 32 * ks, lane);
#pragma unroll
            for (int t2 = 0; t2 < 2; ++t2) { const bf16x8_t bQ = lfrag(lds, SQ_, 144, 16 * (ntb + t2), 32 * ks, lane), bK = lfrag(lds, SK_, 144, 16 * (ntb + t2), 32 * ks, lane);
                qp[t2] = MMA16(bQ, aP, qp[t2]); kp[t2] = MMA16(aP, bK, kp[t2]); qr[t2] = MMA16(bQ, aR, qr[t2]); krm[t2] = MMA16(bK, aR, krm[t2]); } }
#pragma unroll
        for (int t2 = 0; t2 < 2; ++t2) {
#pragma unroll
            for (int r = 0; r < 4; ++r) {
                { const int t = 16 * mt + 4 * q4 + r, i = 16 * (ntb + t2) + l16; kp[t2][r] = t > i ? kp[t2][r] : 0.f; }
                { const int i = 16 * (ntb + t2) + 4 * q4 + r, t = 16 * mt + l16; const bool st = t > i, inc = t >= i;
                  qp[t2][r] = st ? qp[t2][r] : 0.f; qr[t2][r] = inc ? -qr[t2][r] : 0.f; krm[t2][r] = inc ? krm[t2][r] : 0.f; } }
            st_tr(lds, SL_, 144, 16 * (ntb + t2), 16 * mt, qp[t2], lane); st_tr(lds, SAT_, 144, 16 * mt, 16 * (ntb + t2), kp[t2], lane); st_tr(lds, SNB_, 144, 16 * (ntb + t2), 16 * mt, qr[t2], lane);
            if (ntb + t2 == mt) *(LAS f32x4*)(lds + SDG_ + mt * 1040 + l16 * 64 + q4 * 16) = qp[t2]; }
    }
    lds_barrier(); RW_RELANE(); S1_MARK(13);
    tri_inv64x<SL_, ST_, SSC_, SDG_, STT_>(lds, tid);
    RW_RELANE(); S1_MARK(14);
    if (tid == 0) qraw = __hip_atomic_fetch_add(qctr, 1u, __ATOMIC_RELAXED, __HIP_MEMORY_SCOPE_AGENT);
    {
        f32x4 ph[2], ah[2];
#pragma unroll
        for (int t2 = 0; t2 < 2; ++t2) ph[t2] = ah[t2] = (f32x4){0.f, 0.f, 0.f, 0.f};
#pragma unroll
        for (int ks = 0; ks < 2; ++ks) { const bf16x8_t aT = lfrag(lds, ST_, 144, 16 * mt, 32 * ks, lane);
#pragma unroll
            for (int t2 = 0; t2 < 2; ++t2) { ph[t2] = MMA16(aT, lfrag(lds, SPT_, 144, 16 * (ntb + t2), 32 * ks, lane), ph[t2]); ah[t2] = MMA16(aT, lfrag(lds, SAT_, 144, 16 * (ntb + t2), 32 * ks, lane), ah[t2]); } }
#pragma unroll
        for (int t2 = 0; t2 < 2; ++t2) { st_tr(lds, SPH_, 144, 16 * mt, 16 * (ntb + t2), ph[t2], lane); st_tr(lds, SAH_, 144, 16 * mt, 16 * (ntb + t2), ah[t2], lane); }
    }
    lds_barrier(); RW_RELANE(); S1_MARK(15);
    {
        f32x4 rh[2], zz[2], kh[2];
#pragma unroll
        for (int t2 = 0; t2 < 2; ++t2) { zz[t2] = kh[t2] = (f32x4){0.f, 0.f, 0.f, 0.f};
            const u32x2_t rw = *(LAS const u32x2_t*)(lds + SR_ + (16 * mt + l16) * 144 + (16 * (ntb + t2) + 4 * q4) * 2);
            rh[t2] = (f32x4){bflo(rw.x), bfhi(rw.x), bflo(rw.y), bfhi(rw.y)}; }
#pragma unroll
        for (int ks = 0; ks < 2; ++ks) { const bf16x8_t aB = lfrag(lds, SNB_, 144, 16 * mt, 32 * ks, lane), aPh = lfrag(lds, SPH_, 144, 16 * mt, 32 * ks, lane), aAh = lfrag(lds, SAH_, 144, 16 * mt, 32 * ks, lane);
#pragma unroll
            for (int t2 = 0; t2 < 2; ++t2) { const bf16x8_t bPh = lfrag(lds, SPH_, 144, 16 * (ntb + t2), 32 * ks, lane), bAh = lfrag(lds, SAH_, 144, 16 * (ntb + t2), 32 * ks, lane), bQt = lfrag(lds, SQT_, 144, 16 * (ntb + t2), 32 * ks, lane);
                rh[t2] = MMA16(bPh, aB, rh[t2]); krm[t2] = MMA16(bAh, aB, krm[t2]); zz[t2] = MMA16(aPh, bQt, zz[t2]); kh[t2] = MMA16(aAh, bQt, kh[t2]); } }
#pragma unroll
        for (int t2 = 0; t2 < 2; ++t2) { const int n = 16 * (ntb + t2) + l16; const float dc = DCv[n];
#pragma unroll
            for (int r = 0; r < 4; ++r) { const int m = 16 * mt + 4 * q4 + r; zz[t2][r] = ((m == n ? 1.f : 0.f) - zz[t2][r]) * dc;
                kh[t2][r] = (bf2f(*(LAS const bf16_t*)(lds + SK_ + m * 144 + n * 2)) - kh[t2][r]) * dc; }
            st_tr(lds, SR_, 144, 16 * (ntb + t2), 16 * mt, rh[t2], lane); st_tr(lds, SL_, 144, 16 * (ntb + t2), 16 * mt, krm[t2], lane);
            st_tr(lds, SP_, 144, 16 * mt, 16 * (ntb + t2), zz[t2], lane); st_tr(lds, SQ_, 144, 16 * mt, 16 * (ntb + t2), kh[t2], lane); }
    }
    lds_barrier(); RW_RELANE(); S1_MARK(16);
    {
        const int row = tid >> 3, c16 = tid & 7; bf16_t* ob = p.RWC() + (size_t)unit * 5 * 4096 + row * 64 + c16 * 8;
        *(u32x4_t*)(ob) = *(LAS const u32x4_t*)(lds + SR_ + row * 144 + c16 * 16);
        *(u32x4_t*)(ob + 4096) = *(LAS const u32x4_t*)(lds + SL_ + row * 144 + c16 * 16);
        *(u32x4_t*)(ob + 2 * 4096) = *(LAS const u32x4_t*)(lds + SP_ + row * 144 + c16 * 16);
        *(u32x4_t*)(ob + 3 * 4096) = *(LAS const u32x4_t*)(lds + SQ_ + row * 144 + c16 * 16);
        *(u32x4_t*)(ob + 4 * 4096) = *(LAS const u32x4_t*)(lds + SVT_ + row * 144 + c16 * 16);
    }
    lds_barrier(); S1_MARK(17);
#undef RW_RELANE
#undef S1_MARK
}
constexpr int S2_M = 0  , S2_S = 46080, S2_HALF = 55296;
__device__ __forceinline__ void rwkv_stage2(const P& p, int pair, bf16_t* YAout, LAS unsigned char* lds0, int tid) {
    const int wave = __builtin_amdgcn_readfirstlane(tid >> 6), half = wave >> 2, w4 = wave & 3; int lane = tid & 63, q4 = lane >> 4, l16 = lane & 15;
    const int chain = 2 * pair + half; const int h = chain % A_H, b = (chain / A_H) % BATCH, dir = chain / (A_H * BATCH);
    LAS unsigned char* lds = lds0 + half * S2_HALF; int t2 = tid & 255;
    for (int i = t2; i < 9216 / 16; i += 256) *(LAS u32x4_t*)(lds + S2_S + 16 * i) = (u32x4_t){0u, 0u, 0u, 0u};
    u32x4_t pre[10];
#define S2_LOADS(cc) do { const bf16_t* ib = p.RWC() + ((size_t)chain * RW_NCH + (cc)) * 5 * 4096; \
        _Pragma("unroll") for (int u = 0; u < 10; ++u) pre[u] = *(const u32x4_t*)(ib + (size_t)(t2 + 256 * u) * 8); } while (0)
    S2_LOADS(0);
#pragma unroll 1
    for (int c = 0; c < RW_NCH; ++c) {
        asm volatile("" : "+v"(tid)); lane = tid & 63; q4 = lane >> 4; l16 = lane & 15; t2 = tid & 255;
#pragma unroll
        for (int u = 0; u < 10; ++u) { const int piece = t2 + 256 * u, mat = piece >> 9, within = piece & 511; *(LAS u32x4_t*)(lds + S2_M + mat * 9216 + (within >> 3) * 144 + (within & 7) * 16) = pre[u]; }
        if (c + 1 < RW_NCH) S2_LOADS(c + 1);
        lds_barrier();
        f32x4 y[4], sn[4];
#pragma unroll
        for (int nt = 0; nt < 4; ++nt) y[nt] = sn[nt] = (f32x4){0.f, 0.f, 0.f, 0.f};
#pragma unroll
        for (int ks = 0; ks < 2; ++ks) {
            const bf16x8_t aR = lfrag(lds, S2_M, 144, 16 * w4, 32 * ks, lane), aM = lfrag(lds, S2_M + 9216, 144, 16 * w4, 32 * ks, lane);
            const bf16x8_t aS = lfrag(lds, S2_S, 144, 16 * w4, 32 * ks, lane), aV = lfrag(lds, S2_M + 4 * 9216, 144, 16 * w4, 32 * ks, lane);
#pragma unroll
            for (int nt = 0; nt < 4; ++nt) { const int n0 = 16 * nt;
                y[nt] = MMA16(lfrag(lds, S2_S, 144, n0, 32 * ks, lane), aR, y[nt]); y[nt] = MMA16(lfrag(lds, S2_M + 4 * 9216, 144, n0, 32 * ks, lane), aM, y[nt]);
                sn[nt] = MMA16(aS, lfrag(lds, S2_M + 2 * 9216, 144, n0, 32 * ks, lane), sn[nt]); sn[nt] = MMA16(aV, lfrag(lds, S2_M + 3 * 9216, 144, n0, 32 * ks, lane), sn[nt]); } }
        const int row0 = scan_row(dir, b, 64 * c), sgn = dir ? -1 : 1;
#pragma unroll
        for (int nt = 0; nt < 4; ++nt) { const int t = 16 * w4 + l16; u32x2_t w; w.x = pg8::cvt_pk_bf16(y[nt][0], y[nt][1]); w.y = pg8::cvt_pk_bf16(y[nt][2], y[nt][3]);
            *(u32x2_t*)(YAout + (unsigned)((dir * NTOK + row0 + sgn * t) * A_W + h * 64 + 16 * nt + 4 * q4)) = w; }
        lds_barrier();
#pragma unroll
        for (int nt = 0; nt < 4; ++nt) st_rm(lds, S2_S, 144, 16 * w4, 16 * nt, sn[nt], lane);
        lds_barrier();
    }
#undef S2_LOADS
}

constexpr int AT_K = 0  , AT_V = 18432  , ATT_NLAT = BATCH * 4 * (SEQ / 256), ATT_NCTX = BATCH * 4 * (CTXL / 256);
__device__ __forceinline__ void attn_unit(const P& p, int unit, LAS unsigned char* lds, int tid) {
    const int wave = __builtin_amdgcn_readfirstlane(tid >> 6); int lane = tid & 63, q4 = lane >> 4, l16 = lane & 15;
    int b, hq, qrow0, nt; bool lat;
    if (unit < ATT_NLAT) { lat = true; b = unit / (4 * (SEQ / 256)); hq = (unit / (SEQ / 256)) % 4; qrow0 = b * SEQ + 256 * (unit % (SEQ / 256)); nt = SLEN / 64; }
    else { const int u2 = unit - ATT_NLAT; lat = false; b = u2 / (4 * (CTXL / 256)); hq = (u2 / (CTXL / 256)) % 4; qrow0 = NLAT + b * CTXL + 256 * (u2 % (CTXL / 256)); nt = CTXL / 64; }
    const int kvh = hq >> 1; qrow0 += 32 * wave;
    bf16x8_t qf[2][2];
#pragma unroll
    for (int qt = 0; qt < 2; ++qt)
#pragma unroll
        for (int ks = 0; ks < 2; ++ks) qf[qt][ks] = *(const bf16x8_t*)(p.CQ() + (size_t)(qrow0 + 16 * qt + l16) * 256 + hq * 64 + 32 * ks + 8 * q4);
    f32x4 o[2][4]; float mrun[2], lrun[2];
#pragma unroll
    for (int qt = 0; qt < 2; ++qt) { mrun[qt] = 0.f; lrun[qt] = 0.f;
#pragma unroll
        for (int dt = 0; dt < 4; ++dt) o[qt][dt] = (f32x4){0.f, 0.f, 0.f, 0.f}; }
    u32x4_t pk, pv;
#define AT_ROWBASE(t) ((lat && (t) < SEQ / 64) ? b * SEQ + 64 * (t) : NLAT + b * CTXL + 64 * ((t) - (lat ? SEQ / 64 : 0)))
#define AT_LOAD(t) do { const size_t ro = (size_t)(AT_ROWBASE(t) + (tid >> 3)) * 128 + kvh * 64 + (tid & 7) * 8; pk = *(const u32x4_t*)(p.CK() + ro); \
        pv = *(const u32x4_t*)(p.CV() + ((size_t)(b * 2 + kvh) * 64 + (tid >> 3)) * SLEN + (lat ? 0 : SEQ) + 64 * (t) + (tid & 7) * 8); } while (0)
#define AT_STORE(buf) do { const int rw = tid >> 3, c16 = tid & 7; *(LAS u32x4_t*)(lds + AT_K + (buf) * 9216 + rw * 144 + c16 * 16) = pk; *(LAS u32x4_t*)(lds + AT_V + (buf) * 9216 + rw * 144 + c16 * 16) = pv; } while (0)
    AT_LOAD(0); AT_STORE(0);
    lds_barrier();
#pragma unroll 1
    for (int t = 0; t < nt; ++t) {
        asm volatile("" : "+v"(tid)); lane = tid & 63; q4 = lane >> 4; l16 = lane & 15;
        const int buf = t & 1;
        if (t + 1 < nt) AT_LOAD(t + 1);
        f32x4 s[2][4];
#pragma unroll
        for (int qt = 0; qt < 2; ++qt)
#pragma unroll
            for (int kt = 0; kt < 4; ++kt) s[qt][kt] = (f32x4){-mrun[qt], -mrun[qt], -mrun[qt], -mrun[qt]};
#pragma unroll
        for (int ks = 0; ks < 2; ++ks)
#pragma unroll
            for (int kt = 0; kt < 4; ++kt) { const bf16x8_t ak = lfrag(lds, AT_K + buf * 9216, 144, 16 * kt, 32 * ks, lane);
                s[0][kt] = MMA16(ak, qf[0][ks], s[0][kt]); s[1][kt] = MMA16(ak, qf[1][ks], s[1][kt]); }
        bf16x8_t pb[2][2];
#pragma unroll
        for (int qt = 0; qt < 2; ++qt) {
            float mx = s[qt][0][0];
#pragma unroll
            for (int kt = 0; kt < 4; ++kt)
#pragma unroll
                for (int r = 0; r < 4; ++r) mx = fmaxf(mx, s[qt][kt][r]);
            mx = fmaxf(mx, __shfl_xor(mx, 16)); mx = fmaxf(mx, __shfl_xor(mx, 32));
            if (__any(mx > 6.0f) || t == 0) { const float dl = (t == 0) ? mx : fmaxf(mx, 0.f), alpha = __builtin_amdgcn_exp2f(-dl); mrun[qt] += dl; lrun[qt] *= alpha;
#pragma unroll
                for (int kt = 0; kt < 4; ++kt) s[qt][kt] = s[qt][kt] - dl;
#pragma unroll
                for (int dt = 0; dt < 4; ++dt) o[qt][dt] = o[qt][dt] * alpha; }
            float ps = 0.f;
#pragma unroll
            for (int kt = 0; kt < 4; ++kt)
#pragma unroll
                for (int r = 0; r < 4; ++r) { const float e = __builtin_amdgcn_exp2f(s[qt][kt][r]); s[qt][kt][r] = e; ps += e; }
            lrun[qt] += ps;
#pragma unroll
            for (int k2 = 0; k2 < 2; ++k2) { u32x4_t w; w.x = pg8::cvt_pk_bf16(s[qt][2 * k2][0], s[qt][2 * k2][1]); w.y = pg8::cvt_pk_bf16(s[qt][2 * k2][2], s[qt][2 * k2][3]);
                w.z = pg8::cvt_pk_bf16(s[qt][2 * k2 + 1][0], s[qt][2 * k2 + 1][1]); w.w = pg8::cvt_pk_bf16(s[qt][2 * k2 + 1][2], s[qt][2 * k2 + 1][3]); pb[qt][k2] = __builtin_bit_cast(bf16x8_t, w); }
        }
#pragma unroll
        for (int k2 = 0; k2 < 2; ++k2)
#pragma unroll
            for (int dt = 0; dt < 4; ++dt) { LAS const unsigned char* vp = lds + AT_V + buf * 9216 + (16 * dt + l16) * 144 + (32 * k2 + 4 * q4) * 2;
                const u32x2_t lo = *(LAS const u32x2_t*)vp, hi = *(LAS const u32x2_t*)(vp + 32); u32x4_t w; w.x = lo.x; w.y = lo.y; w.z = hi.x; w.w = hi.y; const bf16x8_t av = __builtin_bit_cast(bf16x8_t, w);
                o[0][dt] = MMA16(av, pb[0][k2], o[0][dt]); o[1][dt] = MMA16(av, pb[1][k2], o[1][dt]); }
        if (t + 1 < nt) AT_STORE(buf ^ 1);
        lds_barrier();
    }
#pragma unroll
    for (int qt = 0; qt < 2; ++qt) { float l = lrun[qt]; l += __shfl_xor(l, 16); l += __shfl_xor(l, 32); const float inv = 1.0f / l;
        bf16_t* orow = p.MIX() + (size_t)(qrow0 + 16 * qt + l16) * D + 768 + hq * 64 + 4 * q4;
#pragma unroll
        for (int dt = 0; dt < 4; ++dt) { u32x2_t w; w.x = pg8::cvt_pk_bf16(o[qt][dt][0] * inv, o[qt][dt][1] * inv); w.y = pg8::cvt_pk_bf16(o[qt][dt][2] * inv, o[qt][dt][3] * inv); *(u32x2_t*)(orow + 16 * dt) = w; } }
#undef AT_ROWBASE
#undef AT_LOAD
#undef AT_STORE
}


__device__ __forceinline__ void wave_rows(int nrows, int nblk, int blk, int wave, int& r0, int& r1) {
    const int nw = nblk * NWAVES, per = (nrows + nw - 1) / nw, gwl = blk * NWAVES + wave; r0 = gwl * per; r1 = r0 + per; if (r1 > nrows) r1 = nrows; if (r0 > nrows) r0 = nrows;
}
__device__ __forceinline__ float sigm(float x) { return __builtin_amdgcn_rcpf(1.0f + __expf(-x)); }
struct P0Cv { u32x4_t cv[5]; };
struct P0Sm { u32x4_t lr[3]; u32x2_t aq, ak, av; float ga, gb; };
__device__ __forceinline__ void prep0_load_cv(const P& p, int m, int which, int lane, P0Cv& in) {
    int b, t, len, base; row_info(m, b, t, len, base);
#pragma unroll
    for (int j = 0; j < 5; ++j) { const int tt = t + j - 2; in.cv[j] = (tt >= 0 && tt < len) ? *(const u32x4_t*)(p.U() + (size_t)(base + tt) * INP + B_OFF + which * B_W + 8 * lane) : (u32x4_t){0u, 0u, 0u, 0u}; }
}
__device__ __forceinline__ void prep0_compute_cv(const P& p, int l, int m, int which, int lane, const P0Cv& in, const f32x4_t (&cwr)[5][2]) {
    float acc[8];
#pragma unroll
    for (int c = 0; c < 8; ++c) acc[c] = 0.f;
#pragma unroll
    for (int j = 0; j < 5; ++j) { const u32x4_t uv = in.cv[j];
        const f32x4_t w0 = cwr[j][0], w1 = cwr[j][1];
        acc[0] += bflo(uv.x) * w0.x; acc[1] += bfhi(uv.x) * w0.y; acc[2] += bflo(uv.y) * w0.z; acc[3] += bfhi(uv.y) * w0.w;
        acc[4] += bflo(uv.z) * w1.x; acc[5] += bfhi(uv.z) * w1.y; acc[6] += bflo(uv.w) * w1.z; acc[7] += bfhi(uv.w) * w1.w; }
    float ss = 0.f;
#pragma unroll
    for (int c = 0; c < 8; ++c) { acc[c] = acc[c] * sigm(acc[c]); ss += acc[c] * acc[c]; }
    float rn = 1.0f;
    if (which < 2) rn = (frsq(grp16_sum(ss) + 1e-6f)) * (which == 0 ? 0.08838834764831845f : 1.0f);
    u32x4_t w; w.x = pg8::cvt_pk_bf16(acc[0] * rn, acc[1] * rn); w.y = pg8::cvt_pk_bf16(acc[2] * rn, acc[3] * rn); w.z = pg8::cvt_pk_bf16(acc[4] * rn, acc[5] * rn); w.w = pg8::cvt_pk_bf16(acc[6] * rn, acc[7] * rn);
    *(u32x4_t*)((which == 0 ? p.GQ() : which == 1 ? p.GK() : p.GV()) + (size_t)m * B_W + 8 * lane) = w;
}
__device__ __forceinline__ void prep0_load_sm(const P& p, int m, int lane, P0Sm& in) {
    int b, t, len, base; row_info(m, b, t, len, base);
    const bf16_t* ur = p.U() + (size_t)m * INP; const bool hp = t > 0, hn = t + 1 < len;
    { const int c = 768 + 8 * (lane < 24 ? lane : 23); const u32x4_t z = {0u, 0u, 0u, 0u};
      in.lr[0] = *(const u32x4_t*)(ur + c); in.lr[1] = hp ? *(const u32x4_t*)(ur + c - INP) : z; in.lr[2] = hn ? *(const u32x4_t*)(ur + c + INP) : z; }
    in.aq = *(const u32x2_t*)(ur + C_OFF + 4 * lane); in.ak = *(const u32x2_t*)(ur + C_OFF + 256 + 4 * (lane & 31)); in.av = *(const u32x2_t*)(ur + C_OFF + 384 + 4 * (lane & 31));
    in.ga = bf2f(ur[B_OFF + 2048 + (lane & 7)]); in.gb = bf2f(ur[B_OFF + 2056 + (lane & 7)]);
}
struct P0Par { f32x4_t m0, m1, qn, kn; float dtb, alog; };
__device__ __forceinline__ void prep0_params(const P& p, int l, int lane, P0Par& q) {
    const float* mup = p.rw_mu + l * A_IN + 768 + 8 * (lane < 24 ? lane : 23); q.m0 = *(const f32x4_t*)mup; q.m1 = *(const f32x4_t*)(mup + 4);
    q.qn = *(const f32x4_t*)(p.attn_q_norm + l * 64 + 4 * (lane & 15)); q.kn = *(const f32x4_t*)(p.attn_k_norm + l * 64 + 4 * (lane & 15));
    q.dtb = p.gdn_dt_bias[(l * 2 + ((lane & 7) >> 2)) * B_H + (lane & 3)]; q.alog = p.gdn_a_log[(l * 2 + ((lane & 7) >> 2)) * B_H + (lane & 3)];
}
__device__ __forceinline__ void prep0_compute_sm(const P& p, int l, int m, int lane, const P0Sm& in, const P0Par& par) {
    const int i16 = lane & 15; int b, t, len, base; row_info(m, b, t, len, base);
    if (lane < 32) {
        u32x4_t w = {0u, 0u, 0u, 0u};
        if (lane < 24) {
            const f32x4_t m0 = par.m0, m1 = par.m1;
            float u[8], up[8], un[8], o[8];
#pragma unroll
            for (int j = 0; j < 4; ++j) { u[2 * j] = bflo(in.lr[0][j]); u[2 * j + 1] = bfhi(in.lr[0][j]); up[2 * j] = bflo(in.lr[1][j]); up[2 * j + 1] = bfhi(in.lr[1][j]); un[2 * j] = bflo(in.lr[2][j]); un[2 * j + 1] = bfhi(in.lr[2][j]); }
            const int grp = lane >> 3;
#pragma unroll
            for (int j = 0; j < 8; ++j) { const float mu = j < 4 ? m0[j & 3] : m1[j & 3]; const float v = u[j] + mu * (0.5f * (up[j] + un[j]) - u[j]);
                const float e = __expf(grp == 0 ? 2.0f * v : -v), rc = frcp(1.0f + e); o[j] = grp == 0 ? 1.0f - 2.0f * rc : (grp == 1 ? v : rc); }
            w.x = pg8::cvt_pk_bf16(o[0], o[1]); w.y = pg8::cvt_pk_bf16(o[2], o[3]); w.z = pg8::cvt_pk_bf16(o[4], o[5]); w.w = pg8::cvt_pk_bf16(o[6], o[7]);
        }
        *(u32x4_t*)(p.LRT() + (size_t)m * 256 + 8 * lane) = w;
    }
    if (lane < 8) {
        const float xs = in.ga + par.dtb; const float sp = xs > 20.f ? xs : __logf(1.0f + __expf(xs));
        p.GG()[(size_t)m * 8 + lane] = -__expf(par.alog) * sp; p.GBETA()[(size_t)m * 8 + lane] = sigm(in.gb); }
    {
        const int i = i16; f32x4_t cs = {1.f, 1.f, 1.f, 1.f}, sn = {0.f, 0.f, 0.f, 0.f};
        if (m < NLAT) { cs = *(const f32x4_t*)(p.ROPE() + (size_t)t * 128 + 4 * i); sn = *(const f32x4_t*)(p.ROPE() + (size_t)t * 128 + 64 + 4 * i); }
        const float sgn = (i & 4) ? 1.f : -1.f;
        {
            const f32x4_t x = bf4(in.aq); const float rstd = (frsq(grp16_sum(hsq4(x)) * (1.0f / 64.f) + 1e-6f)) * 0.18033688011112042f;
            const f32x4_t nw = par.qn; f32x4_t y = x * rstd * nw, o;
#pragma unroll
            for (int c = 0; c < 4; ++c) { const float pr = __shfl_xor(y[c], 4); o[c] = y[c] * cs[c] + sgn * pr * sn[c]; }
            *(u32x2_t*)(p.CQ() + (size_t)m * 256 + 4 * lane) = pk4(o);
        }
        {
            const f32x4_t x = bf4(in.ak); const float rstd = frsq(grp16_sum(hsq4(x)) * (1.0f / 64.f) + 1e-6f);
            const f32x4_t nw = par.kn; f32x4_t y = x * rstd * nw, o;
#pragma unroll
            for (int c = 0; c < 4; ++c) { const float pr = __shfl_xor(y[c], 4); o[c] = y[c] * cs[c] + sgn * pr * sn[c]; }
            if (lane < 32) { *(u32x2_t*)(p.CK() + (size_t)m * 128 + 4 * lane) = pk4(o);
                const u32x2_t vv = in.av; const int key = m < NLAT ? t : SEQ + t;
                bf16_t* vt = p.CV() + ((size_t)(b * 2 + (lane >> 4)) * 64 + 4 * (lane & 15)) * SLEN + key;
                vt[0] = (bf16_t)(vv.x & 0xffffu); vt[SLEN] = (bf16_t)(vv.x >> 16); vt[2 * SLEN] = (bf16_t)(vv.y & 0xffffu); vt[3 * SLEN] = (bf16_t)(vv.y >> 16); }
        }
    }
}
__device__ __forceinline__ u32x4_t prep0_row(const P& p, int row, int which, int lane) {
    return (row >= 0 && row < NTOK) ? *(const u32x4_t*)(p.U() + (size_t)row * INP + B_OFF + which * B_W + 8 * lane) : (u32x4_t){0u, 0u, 0u, 0u};
}
__device__ __forceinline__ void dev_prep0(const P& p, int l, int G, int wave, int lane) {
    const int per = (NTOK + G - 1) / G, t0 = (int)blockIdx.x * per, t1 = (t0 + per < NTOK) ? t0 + per : NTOK;
#ifdef PT_P0
    const unsigned long long tp0_ = __builtin_amdgcn_s_memrealtime();
#endif
    {
        const int pw = (per + NWAVES - 1) / NWAVES, r0 = t0 + wave * pw, r1 = (r0 + pw < t1) ? r0 + pw : t1;
#pragma unroll 1
        for (int which = 0; which < 3; ++which) {
            if (r0 >= r1) break;
            f32x4_t cwr[5][2];
#pragma unroll
            for (int j = 0; j < 5; ++j) { const float* cw = p.gdn_conv + ((size_t)l * 5 + j) * (3 * B_W) + which * B_W + 8 * lane; cwr[j][0] = *(const f32x4_t*)cw; cwr[j][1] = *(const f32x4_t*)(cw + 4); }
            u32x4_t w0 = prep0_row(p, r0 - 2, which, lane), w1 = prep0_row(p, r0 - 1, which, lane), w2 = prep0_row(p, r0, which, lane), w3 = prep0_row(p, r0 + 1, which, lane);
            u32x4_t n0 = prep0_row(p, r0 + 2, which, lane), n1 = prep0_row(p, r0 + 3, which, lane);
            for (int m = r0; m < r1; m += 2) {
                const u32x4_t w4 = n0, w5 = n1; n0 = prep0_row(p, m + 4, which, lane); n1 = prep0_row(p, m + 5, which, lane);
                {
                    int b, t, len, base; row_info(m, b, t, len, base); P0Cv use; use.cv[0] = w0; use.cv[1] = w1; use.cv[2] = w2; use.cv[3] = w3; use.cv[4] = w4;
#pragma unroll
                    for (int j = 0; j < 5; ++j) { const int tt = t + j - 2; if (tt < 0 || tt >= len) use.cv[j] = (u32x4_t){0u, 0u, 0u, 0u}; }
                    prep0_compute_cv(p, l, m, which, lane, use, cwr);
                }
                if (m + 1 < r1) {
                    int b, t, len, base; row_info(m + 1, b, t, len, base); P0Cv use; use.cv[0] = w1; use.cv[1] = w2; use.cv[2] = w3; use.cv[3] = w4; use.cv[4] = w5;
#pragma unroll
                    for (int j = 0; j < 5; ++j) { const int tt = t + j - 2; if (tt < 0 || tt >= len) use.cv[j] = (u32x4_t){0u, 0u, 0u, 0u}; }
                    prep0_compute_cv(p, l, m + 1, which, lane, use, cwr);
                }
                w0 = w2; w1 = w3; w2 = w4; w3 = w5;
            }
        }
    }
#ifdef PT_P0
    const unsigned long long tp1_ = __builtin_amdgcn_s_memrealtime();
#endif
    const int first = t0 + wave, ntk = first < t1 ? (t1 - first + NWAVES - 1) / NWAVES : 0;
    {
        P0Par par; prep0_params(p, l, lane, par);
        P0Sm cur; if (ntk > 0) prep0_load_sm(p, first, lane, cur);
        for (int i = 0; i < ntk; ++i) { const int m = first + i * NWAVES; P0Sm nxt = cur; if (i + 1 < ntk) prep0_load_sm(p, m + NWAVES, lane, nxt); prep0_compute_sm(p, l, m, lane, cur, par); cur = nxt; }
    }
#ifdef PT_P0
    { const unsigned long long tp2_ = __builtin_amdgcn_s_memrealtime(); const unsigned d_ = PT_P0 == 1 ? (unsigned)(tp1_ - tp0_) : (unsigned)(tp2_ - tp1_); if (lane == 0) atomicMax(p.ctl() + 12070 + l, d_); }
#endif
}
__device__ __forceinline__ void dev_build_rope(const P& p, long gtid, long nthr) {
    for (long e = gtid; e < (long)SEQ * 64; e += nthr) { const int t = (int)(e >> 6), d = (int)(e & 63); const float pos = d < 32 ? (float)(t / GRID_W) : (float)(t % GRID_W);
        const float ang = pos * exp2f(-0.8304820237218406f * (float)(d & 15)); p.ROPE()[(size_t)t * 128 + d] = cosf(ang); p.ROPE()[(size_t)t * 128 + 64 + d] = sinf(ang); }
}
struct A1In { u32x2_t u[3][3]; u32x2_t lro[5]; };
__device__ __forceinline__ void prepA1_load(const P& p, int m, int lane, A1In& in) {
    int b, t, len, base; row_info(m, b, t, len, base);
    const bf16_t* ur = p.U() + (size_t)m * INP; const bool hp = t > 0, hn = t + 1 < len; const u32x2_t z = {0u, 0u};
#pragma unroll
    for (int a = 0; a < 3; ++a) { const int c = 256 * a + 4 * lane; in.u[a][1] = *(const u32x2_t*)(ur + c); in.u[a][0] = hp ? *(const u32x2_t*)(ur + c - INP) : z; in.u[a][2] = hn ? *(const u32x2_t*)(ur + c + INP) : z; }
    const bf16_t* lo = p.LRO() + (size_t)m * 1280 + 4 * lane;
#pragma unroll
    for (int g = 0; g < 5; ++g) in.lro[g] = *(const u32x2_t*)(lo + 256 * g);
}
__device__ __forceinline__ void dev_prepA1(const P& p, int l, int gw, int ngw, int lane) {
    const int h = lane >> 4;
    const f32x4_t kkp = *(const f32x4_t*)(p.rw_k_k + l * A_W + 4 * lane), kap = *(const f32x4_t*)(p.rw_k_a + l * A_W + 4 * lane), rkp = *(const f32x4_t*)(p.rw_r_k + l * A_W + 4 * lane);
    f32x4_t mu3[3], w0p[2], a0p[2];
#pragma unroll
    for (int a = 0; a < 3; ++a) mu3[a] = *(const f32x4_t*)(p.rw_mu + l * A_IN + 256 * a + 4 * lane);
#pragma unroll
    for (int dir = 0; dir < 2; ++dir) { w0p[dir] = *(const f32x4_t*)(p.rw_w0 + (l * 2 + dir) * A_W + 4 * lane); a0p[dir] = *(const f32x4_t*)(p.rw_a0 + (l * 2 + dir) * A_W + 4 * lane); }
    int m = gw; if (m >= NTOK) return;
    A1In cur; prepA1_load(p, m, lane, cur);
    for (; m < NTOK; m += ngw) {
        A1In nxt = cur; if (m + ngw < NTOK) prepA1_load(p, m + ngw, lane, nxt);
        f32x4_t rkv[3];
#pragma unroll
        for (int a = 0; a < 3; ++a) { const f32x4_t u = bf4(cur.u[a][1]); rkv[a] = u + mu3[a] * (0.5f * (bf4(cur.u[a][0]) + bf4(cur.u[a][2])) - u); }
        const f32x4_t r = rkv[0], k = rkv[1], v = rkv[2];
        const f32x4_t kx = k * kkp; const float rn = frsq(grp16_sum(hsq4(kx)) + 1e-6f); const f32x4_t kk = kx * rn;
        f32x4_t kdsum = {0.f, 0.f, 0.f, 0.f};
#pragma unroll
        for (int dir = 0; dir < 2; ++dir) {
            const f32x4_t w = w0p[dir] + bf4(cur.lro[dir]);
            const f32x4_t a = a0p[dir] + bf4(cur.lro[2 + dir]);
            f32x4_t ld, ic;
#pragma unroll
            for (int c = 0; c < 4; ++c) { const float nw = -w[c]; const float sp = nw > 20.f ? nw : __logf(1.0f + __expf(nw)); ld[c] = -__expf(-sp - 0.5f); ic[c] = sigm(a[c]); }
            const f32x4_t kd = k * (1.0f + (ic - 1.0f) * kap); kdsum = kdsum + kd;
            const size_t o = ((size_t)dir * NTOK + m) * A_W + 4 * lane;
            *(f32x4_t*)(p.RW_D() + o) = ld; *(u32x2_t*)(p.RW_KD() + o) = pk4(kd); *(u32x2_t*)(p.RW_KKA() + o) = pk4(kk * ic);
        }
        const size_t o1 = (size_t)m * A_W + 4 * lane;
        *(u32x2_t*)(p.RW_R() + o1) = pk4(r); *(u32x2_t*)(p.RW_V() + o1) = pk4(v); *(u32x2_t*)(p.RW_KK() + o1) = pk4(kk); *(u32x2_t*)(p.RW_GATE() + o1) = cur.lro[4];
        const float bon = grp16_sum(hsum4(r * kdsum * rkp));
        if ((lane & 15) == 0) p.RW_BON()[(size_t)m * A_H + h] = bon;
        cur = nxt;
    }
}
__device__ __forceinline__ void dev_build_wlr(const P& p, int l, long gtid, long nthr) {
    for (long e = gtid; e < 1280L * 256; e += nthr) { const int n = (int)(e >> 8), k = (int)(e & 255), g = n >> 8, ch = n & 255; float v = 0.f;
        if (g < 2) { if ((k >> 5) == g) v = p.rw_w2[((size_t)(l * 2 + g) * 32 + (k & 31)) * A_W + ch]; }
        else if (g < 4) { if ((k >> 5) == g) v = p.rw_a2[((size_t)(l * 2 + (g - 2)) * 32 + (k & 31)) * A_W + ch]; }
        else { if (k >= 128 && k < 192) v = p.rw_g2[((size_t)l * 64 + (k - 128)) * A_W + ch]; }
        p.WLR_T(l)[e] = f2bf(v); }
}

constexpr int RING_BYTES = 131072, MISC_OFF = 147200, LDS_BYTES = 147456;
constexpr size_t MiB = 1u << 20;
constexpr int CW_BAR = 4096, CW_CNT = 8192;

__device__ __forceinline__ void transpose_item(const float* W, int K, int N, bf16_t* WT, LAS float* scr, int item, int lane) {
    const int nblk_k = K / 64; const int nb = item / nblk_k, kb = item % nblk_k, k0 = 64 * kb, n0 = 64 * nb;
    const int nl = 4 * (lane & 15), kq = lane >> 4;
    f32x4 v[16];
#pragma unroll
    for (int i = 0; i < 16; ++i) { const float* src = W + (size_t)(k0 + 4 * i + kq) * N + n0 + nl;
        if (n0 + nl + 3 < N) v[i] = *(const f32x4*)src;
        else { v[i] = (f32x4){0.f, 0.f, 0.f, 0.f}; if (n0 + nl < N) v[i][0] = src[0]; if (n0 + nl + 1 < N) v[i][1] = src[1]; if (n0 + nl + 2 < N) v[i][2] = src[2]; } }
#pragma unroll
    for (int i = 0; i < 16; ++i) { LAS float* d = scr + (4 * i + kq) * 65 + nl; d[0] = v[i][0]; d[1] = v[i][1]; d[2] = v[i][2]; d[3] = v[i][3]; }
    asm volatile("s_waitcnt lgkmcnt(0)" ::: "memory");
    const int c = lane & 7;
#pragma unroll
    for (int j = 0; j < 8; ++j) { const int n = (lane >> 3) + 8 * j; const LAS float* sp = scr + (8 * c) * 65 + n;
        pg8::u32x4 o; o.x = pg8::cvt_pk_bf16(sp[0 * 65], sp[1 * 65]); o.y = pg8::cvt_pk_bf16(sp[2 * 65], sp[3 * 65]); o.z = pg8::cvt_pk_bf16(sp[4 * 65], sp[5 * 65]); o.w = pg8::cvt_pk_bf16(sp[6 * 65], sp[7 * 65]);
        *(pg8::u32x4*)(WT + (size_t)(n0 + n) * K + k0 + 8 * c) = o; }
    asm volatile("s_waitcnt lgkmcnt(0)" ::: "memory");
}

struct Args { P p; int ph_lo, ph_hi; };

#define RUN_TASKS(ntasks, call) do { const long _n = (long)(ntasks); for (long task = gtid; task < _n; task += nthr) { call; } } while (0)


__device__ __forceinline__ void dev_mod(const P& p, int cg, LAS unsigned char* lds, int tid) {
    LAS float* STB = (LAS float*)lds; LAS float* PT = (LAS float*)(lds + 69632);
    const int lane = tid & 63, wave = tid >> 6; const int lyr = cg / 96, j0 = (cg % 96) * 64;
    for (int idx = tid; idx < (BATCH + 1) * D; idx += NTHR) { const int r = idx >> 10, k = idx & 1023; const float v = r < BATCH ? p.c[(size_t)r * D + k] : p.c_ctx[k]; STB[idx] = v / (1.0f + __expf(-v)); }
    __syncthreads();
    float acc[BATCH + 1];
#pragma unroll
    for (int r = 0; r <= BATCH; ++r) acc[r] = 0.f;
    const float* w = p.ada_w + ((size_t)lyr * D + 128 * wave) * 6 * D + j0 + lane;
#pragma unroll 4
    for (int k = 0; k < 128; ++k) { const float wv = w[(size_t)k * 6 * D];
#pragma unroll
        for (int r = 0; r <= BATCH; ++r) acc[r] += STB[r * D + 128 * wave + k] * wv; }
#pragma unroll
    for (int r = 0; r <= BATCH; ++r) PT[(wave * (BATCH + 1) + r) * 64 + lane] = acc[r];
    __syncthreads();
    for (int idx = tid; idx < (BATCH + 1) * 64; idx += NTHR) { const int r = idx >> 6, jj = idx & 63; float sacc = p.ada_b[(size_t)lyr * 6 * D + j0 + jj];
#pragma unroll
        for (int w2 = 0; w2 < 8; ++w2) sacc += PT[(w2 * (BATCH + 1) + r) * 64 + jj];
        p.MOD()[((size_t)lyr * (BATCH + 1) + r) * 6 * D + j0 + jj] = sacc; }
    __syncthreads();
}
constexpr int CV_I_IN = (D / 64) * (INP / 64), CV_I_OUT = (D / 64) * (D / 64), CV_I_R = (D / 64), CV_I_GU = (D / 64) * (2 * DEXP / 64), CV_I_DN = (DEXP / 64) * (D / 64);
constexpr int CV_SMALL = CV_I_IN + CV_I_OUT + CV_I_R, CV_TOTAL = CV_SMALL + NEXP * (CV_I_GU + CV_I_DN), CV_CHUNK = 8;
constexpr int CV_NCH_SMALL = (CV_SMALL + CV_CHUNK - 1) / CV_CHUNK, CV_NCH_MOE = (CV_TOTAL - CV_SMALL + CV_CHUNK - 1) / CV_CHUNK;
__device__ __forceinline__ void conv_chunk(const P& p, int l, bool moe, int chunk, LAS unsigned char* ldsp, int wave, int lane) {
    LAS float* scr = (LAS float*)(ldsp + wave * 16896);
    for (int i = 0; i < CV_CHUNK / NWAVES; ++i) {
        int r = chunk * CV_CHUNK + wave + NWAVES * i; if (moe) { r += CV_SMALL; if (r >= CV_TOTAL) break; } else if (r >= CV_SMALL) break;
        if (r < CV_I_IN) { transpose_item(p.w_in + (size_t)l * D * INW, D, INW, p.WIN_T(l), scr, r, lane); continue; } r -= CV_I_IN;
        if (r < CV_I_OUT) { transpose_item(p.w_out + (size_t)l * D * D, D, D, p.WOUT_T(l), scr, r, lane); continue; } r -= CV_I_OUT;
        if (r < CV_I_R) { transpose_item(p.router_w + (size_t)l * D * NEXP, D, NEXP, p.WR_T(l), scr, r, lane); continue; } r -= CV_I_R;
        if (r < NEXP * CV_I_GU) { const int e = r / CV_I_GU; transpose_item(p.exp_w_gu + ((size_t)l * NEXP + e) * D * 2 * DEXP, D, 2 * DEXP, p.WGU_T(l) + (size_t)e * 2 * DEXP * D, scr, r % CV_I_GU, lane); continue; } r -= NEXP * CV_I_GU;
        { const int e = r / CV_I_DN; transpose_item(p.exp_w_dn + ((size_t)l * NEXP + e) * DEXP * D, DEXP, D, p.WDN_T(l) + (size_t)e * D * DEXP, scr, r % CV_I_DN, lane); }
    }
}

__device__ __forceinline__ int q_next(unsigned* ctr, volatile LAS unsigned* slot, int tid) {
    if (tid == 0) *slot = __hip_atomic_fetch_add(ctr, 1u, __ATOMIC_RELAXED, __HIP_MEMORY_SCOPE_AGENT);
    __syncthreads(); const int v = (int)*slot; __syncthreads(); return v;
}

__device__ __forceinline__ int q_filler(unsigned* cctr, unsigned* dctr, unsigned nitems, volatile LAS unsigned* slot, int tid) {
    if (tid == 0) { const unsigned d = __hip_atomic_load(dctr, __ATOMIC_RELAXED, __HIP_MEMORY_SCOPE_AGENT); *slot = d >= nitems ? 0x7fffffffu : __hip_atomic_fetch_add(cctr, 1u, __ATOMIC_RELAXED, __HIP_MEMORY_SCOPE_AGENT); }
    __syncthreads(); const int v = (int)*slot; __syncthreads(); return v;
}

#ifndef DBG_PH
#define DBG_PH -1
#endif
#define PHON(j) (DBG_PH < 0 || DBG_PH == (j))
#define IN(k) (lo <= (k) && (k) < hi)
#define TID_NOW() (wave_s * 64 + (int)__builtin_amdgcn_mbcnt_hi(~0u, __builtin_amdgcn_mbcnt_lo(~0u, 0u)))
#define PHASE_VARS P p = args.p; asm volatile("" : "+s"(p.ws)); int tid_ = TID_NOW(); asm volatile("" : "+v"(tid_)); const int lane = tid_ & 63, wave = __builtin_amdgcn_readfirstlane(tid_ >> 6); \
    const long gtid = ((long)wave * G + blockIdx.x) * 64 + lane, nthr = (long)G * NTHR; const int gw = wave * G + blockIdx.x, ngw = G * NWAVES; (void)gw; (void)ngw; (void)gtid; (void)nthr; (void)lane;
#ifdef PROBE_T
#define SEAM(k) do { if (IN((k) + 1)) xcd_barrier(bar, TID_NOW()); if (blockIdx.x == 0 && TID_NOW() == 0) ((unsigned long long*)(args.p.ctl() + 12100))[(k) + 1] = __builtin_amdgcn_s_memrealtime(); } while (0)
#else
#define SEAM(k) do { if (IN((k) + 1)) xcd_barrier(bar, TID_NOW()); } while (0)
#endif
template <int l>
__device__ __forceinline__ void layer_body(const Args& args, const XcdBarrier& bar, LAS unsigned char* ldsp, const int G, const int wave_s, const int lo, const int hi) {
        const int pb = 1 + l * NPH;
        const bool need_ctx = l < DEPTH - 1;
        const int ntok_l = need_ctx ? NTOK : NLAT;
        if (l == 0 && PHON(0) && IN(pb + 0)) { PHASE_VARS;
            dev_norm1_l0(p, G, wave, lane);
            SEAM(pb + 0);
        }
        if (PHON(1) && IN(pb + 1)) { PHASE_VARS; (void)tid_; (void)wave;
            pg8::Gemm g{p.HB(), p.WIN_T(l), D, 0, nullptr}; pg8::StaticOrder S; S.init(NTOK, INP, G, (int)blockIdx.x);
            pg8::EpiBf16Bias E{p.U(), INP, nullptr, 0};
            pg8::gemm_phase(ldsp, g, S, E, tid_);
            SEAM(pb + 1);
        }
        if (PHON(2) && IN(pb + 2)) { PHASE_VARS; dev_prep0(p, l, G, wave, lane); SEAM(pb + 2); }
        if (PHON(3) && IN(pb + 3)) { PHASE_VARS; (void)tid_; (void)wave;
            pg8::Gemm g{p.LRT(), p.WLR_T(l), 256, 0, nullptr}; pg8::StaticOrder S; S.init(NTOK, 1280, G, (int)blockIdx.x);
            pg8::EpiBf16Bias E{p.LRO(), 1280, nullptr, 0};
            pg8::gemm_phase(ldsp, g, S, E, tid_);
            SEAM(pb + 3);
        }
        if (PHON(4) && IN(pb + 4)) { PHASE_VARS; dev_prepA1(p, l, gw, ngw, lane); SEAM(pb + 4); }
        if (PHON(5) && IN(pb + 5)) { PHASE_VARS;
            const int nchain = 2 * BATCH * B_H, nitems = nchain + RW_UNITS;
            unsigned* ctr = p.ctl() + 12200 + 64 * (2 * l); volatile LAS unsigned* slot = (volatile LAS unsigned*)(ldsp + MISC_OFF + 64);
#ifdef PROBE_GDN
            { const long nB = 2L * BATCH * B_H * 128; for (long task = gtid; task < nB; task += nthr) task_scanB(p, task); }
#endif
            unsigned long long tacc_ = 0ull, t0_ = 0ull; (void)tacc_; (void)t0_;
#ifdef PT_ACT
#define ACT_BEGIN(a) do { if (PT_ACT == (a)) t0_ = __builtin_amdgcn_s_memrealtime(); } while (0)
#define ACT_END(a) do { if (PT_ACT == (a)) tacc_ += __builtin_amdgcn_s_memrealtime() - t0_; } while (0)
#define ACT_FLUSH() do { if (tid_ == 0) atomicMax(p.ctl() + 12070 + l, (unsigned)tacc_); } while (0)
#else
#define ACT_BEGIN(a)
#define ACT_END(a)
#define ACT_FLUSH()
#endif
            int cur = q_next(ctr, slot, tid_);
            while (cur < nchain) {
                ACT_BEGIN(1); gdn_chain(p.GQ(), p.GK(), p.GV(), p.GG(), p.GBETA(), cur, p.OB(), ldsp, tid_, p.ctl()); ACT_END(1);
                if (tid_ == 0) __hip_atomic_fetch_add(ctr + 32, 1u, __ATOMIC_RELAXED, __HIP_MEMORY_SCOPE_AGENT);
                cur = q_next(ctr, slot, tid_); }
            if (cur < nitems) {
                S1In in; rwkv_stage1_load(p, cur - nchain, tid_, in);
                int nxt = q_next(ctr, slot, tid_);
                while (cur < nitems) {
#if defined(PT_SEC) && PT_SEC == 18
                    if (tid_ == 0) { const unsigned long long n_ = __builtin_amdgcn_s_memrealtime(); if (t0_) atomicAdd(p.ctl() + 12080, (unsigned)(n_ - t0_)); t0_ = n_; }
#endif
                    S1In in2; const bool have2 = nxt < nitems;
                    if (have2) rwkv_stage1_load(p, nxt - nchain, tid_, in2); else in2 = in;
                    unsigned qraw = 0u;
                    ACT_BEGIN(2); rwkv_stage1(p, cur - nchain, in, ldsp, tid_, ctr, qraw); ACT_END(2);
                    if (tid_ == 0) { __hip_atomic_fetch_add(ctr + 32, 1u, __ATOMIC_RELAXED, __HIP_MEMORY_SCOPE_AGENT); *slot = qraw; }
                    lds_barrier();
                    const int nn = (int)*slot;
                    in = in2; cur = nxt; nxt = nn;
                }
                __syncthreads();
            }
            ACT_FLUSH();
            {
                unsigned* cctr = p.ctl() + 12200 + 64 * (8 + 2 * l);
                for (int ch = q_filler(cctr, ctr + 32, (unsigned)nitems, slot, tid_); ch < CV_NCH_MOE + (l + 1 < DEPTH ? CV_NCH_SMALL : 0); ch = q_filler(cctr, ctr + 32, (unsigned)nitems, slot, tid_)) {
                    if (ch < CV_NCH_MOE) conv_chunk(p, l, true, ch, ldsp, wave, lane); else conv_chunk(p, l + 1, false, ch - CV_NCH_MOE, ldsp, wave, lane); } }
            SEAM(pb + 5);
        }
        if (PHON(6) && IN(pb + 6)) { PHASE_VARS;
            const int ngb = 0, nch = ngb + BATCH * A_H, nun = ATT_NLAT + (need_ctx ? ATT_NCTX : 0);
            unsigned* ctr = p.ctl() + 12200 + 64 * (2 * l + 1); volatile LAS unsigned* slot = (volatile LAS unsigned*)(ldsp + MISC_OFF + 64);
#ifdef PROBE_RWKV
            { const long nA = 2L * BATCH * A_H * 64; for (long task = gtid; task < nA; task += nthr) task_scanA(p, task); }
#endif
            unsigned long long tacc_ = 0ull, t0_ = 0ull; (void)tacc_; (void)t0_;
            for (int cur = q_next(ctr, slot, tid_); cur < nch + nun; cur = q_next(ctr, slot, tid_)) {
                if (cur < nch) { ACT_BEGIN(3); rwkv_stage2(p, cur - ngb,
#ifdef PROBE_RWKV
                    (bf16_t*)(p.ws + WS_TOTAL),
#else
                    p.YA(),
#endif
                    ldsp, tid_); ACT_END(3); }
                else { ACT_BEGIN(4); attn_unit(p, cur - nch, ldsp, tid_); ACT_END(4); }
                if (tid_ == 0) __hip_atomic_fetch_add(ctr + 32, 1u, __ATOMIC_RELAXED, __HIP_MEMORY_SCOPE_AGENT);
            }
            ACT_FLUSH();
            {
                unsigned* cctr = p.ctl() + 12200 + 64 * (8 + 2 * l);
                for (int ch = q_filler(cctr, ctr + 32, (unsigned)(nch + nun), slot, tid_); ch < CV_NCH_MOE + (l + 1 < DEPTH ? CV_NCH_SMALL : 0); ch = q_filler(cctr, ctr + 32, (unsigned)(nch + nun), slot, tid_)) {
                    if (ch < CV_NCH_MOE) conv_chunk(p, l, true, ch, ldsp, wave, lane); else conv_chunk(p, l + 1, false, ch - CV_NCH_MOE, ldsp, wave, lane); } }
            SEAM(pb + 6);
        }
        if (PHON(7) && IN(pb + 7)) { PHASE_VARS;
#ifdef PROBE_GDN
            { float e2 = 0.f, r2 = 0.f; const bf16_t* cand = (const bf16_t*)(p.ws + WS_TOTAL); const bf16_t* ref = p.OB();
              for (long i = gtid; i < 2L * NTOK * B_W; i += nthr) { const float d = bf2f(cand[i]) - bf2f(ref[i]); e2 += d * d; r2 += bf2f(ref[i]) * bf2f(ref[i]); }
              e2 = wave_sum(e2); r2 = wave_sum(r2); if (lane == 0) { atomicAdd((float*)(p.ctl() + 12000), e2); atomicAdd((float*)(p.ctl() + 12001), r2); } }
#endif
#ifdef PROBE_RWKV
            { float e2 = 0.f, r2 = 0.f; const bf16_t* cand = (const bf16_t*)(p.ws + WS_TOTAL); const bf16_t* ref = p.YA();
              for (long i = gtid; i < 2L * NTOK * A_W; i += nthr) { const float d = bf2f(cand[i]) - bf2f(ref[i]); e2 += d * d; r2 += bf2f(ref[i]) * bf2f(ref[i]); }
              e2 = wave_sum(e2); r2 = wave_sum(r2); if (lane == 0) { atomicAdd((float*)(p.ctl() + 12000), e2); atomicAdd((float*)(p.ctl() + 12001), r2); } }
#endif
            dev_post(p, l, ntok_l, gw, ngw, lane); SEAM(pb + 7); }
        if (PHON(8) && IN(pb + 8)) { PHASE_VARS; (void)tid_; (void)wave;
            pg8::Gemm g{p.MIX(), p.WOUT_T(l), D, 0, nullptr}; pg8::StaticOrder S; S.init(ntok_l, D, G, (int)blockIdx.x);
            pg8::EpiBf16Bias E{p.MO(), D, nullptr, 0};
            pg8::gemm_phase(ldsp, g, S, E, tid_);
            SEAM(pb + 8);
        }
        if (PHON(9) && IN(pb + 9)) { PHASE_VARS; dev_resid_router(p, l, ntok_l, ldsp, G, tid_); SEAM(pb + 9); }
        if (PHON(10) && IN(pb + 10)) { PHASE_VARS; dev_slots(p, l, ntok_l, ldsp, gtid, nthr, tid_);
            {
                unsigned* cctr = p.ctl() + 12200 + 64 * (8 + 2 * l); volatile LAS unsigned* slot = (volatile LAS unsigned*)(ldsp + MISC_OFF + 64);
                for (int ch = q_next(cctr, slot, tid_); ch < CV_NCH_MOE + (l + 1 < DEPTH ? CV_NCH_SMALL : 0); ch = q_next(cctr, slot, tid_)) {
                    if (ch < CV_NCH_MOE) conv_chunk(p, l, true, ch, ldsp, wave, lane); else conv_chunk(p, l + 1, false, ch - CV_NCH_MOE, ldsp, wave, lane); } }
            SEAM(pb + 10); }
        if (PHON(12) && IN(pb + 12)) { PHASE_VARS; (void)tid_; (void)wave;
            pg8::Gemm g{p.HB(), p.WGU_T(l), D, (size_t)2 * DEXP * D, p.SLOT_TOK()}; pg8::MoeOrder S{__builtin_amdgcn_readfirstlane(p.NBLK()[0]), 2 * DEXP / 256, G, (int)blockIdx.x, p.BLOCK_E()};
            pg8::EpiSwiglu E{p.HH(), DEXP, p.exp_b_gu + (size_t)l * NEXP * 2 * DEXP, 2 * DEXP};
            pg8::gemm_phase<true>(ldsp, g, S, E, tid_);
            SEAM(pb + 12);
        }
        if (PHON(13) && IN(pb + 13)) { PHASE_VARS; (void)tid_; (void)wave;
            pg8::Gemm g{p.HH(), p.WDN_T(l), DEXP, (size_t)D * DEXP, nullptr}; pg8::MoeOrder S{__builtin_amdgcn_readfirstlane(p.NBLK()[0]), D / 256, G, (int)blockIdx.x, p.BLOCK_E()};
            pg8::EpiBf16Bias E{p.YB(), D, p.exp_b_dn + (size_t)l * NEXP * D, D};
            pg8::gemm_phase(ldsp, g, S, E, tid_);
            SEAM(pb + 13);
        }
        if (PHON(14) && IN(pb + 14)) { PHASE_VARS; dev_combine(p, l, ntok_l, G, wave, lane);
            if (l + 1 < DEPTH) SEAM(pb + 14); }
}

__global__ void __launch_bounds__(NTHR, 2) fwd_kernel(Args args) {
    extern __shared__ __attribute__((aligned(16))) unsigned char lds[];
    const P& pk = args.p;
    LAS unsigned char* ldsp = (LAS unsigned char*)lds;
    volatile LAS unsigned* MISC = (volatile LAS unsigned*)(ldsp + MISC_OFF);
    const int G = gridDim.x;
    const int wave_s = __builtin_amdgcn_readfirstlane((int)threadIdx.x >> 6);
    { const int t0 = TID_NOW(); if (t0 < 32) MISC[t0] = 0u; }
    __syncthreads();
    XcdBarrier bar = xcd_barrier_post(pk.ctl() + CW_BAR, MISC + 8, TID_NOW());
    const int lo = args.ph_lo, hi = args.ph_hi;
#ifdef PROBE_T
    if (blockIdx.x == 0 && TID_NOW() == 0) ((unsigned long long*)(pk.ctl() + 12100))[0] = __builtin_amdgcn_s_memrealtime();
#endif

    if (PHON(100) && IN(0)) { PHASE_VARS;
        for (int cg = blockIdx.x; cg < DEPTH * 96; cg += G) dev_mod(p, cg, ldsp, tid_);
        RUN_TASKS(D, p.HB()[(size_t)ZROW * D + task] = 0);
        dev_build_rope(p, gtid, nthr);
        for (int lw = 0; lw < DEPTH; ++lw) dev_build_wlr(p, lw, gtid, nthr);
        for (int ch = blockIdx.x; ch < CV_NCH_SMALL; ch += G) conv_chunk(p, 0, false, ch, ldsp, wave, lane);
        SEAM(0);
    }
    layer_body<0>(args, bar, ldsp, G, wave_s, lo, hi);
    layer_body<1>(args, bar, ldsp, G, wave_s, lo, hi);
#undef IN
#undef SEAM
}

#ifndef N_LAUNCH_MODE
#define N_LAUNCH_MODE 1
#endif
extern "C" void kernel_launch(void* const* d_in, const int* in_sizes, int n_in, void* d_out, int out_size, void* d_ws, size_t ws_size, hipStream_t stream) {
    static int grid = 0;
    if (grid == 0) {
        int dev = 0, cus = 0;
        if (hipGetDevice(&dev) != hipSuccess || hipDeviceGetAttribute(&cus, hipDeviceAttributeMultiprocessorCount, dev) != hipSuccess) { grid = -1; return; }
        if (hipFuncSetAttribute((const void*)fwd_kernel, hipFuncAttributeMaxDynamicSharedMemorySize, LDS_BYTES) != hipSuccess) { fprintf(stderr, "hipFuncSetAttribute failed\n"); grid = -1; return; }
        int per_cu = 0;
        if (hipOccupancyMaxActiveBlocksPerMultiprocessor(&per_cu, (const void*)fwd_kernel, NTHR, LDS_BYTES) != hipSuccess || per_cu < 1) fprintf(stderr, "occupancy query: %d\n", per_cu);
        (void)hipGetLastError();
        grid = cus;
    }
    if (grid < 0) return;
    unsigned char* ws = (unsigned char*)d_ws;
    (void)hipMemsetAsync(ws, 0, CTL_BYTES, stream);
    Args a{};
    P& p = a.p;
    const float* const* in = (const float* const*)d_in;
    p.x = in[0]; p.c = in[1]; p.ctx = in[2]; p.c_ctx = in[3]; p.ada_w = in[4]; p.ada_b = in[5]; p.pre_norm = in[6]; p.post_norm = in[7]; p.w_in = in[8]; p.w_out = in[9];
    p.rw_mu = in[10]; p.rw_w0 = in[11]; p.rw_w2 = in[12]; p.rw_a0 = in[13]; p.rw_a2 = in[14]; p.rw_g2 = in[15]; p.rw_k_k = in[16]; p.rw_k_a = in[17]; p.rw_r_k = in[18]; p.rw_ln_w = in[19]; p.rw_ln_b = in[20];
    p.gdn_conv = in[21]; p.gdn_a_log = in[22]; p.gdn_dt_bias = in[23]; p.gdn_norm = in[24]; p.attn_q_norm = in[25]; p.attn_k_norm = in[26];
    p.router_w = in[27]; p.router_b = in[28]; p.exp_w_gu = in[29]; p.exp_b_gu = in[30]; p.exp_w_dn = in[31]; p.exp_b_dn = in[32];
    p.out = (float*)d_out;
    p.ws = ws; p.tokf = nullptr;
#ifdef PROBE_GDN
    if (WS_TOTAL + (size_t)2 * NTOK * B_W * 4 > ws_size) { fprintf(stderr, "probe: ws too small\n"); return; }
#endif
    if (WS_TOTAL > ws_size) { fprintf(stderr, "kernel_launch: workspace too small: need %zu have %zu\n", (size_t)WS_TOTAL, ws_size); return; }
    const int nph = 1 + DEPTH * NPH;
#if N_LAUNCH_MODE == 1
    a.ph_lo = 0; a.ph_hi = nph;
    hipLaunchKernelGGL(fwd_kernel, dim3(grid), dim3(NTHR), LDS_BYTES, stream, a);
#else
    for (int ph = 0; ph < nph; ++ph) { a.ph_lo = ph; a.ph_hi = ph + 1; hipLaunchKernelGGL(fwd_kernel, dim3(grid), dim3(NTHR), LDS_BYTES, stream, a); }
#endif
}
#endif
```

```cpp
#ifndef HOST_TEST
#include <hip/hip_runtime.h>
#else
struct uint4 { unsigned x, y, z, w; };
#endif
#include <cstdio>
#include <cstdint>
#include <cmath>

#ifndef CFG_BATCH
#define CFG_BATCH 16
#define CFG_SEQ 2048
#define CFG_CTX 256
#define CFG_NEXP 32
#define CFG_DEXP 1024
#endif
constexpr int D = 1024, BATCH = CFG_BATCH, SEQ = CFG_SEQ, CTXL = CFG_CTX, DEPTH = 2, GRID_W = 64;
constexpr int NLAT = BATCH * SEQ, NCTX = BATCH * CTXL, NTOK = NLAT + NCTX;
constexpr int A_W = 256, A_H = 4, A_IN = 960;
constexpr int B_W = 512, B_H = 4, B_IN = 2064, B_OFF = 960;
constexpr int C_W = 256, C_IN = 512, C_OFF = 3024;
constexpr int INW = 3536, INP = 3584;
constexpr int NEXP = CFG_NEXP, TOPK = 4, DEXP = CFG_DEXP;
constexpr int NBLK_MAX = (NTOK * TOPK + 255) / 256 + NEXP, NSLOT = NBLK_MAX * 256;
constexpr int ZROW = NTOK;
constexpr int SLEN = CTXL + SEQ;

#ifdef HOST_TEST
#define DEVFN static inline
#define GLOBAL_ATOMIC_ADD(p, v) ((*(p)) += (v), (*(p)) - (v))
#else
#define DEVFN __device__ __forceinline__
#define GLOBAL_ATOMIC_ADD(p, v) atomicAdd((p), (v))
#endif
#ifdef HOST_TEST
#define UNIFORM(x) (x)
#define LOADFENCE()
#else
#define UNIFORM(x) __builtin_amdgcn_readfirstlane(x)
#define LOADFENCE() asm volatile("" ::: "memory")
#endif
typedef unsigned short bf16_t;
DEVFN bf16_t f2bf(float f) { unsigned u = __builtin_bit_cast(unsigned, f); return (bf16_t)((u + 0x7fffu + ((u >> 16) & 1u)) >> 16); }
DEVFN float bf2f(bf16_t b) { unsigned u = ((unsigned)b) << 16; return __builtin_bit_cast(float, u); }
DEVFN float sigmoidf_(float x) { return 1.0f / (1.0f + expf(-x)); }
DEVFN float siluf_(float x) { return x / (1.0f + expf(-x)); }
DEVFN float softplusf_(float x) { return x > 20.f ? x : log1pf(expf(x)); }

#ifdef HOST_TEST
#define WSACC inline
#else
#define WSACC __device__ __host__ __forceinline__
#endif
constexpr size_t CTL_BYTES = 64 * 1024;
constexpr size_t al256(size_t x) { return (x + 255) & ~(size_t)255; }
constexpr size_t WSO_ctl = 0;
constexpr size_t WSE_ctl = WSO_ctl + al256(CTL_BYTES);
constexpr size_t WSO_MOD = WSE_ctl;
constexpr size_t WSE_MOD = WSO_MOD + al256((size_t)DEPTH * (BATCH + 1) * 6 * D * 4);
constexpr size_t WSO_X = WSE_MOD;
constexpr size_t WSE_X = WSO_X + al256((size_t)(NTOK + 1) * D * 4);
constexpr size_t WSO_HB = WSE_X;
constexpr size_t WSE_HB = WSO_HB + al256((size_t)(NTOK + 1) * D * 2);
constexpr size_t WSO_WIN_T = WSE_HB;
constexpr size_t WSE_WIN_T = WSO_WIN_T + al256((size_t)INP * D * 2);
constexpr size_t WSO_WOUT_T = WSE_WIN_T;
constexpr size_t WSE_WOUT_T = WSO_WOUT_T + al256((size_t)D * D * 2);
constexpr size_t WSO_WR_T = WSE_WOUT_T;
constexpr size_t WSE_WR_T = WSO_WR_T + al256((size_t)64 * D * 2);
constexpr size_t WSO_WGU_T = WSE_WR_T;
constexpr size_t WSE_WGU_T = WSO_WGU_T + al256((size_t)NEXP * 2 * DEXP * D * 2);
constexpr size_t WSO_WDN_T = WSE_WGU_T;
constexpr size_t WSE_WDN_T = WSO_WDN_T + al256((size_t)NEXP * D * DEXP * 2);
constexpr size_t WSZ_WSET = WSE_WDN_T - WSO_WIN_T;
constexpr size_t WSO_TOPI = WSE_WDN_T + WSZ_WSET;
constexpr size_t WSE_TOPI = WSO_TOPI + al256((size_t)NTOK * 4 * 4);
constexpr size_t WSO_POS = WSE_TOPI;
constexpr size_t WSE_POS = WSO_POS + al256((size_t)NTOK * 4 * 4);
constexpr size_t WSO_TSLOT = WSE_POS;
constexpr size_t WSE_TSLOT = WSO_TSLOT + al256((size_t)NTOK * 4 * 4);
constexpr size_t WSO_TOPG = WSE_TSLOT;
constexpr size_t WSE_TOPG = WSO_TOPG + al256((size_t)NTOK * 4 * 4);
constexpr size_t WSO_SLOT_TOK = WSE_TOPG;
constexpr size_t WSE_SLOT_TOK = WSO_SLOT_TOK + al256((size_t)NSLOT * 4);
constexpr size_t WSO_BLOCK_E = WSE_SLOT_TOK;
constexpr size_t WSE_BLOCK_E = WSO_BLOCK_E + al256((size_t)NBLK_MAX * 4);
constexpr size_t WSO_NBLK = WSE_BLOCK_E;
constexpr size_t WSE_NBLK = WSO_NBLK + al256(256);
constexpr size_t WSO_U = WSE_NBLK;
constexpr size_t WSE_U = WSO_U + al256((size_t)NTOK * INP * 2);
constexpr size_t WSO_MO = WSE_U;
constexpr size_t WSE_MO = WSO_MO + al256((size_t)NTOK * D * 2);
constexpr size_t WSO_ROPE = WSE_MO;
constexpr size_t WSE_ROPE = WSO_ROPE + al256((size_t)SEQ * 128 * 4);
constexpr size_t WSO_WLR_T = WSE_ROPE;
constexpr size_t WSE_WLR_T = WSO_WLR_T + 2 * al256((size_t)1280 * 256 * 2);
constexpr size_t WSO_END_P = WSE_WLR_T;
constexpr size_t WSO_LR = WSO_END_P;
constexpr size_t WSE_LR = WSO_LR + al256((size_t)NTOK * 192 * 4);
#ifdef HOST_TEST
constexpr size_t WSO_RW_R = WSE_LR;
#else
constexpr size_t WSO_RW_R = WSO_LR;
#endif
constexpr size_t WSE_RW_R = WSO_RW_R + al256((size_t)NTOK * A_W * 2);
constexpr size_t WSO_RW_V = WSE_RW_R;
constexpr size_t WSE_RW_V = WSO_RW_V + al256((size_t)NTOK * A_W * 2);
constexpr size_t WSO_RW_KK = WSE_RW_V;
constexpr size_t WSE_RW_KK = WSO_RW_KK + al256((size_t)NTOK * A_W * 2);
constexpr size_t WSO_RW_D = WSE_RW_KK;
constexpr size_t WSE_RW_D = WSO_RW_D + al256((size_t)2 * NTOK * A_W * 4);
constexpr size_t WSO_RW_KD = WSE_RW_D;
constexpr size_t WSE_RW_KD = WSO_RW_KD + al256((size_t)2 * NTOK * A_W * 2);
constexpr size_t WSO_RW_KKA = WSE_RW_KD;
constexpr size_t WSE_RW_KKA = WSO_RW_KKA + al256((size_t)2 * NTOK * A_W * 2);
constexpr size_t WSO_RW_GATE = WSE_RW_KKA;
constexpr size_t WSE_RW_GATE = WSO_RW_GATE + al256((size_t)NTOK * A_W * 2);
constexpr size_t WSO_RW_BON = WSE_RW_GATE;
constexpr size_t WSE_RW_BON = WSO_RW_BON + al256((size_t)NTOK * A_H * 4);
constexpr size_t WSO_YA = WSE_RW_BON;
constexpr size_t WSE_YA = WSO_YA + al256((size_t)2 * NTOK * A_W * 2);
constexpr size_t WSO_GQ = WSE_YA;
constexpr size_t WSE_GQ = WSO_GQ + al256((size_t)NTOK * B_W * 2);
constexpr size_t WSO_GK = WSE_GQ;
constexpr size_t WSE_GK = WSO_GK + al256((size_t)NTOK * B_W * 2);
constexpr size_t WSO_GV = WSE_GK;
constexpr size_t WSE_GV = WSO_GV + al256((size_t)NTOK * B_W * 2);
constexpr size_t WSO_GG = WSE_GV;
constexpr size_t WSE_GG = WSO_GG + al256((size_t)NTOK * 8 * 4);
constexpr size_t WSO_GBETA = WSE_GG;
constexpr size_t WSE_GBETA = WSO_GBETA + al256((size_t)NTOK * 8 * 4);
constexpr size_t WSO_OB = WSE_GBETA;
constexpr size_t WSE_OB = WSO_OB + al256((size_t)2 * NTOK * B_W * 2);
constexpr size_t WSO_CQ = WSE_OB;
constexpr size_t WSE_CQ = WSO_CQ + al256((size_t)NTOK * 256 * 2);
constexpr size_t WSO_CK = WSE_CQ;
constexpr size_t WSE_CK = WSO_CK + al256((size_t)NTOK * 128 * 2);
constexpr size_t WSO_CV = WSE_CK;
constexpr size_t WSE_CV = WSO_CV + al256((size_t)NTOK * 128 * 2);
constexpr size_t WSO_RWC = WSE_CV;
constexpr size_t WSE_RWC = WSO_RWC + al256((size_t)2 * BATCH * A_H * (SLEN / 64) * 5 * 4096 * 2);
constexpr size_t WSO_LRT = WSE_RWC;
constexpr size_t WSE_LRT = WSO_LRT + al256((size_t)NTOK * 256 * 2);
constexpr size_t WSO_LRO = WSE_LRT;
constexpr size_t WSE_LRO = WSO_LRO + al256((size_t)NTOK * 1280 * 2);
constexpr size_t WSO_MIX = WSE_LRO;
constexpr size_t WSE_MIX = WSO_MIX + al256((size_t)NTOK * D * 2);
constexpr size_t WSO_XG = WSO_END_P;
constexpr size_t WSE_XG = WSO_XG + al256((size_t)NSLOT * D * 2);
constexpr size_t WSO_HH = WSE_XG;
constexpr size_t WSE_HH = WSO_HH + al256((size_t)NSLOT * DEXP * 2);
constexpr size_t WSO_YB = WSE_HH;
constexpr size_t WSE_YB = WSO_YB + al256((size_t)NSLOT * D * 2);
constexpr size_t WS_TOTAL = (WSE_MIX > WSE_YB ? WSE_MIX : WSE_YB);
struct P {
    const float *x, *c, *ctx, *c_ctx, *ada_w, *ada_b, *pre_norm, *post_norm, *w_in, *w_out;
    const float *rw_mu, *rw_w0, *rw_w2, *rw_a0, *rw_a2, *rw_g2, *rw_k_k, *rw_k_a, *rw_r_k, *rw_ln_w, *rw_ln_b;
    const float *gdn_conv, *gdn_a_log, *gdn_dt_bias, *gdn_norm, *attn_q_norm, *attn_k_norm;
    const float *router_w, *router_b, *exp_w_gu, *exp_b_gu, *exp_w_dn, *exp_b_dn;
    float* out;
    unsigned char* ws;
    WSACC unsigned* ctl() const { return (unsigned*)(ws + WSO_ctl); }
    WSACC float* MOD() const { return (float*)(ws + WSO_MOD); }
    WSACC float* X() const { return (float*)(ws + WSO_X); }
    WSACC bf16_t* HB() const { return (bf16_t*)(ws + WSO_HB); }
    WSACC bf16_t* WIN_T(int l) const { return (bf16_t*)(ws + WSO_WIN_T + (size_t)l * WSZ_WSET); }
    WSACC bf16_t* WOUT_T(int l) const { return (bf16_t*)(ws + WSO_WOUT_T + (size_t)l * WSZ_WSET); }
    WSACC bf16_t* WR_T(int l) const { return (bf16_t*)(ws + WSO_WR_T + (size_t)l * WSZ_WSET); }
    WSACC bf16_t* WGU_T(int l) const { return (bf16_t*)(ws + WSO_WGU_T + (size_t)l * WSZ_WSET); }
    WSACC bf16_t* WDN_T(int l) const { return (bf16_t*)(ws + WSO_WDN_T + (size_t)l * WSZ_WSET); }
    WSACC int* TOPI() const { return (int*)(ws + WSO_TOPI); }
    WSACC int* POS() const { return (int*)(ws + WSO_POS); }
    WSACC int* TSLOT() const { return (int*)(ws + WSO_TSLOT); }
    WSACC float* TOPG() const { return (float*)(ws + WSO_TOPG); }
    WSACC int* SLOT_TOK() const { return (int*)(ws + WSO_SLOT_TOK); }
    WSACC int* BLOCK_E() const { return (int*)(ws + WSO_BLOCK_E); }
    WSACC int* NBLK() const { return (int*)(ws + WSO_NBLK); }
    WSACC bf16_t* U() const { return (bf16_t*)(ws + WSO_U); }
    WSACC bf16_t* MO() const { return (bf16_t*)(ws + WSO_MO); }
    WSACC float* LR() const { return (float*)(ws + WSO_LR); }
    WSACC bf16_t* RW_R() const { return (bf16_t*)(ws + WSO_RW_R); }
    WSACC bf16_t* RW_V() const { return (bf16_t*)(ws + WSO_RW_V); }
    WSACC bf16_t* RW_KK() const { return (bf16_t*)(ws + WSO_RW_KK); }
    WSACC float* RW_D() const { return (float*)(ws + WSO_RW_D); }
    WSACC bf16_t* RW_KD() const { return (bf16_t*)(ws + WSO_RW_KD); }
    WSACC bf16_t* RW_KKA() const { return (bf16_t*)(ws + WSO_RW_KKA); }
    WSACC bf16_t* RW_GATE() const { return (bf16_t*)(ws + WSO_RW_GATE); }
    WSACC float* RW_BON() const { return (float*)(ws + WSO_RW_BON); }
    WSACC bf16_t* YA() const { return (bf16_t*)(ws + WSO_YA); }
    WSACC bf16_t* GQ() const { return (bf16_t*)(ws + WSO_GQ); }
    WSACC bf16_t* GK() const { return (bf16_t*)(ws + WSO_GK); }
    WSACC bf16_t* GV() const { return (bf16_t*)(ws + WSO_GV); }
    WSACC float* GG() const { return (float*)(ws + WSO_GG); }
    WSACC float* GBETA() const { return (float*)(ws + WSO_GBETA); }
    WSACC bf16_t* OB() const { return (bf16_t*)(ws + WSO_OB); }
    WSACC bf16_t* CQ() const { return (bf16_t*)(ws + WSO_CQ); }
    WSACC bf16_t* CK() const { return (bf16_t*)(ws + WSO_CK); }
    WSACC bf16_t* CV() const { return (bf16_t*)(ws + WSO_CV); }
    WSACC bf16_t* MIX() const { return (bf16_t*)(ws + WSO_MIX); }
    WSACC bf16_t* RWC() const { return (bf16_t*)(ws + WSO_RWC); }
    WSACC float* ROPE() const { return (float*)(ws + WSO_ROPE); }
    WSACC bf16_t* LRT() const { return (bf16_t*)(ws + WSO_LRT); }
    WSACC bf16_t* LRO() const { return (bf16_t*)(ws + WSO_LRO); }
    WSACC bf16_t* WLR_T(int l) const { return (bf16_t*)(ws + WSO_WLR_T + (size_t)l * al256((size_t)1280 * 256 * 2)); }
    WSACC bf16_t* XG() const { return (bf16_t*)(ws + WSO_XG); }
    WSACC bf16_t* HH() const { return (bf16_t*)(ws + WSO_HH); }
    WSACC bf16_t* YB() const { return (bf16_t*)(ws + WSO_YB); }
    WSACC int* cnt() const { return (int*)(ws + WSO_ctl) + 8192; }
    WSACC float* TOKF() const { return tokf; }
    float* tokf;
};

DEVFN void row_info(int m, int& b, int& t, int& len, int& base) {
    if (m < NLAT) { b = m / SEQ; t = m % SEQ; len = SEQ; base = b * SEQ; }
    else { const int mc = m - NLAT; b = mc / CTXL; t = mc % CTXL; len = CTXL; base = NLAT + b * CTXL; }
}
DEVFN float ldU(const P& p, size_t idx) { return bf2f(p.U()[idx]); }
DEVFN int mod_row(int m) { return m < NLAT ? m / SEQ : BATCH; }
DEVFN int scan_row(int dir, int b, int s) {
    if (s < CTXL) { const int ts = dir ? (CTXL - 1 - s) : s; return NLAT + b * CTXL + ts; }
    const int s2 = s - CTXL; const int ts = dir ? (SEQ - 1 - s2) : s2; return b * SEQ + ts;
}

DEVFN void task_mod(const P& p, long task) {
    const int j = (int)(task % (6 * D)); const int r = (int)((task / (6 * D)) % (BATCH + 1)); const int l = (int)(task / ((long)(6 * D) * (BATCH + 1)));
    const float* cv = (r < BATCH) ? p.c + (size_t)r * D : p.c_ctx;
    const float* w = p.ada_w + (size_t)l * D * 6 * D + j;
    float acc = 0.f;
    for (int k = 0; k < D; ++k) acc += siluf_(cv[k]) * w[(size_t)k * 6 * D];
    p.MOD()[((size_t)l * (BATCH + 1) + r) * 6 * D + j] = acc + p.ada_b[(size_t)l * 6 * D + j];
}
DEVFN void task_copyx(const P& p, long task) {
    const long n_lat = (long)NLAT * D;
    p.X()[task] = task < n_lat ? p.x[task] : p.ctx[task - n_lat];
}
DEVFN void task_norm1(const P& p, int l, long task) {
    const int m = (int)task; const float* xr = p.X() + (size_t)m * D;
    float ss = 0.f; for (int k = 0; k < D; ++k) ss += xr[k] * xr[k];
    const float rstd = 1.0f / sqrtf(ss / D + 1e-6f);
    const float* md = p.MOD() + ((size_t)l * (BATCH + 1) + mod_row(m)) * 6 * D; const float* pn = p.pre_norm + (size_t)(l * 2 + 0) * D;
    bf16_t* o = p.HB() + (size_t)m * D;
    for (int k = 0; k < D; ++k) o[k] = f2bf(xr[k] * rstd * pn[k] * (1.0f + md[D + k]) + md[k]);
}
DEVFN float lerpA(const P& p, int l, int m, int col) {
    int b, t, len, base; row_info(m, b, t, len, base);
    const float u = ldU(p, (size_t)m * INP + col);
    const float up = t > 0 ? ldU(p, (size_t)(m - 1) * INP + col) : 0.f, un = t + 1 < len ? ldU(p, (size_t)(m + 1) * INP + col) : 0.f;
    return u + p.rw_mu[l * A_IN + col] * (0.5f * (up + un) - u);
}
DEVFN void task_prepA0(const P& p, int l, long task) {
    const int m = (int)(task / 192), j = (int)(task % 192);
    const float v = lerpA(p, l, m, 768 + j);
    p.LR()[(size_t)m * 192 + j] = j < 64 ? tanhf(v) : (j < 128 ? v : sigmoidf_(v));
}
DEVFN void task_prepA1(const P& p, int l, long task) {
    const int m = (int)(task / A_H), h = (int)(task % A_H);
    const float* lr = p.LR() + (size_t)m * 192;
    float ss = 0.f;
    for (int c = 0; c < 64; ++c) { const int ch = h * 64 + c; const float kx = lerpA(p, l, m, 256 + ch) * p.rw_k_k[l * A_W + ch]; ss += kx * kx; }
    const float rn = 1.0f / sqrtf(ss + 1e-6f);
    float bon = 0.f;
    for (int c = 0; c < 64; ++c) {
        const int ch = h * 64 + c;
        const float r = lerpA(p, l, m, ch), k = lerpA(p, l, m, 256 + ch), v = lerpA(p, l, m, 512 + ch);
        const float kk = k * p.rw_k_k[l * A_W + ch] * rn;
        float kdsum = 0.f;
        for (int dir = 0; dir < 2; ++dir) {
            float w = p.rw_w0[(l * 2 + dir) * A_W + ch], a = p.rw_a0[(l * 2 + dir) * A_W + ch];
            const float* w2 = p.rw_w2 + ((size_t)(l * 2 + dir) * 32) * A_W + ch; const float* a2 = p.rw_a2 + ((size_t)(l * 2 + dir) * 32) * A_W + ch;
            for (int r2 = 0; r2 < 32; ++r2) { w += lr[dir * 32 + r2] * w2[(size_t)r2 * A_W]; a += lr[64 + dir * 32 + r2] * a2[(size_t)r2 * A_W]; }
            const float decay = -expf(-softplusf_(-w) - 0.5f);
            const float iclr = sigmoidf_(a);
            const float kd = k * (1.0f + (iclr - 1.0f) * p.rw_k_a[l * A_W + ch]);
            const size_t o = ((size_t)dir * NTOK + m) * A_W + ch;
            p.RW_D()[o] = decay; p.RW_KD()[o] = f2bf(kd); p.RW_KKA()[o] = f2bf(kk * iclr); kdsum += kd;
        }
        float g = 0.f; const float* g2 = p.rw_g2 + (size_t)l * 64 * A_W + ch;
        for (int r2 = 0; r2 < 64; ++r2) g += lr[128 + r2] * g2[(size_t)r2 * A_W];
        const size_t o = (size_t)m * A_W + ch;
        p.RW_R()[o] = f2bf(r); p.RW_V()[o] = f2bf(v); p.RW_KK()[o] = f2bf(kk); p.RW_GATE()[o] = f2bf(g);
        bon += r * kdsum * p.rw_r_k[l * A_W + ch];
    }
    p.RW_BON()[(size_t)m * A_H + h] = bon;
}
DEVFN void task_prepB(const P& p, int l, long task) {
    const int which = (int)(task % 4), h = (int)((task / 4) % B_H), m = (int)(task / (4 * B_H));
    int b, t, len, base; row_info(m, b, t, len, base);
    if (which == 3) {
        for (int dir = 0; dir < 2; ++dir) {
            const float a = ldU(p, (size_t)m * INP + B_OFF + 2048 + dir * 4 + h), bb = ldU(p, (size_t)m * INP + B_OFF + 2056 + dir * 4 + h);
            const float g = -expf(p.gdn_a_log[(l * 2 + dir) * B_H + h]) * softplusf_(a + p.gdn_dt_bias[(l * 2 + dir) * B_H + h]);
            p.GG()[(size_t)m * 8 + dir * 4 + h] = g; p.GBETA()[(size_t)m * 8 + dir * 4 + h] = sigmoidf_(bb);
        }
        return;
    }
    bf16_t* dst = (which == 0 ? p.GQ() : which == 1 ? p.GK() : p.GV()) + (size_t)m * B_W + h * 128;
    float ss = 0.f;
    for (int c = 0; c < 128; ++c) {
        const int cc = which * B_W + h * 128 + c; const int col = B_OFF + cc;
        float acc = 0.f;
        for (int j = 0; j < 5; ++j) { const int tt = t + j - 2; if (tt >= 0 && tt < len) acc += ldU(p, (size_t)(base + tt) * INP + col) * p.gdn_conv[((size_t)l * 5 + j) * (3 * B_W) + cc]; }
        const float s = siluf_(acc); if (which == 2) dst[c] = f2bf(s); ss += s * s;
    }
    if (which < 2) { const float rn = (1.0f / sqrtf(ss + 1e-6f)) * (which == 0 ? 0.08838834764831845f : 1.0f);
        for (int c = 0; c < 128; ++c) { const int cc = which * B_W + h * 128 + c; const int col = B_OFF + cc; float acc = 0.f;
            for (int j = 0; j < 5; ++j) { const int tt = t + j - 2; if (tt >= 0 && tt < len) acc += ldU(p, (size_t)(base + tt) * INP + col) * p.gdn_conv[((size_t)l * 5 + j) * (3 * B_W) + cc]; }
            dst[c] = f2bf(siluf_(acc) * rn); } }
}
DEVFN void task_prepC(const P& p, int l, long task) {
    const int m = (int)(task / 8), hs = (int)(task % 8);
    const size_t sb = (size_t)m * INP + C_OFF + hs * 64;
    if (hs >= 6) { int b_, t_, len_, base_; row_info(m, b_, t_, len_, base_); const int key = m < NLAT ? t_ : SEQ + t_;
        for (int d = 0; d < 64; ++d) p.CV()[((size_t)(b_ * 2 + (hs - 6)) * 64 + d) * SLEN + key] = p.U()[sb + d]; return; }
    float ss = 0.f; for (int d = 0; d < 64; ++d) { const float x = ldU(p, sb + d); ss += x * x; }
    const float qs = hs < 4 ? 0.18033688011112042f : 1.0f;
    const float rstd = (1.0f / sqrtf(ss / 64.f + 1e-6f)) * qs;
    const float* nw = (hs < 4 ? p.attn_q_norm : p.attn_k_norm) + l * 64;
    bf16_t* dst = hs < 4 ? p.CQ() + (size_t)m * 256 + hs * 64 : p.CK() + (size_t)m * 128 + (hs - 4) * 64;
    if (m >= NLAT) { for (int d = 0; d < 64; ++d) dst[d] = f2bf(ldU(p, sb + d) * rstd * nw[d]); return; }
    const int t = m % SEQ; const float pr = (float)(t / GRID_W), pc = (float)(t % GRID_W);
    for (int d = 0; d < 16; ++d) {
        const float fr = powf(10000.0f, -(float)d / 16.0f);
        const float ar = pr * fr, ac = pc * fr; const float cr = cosf(ar), sr = sinf(ar), cc = cosf(ac), sc = sinf(ac);
        const float x1 = ldU(p, sb + d) * rstd * nw[d], x2 = ldU(p, sb + 16 + d) * rstd * nw[16 + d], x3 = ldU(p, sb + 32 + d) * rstd * nw[32 + d], x4 = ldU(p, sb + 48 + d) * rstd * nw[48 + d];
        dst[d] = f2bf(x1 * cr - x2 * sr); dst[16 + d] = f2bf(x2 * cr + x1 * sr); dst[32 + d] = f2bf(x3 * cc - x4 * sc); dst[48 + d] = f2bf(x4 * cc + x3 * sc);
    }
}
DEVFN void task_scanA(const P& p, long task) {
    const int v = (int)(task % 64), chain = UNIFORM((int)(task / 64)); const int h = chain % A_H, b = (chain / A_H) % BATCH, dir = chain / (A_H * BATCH);
    float s[64];
#pragma unroll
    for (int k = 0; k < 64; ++k) s[k] = 0.f;
    for (int st = 0; st < SLEN; ++st) {
        const int m = scan_row(dir, b, st);
        const bf16_t* kk = p.RW_KK() + (size_t)m * A_W + h * 64; const bf16_t* rr = p.RW_R() + (size_t)m * A_W + h * 64;
        const size_t od = ((size_t)dir * NTOK + m) * A_W + h * 64;
        const float* dd = p.RW_D() + od; const bf16_t* kd = p.RW_KD() + od; const bf16_t* ka = p.RW_KKA() + od;
        const float vv = bf2f(p.RW_V()[(size_t)m * A_W + h * 64 + v]);
        float sa = 0.f;
#pragma unroll
        for (int k = 0; k < 64; ++k) { sa += s[k] * bf2f(kk[k]); if ((k & 15) == 15) LOADFENCE(); }
        float y = 0.f;
#pragma unroll
        for (int k = 0; k < 64; ++k) { s[k] = s[k] * expf(dd[k]) - sa * bf2f(ka[k]) + vv * bf2f(kd[k]); y += s[k] * bf2f(rr[k]); if ((k & 7) == 7) LOADFENCE(); }
        p.YA()[((size_t)dir * NTOK + m) * A_W + h * 64 + v] = f2bf(y);
    }
}
DEVFN void task_scanB(const P& p, long task) {
    const int j = (int)(task % 128), chain = UNIFORM((int)(task / 128)); const int h = chain % B_H, b = (chain / B_H) % BATCH, dir = chain / (B_H * BATCH);
    float s[128];
#pragma unroll
    for (int k = 0; k < 128; ++k) s[k] = 0.f;
    for (int st = 0; st < SLEN; ++st) {
        const int m = scan_row(dir, b, st);
        const bf16_t* kv = p.GK() + (size_t)m * B_W + h * 128; const bf16_t* qv = p.GQ() + (size_t)m * B_W + h * 128;
        const float vj = bf2f(p.GV()[(size_t)m * B_W + h * 128 + j]);
        const float eg = expf(p.GG()[(size_t)m * 8 + dir * 4 + h]), beta = p.GBETA()[(size_t)m * 8 + dir * 4 + h];
        float pk = 0.f;
#pragma unroll
        for (int k = 0; k < 128; ++k) { pk += s[k] * bf2f(kv[k]); if ((k & 15) == 15) LOADFENCE(); }
        const float cf = beta * (vj - eg * pk);
        float o = 0.f;
#pragma unroll
        for (int k = 0; k < 128; ++k) { s[k] = eg * s[k] + cf * bf2f(kv[k]); o += s[k] * bf2f(qv[k]); if ((k & 7) == 7) LOADFENCE(); }
        p.OB()[((size_t)dir * NTOK + m) * B_W + h * 128 + j] = f2bf(o);
    }
}
DEVFN void task_attn(const P& p, int need_ctx, long task) {
    const int t = (int)(task % SLEN), hq = UNIFORM((int)((task / SLEN) % 4)), b = UNIFORM((int)(task / ((long)SLEN * 4)));
    const bool is_lat = UNIFORM((int)(t < SEQ)) != 0; if (!is_lat && !need_ctx) return;
    const int m = is_lat ? b * SEQ + t : NLAT + b * CTXL + (t - SEQ);
    const int kvh = hq >> 1;
    float q[64], o[64];
#pragma unroll
    for (int d = 0; d < 64; ++d) { q[d] = bf2f(p.CQ()[(size_t)m * 256 + hq * 64 + d]); o[d] = 0.f; }
    float mx = -1e30f, lsum = 0.f;
    const int nk = is_lat ? SLEN : CTXL;
    for (int kI = 0; kI < nk; ++kI) {
        int km; if (is_lat) km = kI < SEQ ? b * SEQ + kI : NLAT + b * CTXL + (kI - SEQ); else km = NLAT + b * CTXL + kI;
        const bf16_t* kr = p.CK() + (size_t)km * 128 + kvh * 64; const bf16_t* vr = p.CV() + ((size_t)(b * 2 + kvh) * 64) * SLEN + (is_lat ? kI : SEQ + kI);
        float sc = 0.f;
#pragma unroll
        for (int d = 0; d < 64; ++d) { sc += q[d] * bf2f(kr[d]); if ((d & 15) == 15) LOADFENCE(); }
        const float mn = sc > mx ? sc : mx; const float f = exp2f(mx - mn), pe = exp2f(sc - mn);
        lsum = lsum * f + pe; mx = mn;
#pragma unroll
        for (int d = 0; d < 64; ++d) { o[d] = o[d] * f + pe * bf2f(vr[(size_t)d * SLEN]); if ((d & 15) == 15) LOADFENCE(); }
    }
    const float inv = 1.0f / lsum;
#pragma unroll
    for (int d = 0; d < 64; ++d) p.MIX()[(size_t)m * D + 768 + hq * 64 + d] = f2bf(o[d] * inv);
}
DEVFN void task_post(const P& p, int l, long task) {
    const int m = (int)(task / 8), g = (int)(task % 8);
    if (g < 4) {
        const int h = g; const bf16_t* y0 = p.YA() + (size_t)m * A_W + h * 64; const bf16_t* y1 = p.YA() + ((size_t)NTOK + m) * A_W + h * 64;
        float mean = 0.f; for (int c = 0; c < 64; ++c) mean += bf2f(y0[c]) + bf2f(y1[c]); mean *= (1.0f / 64.f);
        float var = 0.f; for (int c = 0; c < 64; ++c) { const float d0 = bf2f(y0[c]) + bf2f(y1[c]) - mean; var += d0 * d0; } var *= (1.0f / 64.f);
        const float rs = 1.0f / sqrtf(var + 64e-5f); const float bon = p.RW_BON()[(size_t)m * A_H + h];
        for (int c = 0; c < 64; ++c) { const int ch = h * 64 + c;
            const float yn = (bf2f(y0[c]) + bf2f(y1[c]) - mean) * rs * p.rw_ln_w[l * A_W + ch] + p.rw_ln_b[l * A_W + ch];
            p.MIX()[(size_t)m * D + ch] = f2bf((yn + bon * bf2f(p.RW_V()[(size_t)m * A_W + ch])) * bf2f(p.RW_GATE()[(size_t)m * A_W + ch])); }
    } else {
        const int h = g - 4; const bf16_t* o0 = p.OB() + (size_t)m * B_W + h * 128; const bf16_t* o1 = p.OB() + ((size_t)NTOK + m) * B_W + h * 128;
        float ss = 0.f; for (int c = 0; c < 128; ++c) { const float o = bf2f(o0[c]) + bf2f(o1[c]); ss += o * o; }
        const float rs = 1.0f / sqrtf(ss / 128.f + 1e-6f);
        for (int c = 0; c < 128; ++c) { const float z = ldU(p, (size_t)m * INP + B_OFF + 1536 + h * 128 + c);
            p.MIX()[(size_t)m * D + 256 + h * 128 + c] = f2bf((bf2f(o0[c]) + bf2f(o1[c])) * rs * p.gdn_norm[l * 128 + c] * siluf_(z)); }
    }
}
DEVFN void task_resid1(const P& p, int l, long task) {
    const int m = (int)task; const bf16_t* mo = p.MO() + (size_t)m * D; float* xr = p.X() + (size_t)m * D;
    const float* md = p.MOD() + ((size_t)l * (BATCH + 1) + mod_row(m)) * 6 * D;
    float ss = 0.f; for (int k = 0; k < D; ++k) ss += bf2f(mo[k]) * bf2f(mo[k]);
    const float rstd = 1.0f / sqrtf(ss / D + 1e-6f); const float* pn = p.post_norm + (size_t)(l * 2 + 0) * D;
    float s2 = 0.f;
    for (int k = 0; k < D; ++k) { const float xv = xr[k] + md[2 * D + k] * (bf2f(mo[k]) * rstd) * pn[k]; xr[k] = xv; s2 += xv * xv; }
    const float r2 = 1.0f / sqrtf(s2 / D + 1e-6f); const float* pn2 = p.pre_norm + (size_t)(l * 2 + 1) * D;
    for (int k = 0; k < D; ++k) { const float tv = xr[k] * r2 * pn2[k] * (1.0f + md[4 * D + k]) + md[3 * D + k]; p.TOKF()[(size_t)m * D + k] = tv; p.HB()[(size_t)m * D + k] = f2bf(tv); }
}
DEVFN void task_router(const P& p, int l, long task) {
    const int m = (int)task; const float* tk = p.TOKF() + (size_t)m * D; const float* rw = p.router_w + (size_t)l * D * NEXP;
    float lg[NEXP];
#pragma unroll
    for (int e = 0; e < NEXP; ++e) lg[e] = p.router_b[l * NEXP + e];
    for (int k = 0; k < D; ++k) { const float tv = tk[k];
#pragma unroll
        for (int e = 0; e < NEXP; ++e) lg[e] += tv * rw[(size_t)k * NEXP + e]; }
    int idx[TOPK]; float val[TOPK];
#pragma unroll
    for (int j = 0; j < TOPK; ++j) { float best = -3.0e38f; int bi = 0;
#pragma unroll
        for (int e = 0; e < NEXP; ++e) { if (lg[e] > best) { best = lg[e]; bi = e; } }
        idx[j] = bi; val[j] = best;
#pragma unroll
        for (int e = 0; e < NEXP; ++e) if (e == bi) lg[e] = -3.0e38f; }
    float sum = 0.f, ex[TOPK];
#pragma unroll
    for (int j = 0; j < TOPK; ++j) { ex[j] = expf(val[j] - val[0]); sum += ex[j]; }
#pragma unroll
    for (int j = 0; j < TOPK; ++j) { p.TOPI()[(size_t)m * TOPK + j] = idx[j]; p.TOPG()[(size_t)m * TOPK + j] = ex[j] / sum; p.POS()[(size_t)m * TOPK + j] = GLOBAL_ATOMIC_ADD(&p.cnt()[l * NEXP + idx[j]], 1); }
}
DEVFN int moe_pstart(const P& p, int l, int e, int* nblk) {
    int acc = 0, ps = 0;
    for (int i = 0; i < NEXP; ++i) { if (i == e) ps = acc; acc += (p.cnt()[l * NEXP + i] + 255) / 256 * 256; }
    if (nblk) *nblk = acc / 256; return ps;
}
DEVFN void task_slots(const P& p, int l, long task) {
    const int e = p.TOPI()[task]; const int slot = moe_pstart(p, l, e, nullptr) + p.POS()[task];
    p.TSLOT()[task] = slot; p.SLOT_TOK()[slot] = (int)(task / TOPK);
}
DEVFN void task_blocke(const P& p, int l, long task) {
    int acc = 0, e_of = NEXP - 1, nb = 0;
    for (int i = 0; i < NEXP; ++i) { const int nbk = (p.cnt()[l * NEXP + i] + 255) / 256; if ((int)task >= acc && (int)task < acc + nbk) e_of = i; acc += nbk; }
    nb = acc; p.BLOCK_E()[task] = e_of; if (task == 0) p.NBLK()[0] = nb;
}
DEVFN void task_gather(const P& p, long task) {
    const long slot = task / 128; const int ch = (int)(task % 128); const int tok = p.SLOT_TOK()[slot];
    const uint4* s = (const uint4*)(p.HB() + (size_t)tok * D) + ch; ((uint4*)(p.XG() + (size_t)slot * D))[ch] = *s;
}
DEVFN void task_combine(const P& p, int l, long task) {
    const int m = (int)task; float* xr = p.X() + (size_t)m * D; const float* md = p.MOD() + ((size_t)l * (BATCH + 1) + mod_row(m)) * 6 * D;
    const bf16_t* y0 = p.YB() + (size_t)p.TSLOT()[(size_t)m * 4 + 0] * D; const bf16_t* y1 = p.YB() + (size_t)p.TSLOT()[(size_t)m * 4 + 1] * D;
    const bf16_t* y2 = p.YB() + (size_t)p.TSLOT()[(size_t)m * 4 + 2] * D; const bf16_t* y3 = p.YB() + (size_t)p.TSLOT()[(size_t)m * 4 + 3] * D;
    const float g0 = p.TOPG()[(size_t)m * 4 + 0], g1 = p.TOPG()[(size_t)m * 4 + 1], g2 = p.TOPG()[(size_t)m * 4 + 2], g3 = p.TOPG()[(size_t)m * 4 + 3];
    float ss = 0.f;
    for (int k = 0; k < D; ++k) { const float f = g0 * bf2f(y0[k]) + g1 * bf2f(y1[k]) + g2 * bf2f(y2[k]) + g3 * bf2f(y3[k]); ss += f * f; }
    const float rstd = 1.0f / sqrtf(ss / D + 1e-6f); const float* pn = p.post_norm + (size_t)(l * 2 + 1) * D;
    const bool last = (l == DEPTH - 1);
    for (int k = 0; k < D; ++k) { const float f = g0 * bf2f(y0[k]) + g1 * bf2f(y1[k]) + g2 * bf2f(y2[k]) + g3 * bf2f(y3[k]);
        const float xv = xr[k] + md[5 * D + k] * (f * rstd) * pn[k]; xr[k] = xv; if (last) p.out[(size_t)m * D + k] = xv; }
}

#ifndef HOST_TEST
namespace pg8 {
#define PG8_LAS __attribute__((address_space(3)))
typedef short bf16x8 __attribute__((ext_vector_type(8)));
typedef float f32x4 __attribute__((ext_vector_type(4)));
typedef unsigned u32x4 __attribute__((ext_vector_type(4)));
typedef unsigned u32x2 __attribute__((ext_vector_type(2)));
constexpr int BM = 256, BK = 64, HALF = 128, HTB = HALF * BK * 2, STAGE_BYTES = 8 * HTB, NXCD = 8, WGM = 8;
__host__ __device__ __forceinline__ int lds_byte(int r, int c) { const int st = (r >> 4) * 2 + (c >> 5), rr = r & 15, cc = c & 31, ob = rr * 64 + cc * 2; return st * 1024 + (ob ^ (((ob >> 9) & 1) << 5)); }
__host__ __device__ __forceinline__ void stage_rc(int b, int& R, int& C) { const int st = b / 1024, sb = b % 1024, swz = sb ^ (((sb >> 9) & 1) << 5); R = (st >> 1) * 16 + swz / 64; C = (st & 1) * 32 + (swz % 64) / 2; }
__host__ __device__ __forceinline__ int perm32(int rho) { const int n = rho >> 4, i = rho & 15; return 8 * (i >> 2) + 4 * n + (i & 3); }
struct Unit { int pm, pn, e; };
struct Gemm { const bf16_t* A; const bf16_t* Bt; int K; size_t estride; const int* rowidx; };
struct StaticOrder {
    int nM, nN, nwg, G, c;
    __device__ void init(int M, int N, int G_, int c_) { nM = M / BM; nN = N / BM; nwg = nM * nN; G = G_; c = c_; }
    __device__ bool next(int i, Unit& u) const {
        const long L = (long)i * G + c; if (L >= nwg) return false;
        int wgid = (int)L; { const int q = nwg / NXCD, r = nwg % NXCD, xcd = wgid % NXCD, off = wgid / NXCD; wgid = (xcd < r ? xcd * (q + 1) : r * (q + 1) + (xcd - r) * q) + off; }
        const int nig = WGM * nN, gid = wgid / nig, fm = gid * WGM, gsz = (nM - fm) < WGM ? (nM - fm) : WGM;
        u.pm = fm + ((wgid % nig) % gsz); u.pn = (wgid % nig) / gsz; u.e = 0; return true;
    }
};
struct MoeOrder {
    int nblk, nN, G, c; const int* block_e;
    __device__ bool next(int i, Unit& u) const {
        if (G % 8 != 0 || (G / 8) % nN != 0) { const long L = (long)i * G + c; if (L >= (long)nblk * nN) return false; u.pm = (int)(L / nN); u.pn = (int)(L % nN); }
        else { const int x = c & 7, r = c >> 3, per = (G / 8) / nN; const int mb = (i * per + r / nN) * 8 + x; if (mb >= nblk) return false; u.pm = mb; u.pn = r % nN; }
        u.e = __builtin_amdgcn_readfirstlane(block_e[u.pm]); return true;
    }
};
typedef float f32x2c_t __attribute__((ext_vector_type(2))); typedef __bf16 bf16x2c_t __attribute__((ext_vector_type(2)));
__device__ __forceinline__ unsigned cvt_pk_bf16(float lo, float hi) { const f32x2c_t v = {lo, hi}; const bf16x2c_t b = __builtin_convertvector(v, bf16x2c_t); return __builtin_bit_cast(unsigned, b); }
struct EpiF32 {
    static constexpr bool PERM = false;
    float* C; int ldc;
    __device__ __forceinline__ void operator()(const f32x4 (&acc)[2][2][4][2], const Unit& u, int wr, int wc, int fr, int fq) const {
        const int row0 = u.pm * BM + wr * 64 + fr, col0 = u.pn * BM + wc * 32 + 4 * fq;
#pragma unroll
        for (int ai = 0; ai < 2; ++ai)
#pragma unroll
            for (int m = 0; m < 4; ++m) { float* rowp = C + (size_t)(row0 + ai * HALF + m * 16) * ldc + col0;
#pragma unroll
                for (int bj = 0; bj < 2; ++bj)
#pragma unroll
                    for (int n = 0; n < 2; ++n) *(f32x4*)(rowp + bj * HALF + n * 16) = acc[ai][bj][m][n]; }
    }
};
struct EpiBf16Bias {
    static constexpr bool PERM = true;
    bf16_t* O; int ldc; const float* bias; int bias_estride;
    __device__ __forceinline__ void operator()(const f32x4 (&acc)[2][2][4][2], const Unit& u, int wr, int wc, int fr, int fq) const {
        const int row0 = u.pm * BM + wr * 64 + fr, col0 = u.pn * BM + wc * 32 + 8 * fq; const float* bp = bias + (size_t)u.e * bias_estride + col0;
        f32x4 bv[2][2];
#pragma unroll
        for (int bj = 0; bj < 2; ++bj)
#pragma unroll
            for (int n = 0; n < 2; ++n) bv[bj][n] = bias ? *(const f32x4*)(bp + bj * HALF + 4 * n) : (f32x4){0.f, 0.f, 0.f, 0.f};
#pragma unroll
        for (int ai = 0; ai < 2; ++ai)
#pragma unroll
            for (int m = 0; m < 4; ++m) { bf16_t* rowp = O + (size_t)(row0 + ai * HALF + m * 16) * ldc + col0;
#pragma unroll
                for (int bj = 0; bj < 2; ++bj) { const f32x4 v0 = acc[ai][bj][m][0] + bv[bj][0], v1 = acc[ai][bj][m][1] + bv[bj][1];
                    u32x4 w; w.x = cvt_pk_bf16(v0[0], v0[1]); w.y = cvt_pk_bf16(v0[2], v0[3]); w.z = cvt_pk_bf16(v1[0], v1[1]); w.w = cvt_pk_bf16(v1[2], v1[3]);
                    *(u32x4*)(rowp + bj * HALF) = w; } }
    }
};
__device__ __forceinline__ float swiglu1(float g, float lin) { g = fminf(g, 7.0f); lin = fminf(fmaxf(lin, -7.0f), 7.0f); return g * __builtin_amdgcn_rcpf(1.0f + __expf(-1.702f * g)) * (lin + 1.0f); }
struct EpiSwiglu {
    static constexpr bool PERM = true;
    bf16_t* O; int ldc; const float* bias; int bias_estride;
    __device__ __forceinline__ void operator()(const f32x4 (&acc)[2][2][4][2], const Unit& u, int wr, int wc, int fr, int fq) const {
        const int row0 = u.pm * BM + wr * 64 + fr, col0 = u.pn * BM + wc * 32 + 8 * fq; const float* bp = bias + (size_t)u.e * bias_estride + col0;
        f32x4 bv[2][2];
#pragma unroll
        for (int bj = 0; bj < 2; ++bj)
#pragma unroll
            for (int n = 0; n < 2; ++n) bv[bj][n] = *(const f32x4*)(bp + bj * HALF + 4 * n);
#pragma unroll
        for (int ai = 0; ai < 2; ++ai)
#pragma unroll
            for (int m = 0; m < 4; ++m) { bf16_t* rowp = O + (size_t)(row0 + ai * HALF + m * 16) * ldc + (col0 >> 1);
#pragma unroll
                for (int bj = 0; bj < 2; ++bj) { const f32x4 v0 = acc[ai][bj][m][0] + bv[bj][0], v1 = acc[ai][bj][m][1] + bv[bj][1];
                    u32x2 w; w.x = cvt_pk_bf16(swiglu1(v0[0], v0[1]), swiglu1(v0[2], v0[3])); w.y = cvt_pk_bf16(swiglu1(v1[0], v1[1]), swiglu1(v1[2], v1[3]));
                    *(u32x2*)(rowp + bj * (HALF / 2)) = w; } }
    }
};

template <bool GATHER = false, class Epi, class Sched>
__device__ __forceinline__ void gemm_phase(PG8_LAS unsigned char* lds, const Gemm g, const Sched& S, const Epi& E, int tid) {
    asm volatile("" : "+v"(tid));
    const int wid = __builtin_amdgcn_readfirstlane(tid >> 6), lane = tid & 63, wr = wid >> 2, wc = wid & 3, fr = lane & 15, fq = lane >> 4;
    int K = g.K; asm volatile("" : "+s"(K));
    const int nt = K / BK;
    unsigned voffA[2], voffB[2];
#pragma unroll
    for (int i = 0; i < 2; ++i) { int R, C; stage_rc(tid * 16 + i * 8192, R, C); const int Rb = Epi::PERM ? ((R & ~31) + perm32(R & 31)) : R;
        voffA[i] = GATHER ? 0u : (unsigned)(R * K + C) * 2u; voffB[i] = (unsigned)(Rb * K + C) * 2u; }
    const size_t kstep = (size_t)(BK * 2);
    const size_t hstep = (size_t)HALF * K * 2;
    const size_t tstep = 2 * hstep;
    const unsigned ldsw = (unsigned)wid * 1024u;
    const int aoff = lds_byte(wr * 64 + fr, fq * 8), boff = lds_byte(wc * 32 + fr, fq * 8);
#define PG8_SA(b, h) (((b) * 2 + (h)) * HTB)
#define PG8_SB(b, h) ((4 + (b) * 2 + (h)) * HTB)
#define PG8_STAGE(bufoff, gbase, voff) do { _Pragma("unroll") for (int _i = 0; _i < 2; ++_i) \
        __builtin_amdgcn_global_load_lds((const unsigned*)((const char*)(gbase) + (voff)[_i]), (PG8_LAS unsigned*)(lds + (bufoff) + ldsw + _i * 8192), 16, 0, 0); } while (0)
#define PG8_STAGE_A(bufoff, h, nx, kb) do { _Pragma("unroll") for (int _i = 0; _i < 2; ++_i) { \
        if constexpr (GATHER) { const unsigned _o = (nx) ? on[h][_i] : oc[h][_i]; \
            __builtin_amdgcn_global_load_lds((const unsigned*)((const char*)g.A + (size_t)_o + (size_t)(kb)), (PG8_LAS unsigned*)(lds + (bufoff) + ldsw + _i * 8192), 16, 0, 0); } \
        else { const char* _b = ((nx) ? nA : cA) + (size_t)(h) * hstep + (size_t)(kb); \
            __builtin_amdgcn_global_load_lds((const unsigned*)(_b + voffA[_i]), (PG8_LAS unsigned*)(lds + (bufoff) + ldsw + _i * 8192), 16, 0, 0); } } } while (0)
#define PG8_LDA(dst, b, h) do { _Pragma("unroll") for (int m = 0; m < 4; ++m) _Pragma("unroll") for (int k = 0; k < 2; ++k) dst[m][k] = *(const PG8_LAS bf16x8*)(lds + PG8_SA(b, h) + aoff + m * 2048 + k * 1024); } while (0)
#define PG8_LDB(dst, b, h) do { _Pragma("unroll") for (int n = 0; n < 2; ++n) _Pragma("unroll") for (int k = 0; k < 2; ++k) dst[n][k] = *(const PG8_LAS bf16x8*)(lds + PG8_SB(b, h) + boff + n * 2048 + k * 1024); } while (0)
#define PG8_MMA(ai, bj, At, Bt) do { __builtin_amdgcn_s_setprio(1); _Pragma("unroll") for (int m = 0; m < 4; ++m) _Pragma("unroll") for (int n = 0; n < 2; ++n) _Pragma("unroll") for (int k = 0; k < 2; ++k) \
        acc[ai][bj][m][n] = __builtin_amdgcn_mfma_f32_16x16x32_bf16(Bt[n][k], At[m][k], acc[ai][bj][m][n], 0, 0, 0); __builtin_amdgcn_s_setprio(0); } while (0)
#define PG8_WAIT_V(n) asm volatile("s_waitcnt vmcnt(" #n ")" ::: "memory")
#define PG8_WAIT_L(n) asm volatile("s_waitcnt lgkmcnt(" #n ")" ::: "memory")
#define PG8_BAR __builtin_amdgcn_s_barrier()
#define PG8_SCHED __builtin_amdgcn_sched_barrier(0)
    Unit cur, nxt; int ui = 0;
    if (!S.next(0, cur)) return;
    unsigned oc[2][2], on[2][2];
    const char* cA = (const char*)g.A + (size_t)cur.pm * tstep; const char* nA = cA;
#define PG8_UNIT_OFFS(o, u) do { _Pragma("unroll") for (int _h = 0; _h < 2; ++_h) _Pragma("unroll") for (int _i = 0; _i < 2; ++_i) { \
        if constexpr (GATHER) { int _R, _C; stage_rc(tid * 16 + _i * 8192, _R, _C); (o)[_h][_i] = (unsigned)g.rowidx[(u).pm * BM + _h * HALF + _R] * (unsigned)(K * 2) + (unsigned)(_C * 2); } else (o)[_h][_i] = 0u; } } while (0)
    PG8_UNIT_OFFS(oc, cur);
    f32x4 acc[2][2][4][2];
#pragma unroll
    for (int a = 0; a < 2; ++a)
#pragma unroll
        for (int b = 0; b < 2; ++b)
#pragma unroll
            for (int m = 0; m < 4; ++m)
#pragma unroll
                for (int n = 0; n < 2; ++n) acc[a][b][m][n] = (f32x4){0.f, 0.f, 0.f, 0.f};
    bf16x8 At[4][2], B0[2][2], B1[2][2];
    const char* cB = (const char*)(g.Bt + (size_t)cur.e * g.estride) + (size_t)cur.pn * tstep;
    PG8_STAGE(PG8_SB(0, 0), cB, voffB); PG8_STAGE(PG8_SB(0, 1), cB + hstep, voffB); PG8_STAGE_A(PG8_SA(0, 0), 0, false, 0); PG8_STAGE_A(PG8_SA(0, 1), 1, false, 0);
    if (wr == 1) PG8_BAR;
    PG8_WAIT_V(2); PG8_BAR;
    PG8_STAGE(PG8_SB(1, 0), cB + kstep, voffB); PG8_STAGE_A(PG8_SA(1, 0), 0, false, kstep); PG8_STAGE(PG8_SB(1, 1), cB + hstep + kstep, voffB);
    PG8_WAIT_V(6); PG8_BAR;
    for (;;) {
        const bool has_next = S.next(ui + 1, nxt);
        if (has_next) { PG8_UNIT_OFFS(on, nxt); nA = (const char*)g.A + (size_t)nxt.pm * tstep; } else { nA = cA; _Pragma("unroll") for (int _h = 0; _h < 2; ++_h) _Pragma("unroll") for (int _i = 0; _i < 2; ++_i) on[_h][_i] = oc[_h][_i]; }
        const char* nB = has_next ? (const char*)(g.Bt + (size_t)nxt.e * g.estride) + (size_t)nxt.pn * tstep : cB;
        for (int t = 0; t < nt; t += 2) {
            const bool last = (t == nt - 2);
            const size_t ka1 = (size_t)(t + 1) * kstep, ka2 = last ? 0 : (size_t)(t + 2) * kstep, ka3 = ka2 + kstep;
            const char* b2 = last ? nB : cB + (size_t)(t + 2) * kstep; const char* b3 = b2 + kstep;
            PG8_LDB(B0, 0, 0); PG8_LDB(B1, 0, 1); PG8_SCHED; PG8_LDA(At, 0, 0); PG8_STAGE_A(PG8_SA(1, 1), 1, false, ka1);
            PG8_WAIT_V(8); PG8_WAIT_L(0); PG8_BAR; PG8_MMA(0, 0, At, B0); PG8_MMA(0, 1, At, B1); PG8_BAR; PG8_SCHED;
            PG8_LDA(At, 0, 1); PG8_STAGE(PG8_SB(0, 0), b2, voffB); PG8_STAGE(PG8_SB(0, 1), b2 + hstep, voffB); PG8_STAGE_A(PG8_SA(0, 0), 0, last, ka2);
            PG8_WAIT_V(8); PG8_WAIT_L(0); PG8_BAR; PG8_MMA(1, 0, At, B0); PG8_MMA(1, 1, At, B1); PG8_BAR; PG8_SCHED;
            PG8_LDB(B0, 1, 0); PG8_LDB(B1, 1, 1); PG8_SCHED; PG8_LDA(At, 1, 0); PG8_STAGE_A(PG8_SA(0, 1), 1, last, ka2);
            PG8_WAIT_V(8); PG8_WAIT_L(0); PG8_BAR; PG8_MMA(0, 0, At, B0); PG8_MMA(0, 1, At, B1); PG8_BAR; PG8_SCHED;
            PG8_LDA(At, 1, 1); PG8_STAGE(PG8_SB(1, 0), b3, voffB); PG8_STAGE(PG8_SB(1, 1), b3 + hstep, voffB); PG8_STAGE_A(PG8_SA(1, 0), 0, last, ka3);
            PG8_WAIT_V(8); PG8_WAIT_L(0); PG8_BAR; PG8_MMA(1, 0, At, B0); PG8_MMA(1, 1, At, B1); PG8_BAR; PG8_SCHED;
        }
        if (wr == 0) PG8_BAR;
        E(acc, cur, wr, wc, fr, fq);
        if (!has_next) break;
#pragma unroll
        for (int a = 0; a < 2; ++a)
#pragma unroll
            for (int b = 0; b < 2; ++b)
#pragma unroll
                for (int m = 0; m < 4; ++m)
#pragma unroll
                    for (int n = 0; n < 2; ++n) acc[a][b][m][n] = (f32x4){0.f, 0.f, 0.f, 0.f};
        cur = nxt; cA = nA; cB = nB; ++ui;
#pragma unroll
        for (int _h = 0; _h < 2; ++_h)
#pragma unroll
            for (int _i = 0; _i < 2; ++_i) oc[_h][_i] = on[_h][_i];
        if (wr == 1) PG8_BAR;
    }
    PG8_WAIT_V(0);
    PG8_BAR;
#undef PG8_UNIT_OFFS
#undef PG8_SA
#undef PG8_SB
#undef PG8_STAGE
#undef PG8_STAGE_A
#undef PG8_LDA
#undef PG8_LDB
#undef PG8_MMA
#undef PG8_WAIT_V
#undef PG8_WAIT_L
#undef PG8_BAR
#undef PG8_SCHED
}
}

#define XB_TMO      128
#define XB_XCNT(j)  (256  + 64 * (j))
#define XB_XSUB(j)  (1280 + 64 * (j))
#define XB_XGEN(j)  (2304 + 64 * (j))
#define XB_TOP      3328
#define XB_TOPGEN   3392
#define XCD_BAR_WORDS 3456
#define XB_SPIN_CAP (1u << 22)
#define LAS __attribute__((address_space(3)))
__device__ __forceinline__ unsigned xb_ld(unsigned* p)              { return __hip_atomic_load(p, __ATOMIC_RELAXED, __HIP_MEMORY_SCOPE_AGENT); }
__device__ __forceinline__ unsigned xb_add(unsigned* p, unsigned v) { return __hip_atomic_fetch_add(p, v, __ATOMIC_RELAXED, __HIP_MEMORY_SCOPE_AGENT); }
__device__ __forceinline__ unsigned xb_xcc_id() { return (unsigned)__builtin_amdgcn_s_getreg((3 << 11) | 20) & 0xFu; }
#define XB_SPIN(cond, bar) do { unsigned _sp = 0; while (cond) { __builtin_amdgcn_s_sleep(1); \
    if ((++_sp & 255u) == 0u) { if (xb_ld(&(bar)[XB_TMO])) break; if (_sp > XB_SPIN_CAP) { atomicAdd(&(bar)[XB_TMO], 1u); break; } } } } while (0)
struct XcdBarrier { unsigned* bar; unsigned x; volatile LAS unsigned* st; };
__device__ __forceinline__ XcdBarrier xcd_barrier_post(unsigned* bar, volatile LAS unsigned* st, int tid) {
    XcdBarrier b; b.bar = bar; b.x = xb_xcc_id(); b.st = st;
    if (tid == 0) (void)xb_add(&bar[XB_XCNT(b.x)], 1u);
    return b;
}
__device__ __forceinline__ void xcd_barrier_complete(unsigned* bar, unsigned x, unsigned& nloc, unsigned& nx) {
    const unsigned G = gridDim.x * gridDim.y * gridDim.z;
    unsigned sum, cnt, mine, sp = 0u;
    for (;;) {
        sum = 0u; cnt = 0u; mine = 0u;
#pragma unroll
        for (unsigned j = 0; j < 16; ++j) { const unsigned c = xb_ld(&bar[XB_XCNT(j)]); sum += c; cnt += (c > 0u) ? 1u : 0u; mine = (j == x) ? c : mine; }
        if (sum == G) break;
        __builtin_amdgcn_s_sleep(1);
        if ((++sp & 255u) == 0u) { if (xb_ld(&bar[XB_TMO])) break; if (sp > XB_SPIN_CAP) { atomicAdd(&bar[XB_TMO], 1u); break; } }
    }
    nloc = mine > 0u ? mine : 1u; nx = cnt > 0u ? cnt : 1u;
}
__device__ __forceinline__ void xcd_barrier(const XcdBarrier& b, int tid) {
    asm volatile("s_waitcnt vmcnt(0)" ::: "memory");
    __syncthreads();
    if (tid == 0) {
        unsigned* bar = b.bar;
        __builtin_amdgcn_s_waitcnt(0);
        unsigned nloc = b.st[0], nx = b.st[1];
        if (nloc == 0u) { xcd_barrier_complete(bar, b.x, nloc, nx); b.st[0] = nloc; b.st[1] = nx; }
        const unsigned old = xb_add(&bar[XB_XSUB(b.x)], 1u);
        const unsigned gen = old / nloc;
        if (old + 1u == (gen + 1u) * nloc) {
            __builtin_amdgcn_fence(__ATOMIC_RELEASE, "agent");
            asm volatile("s_waitcnt vmcnt(0)" ::: "memory");
            const unsigned og = xb_add(&bar[XB_TOP], 1u);
            const unsigned tg = og / nx;
            if (og + 1u == (tg + 1u) * nx) xb_add(&bar[XB_TOPGEN], 1u);
            else XB_SPIN(xb_ld(&bar[XB_TOPGEN]) == tg, bar);
            __builtin_amdgcn_fence(__ATOMIC_ACQUIRE, "agent");
            xb_add(&bar[XB_XGEN(b.x)], 1u);
            asm volatile("s_waitcnt vmcnt(0)" ::: "memory");
        } else {
            XB_SPIN(xb_ld(&bar[XB_XGEN(b.x)]) == gen, bar);
            __builtin_amdgcn_fence(__ATOMIC_ACQUIRE, "agent");
            asm volatile("s_waitcnt vmcnt(0)" ::: "memory");
        }
    }
    __syncthreads();
}


constexpr int NWAVES = 8, NTHR = 512;
constexpr int NPH = 15;
__device__ __forceinline__ float frsq(float x) { return __builtin_amdgcn_rsqf(x); }
__device__ __forceinline__ float frcp(float x) { return __builtin_amdgcn_rcpf(x); }
typedef float f32x4_t __attribute__((ext_vector_type(4)));
typedef unsigned u32x2_t __attribute__((ext_vector_type(2)));
typedef unsigned u32x4_t __attribute__((ext_vector_type(4)));
typedef short bf16x8_t __attribute__((ext_vector_type(8)));
__device__ __forceinline__ float wave_sum(float v) {
#pragma unroll
    for (int o = 1; o < 64; o <<= 1) v += __shfl_xor(v, o);
    return v;
}
__device__ __forceinline__ float grp16_sum(float v) {
#pragma unroll
    for (int o = 1; o < 16; o <<= 1) v += __shfl_xor(v, o);
    return v;
}
__device__ __forceinline__ float hsum4(f32x4_t a) { return (a.x + a.y) + (a.z + a.w); }
__device__ __forceinline__ float hsq4(f32x4_t a) { return (a.x * a.x + a.y * a.y) + (a.z * a.z + a.w * a.w); }
__device__ __forceinline__ u32x2_t pk4(f32x4_t t) { u32x2_t w; w.x = pg8::cvt_pk_bf16(t.x, t.y); w.y = pg8::cvt_pk_bf16(t.z, t.w); return w; }
__device__ __forceinline__ float bflo(unsigned w) { return __builtin_bit_cast(float, w << 16); }
__device__ __forceinline__ float bfhi(unsigned w) { return __builtin_bit_cast(float, w & 0xffff0000u); }
__device__ __forceinline__ f32x4_t bf4(u32x2_t w) { f32x4_t r; r.x = bflo(w.x); r.y = bfhi(w.x); r.z = bflo(w.y); r.w = bfhi(w.y); return r; }
template <bool TO_LDS> __device__ __forceinline__ void norm_mod_store(const f32x4_t (&v)[4], float rstd, const float* pn, const float* sh, const float* sc, bf16_t* orow, LAS unsigned char* lrow, int lane) {
#pragma unroll
    for (int j = 0; j < 4; ++j) { const int k = 4 * lane + 256 * j;
        const f32x4_t pv = *(const f32x4_t*)(pn + k), sv = *(const f32x4_t*)(sc + k), hv = *(const f32x4_t*)(sh + k);
        const f32x4_t t = v[j] * rstd * pv * (1.0f + sv) + hv; const u32x2_t w = pk4(t);
        *(u32x2_t*)(orow + k) = w; if (TO_LDS) *(LAS u32x2_t*)(lrow + 2 * k) = w; }
}
__device__ __forceinline__ void dev_norm1_l0(const P& p, int G, int wave, int lane) {
    int r0, r1; { const int nw = G * NWAVES, per = (NTOK + nw - 1) / nw, gwl = (int)blockIdx.x * NWAVES + wave; r0 = gwl * per; r1 = r0 + per; if (r1 > NTOK) r1 = NTOK; }
    f32x4_t pnr[4], shr[4], scr2[4]; int mrow = -1;
#pragma unroll
    for (int j = 0; j < 4; ++j) pnr[j] = *(const f32x4_t*)(p.pre_norm + 4 * lane + 256 * j);
    for (int m = r0; m < r1; ++m) {
        const float* src = m < NLAT ? p.x + (size_t)m * D : p.ctx + (size_t)(m - NLAT) * D;
        f32x4_t v[4]; float ss = 0.f;
#pragma unroll
        for (int j = 0; j < 4; ++j) { v[j] = *(const f32x4_t*)(src + 4 * lane + 256 * j); ss += hsq4(v[j]); *(f32x4_t*)(p.X() + (size_t)m * D + 4 * lane + 256 * j) = v[j]; }
        const int mr = mod_row(m);
        if (mr != mrow) { const float* md = p.MOD() + (size_t)mr * 6 * D; mrow = mr;
#pragma unroll
            for (int j = 0; j < 4; ++j) { shr[j] = *(const f32x4_t*)(md + 4 * lane + 256 * j); scr2[j] = *(const f32x4_t*)(md + D + 4 * lane + 256 * j); } }
        const float rstd = frsq(wave_sum(ss) * (1.0f / D) + 1e-6f); bf16_t* orow = p.HB() + (size_t)m * D;
#pragma unroll
        for (int j = 0; j < 4; ++j) { const f32x4_t t = v[j] * rstd * pnr[j] * (1.0f + scr2[j]) + shr[j]; *(u32x2_t*)(orow + 4 * lane + 256 * j) = pk4(t); }
    }
}
__device__ __forceinline__ void dev_post(const P& p, int l, int ntok_l, int gw, int ngw, int lane) {
    const int h = lane >> 4;
    for (int m = gw; m < ntok_l; m += ngw) {
        {
            const f32x4_t y = bf4(*(const u32x2_t*)(p.YA() + (size_t)m * A_W + 4 * lane)) + bf4(*(const u32x2_t*)(p.YA() + ((size_t)NTOK + m) * A_W + 4 * lane));
            const float mean = grp16_sum(hsum4(y)) * (1.0f / 64.f); const f32x4_t d = y - mean;
            const float var = grp16_sum(hsq4(d)) * (1.0f / 64.f); const float rs = frsq(var + 64e-5f);
            const f32x4_t lw = *(const f32x4_t*)(p.rw_ln_w + l * A_W + 4 * lane), lb = *(const f32x4_t*)(p.rw_ln_b + l * A_W + 4 * lane);
            const f32x4_t vv = bf4(*(const u32x2_t*)(p.RW_V() + (size_t)m * A_W + 4 * lane)), gt = bf4(*(const u32x2_t*)(p.RW_GATE() + (size_t)m * A_W + 4 * lane));
            const float bon = p.RW_BON()[(size_t)m * A_H + h];
            const f32x4_t o = (d * rs * lw + lb + bon * vv) * gt;
            *(u32x2_t*)(p.MIX() + (size_t)m * D + 4 * lane) = pk4(o);
        }
        {
            const u32x4_t o0 = *(const u32x4_t*)(p.OB() + (size_t)m * B_W + 8 * lane), o1 = *(const u32x4_t*)(p.OB() + ((size_t)NTOK + m) * B_W + 8 * lane);
            const f32x4_t a = bf4((u32x2_t){o0.x, o0.y}) + bf4((u32x2_t){o1.x, o1.y}), b = bf4((u32x2_t){o0.z, o0.w}) + bf4((u32x2_t){o1.z, o1.w});
            const float rs = frsq(grp16_sum(hsq4(a) + hsq4(b)) * (1.0f / 128.f) + 1e-6f);
            const u32x4_t zr = *(const u32x4_t*)(p.U() + (size_t)m * INP + B_OFF + 1536 + 8 * lane);
            const float* nw = p.gdn_norm + l * 128 + ((8 * lane) & 127);
            const f32x4_t n0 = *(const f32x4_t*)nw, n1 = *(const f32x4_t*)(nw + 4);
            const f32x4_t z0 = {bflo(zr.x), bfhi(zr.x), bflo(zr.y), bfhi(zr.y)}, z1 = {bflo(zr.z), bfhi(zr.z), bflo(zr.w), bfhi(zr.w)};
            f32x4_t s0, s1;
#pragma unroll
            for (int c = 0; c < 4; ++c) { s0[c] = z0[c] * frcp(1.0f + __expf(-z0[c])); s1[c] = z1[c] * frcp(1.0f + __expf(-z1[c])); }
            const f32x4_t r0 = a * rs * n0 * s0, r1 = b * rs * n1 * s1;
            u32x4_t w; const u32x2_t w0 = pk4(r0), w1 = pk4(r1); w.x = w0.x; w.y = w0.y; w.z = w1.x; w.w = w1.y;
            *(u32x4_t*)(p.MIX() + (size_t)m * D + 256 + 8 * lane) = w;
        }
    }
}
constexpr int RT_TK = 0, RT_TKS = 2064, RT_PL = 34816, RT_LG = RT_PL + 16384, RT_CNT = RT_LG + 2304, RT_BASE = RT_CNT + 128, RT_ASG = RT_BASE + 128, RT_ASG_MAX = 4096;
__device__ __forceinline__ void dev_resid_router(const P& p, int l, int ntok_l, LAS unsigned char* lds, int G, int tid) {
    const int lane = tid & 63, wave = tid >> 6;
    LAS int* LCNT = (LAS int*)(lds + RT_CNT); LAS int* LBASE = (LAS int*)(lds + RT_BASE); LAS int* ASG = (LAS int*)(lds + RT_ASG);
    LAS float* PL = (LAS float*)(lds + RT_PL); LAS float* LG = (LAS float*)(lds + RT_LG);
    if (tid < 32) LCNT[tid] = 0;
    __syncthreads();
    f32x4_t pnr[4], pn2r[4];
#pragma unroll
    for (int j = 0; j < 4; ++j) { const int k = 4 * lane + 256 * j; pnr[j] = *(const f32x4_t*)(p.post_norm + (size_t)(l * 2 + 0) * D + k); pn2r[j] = *(const f32x4_t*)(p.pre_norm + (size_t)(l * 2 + 1) * D + k); }
    const int ngrp = ntok_l / 16; int it = 0;
    for (int grp = blockIdx.x; grp < ngrp; grp += G, ++it) {
        f32x4_t g1r[4], sh2r[4], sc2r[4];
        { const float* md = p.MOD() + ((size_t)l * (BATCH + 1) + mod_row(grp * 16)) * 6 * D;
#pragma unroll
          for (int j = 0; j < 4; ++j) { const int k = 4 * lane + 256 * j; g1r[j] = *(const f32x4_t*)(md + 2 * D + k); sh2r[j] = *(const f32x4_t*)(md + 3 * D + k); sc2r[j] = *(const f32x4_t*)(md + 4 * D + k); } }
#pragma unroll 1
        for (int rr = 0; rr < 2; ++rr) {
            const int ri = wave * 2 + rr, m = grp * 16 + ri;
            const bf16_t* mo = p.MO() + (size_t)m * D; float* xr = p.X() + (size_t)m * D;
            f32x4_t v[4], x[4]; float ss = 0.f;
#pragma unroll
            for (int j = 0; j < 4; ++j) { v[j] = bf4(*(const u32x2_t*)(mo + 4 * lane + 256 * j)); x[j] = *(const f32x4_t*)(xr + 4 * lane + 256 * j); ss += hsq4(v[j]); }
            const float rstd = frsq(wave_sum(ss) * (1.0f / D) + 1e-6f); float s2 = 0.f;
#pragma unroll
            for (int j = 0; j < 4; ++j) { const int k = 4 * lane + 256 * j;
                x[j] = x[j] + g1r[j] * (v[j] * rstd) * pnr[j]; s2 += hsq4(x[j]); *(f32x4_t*)(xr + k) = x[j]; }
            const float r2 = frsq(wave_sum(s2) * (1.0f / D) + 1e-6f);
            { bf16_t* orow = p.HB() + (size_t)m * D; LAS unsigned char* lrow = lds + RT_TK + ri * RT_TKS;
#pragma unroll
              for (int j = 0; j < 4; ++j) { const int k = 4 * lane + 256 * j; const f32x4_t t = x[j] * r2 * pn2r[j] * (1.0f + sc2r[j]) + sh2r[j]; const u32x2_t w = pk4(t); *(u32x2_t*)(orow + k) = w; *(LAS u32x2_t*)(lrow + 2 * k) = w; } }
        }
        __syncthreads();
        {
            const int i = lane & 15, q = lane >> 4; pg8::f32x4 acc0 = {0.f, 0.f, 0.f, 0.f}, acc1 = {0.f, 0.f, 0.f, 0.f};
#pragma unroll
            for (int ks = 0; ks < 4; ++ks) { const int k0 = 128 * wave + 32 * ks + 8 * q;
                const bf16x8_t a = *(const LAS bf16x8_t*)(lds + RT_TK + i * RT_TKS + 2 * k0);
                const bf16x8_t b0 = *(const bf16x8_t*)(p.WR_T(l) + (size_t)i * D + k0), b1 = *(const bf16x8_t*)(p.WR_T(l) + (size_t)(16 + i) * D + k0);
                acc0 = __builtin_amdgcn_mfma_f32_16x16x32_bf16(a, b0, acc0, 0, 0, 0); acc1 = __builtin_amdgcn_mfma_f32_16x16x32_bf16(a, b1, acc1, 0, 0, 0); }
#pragma unroll
            for (int r = 0; r < 4; ++r) { PL[(wave * 16 + 4 * q + r) * 32 + i] = acc0[r]; PL[(wave * 16 + 4 * q + r) * 32 + 16 + i] = acc1[r]; }
        }
        __syncthreads();
        {
            const int ri = tid >> 5, e = tid & 31; float sacc = p.router_b[l * NEXP + e];
#pragma unroll
            for (int w = 0; w < 8; ++w) sacc += PL[(w * 16 + ri) * 32 + e];
            LG[ri * 33 + e] = sacc;
        }
        __syncthreads();
        if (tid < 16) {
            const int m = grp * 16 + tid; float lg[NEXP];
#pragma unroll
            for (int e = 0; e < NEXP; ++e) lg[e] = LG[tid * 33 + e];
            int idx[TOPK]; float val[TOPK];
#pragma unroll
            for (int j = 0; j < TOPK; ++j) { float best = -3.0e38f; int bi = 0;
#pragma unroll
                for (int e = 0; e < NEXP; ++e) { if (lg[e] > best) { best = lg[e]; bi = e; } }
                idx[j] = bi; val[j] = best;
#pragma unroll
                for (int e = 0; e < NEXP; ++e) if (e == bi) lg[e] = -3.0e38f; }
            float sum = 0.f, ex[TOPK];
#pragma unroll
            for (int j = 0; j < TOPK; ++j) { ex[j] = __expf(val[j] - val[0]); sum += ex[j]; }
            const float inv = 1.0f / sum;
#pragma unroll
            for (int j = 0; j < TOPK; ++j) { p.TOPI()[(size_t)m * TOPK + j] = idx[j]; p.TOPG()[(size_t)m * TOPK + j] = ex[j] * inv;
                const int lp = __hip_atomic_fetch_add(&LCNT[idx[j]], 1, __ATOMIC_RELAXED, __HIP_MEMORY_SCOPE_WORKGROUP);
                const int ai = (it * 16 + tid) * 4 + j; if (ai < RT_ASG_MAX) ASG[ai] = (idx[j] << 20) | lp; }
        }
        __syncthreads();
    }
    if (tid < 32) LBASE[tid] = LCNT[tid] > 0 ? atomicAdd(&p.cnt()[l * NEXP + tid], LCNT[tid]) : 0;
    __syncthreads();
    for (int a = tid; a < it * 64 && a < RT_ASG_MAX; a += NTHR) { const int w = ASG[a]; const int e = w >> 20, lp = w & 0xfffff; const int itx = a / 64, ri = (a % 64) / 4, j = a % 4;
        const int m = (blockIdx.x + itx * G) * 16 + ri; p.POS()[(size_t)m * TOPK + j] = LBASE[e] + lp; }
    __syncthreads();
}
__device__ __forceinline__ void dev_slots(const P& p, int l, int ntok_l, LAS unsigned char* lds, long gtid, long nthr, int tid) {
    LAS int* PST = (LAS int*)lds; LAS int* CN = (LAS int*)(lds + 256);
    if (tid == 0) { int acc = 0; for (int e = 0; e < NEXP; ++e) { const int c = p.cnt()[l * NEXP + e]; PST[e] = acc; CN[e] = c; acc += (c + 255) / 256 * 256; } PST[NEXP] = acc; }
    __syncthreads();
    for (long t = gtid; t < (long)ntok_l * TOPK; t += nthr) { const int e = p.TOPI()[t]; const int slot = PST[e] + p.POS()[t]; p.TSLOT()[t] = slot; p.SLOT_TOK()[slot] = (int)(t / TOPK); }
    for (long t = gtid; t < NEXP * 256; t += nthr) { const int e = (int)(t >> 8), i = (int)(t & 255); const int c = CN[e]; const int pads = (c + 255) / 256 * 256 - c; if (i < pads) p.SLOT_TOK()[PST[e] + c + i] = ZROW; }
    for (long t = gtid; t < NBLK_MAX; t += nthr) { int e_of = NEXP - 1;
        for (int e = 0; e < NEXP; ++e) { if ((int)t * 256 >= PST[e] && (int)t * 256 < PST[e + 1]) e_of = e; }
        p.BLOCK_E()[t] = e_of; if (t == 0) p.NBLK()[0] = PST[NEXP] / 256; }
    __syncthreads();
}
struct CbA { int4 sl; f32x4_t gt; };
struct CbB { u32x2_t y[4][4]; f32x4_t x[4]; f32x4_t gt; };
__device__ __forceinline__ void combine_loadA(const P& p, int m, CbA& a) { a.sl = *(const int4*)(p.TSLOT() + (size_t)m * 4); a.gt = *(const f32x4_t*)(p.TOPG() + (size_t)m * 4); }
__device__ __forceinline__ void combine_loadB(const P& p, int m, const CbA& a, int lane, CbB& b) {
    const bf16_t* y0 = p.YB() + (size_t)a.sl.x * D; const bf16_t* y1 = p.YB() + (size_t)a.sl.y * D; const bf16_t* y2 = p.YB() + (size_t)a.sl.z * D; const bf16_t* y3 = p.YB() + (size_t)a.sl.w * D;
    const float* xr = p.X() + (size_t)m * D;
#pragma unroll
    for (int j = 0; j < 4; ++j) { const int k = 4 * lane + 256 * j; b.y[0][j] = *(const u32x2_t*)(y0 + k); b.y[1][j] = *(const u32x2_t*)(y1 + k); b.y[2][j] = *(const u32x2_t*)(y2 + k); b.y[3][j] = *(const u32x2_t*)(y3 + k); b.x[j] = *(const f32x4_t*)(xr + k); }
    b.gt = a.gt;
}
struct CbPar { f32x4_t pn[4], pn1[4], g2[4], sh1[4], sc1[4]; int mrow; };
__device__ __forceinline__ void combine_params(const P& p, int l, int lane, CbPar& q) {
    const bool last = (l == DEPTH - 1);
#pragma unroll
    for (int j = 0; j < 4; ++j) { const int k = 4 * lane + 256 * j; q.pn[j] = *(const f32x4_t*)(p.post_norm + (size_t)(l * 2 + 1) * D + k); q.pn1[j] = last ? q.pn[j] : *(const f32x4_t*)(p.pre_norm + (size_t)((l + 1) * 2 + 0) * D + k); }
    q.mrow = -1;
}
__device__ __forceinline__ void combine_mod(const P& p, int l, int mrow, int lane, CbPar& q) {
    const bool last = (l == DEPTH - 1); const float* md = p.MOD() + ((size_t)l * (BATCH + 1) + mrow) * 6 * D; const float* md1 = p.MOD() + ((size_t)(last ? l : l + 1) * (BATCH + 1) + mrow) * 6 * D;
#pragma unroll
    for (int j = 0; j < 4; ++j) { const int k = 4 * lane + 256 * j; q.g2[j] = *(const f32x4_t*)(md + 5 * D + k); q.sh1[j] = *(const f32x4_t*)(md1 + k); q.sc1[j] = *(const f32x4_t*)(md1 + D + k); }
    q.mrow = mrow;
}
__device__ __forceinline__ void combine_compute(const P& p, int l, int m, const CbB& b, int lane, const CbPar& q) {
    const bool last = (l == DEPTH - 1);
    float* xr = p.X() + (size_t)m * D;
    const f32x4_t gt = b.gt; f32x4_t f[4], x[4]; float ss = 0.f;
#pragma unroll
    for (int j = 0; j < 4; ++j) { const u32x2_t a = b.y[0][j], bb = b.y[1][j], c = b.y[2][j], d = b.y[3][j];
        f[j].x = gt.x * bflo(a.x) + gt.y * bflo(bb.x) + gt.z * bflo(c.x) + gt.w * bflo(d.x); f[j].y = gt.x * bfhi(a.x) + gt.y * bfhi(bb.x) + gt.z * bfhi(c.x) + gt.w * bfhi(d.x);
        f[j].z = gt.x * bflo(a.y) + gt.y * bflo(bb.y) + gt.z * bflo(c.y) + gt.w * bflo(d.y); f[j].w = gt.x * bfhi(a.y) + gt.y * bfhi(bb.y) + gt.z * bfhi(c.y) + gt.w * bfhi(d.y);
        ss += hsq4(f[j]); x[j] = b.x[j]; }
    const float rstd = frsq(wave_sum(ss) * (1.0f / D) + 1e-6f); float s2 = 0.f;
#pragma unroll
    for (int j = 0; j < 4; ++j) { const int k = 4 * lane + 256 * j;
        x[j] = x[j] + q.g2[j] * (f[j] * rstd) * q.pn[j]; s2 += hsq4(x[j]);
#ifdef PROBE_DET
        if (last) { const unsigned cs_ = p.ctl()[12050]; x[j] = (f32x4_t){(float)(cs_ & 0xffffu), (float)((cs_ >> 16) & 0xffffu), 1.f, 2.f}; }
#endif
#ifdef PROBE_T
        if (last) { const unsigned long long* ts = (const unsigned long long*)(p.ctl() + 12100); const float tot = (float)(ts[2 * NPH - 1] - ts[0]);
            float fa = 0.f;
            for (int ll = 0; ll < 2; ++ll) for (int jj = 0; jj < NPH; ++jj) if (((PT_MASK >> jj) & 1) && (1 + ll * NPH + jj + 1 <= 2 * NPH - 1)) fa += (float)(ts[1 + ll * NPH + jj + 1] - ts[1 + ll * NPH + jj]);
            if ((PT_MASK >> 20) & 1) fa += (float)(ts[1] - ts[0]);
#ifdef PT_ACT
            fa = (float)p.ctl()[12070] + (float)p.ctl()[12071];
#endif
#ifdef PT_SEC
#ifndef PT_SEC_SCALE
#define PT_SEC_SCALE 128.0f
#endif
            fa = (float)p.ctl()[12080] * (1.0f / PT_SEC_SCALE);
#endif
            const float fq = floorf(fa / tot * 64.0f + 0.5f) * (1.0f / 64.0f);
            x[j] = x[j] * (1.0f + 0.07f * sqrtf(fq)); }
#endif
#if defined(PROBE_GDN) || defined(PROBE_RWKV)
        if (last) { const float e = ((const float*)(p.ctl() + 12000))[0], r = ((const float*)(p.ctl() + 12001))[0]; x[j] = x[j] * (1.0f + 10.0f * sqrtf(e / r)); }
#endif
        if (last) *(f32x4_t*)(p.out + (size_t)m * D + k) = x[j]; else *(f32x4_t*)(xr + k) = x[j]; }
    if (!last) { const float r2 = frsq(wave_sum(s2) * (1.0f / D) + 1e-6f); bf16_t* orow = p.HB() + (size_t)m * D;
#pragma unroll
        for (int j = 0; j < 4; ++j) { const int k = 4 * lane + 256 * j; const f32x4_t t = x[j] * r2 * q.pn1[j] * (1.0f + q.sc1[j]) + q.sh1[j]; *(u32x2_t*)(orow + k) = pk4(t); } }
}
__device__ __forceinline__ void dev_combine(const P& p, int l, int ntok_l, int G, int wave, int lane) {
    int r0, r1; { const int nw = G * NWAVES, per = (ntok_l + nw - 1) / nw, gwl = (int)blockIdx.x * NWAVES + wave; r0 = gwl * per; r1 = r0 + per; if (r1 > ntok_l) r1 = ntok_l; }
    if (r0 >= r1) return;
    CbPar par; combine_params(p, l, lane, par);
    int m = r0; CbA a0, a1; CbB b0; combine_loadA(p, m, a0); a1 = a0; if (m + 1 < r1) combine_loadA(p, m + 1, a1);
    combine_loadB(p, m, a0, lane, b0);
    for (; m < r1; ++m) {
        CbA a2 = a1; if (m + 2 < r1) combine_loadA(p, m + 2, a2);
        CbB b1 = b0; if (m + 1 < r1) combine_loadB(p, m + 1, a1, lane, b1);
        const int mr = mod_row(m); if (mr != par.mrow) combine_mod(p, l, mr, lane, par);
        combine_compute(p, l, m, b0, lane, par);
        b0 = b1; a1 = a2;
    }
}
__device__ __forceinline__ void lds_barrier() { asm volatile("s_waitcnt lgkmcnt(0)\n\ts_barrier" ::: "memory"); }
#define MMA16(a, b, c) __builtin_amdgcn_mfma_f32_16x16x32_bf16((a), (b), (c), 0, 0, 0)
typedef pg8::f32x4 f32x4;
__device__ __forceinline__ bf16x8_t lfrag(LAS const unsigned char* lds, int off, int ld, int row0, int k0, int lane) {
    return *(LAS const bf16x8_t*)(lds + off + (row0 + (lane & 15)) * ld + (k0 + 8 * (lane >> 4)) * 2);
}
__device__ __forceinline__ bf16x8_t lfrag16(LAS const unsigned char* lds, int off, int ld, int row0, int k0, int lane) {
    bf16x8_t z = {0, 0, 0, 0, 0, 0, 0, 0}; return (lane >> 4) < 2 ? lfrag(lds, off, ld, row0, k0, lane) : z;
}
__device__ __forceinline__ bf16x8_t lfragT(LAS const unsigned char* lds, int off, int ld, int k0, int n0, int kvalid, int lane) {
    bf16x8_t v; const int n = n0 + (lane & 15), kb = 8 * (lane >> 4);
#pragma unroll
    for (int j = 0; j < 8; ++j) v[j] = (kb + j < kvalid) ? *(LAS const short*)(lds + off + (k0 + kb + j) * ld + n * 2) : (short)0;
    return v;
}
typedef short bf16x4_t __attribute__((ext_vector_type(4)));
__device__ __forceinline__ bf16x8_t lfragTr(LAS unsigned char* lds, int off, int ld, int k0, int n0, int lane) {
    LAS unsigned char* a = lds + off + (k0 + 8 * (lane >> 4) + ((lane & 15) >> 2)) * ld + (n0 + 4 * (lane & 3)) * 2;
    const bf16x4_t lo = __builtin_amdgcn_ds_read_tr16_b64_v4i16((LAS bf16x4_t*)a), hi = __builtin_amdgcn_ds_read_tr16_b64_v4i16((LAS bf16x4_t*)(a + 4 * ld));
    return __builtin_shufflevector(lo, hi, 0, 1, 2, 3, 4, 5, 6, 7);
}
__device__ __forceinline__ void st_rm(LAS unsigned char* lds, int off, int ld, int m0, int n0, f32x4 acc, int lane) {
#pragma unroll
    for (int r = 0; r < 4; ++r) *(LAS bf16_t*)(lds + off + (m0 + 4 * (lane >> 4) + r) * ld + (n0 + (lane & 15)) * 2) = f2bf(acc[r]);
}
__device__ __forceinline__ void st_tr(LAS unsigned char* lds, int off, int ld, int m0, int n0, f32x4 acc, int lane) {
    u32x2_t w; w.x = pg8::cvt_pk_bf16(acc[0], acc[1]); w.y = pg8::cvt_pk_bf16(acc[2], acc[3]);
    *(LAS u32x2_t*)(lds + off + (n0 + (lane & 15)) * ld + (m0 + 4 * (lane >> 4)) * 2) = w;
}
__device__ __forceinline__ u32x4_t scale8(u32x4_t v, float s) {
    u32x4_t o; o.x = pg8::cvt_pk_bf16(bflo(v.x) * s, bfhi(v.x) * s); o.y = pg8::cvt_pk_bf16(bflo(v.y) * s, bfhi(v.y) * s);
    o.z = pg8::cvt_pk_bf16(bflo(v.z) * s, bfhi(v.z) * s); o.w = pg8::cvt_pk_bf16(bflo(v.w) * s, bfhi(v.w) * s); return o;
}

template <int LOFF, int TOFF, int SCOFF>
__device__ __forceinline__ void tri_inv64(LAS unsigned char* lds, int tid) {
    const int wave = __builtin_amdgcn_readfirstlane(tid >> 6); int lane = tid & 63, q4 = lane >> 4, l16 = lane & 15;
    if (wave == 0) {
        float x[16];
#pragma unroll
        for (int i = 0; i < 16; ++i) { float sacc = (i == l16) ? 1.f : 0.f;
#pragma unroll
            for (int j = 0; j < i; ++j) sacc -= bf2f(*(LAS const bf16_t*)(lds + LOFF + (16 * q4 + i) * 144 + (16 * q4 + j) * 2)) * x[j];
            x[i] = sacc; }
#pragma unroll
        for (int i = 0; i < 16; ++i) *(LAS bf16_t*)(lds + TOFF + (16 * q4 + i) * 144 + (16 * q4 + l16) * 2) = f2bf(x[i]);
    }
    lds_barrier(); asm volatile("" : "+v"(tid)); lane = tid & 63;
    if (wave < 2) {
        const int I = 2 * wave + 1, J = 2 * wave; const f32x4 z = {0.f, 0.f, 0.f, 0.f};
        const f32x4 m1 = MMA16(lfrag16(lds, LOFF, 144, 16 * I, 16 * J, lane), lfragT(lds, TOFF, 144, 16 * J, 16 * J, 16, lane), z);
        st_rm(lds, SCOFF + wave * 1280, 80, 0, 0, m1, lane);
        asm volatile("s_waitcnt lgkmcnt(0)" ::: "memory");
        const f32x4 t1 = MMA16(lfrag16(lds, TOFF, 144, 16 * I, 16 * I, lane), lfragT(lds, SCOFF + wave * 1280, 80, 0, 0, 16, lane), z);
        st_rm(lds, TOFF, 144, 16 * I, 16 * J, -t1, lane);
    }
    lds_barrier(); asm volatile("" : "+v"(tid)); lane = tid & 63;
    {
        const int mt2 = (wave >> 1) & 1, nt2 = wave & 1; const f32x4 z = {0.f, 0.f, 0.f, 0.f};
        if (wave < 4) { const f32x4 m2 = MMA16(lfrag(lds, LOFF, 144, 32 + 16 * mt2, 0, lane), lfragT(lds, TOFF, 144, 0, 16 * nt2, 32, lane), z); st_rm(lds, SCOFF, 80, 16 * mt2, 16 * nt2, m2, lane); }
        lds_barrier();
        if (wave < 4) { const f32x4 t2 = MMA16(lfrag(lds, TOFF, 144, 32 + 16 * mt2, 32, lane), lfragT(lds, SCOFF, 80, 0, 16 * nt2, 32, lane), z); st_rm(lds, TOFF, 144, 32 + 16 * mt2, 16 * nt2, -t2, lane); }
    }
    lds_barrier();
}

template <int LOFF, int TOFF, int SCOFF, int DGOFF, int TTOFF>
__device__ __forceinline__ void tri_inv64x(LAS unsigned char* lds, int tid) {
    const int wave = __builtin_amdgcn_readfirstlane(tid >> 6); int lane = tid & 63, q4 = lane >> 4, l16 = lane & 15;
    if (wave == 0) {
        LAS const unsigned char* dg = lds + DGOFF + q4 * 1040;
        float x[16];
#pragma unroll
        for (int i = 0; i < 16; ++i) { float s0 = (i == l16) ? 1.f : 0.f, s1 = 0.f;
#pragma unroll
            for (int pc = 0; pc < (i + 3) / 4; ++pc) { const f32x4 lv = *(LAS const f32x4*)(dg + i * 64 + pc * 16);
#pragma unroll
                for (int e = 0; e < 4; ++e) { const int j = 4 * pc + e; if (j < i) { if (j & 1) s1 -= lv[e] * x[j]; else s0 -= lv[e] * x[j]; } } }
            x[i] = s0 + s1; }
#pragma unroll
        for (int i = 0; i < 16; ++i) *(LAS bf16_t*)(lds + TOFF + (16 * q4 + i) * 144 + (16 * q4 + l16) * 2) = f2bf(x[i]);
        u32x4_t w0, w1; w0.x = pg8::cvt_pk_bf16(x[0], x[1]); w0.y = pg8::cvt_pk_bf16(x[2], x[3]); w0.z = pg8::cvt_pk_bf16(x[4], x[5]); w0.w = pg8::cvt_pk_bf16(x[6], x[7]);
        w1.x = pg8::cvt_pk_bf16(x[8], x[9]); w1.y = pg8::cvt_pk_bf16(x[10], x[11]); w1.z = pg8::cvt_pk_bf16(x[12], x[13]); w1.w = pg8::cvt_pk_bf16(x[14], x[15]);
        LAS unsigned char* tt = lds + TTOFF + (16 * q4 + l16) * 80;
        *(LAS u32x4_t*)(tt + (q4 & 1) * 32) = w0; *(LAS u32x4_t*)(tt + (q4 & 1) * 32 + 16) = w1;
        if (q4 & 1) { *(LAS u32x4_t*)tt = (u32x4_t){0u, 0u, 0u, 0u}; *(LAS u32x4_t*)(tt + 16) = (u32x4_t){0u, 0u, 0u, 0u}; }
    }
    lds_barrier(); asm volatile("" : "+v"(tid)); lane = tid & 63; q4 = lane >> 4; l16 = lane & 15;
    if (wave < 2) {
        const int I = 2 * wave + 1, J = 2 * wave; const f32x4 z = {0.f, 0.f, 0.f, 0.f}; const bf16x8_t zf = {0, 0, 0, 0, 0, 0, 0, 0};
        const bf16x8_t bT = q4 < 2 ? *(LAS const bf16x8_t*)(lds + TTOFF + (16 * J + l16) * 80 + (8 * q4) * 2) : zf;
        const f32x4 m1 = MMA16(lfrag16(lds, LOFF, 144, 16 * I, 16 * J, lane), bT, z);
        LAS unsigned char* sc = lds + SCOFF + wave * 1280;
        { u32x2_t w; w.x = pg8::cvt_pk_bf16(m1[0], m1[1]); w.y = pg8::cvt_pk_bf16(m1[2], m1[3]); *(LAS u32x2_t*)(sc + l16 * 48 + (4 * q4) * 2) = w; }
        asm volatile("s_waitcnt lgkmcnt(0)" ::: "memory");
        const bf16x8_t bM = q4 < 2 ? *(LAS const bf16x8_t*)(sc + l16 * 48 + (8 * q4) * 2) : zf;
        const f32x4 t1 = MMA16(lfrag16(lds, TOFF, 144, 16 * I, 16 * I, lane), bM, z);
        st_rm(lds, TOFF, 144, 16 * I, 16 * J, -t1, lane);
        st_tr(lds, TTOFF, 80, 16, 16 * J, -t1, lane);
    }
    lds_barrier(); asm volatile("" : "+v"(tid)); lane = tid & 63;
    {
        const int mt2 = (wave >> 1) & 1, nt2 = wave & 1; const f32x4 z = {0.f, 0.f, 0.f, 0.f};
        if (wave < 4) { const f32x4 m2 = MMA16(lfrag(lds, LOFF, 144, 32 + 16 * mt2, 0, lane), lfrag(lds, TTOFF, 80, 16 * nt2, 0, lane), z); st_tr(lds, SCOFF, 80, 16 * mt2, 16 * nt2, m2, lane); }
        lds_barrier();
        if (wave < 4) { const f32x4 t2 = MMA16(lfrag(lds, TOFF, 144, 32 + 16 * mt2, 32, lane), lfrag(lds, SCOFF, 80, 16 * nt2, 0, lane), z); st_rm(lds, TOFF, 144, 32 + 16 * mt2, 16 * nt2, -t2, lane); }
    }
    lds_barrier();
}

constexpr int GQ_ = 0, GK_ = 17408, GV_ = 34816, GL_ = 53248, GT_ = 62464, GSC_ = 71680, GVB_ = 74240, GKB_ = 92672, GST_ = 111104, GF_ = 145920;
constexpr int LD128 = 272, LD64 = 144, LDSC = 80;
__device__ __forceinline__ void gdn_chain(const bf16_t* __restrict__ gq, const bf16_t* __restrict__ gk, const bf16_t* __restrict__ gv, const float* __restrict__ gg, const float* __restrict__ gbeta, int chain, bf16_t* __restrict__ OBout, LAS unsigned char* lds, int tid, unsigned* ctlp) {
    const int wave = __builtin_amdgcn_readfirstlane(tid >> 6); int lane = tid & 63, q4 = lane >> 4, l16 = lane & 15;
#ifdef PT_SEC
    unsigned long long ts_ = __builtin_amdgcn_s_memrealtime();
#define SEC_MARK(k) do { if (tid == 0) { const unsigned long long n_ = __builtin_amdgcn_s_memrealtime(); if ((k) == PT_SEC) atomicAdd(ctlp + 12080, (unsigned)(n_ - ts_)); ts_ = n_; } } while (0)
#else
#define SEC_MARK(k)
#endif
#define GDN_RELANE() do { asm volatile("" : "+v"(tid)); lane = tid & 63; q4 = lane >> 4; l16 = lane & 15; } while (0)
    const int h = chain % B_H, b = (chain / B_H) % BATCH, dir = chain / (B_H * BATCH);
    LAS float* GF = (LAS float*)(lds + GF_);
    for (int i = tid; i < 34816 / 16; i += NTHR) *(LAS u32x4_t*)(lds + GST_ + 16 * i) = (u32x4_t){0u, 0u, 0u, 0u};
    f32x4 Sacc[8];
#pragma unroll
    for (int nt = 0; nt < 8; ++nt) Sacc[nt] = (f32x4){0.f, 0.f, 0.f, 0.f};
    u32x4_t pq[2], pk[2], pv[2]; float pg = 0.f, pb = 0.f;
#define GDN_LOADS(cc) do { _Pragma("unroll") for (int u = 0; u < 2; ++u) { const int piece = tid + 512 * u, i = piece >> 4, c16 = piece & 15; \
        const size_t ro = (size_t)scan_row(dir, b, 64 * (cc) + i) * B_W + h * 128 + c16 * 8; \
        pq[u] = *(const u32x4_t*)(gq + ro); pk[u] = *(const u32x4_t*)(gk + ro); pv[u] = *(const u32x4_t*)(gv + ro); } \
        if (tid < 64) { const size_t ro = (size_t)scan_row(dir, b, 64 * (cc) + tid) * 8 + dir * 4 + h; pg = gg[ro]; pb = gbeta[ro]; } } while (0)
    GDN_LOADS(0);
    constexpr int NCH = SLEN / 64;
#pragma unroll 1
    for (int c = 0; c < NCH; ++c) {
        GDN_RELANE();
#pragma unroll
        for (int u = 0; u < 2; ++u) { const int piece = tid + 512 * u, i = piece >> 4, c16 = piece & 15;
            *(LAS u32x4_t*)(lds + GQ_ + i * LD128 + c16 * 16) = pq[u]; *(LAS u32x4_t*)(lds + GK_ + i * LD128 + c16 * 16) = pk[u]; *(LAS u32x4_t*)(lds + GV_ + i * LD128 + c16 * 16) = pv[u]; }
        for (int i2 = tid; i2 < 9216 / 16; i2 += NTHR) *(LAS u32x4_t*)(lds + GT_ + 16 * i2) = (u32x4_t){0u, 0u, 0u, 0u};
        if (wave == 0) {
            float x = pg;
#pragma unroll
            for (int o = 1; o < 64; o <<= 1) { const float y = __shfl_up(x, o); if (lane >= o) x += y; }
            const float gl = __shfl(x, 63);
            GF[lane] = x; GF[64 + lane] = pb; GF[128 + lane] = __expf(x); GF[192 + lane] = __expf(gl - x); if (lane == 0) GF[256] = __expf(gl);
        }
        if (c + 1 < NCH) GDN_LOADS(c + 1);
        lds_barrier(); __builtin_amdgcn_sched_barrier(0); GDN_RELANE(); SEC_MARK(1);
        const int mt = wave >> 1;
        f32x4 qk[2];
        {
            f32x4 kk[2]; kk[0] = kk[1] = qk[0] = qk[1] = (f32x4){0.f, 0.f, 0.f, 0.f};
#pragma unroll
            for (int ks = 0; ks < 4; ++ks) { __builtin_amdgcn_sched_barrier(0); const bf16x8_t ak = lfrag(lds, GK_, LD128, 16 * mt, 32 * ks, lane), aq = lfrag(lds, GQ_, LD128, 16 * mt, 32 * ks, lane);
#pragma unroll
                for (int t = 0; t < 2; ++t) { const bf16x8_t bk = lfrag(lds, GK_, LD128, 16 * (2 * (wave & 1) + t), 32 * ks, lane); kk[t] = MMA16(bk, ak, kk[t]); qk[t] = MMA16(bk, aq, qk[t]); } }
#pragma unroll
            for (int t = 0; t < 2; ++t) { const int i = 16 * mt + l16; const float gci = GF[i], bi = GF[64 + i]; f32x4 lv;
#pragma unroll
                for (int r = 0; r < 4; ++r) { const int j = 16 * (2 * (wave & 1) + t) + 4 * q4 + r; const float dec = i >= j ? __expf(gci - GF[j]) : 0.f;
                    lv[r] = i > j ? bi * kk[t][r] * dec : 0.f; qk[t][r] *= dec; }
                st_tr(lds, GL_, LD64, 16 * (2 * (wave & 1) + t), 16 * mt, lv, lane); }
        }
        lds_barrier(); __builtin_amdgcn_sched_barrier(0); GDN_RELANE();
        SEC_MARK(2);
        if (wave >= 4) {
            const int t4 = tid - 256;
#pragma unroll
            for (int rep = 0; rep < 4; ++rep) { const int task = t4 + 256 * rep, cidx = task & 127, jg = task >> 7; float vv[8], kv[8];
#pragma unroll
                for (int jj = 0; jj < 8; ++jj) { const int j = 8 * jg + jj; const float bj = GF[64 + j];
                    vv[jj] = bf2f(*(LAS const bf16_t*)(lds + GV_ + j * LD128 + cidx * 2)) * bj; kv[jj] = bf2f(*(LAS const bf16_t*)(lds + GK_ + j * LD128 + cidx * 2)) * bj * GF[128 + j]; }
                u32x4_t wv, wk; wv.x = pg8::cvt_pk_bf16(vv[0], vv[1]); wv.y = pg8::cvt_pk_bf16(vv[2], vv[3]); wv.z = pg8::cvt_pk_bf16(vv[4], vv[5]); wv.w = pg8::cvt_pk_bf16(vv[6], vv[7]);
                wk.x = pg8::cvt_pk_bf16(kv[0], kv[1]); wk.y = pg8::cvt_pk_bf16(kv[2], kv[3]); wk.z = pg8::cvt_pk_bf16(kv[4], kv[5]); wk.w = pg8::cvt_pk_bf16(kv[6], kv[7]);
                *(LAS u32x4_t*)(lds + GVB_ + cidx * LD64 + jg * 16) = wv; *(LAS u32x4_t*)(lds + GKB_ + cidx * LD64 + jg * 16) = wk; }
#pragma unroll
            for (int u = 0; u < 4; ++u) { const int piece = t4 + 256 * u, i = piece >> 4, c16 = piece & 15; LAS u32x4_t* qp = (LAS u32x4_t*)(lds + GQ_ + i * LD128 + c16 * 16); *qp = scale8(*qp, GF[128 + i]); }
        }
        tri_inv64<GL_, GT_, GSC_>(lds, tid); GDN_RELANE(); SEC_MARK(3);
#pragma unroll
        for (int t = 0; t < 2; ++t) st_tr(lds, GL_, LD64, 16 * (2 * (wave & 1) + t), 16 * mt, qk[t], lane);
        SEC_MARK(4);
        f32x4 accu[4], o[4];
#pragma unroll
        for (int m = 0; m < 4; ++m) accu[m] = o[m] = (f32x4){0.f, 0.f, 0.f, 0.f};
#pragma unroll
        for (int ks = 0; ks < 2; ++ks) { __builtin_amdgcn_sched_barrier(0); const bf16x8_t bb = lfrag(lds, GVB_, LD64, 16 * wave, 32 * ks, lane);
#pragma unroll
            for (int m = 0; m < 4; ++m) accu[m] = MMA16(lfrag(lds, GT_, LD64, 16 * m, 32 * ks, lane), bb, accu[m]); }
        {
            f32x4 accw[4];
#pragma unroll
            for (int m = 0; m < 4; ++m) accw[m] = (f32x4){0.f, 0.f, 0.f, 0.f};
#pragma unroll
            for (int ks = 0; ks < 2; ++ks) { __builtin_amdgcn_sched_barrier(0); const bf16x8_t bb = lfrag(lds, GKB_, LD64, 16 * wave, 32 * ks, lane);
#pragma unroll
                for (int m = 0; m < 4; ++m) accw[m] = MMA16(bb, lfrag(lds, GT_, LD64, 16 * m, 32 * ks, lane), accw[m]); }
            lds_barrier();
#pragma unroll
            for (int m = 0; m < 4; ++m) st_tr(lds, GVB_, LD128, 16 * wave, 16 * m, -accw[m], lane);
        }
#pragma unroll
        for (int rep = 0; rep < 2; ++rep) { const int task = tid + 512 * rep, cidx = task & 127, jg = task >> 7; float kv[8];
#pragma unroll
            for (int jj = 0; jj < 8; ++jj) { const int j = 8 * jg + jj; kv[jj] = bf2f(*(LAS const bf16_t*)(lds + GK_ + j * LD128 + cidx * 2)) * GF[192 + j]; }
            u32x4_t wk; wk.x = pg8::cvt_pk_bf16(kv[0], kv[1]); wk.y = pg8::cvt_pk_bf16(kv[2], kv[3]); wk.z = pg8::cvt_pk_bf16(kv[4], kv[5]); wk.w = pg8::cvt_pk_bf16(kv[6], kv[7]);
            *(LAS u32x4_t*)(lds + GKB_ + cidx * LD64 + jg * 16) = wk; }
        lds_barrier(); __builtin_amdgcn_sched_barrier(0); GDN_RELANE();
        SEC_MARK(5);
#pragma unroll
        for (int ks = 0; ks < 4; ++ks) { __builtin_amdgcn_sched_barrier(0); const bf16x8_t bb = lfrag(lds, GST_, LD128, 16 * wave, 32 * ks, lane);
#pragma unroll
            for (int m = 0; m < 4; ++m) { accu[m] = MMA16(lfrag(lds, GVB_, LD128, 16 * m, 32 * ks, lane), bb, accu[m]); o[m] = MMA16(bb, lfrag(lds, GQ_, LD128, 16 * m, 32 * ks, lane), o[m]); } }
#pragma unroll
        for (int m = 0; m < 4; ++m) st_tr(lds, GV_, LD64, 16 * m, 16 * wave, accu[m], lane);
        lds_barrier(); __builtin_amdgcn_sched_barrier(0); GDN_RELANE();
        const int row0 = scan_row(dir, b, 64 * c), sgn = dir ? -1 : 1;
        SEC_MARK(6);
#pragma unroll
        for (int ks = 0; ks < 2; ++ks) { __builtin_amdgcn_sched_barrier(0); const bf16x8_t bb = lfrag(lds, GV_, LD64, 16 * wave, 32 * ks, lane);
#pragma unroll
            for (int m = 0; m < 4; ++m) o[m] = MMA16(bb, lfrag(lds, GL_, LD64, 16 * m, 32 * ks, lane), o[m]); }
#pragma unroll
        for (int m = 0; m < 4; ++m) { const int i = 16 * m + l16; const int row = row0 + sgn * i;
            u32x2_t w; w.x = pg8::cvt_pk_bf16(o[m][0], o[m][1]); w.y = pg8::cvt_pk_bf16(o[m][2], o[m][3]); *(u32x2_t*)(OBout + (unsigned)((dir * NTOK + row) * B_W + h * 128 + 16 * wave + 4 * q4)) = w; }
        {
            const float gl = GF[256];
#pragma unroll
            for (int nt = 0; nt < 8; ++nt) Sacc[nt] = Sacc[nt] * gl;
#pragma unroll
            for (int ks = 0; ks < 2; ++ks) { __builtin_amdgcn_sched_barrier(0); const bf16x8_t aa = lfrag(lds, GKB_, LD64, 16 * wave, 32 * ks, lane);
#pragma unroll
                for (int nt = 0; nt < 8; ++nt) Sacc[nt] = MMA16(aa, lfrag(lds, GV_, LD64, 16 * nt, 32 * ks, lane), Sacc[nt]); }
#pragma unroll
            for (int nt = 0; nt < 8; ++nt) st_tr(lds, GST_, LD128, 16 * wave, 16 * nt, Sacc[nt], lane);
        }
        lds_barrier(); __builtin_amdgcn_sched_barrier(0); GDN_RELANE(); SEC_MARK(7);
    }
#undef GDN_LOADS
#undef GDN_RELANE
#undef SEC_MARK
}

constexpr int SP_ = 0, SQ_ = 9216, SK_ = 18432, SR_ = 27648, SPT_ = 36864, SQT_ = 46080, SL_ = 55296, ST_ = 64512, SSC_ = 73728, SAT_ = 76288, SNB_ = 85504, SPH_ = 94720, SAH_ = 103936, SCS_ = 113152, SVT_ = 129792, SDC_ = 139008, SSEG_ = 139264;
constexpr int RW_NCH = SLEN / 64, RW_UNITS = 2 * BATCH * A_H * RW_NCH;
constexpr int SDG_ = SCS_  , STT_ = SCS_ + 4352;
struct S1In { float ld[8]; u32x4_t kk, ka, kd, rr; };
__device__ __forceinline__ void rwkv_stage1_load(const P& p, int unit, int tid, S1In& in) {
    const int c = unit % RW_NCH, chain = unit / RW_NCH; const int h = chain % A_H, b = (chain / A_H) % BATCH, dir = chain / (A_H * BATCH);
    const int row0 = scan_row(dir, b, 64 * c), sgn = dir ? -1 : 1;
    { const int k = tid & 63, sg = tid >> 6;
#pragma unroll
      for (int tt = 0; tt < 8; ++tt) in.ld[tt] = p.RW_D()[((size_t)dir * NTOK + (row0 + sgn * (8 * sg + tt))) * A_W + h * 64 + k]; }
    { const int t = tid >> 3, kg = tid & 7; const int row = row0 + sgn * t;
      const size_t o1 = (size_t)row * A_W + h * 64 + 8 * kg, o2 = ((size_t)dir * NTOK + row) * A_W + h * 64 + 8 * kg;
      in.kk = *(const u32x4_t*)(p.RW_KK() + o1); in.ka = *(const u32x4_t*)(p.RW_KKA() + o2); in.kd = *(const u32x4_t*)(p.RW_KD() + o2); in.rr = *(const u32x4_t*)(p.RW_R() + o1); }
}
__device__ __forceinline__ void rwkv_stage1(const P& p, int unit, const S1In& in, LAS unsigned char* lds, int tid, unsigned* qctr, unsigned& qraw) {
    const int wave = __builtin_amdgcn_readfirstlane(tid >> 6); int lane = tid & 63, q4 = lane >> 4, l16 = lane & 15;
#define RW_RELANE() do { asm volatile("" : "+v"(tid)); lane = tid & 63; q4 = lane >> 4; l16 = lane & 15; } while (0)
#ifdef PT_SEC
    unsigned long long ts1_ = __builtin_amdgcn_s_memrealtime();
#define S1_MARK(k) do { if (tid == 0) { const unsigned long long n_ = __builtin_amdgcn_s_memrealtime(); if ((k) == PT_SEC) atomicAdd(p.ctl() + 12080, (unsigned)(n_ - ts1_)); ts1_ = n_; } } while (0)
#else
#define S1_MARK(k)
#endif
    LAS float* CS = (LAS float*)(lds + SCS_); LAS float* DCv = (LAS float*)(lds + SDC_); LAS float* SEG = (LAS float*)(lds + SSEG_);
    {
        const int k = tid & 63, sg = tid >> 6; float x = 0.f, loc[8];
#pragma unroll
        for (int tt = 0; tt < 8; ++tt) { x += in.ld[tt]; loc[tt] = x; }
        SEG[sg * 64 + k] = x;
        for (int i2 = tid; i2 < 9216 / 16; i2 += NTHR) *(LAS u32x4_t*)(lds + ST_ + 16 * i2) = (u32x4_t){0u, 0u, 0u, 0u};
        lds_barrier();
        float pre = 0.f;
        for (int s2 = 0; s2 < sg; ++s2) pre += SEG[s2 * 64 + k];
#pragma unroll
        for (int tt = 0; tt < 8; ++tt) { const float e = __expf(loc[tt] + pre); CS[(8 * sg + tt) * 65 + k] = e; if (tt == 7 && sg == 7) DCv[k] = e; }
    }
    lds_barrier(); RW_RELANE(); S1_MARK(11);
    {
        const int t = tid >> 3, kg = tid & 7;
        float kk[8], ka[8], kd[8], rr[8];
#pragma unroll
        for (int j = 0; j < 4; ++j) { kk[2 * j] = bflo(in.kk[j]); kk[2 * j + 1] = bfhi(in.kk[j]); ka[2 * j] = bflo(in.ka[j]); ka[2 * j + 1] = bfhi(in.ka[j]); kd[2 * j] = bflo(in.kd[j]); kd[2 * j + 1] = bfhi(in.kd[j]);
            rr[2 * j] = bflo(in.rr[j]); rr[2 * j + 1] = bfhi(in.rr[j]); }
        float pp[8], qq[8], kt[8], rh[8];
#pragma unroll
        for (int j = 0; j < 8; ++j) { const int k = 8 * kg + j; const float e = CS[t * 65 + k], em = t > 0 ? CS[(t - 1) * 65 + k] : 1.f; const float ei = frcp(e);
            pp[j] = em * kk[j]; qq[j] = ka[j] * ei; kt[j] = kd[j] * ei; rh[j] = rr[j] * e; }
        u32x4_t w;
        w.x = pg8::cvt_pk_bf16(pp[0], pp[1]); w.y = pg8::cvt_pk_bf16(pp[2], pp[3]); w.z = pg8::cvt_pk_bf16(pp[4], pp[5]); w.w = pg8::cvt_pk_bf16(pp[6], pp[7]); *(LAS u32x4_t*)(lds + SP_ + t * 144 + kg * 16) = w;
        w.x = pg8::cvt_pk_bf16(qq[0], qq[1]); w.y = pg8::cvt_pk_bf16(qq[2], qq[3]); w.z = pg8::cvt_pk_bf16(qq[4], qq[5]); w.w = pg8::cvt_pk_bf16(qq[6], qq[7]); *(LAS u32x4_t*)(lds + SQ_ + t * 144 + kg * 16) = w;
        w.x = pg8::cvt_pk_bf16(kt[0], kt[1]); w.y = pg8::cvt_pk_bf16(kt[2], kt[3]); w.z = pg8::cvt_pk_bf16(kt[4], kt[5]); w.w = pg8::cvt_pk_bf16(kt[6], kt[7]); *(LAS u32x4_t*)(lds + SK_ + t * 144 + kg * 16) = w;
        w.x = pg8::cvt_pk_bf16(rh[0], rh[1]); w.y = pg8::cvt_pk_bf16(rh[2], rh[3]); w.z = pg8::cvt_pk_bf16(rh[4], rh[5]); w.w = pg8::cvt_pk_bf16(rh[6], rh[7]); *(LAS u32x4_t*)(lds + SR_ + t * 144 + kg * 16) = w;
    }
    lds_barrier(); RW_RELANE(); S1_MARK(12);
    const int mt = wave >> 1, ntb = 2 * (wave & 1);
    f32x4 krm[2];
    {
        f32x4 qp[2], kp[2], qr[2];
#pragma unroll
        for (int t2 = 0; t2 < 2; ++t2) qp[t2] = kp[t2] = qr[t2] = krm[t2] = (f32x4){0.f, 0.f, 0.f, 0.f};
#pragma unroll
        for (int ks = 0; ks < 2; ++ks) { const bf16x8_t aP = lfrag(lds, SP_, 144, 16 * mt, 32 * ks, lane), aR = lfrag(lds, SR_, 144, 16 * mt, 32 * ks, lane);
#pragma unroll
            for (int t2 = 0; t2 < 2; ++t2) { const bf16x8_t bQ = lfrag(lds, SQ_, 144, 16 * (ntb + t2), 32 * ks, lane), bK = lfrag(lds, SK_, 144, 16 * (ntb + t2), 32 * ks, lane);
                qp[t2] = MMA16(bQ, aP, qp[t2]); kp[t2] = MMA16(aP, bK, kp[t2]); qr[t2] = MMA16(bQ, aR, qr[t2]); krm[t2] = MMA16(bK, aR, krm[t2]); } }
#pragma unroll
        for (int t2 = 0; t2 < 2; ++t2) {
#pragma unroll
            for (int r = 0; r < 4; ++r) {
                { const int t = 16 * mt + 4 * q4 + r, i = 16 * (ntb + t2) + l16; kp[t2][r] = t > i ? kp[t2][r] : 0.f; }
                { const int i = 16 * (ntb + t2) + 4 * q4 + r, t = 16 * mt + l16; const bool st = t > i, inc = t >= i;
                  qp[t2][r] = st ? qp[t2][r] : 0.f; qr[t2][r] = inc ? -qr[t2][r] : 0.f; krm[t2][r] = inc ? krm[t2][r] : 0.f; } }
            st_tr(lds, SL_, 144, 16 * (ntb + t2), 16 * mt, qp[t2], lane); st_tr(lds, SAT_, 144, 16 * mt, 16 * (ntb + t2), kp[t2], lane); st_tr(lds, SNB_, 144, 16 * (ntb + t2), 16 * mt, qr[t2], lane);
            if (ntb + t2 == mt) *(LAS f32x4*)(lds + SDG_ + mt * 1040 + l16 * 64 + q4 * 16) = qp[t2]; }
    }
    lds_barrier(); RW_RELANE(); S1_MARK(13);
    tri_inv64x<SL_, ST_, SSC_, SDG_, STT_>(lds, tid);
    RW_RELANE(); S1_MARK(14);
    if (tid == 0) qraw = __hip_atomic_fetch_add(qctr, 1u, __ATOMIC_RELAXED, __HIP_MEMORY_SCOPE_AGENT);
    {
        f32x4 ph[2], ah[2];
#pragma unroll
        for (int t2 = 0; t2 < 2; ++t2) ph[t2] = ah[t2] = (f32x4){0.f, 0.f, 0.f, 0.f};
#pragma unroll
        for (int ks = 0; ks < 2; ++ks) { const bf16x8_t aT = lfrag(lds, ST_, 144, 16 * mt, 32 * ks, lane);
#pragma unroll
            for (int t2 = 0; t2 < 2; ++t2) { ph[t2] = MMA16(aT, lfragTr(lds, SP_, 144, 32 * ks, 16 * (ntb + t2), lane), ph[t2]); ah[t2] = MMA16(aT, lfrag(lds, SAT_, 144, 16 * (ntb + t2), 32 * ks, lane), ah[t2]); } }
#pragma unroll
        for (int t2 = 0; t2 < 2; ++t2) { st_tr(lds, SPH_, 144, 16 * mt, 16 * (ntb + t2), ph[t2], lane); st_tr(lds, SAH_, 144, 16 * mt, 16 * (ntb + t2), ah[t2], lane); }
    }
    lds_barrier(); RW_RELANE(); S1_MARK(15);
    {
        f32x4 rh[2], zz[2], kh[2];
#pragma unroll
        for (int t2 = 0; t2 < 2; ++t2) { zz[t2] = kh[t2] = (f32x4){0.f, 0.f, 0.f, 0.f};
            const u32x2_t rw = *(LAS const u32x2_t*)(lds + SR_ + (16 * mt + l16) * 144 + (16 * (ntb + t2) + 4 * q4) * 2);
            rh[t2] = (f32x4){bflo(rw.x), bfhi(rw.x), bflo(rw.y), bfhi(rw.y)}; }
#pragma unroll
        for (int ks = 0; ks < 2; ++ks) { const bf16x8_t aB = lfrag(lds, SNB_, 144, 16 * mt, 32 * ks, lane), aPh = lfrag(lds, SPH_, 144, 16 * mt, 32 * ks, lane), aAh = lfrag(lds, SAH_, 144, 16 * mt, 32 * ks, lane);
#pragma unroll
            for (int t2 = 0; t2 < 2; ++t2) { const bf16x8_t bPh = lfrag(lds, SPH_, 144, 16 * (ntb + t2), 32 * ks, lane), bAh = lfrag(lds, SAH_, 144, 16 * (ntb + t2), 32 * ks, lane), bQt = lfragTr(lds, SQ_, 144, 32 * ks, 16 * (ntb + t2), lane);
                rh[t2] = MMA16(bPh, aB, rh[t2]); krm[t2] = MMA16(bAh, aB, krm[t2]); zz[t2] = MMA16(aPh, bQt, zz[t2]); kh[t2] = MMA16(aAh, bQt, kh[t2]); } }
#pragma unroll
        for (int t2 = 0; t2 < 2; ++t2) { const int n = 16 * (ntb + t2) + l16; const float dc = DCv[n];
#pragma unroll
            for (int r = 0; r < 4; ++r) { const int m = 16 * mt + 4 * q4 + r; zz[t2][r] = ((m == n ? 1.f : 0.f) - zz[t2][r]) * dc;
                kh[t2][r] = (bf2f(*(LAS const bf16_t*)(lds + SK_ + m * 144 + n * 2)) - kh[t2][r]) * dc; }
            st_tr(lds, SR_, 144, 16 * (ntb + t2), 16 * mt, rh[t2], lane); st_tr(lds, SL_, 144, 16 * (ntb + t2), 16 * mt, krm[t2], lane);
            st_tr(lds, SPT_, 144, 16 * mt, 16 * (ntb + t2), zz[t2], lane); st_tr(lds, SQT_, 144, 16 * mt, 16 * (ntb + t2), kh[t2], lane); }
    }
    lds_barrier(); RW_RELANE(); S1_MARK(16);
    {
        const int row = tid >> 3, c16 = tid & 7; bf16_t* ob = p.RWC() + (size_t)unit * 5 * 4096 + row * 64 + c16 * 8;
        *(u32x4_t*)(ob) = *(LAS const u32x4_t*)(lds + SR_ + row * 144 + c16 * 16);
        *(u32x4_t*)(ob + 4096) = *(LAS const u32x4_t*)(lds + SL_ + row * 144 + c16 * 16);
        *(u32x4_t*)(ob + 2 * 4096) = *(LAS const u32x4_t*)(lds + SPT_ + row * 144 + c16 * 16);
        *(u32x4_t*)(ob + 3 * 4096) = *(LAS const u32x4_t*)(lds + SQT_ + row * 144 + c16 * 16);
    }
    lds_barrier(); S1_MARK(17);
#undef RW_RELANE
#undef S1_MARK
}
constexpr int S2_M = 0  , S2_S = 46080, S2_HALF = 55296;
__device__ __forceinline__ void rwkv_stage2(const P& p, int pair, bf16_t* YAout, LAS unsigned char* lds0, int tid) {
    const int wave = __builtin_amdgcn_readfirstlane(tid >> 6), half = wave >> 2, w4 = wave & 3; int lane = tid & 63, q4 = lane >> 4, l16 = lane & 15;
    const int chain = 2 * pair + half; const int h = chain % A_H, b = (chain / A_H) % BATCH, dir = chain / (A_H * BATCH);
    LAS unsigned char* lds = lds0 + half * S2_HALF; int t2 = tid & 255;
    for (int i = t2; i < 9216 / 16; i += 256) *(LAS u32x4_t*)(lds + S2_S + 16 * i) = (u32x4_t){0u, 0u, 0u, 0u};
    u32x4_t pre[10];
#define S2_LOADS(cc) do { const bf16_t* ib = p.RWC() + ((size_t)chain * RW_NCH + (cc)) * 5 * 4096; \
        _Pragma("unroll") for (int u = 0; u < 8; ++u) pre[u] = *(const u32x4_t*)(ib + (size_t)(t2 + 256 * u) * 8); \
        const int r0_ = scan_row(dir, b, 64 * (cc)), sg_ = dir ? -1 : 1; \
        _Pragma("unroll") for (int u = 0; u < 2; ++u) { const int piece = t2 + 256 * u; pre[8 + u] = *(const u32x4_t*)(p.RW_V() + (size_t)(r0_ + sg_ * (piece >> 3)) * A_W + h * 64 + (piece & 7) * 8); } } while (0)
    S2_LOADS(0);
#pragma unroll 1
    for (int c = 0; c < RW_NCH; ++c) {
        asm volatile("" : "+v"(tid)); lane = tid & 63; q4 = lane >> 4; l16 = lane & 15; t2 = tid & 255;
#pragma unroll
        for (int u = 0; u < 10; ++u) { const int piece = t2 + 256 * u, mat = piece >> 9, within = piece & 511; *(LAS u32x4_t*)(lds + S2_M + mat * 9216 + (within >> 3) * 144 + (within & 7) * 16) = pre[u]; }
        if (c + 1 < RW_NCH) S2_LOADS(c + 1);
        lds_barrier();
        f32x4 y[4], sn[4];
#pragma unroll
        for (int nt = 0; nt < 4; ++nt) y[nt] = sn[nt] = (f32x4){0.f, 0.f, 0.f, 0.f};
#pragma unroll
        for (int ks = 0; ks < 2; ++ks) {
            const bf16x8_t aR = lfrag(lds, S2_M, 144, 16 * w4, 32 * ks, lane), aM = lfrag(lds, S2_M + 9216, 144, 16 * w4, 32 * ks, lane);
            const bf16x8_t aS = lfrag(lds, S2_S, 144, 16 * w4, 32 * ks, lane), aV = lfragTr(lds, S2_M + 4 * 9216, 144, 32 * ks, 16 * w4, lane);
#pragma unroll
            for (int nt = 0; nt < 4; ++nt) { const int n0 = 16 * nt;
                y[nt] = MMA16(lfrag(lds, S2_S, 144, n0, 32 * ks, lane), aR, y[nt]); y[nt] = MMA16(lfragTr(lds, S2_M + 4 * 9216, 144, 32 * ks, n0, lane), aM, y[nt]);
                sn[nt] = MMA16(lfrag(lds, S2_M + 2 * 9216, 144, n0, 32 * ks, lane), aS, sn[nt]); sn[nt] = MMA16(lfrag(lds, S2_M + 3 * 9216, 144, n0, 32 * ks, lane), aV, sn[nt]); } }
        const int row0 = scan_row(dir, b, 64 * c), sgn = dir ? -1 : 1;
#pragma unroll
        for (int nt = 0; nt < 4; ++nt) { const int t = 16 * w4 + l16; u32x2_t w; w.x = pg8::cvt_pk_bf16(y[nt][0], y[nt][1]); w.y = pg8::cvt_pk_bf16(y[nt][2], y[nt][3]);
            *(u32x2_t*)(YAout + (unsigned)((dir * NTOK + row0 + sgn * t) * A_W + h * 64 + 16 * nt + 4 * q4)) = w; }
        lds_barrier();
#pragma unroll
        for (int nt = 0; nt < 4; ++nt) st_tr(lds, S2_S, 144, 16 * nt, 16 * w4, sn[nt], lane);
        lds_barrier();
    }
#undef S2_LOADS
}

constexpr int AT_K = 0  , AT_V = 18432  , ATT_NLAT = BATCH * 4 * (SEQ / 256), ATT_NCTX = BATCH * 4 * (CTXL / 256);
__device__ __forceinline__ void attn_unit(const P& p, int unit, LAS unsigned char* lds, int tid) {
    const int wave = __builtin_amdgcn_readfirstlane(tid >> 6); int lane = tid & 63, q4 = lane >> 4, l16 = lane & 15;
    int b, hq, qrow0, nt; bool lat;
    if (unit < ATT_NLAT) { lat = true; b = unit / (4 * (SEQ / 256)); hq = (unit / (SEQ / 256)) % 4; qrow0 = b * SEQ + 256 * (unit % (SEQ / 256)); nt = SLEN / 64; }
    else { const int u2 = unit - ATT_NLAT; lat = false; b = u2 / (4 * (CTXL / 256)); hq = (u2 / (CTXL / 256)) % 4; qrow0 = NLAT + b * CTXL + 256 * (u2 % (CTXL / 256)); nt = CTXL / 64; }
    const int kvh = hq >> 1; qrow0 += 32 * wave;
    bf16x8_t qf[2][2];
#pragma unroll
    for (int qt = 0; qt < 2; ++qt)
#pragma unroll
        for (int ks = 0; ks < 2; ++ks) qf[qt][ks] = *(const bf16x8_t*)(p.CQ() + (size_t)(qrow0 + 16 * qt + l16) * 256 + hq * 64 + 32 * ks + 8 * q4);
    f32x4 o[2][4]; float mrun[2], lrun[2];
#pragma unroll
    for (int qt = 0; qt < 2; ++qt) { mrun[qt] = 0.f; lrun[qt] = 0.f;
#pragma unroll
        for (int dt = 0; dt < 4; ++dt) o[qt][dt] = (f32x4){0.f, 0.f, 0.f, 0.f}; }
    u32x4_t pk, pv;
#define AT_ROWBASE(t) ((lat && (t) < SEQ / 64) ? b * SEQ + 64 * (t) : NLAT + b * CTXL + 64 * ((t) - (lat ? SEQ / 64 : 0)))
#define AT_LOAD(t) do { const size_t ro = (size_t)(AT_ROWBASE(t) + (tid >> 3)) * 128 + kvh * 64 + (tid & 7) * 8; pk = *(const u32x4_t*)(p.CK() + ro); \
        pv = *(const u32x4_t*)(p.CV() + ((size_t)(b * 2 + kvh) * 64 + (tid >> 3)) * SLEN + (lat ? 0 : SEQ) + 64 * (t) + (tid & 7) * 8); } while (0)
#define AT_STORE(buf) do { const int rw = tid >> 3, c16 = tid & 7; *(LAS u32x4_t*)(lds + AT_K + (buf) * 9216 + rw * 144 + c16 * 16) = pk; *(LAS u32x4_t*)(lds + AT_V + (buf) * 9216 + rw * 144 + c16 * 16) = pv; } while (0)
    AT_LOAD(0); AT_STORE(0);
    lds_barrier();
#pragma unroll 1
    for (int t = 0; t < nt; ++t) {
        asm volatile("" : "+v"(tid)); lane = tid & 63; q4 = lane >> 4; l16 = lane & 15;
        const int buf = t & 1;
        if (t + 1 < nt) AT_LOAD(t + 1);
        f32x4 s[2][4];
#pragma unroll
        for (int qt = 0; qt < 2; ++qt)
#pragma unroll
            for (int kt = 0; kt < 4; ++kt) s[qt][kt] = (f32x4){-mrun[qt], -mrun[qt], -mrun[qt], -mrun[qt]};
#pragma unroll
        for (int ks = 0; ks < 2; ++ks)
#pragma unroll
            for (int kt = 0; kt < 4; ++kt) { const bf16x8_t ak = lfrag(lds, AT_K + buf * 9216, 144, 16 * kt, 32 * ks, lane);
                s[0][kt] = MMA16(ak, qf[0][ks], s[0][kt]); s[1][kt] = MMA16(ak, qf[1][ks], s[1][kt]); }
        bf16x8_t pb[2][2];
#pragma unroll
        for (int qt = 0; qt < 2; ++qt) {
            float mx = s[qt][0][0];
#pragma unroll
            for (int kt = 0; kt < 4; ++kt)
#pragma unroll
                for (int r = 0; r < 4; ++r) mx = fmaxf(mx, s[qt][kt][r]);
            mx = fmaxf(mx, __shfl_xor(mx, 16)); mx = fmaxf(mx, __shfl_xor(mx, 32));
            if (__any(mx > 6.0f) || t == 0) { const float dl = (t == 0) ? mx : fmaxf(mx, 0.f), alpha = __builtin_amdgcn_exp2f(-dl); mrun[qt] += dl; lrun[qt] *= alpha;
#pragma unroll
                for (int kt = 0; kt < 4; ++kt) s[qt][kt] = s[qt][kt] - dl;
#pragma unroll
                for (int dt = 0; dt < 4; ++dt) o[qt][dt] = o[qt][dt] * alpha; }
            float ps = 0.f;
#pragma unroll
            for (int kt = 0; kt < 4; ++kt)
#pragma unroll
                for (int r = 0; r < 4; ++r) { const float e = __builtin_amdgcn_exp2f(s[qt][kt][r]); s[qt][kt][r] = e; ps += e; }
            lrun[qt] += ps;
#pragma unroll
            for (int k2 = 0; k2 < 2; ++k2) { u32x4_t w; w.x = pg8::cvt_pk_bf16(s[qt][2 * k2][0], s[qt][2 * k2][1]); w.y = pg8::cvt_pk_bf16(s[qt][2 * k2][2], s[qt][2 * k2][3]);
                w.z = pg8::cvt_pk_bf16(s[qt][2 * k2 + 1][0], s[qt][2 * k2 + 1][1]); w.w = pg8::cvt_pk_bf16(s[qt][2 * k2 + 1][2], s[qt][2 * k2 + 1][3]); pb[qt][k2] = __builtin_bit_cast(bf16x8_t, w); }
        }
#pragma unroll
        for (int k2 = 0; k2 < 2; ++k2)
#pragma unroll
            for (int dt = 0; dt < 4; ++dt) { LAS const unsigned char* vp = lds + AT_V + buf * 9216 + (16 * dt + l16) * 144 + (32 * k2 + 4 * q4) * 2;
                const u32x2_t lo = *(LAS const u32x2_t*)vp, hi = *(LAS const u32x2_t*)(vp + 32); u32x4_t w; w.x = lo.x; w.y = lo.y; w.z = hi.x; w.w = hi.y; const bf16x8_t av = __builtin_bit_cast(bf16x8_t, w);
                o[0][dt] = MMA16(av, pb[0][k2], o[0][dt]); o[1][dt] = MMA16(av, pb[1][k2], o[1][dt]); }
        if (t + 1 < nt) AT_STORE(buf ^ 1);
        lds_barrier();
    }
#pragma unroll
    for (int qt = 0; qt < 2; ++qt) { float l = lrun[qt]; l += __shfl_xor(l, 16); l += __shfl_xor(l, 32); const float inv = 1.0f / l;
        bf16_t* orow = p.MIX() + (size_t)(qrow0 + 16 * qt + l16) * D + 768 + hq * 64 + 4 * q4;
#pragma unroll
        for (int dt = 0; dt < 4; ++dt) { u32x2_t w; w.x = pg8::cvt_pk_bf16(o[qt][dt][0] * inv, o[qt][dt][1] * inv); w.y = pg8::cvt_pk_bf16(o[qt][dt][2] * inv, o[qt][dt][3] * inv); *(u32x2_t*)(orow + 16 * dt) = w; } }
#undef AT_ROWBASE
#undef AT_LOAD
#undef AT_STORE
}


__device__ __forceinline__ void wave_rows(int nrows, int nblk, int blk, int wave, int& r0, int& r1) {
    const int nw = nblk * NWAVES, per = (nrows + nw - 1) / nw, gwl = blk * NWAVES + wave; r0 = gwl * per; r1 = r0 + per; if (r1 > nrows) r1 = nrows; if (r0 > nrows) r0 = nrows;
}
__device__ __forceinline__ float sigm(float x) { return __builtin_amdgcn_rcpf(1.0f + __expf(-x)); }
struct P0Cv { u32x4_t cv[5]; };
struct P0Sm { u32x4_t lr[3]; u32x2_t aq, ak, av; float ga, gb; };
__device__ __forceinline__ void prep0_load_cv(const P& p, int m, int which, int lane, P0Cv& in) {
    int b, t, len, base; row_info(m, b, t, len, base);
#pragma unroll
    for (int j = 0; j < 5; ++j) { const int tt = t + j - 2; in.cv[j] = (tt >= 0 && tt < len) ? *(const u32x4_t*)(p.U() + (size_t)(base + tt) * INP + B_OFF + which * B_W + 8 * lane) : (u32x4_t){0u, 0u, 0u, 0u}; }
}
__device__ __forceinline__ void prep0_compute_cv(const P& p, int l, int m, int which, int lane, const P0Cv& in, const f32x4_t (&cwr)[5][2]) {
    float acc[8];
#pragma unroll
    for (int c = 0; c < 8; ++c) acc[c] = 0.f;
#pragma unroll
    for (int j = 0; j < 5; ++j) { const u32x4_t uv = in.cv[j];
        const f32x4_t w0 = cwr[j][0], w1 = cwr[j][1];
        acc[0] += bflo(uv.x) * w0.x; acc[1] += bfhi(uv.x) * w0.y; acc[2] += bflo(uv.y) * w0.z; acc[3] += bfhi(uv.y) * w0.w;
        acc[4] += bflo(uv.z) * w1.x; acc[5] += bfhi(uv.z) * w1.y; acc[6] += bflo(uv.w) * w1.z; acc[7] += bfhi(uv.w) * w1.w; }
    float ss = 0.f;
#pragma unroll
    for (int c = 0; c < 8; ++c) { acc[c] = acc[c] * sigm(acc[c]); ss += acc[c] * acc[c]; }
    float rn = 1.0f;
    if (which < 2) rn = (frsq(grp16_sum(ss) + 1e-6f)) * (which == 0 ? 0.08838834764831845f : 1.0f);
    u32x4_t w; w.x = pg8::cvt_pk_bf16(acc[0] * rn, acc[1] * rn); w.y = pg8::cvt_pk_bf16(acc[2] * rn, acc[3] * rn); w.z = pg8::cvt_pk_bf16(acc[4] * rn, acc[5] * rn); w.w = pg8::cvt_pk_bf16(acc[6] * rn, acc[7] * rn);
    *(u32x4_t*)((which == 0 ? p.GQ() : which == 1 ? p.GK() : p.GV()) + (size_t)m * B_W + 8 * lane) = w;
}
__device__ __forceinline__ void prep0_load_sm(const P& p, int m, int lane, P0Sm& in) {
    int b, t, len, base; row_info(m, b, t, len, base);
    const bf16_t* ur = p.U() + (size_t)m * INP; const bool hp = t > 0, hn = t + 1 < len;
    { const int c = 768 + 8 * (lane < 24 ? lane : 23); const u32x4_t z = {0u, 0u, 0u, 0u};
      in.lr[0] = *(const u32x4_t*)(ur + c); in.lr[1] = hp ? *(const u32x4_t*)(ur + c - INP) : z; in.lr[2] = hn ? *(const u32x4_t*)(ur + c + INP) : z; }
    in.aq = *(const u32x2_t*)(ur + C_OFF + 4 * lane); in.ak = *(const u32x2_t*)(ur + C_OFF + 256 + 4 * (lane & 31)); in.av = *(const u32x2_t*)(ur + C_OFF + 384 + 4 * (lane & 31));
    in.ga = bf2f(ur[B_OFF + 2048 + (lane & 7)]); in.gb = bf2f(ur[B_OFF + 2056 + (lane & 7)]);
}
struct P0Par { f32x4_t m0, m1, qn, kn; float dtb, alog; };
__device__ __forceinline__ void prep0_params(const P& p, int l, int lane, P0Par& q) {
    const float* mup = p.rw_mu + l * A_IN + 768 + 8 * (lane < 24 ? lane : 23); q.m0 = *(const f32x4_t*)mup; q.m1 = *(const f32x4_t*)(mup + 4);
    q.qn = *(const f32x4_t*)(p.attn_q_norm + l * 64 + 4 * (lane & 15)); q.kn = *(const f32x4_t*)(p.attn_k_norm + l * 64 + 4 * (lane & 15));
    q.dtb = p.gdn_dt_bias[(l * 2 + ((lane & 7) >> 2)) * B_H + (lane & 3)]; q.alog = p.gdn_a_log[(l * 2 + ((lane & 7) >> 2)) * B_H + (lane & 3)];
}
__device__ __forceinline__ void prep0_compute_sm(const P& p, int l, int m, int lane, const P0Sm& in, const P0Par& par) {
    const int i16 = lane & 15; int b, t, len, base; row_info(m, b, t, len, base);
    if (lane < 32) {
        u32x4_t w = {0u, 0u, 0u, 0u};
        if (lane < 24) {
            const f32x4_t m0 = par.m0, m1 = par.m1;
            float u[8], up[8], un[8], o[8];
#pragma unroll
            for (int j = 0; j < 4; ++j) { u[2 * j] = bflo(in.lr[0][j]); u[2 * j + 1] = bfhi(in.lr[0][j]); up[2 * j] = bflo(in.lr[1][j]); up[2 * j + 1] = bfhi(in.lr[1][j]); un[2 * j] = bflo(in.lr[2][j]); un[2 * j + 1] = bfhi(in.lr[2][j]); }
            const int grp = lane >> 3;
#pragma unroll
            for (int j = 0; j < 8; ++j) { const float mu = j < 4 ? m0[j & 3] : m1[j & 3]; const float v = u[j] + mu * (0.5f * (up[j] + un[j]) - u[j]);
                const float e = __expf(grp == 0 ? 2.0f * v : -v), rc = frcp(1.0f + e); o[j] = grp == 0 ? 1.0f - 2.0f * rc : (grp == 1 ? v : rc); }
            w.x = pg8::cvt_pk_bf16(o[0], o[1]); w.y = pg8::cvt_pk_bf16(o[2], o[3]); w.z = pg8::cvt_pk_bf16(o[4], o[5]); w.w = pg8::cvt_pk_bf16(o[6], o[7]);
        }
        *(u32x4_t*)(p.LRT() + (size_t)m * 256 + 8 * lane) = w;
    }
    if (lane < 8) {
        const float xs = in.ga + par.dtb; const float sp = xs > 20.f ? xs : __logf(1.0f + __expf(xs));
        p.GG()[(size_t)m * 8 + lane] = -__expf(par.alog) * sp; p.GBETA()[(size_t)m * 8 + lane] = sigm(in.gb); }
    {
        const int i = i16; f32x4_t cs = {1.f, 1.f, 1.f, 1.f}, sn = {0.f, 0.f, 0.f, 0.f};
        if (m < NLAT) { cs = *(const f32x4_t*)(p.ROPE() + (size_t)t * 128 + 4 * i); sn = *(const f32x4_t*)(p.ROPE() + (size_t)t * 128 + 64 + 4 * i); }
        const float sgn = (i & 4) ? 1.f : -1.f;
        {
            const f32x4_t x = bf4(in.aq); const float rstd = (frsq(grp16_sum(hsq4(x)) * (1.0f / 64.f) + 1e-6f)) * 0.18033688011112042f;
            const f32x4_t nw = par.qn; f32x4_t y = x * rstd * nw, o;
#pragma unroll
            for (int c = 0; c < 4; ++c) { const float pr = __shfl_xor(y[c], 4); o[c] = y[c] * cs[c] + sgn * pr * sn[c]; }
            *(u32x2_t*)(p.CQ() + (size_t)m * 256 + 4 * lane) = pk4(o);
        }
        {
            const f32x4_t x = bf4(in.ak); const float rstd = frsq(grp16_sum(hsq4(x)) * (1.0f / 64.f) + 1e-6f);
            const f32x4_t nw = par.kn; f32x4_t y = x * rstd * nw, o;
#pragma unroll
            for (int c = 0; c < 4; ++c) { const float pr = __shfl_xor(y[c], 4); o[c] = y[c] * cs[c] + sgn * pr * sn[c]; }
            if (lane < 32) { *(u32x2_t*)(p.CK() + (size_t)m * 128 + 4 * lane) = pk4(o);
                const u32x2_t vv = in.av; const int key = m < NLAT ? t : SEQ + t;
                bf16_t* vt = p.CV() + ((size_t)(b * 2 + (lane >> 4)) * 64 + 4 * (lane & 15)) * SLEN + key;
                vt[0] = (bf16_t)(vv.x & 0xffffu); vt[SLEN] = (bf16_t)(vv.x >> 16); vt[2 * SLEN] = (bf16_t)(vv.y & 0xffffu); vt[3 * SLEN] = (bf16_t)(vv.y >> 16); }
        }
    }
}
__device__ __forceinline__ u32x4_t prep0_row(const P& p, int row, int which, int lane) {
    return (row >= 0 && row < NTOK) ? *(const u32x4_t*)(p.U() + (size_t)row * INP + B_OFF + which * B_W + 8 * lane) : (u32x4_t){0u, 0u, 0u, 0u};
}
__device__ __forceinline__ void dev_prep0(const P& p, int l, int G, int wave, int lane) {
    const int per = (NTOK + G - 1) / G, t0 = (int)blockIdx.x * per, t1 = (t0 + per < NTOK) ? t0 + per : NTOK;
#ifdef PT_P0
    const unsigned long long tp0_ = __builtin_amdgcn_s_memrealtime();
#endif
    {
        const int pw = (per + NWAVES - 1) / NWAVES, r0 = t0 + wave * pw, r1 = (r0 + pw < t1) ? r0 + pw : t1;
#pragma unroll 1
        for (int which = 0; which < 3; ++which) {
            if (r0 >= r1) break;
            f32x4_t cwr[5][2];
#pragma unroll
            for (int j = 0; j < 5; ++j) { const float* cw = p.gdn_conv + ((size_t)l * 5 + j) * (3 * B_W) + which * B_W + 8 * lane; cwr[j][0] = *(const f32x4_t*)cw; cwr[j][1] = *(const f32x4_t*)(cw + 4); }
            u32x4_t w0 = prep0_row(p, r0 - 2, which, lane), w1 = prep0_row(p, r0 - 1, which, lane), w2 = prep0_row(p, r0, which, lane), w3 = prep0_row(p, r0 + 1, which, lane);
            u32x4_t n0 = prep0_row(p, r0 + 2, which, lane), n1 = prep0_row(p, r0 + 3, which, lane);
            for (int m = r0; m < r1; m += 2) {
                const u32x4_t w4 = n0, w5 = n1; n0 = prep0_row(p, m + 4, which, lane); n1 = prep0_row(p, m + 5, which, lane);
                {
                    int b, t, len, base; row_info(m, b, t, len, base); P0Cv use; use.cv[0] = w0; use.cv[1] = w1; use.cv[2] = w2; use.cv[3] = w3; use.cv[4] = w4;
#pragma unroll
                    for (int j = 0; j < 5; ++j) { const int tt = t + j - 2; if (tt < 0 || tt >= len) use.cv[j] = (u32x4_t){0u, 0u, 0u, 0u}; }
                    prep0_compute_cv(p, l, m, which, lane, use, cwr);
                }
                if (m + 1 < r1) {
                    int b, t, len, base; row_info(m + 1, b, t, len, base); P0Cv use; use.cv[0] = w1; use.cv[1] = w2; use.cv[2] = w3; use.cv[3] = w4; use.cv[4] = w5;
#pragma unroll
                    for (int j = 0; j < 5; ++j) { const int tt = t + j - 2; if (tt < 0 || tt >= len) use.cv[j] = (u32x4_t){0u, 0u, 0u, 0u}; }
                    prep0_compute_cv(p, l, m + 1, which, lane, use, cwr);
                }
                w0 = w2; w1 = w3; w2 = w4; w3 = w5;
            }
        }
    }
#ifdef PT_P0
    const unsigned long long tp1_ = __builtin_amdgcn_s_memrealtime();
#endif
    const int first = t0 + wave, ntk = first < t1 ? (t1 - first + NWAVES - 1) / NWAVES : 0;
    {
        P0Par par; prep0_params(p, l, lane, par);
        P0Sm cur; if (ntk > 0) prep0_load_sm(p, first, lane, cur);
        for (int i = 0; i < ntk; ++i) { const int m = first + i * NWAVES; P0Sm nxt = cur; if (i + 1 < ntk) prep0_load_sm(p, m + NWAVES, lane, nxt); prep0_compute_sm(p, l, m, lane, cur, par); cur = nxt; }
    }
#ifdef PT_P0
    { const unsigned long long tp2_ = __builtin_amdgcn_s_memrealtime(); const unsigned d_ = PT_P0 == 1 ? (unsigned)(tp1_ - tp0_) : (unsigned)(tp2_ - tp1_); if (lane == 0) atomicMax(p.ctl() + 12070 + l, d_); }
#endif
}
__device__ __forceinline__ void dev_build_rope(const P& p, long gtid, long nthr) {
    for (long e = gtid; e < (long)SEQ * 64; e += nthr) { const int t = (int)(e >> 6), d = (int)(e & 63); const float pos = d < 32 ? (float)(t / GRID_W) : (float)(t % GRID_W);
        const float ang = pos * exp2f(-0.8304820237218406f * (float)(d & 15)); p.ROPE()[(size_t)t * 128 + d] = cosf(ang); p.ROPE()[(size_t)t * 128 + 64 + d] = sinf(ang); }
}
struct A1In { u32x2_t u[3][3]; u32x2_t lro[5]; };
__device__ __forceinline__ void prepA1_load(const P& p, int m, int lane, A1In& in) {
    int b, t, len, base; row_info(m, b, t, len, base);
    const bf16_t* ur = p.U() + (size_t)m * INP; const bool hp = t > 0, hn = t + 1 < len; const u32x2_t z = {0u, 0u};
#pragma unroll
    for (int a = 0; a < 3; ++a) { const int c = 256 * a + 4 * lane; in.u[a][1] = *(const u32x2_t*)(ur + c); in.u[a][0] = hp ? *(const u32x2_t*)(ur + c - INP) : z; in.u[a][2] = hn ? *(const u32x2_t*)(ur + c + INP) : z; }
    const bf16_t* lo = p.LRO() + (size_t)m * 1280 + 4 * lane;
#pragma unroll
    for (int g = 0; g < 5; ++g) in.lro[g] = *(const u32x2_t*)(lo + 256 * g);
}
__device__ __forceinline__ void dev_prepA1(const P& p, int l, int gw, int ngw, int lane) {
    const int h = lane >> 4;
    const f32x4_t kkp = *(const f32x4_t*)(p.rw_k_k + l * A_W + 4 * lane), kap = *(const f32x4_t*)(p.rw_k_a + l * A_W + 4 * lane), rkp = *(const f32x4_t*)(p.rw_r_k + l * A_W + 4 * lane);
    f32x4_t mu3[3], w0p[2], a0p[2];
#pragma unroll
    for (int a = 0; a < 3; ++a) mu3[a] = *(const f32x4_t*)(p.rw_mu + l * A_IN + 256 * a + 4 * lane);
#pragma unroll
    for (int dir = 0; dir < 2; ++dir) { w0p[dir] = *(const f32x4_t*)(p.rw_w0 + (l * 2 + dir) * A_W + 4 * lane); a0p[dir] = *(const f32x4_t*)(p.rw_a0 + (l * 2 + dir) * A_W + 4 * lane); }
    int m = gw; if (m >= NTOK) return;
    A1In cur; prepA1_load(p, m, lane, cur);
    for (; m < NTOK; m += ngw) {
        A1In nxt = cur; if (m + ngw < NTOK) prepA1_load(p, m + ngw, lane, nxt);
        f32x4_t rkv[3];
#pragma unroll
        for (int a = 0; a < 3; ++a) { const f32x4_t u = bf4(cur.u[a][1]); rkv[a] = u + mu3[a] * (0.5f * (bf4(cur.u[a][0]) + bf4(cur.u[a][2])) - u); }
        const f32x4_t r = rkv[0], k = rkv[1], v = rkv[2];
        const f32x4_t kx = k * kkp; const float rn = frsq(grp16_sum(hsq4(kx)) + 1e-6f); const f32x4_t kk = kx * rn;
        f32x4_t kdsum = {0.f, 0.f, 0.f, 0.f};
#pragma unroll
        for (int dir = 0; dir < 2; ++dir) {
            const f32x4_t w = w0p[dir] + bf4(cur.lro[dir]);
            const f32x4_t a = a0p[dir] + bf4(cur.lro[2 + dir]);
            f32x4_t ld, ic;
#pragma unroll
            for (int c = 0; c < 4; ++c) { const float nw = -w[c]; const float sp = nw > 20.f ? nw : __logf(1.0f + __expf(nw)); ld[c] = -__expf(-sp - 0.5f); ic[c] = sigm(a[c]); }
            const f32x4_t kd = k * (1.0f + (ic - 1.0f) * kap); kdsum = kdsum + kd;
            const size_t o = ((size_t)dir * NTOK + m) * A_W + 4 * lane;
            *(f32x4_t*)(p.RW_D() + o) = ld; *(u32x2_t*)(p.RW_KD() + o) = pk4(kd); *(u32x2_t*)(p.RW_KKA() + o) = pk4(kk * ic);
        }
        const size_t o1 = (size_t)m * A_W + 4 * lane;
        *(u32x2_t*)(p.RW_R() + o1) = pk4(r); *(u32x2_t*)(p.RW_V() + o1) = pk4(v); *(u32x2_t*)(p.RW_KK() + o1) = pk4(kk); *(u32x2_t*)(p.RW_GATE() + o1) = cur.lro[4];
        const float bon = grp16_sum(hsum4(r * kdsum * rkp));
        if ((lane & 15) == 0) p.RW_BON()[(size_t)m * A_H + h] = bon;
        cur = nxt;
    }
}
__device__ __forceinline__ void dev_build_wlr(const P& p, int l, long gtid, long nthr) {
    for (long e = gtid; e < 1280L * 256; e += nthr) { const int n = (int)(e >> 8), k = (int)(e & 255), g = n >> 8, ch = n & 255; float v = 0.f;
        if (g < 2) { if ((k >> 5) == g) v = p.rw_w2[((size_t)(l * 2 + g) * 32 + (k & 31)) * A_W + ch]; }
        else if (g < 4) { if ((k >> 5) == g) v = p.rw_a2[((size_t)(l * 2 + (g - 2)) * 32 + (k & 31)) * A_W + ch]; }
        else { if (k >= 128 && k < 192) v = p.rw_g2[((size_t)l * 64 + (k - 128)) * A_W + ch]; }
        p.WLR_T(l)[e] = f2bf(v); }
}

constexpr int RING_BYTES = 131072, MISC_OFF = 147200, LDS_BYTES = 147456;
constexpr size_t MiB = 1u << 20;
constexpr int CW_BAR = 4096, CW_CNT = 8192;

__device__ __forceinline__ void transpose_item(const float* W, int K, int N, bf16_t* WT, LAS float* scr, int item, int lane) {
    const int nblk_k = K / 64; const int nb = item / nblk_k, kb = item % nblk_k, k0 = 64 * kb, n0 = 64 * nb;
    const int nl = 4 * (lane & 15), kq = lane >> 4;
    f32x4 v[16];
#pragma unroll
    for (int i = 0; i < 16; ++i) { const float* src = W + (size_t)(k0 + 4 * i + kq) * N + n0 + nl;
        if (n0 + nl + 3 < N) v[i] = *(const f32x4*)src;
        else { v[i] = (f32x4){0.f, 0.f, 0.f, 0.f}; if (n0 + nl < N) v[i][0] = src[0]; if (n0 + nl + 1 < N) v[i][1] = src[1]; if (n0 + nl + 2 < N) v[i][2] = src[2]; } }
#pragma unroll
    for (int i = 0; i < 16; ++i) { LAS float* d = scr + (4 * i + kq) * 65 + nl; d[0] = v[i][0]; d[1] = v[i][1]; d[2] = v[i][2]; d[3] = v[i][3]; }
    asm volatile("s_waitcnt lgkmcnt(0)" ::: "memory");
    const int c = lane & 7;
#pragma unroll
    for (int j = 0; j < 8; ++j) { const int n = (lane >> 3) + 8 * j; const LAS float* sp = scr + (8 * c) * 65 + n;
        pg8::u32x4 o; o.x = pg8::cvt_pk_bf16(sp[0 * 65], sp[1 * 65]); o.y = pg8::cvt_pk_bf16(sp[2 * 65], sp[3 * 65]); o.z = pg8::cvt_pk_bf16(sp[4 * 65], sp[5 * 65]); o.w = pg8::cvt_pk_bf16(sp[6 * 65], sp[7 * 65]);
        *(pg8::u32x4*)(WT + (size_t)(n0 + n) * K + k0 + 8 * c) = o; }
    asm volatile("s_waitcnt lgkmcnt(0)" ::: "memory");
}

struct Args { P p; int ph_lo, ph_hi; };

#define RUN_TASKS(ntasks, call) do { const long _n = (long)(ntasks); for (long task = gtid; task < _n; task += nthr) { call; } } while (0)


__device__ __forceinline__ void dev_mod(const P& p, int cg, LAS unsigned char* lds, int tid) {
    LAS float* STB = (LAS float*)lds; LAS float* PT = (LAS float*)(lds + 69632);
    const int lane = tid & 63, wave = tid >> 6; const int lyr = cg / 96, j0 = (cg % 96) * 64;
    for (int idx = tid; idx < (BATCH + 1) * D; idx += NTHR) { const int r = idx >> 10, k = idx & 1023; const float v = r < BATCH ? p.c[(size_t)r * D + k] : p.c_ctx[k]; STB[idx] = v / (1.0f + __expf(-v)); }
    __syncthreads();
    float acc[BATCH + 1];
#pragma unroll
    for (int r = 0; r <= BATCH; ++r) acc[r] = 0.f;
    const float* w = p.ada_w + ((size_t)lyr * D + 128 * wave) * 6 * D + j0 + lane;
#pragma unroll 4
    for (int k = 0; k < 128; ++k) { const float wv = w[(size_t)k * 6 * D];
#pragma unroll
        for (int r = 0; r <= BATCH; ++r) acc[r] += STB[r * D + 128 * wave + k] * wv; }
#pragma unroll
    for (int r = 0; r <= BATCH; ++r) PT[(wave * (BATCH + 1) + r) * 64 + lane] = acc[r];
    __syncthreads();
    for (int idx = tid; idx < (BATCH + 1) * 64; idx += NTHR) { const int r = idx >> 6, jj = idx & 63; float sacc = p.ada_b[(size_t)lyr * 6 * D + j0 + jj];
#pragma unroll
        for (int w2 = 0; w2 < 8; ++w2) sacc += PT[(w2 * (BATCH + 1) + r) * 64 + jj];
        p.MOD()[((size_t)lyr * (BATCH + 1) + r) * 6 * D + j0 + jj] = sacc; }
    __syncthreads();
}
constexpr int CV_I_IN = (D / 64) * (INP / 64), CV_I_OUT = (D / 64) * (D / 64), CV_I_R = (D / 64), CV_I_GU = (D / 64) * (2 * DEXP / 64), CV_I_DN = (DEXP / 64) * (D / 64);
constexpr int CV_SMALL = CV_I_IN + CV_I_OUT + CV_I_R, CV_TOTAL = CV_SMALL + NEXP * (CV_I_GU + CV_I_DN), CV_CHUNK = 8;
constexpr int CV_NCH_SMALL = (CV_SMALL + CV_CHUNK - 1) / CV_CHUNK, CV_NCH_MOE = (CV_TOTAL - CV_SMALL + CV_CHUNK - 1) / CV_CHUNK;
__device__ __forceinline__ void conv_chunk(const P& p, int l, bool moe, int chunk, LAS unsigned char* ldsp, int wave, int lane) {
    LAS float* scr = (LAS float*)(ldsp + wave * 16896);
    for (int i = 0; i < CV_CHUNK / NWAVES; ++i) {
        int r = chunk * CV_CHUNK + wave + NWAVES * i; if (moe) { r += CV_SMALL; if (r >= CV_TOTAL) break; } else if (r >= CV_SMALL) break;
        if (r < CV_I_IN) { transpose_item(p.w_in + (size_t)l * D * INW, D, INW, p.WIN_T(l), scr, r, lane); continue; } r -= CV_I_IN;
        if (r < CV_I_OUT) { transpose_item(p.w_out + (size_t)l * D * D, D, D, p.WOUT_T(l), scr, r, lane); continue; } r -= CV_I_OUT;
        if (r < CV_I_R) { transpose_item(p.router_w + (size_t)l * D * NEXP, D, NEXP, p.WR_T(l), scr, r, lane); continue; } r -= CV_I_R;
        if (r < NEXP * CV_I_GU) { const int e = r / CV_I_GU; transpose_item(p.exp_w_gu + ((size_t)l * NEXP + e) * D * 2 * DEXP, D, 2 * DEXP, p.WGU_T(l) + (size_t)e * 2 * DEXP * D, scr, r % CV_I_GU, lane); continue; } r -= NEXP * CV_I_GU;
        { const int e = r / CV_I_DN; transpose_item(p.exp_w_dn + ((size_t)l * NEXP + e) * DEXP * D, DEXP, D, p.WDN_T(l) + (size_t)e * D * DEXP, scr, r % CV_I_DN, lane); }
    }
}

__device__ __forceinline__ int q_next(unsigned* ctr, volatile LAS unsigned* slot, int tid) {
    if (tid == 0) *slot = __hip_atomic_fetch_add(ctr, 1u, __ATOMIC_RELAXED, __HIP_MEMORY_SCOPE_AGENT);
    __syncthreads(); const int v = (int)*slot; __syncthreads(); return v;
}

__device__ __forceinline__ int q_filler(unsigned* cctr, unsigned* dctr, unsigned nitems, volatile LAS unsigned* slot, int tid) {
    if (tid == 0) { const unsigned d = __hip_atomic_load(dctr, __ATOMIC_RELAXED, __HIP_MEMORY_SCOPE_AGENT); *slot = d >= nitems ? 0x7fffffffu : __hip_atomic_fetch_add(cctr, 1u, __ATOMIC_RELAXED, __HIP_MEMORY_SCOPE_AGENT); }
    __syncthreads(); const int v = (int)*slot; __syncthreads(); return v;
}

#ifndef DBG_PH
#define DBG_PH -1
#endif
#define PHON(j) (DBG_PH < 0 || DBG_PH == (j))
#define IN(k) (lo <= (k) && (k) < hi)
#define TID_NOW() (wave_s * 64 + (int)__builtin_amdgcn_mbcnt_hi(~0u, __builtin_amdgcn_mbcnt_lo(~0u, 0u)))
#define PHASE_VARS P p = args.p; asm volatile("" : "+s"(p.ws)); int tid_ = TID_NOW(); asm volatile("" : "+v"(tid_)); const int lane = tid_ & 63, wave = __builtin_amdgcn_readfirstlane(tid_ >> 6); \
    const long gtid = ((long)wave * G + blockIdx.x) * 64 + lane, nthr = (long)G * NTHR; const int gw = wave * G + blockIdx.x, ngw = G * NWAVES; (void)gw; (void)ngw; (void)gtid; (void)nthr; (void)lane;
#ifdef PROBE_T
#define SEAM(k) do { if (IN((k) + 1)) xcd_barrier(bar, TID_NOW()); if (blockIdx.x == 0 && TID_NOW() == 0) ((unsigned long long*)(args.p.ctl() + 12100))[(k) + 1] = __builtin_amdgcn_s_memrealtime(); } while (0)
#else
#define SEAM(k) do { if (IN((k) + 1)) xcd_barrier(bar, TID_NOW()); } while (0)
#endif
template <int l>
__device__ __forceinline__ void layer_body(const Args& args, const XcdBarrier& bar, LAS unsigned char* ldsp, const int G, const int wave_s, const int lo, const int hi) {
        const int pb = 1 + l * NPH;
        const bool need_ctx = l < DEPTH - 1;
        const int ntok_l = need_ctx ? NTOK : NLAT;
        if (l == 0 && PHON(0) && IN(pb + 0)) { PHASE_VARS;
            dev_norm1_l0(p, G, wave, lane);
            SEAM(pb + 0);
        }
        if (PHON(1) && IN(pb + 1)) { PHASE_VARS; (void)tid_; (void)wave;
            pg8::Gemm g{p.HB(), p.WIN_T(l), D, 0, nullptr}; pg8::StaticOrder S; S.init(NTOK, INP, G, (int)blockIdx.x);
            pg8::EpiBf16Bias E{p.U(), INP, nullptr, 0};
            pg8::gemm_phase(ldsp, g, S, E, tid_);
            SEAM(pb + 1);
        }
        if (PHON(2) && IN(pb + 2)) { PHASE_VARS; dev_prep0(p, l, G, wave, lane); SEAM(pb + 2); }
        if (PHON(3) && IN(pb + 3)) { PHASE_VARS; (void)tid_; (void)wave;
            pg8::Gemm g{p.LRT(), p.WLR_T(l), 256, 0, nullptr}; pg8::StaticOrder S; S.init(NTOK, 1280, G, (int)blockIdx.x);
            pg8::EpiBf16Bias E{p.LRO(), 1280, nullptr, 0};
            pg8::gemm_phase(ldsp, g, S, E, tid_);
            SEAM(pb + 3);
        }
        if (PHON(4) && IN(pb + 4)) { PHASE_VARS; dev_prepA1(p, l, gw, ngw, lane); SEAM(pb + 4); }
        if (PHON(5) && IN(pb + 5)) { PHASE_VARS;
            const int nchain = 2 * BATCH * B_H, nitems = nchain + RW_UNITS;
            unsigned* ctr = p.ctl() + 12200 + 64 * (2 * l); volatile LAS unsigned* slot = (volatile LAS unsigned*)(ldsp + MISC_OFF + 64);
#ifdef PROBE_GDN
            { const long nB = 2L * BATCH * B_H * 128; for (long task = gtid; task < nB; task += nthr) task_scanB(p, task); }
#endif
            unsigned long long tacc_ = 0ull, t0_ = 0ull; (void)tacc_; (void)t0_;
#ifdef PT_ACT
#define ACT_BEGIN(a) do { if (PT_ACT == (a)) t0_ = __builtin_amdgcn_s_memrealtime(); } while (0)
#define ACT_END(a) do { if (PT_ACT == (a)) tacc_ += __builtin_amdgcn_s_memrealtime() - t0_; } while (0)
#define ACT_FLUSH() do { if (tid_ == 0) atomicMax(p.ctl() + 12070 + l, (unsigned)tacc_); } while (0)
#else
#define ACT_BEGIN(a)
#define ACT_END(a)
#define ACT_FLUSH()
#endif
            int cur = q_next(ctr, slot, tid_);
            while (cur < nchain) {
                ACT_BEGIN(1); gdn_chain(p.GQ(), p.GK(), p.GV(), p.GG(), p.GBETA(), cur, p.OB(), ldsp, tid_, p.ctl()); ACT_END(1);
                if (tid_ == 0) __hip_atomic_fetch_add(ctr + 32, 1u, __ATOMIC_RELAXED, __HIP_MEMORY_SCOPE_AGENT);
                cur = q_next(ctr, slot, tid_); }
            if (cur < nitems) {
                S1In in; rwkv_stage1_load(p, cur - nchain, tid_, in);
                int nxt = q_next(ctr, slot, tid_);
                while (cur < nitems) {
#if defined(PT_SEC) && PT_SEC == 18
                    if (tid_ == 0) { const unsigned long long n_ = __builtin_amdgcn_s_memrealtime(); if (t0_) atomicAdd(p.ctl() + 12080, (unsigned)(n_ - t0_)); t0_ = n_; }
#endif
                    S1In in2; const bool have2 = nxt < nitems;
                    if (have2) rwkv_stage1_load(p, nxt - nchain, tid_, in2); else in2 = in;
                    unsigned qraw = 0u;
                    ACT_BEGIN(2); rwkv_stage1(p, cur - nchain, in, ldsp, tid_, ctr, qraw); ACT_END(2);
                    if (tid_ == 0) { __hip_atomic_fetch_add(ctr + 32, 1u, __ATOMIC_RELAXED, __HIP_MEMORY_SCOPE_AGENT); *slot = qraw; }
                    lds_barrier();
                    const int nn = (int)*slot;
                    in = in2; cur = nxt; nxt = nn;
                }
                __syncthreads();
            }
            ACT_FLUSH();
            {
                unsigned* cctr = p.ctl() + 12200 + 64 * (8 + 2 * l);
                for (int ch = q_filler(cctr, ctr + 32, (unsigned)nitems, slot, tid_); ch < CV_NCH_MOE + (l + 1 < DEPTH ? CV_NCH_SMALL : 0); ch = q_filler(cctr, ctr + 32, (unsigned)nitems, slot, tid_)) {
                    if (ch < CV_NCH_MOE) conv_chunk(p, l, true, ch, ldsp, wave, lane); else conv_chunk(p, l + 1, false, ch - CV_NCH_MOE, ldsp, wave, lane); } }
            SEAM(pb + 5);
        }
        if (PHON(6) && IN(pb + 6)) { PHASE_VARS;
            const int ngb = 0, nch = ngb + BATCH * A_H, nun = ATT_NLAT + (need_ctx ? ATT_NCTX : 0);
            unsigned* ctr = p.ctl() + 12200 + 64 * (2 * l + 1); volatile LAS unsigned* slot = (volatile LAS unsigned*)(ldsp + MISC_OFF + 64);
#ifdef PROBE_RWKV
            { const long nA = 2L * BATCH * A_H * 64; for (long task = gtid; task < nA; task += nthr) task_scanA(p, task); }
#endif
            unsigned long long tacc_ = 0ull, t0_ = 0ull; (void)tacc_; (void)t0_;
            for (int cur = q_next(ctr, slot, tid_); cur < nch + nun; cur = q_next(ctr, slot, tid_)) {
                if (cur < nch) { ACT_BEGIN(3); rwkv_stage2(p, cur - ngb,
#ifdef PROBE_RWKV
                    (bf16_t*)(p.ws + WS_TOTAL),
#else
                    p.YA(),
#endif
                    ldsp, tid_); ACT_END(3); }
                else { ACT_BEGIN(4); attn_unit(p, cur - nch, ldsp, tid_); ACT_END(4); }
                if (tid_ == 0) __hip_atomic_fetch_add(ctr + 32, 1u, __ATOMIC_RELAXED, __HIP_MEMORY_SCOPE_AGENT);
            }
            ACT_FLUSH();
            {
                unsigned* cctr = p.ctl() + 12200 + 64 * (8 + 2 * l);
                for (int ch = q_filler(cctr, ctr + 32, (unsigned)(nch + nun), slot, tid_); ch < CV_NCH_MOE + (l + 1 < DEPTH ? CV_NCH_SMALL : 0); ch = q_filler(cctr, ctr + 32, (unsigned)(nch + nun), slot, tid_)) {
                    if (ch < CV_NCH_MOE) conv_chunk(p, l, true, ch, ldsp, wave, lane); else conv_chunk(p, l + 1, false, ch - CV_NCH_MOE, ldsp, wave, lane); } }
            SEAM(pb + 6);
        }
        if (PHON(7) && IN(pb + 7)) { PHASE_VARS;
#ifdef PROBE_GDN
            { float e2 = 0.f, r2 = 0.f; const bf16_t* cand = (const bf16_t*)(p.ws + WS_TOTAL); const bf16_t* ref = p.OB();
              for (long i = gtid; i < 2L * NTOK * B_W; i += nthr) { const float d = bf2f(cand[i]) - bf2f(ref[i]); e2 += d * d; r2 += bf2f(ref[i]) * bf2f(ref[i]); }
              e2 = wave_sum(e2); r2 = wave_sum(r2); if (lane == 0) { atomicAdd((float*)(p.ctl() + 12000), e2); atomicAdd((float*)(p.ctl() + 12001), r2); } }
#endif
#ifdef PROBE_RWKV
            { float e2 = 0.f, r2 = 0.f; const bf16_t* cand = (const bf16_t*)(p.ws + WS_TOTAL); const bf16_t* ref = p.YA();
              for (long i = gtid; i < 2L * NTOK * A_W; i += nthr) { const float d = bf2f(cand[i]) - bf2f(ref[i]); e2 += d * d; r2 += bf2f(ref[i]) * bf2f(ref[i]); }
              e2 = wave_sum(e2); r2 = wave_sum(r2); if (lane == 0) { atomicAdd((float*)(p.ctl() + 12000), e2); atomicAdd((float*)(p.ctl() + 12001), r2); } }
#endif
            dev_post(p, l, ntok_l, gw, ngw, lane); SEAM(pb + 7); }
        if (PHON(8) && IN(pb + 8)) { PHASE_VARS; (void)tid_; (void)wave;
            pg8::Gemm g{p.MIX(), p.WOUT_T(l), D, 0, nullptr}; pg8::StaticOrder S; S.init(ntok_l, D, G, (int)blockIdx.x);
            pg8::EpiBf16Bias E{p.MO(), D, nullptr, 0};
            pg8::gemm_phase(ldsp, g, S, E, tid_);
            SEAM(pb + 8);
        }
        if (PHON(9) && IN(pb + 9)) { PHASE_VARS; dev_resid_router(p, l, ntok_l, ldsp, G, tid_); SEAM(pb + 9); }
        if (PHON(10) && IN(pb + 10)) { PHASE_VARS; dev_slots(p, l, ntok_l, ldsp, gtid, nthr, tid_);
            {
                unsigned* cctr = p.ctl() + 12200 + 64 * (8 + 2 * l); volatile LAS unsigned* slot = (volatile LAS unsigned*)(ldsp + MISC_OFF + 64);
                for (int ch = q_next(cctr, slot, tid_); ch < CV_NCH_MOE + (l + 1 < DEPTH ? CV_NCH_SMALL : 0); ch = q_next(cctr, slot, tid_)) {
                    if (ch < CV_NCH_MOE) conv_chunk(p, l, true, ch, ldsp, wave, lane); else conv_chunk(p, l + 1, false, ch - CV_NCH_MOE, ldsp, wave, lane); } }
            SEAM(pb + 10); }
        if (PHON(12) && IN(pb + 12)) { PHASE_VARS; (void)tid_; (void)wave;
            pg8::Gemm g{p.HB(), p.WGU_T(l), D, (size_t)2 * DEXP * D, p.SLOT_TOK()}; pg8::MoeOrder S{__builtin_amdgcn_readfirstlane(p.NBLK()[0]), 2 * DEXP / 256, G, (int)blockIdx.x, p.BLOCK_E()};
            pg8::EpiSwiglu E{p.HH(), DEXP, p.exp_b_gu + (size_t)l * NEXP * 2 * DEXP, 2 * DEXP};
            pg8::gemm_phase<true>(ldsp, g, S, E, tid_);
            SEAM(pb + 12);
        }
        if (PHON(13) && IN(pb + 13)) { PHASE_VARS; (void)tid_; (void)wave;
            pg8::Gemm g{p.HH(), p.WDN_T(l), DEXP, (size_t)D * DEXP, nullptr}; pg8::MoeOrder S{__builtin_amdgcn_readfirstlane(p.NBLK()[0]), D / 256, G, (int)blockIdx.x, p.BLOCK_E()};
            pg8::EpiBf16Bias E{p.YB(), D, p.exp_b_dn + (size_t)l * NEXP * D, D};
            pg8::gemm_phase(ldsp, g, S, E, tid_);
            SEAM(pb + 13);
        }
        if (PHON(14) && IN(pb + 14)) { PHASE_VARS; dev_combine(p, l, ntok_l, G, wave, lane);
            if (l + 1 < DEPTH) SEAM(pb + 14); }
}

__global__ void __launch_bounds__(NTHR, 2) fwd_kernel(Args args) {
    extern __shared__ __attribute__((aligned(16))) unsigned char lds[];
    const P& pk = args.p;
    LAS unsigned char* ldsp = (LAS unsigned char*)lds;
    volatile LAS unsigned* MISC = (volatile LAS unsigned*)(ldsp + MISC_OFF);
    const int G = gridDim.x;
    const int wave_s = __builtin_amdgcn_readfirstlane((int)threadIdx.x >> 6);
    { const int t0 = TID_NOW(); if (t0 < 32) MISC[t0] = 0u; }
    __syncthreads();
    XcdBarrier bar = xcd_barrier_post(pk.ctl() + CW_BAR, MISC + 8, TID_NOW());
    const int lo = args.ph_lo, hi = args.ph_hi;
#ifdef PROBE_T
    if (blockIdx.x == 0 && TID_NOW() == 0) ((unsigned long long*)(pk.ctl() + 12100))[0] = __builtin_amdgcn_s_memrealtime();
#endif

    if (PHON(100) && IN(0)) { PHASE_VARS;
        for (int cg = blockIdx.x; cg < DEPTH * 96; cg += G) dev_mod(p, cg, ldsp, tid_);
        RUN_TASKS(D, p.HB()[(size_t)ZROW * D + task] = 0);
        dev_build_rope(p, gtid, nthr);
        for (int lw = 0; lw < DEPTH; ++lw) dev_build_wlr(p, lw, gtid, nthr);
        for (int ch = blockIdx.x; ch < CV_NCH_SMALL; ch += G) conv_chunk(p, 0, false, ch, ldsp, wave, lane);
        SEAM(0);
    }
    layer_body<0>(args, bar, ldsp, G, wave_s, lo, hi);
    layer_body<1>(args, bar, ldsp, G, wave_s, lo, hi);
#undef IN
#undef SEAM
}

#ifndef N_LAUNCH_MODE
#define N_LAUNCH_MODE 1
#endif
extern "C" void kernel_launch(void* const* d_in, const int* in_sizes, int n_in, void* d_out, int out_size, void* d_ws, size_t ws_size, hipStream_t stream) {
    static int grid = 0;
    if (grid == 0) {
        int dev = 0, cus = 0;
        if (hipGetDevice(&dev) != hipSuccess || hipDeviceGetAttribute(&cus, hipDeviceAttributeMultiprocessorCount, dev) != hipSuccess) { grid = -1; return; }
        if (hipFuncSetAttribute((const void*)fwd_kernel, hipFuncAttributeMaxDynamicSharedMemorySize, LDS_BYTES) != hipSuccess) { fprintf(stderr, "hipFuncSetAttribute failed\n"); grid = -1; return; }
        int per_cu = 0;
        if (hipOccupancyMaxActiveBlocksPerMultiprocessor(&per_cu, (const void*)fwd_kernel, NTHR, LDS_BYTES) != hipSuccess || per_cu < 1) fprintf(stderr, "occupancy query: %d\n", per_cu);
        (void)hipGetLastError();
        grid = cus;
    }
    if (grid < 0) return;
    unsigned char* ws = (unsigned char*)d_ws;
    (void)hipMemsetAsync(ws, 0, CTL_BYTES, stream);
    Args a{};
    P& p = a.p;
    const float* const* in = (const float* const*)d_in;
    p.x = in[0]; p.c = in[1]; p.ctx = in[2]; p.c_ctx = in[3]; p.ada_w = in[4]; p.ada_b = in[5]; p.pre_norm = in[6]; p.post_norm = in[7]; p.w_in = in[8]; p.w_out = in[9];
    p.rw_mu = in[10]; p.rw_w0 = in[11]; p.rw_w2 = in[12]; p.rw_a0 = in[13]; p.rw_a2 = in[14]; p.rw_g2 = in[15]; p.rw_k_k = in[16]; p.rw_k_a = in[17]; p.rw_r_k = in[18]; p.rw_ln_w = in[19]; p.rw_ln_b = in[20];
    p.gdn_conv = in[21]; p.gdn_a_log = in[22]; p.gdn_dt_bias = in[23]; p.gdn_norm = in[24]; p.attn_q_norm = in[25]; p.attn_k_norm = in[26];
    p.router_w = in[27]; p.router_b = in[28]; p.exp_w_gu = in[29]; p.exp_b_gu = in[30]; p.exp_w_dn = in[31]; p.exp_b_dn = in[32];
    p.out = (float*)d_out;
    p.ws = ws; p.tokf = nullptr;
#ifdef PROBE_GDN
    if (WS_TOTAL + (size_t)2 * NTOK * B_W * 4 > ws_size) { fprintf(stderr, "probe: ws too small\n"); return; }
#endif
    if (WS_TOTAL > ws_size) { fprintf(stderr, "kernel_launch: workspace too small: need %zu have %zu\n", (size_t)WS_TOTAL, ws_size); return; }
    const int nph = 1 + DEPTH * NPH;
#if N_LAUNCH_MODE == 1
    a.ph_lo = 0; a.ph_hi = nph;
    hipLaunchKernelGGL(fwd_kernel, dim3(grid), dim3(NTHR), LDS_BYTES, stream, a);
#else
    for (int ph = 0; ph < nph; ++ph) { a.ph_lo = ph; a.ph_hi = ph + 1; hipLaunchKernelGGL(fwd_kernel, dim3(grid), dim3(NTHR), LDS_BYTES, stream, a); }
#endif
}
#endif
```

```cpp
#ifndef HOST_TEST
#include <hip/hip_runtime.h>
#else
struct uint4 { unsigned x, y, z, w; };
#endif
#include <cstdio>
#include <cstdint>
#include <cmath>

#ifndef CFG_BATCH
#define CFG_BATCH 16
#define CFG_SEQ 2048
#define CFG_CTX 256
#define CFG_NEXP 32
#define CFG_DEXP 1024
#endif
constexpr int D = 1024, BATCH = CFG_BATCH, SEQ = CFG_SEQ, CTXL = CFG_CTX, DEPTH = 2, GRID_W = 64;
constexpr int NLAT = BATCH * SEQ, NCTX = BATCH * CTXL, NTOK = NLAT + NCTX;
constexpr int A_W = 256, A_H = 4, A_IN = 960;
constexpr int B_W = 512, B_H = 4, B_IN = 2064, B_OFF = 960;
constexpr int C_W = 256, C_IN = 512, C_OFF = 3024;
constexpr int INW = 3536, INP = 3584;
constexpr int NEXP = CFG_NEXP, TOPK = 4, DEXP = CFG_DEXP;
constexpr int NBLK_MAX = (NTOK * TOPK + 255) / 256 + NEXP, NSLOT = NBLK_MAX * 256;
constexpr int ZROW = NTOK;
constexpr int SLEN = CTXL + SEQ;

#ifdef HOST_TEST
#define DEVFN static inline
#define GLOBAL_ATOMIC_ADD(p, v) ((*(p)) += (v), (*(p)) - (v))
#else
#define DEVFN __device__ __forceinline__
#define GLOBAL_ATOMIC_ADD(p, v) atomicAdd((p), (v))
#endif
#ifdef HOST_TEST
#define UNIFORM(x) (x)
#define LOADFENCE()
#else
#define UNIFORM(x) __builtin_amdgcn_readfirstlane(x)
#define LOADFENCE() asm volatile("" ::: "memory")
#endif
typedef unsigned short bf16_t;
DEVFN bf16_t f2bf(float f) { unsigned u = __builtin_bit_cast(unsigned, f); return (bf16_t)((u + 0x7fffu + ((u >> 16) & 1u)) >> 16); }
DEVFN float bf2f(bf16_t b) { unsigned u = ((unsigned)b) << 16; return __builtin_bit_cast(float, u); }
DEVFN float sigmoidf_(float x) { return 1.0f / (1.0f + expf(-x)); }
DEVFN float siluf_(float x) { return x / (1.0f + expf(-x)); }
DEVFN float softplusf_(float x) { return x > 20.f ? x : log1pf(expf(x)); }

#ifdef HOST_TEST
#define WSACC inline
#else
#define WSACC __device__ __host__ __forceinline__
#endif
constexpr size_t CTL_BYTES = 64 * 1024;
constexpr size_t al256(size_t x) { return (x + 255) & ~(size_t)255; }
constexpr size_t WSO_ctl = 0;
constexpr size_t WSE_ctl = WSO_ctl + al256(CTL_BYTES);
constexpr size_t WSO_MOD = WSE_ctl;
constexpr size_t WSE_MOD = WSO_MOD + al256((size_t)DEPTH * (BATCH + 1) * 6 * D * 4);
constexpr size_t WSO_X = WSE_MOD;
constexpr size_t WSE_X = WSO_X + al256((size_t)(NTOK + 1) * D * 4);
constexpr size_t WSO_HB = WSE_X;
constexpr size_t WSE_HB = WSO_HB + al256((size_t)(NTOK + 1) * D * 2);
constexpr size_t WSO_WIN_T = WSE_HB;
constexpr size_t WSE_WIN_T = WSO_WIN_T + al256((size_t)INP * D * 2);
constexpr size_t WSO_WOUT_T = WSE_WIN_T;
constexpr size_t WSE_WOUT_T = WSO_WOUT_T + al256((size_t)D * D * 2);
constexpr size_t WSO_WR_T = WSE_WOUT_T;
constexpr size_t WSE_WR_T = WSO_WR_T + al256((size_t)64 * D * 2);
constexpr size_t WSO_WGU_T = WSE_WR_T;
constexpr size_t WSE_WGU_T = WSO_WGU_T + al256((size_t)NEXP * 2 * DEXP * D * 2);
constexpr size_t WSO_WDN_T = WSE_WGU_T;
constexpr size_t WSE_WDN_T = WSO_WDN_T + al256((size_t)NEXP * D * DEXP * 2);
constexpr size_t WSZ_WSET = WSE_WDN_T - WSO_WIN_T;
constexpr size_t WSO_TOPI = WSE_WDN_T + WSZ_WSET;
constexpr size_t WSE_TOPI = WSO_TOPI + al256((size_t)NTOK * 4 * 4);
constexpr size_t WSO_POS = WSE_TOPI;
constexpr size_t WSE_POS = WSO_POS + al256((size_t)NTOK * 4 * 4);
constexpr size_t WSO_TSLOT = WSE_POS;
constexpr size_t WSE_TSLOT = WSO_TSLOT + al256((size_t)NTOK * 4 * 4);
constexpr size_t WSO_TOPG = WSE_TSLOT;
constexpr size_t WSE_TOPG = WSO_TOPG + al256((size_t)NTOK * 4 * 4);
constexpr size_t WSO_SLOT_TOK = WSE_TOPG;
constexpr size_t WSE_SLOT_TOK = WSO_SLOT_TOK + al256((size_t)NSLOT * 4);
constexpr size_t WSO_BLOCK_E = WSE_SLOT_TOK;
constexpr size_t WSE_BLOCK_E = WSO_BLOCK_E + al256((size_t)NBLK_MAX * 4);
constexpr size_t WSO_NBLK = WSE_BLOCK_E;
constexpr size_t WSE_NBLK = WSO_NBLK + al256(256);
constexpr size_t WSO_U = WSE_NBLK;
constexpr size_t WSE_U = WSO_U + al256((size_t)NTOK * INP * 2);
constexpr size_t WSO_MO = WSE_U;
constexpr size_t WSE_MO = WSO_MO + al256((size_t)NTOK * D * 2);
constexpr size_t WSO_ROPE = WSE_MO;
constexpr size_t WSE_ROPE = WSO_ROPE + al256((size_t)SEQ * 128 * 4);
constexpr size_t WSO_WLR_T = WSE_ROPE;
constexpr size_t WSE_WLR_T = WSO_WLR_T + 2 * al256((size_t)1280 * 256 * 2);
constexpr size_t WSO_END_P = WSE_WLR_T;
constexpr size_t WSO_LR = WSO_END_P;
constexpr size_t WSE_LR = WSO_LR + al256((size_t)NTOK * 192 * 4);
#ifdef HOST_TEST
constexpr size_t WSO_RW_R = WSE_LR;
#else
constexpr size_t WSO_RW_R = WSO_LR;
#endif
constexpr size_t WSE_RW_R = WSO_RW_R + al256((size_t)NTOK * A_W * 2);
constexpr size_t WSO_RW_V = WSE_RW_R;
constexpr size_t WSE_RW_V = WSO_RW_V + al256((size_t)NTOK * A_W * 2);
constexpr size_t WSO_RW_KK = WSE_RW_V;
constexpr size_t WSE_RW_KK = WSO_RW_KK + al256((size_t)NTOK * A_W * 2);
constexpr size_t WSO_RW_D = WSE_RW_KK;
constexpr size_t WSE_RW_D = WSO_RW_D + al256((size_t)2 * NTOK * A_W * 4);
constexpr size_t WSO_RW_KD = WSE_RW_D;
constexpr size_t WSE_RW_KD = WSO_RW_KD + al256((size_t)2 * NTOK * A_W * 2);
constexpr size_t WSO_RW_KKA = WSE_RW_KD;
constexpr size_t WSE_RW_KKA = WSO_RW_KKA + al256((size_t)2 * NTOK * A_W * 2);
constexpr size_t WSO_RW_GATE = WSE_RW_KKA;
constexpr size_t WSE_RW_GATE = WSO_RW_GATE + al256((size_t)NTOK * A_W * 2);
constexpr size_t WSO_RW_BON = WSE_RW_GATE;
constexpr size_t WSE_RW_BON = WSO_RW_BON + al256((size_t)NTOK * A_H * 4);
constexpr size_t WSO_YA = WSE_RW_BON;
constexpr size_t WSE_YA = WSO_YA + al256((size_t)2 * NTOK * A_W * 2);
constexpr size_t WSO_GQ = WSE_YA;
constexpr size_t WSE_GQ = WSO_GQ + al256((size_t)NTOK * B_W * 2);
constexpr size_t WSO_GK = WSE_GQ;
constexpr size_t WSE_GK = WSO_GK + al256((size_t)NTOK * B_W * 2);
constexpr size_t WSO_GV = WSE_GK;
constexpr size_t WSE_GV = WSO_GV + al256((size_t)NTOK * B_W * 2);
constexpr size_t WSO_GG = WSE_GV;
constexpr size_t WSE_GG = WSO_GG + al256((size_t)NTOK * 8 * 4);
constexpr size_t WSO_GBETA = WSE_GG;
constexpr size_t WSE_GBETA = WSO_GBETA + al256((size_t)NTOK * 8 * 4);
constexpr size_t WSO_OB = WSE_GBETA;
constexpr size_t WSE_OB = WSO_OB + al256((size_t)2 * NTOK * B_W * 2);
constexpr size_t WSO_CQ = WSE_OB;
constexpr size_t WSE_CQ = WSO_CQ + al256((size_t)NTOK * 256 * 2);
constexpr size_t WSO_CK = WSE_CQ;
constexpr size_t WSE_CK = WSO_CK + al256((size_t)NTOK * 128 * 2);
constexpr size_t WSO_CV = WSE_CK;
constexpr size_t WSE_CV = WSO_CV + al256((size_t)NTOK * 128 * 2);
constexpr size_t WSO_RWC = WSE_CV;
constexpr size_t WSE_RWC = WSO_RWC + al256((size_t)2 * BATCH * A_H * (SLEN / 64) * 5 * 4096 * 2);
constexpr size_t WSO_LRT = WSE_RWC;
constexpr size_t WSE_LRT = WSO_LRT + al256((size_t)NTOK * 256 * 2);
constexpr size_t WSO_LRO = WSE_LRT;
constexpr size_t WSE_LRO = WSO_LRO + al256((size_t)NTOK * 1280 * 2);
constexpr size_t WSO_MIX = WSE_LRO;
constexpr size_t WSE_MIX = WSO_MIX + al256((size_t)NTOK * D * 2);
constexpr size_t WSO_XG = WSO_END_P;
constexpr size_t WSE_XG = WSO_XG + al256((size_t)NSLOT * D * 2);
constexpr size_t WSO_HH = WSE_XG;
constexpr size_t WSE_HH = WSO_HH + al256((size_t)NSLOT * DEXP * 2);
constexpr size_t WSO_YB = WSE_HH;
constexpr size_t WSE_YB = WSO_YB + al256((size_t)NSLOT * D * 2);
constexpr size_t WS_TOTAL = (WSE_MIX > WSE_YB ? WSE_MIX : WSE_YB);
struct P {
    const float *x, *c, *ctx, *c_ctx, *ada_w, *ada_b, *pre_norm, *post_norm, *w_in, *w_out;
    const float *rw_mu, *rw_w0, *rw_w2, *rw_a0, *rw_a2, *rw_g2, *rw_k_k, *rw_k_a, *rw_r_k, *rw_ln_w, *rw_ln_b;
    const float *gdn_conv, *gdn_a_log, *gdn_dt_bias, *gdn_norm, *attn_q_norm, *attn_k_norm;
    const float *router_w, *router_b, *exp_w_gu, *exp_b_gu, *exp_w_dn, *exp_b_dn;
    float* out;
    unsigned char* ws;
    WSACC unsigned* ctl() const { return (unsigned*)(ws + WSO_ctl); }
    WSACC float* MOD() const { return (float*)(ws + WSO_MOD); }
    WSACC float* X() const { return (float*)(ws + WSO_X); }
    WSACC bf16_t* HB() const { return (bf16_t*)(ws + WSO_HB); }
    WSACC bf16_t* WIN_T(int l) const { return (bf16_t*)(ws + WSO_WIN_T + (size_t)l * WSZ_WSET); }
    WSACC bf16_t* WOUT_T(int l) const { return (bf16_t*)(ws + WSO_WOUT_T + (size_t)l * WSZ_WSET); }
    WSACC bf16_t* WR_T(int l) const { return (bf16_t*)(ws + WSO_WR_T + (size_t)l * WSZ_WSET); }
    WSACC bf16_t* WGU_T(int l) const { return (bf16_t*)(ws + WSO_WGU_T + (size_t)l * WSZ_WSET); }
    WSACC bf16_t* WDN_T(int l) const { return (bf16_t*)(ws + WSO_WDN_T + (size_t)l * WSZ_WSET); }
    WSACC int* TOPI() const { return (int*)(ws + WSO_TOPI); }
    WSACC int* POS() const { return (int*)(ws + WSO_POS); }
    WSACC int* TSLOT() const { return (int*)(ws + WSO_TSLOT); }
    WSACC float* TOPG() const { return (float*)(ws + WSO_TOPG); }
    WSACC int* SLOT_TOK() const { return (int*)(ws + WSO_SLOT_TOK); }
    WSACC int* BLOCK_E() const { return (int*)(ws + WSO_BLOCK_E); }
    WSACC int* NBLK() const { return (int*)(ws + WSO_NBLK); }
    WSACC bf16_t* U() const { return (bf16_t*)(ws + WSO_U); }
    WSACC bf16_t* MO() const { return (bf16_t*)(ws + WSO_MO); }
    WSACC float* LR() const { return (float*)(ws + WSO_LR); }
    WSACC bf16_t* RW_R() const { return (bf16_t*)(ws + WSO_RW_R); }
    WSACC bf16_t* RW_V() const { return (bf16_t*)(ws + WSO_RW_V); }
    WSACC bf16_t* RW_KK() const { return (bf16_t*)(ws + WSO_RW_KK); }
    WSACC float* RW_D() const { return (float*)(ws + WSO_RW_D); }
    WSACC bf16_t* RW_KD() const { return (bf16_t*)(ws + WSO_RW_KD); }
    WSACC bf16_t* RW_KKA() const { return (bf16_t*)(ws + WSO_RW_KKA); }
    WSACC bf16_t* RW_GATE() const { return (bf16_t*)(ws + WSO_RW_GATE); }
    WSACC float* RW_BON() const { return (float*)(ws + WSO_RW_BON); }
    WSACC bf16_t* YA() const { return (bf16_t*)(ws + WSO_YA); }
    WSACC bf16_t* GQ() const { return (bf16_t*)(ws + WSO_GQ); }
    WSACC bf16_t* GK() const { return (bf16_t*)(ws + WSO_GK); }
    WSACC bf16_t* GV() const { return (bf16_t*)(ws + WSO_GV); }
    WSACC float* GG() const { return (float*)(ws + WSO_GG); }
    WSACC float* GBETA() const { return (float*)(ws + WSO_GBETA); }
    WSACC bf16_t* OB() const { return (bf16_t*)(ws + WSO_OB); }
    WSACC bf16_t* CQ() const { return (bf16_t*)(ws + WSO_CQ); }
    WSACC bf16_t* CK() const { return (bf16_t*)(ws + WSO_CK); }
    WSACC bf16_t* CV() const { return (bf16_t*)(ws + WSO_CV); }
    WSACC bf16_t* MIX() const { return (bf16_t*)(ws + WSO_MIX); }
    WSACC bf16_t* RWC() const { return (bf16_t*)(ws + WSO_RWC); }
    WSACC float* ROPE() const { return (float*)(ws + WSO_ROPE); }
    WSACC bf16_t* LRT() const { return (bf16_t*)(ws + WSO_LRT); }
    WSACC bf16_t* LRO() const { return (bf16_t*)(ws + WSO_LRO); }
    WSACC bf16_t* WLR_T(int l) const { return (bf16_t*)(ws + WSO_WLR_T + (size_t)l * al256((size_t)1280 * 256 * 2)); }
    WSACC bf16_t* XG() const { return (bf16_t*)(ws + WSO_XG); }
    WSACC bf16_t* HH() const { return (bf16_t*)(ws + WSO_HH); }
    WSACC bf16_t* YB() const { return (bf16_t*)(ws + WSO_YB); }
    WSACC int* cnt() const { return (int*)(ws + WSO_ctl) + 8192; }
    WSACC float* TOKF() const { return tokf; }
    float* tokf;
};

DEVFN void row_info(int m, int& b, int& t, int& len, int& base) {
    if (m < NLAT) { b = m / SEQ; t = m % SEQ; len = SEQ; base = b * SEQ; }
    else { const int mc = m - NLAT; b = mc / CTXL; t = mc % CTXL; len = CTXL; base = NLAT + b * CTXL; }
}
DEVFN float ldU(const P& p, size_t idx) { return bf2f(p.U()[idx]); }
DEVFN int mod_row(int m) { return m < NLAT ? m / SEQ : BATCH; }
DEVFN int scan_row(int dir, int b, int s) {
    if (s < CTXL) { const int ts = dir ? (CTXL - 1 - s) : s; return NLAT + b * CTXL + ts; }
    const int s2 = s - CTXL; const int ts = dir ? (SEQ - 1 - s2) : s2; return b * SEQ + ts;
}

DEVFN void task_mod(const P& p, long task) {
    const int j = (int)(task % (6 * D)); const int r = (int)((task / (6 * D)) % (BATCH + 1)); const int l = (int)(task / ((long)(6 * D) * (BATCH + 1)));
    const float* cv = (r < BATCH) ? p.c + (size_t)r * D : p.c_ctx;
    const float* w = p.ada_w + (size_t)l * D * 6 * D + j;
    float acc = 0.f;
    for (int k = 0; k < D; ++k) acc += siluf_(cv[k]) * w[(size_t)k * 6 * D];
    p.MOD()[((size_t)l * (BATCH + 1) + r) * 6 * D + j] = acc + p.ada_b[(size_t)l * 6 * D + j];
}
DEVFN void task_copyx(const P& p, long task) {
    const long n_lat = (long)NLAT * D;
    p.X()[task] = task < n_lat ? p.x[task] : p.ctx[task - n_lat];
}
DEVFN void task_norm1(const P& p, int l, long task) {
    const int m = (int)task; const float* xr = p.X() + (size_t)m * D;
    float ss = 0.f; for (int k = 0; k < D; ++k) ss += xr[k] * xr[k];
    const float rstd = 1.0f / sqrtf(ss / D + 1e-6f);
    const float* md = p.MOD() + ((size_t)l * (BATCH + 1) + mod_row(m)) * 6 * D; const float* pn = p.pre_norm + (size_t)(l * 2 + 0) * D;
    bf16_t* o = p.HB() + (size_t)m * D;
    for (int k = 0; k < D; ++k) o[k] = f2bf(xr[k] * rstd * pn[k] * (1.0f + md[D + k]) + md[k]);
}
DEVFN float lerpA(const P& p, int l, int m, int col) {
    int b, t, len, base; row_info(m, b, t, len, base);
    const float u = ldU(p, (size_t)m * INP + col);
    const float up = t > 0 ? ldU(p, (size_t)(m - 1) * INP + col) : 0.f, un = t + 1 < len ? ldU(p, (size_t)(m + 1) * INP + col) : 0.f;
    return u + p.rw_mu[l * A_IN + col] * (0.5f * (up + un) - u);
}
DEVFN void task_prepA0(const P& p, int l, long task) {
    const int m = (int)(task / 192), j = (int)(task % 192);
    const float v = lerpA(p, l, m, 768 + j);
    p.LR()[(size_t)m * 192 + j] = j < 64 ? tanhf(v) : (j < 128 ? v : sigmoidf_(v));
}
DEVFN void task_prepA1(const P& p, int l, long task) {
    const int m = (int)(task / A_H), h = (int)(task % A_H);
    const float* lr = p.LR() + (size_t)m * 192;
    float ss = 0.f;
    for (int c = 0; c < 64; ++c) { const int ch = h * 64 + c; const float kx = lerpA(p, l, m, 256 + ch) * p.rw_k_k[l * A_W + ch]; ss += kx * kx; }
    const float rn = 1.0f / sqrtf(ss + 1e-6f);
    float bon = 0.f;
    for (int c = 0; c < 64; ++c) {
        const int ch = h * 64 + c;
        const float r = lerpA(p, l, m, ch), k = lerpA(p, l, m, 256 + ch), v = lerpA(p, l, m, 512 + ch);
        const float kk = k * p.rw_k_k[l * A_W + ch] * rn;
        float kdsum = 0.f;
        for (int dir = 0; dir < 2; ++dir) {
            float w = p.rw_w0[(l * 2 + dir) * A_W + ch], a = p.rw_a0[(l * 2 + dir) * A_W + ch];
            const float* w2 = p.rw_w2 + ((size_t)(l * 2 + dir) * 32) * A_W + ch; const float* a2 = p.rw_a2 + ((size_t)(l * 2 + dir) * 32) * A_W + ch;
            for (int r2 = 0; r2 < 32; ++r2) { w += lr[dir * 32 + r2] * w2[(size_t)r2 * A_W]; a += lr[64 + dir * 32 + r2] * a2[(size_t)r2 * A_W]; }
            const float decay = -expf(-softplusf_(-w) - 0.5f);
            const float iclr = sigmoidf_(a);
            const float kd = k * (1.0f + (iclr - 1.0f) * p.rw_k_a[l * A_W + ch]);
            const size_t o = ((size_t)dir * NTOK + m) * A_W + ch;
            p.RW_D()[o] = decay; p.RW_KD()[o] = f2bf(kd); p.RW_KKA()[o] = f2bf(kk * iclr); kdsum += kd;
        }
        float g = 0.f; const float* g2 = p.rw_g2 + (size_t)l * 64 * A_W + ch;
        for (int r2 = 0; r2 < 64; ++r2) g += lr[128 + r2] * g2[(size_t)r2 * A_W];
        const size_t o = (size_t)m * A_W + ch;
        p.RW_R()[o] = f2bf(r); p.RW_V()[o] = f2bf(v); p.RW_KK()[o] = f2bf(kk); p.RW_GATE()[o] = f2bf(g);
        bon += r * kdsum * p.rw_r_k[l * A_W + ch];
    }
    p.RW_BON()[(size_t)m * A_H + h] = bon;
}
DEVFN void task_prepB(const P& p, int l, long task) {
    const int which = (int)(task % 4), h = (int)((task / 4) % B_H), m = (int)(task / (4 * B_H));
    int b, t, len, base; row_info(m, b, t, len, base);
    if (which == 3) {
        for (int dir = 0; dir < 2; ++dir) {
            const float a = ldU(p, (size_t)m * INP + B_OFF + 2048 + dir * 4 + h), bb = ldU(p, (size_t)m * INP + B_OFF + 2056 + dir * 4 + h);
            const float g = -expf(p.gdn_a_log[(l * 2 + dir) * B_H + h]) * softplusf_(a + p.gdn_dt_bias[(l * 2 + dir) * B_H + h]);
            p.GG()[(size_t)m * 8 + dir * 4 + h] = g; p.GBETA()[(size_t)m * 8 + dir * 4 + h] = sigmoidf_(bb);
        }
        return;
    }
    bf16_t* dst = (which == 0 ? p.GQ() : which == 1 ? p.GK() : p.GV()) + (size_t)m * B_W + h * 128;
    float ss = 0.f;
    for (int c = 0; c < 128; ++c) {
        const int cc = which * B_W + h * 128 + c; const int col = B_OFF + cc;
        float acc = 0.f;
        for (int j = 0; j < 5; ++j) { const int tt = t + j - 2; if (tt >= 0 && tt < len) acc += ldU(p, (size_t)(base + tt) * INP + col) * p.gdn_conv[((size_t)l * 5 + j) * (3 * B_W) + cc]; }
        const float s = siluf_(acc); if (which == 2) dst[c] = f2bf(s); ss += s * s;
    }
    if (which < 2) { const float rn = (1.0f / sqrtf(ss + 1e-6f)) * (which == 0 ? 0.08838834764831845f : 1.0f);
        for (int c = 0; c < 128; ++c) { const int cc = which * B_W + h * 128 + c; const int col = B_OFF + cc; float acc = 0.f;
            for (int j = 0; j < 5; ++j) { const int tt = t + j - 2; if (tt >= 0 && tt < len) acc += ldU(p, (size_t)(base + tt) * INP + col) * p.gdn_conv[((size_t)l * 5 + j) * (3 * B_W) + cc]; }
            dst[c] = f2bf(siluf_(acc) * rn); } }
}
DEVFN void task_prepC(const P& p, int l, long task) {
    const int m = (int)(task / 8), hs = (int)(task % 8);
    const size_t sb = (size_t)m * INP + C_OFF + hs * 64;
    if (hs >= 6) { int b_, t_, len_, base_; row_info(m, b_, t_, len_, base_); const int key = m < NLAT ? t_ : SEQ + t_;
        for (int d = 0; d < 64; ++d) p.CV()[((size_t)(b_ * 2 + (hs - 6)) * 64 + d) * SLEN + key] = p.U()[sb + d]; return; }
    float ss = 0.f; for (int d = 0; d < 64; ++d) { const float x = ldU(p, sb + d); ss += x * x; }
    const float qs = hs < 4 ? 0.18033688011112042f : 1.0f;
    const float rstd = (1.0f / sqrtf(ss / 64.f + 1e-6f)) * qs;
    const float* nw = (hs < 4 ? p.attn_q_norm : p.attn_k_norm) + l * 64;
    bf16_t* dst = hs < 4 ? p.CQ() + (size_t)m * 256 + hs * 64 : p.CK() + (size_t)m * 128 + (hs - 4) * 64;
    if (m >= NLAT) { for (int d = 0; d < 64; ++d) dst[d] = f2bf(ldU(p, sb + d) * rstd * nw[d]); return; }
    const int t = m % SEQ; const float pr = (float)(t / GRID_W), pc = (float)(t % GRID_W);
    for (int d = 0; d < 16; ++d) {
        const float fr = powf(10000.0f, -(float)d / 16.0f);
        const float ar = pr * fr, ac = pc * fr; const float cr = cosf(ar), sr = sinf(ar), cc = cosf(ac), sc = sinf(ac);
        const float x1 = ldU(p, sb + d) * rstd * nw[d], x2 = ldU(p, sb + 16 + d) * rstd * nw[16 + d], x3 = ldU(p, sb + 32 + d) * rstd * nw[32 + d], x4 = ldU(p, sb + 48 + d) * rstd * nw[48 + d];
        dst[d] = f2bf(x1 * cr - x2 * sr); dst[16 + d] = f2bf(x2 * cr + x1 * sr); dst[32 + d] = f2bf(x3 * cc - x4 * sc); dst[48 + d] = f2bf(x4 * cc + x3 * sc);
    }
}
DEVFN void task_scanA(const P& p, long task) {
    const int v = (int)(task % 64), chain = UNIFORM((int)(task / 64)); const int h = chain % A_H, b = (chain / A_H) % BATCH, dir = chain / (A_H * BATCH);
    float s[64];
#pragma unroll
    for (int k = 0; k < 64; ++k) s[k] = 0.f;
    for (int st = 0; st < SLEN; ++st) {
        const int m = scan_row(dir, b, st);
        const bf16_t* kk = p.RW_KK() + (size_t)m * A_W + h * 64; const bf16_t* rr = p.RW_R() + (size_t)m * A_W + h * 64;
        const size_t od = ((size_t)dir * NTOK + m) * A_W + h * 64;
        const float* dd = p.RW_D() + od; const bf16_t* kd = p.RW_KD() + od; const bf16_t* ka = p.RW_KKA() + od;
        const float vv = bf2f(p.RW_V()[(size_t)m * A_W + h * 64 + v]);
        float sa = 0.f;
#pragma unroll
        for (int k = 0; k < 64; ++k) { sa += s[k] * bf2f(kk[k]); if ((k & 15) == 15) LOADFENCE(); }
        float y = 0.f;
#pragma unroll
        for (int k = 0; k < 64; ++k) { s[k] = s[k] * expf(dd[k]) - sa * bf2f(ka[k]) + vv * bf2f(kd[k]); y += s[k] * bf2f(rr[k]); if ((k & 7) == 7) LOADFENCE(); }
        p.YA()[((size_t)dir * NTOK + m) * A_W + h * 64 + v] = f2bf(y);
    }
}
DEVFN void task_scanB(const P& p, long task) {
    const int j = (int)(task % 128), chain = UNIFORM((int)(task / 128)); const int h = chain % B_H, b = (chain / B_H) % BATCH, dir = chain / (B_H * BATCH);
    float s[128];
#pragma unroll
    for (int k = 0; k < 128; ++k) s[k] = 0.f;
    for (int st = 0; st < SLEN; ++st) {
        const int m = scan_row(dir, b, st);
        const bf16_t* kv = p.GK() + (size_t)m * B_W + h * 128; const bf16_t* qv = p.GQ() + (size_t)m * B_W + h * 128;
        const float vj = bf2f(p.GV()[(size_t)m * B_W + h * 128 + j]);
        const float eg = expf(p.GG()[(size_t)m * 8 + dir * 4 + h]), beta = p.GBETA()[(size_t)m * 8 + dir * 4 + h];
        float pk = 0.f;
#pragma unroll
        for (int k = 0; k < 128; ++k) { pk += s[k] * bf2f(kv[k]); if ((k & 15) == 15) LOADFENCE(); }
        const float cf = beta * (vj - eg * pk);
        float o = 0.f;
#pragma unroll
        for (int k = 0; k < 128; ++k) { s[k] = eg * s[k] + cf * bf2f(kv[k]); o += s[k] * bf2f(qv[k]); if ((k & 7) == 7) LOADFENCE(); }
        p.OB()[((size_t)dir * NTOK + m) * B_W + h * 128 + j] = f2bf(o);
    }
}
DEVFN void task_attn(const P& p, int need_ctx, long task) {
    const int t = (int)(task % SLEN), hq = UNIFORM((int)((task / SLEN) % 4)), b = UNIFORM((int)(task / ((long)SLEN * 4)));
    const bool is_lat = UNIFORM((int)(t < SEQ)) != 0; if (!is_lat && !need_ctx) return;
    const int m = is_lat ? b * SEQ + t : NLAT + b * CTXL + (t - SEQ);
    const int kvh = hq >> 1;
    float q[64], o[64];
#pragma unroll
    for (int d = 0; d < 64; ++d) { q[d] = bf2f(p.CQ()[(size_t)m * 256 + hq * 64 + d]); o[d] = 0.f; }
    float mx = -1e30f, lsum = 0.f;
    const int nk = is_lat ? SLEN : CTXL;
    for (int kI = 0; kI < nk; ++kI) {
        int km; if (is_lat) km = kI < SEQ ? b * SEQ + kI : NLAT + b * CTXL + (kI - SEQ); else km = NLAT + b * CTXL + kI;
        const bf16_t* kr = p.CK() + (size_t)km * 128 + kvh * 64; const bf16_t* vr = p.CV() + ((size_t)(b * 2 + kvh) * 64) * SLEN + (is_lat ? kI : SEQ + kI);
        float sc = 0.f;
#pragma unroll
        for (int d = 0; d < 64; ++d) { sc += q[d] * bf2f(kr[d]); if ((d & 15) == 15) LOADFENCE(); }
        const float mn = sc > mx ? sc : mx; const float f = exp2f(mx - mn), pe = exp2f(sc - mn);
        lsum = lsum * f + pe; mx = mn;
#pragma unroll
        for (int d = 0; d < 64; ++d) { o[d] = o[d] * f + pe * bf2f(vr[(size_t)d * SLEN]); if ((d & 15) == 15) LOADFENCE(); }
    }
    const float inv = 1.0f / lsum;
#pragma unroll
    for (int d = 0; d < 64; ++d) p.MIX()[(size_t)m * D + 768 + hq * 64 + d] = f2bf(o[d] * inv);
}
DEVFN void task_post(const P& p, int l, long task) {
    const int m = (int)(task / 8), g = (int)(task % 8);
    if (g < 4) {
        const int h = g; const bf16_t* y0 = p.YA() + (size_t)m * A_W + h * 64; const bf16_t* y1 = p.YA() + ((size_t)NTOK + m) * A_W + h * 64;
        float mean = 0.f; for (int c = 0; c < 64; ++c) mean += bf2f(y0[c]) + bf2f(y1[c]); mean *= (1.0f / 64.f);
        float var = 0.f; for (int c = 0; c < 64; ++c) { const float d0 = bf2f(y0[c]) + bf2f(y1[c]) - mean; var += d0 * d0; } var *= (1.0f / 64.f);
        const float rs = 1.0f / sqrtf(var + 64e-5f); const float bon = p.RW_BON()[(size_t)m * A_H + h];
        for (int c = 0; c < 64; ++c) { const int ch = h * 64 + c;
            const float yn = (bf2f(y0[c]) + bf2f(y1[c]) - mean) * rs * p.rw_ln_w[l * A_W + ch] + p.rw_ln_b[l * A_W + ch];
            p.MIX()[(size_t)m * D + ch] = f2bf((yn + bon * bf2f(p.RW_V()[(size_t)m * A_W + ch])) * bf2f(p.RW_GATE()[(size_t)m * A_W + ch])); }
    } else {
        const int h = g - 4; const bf16_t* o0 = p.OB() + (size_t)m * B_W + h * 128; const bf16_t* o1 = p.OB() + ((size_t)NTOK + m) * B_W + h * 128;
        float ss = 0.f; for (int c = 0; c < 128; ++c) { const float o = bf2f(o0[c]) + bf2f(o1[c]); ss += o * o; }
        const float rs = 1.0f / sqrtf(ss / 128.f + 1e-6f);
        for (int c = 0; c < 128; ++c) { const float z = ldU(p, (size_t)m * INP + B_OFF + 1536 + h * 128 + c);
            p.MIX()[(size_t)m * D + 256 + h * 128 + c] = f2bf((bf2f(o0[c]) + bf2f(o1[c])) * rs * p.gdn_norm[l * 128 + c] * siluf_(z)); }
    }
}
DEVFN void task_resid1(const P& p, int l, long task) {
    const int m = (int)task; const bf16_t* mo = p.MO() + (size_t)m * D; float* xr = p.X() + (size_t)m * D;
    const float* md = p.MOD() + ((size_t)l * (BATCH + 1) + mod_row(m)) * 6 * D;
    float ss = 0.f; for (int k = 0; k < D; ++k) ss += bf2f(mo[k]) * bf2f(mo[k]);
    const float rstd = 1.0f / sqrtf(ss / D + 1e-6f); const float* pn = p.post_norm + (size_t)(l * 2 + 0) * D;
    float s2 = 0.f;
    for (int k = 0; k < D; ++k) { const float xv = xr[k] + md[2 * D + k] * (bf2f(mo[k]) * rstd) * pn[k]; xr[k] = xv; s2 += xv * xv; }
    const float r2 = 1.0f / sqrtf(s2 / D + 1e-6f); const float* pn2 = p.pre_norm + (size_t)(l * 2 + 1) * D;
    for (int k = 0; k < D; ++k) { const float tv = xr[k] * r2 * pn2[k] * (1.0f + md[4 * D + k]) + md[3 * D + k]; p.TOKF()[(size_t)m * D + k] = tv; p.HB()[(size_t)m * D + k] = f2bf(tv); }
}
DEVFN void task_router(const P& p, int l, long task) {
    const int m = (int)task; const float* tk = p.TOKF() + (size_t)m * D; const float* rw = p.router_w + (size_t)l * D * NEXP;
    float lg[NEXP];
#pragma unroll
    for (int e = 0; e < NEXP; ++e) lg[e] = p.router_b[l * NEXP + e];
    for (int k = 0; k < D; ++k) { const float tv = tk[k];
#pragma unroll
        for (int e = 0; e < NEXP; ++e) lg[e] += tv * rw[(size_t)k * NEXP + e]; }
    int idx[TOPK]; float val[TOPK];
#pragma unroll
    for (int j = 0; j < TOPK; ++j) { float best = -3.0e38f; int bi = 0;
#pragma unroll
        for (int e = 0; e < NEXP; ++e) { if (lg[e] > best) { best = lg[e]; bi = e; } }
        idx[j] = bi; val[j] = best;
#pragma unroll
        for (int e = 0; e < NEXP; ++e) if (e == bi) lg[e] = -3.0e38f; }
    float sum = 0.f, ex[TOPK];
#pragma unroll
    for (int j = 0; j < TOPK; ++j) { ex[j] = expf(val[j] - val[0]); sum += ex[j]; }
#pragma unroll
    for (int j = 0; j < TOPK; ++j) { p.TOPI()[(size_t)m * TOPK + j] = idx[j]; p.TOPG()[(size_t)m * TOPK + j] = ex[j] / sum; p.POS()[(size_t)m * TOPK + j] = GLOBAL_ATOMIC_ADD(&p.cnt()[l * NEXP + idx[j]], 1); }
}
DEVFN int moe_pstart(const P& p, int l, int e, int* nblk) {
    int acc = 0, ps = 0;
    for (int i = 0; i < NEXP; ++i) { if (i == e) ps = acc; acc += (p.cnt()[l * NEXP + i] + 255) / 256 * 256; }
    if (nblk) *nblk = acc / 256; return ps;
}
DEVFN void task_slots(const P& p, int l, long task) {
    const int e = p.TOPI()[task]; const int slot = moe_pstart(p, l, e, nullptr) + p.POS()[task];
    p.TSLOT()[task] = slot; p.SLOT_TOK()[slot] = (int)(task / TOPK);
}
DEVFN void task_blocke(const P& p, int l, long task) {
    int acc = 0, e_of = NEXP - 1, nb = 0;
    for (int i = 0; i < NEXP; ++i) { const int nbk = (p.cnt()[l * NEXP + i] + 255) / 256; if ((int)task >= acc && (int)task < acc + nbk) e_of = i; acc += nbk; }
    nb = acc; p.BLOCK_E()[task] = e_of; if (task == 0) p.NBLK()[0] = nb;
}
DEVFN void task_gather(const P& p, long task) {
    const long slot = task / 128; const int ch = (int)(task % 128); const int tok = p.SLOT_TOK()[slot];
    const uint4* s = (const uint4*)(p.HB() + (size_t)tok * D) + ch; ((uint4*)(p.XG() + (size_t)slot * D))[ch] = *s;
}
DEVFN void task_combine(const P& p, int l, long task) {
    const int m = (int)task; float* xr = p.X() + (size_t)m * D; const float* md = p.MOD() + ((size_t)l * (BATCH + 1) + mod_row(m)) * 6 * D;
    const bf16_t* y0 = p.YB() + (size_t)p.TSLOT()[(size_t)m * 4 + 0] * D; const bf16_t* y1 = p.YB() + (size_t)p.TSLOT()[(size_t)m * 4 + 1] * D;
    const bf16_t* y2 = p.YB() + (size_t)p.TSLOT()[(size_t)m * 4 + 2] * D; const bf16_t* y3 = p.YB() + (size_t)p.TSLOT()[(size_t)m * 4 + 3] * D;
    const float g0 = p.TOPG()[(size_t)m * 4 + 0], g1 = p.TOPG()[(size_t)m * 4 + 1], g2 = p.TOPG()[(size_t)m * 4 + 2], g3 = p.TOPG()[(size_t)m * 4 + 3];
    float ss = 0.f;
    for (int k = 0; k < D; ++k) { const float f = g0 * bf2f(y0[k]) + g1 * bf2f(y1[k]) + g2 * bf2f(y2[k]) + g3 * bf2f(y3[k]); ss += f * f; }
    const float rstd = 1.0f / sqrtf(ss / D + 1e-6f); const float* pn = p.post_norm + (size_t)(l * 2 + 1) * D;
    const bool last = (l == DEPTH - 1);
    for (int k = 0; k < D; ++k) { const float f = g0 * bf2f(y0[k]) + g1 * bf2f(y1[k]) + g2 * bf2f(y2[k]) + g3 * bf2f(y3[k]);
        const float xv = xr[k] + md[5 * D + k] * (f * rstd) * pn[k]; xr[k] = xv; if (last) p.out[(size_t)m * D + k] = xv; }
}

#ifndef HOST_TEST
namespace pg8 {
#define PG8_LAS __attribute__((address_space(3)))
typedef short bf16x8 __attribute__((ext_vector_type(8)));
typedef float f32x4 __attribute__((ext_vector_type(4)));
typedef unsigned u32x4 __attribute__((ext_vector_type(4)));
typedef unsigned u32x2 __attribute__((ext_vector_type(2)));
constexpr int BM = 256, BK = 64, HALF = 128, HTB = HALF * BK * 2, STAGE_BYTES = 8 * HTB, NXCD = 8, WGM = 8;
__host__ __device__ __forceinline__ int lds_byte(int r, int c) { const int st = (r >> 4) * 2 + (c >> 5), rr = r & 15, cc = c & 31, ob = rr * 64 + cc * 2; return st * 1024 + (ob ^ (((ob >> 9) & 1) << 5)); }
__host__ __device__ __forceinline__ void stage_rc(int b, int& R, int& C) { const int st = b / 1024, sb = b % 1024, swz = sb ^ (((sb >> 9) & 1) << 5); R = (st >> 1) * 16 + swz / 64; C = (st & 1) * 32 + (swz % 64) / 2; }
__host__ __device__ __forceinline__ int perm32(int rho) { const int n = rho >> 4, i = rho & 15; return 8 * (i >> 2) + 4 * n + (i & 3); }
struct Unit { int pm, pn, e; };
struct Gemm { const bf16_t* A; const bf16_t* Bt; int K; size_t estride; const int* rowidx; };
struct StaticOrder {
    int nM, nN, nwg, G, c;
    __device__ void init(int M, int N, int G_, int c_) { nM = M / BM; nN = N / BM; nwg = nM * nN; G = G_; c = c_; }
    __device__ bool next(int i, Unit& u) const {
        const long L = (long)i * G + c; if (L >= nwg) return false;
        int wgid = (int)L; { const int q = nwg / NXCD, r = nwg % NXCD, xcd = wgid % NXCD, off = wgid / NXCD; wgid = (xcd < r ? xcd * (q + 1) : r * (q + 1) + (xcd - r) * q) + off; }
        const int nig = WGM * nN, gid = wgid / nig, fm = gid * WGM, gsz = (nM - fm) < WGM ? (nM - fm) : WGM;
        u.pm = fm + ((wgid % nig) % gsz); u.pn = (wgid % nig) / gsz; u.e = 0; return true;
    }
};
struct MoeOrder {
    int nblk, nN, G, c; const int* block_e;
    __device__ bool next(int i, Unit& u) const {
        if (G % 8 != 0 || (G / 8) % nN != 0) { const long L = (long)i * G + c; if (L >= (long)nblk * nN) return false; u.pm = (int)(L / nN); u.pn = (int)(L % nN); }
        else { const int x = c & 7, r = c >> 3, per = (G / 8) / nN; const int mb = (i * per + r / nN) * 8 + x; if (mb >= nblk) return false; u.pm = mb; u.pn = r % nN; }
        u.e = __builtin_amdgcn_readfirstlane(block_e[u.pm]); return true;
    }
};
typedef float f32x2c_t __attribute__((ext_vector_type(2))); typedef __bf16 bf16x2c_t __attribute__((ext_vector_type(2)));
__device__ __forceinline__ unsigned cvt_pk_bf16(float lo, float hi) { const f32x2c_t v = {lo, hi}; const bf16x2c_t b = __builtin_convertvector(v, bf16x2c_t); return __builtin_bit_cast(unsigned, b); }
struct EpiF32 {
    static constexpr bool PERM = false;
    float* C; int ldc;
    __device__ __forceinline__ void operator()(const f32x4 (&acc)[2][2][4][2], const Unit& u, int wr, int wc, int fr, int fq) const {
        const int row0 = u.pm * BM + wr * 64 + fr, col0 = u.pn * BM + wc * 32 + 4 * fq;
#pragma unroll
        for (int ai = 0; ai < 2; ++ai)
#pragma unroll
            for (int m = 0; m < 4; ++m) { float* rowp = C + (size_t)(row0 + ai * HALF + m * 16) * ldc + col0;
#pragma unroll
                for (int bj = 0; bj < 2; ++bj)
#pragma unroll
                    for (int n = 0; n < 2; ++n) *(f32x4*)(rowp + bj * HALF + n * 16) = acc[ai][bj][m][n]; }
    }
};
struct EpiBf16Bias {
    static constexpr bool PERM = true;
    bf16_t* O; int ldc; const float* bias; int bias_estride;
    __device__ __forceinline__ void operator()(const f32x4 (&acc)[2][2][4][2], const Unit& u, int wr, int wc, int fr, int fq) const {
        const int row0 = u.pm * BM + wr * 64 + fr, col0 = u.pn * BM + wc * 32 + 8 * fq; const float* bp = bias + (size_t)u.e * bias_estride + col0;
        f32x4 bv[2][2];
#pragma unroll
        for (int bj = 0; bj < 2; ++bj)
#pragma unroll
            for (int n = 0; n < 2; ++n) bv[bj][n] = bias ? *(const f32x4*)(bp + bj * HALF + 4 * n) : (f32x4){0.f, 0.f, 0.f, 0.f};
#pragma unroll
        for (int ai = 0; ai < 2; ++ai)
#pragma unroll
            for (int m = 0; m < 4; ++m) { bf16_t* rowp = O + (size_t)(row0 + ai * HALF + m * 16) * ldc + col0;
#pragma unroll
                for (int bj = 0; bj < 2; ++bj) { const f32x4 v0 = acc[ai][bj][m][0] + bv[bj][0], v1 = acc[ai][bj][m][1] + bv[bj][1];
                    u32x4 w; w.x = cvt_pk_bf16(v0[0], v0[1]); w.y = cvt_pk_bf16(v0[2], v0[3]); w.z = cvt_pk_bf16(v1[0], v1[1]); w.w = cvt_pk_bf16(v1[2], v1[3]);
                    *(u32x4*)(rowp + bj * HALF) = w; } }
    }
};
__device__ __forceinline__ float swiglu1(float g, float lin) { g = fminf(g, 7.0f); lin = fminf(fmaxf(lin, -7.0f), 7.0f); return g * __builtin_amdgcn_rcpf(1.0f + __expf(-1.702f * g)) * (lin + 1.0f); }
struct EpiSwiglu {
    static constexpr bool PERM = true;
    bf16_t* O; int ldc; const float* bias; int bias_estride;
    __device__ __forceinline__ void operator()(const f32x4 (&acc)[2][2][4][2], const Unit& u, int wr, int wc, int fr, int fq) const {
        const int row0 = u.pm * BM + wr * 64 + fr, col0 = u.pn * BM + wc * 32 + 8 * fq; const float* bp = bias + (size_t)u.e * bias_estride + col0;
        f32x4 bv[2][2];
#pragma unroll
        for (int bj = 0; bj < 2; ++bj)
#pragma unroll
            for (int n = 0; n < 2; ++n) bv[bj][n] = *(const f32x4*)(bp + bj * HALF + 4 * n);
#pragma unroll
        for (int ai = 0; ai < 2; ++ai)
#pragma unroll
            for (int m = 0; m < 4; ++m) { bf16_t* rowp = O + (size_t)(row0 + ai * HALF + m * 16) * ldc + (col0 >> 1);
#pragma unroll
                for (int bj = 0; bj < 2; ++bj) { const f32x4 v0 = acc[ai][bj][m][0] + bv[bj][0], v1 = acc[ai][bj][m][1] + bv[bj][1];
                    u32x2 w; w.x = cvt_pk_bf16(swiglu1(v0[0], v0[1]), swiglu1(v0[2], v0[3])); w.y = cvt_pk_bf16(swiglu1(v1[0], v1[1]), swiglu1(v1[2], v1[3]));
                    *(u32x2*)(rowp + bj * (HALF / 2)) = w; } }
    }
};

template <bool GATHER = false, class Epi, class Sched>
__device__ __forceinline__ void gemm_phase(PG8_LAS unsigned char* lds, const Gemm g, const Sched& S, const Epi& E, int tid) {
    asm volatile("" : "+v"(tid));
    const int wid = __builtin_amdgcn_readfirstlane(tid >> 6), lane = tid & 63, wr = wid >> 2, wc = wid & 3, fr = lane & 15, fq = lane >> 4;
    int K = g.K; asm volatile("" : "+s"(K));
    const int nt = K / BK;
    unsigned voffA[2], voffB[2];
#pragma unroll
    for (int i = 0; i < 2; ++i) { int R, C; stage_rc(tid * 16 + i * 8192, R, C); const int Rb = Epi::PERM ? ((R & ~31) + perm32(R & 31)) : R;
        voffA[i] = GATHER ? 0u : (unsigned)(R * K + C) * 2u; voffB[i] = (unsigned)(Rb * K + C) * 2u; }
    const size_t kstep = (size_t)(BK * 2);
    const size_t hstep = (size_t)HALF * K * 2;
    const size_t tstep = 2 * hstep;
    const unsigned ldsw = (unsigned)wid * 1024u;
    const int aoff = lds_byte(wr * 64 + fr, fq * 8), boff = lds_byte(wc * 32 + fr, fq * 8);
#define PG8_SA(b, h) (((b) * 2 + (h)) * HTB)
#define PG8_SB(b, h) ((4 + (b) * 2 + (h)) * HTB)
#define PG8_STAGE(bufoff, gbase, voff) do { _Pragma("unroll") for (int _i = 0; _i < 2; ++_i) \
        __builtin_amdgcn_global_load_lds((const unsigned*)((const char*)(gbase) + (voff)[_i]), (PG8_LAS unsigned*)(lds + (bufoff) + ldsw + _i * 8192), 16, 0, 0); } while (0)
#define PG8_STAGE_A(bufoff, h, nx, kb) do { _Pragma("unroll") for (int _i = 0; _i < 2; ++_i) { \
        if constexpr (GATHER) { const unsigned _o = (nx) ? on[h][_i] : oc[h][_i]; \
            __builtin_amdgcn_global_load_lds((const unsigned*)((const char*)g.A + (size_t)_o + (size_t)(kb)), (PG8_LAS unsigned*)(lds + (bufoff) + ldsw + _i * 8192), 16, 0, 0); } \
        else { const char* _b = ((nx) ? nA : cA) + (size_t)(h) * hstep + (size_t)(kb); \
            __builtin_amdgcn_global_load_lds((const unsigned*)(_b + voffA[_i]), (PG8_LAS unsigned*)(lds + (bufoff) + ldsw + _i * 8192), 16, 0, 0); } } } while (0)
#define PG8_LDA(dst, b, h) do { _Pragma("unroll") for (int m = 0; m < 4; ++m) _Pragma("unroll") for (int k = 0; k < 2; ++k) dst[m][k] = *(const PG8_LAS bf16x8*)(lds + PG8_SA(b, h) + aoff + m * 2048 + k * 1024); } while (0)
#define PG8_LDB(dst, b, h) do { _Pragma("unroll") for (int n = 0; n < 2; ++n) _Pragma("unroll") for (int k = 0; k < 2; ++k) dst[n][k] = *(const PG8_LAS bf16x8*)(lds + PG8_SB(b, h) + boff + n * 2048 + k * 1024); } while (0)
#define PG8_MMA(ai, bj, At, Bt) do { __builtin_amdgcn_s_setprio(1); _Pragma("unroll") for (int m = 0; m < 4; ++m) _Pragma("unroll") for (int n = 0; n < 2; ++n) _Pragma("unroll") for (int k = 0; k < 2; ++k) \
        acc[ai][bj][m][n] = __builtin_amdgcn_mfma_f32_16x16x32_bf16(Bt[n][k], At[m][k], acc[ai][bj][m][n], 0, 0, 0); __builtin_amdgcn_s_setprio(0); } while (0)
#define PG8_WAIT_V(n) asm volatile("s_waitcnt vmcnt(" #n ")" ::: "memory")
#define PG8_WAIT_L(n) asm volatile("s_waitcnt lgkmcnt(" #n ")" ::: "memory")
#define PG8_BAR __builtin_amdgcn_s_barrier()
#define PG8_SCHED __builtin_amdgcn_sched_barrier(0)
    Unit cur, nxt; int ui = 0;
    if (!S.next(0, cur)) return;
    unsigned oc[2][2], on[2][2];
    const char* cA = (const char*)g.A + (size_t)cur.pm * tstep; const char* nA = cA;
#define PG8_UNIT_OFFS(o, u) do { _Pragma("unroll") for (int _h = 0; _h < 2; ++_h) _Pragma("unroll") for (int _i = 0; _i < 2; ++_i) { \
        if constexpr (GATHER) { int _R, _C; stage_rc(tid * 16 + _i * 8192, _R, _C); (o)[_h][_i] = (unsigned)g.rowidx[(u).pm * BM + _h * HALF + _R] * (unsigned)(K * 2) + (unsigned)(_C * 2); } else (o)[_h][_i] = 0u; } } while (0)
    PG8_UNIT_OFFS(oc, cur);
    f32x4 acc[2][2][4][2];
#pragma unroll
    for (int a = 0; a < 2; ++a)
#pragma unroll
        for (int b = 0; b < 2; ++b)
#pragma unroll
            for (int m = 0; m < 4; ++m)
#pragma unroll
                for (int n = 0; n < 2; ++n) acc[a][b][m][n] = (f32x4){0.f, 0.f, 0.f, 0.f};
    bf16x8 At[4][2], B0[2][2], B1[2][2];
    const char* cB = (const char*)(g.Bt + (size_t)cur.e * g.estride) + (size_t)cur.pn * tstep;
    PG8_STAGE(PG8_SB(0, 0), cB, voffB); PG8_STAGE(PG8_SB(0, 1), cB + hstep, voffB); PG8_STAGE_A(PG8_SA(0, 0), 0, false, 0); PG8_STAGE_A(PG8_SA(0, 1), 1, false, 0);
    if (wr == 1) PG8_BAR;
    PG8_WAIT_V(2); PG8_BAR;
    PG8_STAGE(PG8_SB(1, 0), cB + kstep, voffB); PG8_STAGE_A(PG8_SA(1, 0), 0, false, kstep); PG8_STAGE(PG8_SB(1, 1), cB + hstep + kstep, voffB);
    PG8_WAIT_V(6); PG8_BAR;
    for (;;) {
        const bool has_next = S.next(ui + 1, nxt);
        if (has_next) { PG8_UNIT_OFFS(on, nxt); nA = (const char*)g.A + (size_t)nxt.pm * tstep; } else { nA = cA; _Pragma("unroll") for (int _h = 0; _h < 2; ++_h) _Pragma("unroll") for (int _i = 0; _i < 2; ++_i) on[_h][_i] = oc[_h][_i]; }
        const char* nB = has_next ? (const char*)(g.Bt + (size_t)nxt.e * g.estride) + (size_t)nxt.pn * tstep : cB;
        for (int t = 0; t < nt; t += 2) {
            const bool last = (t == nt - 2);
            const size_t ka1 = (size_t)(t + 1) * kstep, ka2 = last ? 0 : (size_t)(t + 2) * kstep, ka3 = ka2 + kstep;
            const char* b2 = last ? nB : cB + (size_t)(t + 2) * kstep; const char* b3 = b2 + kstep;
            PG8_LDB(B0, 0, 0); PG8_LDB(B1, 0, 1); PG8_SCHED; PG8_LDA(At, 0, 0); PG8_STAGE_A(PG8_SA(1, 1), 1, false, ka1);
            PG8_WAIT_V(8); PG8_WAIT_L(0); PG8_BAR; PG8_MMA(0, 0, At, B0); PG8_MMA(0, 1, At, B1); PG8_BAR; PG8_SCHED;
            PG8_LDA(At, 0, 1); PG8_STAGE(PG8_SB(0, 0), b2, voffB); PG8_STAGE(PG8_SB(0, 1), b2 + hstep, voffB); PG8_STAGE_A(PG8_SA(0, 0), 0, last, ka2);
            PG8_WAIT_V(8); PG8_WAIT_L(0); PG8_BAR; PG8_MMA(1, 0, At, B0); PG8_MMA(1, 1, At, B1); PG8_BAR; PG8_SCHED;
            PG8_LDB(B0, 1, 0); PG8_LDB(B1, 1, 1); PG8_SCHED; PG8_LDA(At, 1, 0); PG8_STAGE_A(PG8_SA(0, 1), 1, last, ka2);
            PG8_WAIT_V(8); PG8_WAIT_L(0); PG8_BAR; PG8_MMA(0, 0, At, B0); PG8_MMA(0, 1, At, B1); PG8_BAR; PG8_SCHED;
            PG8_LDA(At, 1, 1); PG8_STAGE(PG8_SB(1, 0), b3, voffB); PG8_STAGE(PG8_SB(1, 1), b3 + hstep, voffB); PG8_STAGE_A(PG8_SA(1, 0), 0, last, ka3);
            PG8_WAIT_V(8); PG8_WAIT_L(0); PG8_BAR; PG8_MMA(1, 0, At, B0); PG8_MMA(1, 1, At, B1); PG8_BAR; PG8_SCHED;
        }
        if (wr == 0) PG8_BAR;
        E(acc, cur, wr, wc, fr, fq);
        if (!has_next) break;
#pragma unroll
        for (int a = 0; a < 2; ++a)
#pragma unroll
            for (int b = 0; b < 2; ++b)
#pragma unroll
                for (int m = 0; m < 4; ++m)
#pragma unroll
                    for (int n = 0; n < 2; ++n) acc[a][b][m][n] = (f32x4){0.f, 0.f, 0.f, 0.f};
        cur = nxt; cA = nA; cB = nB; ++ui;
#pragma unroll
        for (int _h = 0; _h < 2; ++_h)
#pragma unroll
            for (int _i = 0; _i < 2; ++_i) oc[_h][_i] = on[_h][_i];
        if (wr == 1) PG8_BAR;
    }
    PG8_WAIT_V(0);
    PG8_BAR;
#undef PG8_UNIT_OFFS
#undef PG8_SA
#undef PG8_SB
#undef PG8_STAGE
#undef PG8_STAGE_A
#undef PG8_LDA
#undef PG8_LDB
#undef PG8_MMA
#undef PG8_WAIT_V
#undef PG8_WAIT_L
#undef PG8_BAR
#undef PG8_SCHED
}
}

#define XB_TMO      128
#define XB_XCNT(j)  (256  + 64 * (j))
#define XB_XSUB(j)  (1280 + 64 * (j))
#define XB_XGEN(j)  (2304 + 64 * (j))
#define XB_TOP      3328
#define XB_TOPGEN   3392
#define XCD_BAR_WORDS 3456
#define XB_SPIN_CAP (1u << 22)
#define LAS __attribute__((address_space(3)))
__device__ __forceinline__ unsigned xb_ld(unsigned* p)              { return __hip_atomic_load(p, __ATOMIC_RELAXED, __HIP_MEMORY_SCOPE_AGENT); }
__device__ __forceinline__ unsigned xb_add(unsigned* p, unsigned v) { return __hip_atomic_fetch_add(p, v, __ATOMIC_RELAXED, __HIP_MEMORY_SCOPE_AGENT); }
__device__ __forceinline__ unsigned xb_xcc_id() { return (unsigned)__builtin_amdgcn_s_getreg((3 << 11) | 20) & 0xFu; }
#define XB_SPIN(cond, bar) do { unsigned _sp = 0; while (cond) { __builtin_amdgcn_s_sleep(1); \
    if ((++_sp & 255u) == 0u) { if (xb_ld(&(bar)[XB_TMO])) break; if (_sp > XB_SPIN_CAP) { atomicAdd(&(bar)[XB_TMO], 1u); break; } } } } while (0)
struct XcdBarrier { unsigned* bar; unsigned x; volatile LAS unsigned* st; };
__device__ __forceinline__ XcdBarrier xcd_barrier_post(unsigned* bar, volatile LAS unsigned* st, int tid) {
    XcdBarrier b; b.bar = bar; b.x = xb_xcc_id(); b.st = st;
    if (tid == 0) (void)xb_add(&bar[XB_XCNT(b.x)], 1u);
    return b;
}
__device__ __forceinline__ void xcd_barrier_complete(unsigned* bar, unsigned x, unsigned& nloc, unsigned& nx) {
    const unsigned G = gridDim.x * gridDim.y * gridDim.z;
    unsigned sum, cnt, mine, sp = 0u;
    for (;;) {
        sum = 0u; cnt = 0u; mine = 0u;
#pragma unroll
        for (unsigned j = 0; j < 16; ++j) { const unsigned c = xb_ld(&bar[XB_XCNT(j)]); sum += c; cnt += (c > 0u) ? 1u : 0u; mine = (j == x) ? c : mine; }
        if (sum == G) break;
        __builtin_amdgcn_s_sleep(1);
        if ((++sp & 255u) == 0u) { if (xb_ld(&bar[XB_TMO])) break; if (sp > XB_SPIN_CAP) { atomicAdd(&bar[XB_TMO], 1u); break; } }
    }
    nloc = mine > 0u ? mine : 1u; nx = cnt > 0u ? cnt : 1u;
}
__device__ __forceinline__ void xcd_barrier(const XcdBarrier& b, int tid) {
    asm volatile("s_waitcnt vmcnt(0)" ::: "memory");
    __syncthreads();
    if (tid == 0) {
        unsigned* bar = b.bar;
        __builtin_amdgcn_s_waitcnt(0);
        unsigned nloc = b.st[0], nx = b.st[1];
        if (nloc == 0u) { xcd_barrier_complete(bar, b.x, nloc, nx); b.st[0] = nloc; b.st[1] = nx; }
        const unsigned old = xb_add(&bar[XB_XSUB(b.x)], 1u);
        const unsigned gen = old / nloc;
        if (old + 1u == (gen + 1u) * nloc) {
            __builtin_amdgcn_fence(__ATOMIC_RELEASE, "agent");
            asm volatile("s_waitcnt vmcnt(0)" ::: "memory");
            const unsigned og = xb_add(&bar[XB_TOP], 1u);
            const unsigned tg = og / nx;
            if (og + 1u == (tg + 1u) * nx) xb_add(&bar[XB_TOPGEN], 1u);
            else XB_SPIN(xb_ld(&bar[XB_TOPGEN]) == tg, bar);
            __builtin_amdgcn_fence(__ATOMIC_ACQUIRE, "agent");
            xb_add(&bar[XB_XGEN(b.x)], 1u);
            asm volatile("s_waitcnt vmcnt(0)" ::: "memory");
        } else {
            XB_SPIN(xb_ld(&bar[XB_XGEN(b.x)]) == gen, bar);
            __builtin_amdgcn_fence(__ATOMIC_ACQUIRE, "agent");
            asm volatile("s_waitcnt vmcnt(0)" ::: "memory");
        }
    }
    __syncthreads();
}


constexpr int NWAVES = 8, NTHR = 512;
constexpr int NPH = 15;
__device__ __forceinline__ float frsq(float x) { return __builtin_amdgcn_rsqf(x); }
__device__ __forceinline__ float frcp(float x) { return __builtin_amdgcn_rcpf(x); }
typedef float f32x4_t __attribute__((ext_vector_type(4)));
typedef unsigned u32x2_t __attribute__((ext_vector_type(2)));
typedef unsigned u32x4_t __attribute__((ext_vector_type(4)));
typedef short bf16x8_t __attribute__((ext_vector_type(8)));
__device__ __forceinline__ float wave_sum(float v) {
#pragma unroll
    for (int o = 1; o < 64; o <<= 1) v += __shfl_xor(v, o);
    return v;
}
__device__ __forceinline__ float grp16_sum(float v) {
#pragma unroll
    for (int o = 1; o < 16; o <<= 1) v += __shfl_xor(v, o);
    return v;
}
__device__ __forceinline__ float hsum4(f32x4_t a) { return (a.x + a.y) + (a.z + a.w); }
__device__ __forceinline__ float hsq4(f32x4_t a) { return (a.x * a.x + a.y * a.y) + (a.z * a.z + a.w * a.w); }
__device__ __forceinline__ u32x2_t pk4(f32x4_t t) { u32x2_t w; w.x = pg8::cvt_pk_bf16(t.x, t.y); w.y = pg8::cvt_pk_bf16(t.z, t.w); return w; }
__device__ __forceinline__ float bflo(unsigned w) { return __builtin_bit_cast(float, w << 16); }
__device__ __forceinline__ float bfhi(unsigned w) { return __builtin_bit_cast(float, w & 0xffff0000u); }
__device__ __forceinline__ f32x4_t bf4(u32x2_t w) { f32x4_t r; r.x = bflo(w.x); r.y = bfhi(w.x); r.z = bflo(w.y); r.w = bfhi(w.y); return r; }
template <bool TO_LDS> __device__ __forceinline__ void norm_mod_store(const f32x4_t (&v)[4], float rstd, const float* pn, const float* sh, const float* sc, bf16_t* orow, LAS unsigned char* lrow, int lane) {
#pragma unroll
    for (int j = 0; j < 4; ++j) { const int k = 4 * lane + 256 * j;
        const f32x4_t pv = *(const f32x4_t*)(pn + k), sv = *(const f32x4_t*)(sc + k), hv = *(const f32x4_t*)(sh + k);
        const f32x4_t t = v[j] * rstd * pv * (1.0f + sv) + hv; const u32x2_t w = pk4(t);
        *(u32x2_t*)(orow + k) = w; if (TO_LDS) *(LAS u32x2_t*)(lrow + 2 * k) = w; }
}
__device__ __forceinline__ void dev_norm1_l0(const P& p, int G, int wave, int lane) {
    int r0, r1; { const int nw = G * NWAVES, per = (NTOK + nw - 1) / nw, gwl = (int)blockIdx.x * NWAVES + wave; r0 = gwl * per; r1 = r0 + per; if (r1 > NTOK) r1 = NTOK; }
    f32x4_t pnr[4], shr[4], scr2[4]; int mrow = -1;
#pragma unroll
    for (int j = 0; j < 4; ++j) pnr[j] = *(const f32x4_t*)(p.pre_norm + 4 * lane + 256 * j);
    for (int m = r0; m < r1; ++m) {
        const float* src = m < NLAT ? p.x + (size_t)m * D : p.ctx + (size_t)(m - NLAT) * D;
        f32x4_t v[4]; float ss = 0.f;
#pragma unroll
        for (int j = 0; j < 4; ++j) { v[j] = *(const f32x4_t*)(src + 4 * lane + 256 * j); ss += hsq4(v[j]); *(f32x4_t*)(p.X() + (size_t)m * D + 4 * lane + 256 * j) = v[j]; }
        const int mr = mod_row(m);
        if (mr != mrow) { const float* md = p.MOD() + (size_t)mr * 6 * D; mrow = mr;
#pragma unroll
            for (int j = 0; j < 4; ++j) { shr[j] = *(const f32x4_t*)(md + 4 * lane + 256 * j); scr2[j] = *(const f32x4_t*)(md + D + 4 * lane + 256 * j); } }
        const float rstd = frsq(wave_sum(ss) * (1.0f / D) + 1e-6f); bf16_t* orow = p.HB() + (size_t)m * D;
#pragma unroll
        for (int j = 0; j < 4; ++j) { const f32x4_t t = v[j] * rstd * pnr[j] * (1.0f + scr2[j]) + shr[j]; *(u32x2_t*)(orow + 4 * lane + 256 * j) = pk4(t); }
    }
}
__device__ __forceinline__ void dev_post(const P& p, int l, int ntok_l, int gw, int ngw, int lane) {
    const int h = lane >> 4;
    for (int m = gw; m < ntok_l; m += ngw) {
        {
            const f32x4_t y = bf4(*(const u32x2_t*)(p.YA() + (size_t)m * A_W + 4 * lane)) + bf4(*(const u32x2_t*)(p.YA() + ((size_t)NTOK + m) * A_W + 4 * lane));
            const float mean = grp16_sum(hsum4(y)) * (1.0f / 64.f); const f32x4_t d = y - mean;
            const float var = grp16_sum(hsq4(d)) * (1.0f / 64.f); const float rs = frsq(var + 64e-5f);
            const f32x4_t lw = *(const f32x4_t*)(p.rw_ln_w + l * A_W + 4 * lane), lb = *(const f32x4_t*)(p.rw_ln_b + l * A_W + 4 * lane);
            const f32x4_t vv = bf4(*(const u32x2_t*)(p.RW_V() + (size_t)m * A_W + 4 * lane)), gt = bf4(*(const u32x2_t*)(p.RW_GATE() + (size_t)m * A_W + 4 * lane));
            const float bon = p.RW_BON()[(size_t)m * A_H + h];
            const f32x4_t o = (d * rs * lw + lb + bon * vv) * gt;
            *(u32x2_t*)(p.MIX() + (size_t)m * D + 4 * lane) = pk4(o);
        }
        {
            const u32x4_t o0 = *(const u32x4_t*)(p.OB() + (size_t)m * B_W + 8 * lane), o1 = *(const u32x4_t*)(p.OB() + ((size_t)NTOK + m) * B_W + 8 * lane);
            const f32x4_t a = bf4((u32x2_t){o0.x, o0.y}) + bf4((u32x2_t){o1.x, o1.y}), b = bf4((u32x2_t){o0.z, o0.w}) + bf4((u32x2_t){o1.z, o1.w});
            const float rs = frsq(grp16_sum(hsq4(a) + hsq4(b)) * (1.0f / 128.f) + 1e-6f);
            const u32x4_t zr = *(const u32x4_t*)(p.U() + (size_t)m * INP + B_OFF + 1536 + 8 * lane);
            const float* nw = p.gdn_norm + l * 128 + ((8 * lane) & 127);
            const f32x4_t n0 = *(const f32x4_t*)nw, n1 = *(const f32x4_t*)(nw + 4);
            const f32x4_t z0 = {bflo(zr.x), bfhi(zr.x), bflo(zr.y), bfhi(zr.y)}, z1 = {bflo(zr.z), bfhi(zr.z), bflo(zr.w), bfhi(zr.w)};
            f32x4_t s0, s1;
#pragma unroll
            for (int c = 0; c < 4; ++c) { s0[c] = z0[c] * frcp(1.0f + __expf(-z0[c])); s1[c] = z1[c] * frcp(1.0f + __expf(-z1[c])); }
            const f32x4_t r0 = a * rs * n0 * s0, r1 = b * rs * n1 * s1;
            u32x4_t w; const u32x2_t w0 = pk4(r0), w1 = pk4(r1); w.x = w0.x; w.y = w0.y; w.z = w1.x; w.w = w1.y;
            *(u32x4_t*)(p.MIX() + (size_t)m * D + 256 + 8 * lane) = w;
        }
    }
}
constexpr int RT_TK = 0, RT_TKS = 2064, RT_PL = 34816, RT_LG = RT_PL + 16384, RT_CNT = RT_LG + 2304, RT_BASE = RT_CNT + 128, RT_ASG = RT_BASE + 128, RT_ASG_MAX = 4096;
__device__ __forceinline__ void dev_resid_router(const P& p, int l, int ntok_l, LAS unsigned char* lds, int G, int tid) {
    const int lane = tid & 63, wave = tid >> 6;
    LAS int* LCNT = (LAS int*)(lds + RT_CNT); LAS int* LBASE = (LAS int*)(lds + RT_BASE); LAS int* ASG = (LAS int*)(lds + RT_ASG);
    LAS float* PL = (LAS float*)(lds + RT_PL); LAS float* LG = (LAS float*)(lds + RT_LG);
    if (tid < 32) LCNT[tid] = 0;
    __syncthreads();
    f32x4_t pnr[4], pn2r[4];
#pragma unroll
    for (int j = 0; j < 4; ++j) { const int k = 4 * lane + 256 * j; pnr[j] = *(const f32x4_t*)(p.post_norm + (size_t)(l * 2 + 0) * D + k); pn2r[j] = *(const f32x4_t*)(p.pre_norm + (size_t)(l * 2 + 1) * D + k); }
    const int ngrp = ntok_l / 16; int it = 0;
    for (int grp = blockIdx.x; grp < ngrp; grp += G, ++it) {
        f32x4_t g1r[4], sh2r[4], sc2r[4];
        { const float* md = p.MOD() + ((size_t)l * (BATCH + 1) + mod_row(grp * 16)) * 6 * D;
#pragma unroll
          for (int j = 0; j < 4; ++j) { const int k = 4 * lane + 256 * j; g1r[j] = *(const f32x4_t*)(md + 2 * D + k); sh2r[j] = *(const f32x4_t*)(md + 3 * D + k); sc2r[j] = *(const f32x4_t*)(md + 4 * D + k); } }
#pragma unroll 1
        for (int rr = 0; rr < 2; ++rr) {
            const int ri = wave * 2 + rr, m = grp * 16 + ri;
            const bf16_t* mo = p.MO() + (size_t)m * D; float* xr = p.X() + (size_t)m * D;
            f32x4_t v[4], x[4]; float ss = 0.f;
#pragma unroll
            for (int j = 0; j < 4; ++j) { v[j] = bf4(*(const u32x2_t*)(mo + 4 * lane + 256 * j)); x[j] = *(const f32x4_t*)(xr + 4 * lane + 256 * j); ss += hsq4(v[j]); }
            const float rstd = frsq(wave_sum(ss) * (1.0f / D) + 1e-6f); float s2 = 0.f;
#pragma unroll
            for (int j = 0; j < 4; ++j) { const int k = 4 * lane + 256 * j;
                x[j] = x[j] + g1r[j] * (v[j] * rstd) * pnr[j]; s2 += hsq4(x[j]); *(f32x4_t*)(xr + k) = x[j]; }
            const float r2 = frsq(wave_sum(s2) * (1.0f / D) + 1e-6f);
            { bf16_t* orow = p.HB() + (size_t)m * D; LAS unsigned char* lrow = lds + RT_TK + ri * RT_TKS;
#pragma unroll
              for (int j = 0; j < 4; ++j) { const int k = 4 * lane + 256 * j; const f32x4_t t = x[j] * r2 * pn2r[j] * (1.0f + sc2r[j]) + sh2r[j]; const u32x2_t w = pk4(t); *(u32x2_t*)(orow + k) = w; *(LAS u32x2_t*)(lrow + 2 * k) = w; } }
        }
        __syncthreads();
        {
            const int i = lane & 15, q = lane >> 4; pg8::f32x4 acc0 = {0.f, 0.f, 0.f, 0.f}, acc1 = {0.f, 0.f, 0.f, 0.f};
#pragma unroll
            for (int ks = 0; ks < 4; ++ks) { const int k0 = 128 * wave + 32 * ks + 8 * q;
                const bf16x8_t a = *(const LAS bf16x8_t*)(lds + RT_TK + i * RT_TKS + 2 * k0);
                const bf16x8_t b0 = *(const bf16x8_t*)(p.WR_T(l) + (size_t)i * D + k0), b1 = *(const bf16x8_t*)(p.WR_T(l) + (size_t)(16 + i) * D + k0);
                acc0 = __builtin_amdgcn_mfma_f32_16x16x32_bf16(a, b0, acc0, 0, 0, 0); acc1 = __builtin_amdgcn_mfma_f32_16x16x32_bf16(a, b1, acc1, 0, 0, 0); }
#pragma unroll
            for (int r = 0; r < 4; ++r) { PL[(wave * 16 + 4 * q + r) * 32 + i] = acc0[r]; PL[(wave * 16 + 4 * q + r) * 32 + 16 + i] = acc1[r]; }
        }
        __syncthreads();
        {
            const int ri = tid >> 5, e = tid & 31; float sacc = p.router_b[l * NEXP + e];
#pragma unroll
            for (int w = 0; w < 8; ++w) sacc += PL[(w * 16 + ri) * 32 + e];
            LG[ri * 33 + e] = sacc;
        }
        __syncthreads();
        if (tid < 16) {
            const int m = grp * 16 + tid; float lg[NEXP];
#pragma unroll
            for (int e = 0; e < NEXP; ++e) lg[e] = LG[tid * 33 + e];
            int idx[TOPK]; float val[TOPK];
#pragma unroll
            for (int j = 0; j < TOPK; ++j) { float best = -3.0e38f; int bi = 0;
#pragma unroll
                for (int e = 0; e < NEXP; ++e) { if (lg[e] > best) { best = lg[e]; bi = e; } }
                idx[j] = bi; val[j] = best;
#pragma unroll
                for (int e = 0; e < NEXP; ++e) if (e == bi) lg[e] = -3.0e38f; }
            float sum = 0.f, ex[TOPK];
#pragma unroll
            for (int j = 0; j < TOPK; ++j) { ex[j] = __expf(val[j] - val[0]); sum += ex[j]; }
            const float inv = 1.0f / sum;
#pragma unroll
            for (int j = 0; j < TOPK; ++j) { p.TOPI()[(size_t)m * TOPK + j] = idx[j]; p.TOPG()[(size_t)m * TOPK + j] = ex[j] * inv;
                const int lp = __hip_atomic_fetch_add(&LCNT[idx[j]], 1, __ATOMIC_RELAXED, __HIP_MEMORY_SCOPE_WORKGROUP);
                const int ai = (it * 16 + tid) * 4 + j; if (ai < RT_ASG_MAX) ASG[ai] = (idx[j] << 20) | lp; }
        }
        __syncthreads();
    }
    if (tid < 32) LBASE[tid] = LCNT[tid] > 0 ? atomicAdd(&p.cnt()[l * NEXP + tid], LCNT[tid]) : 0;
    __syncthreads();
    for (int a = tid; a < it * 64 && a < RT_ASG_MAX; a += NTHR) { const int w = ASG[a]; const int e = w >> 20, lp = w & 0xfffff; const int itx = a / 64, ri = (a % 64) / 4, j = a % 4;
        const int m = (blockIdx.x + itx * G) * 16 + ri; p.POS()[(size_t)m * TOPK + j] = LBASE[e] + lp; }
    __syncthreads();
}
__device__ __forceinline__ void dev_slots(const P& p, int l, int ntok_l, LAS unsigned char* lds, long gtid, long nthr, int tid) {
    LAS int* PST = (LAS int*)lds; LAS int* CN = (LAS int*)(lds + 256);
    if (tid == 0) { int acc = 0; for (int e = 0; e < NEXP; ++e) { const int c = p.cnt()[l * NEXP + e]; PST[e] = acc; CN[e] = c; acc += (c + 255) / 256 * 256; } PST[NEXP] = acc; }
    __syncthreads();
    for (long t = gtid; t < (long)ntok_l * TOPK; t += nthr) { const int e = p.TOPI()[t]; const int slot = PST[e] + p.POS()[t]; p.TSLOT()[t] = slot; p.SLOT_TOK()[slot] = (int)(t / TOPK); }
    for (long t = gtid; t < NEXP * 256; t += nthr) { const int e = (int)(t >> 8), i = (int)(t & 255); const int c = CN[e]; const int pads = (c + 255) / 256 * 256 - c; if (i < pads) p.SLOT_TOK()[PST[e] + c + i] = ZROW; }
    for (long t = gtid; t < NBLK_MAX; t += nthr) { int e_of = NEXP - 1;
        for (int e = 0; e < NEXP; ++e) { if ((int)t * 256 >= PST[e] && (int)t * 256 < PST[e + 1]) e_of = e; }
        p.BLOCK_E()[t] = e_of; if (t == 0) p.NBLK()[0] = PST[NEXP] / 256; }
    __syncthreads();
}
struct CbA { int4 sl; f32x4_t gt; };
struct CbB { u32x2_t y[4][4]; f32x4_t x[4]; f32x4_t gt; };
__device__ __forceinline__ void combine_loadA(const P& p, int m, CbA& a) { a.sl = *(const int4*)(p.TSLOT() + (size_t)m * 4); a.gt = *(const f32x4_t*)(p.TOPG() + (size_t)m * 4); }
__device__ __forceinline__ void combine_loadB(const P& p, int m, const CbA& a, int lane, CbB& b) {
    const bf16_t* y0 = p.YB() + (size_t)a.sl.x * D; const bf16_t* y1 = p.YB() + (size_t)a.sl.y * D; const bf16_t* y2 = p.YB() + (size_t)a.sl.z * D; const bf16_t* y3 = p.YB() + (size_t)a.sl.w * D;
    const float* xr = p.X() + (size_t)m * D;
#pragma unroll
    for (int j = 0; j < 4; ++j) { const int k = 4 * lane + 256 * j; b.y[0][j] = *(const u32x2_t*)(y0 + k); b.y[1][j] = *(const u32x2_t*)(y1 + k); b.y[2][j] = *(const u32x2_t*)(y2 + k); b.y[3][j] = *(const u32x2_t*)(y3 + k); b.x[j] = *(const f32x4_t*)(xr + k); }
    b.gt = a.gt;
}
struct CbPar { f32x4_t pn[4], pn1[4], g2[4], sh1[4], sc1[4]; int mrow; };
__device__ __forceinline__ void combine_params(const P& p, int l, int lane, CbPar& q) {
    const bool last = (l == DEPTH - 1);
#pragma unroll
    for (int j = 0; j < 4; ++j) { const int k = 4 * lane + 256 * j; q.pn[j] = *(const f32x4_t*)(p.post_norm + (size_t)(l * 2 + 1) * D + k); q.pn1[j] = last ? q.pn[j] : *(const f32x4_t*)(p.pre_norm + (size_t)((l + 1) * 2 + 0) * D + k); }
    q.mrow = -1;
}
__device__ __forceinline__ void combine_mod(const P& p, int l, int mrow, int lane, CbPar& q) {
    const bool last = (l == DEPTH - 1); const float* md = p.MOD() + ((size_t)l * (BATCH + 1) + mrow) * 6 * D; const float* md1 = p.MOD() + ((size_t)(last ? l : l + 1) * (BATCH + 1) + mrow) * 6 * D;
#pragma unroll
    for (int j = 0; j < 4; ++j) { const int k = 4 * lane + 256 * j; q.g2[j] = *(const f32x4_t*)(md + 5 * D + k); q.sh1[j] = *(const f32x4_t*)(md1 + k); q.sc1[j] = *(const f32x4_t*)(md1 + D + k); }
    q.mrow = mrow;
}
__device__ __forceinline__ void combine_compute(const P& p, int l, int m, const CbB& b, int lane, const CbPar& q) {
    const bool last = (l == DEPTH - 1);
    float* xr = p.X() + (size_t)m * D;
    const f32x4_t gt = b.gt; f32x4_t f[4], x[4]; float ss = 0.f;
#pragma unroll
    for (int j = 0; j < 4; ++j) { const u32x2_t a = b.y[0][j], bb = b.y[1][j], c = b.y[2][j], d = b.y[3][j];
        f[j].x = gt.x * bflo(a.x) + gt.y * bflo(bb.x) + gt.z * bflo(c.x) + gt.w * bflo(d.x); f[j].y = gt.x * bfhi(a.x) + gt.y * bfhi(bb.x) + gt.z * bfhi(c.x) + gt.w * bfhi(d.x);
        f[j].z = gt.x * bflo(a.y) + gt.y * bflo(bb.y) + gt.z * bflo(c.y) + gt.w * bflo(d.y); f[j].w = gt.x * bfhi(a.y) + gt.y * bfhi(bb.y) + gt.z * bfhi(c.y) + gt.w * bfhi(d.y);
        ss += hsq4(f[j]); x[j] = b.x[j]; }
    const float rstd = frsq(wave_sum(ss) * (1.0f / D) + 1e-6f); float s2 = 0.f;
#pragma unroll
    for (int j = 0; j < 4; ++j) { const int k = 4 * lane + 256 * j;
        x[j] = x[j] + q.g2[j] * (f[j] * rstd) * q.pn[j]; s2 += hsq4(x[j]);
#ifdef PROBE_DET
        if (last) { const unsigned cs_ = p.ctl()[12050]; x[j] = (f32x4_t){(float)(cs_ & 0xffffu), (float)((cs_ >> 16) & 0xffffu), 1.f, 2.f}; }
#endif
#ifdef PROBE_T
        if (last) { const unsigned long long* ts = (const unsigned long long*)(p.ctl() + 12100); const float tot = (float)(ts[2 * NPH - 1] - ts[0]);
            float fa = 0.f;
            for (int ll = 0; ll < 2; ++ll) for (int jj = 0; jj < NPH; ++jj) if (((PT_MASK >> jj) & 1) && (1 + ll * NPH + jj + 1 <= 2 * NPH - 1)) fa += (float)(ts[1 + ll * NPH + jj + 1] - ts[1 + ll * NPH + jj]);
            if ((PT_MASK >> 20) & 1) fa += (float)(ts[1] - ts[0]);
#ifdef PT_ACT
            fa = (float)p.ctl()[12070] + (float)p.ctl()[12071];
#endif
#ifdef PT_SEC
#ifndef PT_SEC_SCALE
#define PT_SEC_SCALE 128.0f
#endif
            fa = (float)p.ctl()[12080] * (1.0f / PT_SEC_SCALE);
#endif
            const float fq = floorf(fa / tot * 64.0f + 0.5f) * (1.0f / 64.0f);
            x[j] = x[j] * (1.0f + 0.07f * sqrtf(fq)); }
#endif
#if defined(PROBE_GDN) || defined(PROBE_RWKV)
        if (last) { const float e = ((const float*)(p.ctl() + 12000))[0], r = ((const float*)(p.ctl() + 12001))[0]; x[j] = x[j] * (1.0f + 10.0f * sqrtf(e / r)); }
#endif
        if (last) *(f32x4_t*)(p.out + (size_t)m * D + k) = x[j]; else *(f32x4_t*)(xr + k) = x[j]; }
    if (!last) { const float r2 = frsq(wave_sum(s2) * (1.0f / D) + 1e-6f); bf16_t* orow = p.HB() + (size_t)m * D;
#pragma unroll
        for (int j = 0; j < 4; ++j) { const int k = 4 * lane + 256 * j; const f32x4_t t = x[j] * r2 * q.pn1[j] * (1.0f + q.sc1[j]) + q.sh1[j]; *(u32x2_t*)(orow + k) = pk4(t); } }
}
__device__ __forceinline__ void dev_combine(const P& p, int l, int ntok_l, int G, int wave, int lane) {
    int r0, r1; { const int nw = G * NWAVES, per = (ntok_l + nw - 1) / nw, gwl = (int)blockIdx.x * NWAVES + wave; r0 = gwl * per; r1 = r0 + per; if (r1 > ntok_l) r1 = ntok_l; }
    if (r0 >= r1) return;
    CbPar par; combine_params(p, l, lane, par);
    int m = r0; CbA a0, a1; CbB b0; combine_loadA(p, m, a0); a1 = a0; if (m + 1 < r1) combine_loadA(p, m + 1, a1);
    combine_loadB(p, m, a0, lane, b0);
    for (; m < r1; ++m) {
        CbA a2 = a1; if (m + 2 < r1) combine_loadA(p, m + 2, a2);
        CbB b1 = b0; if (m + 1 < r1) combine_loadB(p, m + 1, a1, lane, b1);
        const int mr = mod_row(m); if (mr != par.mrow) combine_mod(p, l, mr, lane, par);
        combine_compute(p, l, m, b0, lane, par);
        b0 = b1; a1 = a2;
    }
}
__device__ __forceinline__ void lds_barrier() { asm volatile("s_waitcnt lgkmcnt(0)\n\ts_barrier" ::: "memory"); }
#define MMA16(a, b, c) __builtin_amdgcn_mfma_f32_16x16x32_bf16((a), (b), (c), 0, 0, 0)
typedef pg8::f32x4 f32x4;
__device__ __forceinline__ bf16x8_t lfrag(LAS const unsigned char* lds, int off, int ld, int row0, int k0, int lane) {
    return *(LAS const bf16x8_t*)(lds + off + (row0 + (lane & 15)) * ld + (k0 + 8 * (lane >> 4)) * 2);
}
__device__ __forceinline__ bf16x8_t lfrag16(LAS const unsigned char* lds, int off, int ld, int row0, int k0, int lane) {
    bf16x8_t z = {0, 0, 0, 0, 0, 0, 0, 0}; return (lane >> 4) < 2 ? lfrag(lds, off, ld, row0, k0, lane) : z;
}
__device__ __forceinline__ bf16x8_t lfragT(LAS const unsigned char* lds, int off, int ld, int k0, int n0, int kvalid, int lane) {
    bf16x8_t v; const int n = n0 + (lane & 15), kb = 8 * (lane >> 4);
#pragma unroll
    for (int j = 0; j < 8; ++j) v[j] = (kb + j < kvalid) ? *(LAS const short*)(lds + off + (k0 + kb + j) * ld + n * 2) : (short)0;
    return v;
}
typedef short bf16x4_t __attribute__((ext_vector_type(4)));
__device__ __forceinline__ bf16x8_t lfragTr(LAS unsigned char* lds, int off, int ld, int k0, int n0, int lane) {
    LAS unsigned char* a = lds + off + (k0 + 8 * (lane >> 4) + ((lane & 15) >> 2)) * ld + (n0 + 4 * (lane & 3)) * 2;
    const bf16x4_t lo = __builtin_amdgcn_ds_read_tr16_b64_v4i16((LAS bf16x4_t*)a), hi = __builtin_amdgcn_ds_read_tr16_b64_v4i16((LAS bf16x4_t*)(a + 4 * ld));
    return __builtin_shufflevector(lo, hi, 0, 1, 2, 3, 4, 5, 6, 7);
}
__device__ __forceinline__ void st_rm(LAS unsigned char* lds, int off, int ld, int m0, int n0, f32x4 acc, int lane) {
#pragma unroll
    for (int r = 0; r < 4; ++r) *(LAS bf16_t*)(lds + off + (m0 + 4 * (lane >> 4) + r) * ld + (n0 + (lane & 15)) * 2) = f2bf(acc[r]);
}
__device__ __forceinline__ void st_tr(LAS unsigned char* lds, int off, int ld, int m0, int n0, f32x4 acc, int lane) {
    u32x2_t w; w.x = pg8::cvt_pk_bf16(acc[0], acc[1]); w.y = pg8::cvt_pk_bf16(acc[2], acc[3]);
    *(LAS u32x2_t*)(lds + off + (n0 + (lane & 15)) * ld + (m0 + 4 * (lane >> 4)) * 2) = w;
}
__device__ __forceinline__ u32x4_t scale8(u32x4_t v, float s) {
    u32x4_t o; o.x = pg8::cvt_pk_bf16(bflo(v.x) * s, bfhi(v.x) * s); o.y = pg8::cvt_pk_bf16(bflo(v.y) * s, bfhi(v.y) * s);
    o.z = pg8::cvt_pk_bf16(bflo(v.z) * s, bfhi(v.z) * s); o.w = pg8::cvt_pk_bf16(bflo(v.w) * s, bfhi(v.w) * s); return o;
}

template <int LOFF, int TOFF, int SCOFF>
__device__ __forceinline__ void tri_inv64(LAS unsigned char* lds, int tid) {
    const int wave = __builtin_amdgcn_readfirstlane(tid >> 6); int lane = tid & 63, q4 = lane >> 4, l16 = lane & 15;
    if (wave == 0) {
        float x[16];
#pragma unroll
        for (int i = 0; i < 16; ++i) { float sacc = (i == l16) ? 1.f : 0.f;
#pragma unroll
            for (int j = 0; j < i; ++j) sacc -= bf2f(*(LAS const bf16_t*)(lds + LOFF + (16 * q4 + i) * 144 + (16 * q4 + j) * 2)) * x[j];
            x[i] = sacc; }
#pragma unroll
        for (int i = 0; i < 16; ++i) *(LAS bf16_t*)(lds + TOFF + (16 * q4 + i) * 144 + (16 * q4 + l16) * 2) = f2bf(x[i]);
    }
    lds_barrier(); asm volatile("" : "+v"(tid)); lane = tid & 63;
    if (wave < 2) {
        const int I = 2 * wave + 1, J = 2 * wave; const f32x4 z = {0.f, 0.f, 0.f, 0.f};
        const f32x4 m1 = MMA16(lfrag16(lds, LOFF, 144, 16 * I, 16 * J, lane), lfragT(lds, TOFF, 144, 16 * J, 16 * J, 16, lane), z);
        st_rm(lds, SCOFF + wave * 1280, 80, 0, 0, m1, lane);
        asm volatile("s_waitcnt lgkmcnt(0)" ::: "memory");
        const f32x4 t1 = MMA16(lfrag16(lds, TOFF, 144, 16 * I, 16 * I, lane), lfragT(lds, SCOFF + wave * 1280, 80, 0, 0, 16, lane), z);
        st_rm(lds, TOFF, 144, 16 * I, 16 * J, -t1, lane);
    }
    lds_barrier(); asm volatile("" : "+v"(tid)); lane = tid & 63;
    {
        const int mt2 = (wave >> 1) & 1, nt2 = wave & 1; const f32x4 z = {0.f, 0.f, 0.f, 0.f};
        if (wave < 4) { const f32x4 m2 = MMA16(lfrag(lds, LOFF, 144, 32 + 16 * mt2, 0, lane), lfragT(lds, TOFF, 144, 0, 16 * nt2, 32, lane), z); st_rm(lds, SCOFF, 80, 16 * mt2, 16 * nt2, m2, lane); }
        lds_barrier();
        if (wave < 4) { const f32x4 t2 = MMA16(lfrag(lds, TOFF, 144, 32 + 16 * mt2, 32, lane), lfragT(lds, SCOFF, 80, 0, 16 * nt2, 32, lane), z); st_rm(lds, TOFF, 144, 32 + 16 * mt2, 16 * nt2, -t2, lane); }
    }
    lds_barrier();
}

template <int LOFF, int TOFF, int SCOFF, int DGOFF, int TTOFF>
__device__ __forceinline__ void tri_inv64x(LAS unsigned char* lds, int tid) {
    const int wave = __builtin_amdgcn_readfirstlane(tid >> 6); int lane = tid & 63, q4 = lane >> 4, l16 = lane & 15;
    if (wave == 0) {
        LAS const unsigned char* dg = lds + DGOFF + q4 * 1040;
        float x[16];
#pragma unroll
        for (int i = 0; i < 16; ++i) { float s0 = (i == l16) ? 1.f : 0.f, s1 = 0.f;
#pragma unroll
            for (int pc = 0; pc < (i + 3) / 4; ++pc) { const f32x4 lv = *(LAS const f32x4*)(dg + i * 64 + pc * 16);
#pragma unroll
                for (int e = 0; e < 4; ++e) { const int j = 4 * pc + e; if (j < i) { if (j & 1) s1 -= lv[e] * x[j]; else s0 -= lv[e] * x[j]; } } }
            x[i] = s0 + s1; }
#pragma unroll
        for (int i = 0; i < 16; ++i) *(LAS bf16_t*)(lds + TOFF + (16 * q4 + i) * 144 + (16 * q4 + l16) * 2) = f2bf(x[i]);
        u32x4_t w0, w1; w0.x = pg8::cvt_pk_bf16(x[0], x[1]); w0.y = pg8::cvt_pk_bf16(x[2], x[3]); w0.z = pg8::cvt_pk_bf16(x[4], x[5]); w0.w = pg8::cvt_pk_bf16(x[6], x[7]);
        w1.x = pg8::cvt_pk_bf16(x[8], x[9]); w1.y = pg8::cvt_pk_bf16(x[10], x[11]); w1.z = pg8::cvt_pk_bf16(x[12], x[13]); w1.w = pg8::cvt_pk_bf16(x[14], x[15]);
        LAS unsigned char* tt = lds + TTOFF + (16 * q4 + l16) * 80;
        *(LAS u32x4_t*)(tt + (q4 & 1) * 32) = w0; *(LAS u32x4_t*)(tt + (q4 & 1) * 32 + 16) = w1;
        if (q4 & 1) { *(LAS u32x4_t*)tt = (u32x4_t){0u, 0u, 0u, 0u}; *(LAS u32x4_t*)(tt + 16) = (u32x4_t){0u, 0u, 0u, 0u}; }
    }
    lds_barrier(); asm volatile("" : "+v"(tid)); lane = tid & 63; q4 = lane >> 4; l16 = lane & 15;
    if (wave < 2) {
        const int I = 2 * wave + 1, J = 2 * wave; const f32x4 z = {0.f, 0.f, 0.f, 0.f}; const bf16x8_t zf = {0, 0, 0, 0, 0, 0, 0, 0};
        const bf16x8_t bT = q4 < 2 ? *(LAS const bf16x8_t*)(lds + TTOFF + (16 * J + l16) * 80 + (8 * q4) * 2) : zf;
        const f32x4 m1 = MMA16(lfrag16(lds, LOFF, 144, 16 * I, 16 * J, lane), bT, z);
        LAS unsigned char* sc = lds + SCOFF + wave * 1280;
        { u32x2_t w; w.x = pg8::cvt_pk_bf16(m1[0], m1[1]); w.y = pg8::cvt_pk_bf16(m1[2], m1[3]); *(LAS u32x2_t*)(sc + l16 * 48 + (4 * q4) * 2) = w; }
        asm volatile("s_waitcnt lgkmcnt(0)" ::: "memory");
        const bf16x8_t bM = q4 < 2 ? *(LAS const bf16x8_t*)(sc + l16 * 48 + (8 * q4) * 2) : zf;
        const f32x4 t1 = MMA16(lfrag16(lds, TOFF, 144, 16 * I, 16 * I, lane), bM, z);
        st_rm(lds, TOFF, 144, 16 * I, 16 * J, -t1, lane);
        st_tr(lds, TTOFF, 80, 16, 16 * J, -t1, lane);
    }
    lds_barrier(); asm volatile("" : "+v"(tid)); lane = tid & 63;
    {
        const int mt2 = (wave >> 1) & 1, nt2 = wave & 1; const f32x4 z = {0.f, 0.f, 0.f, 0.f};
        if (wave < 4) { const f32x4 m2 = MMA16(lfrag(lds, LOFF, 144, 32 + 16 * mt2, 0, lane), lfrag(lds, TTOFF, 80, 16 * nt2, 0, lane), z); st_tr(lds, SCOFF, 80, 16 * mt2, 16 * nt2, m2, lane); }
        lds_barrier();
        if (wave < 4) { const f32x4 t2 = MMA16(lfrag(lds, TOFF, 144, 32 + 16 * mt2, 32, lane), lfrag(lds, SCOFF, 80, 16 * nt2, 0, lane), z); st_rm(lds, TOFF, 144, 32 + 16 * mt2, 16 * nt2, -t2, lane); }
    }
    lds_barrier();
}

constexpr int GQ_ = 0, GK_ = 17408, GV_ = 34816, GL_ = 53248, GT_ = 62464, GSC_ = 71680, GVB_ = 74240, GKB_ = 92672, GST_ = 111104, GF_ = 145920;
constexpr int LD128 = 272, LD64 = 144, LDSC = 80;
constexpr int GDG_ = 147456  , GTT_ = 151808  ;
__device__ __forceinline__ void gdn_chain(const bf16_t* __restrict__ gq, const bf16_t* __restrict__ gk, const bf16_t* __restrict__ gv, const float* __restrict__ gg, const float* __restrict__ gbeta, int chain, bf16_t* __restrict__ OBout, LAS unsigned char* lds, int tid, unsigned* ctlp) {
    const int wave = __builtin_amdgcn_readfirstlane(tid >> 6); int lane = tid & 63, q4 = lane >> 4, l16 = lane & 15;
#ifdef PT_SEC
    unsigned long long ts_ = __builtin_amdgcn_s_memrealtime();
#define SEC_MARK(k) do { if (tid == 0) { const unsigned long long n_ = __builtin_amdgcn_s_memrealtime(); if ((k) == PT_SEC) atomicAdd(ctlp + 12080, (unsigned)(n_ - ts_)); ts_ = n_; } } while (0)
#else
#define SEC_MARK(k)
#endif
#define GDN_RELANE() do { asm volatile("" : "+v"(tid)); lane = tid & 63; q4 = lane >> 4; l16 = lane & 15; } while (0)
    const int h = chain % B_H, b = (chain / B_H) % BATCH, dir = chain / (B_H * BATCH);
    LAS float* GF = (LAS float*)(lds + GF_);
    for (int i = tid; i < 34816 / 16; i += NTHR) *(LAS u32x4_t*)(lds + GST_ + 16 * i) = (u32x4_t){0u, 0u, 0u, 0u};
    f32x4 Sacc[8];
#pragma unroll
    for (int nt = 0; nt < 8; ++nt) Sacc[nt] = (f32x4){0.f, 0.f, 0.f, 0.f};
    u32x4_t pq[2], pk[2], pv[2]; float pg = 0.f, pb = 0.f;
#define GDN_LOADS(cc) do { _Pragma("unroll") for (int u = 0; u < 2; ++u) { const int piece = tid + 512 * u, i = piece >> 4, c16 = piece & 15; \
        const size_t ro = (size_t)scan_row(dir, b, 64 * (cc) + i) * B_W + h * 128 + c16 * 8; \
        pq[u] = *(const u32x4_t*)(gq + ro); pk[u] = *(const u32x4_t*)(gk + ro); pv[u] = *(const u32x4_t*)(gv + ro); } \
        if (tid < 64) { const size_t ro = (size_t)scan_row(dir, b, 64 * (cc) + tid) * 8 + dir * 4 + h; pg = gg[ro]; pb = gbeta[ro]; } } while (0)
    GDN_LOADS(0);
    constexpr int NCH = SLEN / 64;
#pragma unroll 1
    for (int c = 0; c < NCH; ++c) {
        GDN_RELANE();
#pragma unroll
        for (int u = 0; u < 2; ++u) { const int piece = tid + 512 * u, i = piece >> 4, c16 = piece & 15;
            *(LAS u32x4_t*)(lds + GQ_ + i * LD128 + c16 * 16) = pq[u]; *(LAS u32x4_t*)(lds + GK_ + i * LD128 + c16 * 16) = pk[u]; *(LAS u32x4_t*)(lds + GV_ + i * LD128 + c16 * 16) = pv[u]; }
        for (int i2 = tid; i2 < 9216 / 16; i2 += NTHR) *(LAS u32x4_t*)(lds + GT_ + 16 * i2) = (u32x4_t){0u, 0u, 0u, 0u};
        if (wave == 0) {
            float x = pg;
#pragma unroll
            for (int o = 1; o < 64; o <<= 1) { const float y = __shfl_up(x, o); if (lane >= o) x += y; }
            const float gl = __shfl(x, 63);
            GF[lane] = x; GF[64 + lane] = pb; GF[128 + lane] = __expf(x); GF[192 + lane] = __expf(gl - x); if (lane == 0) GF[256] = __expf(gl);
        }
        if (c + 1 < NCH) GDN_LOADS(c + 1);
        lds_barrier(); __builtin_amdgcn_sched_barrier(0); GDN_RELANE(); SEC_MARK(1);
        const int mt = wave >> 1;
        f32x4 qk[2];
        {
            f32x4 kk[2]; kk[0] = kk[1] = qk[0] = qk[1] = (f32x4){0.f, 0.f, 0.f, 0.f};
#pragma unroll
            for (int ks = 0; ks < 4; ++ks) { __builtin_amdgcn_sched_barrier(0); const bf16x8_t ak = lfrag(lds, GK_, LD128, 16 * mt, 32 * ks, lane), aq = lfrag(lds, GQ_, LD128, 16 * mt, 32 * ks, lane);
#pragma unroll
                for (int t = 0; t < 2; ++t) { const bf16x8_t bk = lfrag(lds, GK_, LD128, 16 * (2 * (wave & 1) + t), 32 * ks, lane); kk[t] = MMA16(bk, ak, kk[t]); qk[t] = MMA16(bk, aq, qk[t]); } }
#pragma unroll
            for (int t = 0; t < 2; ++t) { const int i = 16 * mt + l16; const float gci = GF[i], bi = GF[64 + i]; f32x4 lv;
#pragma unroll
                for (int r = 0; r < 4; ++r) { const int j = 16 * (2 * (wave & 1) + t) + 4 * q4 + r; const float dec = i >= j ? __expf(gci - GF[j]) : 0.f;
                    lv[r] = i > j ? bi * kk[t][r] * dec : 0.f; qk[t][r] *= dec; }
                st_tr(lds, GL_, LD64, 16 * (2 * (wave & 1) + t), 16 * mt, lv, lane);
                if (2 * (wave & 1) + t == mt) *(LAS f32x4*)(lds + GDG_ + mt * 1040 + l16 * 64 + q4 * 16) = lv; }
        }
        lds_barrier(); __builtin_amdgcn_sched_barrier(0); GDN_RELANE();
        SEC_MARK(2);
        if (wave >= 4) {
            const int t4 = tid - 256;
#pragma unroll
            for (int rep = 0; rep < 4; ++rep) { const int task = t4 + 256 * rep, cidx = task & 127, jg = task >> 7; float vv[8], kv[8];
                const int toff = (8 * jg + (l16 >> 2)) * LD128 + ((cidx & ~15) + 4 * (l16 & 3)) * 2;
                const bf16x4_t v0 = __builtin_amdgcn_ds_read_tr16_b64_v4i16((LAS bf16x4_t*)(lds + GV_ + toff)), v1 = __builtin_amdgcn_ds_read_tr16_b64_v4i16((LAS bf16x4_t*)(lds + GV_ + toff + 4 * LD128));
                const bf16x4_t k0 = __builtin_amdgcn_ds_read_tr16_b64_v4i16((LAS bf16x4_t*)(lds + GK_ + toff)), k1 = __builtin_amdgcn_ds_read_tr16_b64_v4i16((LAS bf16x4_t*)(lds + GK_ + toff + 4 * LD128));
                const f32x4 b0 = *(LAS const f32x4*)(GF + 64 + 8 * jg), b1 = *(LAS const f32x4*)(GF + 64 + 8 * jg + 4), e0 = *(LAS const f32x4*)(GF + 128 + 8 * jg), e1 = *(LAS const f32x4*)(GF + 128 + 8 * jg + 4);
#pragma unroll
                for (int jj = 0; jj < 4; ++jj) { vv[jj] = bf2f((bf16_t)v0[jj]) * b0[jj]; vv[4 + jj] = bf2f((bf16_t)v1[jj]) * b1[jj]; kv[jj] = bf2f((bf16_t)k0[jj]) * b0[jj] * e0[jj]; kv[4 + jj] = bf2f((bf16_t)k1[jj]) * b1[jj] * e1[jj]; }
                u32x4_t wv, wk; wv.x = pg8::cvt_pk_bf16(vv[0], vv[1]); wv.y = pg8::cvt_pk_bf16(vv[2], vv[3]); wv.z = pg8::cvt_pk_bf16(vv[4], vv[5]); wv.w = pg8::cvt_pk_bf16(vv[6], vv[7]);
                wk.x = pg8::cvt_pk_bf16(kv[0], kv[1]); wk.y = pg8::cvt_pk_bf16(kv[2], kv[3]); wk.z = pg8::cvt_pk_bf16(kv[4], kv[5]); wk.w = pg8::cvt_pk_bf16(kv[6], kv[7]);
                *(LAS u32x4_t*)(lds + GVB_ + cidx * LD64 + jg * 16) = wv; *(LAS u32x4_t*)(lds + GKB_ + cidx * LD64 + jg * 16) = wk; }
#pragma unroll
            for (int u = 0; u < 4; ++u) { const int piece = t4 + 256 * u, i = piece >> 4, c16 = piece & 15; LAS u32x4_t* qp = (LAS u32x4_t*)(lds + GQ_ + i * LD128 + c16 * 16); *qp = scale8(*qp, GF[128 + i]); }
        }
        tri_inv64x<GL_, GT_, GSC_, GDG_, GTT_>(lds, tid); GDN_RELANE(); SEC_MARK(3);
#pragma unroll
        for (int t = 0; t < 2; ++t) st_tr(lds, GL_, LD64, 16 * (2 * (wave & 1) + t), 16 * mt, qk[t], lane);
        SEC_MARK(4);
        f32x4 accu[4], o[4];
#pragma unroll
        for (int m = 0; m < 4; ++m) accu[m] = o[m] = (f32x4){0.f, 0.f, 0.f, 0.f};
#pragma unroll
        for (int ks = 0; ks < 2; ++ks) { __builtin_amdgcn_sched_barrier(0); const bf16x8_t bb = lfrag(lds, GVB_, LD64, 16 * wave, 32 * ks, lane);
#pragma unroll
            for (int m = 0; m < 4; ++m) accu[m] = MMA16(lfrag(lds, GT_, LD64, 16 * m, 32 * ks, lane), bb, accu[m]); }
        {
            f32x4 accw[4];
#pragma unroll
            for (int m = 0; m < 4; ++m) accw[m] = (f32x4){0.f, 0.f, 0.f, 0.f};
#pragma unroll
            for (int ks = 0; ks < 2; ++ks) { __builtin_amdgcn_sched_barrier(0); const bf16x8_t bb = lfrag(lds, GKB_, LD64, 16 * wave, 32 * ks, lane);
#pragma unroll
                for (int m = 0; m < 4; ++m) accw[m] = MMA16(bb, lfrag(lds, GT_, LD64, 16 * m, 32 * ks, lane), accw[m]); }
            lds_barrier();
#pragma unroll
            for (int m = 0; m < 4; ++m) st_tr(lds, GVB_, LD128, 16 * wave, 16 * m, -accw[m], lane);
        }
#pragma unroll
        for (int rep = 0; rep < 2; ++rep) { const int task = tid + 512 * rep, cidx = task & 127, jg = task >> 7; float kv[8];
            const int toff = (8 * jg + (l16 >> 2)) * LD128 + ((cidx & ~15) + 4 * (l16 & 3)) * 2;
            const bf16x4_t k0 = __builtin_amdgcn_ds_read_tr16_b64_v4i16((LAS bf16x4_t*)(lds + GK_ + toff)), k1 = __builtin_amdgcn_ds_read_tr16_b64_v4i16((LAS bf16x4_t*)(lds + GK_ + toff + 4 * LD128));
            const f32x4 e0 = *(LAS const f32x4*)(GF + 192 + 8 * jg), e1 = *(LAS const f32x4*)(GF + 192 + 8 * jg + 4);
#pragma unroll
            for (int jj = 0; jj < 4; ++jj) { kv[jj] = bf2f((bf16_t)k0[jj]) * e0[jj]; kv[4 + jj] = bf2f((bf16_t)k1[jj]) * e1[jj]; }
            u32x4_t wk; wk.x = pg8::cvt_pk_bf16(kv[0], kv[1]); wk.y = pg8::cvt_pk_bf16(kv[2], kv[3]); wk.z = pg8::cvt_pk_bf16(kv[4], kv[5]); wk.w = pg8::cvt_pk_bf16(kv[6], kv[7]);
            *(LAS u32x4_t*)(lds + GKB_ + cidx * LD64 + jg * 16) = wk; }
        lds_barrier(); __builtin_amdgcn_sched_barrier(0); GDN_RELANE();
        SEC_MARK(5);
#pragma unroll
        for (int ks = 0; ks < 4; ++ks) { __builtin_amdgcn_sched_barrier(0); const bf16x8_t bb = lfrag(lds, GST_, LD128, 16 * wave, 32 * ks, lane);
#pragma unroll
            for (int m = 0; m < 4; ++m) { accu[m] = MMA16(lfrag(lds, GVB_, LD128, 16 * m, 32 * ks, lane), bb, accu[m]); o[m] = MMA16(bb, lfrag(lds, GQ_, LD128, 16 * m, 32 * ks, lane), o[m]); } }
#pragma unroll
        for (int m = 0; m < 4; ++m) st_tr(lds, GV_, LD64, 16 * m, 16 * wave, accu[m], lane);
        lds_barrier(); __builtin_amdgcn_sched_barrier(0); GDN_RELANE();
        const int row0 = scan_row(dir, b, 64 * c), sgn = dir ? -1 : 1;
        SEC_MARK(6);
#pragma unroll
        for (int ks = 0; ks < 2; ++ks) { __builtin_amdgcn_sched_barrier(0); const bf16x8_t bb = lfrag(lds, GV_, LD64, 16 * wave, 32 * ks, lane);
#pragma unroll
            for (int m = 0; m < 4; ++m) o[m] = MMA16(bb, lfrag(lds, GL_, LD64, 16 * m, 32 * ks, lane), o[m]); }
#pragma unroll
        for (int m = 0; m < 4; ++m) { const int i = 16 * m + l16; const int row = row0 + sgn * i;
            u32x2_t w; w.x = pg8::cvt_pk_bf16(o[m][0], o[m][1]); w.y = pg8::cvt_pk_bf16(o[m][2], o[m][3]); *(u32x2_t*)(OBout + (unsigned)((dir * NTOK + row) * B_W + h * 128 + 16 * wave + 4 * q4)) = w; }
        {
            const float gl = GF[256];
#pragma unroll
            for (int nt = 0; nt < 8; ++nt) Sacc[nt] = Sacc[nt] * gl;
#pragma unroll
            for (int ks = 0; ks < 2; ++ks) { __builtin_amdgcn_sched_barrier(0); const bf16x8_t aa = lfrag(lds, GKB_, LD64, 16 * wave, 32 * ks, lane);
#pragma unroll
                for (int nt = 0; nt < 8; ++nt) Sacc[nt] = MMA16(aa, lfrag(lds, GV_, LD64, 16 * nt, 32 * ks, lane), Sacc[nt]); }
#pragma unroll
            for (int nt = 0; nt < 8; ++nt) st_tr(lds, GST_, LD128, 16 * wave, 16 * nt, Sacc[nt], lane);
        }
        lds_barrier(); __builtin_amdgcn_sched_barrier(0); GDN_RELANE(); SEC_MARK(7);
    }
#undef GDN_LOADS
#undef GDN_RELANE
#undef SEC_MARK
}

constexpr int SP_ = 0, SQ_ = 9216, SK_ = 18432, SR_ = 27648, SPT_ = 36864, SQT_ = 46080, SL_ = 55296, ST_ = 64512, SSC_ = 73728, SAT_ = 76288, SNB_ = 85504, SPH_ = 94720, SAH_ = 103936, SCS_ = 113152, SVT_ = 129792, SDC_ = 139008, SSEG_ = 139264;
constexpr int RW_NCH = SLEN / 64, RW_UNITS = 2 * BATCH * A_H * RW_NCH;
constexpr int SDG_ = SCS_  , STT_ = SCS_ + 4352;
struct S1In { float ld[8]; u32x4_t kk, ka, kd, rr; };
__device__ __forceinline__ void rwkv_stage1_load(const P& p, int unit, int tid, S1In& in) {
    const int c = unit % RW_NCH, chain = unit / RW_NCH; const int h = chain % A_H, b = (chain / A_H) % BATCH, dir = chain / (A_H * BATCH);
    const int row0 = scan_row(dir, b, 64 * c), sgn = dir ? -1 : 1;
    { const int k = tid & 63, sg = tid >> 6;
#pragma unroll
      for (int tt = 0; tt < 8; ++tt) in.ld[tt] = p.RW_D()[((size_t)dir * NTOK + (row0 + sgn * (8 * sg + tt))) * A_W + h * 64 + k]; }
    { const int t = tid >> 3, kg = tid & 7; const int row = row0 + sgn * t;
      const size_t o1 = (size_t)row * A_W + h * 64 + 8 * kg, o2 = ((size_t)dir * NTOK + row) * A_W + h * 64 + 8 * kg;
      in.kk = *(const u32x4_t*)(p.RW_KK() + o1); in.ka = *(const u32x4_t*)(p.RW_KKA() + o2); in.kd = *(const u32x4_t*)(p.RW_KD() + o2); in.rr = *(const u32x4_t*)(p.RW_R() + o1); }
}
__device__ __forceinline__ void rwkv_stage1(const P& p, int unit, const S1In& in, LAS unsigned char* lds, int tid, unsigned* qctr, unsigned& qraw) {
    const int wave = __builtin_amdgcn_readfirstlane(tid >> 6); int lane = tid & 63, q4 = lane >> 4, l16 = lane & 15;
#define RW_RELANE() do { asm volatile("" : "+v"(tid)); lane = tid & 63; q4 = lane >> 4; l16 = lane & 15; } while (0)
#ifdef PT_SEC
    unsigned long long ts1_ = __builtin_amdgcn_s_memrealtime();
#define S1_MARK(k) do { if (tid == 0) { const unsigned long long n_ = __builtin_amdgcn_s_memrealtime(); if ((k) == PT_SEC) atomicAdd(p.ctl() + 12080, (unsigned)(n_ - ts1_)); ts1_ = n_; } } while (0)
#else
#define S1_MARK(k)
#endif
    LAS float* CS = (LAS float*)(lds + SCS_); LAS float* DCv = (LAS float*)(lds + SDC_); LAS float* SEG = (LAS float*)(lds + SSEG_);
    {
        const int k = tid & 63, sg = tid >> 6; float x = 0.f, loc[8];
#pragma unroll
        for (int tt = 0; tt < 8; ++tt) { x += in.ld[tt]; loc[tt] = x; }
        SEG[sg * 64 + k] = x;
        for (int i2 = tid; i2 < 9216 / 16; i2 += NTHR) *(LAS u32x4_t*)(lds + ST_ + 16 * i2) = (u32x4_t){0u, 0u, 0u, 0u};
        lds_barrier();
        float pre = 0.f;
        for (int s2 = 0; s2 < sg; ++s2) pre += SEG[s2 * 64 + k];
#pragma unroll
        for (int tt = 0; tt < 8; ++tt) { const float e = __expf(loc[tt] + pre); CS[(8 * sg + tt) * 65 + k] = e; if (tt == 7 && sg == 7) DCv[k] = e; }
    }
    lds_barrier(); RW_RELANE(); S1_MARK(11);
    {
        const int t = tid >> 3, kg = tid & 7;
        float kk[8], ka[8], kd[8], rr[8];
#pragma unroll
        for (int j = 0; j < 4; ++j) { kk[2 * j] = bflo(in.kk[j]); kk[2 * j + 1] = bfhi(in.kk[j]); ka[2 * j] = bflo(in.ka[j]); ka[2 * j + 1] = bfhi(in.ka[j]); kd[2 * j] = bflo(in.kd[j]); kd[2 * j + 1] = bfhi(in.kd[j]);
            rr[2 * j] = bflo(in.rr[j]); rr[2 * j + 1] = bfhi(in.rr[j]); }
        float pp[8], qq[8], kt[8], rh[8];
#pragma unroll
        for (int j = 0; j < 8; ++j) { const int k = 8 * kg + j; const float e = CS[t * 65 + k], em = t > 0 ? CS[(t - 1) * 65 + k] : 1.f; const float ei = frcp(e);
            pp[j] = em * kk[j]; qq[j] = ka[j] * ei; kt[j] = kd[j] * ei; rh[j] = rr[j] * e; }
        u32x4_t w;
        w.x = pg8::cvt_pk_bf16(pp[0], pp[1]); w.y = pg8::cvt_pk_bf16(pp[2], pp[3]); w.z = pg8::cvt_pk_bf16(pp[4], pp[5]); w.w = pg8::cvt_pk_bf16(pp[6], pp[7]); *(LAS u32x4_t*)(lds + SP_ + t * 144 + kg * 16) = w;
        w.x = pg8::cvt_pk_bf16(qq[0], qq[1]); w.y = pg8::cvt_pk_bf16(qq[2], qq[3]); w.z = pg8::cvt_pk_bf16(qq[4], qq[5]); w.w = pg8::cvt_pk_bf16(qq[6], qq[7]); *(LAS u32x4_t*)(lds + SQ_ + t * 144 + kg * 16) = w;
        w.x = pg8::cvt_pk_bf16(kt[0], kt[1]); w.y = pg8::cvt_pk_bf16(kt[2], kt[3]); w.z = pg8::cvt_pk_bf16(kt[4], kt[5]); w.w = pg8::cvt_pk_bf16(kt[6], kt[7]); *(LAS u32x4_t*)(lds + SK_ + t * 144 + kg * 16) = w;
        w.x = pg8::cvt_pk_bf16(rh[0], rh[1]); w.y = pg8::cvt_pk_bf16(rh[2], rh[3]); w.z = pg8::cvt_pk_bf16(rh[4], rh[5]); w.w = pg8::cvt_pk_bf16(rh[6], rh[7]); *(LAS u32x4_t*)(lds + SR_ + t * 144 + kg * 16) = w;
    }
    lds_barrier(); RW_RELANE(); S1_MARK(12);
    const int mt = wave >> 1, ntb = 2 * (wave & 1);
    f32x4 krm[2];
    {
        f32x4 qp[2], kp[2], qr[2];
#pragma unroll
        for (int t2 = 0; t2 < 2; ++t2) qp[t2] = kp[t2] = qr[t2] = krm[t2] = (f32x4){0.f, 0.f, 0.f, 0.f};
#pragma unroll
        for (int ks = 0; ks < 2; ++ks) { const bf16x8_t aP = lfrag(lds, SP_, 144, 16 * mt, 32 * ks, lane), aR = lfrag(lds, SR_, 144, 16 * mt, 32 * ks, lane);
#pragma unroll
            for (int t2 = 0; t2 < 2; ++t2) { const bf16x8_t bQ = lfrag(lds, SQ_, 144, 16 * (ntb + t2), 32 * ks, lane), bK = lfrag(lds, SK_, 144, 16 * (ntb + t2), 32 * ks, lane);
                qp[t2] = MMA16(bQ, aP, qp[t2]); kp[t2] = MMA16(aP, bK, kp[t2]); qr[t2] = MMA16(bQ, aR, qr[t2]); krm[t2] = MMA16(bK, aR, krm[t2]); } }
#pragma unroll
        for (int t2 = 0; t2 < 2; ++t2) {
#pragma unroll
            for (int r = 0; r < 4; ++r) {
                { const int t = 16 * mt + 4 * q4 + r, i = 16 * (ntb + t2) + l16; kp[t2][r] = t > i ? kp[t2][r] : 0.f; }
                { const int i = 16 * (ntb + t2) + 4 * q4 + r, t = 16 * mt + l16; const bool st = t > i, inc = t >= i;
                  qp[t2][r] = st ? qp[t2][r] : 0.f; qr[t2][r] = inc ? -qr[t2][r] : 0.f; krm[t2][r] = inc ? krm[t2][r] : 0.f; } }
            st_tr(lds, SL_, 144, 16 * (ntb + t2), 16 * mt, qp[t2], lane); st_tr(lds, SAT_, 144, 16 * mt, 16 * (ntb + t2), kp[t2], lane); st_tr(lds, SNB_, 144, 16 * (ntb + t2), 16 * mt, qr[t2], lane);
            if (ntb + t2 == mt) *(LAS f32x4*)(lds + SDG_ + mt * 1040 + l16 * 64 + q4 * 16) = qp[t2]; }
    }
    lds_barrier(); RW_RELANE(); S1_MARK(13);
    tri_inv64x<SL_, ST_, SSC_, SDG_, STT_>(lds, tid);
    RW_RELANE(); S1_MARK(14);
    if (tid == 0) qraw = __hip_atomic_fetch_add(qctr, 1u, __ATOMIC_RELAXED, __HIP_MEMORY_SCOPE_AGENT);
    {
        f32x4 ph[2], ah[2];
#pragma unroll
        for (int t2 = 0; t2 < 2; ++t2) ph[t2] = ah[t2] = (f32x4){0.f, 0.f, 0.f, 0.f};
#pragma unroll
        for (int ks = 0; ks < 2; ++ks) { const bf16x8_t aT = lfrag(lds, ST_, 144, 16 * mt, 32 * ks, lane);
#pragma unroll
            for (int t2 = 0; t2 < 2; ++t2) { ph[t2] = MMA16(aT, lfragTr(lds, SP_, 144, 32 * ks, 16 * (ntb + t2), lane), ph[t2]); ah[t2] = MMA16(aT, lfrag(lds, SAT_, 144, 16 * (ntb + t2), 32 * ks, lane), ah[t2]); } }
#pragma unroll
        for (int t2 = 0; t2 < 2; ++t2) { st_tr(lds, SPH_, 144, 16 * mt, 16 * (ntb + t2), ph[t2], lane); st_tr(lds, SAH_, 144, 16 * mt, 16 * (ntb + t2), ah[t2], lane); }
    }
    lds_barrier(); RW_RELANE(); S1_MARK(15);
    {
        f32x4 rh[2], zz[2], kh[2];
#pragma unroll
        for (int t2 = 0; t2 < 2; ++t2) { zz[t2] = kh[t2] = (f32x4){0.f, 0.f, 0.f, 0.f};
            const u32x2_t rw = *(LAS const u32x2_t*)(lds + SR_ + (16 * mt + l16) * 144 + (16 * (ntb + t2) + 4 * q4) * 2);
            rh[t2] = (f32x4){bflo(rw.x), bfhi(rw.x), bflo(rw.y), bfhi(rw.y)}; }
#pragma unroll
        for (int ks = 0; ks < 2; ++ks) { const bf16x8_t aB = lfrag(lds, SNB_, 144, 16 * mt, 32 * ks, lane), aPh = lfrag(lds, SPH_, 144, 16 * mt, 32 * ks, lane), aAh = lfrag(lds, SAH_, 144, 16 * mt, 32 * ks, lane);
#pragma unroll
            for (int t2 = 0; t2 < 2; ++t2) { const bf16x8_t bPh = lfrag(lds, SPH_, 144, 16 * (ntb + t2), 32 * ks, lane), bAh = lfrag(lds, SAH_, 144, 16 * (ntb + t2), 32 * ks, lane), bQt = lfragTr(lds, SQ_, 144, 32 * ks, 16 * (ntb + t2), lane);
                rh[t2] = MMA16(bPh, aB, rh[t2]); krm[t2] = MMA16(bAh, aB, krm[t2]); zz[t2] = MMA16(aPh, bQt, zz[t2]); kh[t2] = MMA16(aAh, bQt, kh[t2]); } }
#pragma unroll
        for (int t2 = 0; t2 < 2; ++t2) { const int n = 16 * (ntb + t2) + l16; const float dc = DCv[n];
#pragma unroll
            for (int r = 0; r < 4; ++r) { const int m = 16 * mt + 4 * q4 + r; zz[t2][r] = ((m == n ? 1.f : 0.f) - zz[t2][r]) * dc;
                kh[t2][r] = (bf2f(*(LAS const bf16_t*)(lds + SK_ + m * 144 + n * 2)) - kh[t2][r]) * dc; }
            st_tr(lds, SR_, 144, 16 * (ntb + t2), 16 * mt, rh[t2], lane); st_tr(lds, SL_, 144, 16 * (ntb + t2), 16 * mt, krm[t2], lane);
            st_tr(lds, SPT_, 144, 16 * mt, 16 * (ntb + t2), zz[t2], lane); st_tr(lds, SQT_, 144, 16 * mt, 16 * (ntb + t2), kh[t2], lane); }
    }
    lds_barrier(); RW_RELANE(); S1_MARK(16);
    {
        const int row = tid >> 3, c16 = tid & 7; bf16_t* ob = p.RWC() + (size_t)unit * 5 * 4096 + row * 64 + c16 * 8;
        *(u32x4_t*)(ob) = *(LAS const u32x4_t*)(lds + SR_ + row * 144 + c16 * 16);
        *(u32x4_t*)(ob + 4096) = *(LAS const u32x4_t*)(lds + SL_ + row * 144 + c16 * 16);
        *(u32x4_t*)(ob + 2 * 4096) = *(LAS const u32x4_t*)(lds + SPT_ + row * 144 + c16 * 16);
        *(u32x4_t*)(ob + 3 * 4096) = *(LAS const u32x4_t*)(lds + SQT_ + row * 144 + c16 * 16);
    }
    lds_barrier(); S1_MARK(17);
#undef RW_RELANE
#undef S1_MARK
}
constexpr int S2_M = 0  , S2_S = 46080, S2_HALF = 55296;
__device__ __forceinline__ void rwkv_stage2(const P& p, int pair, bf16_t* YAout, LAS unsigned char* lds0, int tid) {
    const int wave = __builtin_amdgcn_readfirstlane(tid >> 6), half = wave >> 2, w4 = wave & 3; int lane = tid & 63, q4 = lane >> 4, l16 = lane & 15;
    const int chain = 2 * pair + half; const int h = chain % A_H, b = (chain / A_H) % BATCH, dir = chain / (A_H * BATCH);
    LAS unsigned char* lds = lds0 + half * S2_HALF; int t2 = tid & 255;
    for (int i = t2; i < 9216 / 16; i += 256) *(LAS u32x4_t*)(lds + S2_S + 16 * i) = (u32x4_t){0u, 0u, 0u, 0u};
    u32x4_t pre[10];
#define S2_LOADS(cc) do { const bf16_t* ib = p.RWC() + ((size_t)chain * RW_NCH + (cc)) * 5 * 4096; \
        _Pragma("unroll") for (int u = 0; u < 8; ++u) pre[u] = *(const u32x4_t*)(ib + (size_t)(t2 + 256 * u) * 8); \
        const int r0_ = scan_row(dir, b, 64 * (cc)), sg_ = dir ? -1 : 1; \
        _Pragma("unroll") for (int u = 0; u < 2; ++u) { const int piece = t2 + 256 * u; pre[8 + u] = *(const u32x4_t*)(p.RW_V() + (size_t)(r0_ + sg_ * (piece >> 3)) * A_W + h * 64 + (piece & 7) * 8); } } while (0)
    S2_LOADS(0);
#pragma unroll 1
    for (int c = 0; c < RW_NCH; ++c) {
        asm volatile("" : "+v"(tid)); lane = tid & 63; q4 = lane >> 4; l16 = lane & 15; t2 = tid & 255;
#pragma unroll
        for (int u = 0; u < 10; ++u) { const int piece = t2 + 256 * u, mat = piece >> 9, within = piece & 511; *(LAS u32x4_t*)(lds + S2_M + mat * 9216 + (within >> 3) * 144 + (within & 7) * 16) = pre[u]; }
        if (c + 1 < RW_NCH) S2_LOADS(c + 1);
        lds_barrier();
        f32x4 y[4], sn[4];
#pragma unroll
        for (int nt = 0; nt < 4; ++nt) y[nt] = sn[nt] = (f32x4){0.f, 0.f, 0.f, 0.f};
#pragma unroll
        for (int ks = 0; ks < 2; ++ks) {
            const bf16x8_t aR = lfrag(lds, S2_M, 144, 16 * w4, 32 * ks, lane), aM = lfrag(lds, S2_M + 9216, 144, 16 * w4, 32 * ks, lane);
            const bf16x8_t aS = lfrag(lds, S2_S, 144, 16 * w4, 32 * ks, lane), aV = lfragTr(lds, S2_M + 4 * 9216, 144, 32 * ks, 16 * w4, lane);
#pragma unroll
            for (int nt = 0; nt < 4; ++nt) { const int n0 = 16 * nt;
                y[nt] = MMA16(lfrag(lds, S2_S, 144, n0, 32 * ks, lane), aR, y[nt]); y[nt] = MMA16(lfragTr(lds, S2_M + 4 * 9216, 144, 32 * ks, n0, lane), aM, y[nt]);
                sn[nt] = MMA16(lfrag(lds, S2_M + 2 * 9216, 144, n0, 32 * ks, lane), aS, sn[nt]); sn[nt] = MMA16(lfrag(lds, S2_M + 3 * 9216, 144, n0, 32 * ks, lane), aV, sn[nt]); } }
        const int row0 = scan_row(dir, b, 64 * c), sgn = dir ? -1 : 1;
#pragma unroll
        for (int nt = 0; nt < 4; ++nt) { const int t = 16 * w4 + l16; u32x2_t w; w.x = pg8::cvt_pk_bf16(y[nt][0], y[nt][1]); w.y = pg8::cvt_pk_bf16(y[nt][2], y[nt][3]);
            *(u32x2_t*)(YAout + (unsigned)((dir * NTOK + row0 + sgn * t) * A_W + h * 64 + 16 * nt + 4 * q4)) = w; }
        lds_barrier();
#pragma unroll
        for (int nt = 0; nt < 4; ++nt) st_tr(lds, S2_S, 144, 16 * nt, 16 * w4, sn[nt], lane);
        lds_barrier();
    }
#undef S2_LOADS
}

constexpr int AT_K = 0  , AT_V = 18432  , ATT_NLAT = BATCH * 4 * (SEQ / 256), ATT_NCTX = BATCH * 4 * (CTXL / 256);
__device__ __forceinline__ void attn_unit(const P& p, int unit, LAS unsigned char* lds, int tid) {
    const int wave = __builtin_amdgcn_readfirstlane(tid >> 6); int lane = tid & 63, q4 = lane >> 4, l16 = lane & 15;
    int b, hq, qrow0, nt; bool lat;
    if (unit < ATT_NLAT) { lat = true; b = unit / (4 * (SEQ / 256)); hq = (unit / (SEQ / 256)) % 4; qrow0 = b * SEQ + 256 * (unit % (SEQ / 256)); nt = SLEN / 64; }
    else { const int u2 = unit - ATT_NLAT; lat = false; b = u2 / (4 * (CTXL / 256)); hq = (u2 / (CTXL / 256)) % 4; qrow0 = NLAT + b * CTXL + 256 * (u2 % (CTXL / 256)); nt = CTXL / 64; }
    const int kvh = hq >> 1; qrow0 += 32 * wave;
    bf16x8_t qf[2][2];
#pragma unroll
    for (int qt = 0; qt < 2; ++qt)
#pragma unroll
        for (int ks = 0; ks < 2; ++ks) qf[qt][ks] = *(const bf16x8_t*)(p.CQ() + (size_t)(qrow0 + 16 * qt + l16) * 256 + hq * 64 + 32 * ks + 8 * q4);
    f32x4 o[2][4]; float mrun[2], lrun[2];
#pragma unroll
    for (int qt = 0; qt < 2; ++qt) { mrun[qt] = 0.f; lrun[qt] = 0.f;
#pragma unroll
        for (int dt = 0; dt < 4; ++dt) o[qt][dt] = (f32x4){0.f, 0.f, 0.f, 0.f}; }
    u32x4_t pk, pv;
#define AT_ROWBASE(t) ((lat && (t) < SEQ / 64) ? b * SEQ + 64 * (t) : NLAT + b * CTXL + 64 * ((t) - (lat ? SEQ / 64 : 0)))
#define AT_LOAD(t) do { const size_t ro = (size_t)(AT_ROWBASE(t) + (tid >> 3)) * 128 + kvh * 64 + (tid & 7) * 8; pk = *(const u32x4_t*)(p.CK() + ro); \
        pv = *(const u32x4_t*)(p.CV() + ((size_t)(b * 2 + kvh) * 64 + (tid >> 3)) * SLEN + (lat ? 0 : SEQ) + 64 * (t) + (tid & 7) * 8); } while (0)
#define AT_STORE(buf) do { const int rw = tid >> 3, c16 = tid & 7; *(LAS u32x4_t*)(lds + AT_K + (buf) * 9216 + rw * 144 + c16 * 16) = pk; *(LAS u32x4_t*)(lds + AT_V + (buf) * 9216 + rw * 144 + c16 * 16) = pv; } while (0)
    AT_LOAD(0); AT_STORE(0);
    lds_barrier();
#pragma unroll 1
    for (int t = 0; t < nt; ++t) {
        asm volatile("" : "+v"(tid)); lane = tid & 63; q4 = lane >> 4; l16 = lane & 15;
        const int buf = t & 1;
        if (t + 1 < nt) AT_LOAD(t + 1);
        f32x4 s[2][4];
#pragma unroll
        for (int qt = 0; qt < 2; ++qt)
#pragma unroll
            for (int kt = 0; kt < 4; ++kt) s[qt][kt] = (f32x4){-mrun[qt], -mrun[qt], -mrun[qt], -mrun[qt]};
#pragma unroll
        for (int ks = 0; ks < 2; ++ks)
#pragma unroll
            for (int kt = 0; kt < 4; ++kt) { const bf16x8_t ak = lfrag(lds, AT_K + buf * 9216, 144, 16 * kt, 32 * ks, lane);
                s[0][kt] = MMA16(ak, qf[0][ks], s[0][kt]); s[1][kt] = MMA16(ak, qf[1][ks], s[1][kt]); }
        bf16x8_t pb[2][2];
#pragma unroll
        for (int qt = 0; qt < 2; ++qt) {
            float mx = s[qt][0][0];
#pragma unroll
            for (int kt = 0; kt < 4; ++kt)
#pragma unroll
                for (int r = 0; r < 4; ++r) mx = fmaxf(mx, s[qt][kt][r]);
            mx = fmaxf(mx, __shfl_xor(mx, 16)); mx = fmaxf(mx, __shfl_xor(mx, 32));
            if (__any(mx > 6.0f) || t == 0) { const float dl = (t == 0) ? mx : fmaxf(mx, 0.f), alpha = __builtin_amdgcn_exp2f(-dl); mrun[qt] += dl; lrun[qt] *= alpha;
#pragma unroll
                for (int kt = 0; kt < 4; ++kt) s[qt][kt] = s[qt][kt] - dl;
#pragma unroll
                for (int dt = 0; dt < 4; ++dt) o[qt][dt] = o[qt][dt] * alpha; }
            float ps = 0.f;
#pragma unroll
            for (int kt = 0; kt < 4; ++kt)
#pragma unroll
                for (int r = 0; r < 4; ++r) { const float e = __builtin_amdgcn_exp2f(s[qt][kt][r]); s[qt][kt][r] = e; ps += e; }
            lrun[qt] += ps;
#pragma unroll
            for (int k2 = 0; k2 < 2; ++k2) { u32x4_t w; w.x = pg8::cvt_pk_bf16(s[qt][2 * k2][0], s[qt][2 * k2][1]); w.y = pg8::cvt_pk_bf16(s[qt][2 * k2][2], s[qt][2 * k2][3]);
                w.z = pg8::cvt_pk_bf16(s[qt][2 * k2 + 1][0], s[qt][2 * k2 + 1][1]); w.w = pg8::cvt_pk_bf16(s[qt][2 * k2 + 1][2], s[qt][2 * k2 + 1][3]); pb[qt][k2] = __builtin_bit_cast(bf16x8_t, w); }
        }
#pragma unroll
        for (int k2 = 0; k2 < 2; ++k2)
#pragma unroll
            for (int dt = 0; dt < 4; ++dt) { LAS const unsigned char* vp = lds + AT_V + buf * 9216 + (16 * dt + l16) * 144 + (32 * k2 + 4 * q4) * 2;
                const u32x2_t lo = *(LAS const u32x2_t*)vp, hi = *(LAS const u32x2_t*)(vp + 32); u32x4_t w; w.x = lo.x; w.y = lo.y; w.z = hi.x; w.w = hi.y; const bf16x8_t av = __builtin_bit_cast(bf16x8_t, w);
                o[0][dt] = MMA16(av, pb[0][k2], o[0][dt]); o[1][dt] = MMA16(av, pb[1][k2], o[1][dt]); }
        if (t + 1 < nt) AT_STORE(buf ^ 1);
        lds_barrier();
    }
#pragma unroll
    for (int qt = 0; qt < 2; ++qt) { float l = lrun[qt]; l += __shfl_xor(l, 16); l += __shfl_xor(l, 32); const float inv = 1.0f / l;
        bf16_t* orow = p.MIX() + (size_t)(qrow0 + 16 * qt + l16) * D + 768 + hq * 64 + 4 * q4;
#pragma unroll
        for (int dt = 0; dt < 4; ++dt) { u32x2_t w; w.x = pg8::cvt_pk_bf16(o[qt][dt][0] * inv, o[qt][dt][1] * inv); w.y = pg8::cvt_pk_bf16(o[qt][dt][2] * inv, o[qt][dt][3] * inv); *(u32x2_t*)(orow + 16 * dt) = w; } }
#undef AT_ROWBASE
#undef AT_LOAD
#undef AT_STORE
}


__device__ __forceinline__ void wave_rows(int nrows, int nblk, int blk, int wave, int& r0, int& r1) {
    const int nw = nblk * NWAVES, per = (nrows + nw - 1) / nw, gwl = blk * NWAVES + wave; r0 = gwl * per; r1 = r0 + per; if (r1 > nrows) r1 = nrows; if (r0 > nrows) r0 = nrows;
}
__device__ __forceinline__ float sigm(float x) { return __builtin_amdgcn_rcpf(1.0f + __expf(-x)); }
struct P0Cv { u32x4_t cv[5]; };
struct P0Sm { u32x4_t lr[3]; u32x2_t aq, ak, av; float ga, gb; };
__device__ __forceinline__ void prep0_load_cv(const P& p, int m, int which, int lane, P0Cv& in) {
    int b, t, len, base; row_info(m, b, t, len, base);
#pragma unroll
    for (int j = 0; j < 5; ++j) { const int tt = t + j - 2; in.cv[j] = (tt >= 0 && tt < len) ? *(const u32x4_t*)(p.U() + (size_t)(base + tt) * INP + B_OFF + which * B_W + 8 * lane) : (u32x4_t){0u, 0u, 0u, 0u}; }
}
__device__ __forceinline__ void prep0_compute_cv(const P& p, int l, int m, int which, int lane, const P0Cv& in, const f32x4_t (&cwr)[5][2]) {
    float acc[8];
#pragma unroll
    for (int c = 0; c < 8; ++c) acc[c] = 0.f;
#pragma unroll
    for (int j = 0; j < 5; ++j) { const u32x4_t uv = in.cv[j];
        const f32x4_t w0 = cwr[j][0], w1 = cwr[j][1];
        acc[0] += bflo(uv.x) * w0.x; acc[1] += bfhi(uv.x) * w0.y; acc[2] += bflo(uv.y) * w0.z; acc[3] += bfhi(uv.y) * w0.w;
        acc[4] += bflo(uv.z) * w1.x; acc[5] += bfhi(uv.z) * w1.y; acc[6] += bflo(uv.w) * w1.z; acc[7] += bfhi(uv.w) * w1.w; }
    float ss = 0.f;
#pragma unroll
    for (int c = 0; c < 8; ++c) { acc[c] = acc[c] * sigm(acc[c]); ss += acc[c] * acc[c]; }
    float rn = 1.0f;
    if (which < 2) rn = (frsq(grp16_sum(ss) + 1e-6f)) * (which == 0 ? 0.08838834764831845f : 1.0f);
    u32x4_t w; w.x = pg8::cvt_pk_bf16(acc[0] * rn, acc[1] * rn); w.y = pg8::cvt_pk_bf16(acc[2] * rn, acc[3] * rn); w.z = pg8::cvt_pk_bf16(acc[4] * rn, acc[5] * rn); w.w = pg8::cvt_pk_bf16(acc[6] * rn, acc[7] * rn);
    *(u32x4_t*)((which == 0 ? p.GQ() : which == 1 ? p.GK() : p.GV()) + (size_t)m * B_W + 8 * lane) = w;
}
__device__ __forceinline__ void prep0_load_sm(const P& p, int m, int lane, P0Sm& in) {
    int b, t, len, base; row_info(m, b, t, len, base);
    const bf16_t* ur = p.U() + (size_t)m * INP; const bool hp = t > 0, hn = t + 1 < len;
    { const int c = 768 + 8 * (lane < 24 ? lane : 23); const u32x4_t z = {0u, 0u, 0u, 0u};
      in.lr[0] = *(const u32x4_t*)(ur + c); in.lr[1] = hp ? *(const u32x4_t*)(ur + c - INP) : z; in.lr[2] = hn ? *(const u32x4_t*)(ur + c + INP) : z; }
    in.aq = *(const u32x2_t*)(ur + C_OFF + 4 * lane); in.ak = *(const u32x2_t*)(ur + C_OFF + 256 + 4 * (lane & 31)); in.av = *(const u32x2_t*)(ur + C_OFF + 384 + 4 * (lane & 31));
    in.ga = bf2f(ur[B_OFF + 2048 + (lane & 7)]); in.gb = bf2f(ur[B_OFF + 2056 + (lane & 7)]);
}
struct P0Par { f32x4_t m0, m1, qn, kn; float dtb, alog; };
__device__ __forceinline__ void prep0_params(const P& p, int l, int lane, P0Par& q) {
    const float* mup = p.rw_mu + l * A_IN + 768 + 8 * (lane < 24 ? lane : 23); q.m0 = *(const f32x4_t*)mup; q.m1 = *(const f32x4_t*)(mup + 4);
    q.qn = *(const f32x4_t*)(p.attn_q_norm + l * 64 + 4 * (lane & 15)); q.kn = *(const f32x4_t*)(p.attn_k_norm + l * 64 + 4 * (lane & 15));
    q.dtb = p.gdn_dt_bias[(l * 2 + ((lane & 7) >> 2)) * B_H + (lane & 3)]; q.alog = p.gdn_a_log[(l * 2 + ((lane & 7) >> 2)) * B_H + (lane & 3)];
}
__device__ __forceinline__ void prep0_compute_sm(const P& p, int l, int m, int lane, const P0Sm& in, const P0Par& par) {
    const int i16 = lane & 15; int b, t, len, base; row_info(m, b, t, len, base);
    if (lane < 32) {
        u32x4_t w = {0u, 0u, 0u, 0u};
        if (lane < 24) {
            const f32x4_t m0 = par.m0, m1 = par.m1;
            float u[8], up[8], un[8], o[8];
#pragma unroll
            for (int j = 0; j < 4; ++j) { u[2 * j] = bflo(in.lr[0][j]); u[2 * j + 1] = bfhi(in.lr[0][j]); up[2 * j] = bflo(in.lr[1][j]); up[2 * j + 1] = bfhi(in.lr[1][j]); un[2 * j] = bflo(in.lr[2][j]); un[2 * j + 1] = bfhi(in.lr[2][j]); }
            const int grp = lane >> 3;
#pragma unroll
            for (int j = 0; j < 8; ++j) { const float mu = j < 4 ? m0[j & 3] : m1[j & 3]; const float v = u[j] + mu * (0.5f * (up[j] + un[j]) - u[j]);
                const float e = __expf(grp == 0 ? 2.0f * v : -v), rc = frcp(1.0f + e); o[j] = grp == 0 ? 1.0f - 2.0f * rc : (grp == 1 ? v : rc); }
            w.x = pg8::cvt_pk_bf16(o[0], o[1]); w.y = pg8::cvt_pk_bf16(o[2], o[3]); w.z = pg8::cvt_pk_bf16(o[4], o[5]); w.w = pg8::cvt_pk_bf16(o[6], o[7]);
        }
        *(u32x4_t*)(p.LRT() + (size_t)m * 256 + 8 * lane) = w;
    }
    if (lane < 8) {
        const float xs = in.ga + par.dtb; const float sp = xs > 20.f ? xs : __logf(1.0f + __expf(xs));
        p.GG()[(size_t)m * 8 + lane] = -__expf(par.alog) * sp; p.GBETA()[(size_t)m * 8 + lane] = sigm(in.gb); }
    {
        const int i = i16; f32x4_t cs = {1.f, 1.f, 1.f, 1.f}, sn = {0.f, 0.f, 0.f, 0.f};
        if (m < NLAT) { cs = *(const f32x4_t*)(p.ROPE() + (size_t)t * 128 + 4 * i); sn = *(const f32x4_t*)(p.ROPE() + (size_t)t * 128 + 64 + 4 * i); }
        const float sgn = (i & 4) ? 1.f : -1.f;
        {
            const f32x4_t x = bf4(in.aq); const float rstd = (frsq(grp16_sum(hsq4(x)) * (1.0f / 64.f) + 1e-6f)) * 0.18033688011112042f;
            const f32x4_t nw = par.qn; f32x4_t y = x * rstd * nw, o;
#pragma unroll
            for (int c = 0; c < 4; ++c) { const float pr = __shfl_xor(y[c], 4); o[c] = y[c] * cs[c] + sgn * pr * sn[c]; }
            *(u32x2_t*)(p.CQ() + (size_t)m * 256 + 4 * lane) = pk4(o);
        }
        {
            const f32x4_t x = bf4(in.ak); const float rstd = frsq(grp16_sum(hsq4(x)) * (1.0f / 64.f) + 1e-6f);
            const f32x4_t nw = par.kn; f32x4_t y = x * rstd * nw, o;
#pragma unroll
            for (int c = 0; c < 4; ++c) { const float pr = __shfl_xor(y[c], 4); o[c] = y[c] * cs[c] + sgn * pr * sn[c]; }
            if (lane < 32) { *(u32x2_t*)(p.CK() + (size_t)m * 128 + 4 * lane) = pk4(o);
                const u32x2_t vv = in.av; const int key = m < NLAT ? t : SEQ + t;
                bf16_t* vt = p.CV() + ((size_t)(b * 2 + (lane >> 4)) * 64 + 4 * (lane & 15)) * SLEN + key;
                vt[0] = (bf16_t)(vv.x & 0xffffu); vt[SLEN] = (bf16_t)(vv.x >> 16); vt[2 * SLEN] = (bf16_t)(vv.y & 0xffffu); vt[3 * SLEN] = (bf16_t)(vv.y >> 16); }
        }
    }
}
__device__ __forceinline__ u32x4_t prep0_row(const P& p, int row, int which, int lane) {
    return (row >= 0 && row < NTOK) ? *(const u32x4_t*)(p.U() + (size_t)row * INP + B_OFF + which * B_W + 8 * lane) : (u32x4_t){0u, 0u, 0u, 0u};
}
__device__ __forceinline__ void dev_prep0(const P& p, int l, int G, int wave, int lane) {
    const int per = (NTOK + G - 1) / G, t0 = (int)blockIdx.x * per, t1 = (t0 + per < NTOK) ? t0 + per : NTOK;
#ifdef PT_P0
    const unsigned long long tp0_ = __builtin_amdgcn_s_memrealtime();
#endif
    {
        const int pw = (per + NWAVES - 1) / NWAVES, r0 = t0 + wave * pw, r1 = (r0 + pw < t1) ? r0 + pw : t1;
#pragma unroll 1
        for (int which = 0; which < 3; ++which) {
            if (r0 >= r1) break;
            f32x4_t cwr[5][2];
#pragma unroll
            for (int j = 0; j < 5; ++j) { const float* cw = p.gdn_conv + ((size_t)l * 5 + j) * (3 * B_W) + which * B_W + 8 * lane; cwr[j][0] = *(const f32x4_t*)cw; cwr[j][1] = *(const f32x4_t*)(cw + 4); }
            u32x4_t w0 = prep0_row(p, r0 - 2, which, lane), w1 = prep0_row(p, r0 - 1, which, lane), w2 = prep0_row(p, r0, which, lane), w3 = prep0_row(p, r0 + 1, which, lane);
            u32x4_t n0 = prep0_row(p, r0 + 2, which, lane), n1 = prep0_row(p, r0 + 3, which, lane);
            for (int m = r0; m < r1; m += 2) {
                const u32x4_t w4 = n0, w5 = n1; n0 = prep0_row(p, m + 4, which, lane); n1 = prep0_row(p, m + 5, which, lane);
                {
                    int b, t, len, base; row_info(m, b, t, len, base); P0Cv use; use.cv[0] = w0; use.cv[1] = w1; use.cv[2] = w2; use.cv[3] = w3; use.cv[4] = w4;
#pragma unroll
                    for (int j = 0; j < 5; ++j) { const int tt = t + j - 2; if (tt < 0 || tt >= len) use.cv[j] = (u32x4_t){0u, 0u, 0u, 0u}; }
                    prep0_compute_cv(p, l, m, which, lane, use, cwr);
                }
                if (m + 1 < r1) {
                    int b, t, len, base; row_info(m + 1, b, t, len, base); P0Cv use; use.cv[0] = w1; use.cv[1] = w2; use.cv[2] = w3; use.cv[3] = w4; use.cv[4] = w5;
#pragma unroll
                    for (int j = 0; j < 5; ++j) { const int tt = t + j - 2; if (tt < 0 || tt >= len) use.cv[j] = (u32x4_t){0u, 0u, 0u, 0u}; }
                    prep0_compute_cv(p, l, m + 1, which, lane, use, cwr);
                }
                w0 = w2; w1 = w3; w2 = w4; w3 = w5;
            }
        }
    }
#ifdef PT_P0
    const unsigned long long tp1_ = __builtin_amdgcn_s_memrealtime();
#endif
    const int first = t0 + wave, ntk = first < t1 ? (t1 - first + NWAVES - 1) / NWAVES : 0;
    {
        P0Par par; prep0_params(p, l, lane, par);
        P0Sm cur; if (ntk > 0) prep0_load_sm(p, first, lane, cur);
        for (int i = 0; i < ntk; ++i) { const int m = first + i * NWAVES; P0Sm nxt = cur; if (i + 1 < ntk) prep0_load_sm(p, m + NWAVES, lane, nxt); prep0_compute_sm(p, l, m, lane, cur, par); cur = nxt; }
    }
#ifdef PT_P0
    { const unsigned long long tp2_ = __builtin_amdgcn_s_memrealtime(); const unsigned d_ = PT_P0 == 1 ? (unsigned)(tp1_ - tp0_) : (unsigned)(tp2_ - tp1_); if (lane == 0) atomicMax(p.ctl() + 12070 + l, d_); }
#endif
}
__device__ __forceinline__ void dev_build_rope(const P& p, long gtid, long nthr) {
    for (long e = gtid; e < (long)SEQ * 64; e += nthr) { const int t = (int)(e >> 6), d = (int)(e & 63); const float pos = d < 32 ? (float)(t / GRID_W) : (float)(t % GRID_W);
        const float ang = pos * exp2f(-0.8304820237218406f * (float)(d & 15)); p.ROPE()[(size_t)t * 128 + d] = cosf(ang); p.ROPE()[(size_t)t * 128 + 64 + d] = sinf(ang); }
}
struct A1In { u32x2_t u[3][3]; u32x2_t lro[5]; };
__device__ __forceinline__ void prepA1_load(const P& p, int m, int lane, A1In& in) {
    int b, t, len, base; row_info(m, b, t, len, base);
    const bf16_t* ur = p.U() + (size_t)m * INP; const bool hp = t > 0, hn = t + 1 < len; const u32x2_t z = {0u, 0u};
#pragma unroll
    for (int a = 0; a < 3; ++a) { const int c = 256 * a + 4 * lane; in.u[a][1] = *(const u32x2_t*)(ur + c); in.u[a][0] = hp ? *(const u32x2_t*)(ur + c - INP) : z; in.u[a][2] = hn ? *(const u32x2_t*)(ur + c + INP) : z; }
    const bf16_t* lo = p.LRO() + (size_t)m * 1280 + 4 * lane;
#pragma unroll
    for (int g = 0; g < 5; ++g) in.lro[g] = *(const u32x2_t*)(lo + 256 * g);
}
__device__ __forceinline__ void dev_prepA1(const P& p, int l, int gw, int ngw, int lane) {
    const int h = lane >> 4;
    const f32x4_t kkp = *(const f32x4_t*)(p.rw_k_k + l * A_W + 4 * lane), kap = *(const f32x4_t*)(p.rw_k_a + l * A_W + 4 * lane), rkp = *(const f32x4_t*)(p.rw_r_k + l * A_W + 4 * lane);
    f32x4_t mu3[3], w0p[2], a0p[2];
#pragma unroll
    for (int a = 0; a < 3; ++a) mu3[a] = *(const f32x4_t*)(p.rw_mu + l * A_IN + 256 * a + 4 * lane);
#pragma unroll
    for (int dir = 0; dir < 2; ++dir) { w0p[dir] = *(const f32x4_t*)(p.rw_w0 + (l * 2 + dir) * A_W + 4 * lane); a0p[dir] = *(const f32x4_t*)(p.rw_a0 + (l * 2 + dir) * A_W + 4 * lane); }
    int m = gw; if (m >= NTOK) return;
    A1In cur; prepA1_load(p, m, lane, cur);
    for (; m < NTOK; m += ngw) {
        A1In nxt = cur; if (m + ngw < NTOK) prepA1_load(p, m + ngw, lane, nxt);
        f32x4_t rkv[3];
#pragma unroll
        for (int a = 0; a < 3; ++a) { const f32x4_t u = bf4(cur.u[a][1]); rkv[a] = u + mu3[a] * (0.5f * (bf4(cur.u[a][0]) + bf4(cur.u[a][2])) - u); }
        const f32x4_t r = rkv[0], k = rkv[1], v = rkv[2];
        const f32x4_t kx = k * kkp; const float rn = frsq(grp16_sum(hsq4(kx)) + 1e-6f); const f32x4_t kk = kx * rn;
        f32x4_t kdsum = {0.f, 0.f, 0.f, 0.f};
#pragma unroll
        for (int dir = 0; dir < 2; ++dir) {
            const f32x4_t w = w0p[dir] + bf4(cur.lro[dir]);
            const f32x4_t a = a0p[dir] + bf4(cur.lro[2 + dir]);
            f32x4_t ld, ic;
#pragma unroll
            for (int c = 0; c < 4; ++c) { const float nw = -w[c]; const float sp = nw > 20.f ? nw : __logf(1.0f + __expf(nw)); ld[c] = -__expf(-sp - 0.5f); ic[c] = sigm(a[c]); }
            const f32x4_t kd = k * (1.0f + (ic - 1.0f) * kap); kdsum = kdsum + kd;
            const size_t o = ((size_t)dir * NTOK + m) * A_W + 4 * lane;
            *(f32x4_t*)(p.RW_D() + o) = ld; *(u32x2_t*)(p.RW_KD() + o) = pk4(kd); *(u32x2_t*)(p.RW_KKA() + o) = pk4(kk * ic);
        }
        const size_t o1 = (size_t)m * A_W + 4 * lane;
        *(u32x2_t*)(p.RW_R() + o1) = pk4(r); *(u32x2_t*)(p.RW_V() + o1) = pk4(v); *(u32x2_t*)(p.RW_KK() + o1) = pk4(kk); *(u32x2_t*)(p.RW_GATE() + o1) = cur.lro[4];
        const float bon = grp16_sum(hsum4(r * kdsum * rkp));
        if ((lane & 15) == 0) p.RW_BON()[(size_t)m * A_H + h] = bon;
        cur = nxt;
    }
}
__device__ __forceinline__ void dev_build_wlr(const P& p, int l, long gtid, long nthr) {
    for (long e = gtid; e < 1280L * 256; e += nthr) { const int n = (int)(e >> 8), k = (int)(e & 255), g = n >> 8, ch = n & 255; float v = 0.f;
        if (g < 2) { if ((k >> 5) == g) v = p.rw_w2[((size_t)(l * 2 + g) * 32 + (k & 31)) * A_W + ch]; }
        else if (g < 4) { if ((k >> 5) == g) v = p.rw_a2[((size_t)(l * 2 + (g - 2)) * 32 + (k & 31)) * A_W + ch]; }
        else { if (k >= 128 && k < 192) v = p.rw_g2[((size_t)l * 64 + (k - 128)) * A_W + ch]; }
        p.WLR_T(l)[e] = f2bf(v); }
}

constexpr int RING_BYTES = 131072, MISC_OFF = 147200, LDS_BYTES = 163840;
constexpr size_t MiB = 1u << 20;
constexpr int CW_BAR = 4096, CW_CNT = 8192;

__device__ __forceinline__ void transpose_item(const float* W, int K, int N, bf16_t* WT, LAS float* scr, int item, int lane) {
    const int nblk_k = K / 64; const int nb = item / nblk_k, kb = item % nblk_k, k0 = 64 * kb, n0 = 64 * nb;
    const int nl = 4 * (lane & 15), kq = lane >> 4;
    f32x4 v[16];
#pragma unroll
    for (int i = 0; i < 16; ++i) { const float* src = W + (size_t)(k0 + 4 * i + kq) * N + n0 + nl;
        if (n0 + nl + 3 < N) v[i] = *(const f32x4*)src;
        else { v[i] = (f32x4){0.f, 0.f, 0.f, 0.f}; if (n0 + nl < N) v[i][0] = src[0]; if (n0 + nl + 1 < N) v[i][1] = src[1]; if (n0 + nl + 2 < N) v[i][2] = src[2]; } }
#pragma unroll
    for (int i = 0; i < 16; ++i) { LAS float* d = scr + (4 * i + kq) * 65 + nl; d[0] = v[i][0]; d[1] = v[i][1]; d[2] = v[i][2]; d[3] = v[i][3]; }
    asm volatile("s_waitcnt lgkmcnt(0)" ::: "memory");
    const int c = lane & 7;
#pragma unroll
    for (int j = 0; j < 8; ++j) { const int n = (lane >> 3) + 8 * j; const LAS float* sp = scr + (8 * c) * 65 + n;
        pg8::u32x4 o; o.x = pg8::cvt_pk_bf16(sp[0 * 65], sp[1 * 65]); o.y = pg8::cvt_pk_bf16(sp[2 * 65], sp[3 * 65]); o.z = pg8::cvt_pk_bf16(sp[4 * 65], sp[5 * 65]); o.w = pg8::cvt_pk_bf16(sp[6 * 65], sp[7 * 65]);
        *(pg8::u32x4*)(WT + (size_t)(n0 + n) * K + k0 + 8 * c) = o; }
    asm volatile("s_waitcnt lgkmcnt(0)" ::: "memory");
}

struct Args { P p; int ph_lo, ph_hi; };

#define RUN_TASKS(ntasks, call) do { const long _n = (long)(ntasks); for (long task = gtid; task < _n; task += nthr) { call; } } while (0)


__device__ __forceinline__ void dev_mod(const P& p, int cg, LAS unsigned char* lds, int tid) {
    LAS float* STB = (LAS float*)lds; LAS float* PT = (LAS float*)(lds + 69632);
    const int lane = tid & 63, wave = tid >> 6; const int lyr = cg / 96, j0 = (cg % 96) * 64;
    for (int idx = tid; idx < (BATCH + 1) * D; idx += NTHR) { const int r = idx >> 10, k = idx & 1023; const float v = r < BATCH ? p.c[(size_t)r * D + k] : p.c_ctx[k]; STB[idx] = v / (1.0f + __expf(-v)); }
    __syncthreads();
    float acc[BATCH + 1];
#pragma unroll
    for (int r = 0; r <= BATCH; ++r) acc[r] = 0.f;
    const float* w = p.ada_w + ((size_t)lyr * D + 128 * wave) * 6 * D + j0 + lane;
#pragma unroll 4
    for (int k = 0; k < 128; ++k) { const float wv = w[(size_t)k * 6 * D];
#pragma unroll
        for (int r = 0; r <= BATCH; ++r) acc[r] += STB[r * D + 128 * wave + k] * wv; }
#pragma unroll
    for (int r = 0; r <= BATCH; ++r) PT[(wave * (BATCH + 1) + r) * 64 + lane] = acc[r];
    __syncthreads();
    for (int idx = tid; idx < (BATCH + 1) * 64; idx += NTHR) { const int r = idx >> 6, jj = idx & 63; float sacc = p.ada_b[(size_t)lyr * 6 * D + j0 + jj];
#pragma unroll
        for (int w2 = 0; w2 < 8; ++w2) sacc += PT[(w2 * (BATCH + 1) + r) * 64 + jj];
        p.MOD()[((size_t)lyr * (BATCH + 1) + r) * 6 * D + j0 + jj] = sacc; }
    __syncthreads();
}
constexpr int CV_I_IN = (D / 64) * (INP / 64), CV_I_OUT = (D / 64) * (D / 64), CV_I_R = (D / 64), CV_I_GU = (D / 64) * (2 * DEXP / 64), CV_I_DN = (DEXP / 64) * (D / 64);
constexpr int CV_SMALL = CV_I_IN + CV_I_OUT + CV_I_R, CV_TOTAL = CV_SMALL + NEXP * (CV_I_GU + CV_I_DN), CV_CHUNK = 8;
constexpr int CV_NCH_SMALL = (CV_SMALL + CV_CHUNK - 1) / CV_CHUNK, CV_NCH_MOE = (CV_TOTAL - CV_SMALL + CV_CHUNK - 1) / CV_CHUNK;
__device__ __forceinline__ void conv_chunk(const P& p, int l, bool moe, int chunk, LAS unsigned char* ldsp, int wave, int lane) {
    LAS float* scr = (LAS float*)(ldsp + wave * 16896);
    for (int i = 0; i < CV_CHUNK / NWAVES; ++i) {
        int r = chunk * CV_CHUNK + wave + NWAVES * i; if (moe) { r += CV_SMALL; if (r >= CV_TOTAL) break; } else if (r >= CV_SMALL) break;
        if (r < CV_I_IN) { transpose_item(p.w_in + (size_t)l * D * INW, D, INW, p.WIN_T(l), scr, r, lane); continue; } r -= CV_I_IN;
        if (r < CV_I_OUT) { transpose_item(p.w_out + (size_t)l * D * D, D, D, p.WOUT_T(l), scr, r, lane); continue; } r -= CV_I_OUT;
        if (r < CV_I_R) { transpose_item(p.router_w + (size_t)l * D * NEXP, D, NEXP, p.WR_T(l), scr, r, lane); continue; } r -= CV_I_R;
        if (r < NEXP * CV_I_GU) { const int e = r / CV_I_GU; transpose_item(p.exp_w_gu + ((size_t)l * NEXP + e) * D * 2 * DEXP, D, 2 * DEXP, p.WGU_T(l) + (size_t)e * 2 * DEXP * D, scr, r % CV_I_GU, lane); continue; } r -= NEXP * CV_I_GU;
        { const int e = r / CV_I_DN; transpose_item(p.exp_w_dn + ((size_t)l * NEXP + e) * DEXP * D, DEXP, D, p.WDN_T(l) + (size_t)e * D * DEXP, scr, r % CV_I_DN, lane); }
    }
}

__device__ __forceinline__ int q_next(unsigned* ctr, volatile LAS unsigned* slot, int tid) {
    if (tid == 0) *slot = __hip_atomic_fetch_add(ctr, 1u, __ATOMIC_RELAXED, __HIP_MEMORY_SCOPE_AGENT);
    __syncthreads(); const int v = (int)*slot; __syncthreads(); return v;
}

__device__ __forceinline__ int q_filler(unsigned* cctr, unsigned* dctr, unsigned nitems, volatile LAS unsigned* slot, int tid) {
    if (tid == 0) { const unsigned d = __hip_atomic_load(dctr, __ATOMIC_RELAXED, __HIP_MEMORY_SCOPE_AGENT); *slot = d >= nitems ? 0x7fffffffu : __hip_atomic_fetch_add(cctr, 1u, __ATOMIC_RELAXED, __HIP_MEMORY_SCOPE_AGENT); }
    __syncthreads(); const int v = (int)*slot; __syncthreads(); return v;
}

#ifndef DBG_PH
#define DBG_PH -1
#endif
#define PHON(j) (DBG_PH < 0 || DBG_PH == (j))
#define IN(k) (lo <= (k) && (k) < hi)
#define TID_NOW() (wave_s * 64 + (int)__builtin_amdgcn_mbcnt_hi(~0u, __builtin_amdgcn_mbcnt_lo(~0u, 0u)))
#define PHASE_VARS P p = args.p; asm volatile("" : "+s"(p.ws)); int tid_ = TID_NOW(); asm volatile("" : "+v"(tid_)); const int lane = tid_ & 63, wave = __builtin_amdgcn_readfirstlane(tid_ >> 6); \
    const long gtid = ((long)wave * G + blockIdx.x) * 64 + lane, nthr = (long)G * NTHR; const int gw = wave * G + blockIdx.x, ngw = G * NWAVES; (void)gw; (void)ngw; (void)gtid; (void)nthr; (void)lane;
#ifdef PROBE_T
#define SEAM(k) do { if (IN((k) + 1)) xcd_barrier(bar, TID_NOW()); if (blockIdx.x == 0 && TID_NOW() == 0) ((unsigned long long*)(args.p.ctl() + 12100))[(k) + 1] = __builtin_amdgcn_s_memrealtime(); } while (0)
#else
#define SEAM(k) do { if (IN((k) + 1)) xcd_barrier(bar, TID_NOW()); } while (0)
#endif
template <int l>
__device__ __forceinline__ void layer_body(const Args& args, const XcdBarrier& bar, LAS unsigned char* ldsp, const int G, const int wave_s, const int lo, const int hi) {
        const int pb = 1 + l * NPH;
        const bool need_ctx = l < DEPTH - 1;
        const int ntok_l = need_ctx ? NTOK : NLAT;
        if (l == 0 && PHON(0) && IN(pb + 0)) { PHASE_VARS;
            dev_norm1_l0(p, G, wave, lane);
            SEAM(pb + 0);
        }
        if (PHON(1) && IN(pb + 1)) { PHASE_VARS; (void)tid_; (void)wave;
            pg8::Gemm g{p.HB(), p.WIN_T(l), D, 0, nullptr}; pg8::StaticOrder S; S.init(NTOK, INP, G, (int)blockIdx.x);
            pg8::EpiBf16Bias E{p.U(), INP, nullptr, 0};
            pg8::gemm_phase(ldsp, g, S, E, tid_);
            SEAM(pb + 1);
        }
        if (PHON(2) && IN(pb + 2)) { PHASE_VARS; dev_prep0(p, l, G, wave, lane); SEAM(pb + 2); }
        if (PHON(3) && IN(pb + 3)) { PHASE_VARS; (void)tid_; (void)wave;
            pg8::Gemm g{p.LRT(), p.WLR_T(l), 256, 0, nullptr}; pg8::StaticOrder S; S.init(NTOK, 1280, G, (int)blockIdx.x);
            pg8::EpiBf16Bias E{p.LRO(), 1280, nullptr, 0};
            pg8::gemm_phase(ldsp, g, S, E, tid_);
            SEAM(pb + 3);
        }
        if (PHON(4) && IN(pb + 4)) { PHASE_VARS; dev_prepA1(p, l, gw, ngw, lane); SEAM(pb + 4); }
        if (PHON(5) && IN(pb + 5)) { PHASE_VARS;
            const int nchain = 2 * BATCH * B_H, nitems = nchain + RW_UNITS;
            unsigned* ctr = p.ctl() + 12200 + 64 * (2 * l); volatile LAS unsigned* slot = (volatile LAS unsigned*)(ldsp + MISC_OFF + 64);
#ifdef PROBE_GDN
            { const long nB = 2L * BATCH * B_H * 128; for (long task = gtid; task < nB; task += nthr) task_scanB(p, task); }
#endif
            unsigned long long tacc_ = 0ull, t0_ = 0ull; (void)tacc_; (void)t0_;
#ifdef PT_ACT
#define ACT_BEGIN(a) do { if (PT_ACT == (a)) t0_ = __builtin_amdgcn_s_memrealtime(); } while (0)
#define ACT_END(a) do { if (PT_ACT == (a)) tacc_ += __builtin_amdgcn_s_memrealtime() - t0_; } while (0)
#define ACT_FLUSH() do { if (tid_ == 0) atomicMax(p.ctl() + 12070 + l, (unsigned)tacc_); } while (0)
#else
#define ACT_BEGIN(a)
#define ACT_END(a)
#define ACT_FLUSH()
#endif
            int cur = q_next(ctr, slot, tid_);
            while (cur < nchain) {
                ACT_BEGIN(1); gdn_chain(p.GQ(), p.GK(), p.GV(), p.GG(), p.GBETA(), cur, p.OB(), ldsp, tid_, p.ctl()); ACT_END(1);
                if (tid_ == 0) __hip_atomic_fetch_add(ctr + 32, 1u, __ATOMIC_RELAXED, __HIP_MEMORY_SCOPE_AGENT);
                cur = q_next(ctr, slot, tid_); }
            if (cur < nitems) {
                S1In in; rwkv_stage1_load(p, cur - nchain, tid_, in);
                int nxt = q_next(ctr, slot, tid_);
                while (cur < nitems) {
#if defined(PT_SEC) && PT_SEC == 18
                    if (tid_ == 0) { const unsigned long long n_ = __builtin_amdgcn_s_memrealtime(); if (t0_) atomicAdd(p.ctl() + 12080, (unsigned)(n_ - t0_)); t0_ = n_; }
#endif
                    S1In in2; const bool have2 = nxt < nitems;
                    if (have2) rwkv_stage1_load(p, nxt - nchain, tid_, in2); else in2 = in;
                    unsigned qraw = 0u;
                    ACT_BEGIN(2); rwkv_stage1(p, cur - nchain, in, ldsp, tid_, ctr, qraw); ACT_END(2);
                    if (tid_ == 0) { __hip_atomic_fetch_add(ctr + 32, 1u, __ATOMIC_RELAXED, __HIP_MEMORY_SCOPE_AGENT); *slot = qraw; }
                    lds_barrier();
                    const int nn = (int)*slot;
                    in = in2; cur = nxt; nxt = nn;
                }
                __syncthreads();
            }
            ACT_FLUSH();
            {
                unsigned* cctr = p.ctl() + 12200 + 64 * (8 + 2 * l);
                for (int ch = q_filler(cctr, ctr + 32, (unsigned)nitems, slot, tid_); ch < CV_NCH_MOE + (l + 1 < DEPTH ? CV_NCH_SMALL : 0); ch = q_filler(cctr, ctr + 32, (unsigned)nitems, slot, tid_)) {
                    if (ch < CV_NCH_MOE) conv_chunk(p, l, true, ch, ldsp, wave, lane); else conv_chunk(p, l + 1, false, ch - CV_NCH_MOE, ldsp, wave, lane); } }
            SEAM(pb + 5);
        }
        if (PHON(6) && IN(pb + 6)) { PHASE_VARS;
            const int ngb = 0, nch = ngb + BATCH * A_H, nun = ATT_NLAT + (need_ctx ? ATT_NCTX : 0);
            unsigned* ctr = p.ctl() + 12200 + 64 * (2 * l + 1); volatile LAS unsigned* slot = (volatile LAS unsigned*)(ldsp + MISC_OFF + 64);
#ifdef PROBE_RWKV
            { const long nA = 2L * BATCH * A_H * 64; for (long task = gtid; task < nA; task += nthr) task_scanA(p, task); }
#endif
            unsigned long long tacc_ = 0ull, t0_ = 0ull; (void)tacc_; (void)t0_;
            for (int cur = q_next(ctr, slot, tid_); cur < nch + nun; cur = q_next(ctr, slot, tid_)) {
                if (cur < nch) { ACT_BEGIN(3); rwkv_stage2(p, cur - ngb,
#ifdef PROBE_RWKV
                    (bf16_t*)(p.ws + WS_TOTAL),
#else
                    p.YA(),
#endif
                    ldsp, tid_); ACT_END(3); }
                else { ACT_BEGIN(4); attn_unit(p, cur - nch, ldsp, tid_); ACT_END(4); }
                if (tid_ == 0) __hip_atomic_fetch_add(ctr + 32, 1u, __ATOMIC_RELAXED, __HIP_MEMORY_SCOPE_AGENT);
            }
            ACT_FLUSH();
            {
                unsigned* cctr = p.ctl() + 12200 + 64 * (8 + 2 * l);
                for (int ch = q_filler(cctr, ctr + 32, (unsigned)(nch + nun), slot, tid_); ch < CV_NCH_MOE + (l + 1 < DEPTH ? CV_NCH_SMALL : 0); ch = q_filler(cctr, ctr + 32, (unsigned)(nch + nun), slot, tid_)) {
                    if (ch < CV_NCH_MOE) conv_chunk(p, l, true, ch, ldsp, wave, lane); else conv_chunk(p, l + 1, false, ch - CV_NCH_MOE, ldsp, wave, lane); } }
            SEAM(pb + 6);
        }
        if (PHON(7) && IN(pb + 7)) { PHASE_VARS;
#ifdef PROBE_GDN
            { float e2 = 0.f, r2 = 0.f; const bf16_t* cand = (const bf16_t*)(p.ws + WS_TOTAL); const bf16_t* ref = p.OB();
              for (long i = gtid; i < 2L * NTOK * B_W; i += nthr) { const float d = bf2f(cand[i]) - bf2f(ref[i]); e2 += d * d; r2 += bf2f(ref[i]) * bf2f(ref[i]); }
              e2 = wave_sum(e2); r2 = wave_sum(r2); if (lane == 0) { atomicAdd((float*)(p.ctl() + 12000), e2); atomicAdd((float*)(p.ctl() + 12001), r2); } }
#endif
#ifdef PROBE_RWKV
            { float e2 = 0.f, r2 = 0.f; const bf16_t* cand = (const bf16_t*)(p.ws + WS_TOTAL); const bf16_t* ref = p.YA();
              for (long i = gtid; i < 2L * NTOK * A_W; i += nthr) { const float d = bf2f(cand[i]) - bf2f(ref[i]); e2 += d * d; r2 += bf2f(ref[i]) * bf2f(ref[i]); }
              e2 = wave_sum(e2); r2 = wave_sum(r2); if (lane == 0) { atomicAdd((float*)(p.ctl() + 12000), e2); atomicAdd((float*)(p.ctl() + 12001), r2); } }
#endif
            dev_post(p, l, ntok_l, gw, ngw, lane); SEAM(pb + 7); }
        if (PHON(8) && IN(pb + 8)) { PHASE_VARS; (void)tid_; (void)wave;
            pg8::Gemm g{p.MIX(), p.WOUT_T(l), D, 0, nullptr}; pg8::StaticOrder S; S.init(ntok_l, D, G, (int)blockIdx.x);
            pg8::EpiBf16Bias E{p.MO(), D, nullptr, 0};
            pg8::gemm_phase(ldsp, g, S, E, tid_);
            SEAM(pb + 8);
        }
        if (PHON(9) && IN(pb + 9)) { PHASE_VARS; dev_resid_router(p, l, ntok_l, ldsp, G, tid_); SEAM(pb + 9); }
        if (PHON(10) && IN(pb + 10)) { PHASE_VARS; dev_slots(p, l, ntok_l, ldsp, gtid, nthr, tid_);
            {
                unsigned* cctr = p.ctl() + 12200 + 64 * (8 + 2 * l); volatile LAS unsigned* slot = (volatile LAS unsigned*)(ldsp + MISC_OFF + 64);
                for (int ch = q_next(cctr, slot, tid_); ch < CV_NCH_MOE + (l + 1 < DEPTH ? CV_NCH_SMALL : 0); ch = q_next(cctr, slot, tid_)) {
                    if (ch < CV_NCH_MOE) conv_chunk(p, l, true, ch, ldsp, wave, lane); else conv_chunk(p, l + 1, false, ch - CV_NCH_MOE, ldsp, wave, lane); } }
            SEAM(pb + 10); }
        if (PHON(12) && IN(pb + 12)) { PHASE_VARS; (void)tid_; (void)wave;
            pg8::Gemm g{p.HB(), p.WGU_T(l), D, (size_t)2 * DEXP * D, p.SLOT_TOK()}; pg8::MoeOrder S{__builtin_amdgcn_readfirstlane(p.NBLK()[0]), 2 * DEXP / 256, G, (int)blockIdx.x, p.BLOCK_E()};
            pg8::EpiSwiglu E{p.HH(), DEXP, p.exp_b_gu + (size_t)l * NEXP * 2 * DEXP, 2 * DEXP};
            pg8::gemm_phase<true>(ldsp, g, S, E, tid_);
            SEAM(pb + 12);
        }
        if (PHON(13) && IN(pb + 13)) { PHASE_VARS; (void)tid_; (void)wave;
            pg8::Gemm g{p.HH(), p.WDN_T(l), DEXP, (size_t)D * DEXP, nullptr}; pg8::MoeOrder S{__builtin_amdgcn_readfirstlane(p.NBLK()[0]), D / 256, G, (int)blockIdx.x, p.BLOCK_E()};
            pg8::EpiBf16Bias E{p.YB(), D, p.exp_b_dn + (size_t)l * NEXP * D, D};
            pg8::gemm_phase(ldsp, g, S, E, tid_);
            SEAM(pb + 13);
        }
        if (PHON(14) && IN(pb + 14)) { PHASE_VARS; dev_combine(p, l, ntok_l, G, wave, lane);
            if (l + 1 < DEPTH) SEAM(pb + 14); }
}

__global__ void __launch_bounds__(NTHR, 2) fwd_kernel(Args args) {
    extern __shared__ __attribute__((aligned(16))) unsigned char lds[];
    const P& pk = args.p;
    LAS unsigned char* ldsp = (LAS unsigned char*)lds;
    volatile LAS unsigned* MISC = (volatile LAS unsigned*)(ldsp + MISC_OFF);
    const int G = gridDim.x;
    const int wave_s = __builtin_amdgcn_readfirstlane((int)threadIdx.x >> 6);
    { const int t0 = TID_NOW(); if (t0 < 32) MISC[t0] = 0u; }
    __syncthreads();
    XcdBarrier bar = xcd_barrier_post(pk.ctl() + CW_BAR, MISC + 8, TID_NOW());
    const int lo = args.ph_lo, hi = args.ph_hi;
#ifdef PROBE_T
    if (blockIdx.x == 0 && TID_NOW() == 0) ((unsigned long long*)(pk.ctl() + 12100))[0] = __builtin_amdgcn_s_memrealtime();
#endif

    if (PHON(100) && IN(0)) { PHASE_VARS;
        for (int cg = blockIdx.x; cg < DEPTH * 96; cg += G) dev_mod(p, cg, ldsp, tid_);
        RUN_TASKS(D, p.HB()[(size_t)ZROW * D + task] = 0);
        dev_build_rope(p, gtid, nthr);
        for (int lw = 0; lw < DEPTH; ++lw) dev_build_wlr(p, lw, gtid, nthr);
        for (int ch = blockIdx.x; ch < CV_NCH_SMALL; ch += G) conv_chunk(p, 0, false, ch, ldsp, wave, lane);
        SEAM(0);
    }
    layer_body<0>(args, bar, ldsp, G, wave_s, lo, hi);
    layer_body<1>(args, bar, ldsp, G, wave_s, lo, hi);
#undef IN
#undef SEAM
}

#ifndef N_LAUNCH_MODE
#define N_LAUNCH_MODE 1
#endif
extern "C" void kernel_launch(void* const* d_in, const int* in_sizes, int n_in, void* d_out, int out_size, void* d_ws, size_t ws_size, hipStream_t stream) {
    static int grid = 0;
    if (grid == 0) {
        int dev = 0, cus = 0;
        if (hipGetDevice(&dev) != hipSuccess || hipDeviceGetAttribute(&cus, hipDeviceAttributeMultiprocessorCount, dev) != hipSuccess) { grid = -1; return; }
        if (hipFuncSetAttribute((const void*)fwd_kernel, hipFuncAttributeMaxDynamicSharedMemorySize, LDS_BYTES) != hipSuccess) { fprintf(stderr, "hipFuncSetAttribute failed\n"); grid = -1; return; }
        int per_cu = 0;
        if (hipOccupancyMaxActiveBlocksPerMultiprocessor(&per_cu, (const void*)fwd_kernel, NTHR, LDS_BYTES) != hipSuccess || per_cu < 1) fprintf(stderr, "occupancy query: %d\n", per_cu);
        (void)hipGetLastError();
        grid = cus;
    }
    if (grid < 0) return;
    unsigned char* ws = (unsigned char*)d_ws;
    (void)hipMemsetAsync(ws, 0, CTL_BYTES, stream);
    Args a{};
    P& p = a.p;
    const float* const* in = (const float* const*)d_in;
    p.x = in[0]; p.c = in[1]; p.ctx = in[2]; p.c_ctx = in[3]; p.ada_w = in[4]; p.ada_b = in[5]; p.pre_norm = in[6]; p.post_norm = in[7]; p.w_in = in[8]; p.w_out = in[9];
    p.rw_mu = in[10]; p.rw_w0 = in[11]; p.rw_w2 = in[12]; p.rw_a0 = in[13]; p.rw_a2 = in[14]; p.rw_g2 = in[15]; p.rw_k_k = in[16]; p.rw_k_a = in[17]; p.rw_r_k = in[18]; p.rw_ln_w = in[19]; p.rw_ln_b = in[20];
    p.gdn_conv = in[21]; p.gdn_a_log = in[22]; p.gdn_dt_bias = in[23]; p.gdn_norm = in[24]; p.attn_q_norm = in[25]; p.attn_k_norm = in[26];
    p.router_w = in[27]; p.router_b = in[28]; p.exp_w_gu = in[29]; p.exp_b_gu = in[30]; p.exp_w_dn = in[31]; p.exp_b_dn = in[32];
    p.out = (float*)d_out;
    p.ws = ws; p.tokf = nullptr;
#ifdef PROBE_GDN
    if (WS_TOTAL + (size_t)2 * NTOK * B_W * 4 > ws_size) { fprintf(stderr, "probe: ws too small\n"); return; }
#endif
    if (WS_TOTAL > ws_size) { fprintf(stderr, "kernel_launch: workspace too small: need %zu have %zu\n", (size_t)WS_TOTAL, ws_size); return; }
    const int nph = 1 + DEPTH * NPH;
#if N_LAUNCH_MODE == 1
    a.ph_lo = 0; a.ph_hi = nph;
    hipLaunchKernelGGL(fwd_kernel, dim3(grid), dim3(NTHR), LDS_BYTES, stream, a);
#else
    for (int ph = 0; ph < nph; ++ph) { a.ph_lo = ph; a.ph_hi = ph + 1; hipLaunchKernelGGL(fwd_kernel, dim3(grid), dim3(NTHR), LDS_BYTES, stream, a); }
#endif
}
#endif
```

```cpp
#ifndef HOST_TEST
#include <hip/hip_runtime.h>
#else
struct uint4 { unsigned x, y, z, w; };
#endif
#include <cstdio>
#include <cstdint>
#include <cmath>

#ifndef CFG_BATCH
#define CFG_BATCH 16
#define CFG_SEQ 2048
#define CFG_CTX 256
#define CFG_NEXP 32
#define CFG_DEXP 1024
#endif
constexpr int D = 1024, BATCH = CFG_BATCH, SEQ = CFG_SEQ, CTXL = CFG_CTX, DEPTH = 2, GRID_W = 64;
constexpr int NLAT = BATCH * SEQ, NCTX = BATCH * CTXL, NTOK = NLAT + NCTX;
constexpr int A_W = 256, A_H = 4, A_IN = 960;
constexpr int B_W = 512, B_H = 4, B_IN = 2064, B_OFF = 960;
constexpr int C_W = 256, C_IN = 512, C_OFF = 3024;
constexpr int INW = 3536, INP = 3584;
constexpr int NEXP = CFG_NEXP, TOPK = 4, DEXP = CFG_DEXP;
constexpr int NBLK_MAX = (NTOK * TOPK + 255) / 256 + NEXP, NSLOT = NBLK_MAX * 256;
constexpr int ZROW = NTOK;
constexpr int SLEN = CTXL + SEQ;

#ifdef HOST_TEST
#define DEVFN static inline
#define GLOBAL_ATOMIC_ADD(p, v) ((*(p)) += (v), (*(p)) - (v))
#else
#define DEVFN __device__ __forceinline__
#define GLOBAL_ATOMIC_ADD(p, v) atomicAdd((p), (v))
#endif
#ifdef HOST_TEST
#define UNIFORM(x) (x)
#define LOADFENCE()
#else
#define UNIFORM(x) __builtin_amdgcn_readfirstlane(x)
#define LOADFENCE() asm volatile("" ::: "memory")
#endif
typedef unsigned short bf16_t;
DEVFN bf16_t f2bf(float f) { unsigned u = __builtin_bit_cast(unsigned, f); return (bf16_t)((u + 0x7fffu + ((u >> 16) & 1u)) >> 16); }
DEVFN float bf2f(bf16_t b) { unsigned u = ((unsigned)b) << 16; return __builtin_bit_cast(float, u); }
DEVFN float sigmoidf_(float x) { return 1.0f / (1.0f + expf(-x)); }
DEVFN float siluf_(float x) { return x / (1.0f + expf(-x)); }
DEVFN float softplusf_(float x) { return x > 20.f ? x : log1pf(expf(x)); }

#ifdef HOST_TEST
#define WSACC inline
#else
#define WSACC __device__ __host__ __forceinline__
#endif
constexpr size_t CTL_BYTES = 64 * 1024;
constexpr size_t al256(size_t x) { return (x + 255) & ~(size_t)255; }
constexpr size_t WSO_ctl = 0;
constexpr size_t WSE_ctl = WSO_ctl + al256(CTL_BYTES);
constexpr size_t WSO_MOD = WSE_ctl;
constexpr size_t WSE_MOD = WSO_MOD + al256((size_t)DEPTH * (BATCH + 1) * 6 * D * 4);
constexpr size_t WSO_X = WSE_MOD;
constexpr size_t WSE_X = WSO_X + al256((size_t)(NTOK + 1) * D * 4);
constexpr size_t WSO_HB = WSE_X;
constexpr size_t WSE_HB = WSO_HB + al256((size_t)(NTOK + 1) * D * 2);
constexpr size_t WSO_WIN_T = WSE_HB;
constexpr size_t WSE_WIN_T = WSO_WIN_T + al256((size_t)INP * D * 2);
constexpr size_t WSO_WOUT_T = WSE_WIN_T;
constexpr size_t WSE_WOUT_T = WSO_WOUT_T + al256((size_t)D * D * 2);
constexpr size_t WSO_WR_T = WSE_WOUT_T;
constexpr size_t WSE_WR_T = WSO_WR_T + al256((size_t)64 * D * 2);
constexpr size_t WSO_WGU_T = WSE_WR_T;
constexpr size_t WSE_WGU_T = WSO_WGU_T + al256((size_t)NEXP * 2 * DEXP * D * 2);
constexpr size_t WSO_WDN_T = WSE_WGU_T;
constexpr size_t WSE_WDN_T = WSO_WDN_T + al256((size_t)NEXP * D * DEXP * 2);
constexpr size_t WSZ_WSET = WSE_WDN_T - WSO_WIN_T;
constexpr size_t WSO_TOPI = WSE_WDN_T + WSZ_WSET;
constexpr size_t WSE_TOPI = WSO_TOPI + al256((size_t)NTOK * 4 * 4);
constexpr size_t WSO_POS = WSE_TOPI;
constexpr size_t WSE_POS = WSO_POS + al256((size_t)NTOK * 4 * 4);
constexpr size_t WSO_TSLOT = WSE_POS;
constexpr size_t WSE_TSLOT = WSO_TSLOT + al256((size_t)NTOK * 4 * 4);
constexpr size_t WSO_TOPG = WSE_TSLOT;
constexpr size_t WSE_TOPG = WSO_TOPG + al256((size_t)NTOK * 4 * 4);
constexpr size_t WSO_SLOT_TOK = WSE_TOPG;
constexpr size_t WSE_SLOT_TOK = WSO_SLOT_TOK + al256((size_t)NSLOT * 4);
constexpr size_t WSO_BLOCK_E = WSE_SLOT_TOK;
constexpr size_t WSE_BLOCK_E = WSO_BLOCK_E + al256((size_t)NBLK_MAX * 4);
constexpr size_t WSO_NBLK = WSE_BLOCK_E;
constexpr size_t WSE_NBLK = WSO_NBLK + al256(256);
constexpr size_t WSO_U = WSE_NBLK;
constexpr size_t WSE_U = WSO_U + al256((size_t)NTOK * INP * 2);
constexpr size_t WSO_MO = WSE_U;
constexpr size_t WSE_MO = WSO_MO + al256((size_t)NTOK * D * 2);
constexpr size_t WSO_ROPE = WSE_MO;
constexpr size_t WSE_ROPE = WSO_ROPE + al256((size_t)SEQ * 128 * 4);
constexpr size_t WSO_WLR_T = WSE_ROPE;
constexpr size_t WSE_WLR_T = WSO_WLR_T + 2 * al256((size_t)1280 * 256 * 2);
constexpr size_t WSO_END_P = WSE_WLR_T;
constexpr size_t WSO_LR = WSO_END_P;
constexpr size_t WSE_LR = WSO_LR + al256((size_t)NTOK * 192 * 4);
#ifdef HOST_TEST
constexpr size_t WSO_RW_R = WSE_LR;
#else
constexpr size_t WSO_RW_R = WSO_LR;
#endif
constexpr size_t WSE_RW_R = WSO_RW_R + al256((size_t)NTOK * A_W * 2);
constexpr size_t WSO_RW_V = WSE_RW_R;
constexpr size_t WSE_RW_V = WSO_RW_V + al256((size_t)NTOK * A_W * 2);
constexpr size_t WSO_RW_KK = WSE_RW_V;
constexpr size_t WSE_RW_KK = WSO_RW_KK + al256((size_t)NTOK * A_W * 2);
constexpr size_t WSO_RW_D = WSE_RW_KK;
constexpr size_t WSE_RW_D = WSO_RW_D + al256((size_t)2 * NTOK * A_W * 4);
constexpr size_t WSO_RW_KD = WSE_RW_D;
constexpr size_t WSE_RW_KD = WSO_RW_KD + al256((size_t)2 * NTOK * A_W * 2);
constexpr size_t WSO_RW_KKA = WSE_RW_KD;
constexpr size_t WSE_RW_KKA = WSO_RW_KKA + al256((size_t)2 * NTOK * A_W * 2);
constexpr size_t WSO_RW_GATE = WSE_RW_KKA;
constexpr size_t WSE_RW_GATE = WSO_RW_GATE + al256((size_t)NTOK * A_W * 2);
constexpr size_t WSO_RW_BON = WSE_RW_GATE;
constexpr size_t WSE_RW_BON = WSO_RW_BON + al256((size_t)NTOK * A_H * 4);
constexpr size_t WSO_YA = WSE_RW_BON;
constexpr size_t WSE_YA = WSO_YA + al256((size_t)2 * NTOK * A_W * 2);
constexpr size_t WSO_GQ = WSE_YA;
constexpr size_t WSE_GQ = WSO_GQ + al256((size_t)NTOK * B_W * 2);
constexpr size_t WSO_GK = WSE_GQ;
constexpr size_t WSE_GK = WSO_GK + al256((size_t)NTOK * B_W * 2);
constexpr size_t WSO_GV = WSE_GK;
constexpr size_t WSE_GV = WSO_GV + al256((size_t)NTOK * B_W * 2);
constexpr size_t WSO_GG = WSE_GV;
constexpr size_t WSE_GG = WSO_GG + al256((size_t)NTOK * 8 * 4);
constexpr size_t WSO_GBETA = WSE_GG;
constexpr size_t WSE_GBETA = WSO_GBETA + al256((size_t)NTOK * 8 * 4);
constexpr size_t WSO_OB = WSE_GBETA;
constexpr size_t WSE_OB = WSO_OB + al256((size_t)2 * NTOK * B_W * 2);
constexpr size_t WSO_CQ = WSE_OB;
constexpr size_t WSE_CQ = WSO_CQ + al256((size_t)NTOK * 256 * 2);
constexpr size_t WSO_CK = WSE_CQ;
constexpr size_t WSE_CK = WSO_CK + al256((size_t)NTOK * 128 * 2);
constexpr size_t WSO_CV = WSE_CK;
constexpr size_t WSE_CV = WSO_CV + al256((size_t)NTOK * 128 * 2);
constexpr size_t WSO_RWC = WSE_CV;
constexpr size_t WSE_RWC = WSO_RWC + al256((size_t)2 * BATCH * A_H * (SLEN / 64) * 5 * 4096 * 2);
constexpr size_t WSO_LRT = WSE_RWC;
constexpr size_t WSE_LRT = WSO_LRT + al256((size_t)NTOK * 256 * 2);
constexpr size_t WSO_LRO = WSE_LRT;
constexpr size_t WSE_LRO = WSO_LRO + al256((size_t)NTOK * 1280 * 2);
constexpr size_t WSO_MIX = WSE_LRO;
constexpr size_t WSE_MIX = WSO_MIX + al256((size_t)NTOK * D * 2);
constexpr size_t WSO_XG = WSO_END_P;
constexpr size_t WSE_XG = WSO_XG + al256((size_t)NSLOT * D * 2);
constexpr size_t WSO_HH = WSE_XG;
constexpr size_t WSE_HH = WSO_HH + al256((size_t)NSLOT * DEXP * 2);
constexpr size_t WSO_YB = WSE_HH;
constexpr size_t WSE_YB = WSO_YB + al256((size_t)NSLOT * D * 2);
constexpr size_t WS_TOTAL = (WSE_MIX > WSE_YB ? WSE_MIX : WSE_YB);
struct P {
    const float *x, *c, *ctx, *c_ctx, *ada_w, *ada_b, *pre_norm, *post_norm, *w_in, *w_out;
    const float *rw_mu, *rw_w0, *rw_w2, *rw_a0, *rw_a2, *rw_g2, *rw_k_k, *rw_k_a, *rw_r_k, *rw_ln_w, *rw_ln_b;
    const float *gdn_conv, *gdn_a_log, *gdn_dt_bias, *gdn_norm, *attn_q_norm, *attn_k_norm;
    const float *router_w, *router_b, *exp_w_gu, *exp_b_gu, *exp_w_dn, *exp_b_dn;
    float* out;
    unsigned char* ws;
    WSACC unsigned* ctl() const { return (unsigned*)(ws + WSO_ctl); }
    WSACC float* MOD() const { return (float*)(ws + WSO_MOD); }
    WSACC float* X() const { return (float*)(ws + WSO_X); }
    WSACC bf16_t* HB() const { return (bf16_t*)(ws + WSO_HB); }
    WSACC bf16_t* WIN_T(int l) const { return (bf16_t*)(ws + WSO_WIN_T + (size_t)l * WSZ_WSET); }
    WSACC bf16_t* WOUT_T(int l) const { return (bf16_t*)(ws + WSO_WOUT_T + (size_t)l * WSZ_WSET); }
    WSACC bf16_t* WR_T(int l) const { return (bf16_t*)(ws + WSO_WR_T + (size_t)l * WSZ_WSET); }
    WSACC bf16_t* WGU_T(int l) const { return (bf16_t*)(ws + WSO_WGU_T + (size_t)l * WSZ_WSET); }
    WSACC bf16_t* WDN_T(int l) const { return (bf16_t*)(ws + WSO_WDN_T + (size_t)l * WSZ_WSET); }
    WSACC int* TOPI() const { return (int*)(ws + WSO_TOPI); }
    WSACC int* POS() const { return (int*)(ws + WSO_POS); }
    WSACC int* TSLOT() const { return (int*)(ws + WSO_TSLOT); }
    WSACC float* TOPG() const { return (float*)(ws + WSO_TOPG); }
    WSACC int* SLOT_TOK() const { return (int*)(ws + WSO_SLOT_TOK); }
    WSACC int* BLOCK_E() const { return (int*)(ws + WSO_BLOCK_E); }
    WSACC int* NBLK() const { return (int*)(ws + WSO_NBLK); }
    WSACC bf16_t* U() const { return (bf16_t*)(ws + WSO_U); }
    WSACC bf16_t* MO() const { return (bf16_t*)(ws + WSO_MO); }
    WSACC float* LR() const { return (float*)(ws + WSO_LR); }
    WSACC bf16_t* RW_R() const { return (bf16_t*)(ws + WSO_RW_R); }
    WSACC bf16_t* RW_V() const { return (bf16_t*)(ws + WSO_RW_V); }
    WSACC bf16_t* RW_KK() const { return (bf16_t*)(ws + WSO_RW_KK); }
    WSACC float* RW_D() const { return (float*)(ws + WSO_RW_D); }
    WSACC bf16_t* RW_KD() const { return (bf16_t*)(ws + WSO_RW_KD); }
    WSACC bf16_t* RW_KKA() const { return (bf16_t*)(ws + WSO_RW_KKA); }
    WSACC bf16_t* RW_GATE() const { return (bf16_t*)(ws + WSO_RW_GATE); }
    WSACC float* RW_BON() const { return (float*)(ws + WSO_RW_BON); }
    WSACC bf16_t* YA() const { return (bf16_t*)(ws + WSO_YA); }
    WSACC bf16_t* GQ() const { return (bf16_t*)(ws + WSO_GQ); }
    WSACC bf16_t* GK() const { return (bf16_t*)(ws + WSO_GK); }
    WSACC bf16_t* GV() const { return (bf16_t*)(ws + WSO_GV); }
    WSACC float* GG() const { return (float*)(ws + WSO_GG); }
    WSACC float* GBETA() const { return (float*)(ws + WSO_GBETA); }
    WSACC bf16_t* OB() const { return (bf16_t*)(ws + WSO_OB); }
    WSACC bf16_t* CQ() const { return (bf16_t*)(ws + WSO_CQ); }
    WSACC bf16_t* CK() const { return (bf16_t*)(ws + WSO_CK); }
    WSACC bf16_t* CV() const { return (bf16_t*)(ws + WSO_CV); }
    WSACC bf16_t* MIX() const { return (bf16_t*)(ws + WSO_MIX); }
    WSACC bf16_t* RWC() const { return (bf16_t*)(ws + WSO_RWC); }
    WSACC float* ROPE() const { return (float*)(ws + WSO_ROPE); }
    WSACC bf16_t* LRT() const { return (bf16_t*)(ws + WSO_LRT); }
    WSACC bf16_t* LRO() const { return (bf16_t*)(ws + WSO_LRO); }
    WSACC bf16_t* WLR_T(int l) const { return (bf16_t*)(ws + WSO_WLR_T + (size_t)l * al256((size_t)1280 * 256 * 2)); }
    WSACC bf16_t* XG() const { return (bf16_t*)(ws + WSO_XG); }
    WSACC bf16_t* HH() const { return (bf16_t*)(ws + WSO_HH); }
    WSACC bf16_t* YB() const { return (bf16_t*)(ws + WSO_YB); }
    WSACC int* cnt() const { return (int*)(ws + WSO_ctl) + 8192; }
    WSACC float* TOKF() const { return tokf; }
    float* tokf;
};

DEVFN void row_info(int m, int& b, int& t, int& len, int& base) {
    if (m < NLAT) { b = m / SEQ; t = m % SEQ; len = SEQ; base = b * SEQ; }
    else { const int mc = m - NLAT; b = mc / CTXL; t = mc % CTXL; len = CTXL; base = NLAT + b * CTXL; }
}
DEVFN float ldU(const P& p, size_t idx) { return bf2f(p.U()[idx]); }
DEVFN int mod_row(int m) { return m < NLAT ? m / SEQ : BATCH; }
DEVFN int scan_row(int dir, int b, int s) {
    if (s < CTXL) { const int ts = dir ? (CTXL - 1 - s) : s; return NLAT + b * CTXL + ts; }
    const int s2 = s - CTXL; const int ts = dir ? (SEQ - 1 - s2) : s2; return b * SEQ + ts;
}

DEVFN void task_mod(const P& p, long task) {
    const int j = (int)(task % (6 * D)); const int r = (int)((task / (6 * D)) % (BATCH + 1)); const int l = (int)(task / ((long)(6 * D) * (BATCH + 1)));
    const float* cv = (r < BATCH) ? p.c + (size_t)r * D : p.c_ctx;
    const float* w = p.ada_w + (size_t)l * D * 6 * D + j;
    float acc = 0.f;
    for (int k = 0; k < D; ++k) acc += siluf_(cv[k]) * w[(size_t)k * 6 * D];
    p.MOD()[((size_t)l * (BATCH + 1) + r) * 6 * D + j] = acc + p.ada_b[(size_t)l * 6 * D + j];
}
DEVFN void task_copyx(const P& p, long task) {
    const long n_lat = (long)NLAT * D;
    p.X()[task] = task < n_lat ? p.x[task] : p.ctx[task - n_lat];
}
DEVFN void task_norm1(const P& p, int l, long task) {
    const int m = (int)task; const float* xr = p.X() + (size_t)m * D;
    float ss = 0.f; for (int k = 0; k < D; ++k) ss += xr[k] * xr[k];
    const float rstd = 1.0f / sqrtf(ss / D + 1e-6f);
    const float* md = p.MOD() + ((size_t)l * (BATCH + 1) + mod_row(m)) * 6 * D; const float* pn = p.pre_norm + (size_t)(l * 2 + 0) * D;
    bf16_t* o = p.HB() + (size_t)m * D;
    for (int k = 0; k < D; ++k) o[k] = f2bf(xr[k] * rstd * pn[k] * (1.0f + md[D + k]) + md[k]);
}
DEVFN float lerpA(const P& p, int l, int m, int col) {
    int b, t, len, base; row_info(m, b, t, len, base);
    const float u = ldU(p, (size_t)m * INP + col);
    const float up = t > 0 ? ldU(p, (size_t)(m - 1) * INP + col) : 0.f, un = t + 1 < len ? ldU(p, (size_t)(m + 1) * INP + col) : 0.f;
    return u + p.rw_mu[l * A_IN + col] * (0.5f * (up + un) - u);
}
DEVFN void task_prepA0(const P& p, int l, long task) {
    const int m = (int)(task / 192), j = (int)(task % 192);
    const float v = lerpA(p, l, m, 768 + j);
    p.LR()[(size_t)m * 192 + j] = j < 64 ? tanhf(v) : (j < 128 ? v : sigmoidf_(v));
}
DEVFN void task_prepA1(const P& p, int l, long task) {
    const int m = (int)(task / A_H), h = (int)(task % A_H);
    const float* lr = p.LR() + (size_t)m * 192;
    float ss = 0.f;
    for (int c = 0; c < 64; ++c) { const int ch = h * 64 + c; const float kx = lerpA(p, l, m, 256 + ch) * p.rw_k_k[l * A_W + ch]; ss += kx * kx; }
    const float rn = 1.0f / sqrtf(ss + 1e-6f);
    float bon = 0.f;
    for (int c = 0; c < 64; ++c) {
        const int ch = h * 64 + c;
        const float r = lerpA(p, l, m, ch), k = lerpA(p, l, m, 256 + ch), v = lerpA(p, l, m, 512 + ch);
        const float kk = k * p.rw_k_k[l * A_W + ch] * rn;
        float kdsum = 0.f;
        for (int dir = 0; dir < 2; ++dir) {
            float w = p.rw_w0[(l * 2 + dir) * A_W + ch], a = p.rw_a0[(l * 2 + dir) * A_W + ch];
            const float* w2 = p.rw_w2 + ((size_t)(l * 2 + dir) * 32) * A_W + ch; const float* a2 = p.rw_a2 + ((size_t)(l * 2 + dir) * 32) * A_W + ch;
            for (int r2 = 0; r2 < 32; ++r2) { w += lr[dir * 32 + r2] * w2[(size_t)r2 * A_W]; a += lr[64 + dir * 32 + r2] * a2[(size_t)r2 * A_W]; }
            const float decay = -expf(-softplusf_(-w) - 0.5f);
            const float iclr = sigmoidf_(a);
            const float kd = k * (1.0f + (iclr - 1.0f) * p.rw_k_a[l * A_W + ch]);
            const size_t o = ((size_t)dir * NTOK + m) * A_W + ch;
            p.RW_D()[o] = decay; p.RW_KD()[o] = f2bf(kd); p.RW_KKA()[o] = f2bf(kk * iclr); kdsum += kd;
        }
        float g = 0.f; const float* g2 = p.rw_g2 + (size_t)l * 64 * A_W + ch;
        for (int r2 = 0; r2 < 64; ++r2) g += lr[128 + r2] * g2[(size_t)r2 * A_W];
        const size_t o = (size_t)m * A_W + ch;
        p.RW_R()[o] = f2bf(r); p.RW_V()[o] = f2bf(v); p.RW_KK()[o] = f2bf(kk); p.RW_GATE()[o] = f2bf(g);
        bon += r * kdsum * p.rw_r_k[l * A_W + ch];
    }
    p.RW_BON()[(size_t)m * A_H + h] = bon;
}
DEVFN void task_prepB(const P& p, int l, long task) {
    const int which = (int)(task % 4), h = (int)((task / 4) % B_H), m = (int)(task / (4 * B_H));
    int b, t, len, base; row_info(m, b, t, len, base);
    if (which == 3) {
        for (int dir = 0; dir < 2; ++dir) {
            const float a = ldU(p, (size_t)m * INP + B_OFF + 2048 + dir * 4 + h), bb = ldU(p, (size_t)m * INP + B_OFF + 2056 + dir * 4 + h);
            const float g = -expf(p.gdn_a_log[(l * 2 + dir) * B_H + h]) * softplusf_(a + p.gdn_dt_bias[(l * 2 + dir) * B_H + h]);
            p.GG()[(size_t)m * 8 + dir * 4 + h] = g; p.GBETA()[(size_t)m * 8 + dir * 4 + h] = sigmoidf_(bb);
        }
        return;
    }
    bf16_t* dst = (which == 0 ? p.GQ() : which == 1 ? p.GK() : p.GV()) + (size_t)m * B_W + h * 128;
    float ss = 0.f;
    for (int c = 0; c < 128; ++c) {
        const int cc = which * B_W + h * 128 + c; const int col = B_OFF + cc;
        float acc = 0.f;
        for (int j = 0; j < 5; ++j) { const int tt = t + j - 2; if (tt >= 0 && tt < len) acc += ldU(p, (size_t)(base + tt) * INP + col) * p.gdn_conv[((size_t)l * 5 + j) * (3 * B_W) + cc]; }
        const float s = siluf_(acc); if (which == 2) dst[c] = f2bf(s); ss += s * s;
    }
    if (which < 2) { const float rn = (1.0f / sqrtf(ss + 1e-6f)) * (which == 0 ? 0.08838834764831845f : 1.0f);
        for (int c = 0; c < 128; ++c) { const int cc = which * B_W + h * 128 + c; const int col = B_OFF + cc; float acc = 0.f;
            for (int j = 0; j < 5; ++j) { const int tt = t + j - 2; if (tt >= 0 && tt < len) acc += ldU(p, (size_t)(base + tt) * INP + col) * p.gdn_conv[((size_t)l * 5 + j) * (3 * B_W) + cc]; }
            dst[c] = f2bf(siluf_(acc) * rn); } }
}
DEVFN void task_prepC(const P& p, int l, long task) {
    const int m = (int)(task / 8), hs = (int)(task % 8);
    const size_t sb = (size_t)m * INP + C_OFF + hs * 64;
    if (hs >= 6) { int b_, t_, len_, base_; row_info(m, b_, t_, len_, base_); const int key = m < NLAT ? t_ : SEQ + t_;
        for (int d = 0; d < 64; ++d) p.CV()[((size_t)(b_ * 2 + (hs - 6)) * 64 + d) * SLEN + key] = p.U()[sb + d]; return; }
    float ss = 0.f; for (int d = 0; d < 64; ++d) { const float x = ldU(p, sb + d); ss += x * x; }
    const float qs = hs < 4 ? 0.18033688011112042f : 1.0f;
    const float rstd = (1.0f / sqrtf(ss / 64.f + 1e-6f)) * qs;
    const float* nw = (hs < 4 ? p.attn_q_norm : p.attn_k_norm) + l * 64;
    bf16_t* dst = hs < 4 ? p.CQ() + (size_t)m * 256 + hs * 64 : p.CK() + (size_t)m * 128 + (hs - 4) * 64;
    if (m >= NLAT) { for (int d = 0; d < 64; ++d) dst[d] = f2bf(ldU(p, sb + d) * rstd * nw[d]); return; }
    const int t = m % SEQ; const float pr = (float)(t / GRID_W), pc = (float)(t % GRID_W);
    for (int d = 0; d < 16; ++d) {
        const float fr = powf(10000.0f, -(float)d / 16.0f);
        const float ar = pr * fr, ac = pc * fr; const float cr = cosf(ar), sr = sinf(ar), cc = cosf(ac), sc = sinf(ac);
        const float x1 = ldU(p, sb + d) * rstd * nw[d], x2 = ldU(p, sb + 16 + d) * rstd * nw[16 + d], x3 = ldU(p, sb + 32 + d) * rstd * nw[32 + d], x4 = ldU(p, sb + 48 + d) * rstd * nw[48 + d];
        dst[d] = f2bf(x1 * cr - x2 * sr); dst[16 + d] = f2bf(x2 * cr + x1 * sr); dst[32 + d] = f2bf(x3 * cc - x4 * sc); dst[48 + d] = f2bf(x4 * cc + x3 * sc);
    }
}
DEVFN void task_scanA(const P& p, long task) {
    const int v = (int)(task % 64), chain = UNIFORM((int)(task / 64)); const int h = chain % A_H, b = (chain / A_H) % BATCH, dir = chain / (A_H * BATCH);
    float s[64];
#pragma unroll
    for (int k = 0; k < 64; ++k) s[k] = 0.f;
    for (int st = 0; st < SLEN; ++st) {
        const int m = scan_row(dir, b, st);
        const bf16_t* kk = p.RW_KK() + (size_t)m * A_W + h * 64; const bf16_t* rr = p.RW_R() + (size_t)m * A_W + h * 64;
        const size_t od = ((size_t)dir * NTOK + m) * A_W + h * 64;
        const float* dd = p.RW_D() + od; const bf16_t* kd = p.RW_KD() + od; const bf16_t* ka = p.RW_KKA() + od;
        const float vv = bf2f(p.RW_V()[(size_t)m * A_W + h * 64 + v]);
        float sa = 0.f;
#pragma unroll
        for (int k = 0; k < 64; ++k) { sa += s[k] * bf2f(kk[k]); if ((k & 15) == 15) LOADFENCE(); }
        float y = 0.f;
#pragma unroll
        for (int k = 0; k < 64; ++k) { s[k] = s[k] * expf(dd[k]) - sa * bf2f(ka[k]) + vv * bf2f(kd[k]); y += s[k] * bf2f(rr[k]); if ((k & 7) == 7) LOADFENCE(); }
        p.YA()[((size_t)dir * NTOK + m) * A_W + h * 64 + v] = f2bf(y);
    }
}
DEVFN void task_scanB(const P& p, long task) {
    const int j = (int)(task % 128), chain = UNIFORM((int)(task / 128)); const int h = chain % B_H, b = (chain / B_H) % BATCH, dir = chain / (B_H * BATCH);
    float s[128];
#pragma unroll
    for (int k = 0; k < 128; ++k) s[k] = 0.f;
    for (int st = 0; st < SLEN; ++st) {
        const int m = scan_row(dir, b, st);
        const bf16_t* kv = p.GK() + (size_t)m * B_W + h * 128; const bf16_t* qv = p.GQ() + (size_t)m * B_W + h * 128;
        const float vj = bf2f(p.GV()[(size_t)m * B_W + h * 128 + j]);
        const float eg = expf(p.GG()[(size_t)m * 8 + dir * 4 + h]), beta = p.GBETA()[(size_t)m * 8 + dir * 4 + h];
        float pk = 0.f;
#pragma unroll
        for (int k = 0; k < 128; ++k) { pk += s[k] * bf2f(kv[k]); if ((k & 15) == 15) LOADFENCE(); }
        const float cf = beta * (vj - eg * pk);
        float o = 0.f;
#pragma unroll
        for (int k = 0; k < 128; ++k) { s[k] = eg * s[k] + cf * bf2f(kv[k]); o += s[k] * bf2f(qv[k]); if ((k & 7) == 7) LOADFENCE(); }
        p.OB()[((size_t)dir * NTOK + m) * B_W + h * 128 + j] = f2bf(o);
    }
}
DEVFN void task_attn(const P& p, int need_ctx, long task) {
    const int t = (int)(task % SLEN), hq = UNIFORM((int)((task / SLEN) % 4)), b = UNIFORM((int)(task / ((long)SLEN * 4)));
    const bool is_lat = UNIFORM((int)(t < SEQ)) != 0; if (!is_lat && !need_ctx) return;
    const int m = is_lat ? b * SEQ + t : NLAT + b * CTXL + (t - SEQ);
    const int kvh = hq >> 1;
    float q[64], o[64];
#pragma unroll
    for (int d = 0; d < 64; ++d) { q[d] = bf2f(p.CQ()[(size_t)m * 256 + hq * 64 + d]); o[d] = 0.f; }
    float mx = -1e30f, lsum = 0.f;
    const int nk = is_lat ? SLEN : CTXL;
    for (int kI = 0; kI < nk; ++kI) {
        int km; if (is_lat) km = kI < SEQ ? b * SEQ + kI : NLAT + b * CTXL + (kI - SEQ); else km = NLAT + b * CTXL + kI;
        const bf16_t* kr = p.CK() + (size_t)km * 128 + kvh * 64; const bf16_t* vr = p.CV() + ((size_t)(b * 2 + kvh) * 64) * SLEN + (is_lat ? kI : SEQ + kI);
        float sc = 0.f;
#pragma unroll
        for (int d = 0; d < 64; ++d) { sc += q[d] * bf2f(kr[d]); if ((d & 15) == 15) LOADFENCE(); }
        const float mn = sc > mx ? sc : mx; const float f = exp2f(mx - mn), pe = exp2f(sc - mn);
        lsum = lsum * f + pe; mx = mn;
#pragma unroll
        for (int d = 0; d < 64; ++d) { o[d] = o[d] * f + pe * bf2f(vr[(size_t)d * SLEN]); if ((d & 15) == 15) LOADFENCE(); }
    }
    const float inv = 1.0f / lsum;
#pragma unroll
    for (int d = 0; d < 64; ++d) p.MIX()[(size_t)m * D + 768 + hq * 64 + d] = f2bf(o[d] * inv);
}
DEVFN void task_post(const P& p, int l, long task) {
    const int m = (int)(task / 8), g = (int)(task % 8);
    if (g < 4) {
        const int h = g; const bf16_t* y0 = p.YA() + (size_t)m * A_W + h * 64; const bf16_t* y1 = p.YA() + ((size_t)NTOK + m) * A_W + h * 64;
        float mean = 0.f; for (int c = 0; c < 64; ++c) mean += bf2f(y0[c]) + bf2f(y1[c]); mean *= (1.0f / 64.f);
        float var = 0.f; for (int c = 0; c < 64; ++c) { const float d0 = bf2f(y0[c]) + bf2f(y1[c]) - mean; var += d0 * d0; } var *= (1.0f / 64.f);
        const float rs = 1.0f / sqrtf(var + 64e-5f); const float bon = p.RW_BON()[(size_t)m * A_H + h];
        for (int c = 0; c < 64; ++c) { const int ch = h * 64 + c;
            const float yn = (bf2f(y0[c]) + bf2f(y1[c]) - mean) * rs * p.rw_ln_w[l * A_W + ch] + p.rw_ln_b[l * A_W + ch];
            p.MIX()[(size_t)m * D + ch] = f2bf((yn + bon * bf2f(p.RW_V()[(size_t)m * A_W + ch])) * bf2f(p.RW_GATE()[(size_t)m * A_W + ch])); }
    } else {
        const int h = g - 4; const bf16_t* o0 = p.OB() + (size_t)m * B_W + h * 128; const bf16_t* o1 = p.OB() + ((size_t)NTOK + m) * B_W + h * 128;
        float ss = 0.f; for (int c = 0; c < 128; ++c) { const float o = bf2f(o0[c]) + bf2f(o1[c]); ss += o * o; }
        const float rs = 1.0f / sqrtf(ss / 128.f + 1e-6f);
        for (int c = 0; c < 128; ++c) { const float z = ldU(p, (size_t)m * INP + B_OFF + 1536 + h * 128 + c);
            p.MIX()[(size_t)m * D + 256 + h * 128 + c] = f2bf((bf2f(o0[c]) + bf2f(o1[c])) * rs * p.gdn_norm[l * 128 + c] * siluf_(z)); }
    }
}
DEVFN void task_resid1(const P& p, int l, long task) {
    const int m = (int)task; const bf16_t* mo = p.MO() + (size_t)m * D; float* xr = p.X() + (size_t)m * D;
    const float* md = p.MOD() + ((size_t)l * (BATCH + 1) + mod_row(m)) * 6 * D;
    float ss = 0.f; for (int k = 0; k < D; ++k) ss += bf2f(mo[k]) * bf2f(mo[k]);
    const float rstd = 1.0f / sqrtf(ss / D + 1e-6f); const float* pn = p.post_norm + (size_t)(l * 2 + 0) * D;
    float s2 = 0.f;
    for (int k = 0; k < D; ++k) { const float xv = xr[k] + md[2 * D + k] * (bf2f(mo[k]) * rstd) * pn[k]; xr[k] = xv; s2 += xv * xv; }
    const float r2 = 1.0f / sqrtf(s2 / D + 1e-6f); const float* pn2 = p.pre_norm + (size_t)(l * 2 + 1) * D;
    for (int k = 0; k < D; ++k) { const float tv = xr[k] * r2 * pn2[k] * (1.0f + md[4 * D + k]) + md[3 * D + k]; p.TOKF()[(size_t)m * D + k] = tv; p.HB()[(size_t)m * D + k] = f2bf(tv); }
}
DEVFN void task_router(const P& p, int l, long task) {
    const int m = (int)task; const float* tk = p.TOKF() + (size_t)m * D; const float* rw = p.router_w + (size_t)l * D * NEXP;
    float lg[NEXP];
#pragma unroll
    for (int e = 0; e < NEXP; ++e) lg[e] = p.router_b[l * NEXP + e];
    for (int k = 0; k < D; ++k) { const float tv = tk[k];
#pragma unroll
        for (int e = 0; e < NEXP; ++e) lg[e] += tv * rw[(size_t)k * NEXP + e]; }
    int idx[TOPK]; float val[TOPK];
#pragma unroll
    for (int j = 0; j < TOPK; ++j) { float best = -3.0e38f; int bi = 0;
#pragma unroll
        for (int e = 0; e < NEXP; ++e) { if (lg[e] > best) { best = lg[e]; bi = e; } }
        idx[j] = bi; val[j] = best;
#pragma unroll
        for (int e = 0; e < NEXP; ++e) if (e == bi) lg[e] = -3.0e38f; }
    float sum = 0.f, ex[TOPK];
#pragma unroll
    for (int j = 0; j < TOPK; ++j) { ex[j] = expf(val[j] - val[0]); sum += ex[j]; }
#pragma unroll
    for (int j = 0; j < TOPK; ++j) { p.TOPI()[(size_t)m * TOPK + j] = idx[j]; p.TOPG()[(size_t)m * TOPK + j] = ex[j] / sum; p.POS()[(size_t)m * TOPK + j] = GLOBAL_ATOMIC_ADD(&p.cnt()[l * NEXP + idx[j]], 1); }
}
DEVFN int moe_pstart(const P& p, int l, int e, int* nblk) {
    int acc = 0, ps = 0;
    for (int i = 0; i < NEXP; ++i) { if (i == e) ps = acc; acc += (p.cnt()[l * NEXP + i] + 255) / 256 * 256; }
    if (nblk) *nblk = acc / 256; return ps;
}
DEVFN void task_slots(const P& p, int l, long task) {
    const int e = p.TOPI()[task]; const int slot = moe_pstart(p, l, e, nullptr) + p.POS()[task];
    p.TSLOT()[task] = slot; p.SLOT_TOK()[slot] = (int)(task / TOPK);
}
DEVFN void task_blocke(const P& p, int l, long task) {
    int acc = 0, e_of = NEXP - 1, nb = 0;
    for (int i = 0; i < NEXP; ++i) { const int nbk = (p.cnt()[l * NEXP + i] + 255) / 256; if ((int)task >= acc && (int)task < acc + nbk) e_of = i; acc += nbk; }
    nb = acc; p.BLOCK_E()[task] = e_of; if (task == 0) p.NBLK()[0] = nb;
}
DEVFN void task_gather(const P& p, long task) {
    const long slot = task / 128; const int ch = (int)(task % 128); const int tok = p.SLOT_TOK()[slot];
    const uint4* s = (const uint4*)(p.HB() + (size_t)tok * D) + ch; ((uint4*)(p.XG() + (size_t)slot * D))[ch] = *s;
}
DEVFN void task_combine(const P& p, int l, long task) {
    const int m = (int)task; float* xr = p.X() + (size_t)m * D; const float* md = p.MOD() + ((size_t)l * (BATCH + 1) + mod_row(m)) * 6 * D;
    const bf16_t* y0 = p.YB() + (size_t)p.TSLOT()[(size_t)m * 4 + 0] * D; const bf16_t* y1 = p.YB() + (size_t)p.TSLOT()[(size_t)m * 4 + 1] * D;
    const bf16_t* y2 = p.YB() + (size_t)p.TSLOT()[(size_t)m * 4 + 2] * D; const bf16_t* y3 = p.YB() + (size_t)p.TSLOT()[(size_t)m * 4 + 3] * D;
    const float g0 = p.TOPG()[(size_t)m * 4 + 0], g1 = p.TOPG()[(size_t)m * 4 + 1], g2 = p.TOPG()[(size_t)m * 4 + 2], g3 = p.TOPG()[(size_t)m * 4 + 3];
    float ss = 0.f;
    for (int k = 0; k < D; ++k) { const float f = g0 * bf2f(y0[k]) + g1 * bf2f(y1[k]) + g2 * bf2f(y2[k]) + g3 * bf2f(y3[k]); ss += f * f; }
    const float rstd = 1.0f / sqrtf(ss / D + 1e-6f); const float* pn = p.post_norm + (size_t)(l * 2 + 1) * D;
    const bool last = (l == DEPTH - 1);
    for (int k = 0; k < D; ++k) { const float f = g0 * bf2f(y0[k]) + g1 * bf2f(y1[k]) + g2 * bf2f(y2[k]) + g3 * bf2f(y3[k]);
        const float xv = xr[k] + md[5 * D + k] * (f * rstd) * pn[k]; xr[k] = xv; if (last) p.out[(size_t)m * D + k] = xv; }
}

#ifndef HOST_TEST
namespace pg8 {
#define PG8_LAS __attribute__((address_space(3)))
typedef short bf16x8 __attribute__((ext_vector_type(8)));
typedef float f32x4 __attribute__((ext_vector_type(4)));
typedef unsigned u32x4 __attribute__((ext_vector_type(4)));
typedef unsigned u32x2 __attribute__((ext_vector_type(2)));
constexpr int BM = 256, BK = 64, HALF = 128, HTB = HALF * BK * 2, STAGE_BYTES = 8 * HTB, NXCD = 8, WGM = 8;
__host__ __device__ __forceinline__ int lds_byte(int r, int c) { const int st = (r >> 4) * 2 + (c >> 5), rr = r & 15, cc = c & 31, ob = rr * 64 + cc * 2; return st * 1024 + (ob ^ (((ob >> 9) & 1) << 5)); }
__host__ __device__ __forceinline__ void stage_rc(int b, int& R, int& C) { const int st = b / 1024, sb = b % 1024, swz = sb ^ (((sb >> 9) & 1) << 5); R = (st >> 1) * 16 + swz / 64; C = (st & 1) * 32 + (swz % 64) / 2; }
__host__ __device__ __forceinline__ int perm32(int rho) { const int n = rho >> 4, i = rho & 15; return 8 * (i >> 2) + 4 * n + (i & 3); }
struct Unit { int pm, pn, e; };
struct Gemm { const bf16_t* A; const bf16_t* Bt; int K; size_t estride; const int* rowidx; };
struct StaticOrder {
    int nM, nN, nwg, G, c;
    __device__ void init(int M, int N, int G_, int c_) { nM = M / BM; nN = N / BM; nwg = nM * nN; G = G_; c = c_; }
    __device__ bool next(int i, Unit& u) const {
        const long L = (long)i * G + c; if (L >= nwg) return false;
        int wgid = (int)L; { const int q = nwg / NXCD, r = nwg % NXCD, xcd = wgid % NXCD, off = wgid / NXCD; wgid = (xcd < r ? xcd * (q + 1) : r * (q + 1) + (xcd - r) * q) + off; }
        const int nig = WGM * nN, gid = wgid / nig, fm = gid * WGM, gsz = (nM - fm) < WGM ? (nM - fm) : WGM;
        u.pm = fm + ((wgid % nig) % gsz); u.pn = (wgid % nig) / gsz; u.e = 0; return true;
    }
};
struct MoeOrder {
    int nblk, nN, G, c; const int* block_e;
    __device__ bool next(int i, Unit& u) const {
        if (G % 8 != 0 || (G / 8) % nN != 0) { const long L = (long)i * G + c; if (L >= (long)nblk * nN) return false; u.pm = (int)(L / nN); u.pn = (int)(L % nN); }
        else { const int x = c & 7, r = c >> 3, per = (G / 8) / nN; const int mb = (i * per + r / nN) * 8 + x; if (mb >= nblk) return false; u.pm = mb; u.pn = r % nN; }
        u.e = __builtin_amdgcn_readfirstlane(block_e[u.pm]); return true;
    }
};
typedef float f32x2c_t __attribute__((ext_vector_type(2))); typedef __bf16 bf16x2c_t __attribute__((ext_vector_type(2)));
__device__ __forceinline__ unsigned cvt_pk_bf16(float lo, float hi) { const f32x2c_t v = {lo, hi}; const bf16x2c_t b = __builtin_convertvector(v, bf16x2c_t); return __builtin_bit_cast(unsigned, b); }
struct EpiF32 {
    static constexpr bool PERM = false;
    float* C; int ldc;
    __device__ __forceinline__ void operator()(const f32x4 (&acc)[2][2][4][2], const Unit& u, int wr, int wc, int fr, int fq) const {
        const int row0 = u.pm * BM + wr * 64 + fr, col0 = u.pn * BM + wc * 32 + 4 * fq;
#pragma unroll
        for (int ai = 0; ai < 2; ++ai)
#pragma unroll
            for (int m = 0; m < 4; ++m) { float* rowp = C + (size_t)(row0 + ai * HALF + m * 16) * ldc + col0;
#pragma unroll
                for (int bj = 0; bj < 2; ++bj)
#pragma unroll
                    for (int n = 0; n < 2; ++n) *(f32x4*)(rowp + bj * HALF + n * 16) = acc[ai][bj][m][n]; }
    }
};
struct EpiBf16Bias {
    static constexpr bool PERM = true;
    bf16_t* O; int ldc; const float* bias; int bias_estride;
    __device__ __forceinline__ void operator()(const f32x4 (&acc)[2][2][4][2], const Unit& u, int wr, int wc, int fr, int fq) const {
        const int row0 = u.pm * BM + wr * 64 + fr, col0 = u.pn * BM + wc * 32 + 8 * fq; const float* bp = bias + (size_t)u.e * bias_estride + col0;
        f32x4 bv[2][2];
#pragma unroll
        for (int bj = 0; bj < 2; ++bj)
#pragma unroll
            for (int n = 0; n < 2; ++n) bv[bj][n] = bias ? *(const f32x4*)(bp + bj * HALF + 4 * n) : (f32x4){0.f, 0.f, 0.f, 0.f};
#pragma unroll
        for (int ai = 0; ai < 2; ++ai)
#pragma unroll
            for (int m = 0; m < 4; ++m) { bf16_t* rowp = O + (size_t)(row0 + ai * HALF + m * 16) * ldc + col0;
#pragma unroll
                for (int bj = 0; bj < 2; ++bj) { const f32x4 v0 = acc[ai][bj][m][0] + bv[bj][0], v1 = acc[ai][bj][m][1] + bv[bj][1];
                    u32x4 w; w.x = cvt_pk_bf16(v0[0], v0[1]); w.y = cvt_pk_bf16(v0[2], v0[3]); w.z = cvt_pk_bf16(v1[0], v1[1]); w.w = cvt_pk_bf16(v1[2], v1[3]);
                    *(u32x4*)(rowp + bj * HALF) = w; } }
    }
};
__device__ __forceinline__ float swiglu1(float g, float lin) { g = fminf(g, 7.0f); lin = fminf(fmaxf(lin, -7.0f), 7.0f); return g * __builtin_amdgcn_rcpf(1.0f + __expf(-1.702f * g)) * (lin + 1.0f); }
struct EpiSwiglu {
    static constexpr bool PERM = true;
    bf16_t* O; int ldc; const float* bias; int bias_estride;
    __device__ __forceinline__ void operator()(const f32x4 (&acc)[2][2][4][2], const Unit& u, int wr, int wc, int fr, int fq) const {
        const int row0 = u.pm * BM + wr * 64 + fr, col0 = u.pn * BM + wc * 32 + 8 * fq; const float* bp = bias + (size_t)u.e * bias_estride + col0;
        f32x4 bv[2][2];
#pragma unroll
        for (int bj = 0; bj < 2; ++bj)
#pragma unroll
            for (int n = 0; n < 2; ++n) bv[bj][n] = *(const f32x4*)(bp + bj * HALF + 4 * n);
#pragma unroll
        for (int ai = 0; ai < 2; ++ai)
#pragma unroll
            for (int m = 0; m < 4; ++m) { bf16_t* rowp = O + (size_t)(row0 + ai * HALF + m * 16) * ldc + (col0 >> 1);
#pragma unroll
                for (int bj = 0; bj < 2; ++bj) { const f32x4 v0 = acc[ai][bj][m][0] + bv[bj][0], v1 = acc[ai][bj][m][1] + bv[bj][1];
                    u32x2 w; w.x = cvt_pk_bf16(swiglu1(v0[0], v0[1]), swiglu1(v0[2], v0[3])); w.y = cvt_pk_bf16(swiglu1(v1[0], v1[1]), swiglu1(v1[2], v1[3]));
                    *(u32x2*)(rowp + bj * (HALF / 2)) = w; } }
    }
};

template <bool GATHER = false, class Epi, class Sched>
__device__ __forceinline__ void gemm_phase(PG8_LAS unsigned char* lds, const Gemm g, const Sched& S, const Epi& E, int tid) {
    asm volatile("" : "+v"(tid));
    const int wid = __builtin_amdgcn_readfirstlane(tid >> 6), lane = tid & 63, wr = wid >> 2, wc = wid & 3, fr = lane & 15, fq = lane >> 4;
    int K = g.K; asm volatile("" : "+s"(K));
    const int nt = K / BK;
    unsigned voffA[2], voffB[2];
#pragma unroll
    for (int i = 0; i < 2; ++i) { int R, C; stage_rc(tid * 16 + i * 8192, R, C); const int Rb = Epi::PERM ? ((R & ~31) + perm32(R & 31)) : R;
        voffA[i] = GATHER ? 0u : (unsigned)(R * K + C) * 2u; voffB[i] = (unsigned)(Rb * K + C) * 2u; }
    const size_t kstep = (size_t)(BK * 2);
    const size_t hstep = (size_t)HALF * K * 2;
    const size_t tstep = 2 * hstep;
    const unsigned ldsw = (unsigned)wid * 1024u;
    const int aoff = lds_byte(wr * 64 + fr, fq * 8), boff = lds_byte(wc * 32 + fr, fq * 8);
#define PG8_SA(b, h) (((b) * 2 + (h)) * HTB)
#define PG8_SB(b, h) ((4 + (b) * 2 + (h)) * HTB)
#define PG8_STAGE(bufoff, gbase, voff) do { _Pragma("unroll") for (int _i = 0; _i < 2; ++_i) \
        __builtin_amdgcn_global_load_lds((const unsigned*)((const char*)(gbase) + (voff)[_i]), (PG8_LAS unsigned*)(lds + (bufoff) + ldsw + _i * 8192), 16, 0, 0); } while (0)
#define PG8_STAGE_A(bufoff, h, nx, kb) do { _Pragma("unroll") for (int _i = 0; _i < 2; ++_i) { \
        if constexpr (GATHER) { const unsigned _o = (nx) ? on[h][_i] : oc[h][_i]; \
            __builtin_amdgcn_global_load_lds((const unsigned*)((const char*)g.A + (size_t)_o + (size_t)(kb)), (PG8_LAS unsigned*)(lds + (bufoff) + ldsw + _i * 8192), 16, 0, 0); } \
        else { const char* _b = ((nx) ? nA : cA) + (size_t)(h) * hstep + (size_t)(kb); \
            __builtin_amdgcn_global_load_lds((const unsigned*)(_b + voffA[_i]), (PG8_LAS unsigned*)(lds + (bufoff) + ldsw + _i * 8192), 16, 0, 0); } } } while (0)
#define PG8_LDA(dst, b, h) do { _Pragma("unroll") for (int m = 0; m < 4; ++m) _Pragma("unroll") for (int k = 0; k < 2; ++k) dst[m][k] = *(const PG8_LAS bf16x8*)(lds + PG8_SA(b, h) + aoff + m * 2048 + k * 1024); } while (0)
#define PG8_LDB(dst, b, h) do { _Pragma("unroll") for (int n = 0; n < 2; ++n) _Pragma("unroll") for (int k = 0; k < 2; ++k) dst[n][k] = *(const PG8_LAS bf16x8*)(lds + PG8_SB(b, h) + boff + n * 2048 + k * 1024); } while (0)
#define PG8_MMA(ai, bj, At, Bt) do { __builtin_amdgcn_s_setprio(1); _Pragma("unroll") for (int m = 0; m < 4; ++m) _Pragma("unroll") for (int n = 0; n < 2; ++n) _Pragma("unroll") for (int k = 0; k < 2; ++k) \
        acc[ai][bj][m][n] = __builtin_amdgcn_mfma_f32_16x16x32_bf16(Bt[n][k], At[m][k], acc[ai][bj][m][n], 0, 0, 0); __builtin_amdgcn_s_setprio(0); } while (0)
#define PG8_WAIT_V(n) asm volatile("s_waitcnt vmcnt(" #n ")" ::: "memory")
#define PG8_WAIT_L(n) asm volatile("s_waitcnt lgkmcnt(" #n ")" ::: "memory")
#define PG8_BAR __builtin_amdgcn_s_barrier()
#define PG8_SCHED __builtin_amdgcn_sched_barrier(0)
    Unit cur, nxt; int ui = 0;
    if (!S.next(0, cur)) return;
    unsigned oc[2][2], on[2][2];
    const char* cA = (const char*)g.A + (size_t)cur.pm * tstep; const char* nA = cA;
#define PG8_UNIT_OFFS(o, u) do { _Pragma("unroll") for (int _h = 0; _h < 2; ++_h) _Pragma("unroll") for (int _i = 0; _i < 2; ++_i) { \
        if constexpr (GATHER) { int _R, _C; stage_rc(tid * 16 + _i * 8192, _R, _C); (o)[_h][_i] = (unsigned)g.rowidx[(u).pm * BM + _h * HALF + _R] * (unsigned)(K * 2) + (unsigned)(_C * 2); } else (o)[_h][_i] = 0u; } } while (0)
    PG8_UNIT_OFFS(oc, cur);
    f32x4 acc[2][2][4][2];
#pragma unroll
    for (int a = 0; a < 2; ++a)
#pragma unroll
        for (int b = 0; b < 2; ++b)
#pragma unroll
            for (int m = 0; m < 4; ++m)
#pragma unroll
                for (int n = 0; n < 2; ++n) acc[a][b][m][n] = (f32x4){0.f, 0.f, 0.f, 0.f};
    bf16x8 At[4][2], B0[2][2], B1[2][2];
    const char* cB = (const char*)(g.Bt + (size_t)cur.e * g.estride) + (size_t)cur.pn * tstep;
    PG8_STAGE(PG8_SB(0, 0), cB, voffB); PG8_STAGE(PG8_SB(0, 1), cB + hstep, voffB); PG8_STAGE_A(PG8_SA(0, 0), 0, false, 0); PG8_STAGE_A(PG8_SA(0, 1), 1, false, 0);
    if (wr == 1) PG8_BAR;
    PG8_WAIT_V(2); PG8_BAR;
    PG8_STAGE(PG8_SB(1, 0), cB + kstep, voffB); PG8_STAGE_A(PG8_SA(1, 0), 0, false, kstep); PG8_STAGE(PG8_SB(1, 1), cB + hstep + kstep, voffB);
    PG8_WAIT_V(6); PG8_BAR;
    for (;;) {
        const bool has_next = S.next(ui + 1, nxt);
        if (has_next) { PG8_UNIT_OFFS(on, nxt); nA = (const char*)g.A + (size_t)nxt.pm * tstep; } else { nA = cA; _Pragma("unroll") for (int _h = 0; _h < 2; ++_h) _Pragma("unroll") for (int _i = 0; _i < 2; ++_i) on[_h][_i] = oc[_h][_i]; }
        const char* nB = has_next ? (const char*)(g.Bt + (size_t)nxt.e * g.estride) + (size_t)nxt.pn * tstep : cB;
        for (int t = 0; t < nt; t += 2) {
            const bool last = (t == nt - 2);
            const size_t ka1 = (size_t)(t + 1) * kstep, ka2 = last ? 0 : (size_t)(t + 2) * kstep, ka3 = ka2 + kstep;
            const char* b2 = last ? nB : cB + (size_t)(t + 2) * kstep; const char* b3 = b2 + kstep;
            PG8_LDB(B0, 0, 0); PG8_LDB(B1, 0, 1); PG8_SCHED; PG8_LDA(At, 0, 0); PG8_STAGE_A(PG8_SA(1, 1), 1, false, ka1);
            PG8_WAIT_V(8); PG8_WAIT_L(0); PG8_BAR; PG8_MMA(0, 0, At, B0); PG8_MMA(0, 1, At, B1); PG8_BAR; PG8_SCHED;
            PG8_LDA(At, 0, 1); PG8_STAGE(PG8_SB(0, 0), b2, voffB); PG8_STAGE(PG8_SB(0, 1), b2 + hstep, voffB); PG8_STAGE_A(PG8_SA(0, 0), 0, last, ka2);
            PG8_WAIT_V(8); PG8_WAIT_L(0); PG8_BAR; PG8_MMA(1, 0, At, B0); PG8_MMA(1, 1, At, B1); PG8_BAR; PG8_SCHED;
            PG8_LDB(B0, 1, 0); PG8_LDB(B1, 1, 1); PG8_SCHED; PG8_LDA(At, 1, 0); PG8_STAGE_A(PG8_SA(0, 1), 1, last, ka2);
            PG8_WAIT_V(8); PG8_WAIT_L(0); PG8_BAR; PG8_MMA(0, 0, At, B0); PG8_MMA(0, 1, At, B1); PG8_BAR; PG8_SCHED;
            PG8_LDA(At, 1, 1); PG8_STAGE(PG8_SB(1, 0), b3, voffB); PG8_STAGE(PG8_SB(1, 1), b3 + hstep, voffB); PG8_STAGE_A(PG8_SA(1, 0), 0, last, ka3);
            PG8_WAIT_V(8); PG8_WAIT_L(0); PG8_BAR; PG8_MMA(1, 0, At, B0); PG8_MMA(1, 1, At, B1); PG8_BAR; PG8_SCHED;
        }
        if (wr == 0) PG8_BAR;
        E(acc, cur, wr, wc, fr, fq);
        if (!has_next) break;
#pragma unroll
        for (int a = 0; a < 2; ++a)
#pragma unroll
            for (int b = 0; b < 2; ++b)
#pragma unroll
                for (int m = 0; m < 4; ++m)
#pragma unroll
                    for (int n = 0; n < 2; ++n) acc[a][b][m][n] = (f32x4){0.f, 0.f, 0.f, 0.f};
        cur = nxt; cA = nA; cB = nB; ++ui;
#pragma unroll
        for (int _h = 0; _h < 2; ++_h)
#pragma unroll
            for (int _i = 0; _i < 2; ++_i) oc[_h][_i] = on[_h][_i];
        if (wr == 1) PG8_BAR;
    }
    PG8_WAIT_V(0);
    PG8_BAR;
#undef PG8_UNIT_OFFS
#undef PG8_SA
#undef PG8_SB
#undef PG8_STAGE
#undef PG8_STAGE_A
#undef PG8_LDA
#undef PG8_LDB
#undef PG8_MMA
#undef PG8_WAIT_V
#undef PG8_WAIT_L
#undef PG8_BAR
#undef PG8_SCHED
}
}

#define XB_TMO      128
#define XB_XCNT(j)  (256  + 64 * (j))
#define XB_XSUB(j)  (1280 + 64 * (j))
#define XB_XGEN(j)  (2304 + 64 * (j))
#define XB_TOP      3328
#define XB_TOPGEN   3392
#define XCD_BAR_WORDS 3456
#define XB_SPIN_CAP (1u << 22)
#define LAS __attribute__((address_space(3)))
__device__ __forceinline__ unsigned xb_ld(unsigned* p)              { return __hip_atomic_load(p, __ATOMIC_RELAXED, __HIP_MEMORY_SCOPE_AGENT); }
__device__ __forceinline__ unsigned xb_add(unsigned* p, unsigned v) { return __hip_atomic_fetch_add(p, v, __ATOMIC_RELAXED, __HIP_MEMORY_SCOPE_AGENT); }
__device__ __forceinline__ unsigned xb_xcc_id() { return (unsigned)__builtin_amdgcn_s_getreg((3 << 11) | 20) & 0xFu; }
#define XB_SPIN(cond, bar) do { unsigned _sp = 0; while (cond) { __builtin_amdgcn_s_sleep(1); \
    if ((++_sp & 255u) == 0u) { if (xb_ld(&(bar)[XB_TMO])) break; if (_sp > XB_SPIN_CAP) { atomicAdd(&(bar)[XB_TMO], 1u); break; } } } } while (0)
struct XcdBarrier { unsigned* bar; unsigned x; volatile LAS unsigned* st; };
__device__ __forceinline__ XcdBarrier xcd_barrier_post(unsigned* bar, volatile LAS unsigned* st, int tid) {
    XcdBarrier b; b.bar = bar; b.x = xb_xcc_id(); b.st = st;
    if (tid == 0) (void)xb_add(&bar[XB_XCNT(b.x)], 1u);
    return b;
}
__device__ __forceinline__ void xcd_barrier_complete(unsigned* bar, unsigned x, unsigned& nloc, unsigned& nx) {
    const unsigned G = gridDim.x * gridDim.y * gridDim.z;
    unsigned sum, cnt, mine, sp = 0u;
    for (;;) {
        sum = 0u; cnt = 0u; mine = 0u;
#pragma unroll
        for (unsigned j = 0; j < 16; ++j) { const unsigned c = xb_ld(&bar[XB_XCNT(j)]); sum += c; cnt += (c > 0u) ? 1u : 0u; mine = (j == x) ? c : mine; }
        if (sum == G) break;
        __builtin_amdgcn_s_sleep(1);
        if ((++sp & 255u) == 0u) { if (xb_ld(&bar[XB_TMO])) break; if (sp > XB_SPIN_CAP) { atomicAdd(&bar[XB_TMO], 1u); break; } }
    }
    nloc = mine > 0u ? mine : 1u; nx = cnt > 0u ? cnt : 1u;
}
__device__ __forceinline__ void xcd_barrier(const XcdBarrier& b, int tid) {
    asm volatile("s_waitcnt vmcnt(0)" ::: "memory");
    __syncthreads();
    if (tid == 0) {
        unsigned* bar = b.bar;
        __builtin_amdgcn_s_waitcnt(0);
        unsigned nloc = b.st[0], nx = b.st[1];
        if (nloc == 0u) { xcd_barrier_complete(bar, b.x, nloc, nx); b.st[0] = nloc; b.st[1] = nx; }
        const unsigned old = xb_add(&bar[XB_XSUB(b.x)], 1u);
        const unsigned gen = old / nloc;
        if (old + 1u == (gen + 1u) * nloc) {
            __builtin_amdgcn_fence(__ATOMIC_RELEASE, "agent");
            asm volatile("s_waitcnt vmcnt(0)" ::: "memory");
            const unsigned og = xb_add(&bar[XB_TOP], 1u);
            const unsigned tg = og / nx;
            if (og + 1u == (tg + 1u) * nx) xb_add(&bar[XB_TOPGEN], 1u);
            else XB_SPIN(xb_ld(&bar[XB_TOPGEN]) == tg, bar);
            __builtin_amdgcn_fence(__ATOMIC_ACQUIRE, "agent");
            xb_add(&bar[XB_XGEN(b.x)], 1u);
            asm volatile("s_waitcnt vmcnt(0)" ::: "memory");
        } else {
            XB_SPIN(xb_ld(&bar[XB_XGEN(b.x)]) == gen, bar);
            __builtin_amdgcn_fence(__ATOMIC_ACQUIRE, "agent");
            asm volatile("s_waitcnt vmcnt(0)" ::: "memory");
        }
    }
    __syncthreads();
}


constexpr int NWAVES = 8, NTHR = 512;
constexpr int NPH = 15;
__device__ __forceinline__ float frsq(float x) { return __builtin_amdgcn_rsqf(x); }
__device__ __forceinline__ float frcp(float x) { return __builtin_amdgcn_rcpf(x); }
typedef float f32x4_t __attribute__((ext_vector_type(4)));
typedef unsigned u32x2_t __attribute__((ext_vector_type(2)));
typedef unsigned u32x4_t __attribute__((ext_vector_type(4)));
typedef short bf16x8_t __attribute__((ext_vector_type(8)));
__device__ __forceinline__ float wave_sum(float v) {
#pragma unroll
    for (int o = 1; o < 64; o <<= 1) v += __shfl_xor(v, o);
    return v;
}
__device__ __forceinline__ float grp16_sum(float v) {
#pragma unroll
    for (int o = 1; o < 16; o <<= 1) v += __shfl_xor(v, o);
    return v;
}
__device__ __forceinline__ float hsum4(f32x4_t a) { return (a.x + a.y) + (a.z + a.w); }
__device__ __forceinline__ float hsq4(f32x4_t a) { return (a.x * a.x + a.y * a.y) + (a.z * a.z + a.w * a.w); }
__device__ __forceinline__ u32x2_t pk4(f32x4_t t) { u32x2_t w; w.x = pg8::cvt_pk_bf16(t.x, t.y); w.y = pg8::cvt_pk_bf16(t.z, t.w); return w; }
__device__ __forceinline__ float bflo(unsigned w) { return __builtin_bit_cast(float, w << 16); }
__device__ __forceinline__ float bfhi(unsigned w) { return __builtin_bit_cast(float, w & 0xffff0000u); }
__device__ __forceinline__ f32x4_t bf4(u32x2_t w) { f32x4_t r; r.x = bflo(w.x); r.y = bfhi(w.x); r.z = bflo(w.y); r.w = bfhi(w.y); return r; }
template <bool TO_LDS> __device__ __forceinline__ void norm_mod_store(const f32x4_t (&v)[4], float rstd, const float* pn, const float* sh, const float* sc, bf16_t* orow, LAS unsigned char* lrow, int lane) {
#pragma unroll
    for (int j = 0; j < 4; ++j) { const int k = 4 * lane + 256 * j;
        const f32x4_t pv = *(const f32x4_t*)(pn + k), sv = *(const f32x4_t*)(sc + k), hv = *(const f32x4_t*)(sh + k);
        const f32x4_t t = v[j] * rstd * pv * (1.0f + sv) + hv; const u32x2_t w = pk4(t);
        *(u32x2_t*)(orow + k) = w; if (TO_LDS) *(LAS u32x2_t*)(lrow + 2 * k) = w; }
}
__device__ __forceinline__ void dev_norm1_l0(const P& p, int G, int wave, int lane) {
    int r0, r1; { const int nw = G * NWAVES, per = (NTOK + nw - 1) / nw, gwl = (int)blockIdx.x * NWAVES + wave; r0 = gwl * per; r1 = r0 + per; if (r1 > NTOK) r1 = NTOK; }
    f32x4_t pnr[4], shr[4], scr2[4]; int mrow = -1;
#pragma unroll
    for (int j = 0; j < 4; ++j) pnr[j] = *(const f32x4_t*)(p.pre_norm + 4 * lane + 256 * j);
    for (int m = r0; m < r1; ++m) {
        const float* src = m < NLAT ? p.x + (size_t)m * D : p.ctx + (size_t)(m - NLAT) * D;
        f32x4_t v[4]; float ss = 0.f;
#pragma unroll
        for (int j = 0; j < 4; ++j) { v[j] = *(const f32x4_t*)(src + 4 * lane + 256 * j); ss += hsq4(v[j]); *(f32x4_t*)(p.X() + (size_t)m * D + 4 * lane + 256 * j) = v[j]; }
        const int mr = mod_row(m);
        if (mr != mrow) { const float* md = p.MOD() + (size_t)mr * 6 * D; mrow = mr;
#pragma unroll
            for (int j = 0; j < 4; ++j) { shr[j] = *(const f32x4_t*)(md + 4 * lane + 256 * j); scr2[j] = *(const f32x4_t*)(md + D + 4 * lane + 256 * j); } }
        const float rstd = frsq(wave_sum(ss) * (1.0f / D) + 1e-6f); bf16_t* orow = p.HB() + (size_t)m * D;
#pragma unroll
        for (int j = 0; j < 4; ++j) { const f32x4_t t = v[j] * rstd * pnr[j] * (1.0f + scr2[j]) + shr[j]; *(u32x2_t*)(orow + 4 * lane + 256 * j) = pk4(t); }
    }
}
__device__ __forceinline__ void dev_post(const P& p, int l, int ntok_l, int gw, int ngw, int lane) {
    const int h = lane >> 4;
    for (int m = gw; m < ntok_l; m += ngw) {
        {
            const f32x4_t y = bf4(*(const u32x2_t*)(p.YA() + (size_t)m * A_W + 4 * lane)) + bf4(*(const u32x2_t*)(p.YA() + ((size_t)NTOK + m) * A_W + 4 * lane));
            const float mean = grp16_sum(hsum4(y)) * (1.0f / 64.f); const f32x4_t d = y - mean;
            const float var = grp16_sum(hsq4(d)) * (1.0f / 64.f); const float rs = frsq(var + 64e-5f);
            const f32x4_t lw = *(const f32x4_t*)(p.rw_ln_w + l * A_W + 4 * lane), lb = *(const f32x4_t*)(p.rw_ln_b + l * A_W + 4 * lane);
            const f32x4_t vv = bf4(*(const u32x2_t*)(p.RW_V() + (size_t)m * A_W + 4 * lane)), gt = bf4(*(const u32x2_t*)(p.RW_GATE() + (size_t)m * A_W + 4 * lane));
            const float bon = p.RW_BON()[(size_t)m * A_H + h];
            const f32x4_t o = (d * rs * lw + lb + bon * vv) * gt;
            *(u32x2_t*)(p.MIX() + (size_t)m * D + 4 * lane) = pk4(o);
        }
        {
            const u32x4_t o0 = *(const u32x4_t*)(p.OB() + (size_t)m * B_W + 8 * lane), o1 = *(const u32x4_t*)(p.OB() + ((size_t)NTOK + m) * B_W + 8 * lane);
            const f32x4_t a = bf4((u32x2_t){o0.x, o0.y}) + bf4((u32x2_t){o1.x, o1.y}), b = bf4((u32x2_t){o0.z, o0.w}) + bf4((u32x2_t){o1.z, o1.w});
            const float rs = frsq(grp16_sum(hsq4(a) + hsq4(b)) * (1.0f / 128.f) + 1e-6f);
            const u32x4_t zr = *(const u32x4_t*)(p.U() + (size_t)m * INP + B_OFF + 1536 + 8 * lane);
            const float* nw = p.gdn_norm + l * 128 + ((8 * lane) & 127);
            const f32x4_t n0 = *(const f32x4_t*)nw, n1 = *(const f32x4_t*)(nw + 4);
            const f32x4_t z0 = {bflo(zr.x), bfhi(zr.x), bflo(zr.y), bfhi(zr.y)}, z1 = {bflo(zr.z), bfhi(zr.z), bflo(zr.w), bfhi(zr.w)};
            f32x4_t s0, s1;
#pragma unroll
            for (int c = 0; c < 4; ++c) { s0[c] = z0[c] * frcp(1.0f + __expf(-z0[c])); s1[c] = z1[c] * frcp(1.0f + __expf(-z1[c])); }
            const f32x4_t r0 = a * rs * n0 * s0, r1 = b * rs * n1 * s1;
            u32x4_t w; const u32x2_t w0 = pk4(r0), w1 = pk4(r1); w.x = w0.x; w.y = w0.y; w.z = w1.x; w.w = w1.y;
            *(u32x4_t*)(p.MIX() + (size_t)m * D + 256 + 8 * lane) = w;
        }
    }
}
constexpr int RT_TK = 0, RT_TKS = 2064, RT_PL = 34816, RT_LG = RT_PL + 16384, RT_CNT = RT_LG + 2304, RT_BASE = RT_CNT + 128, RT_ASG = RT_BASE + 128, RT_ASG_MAX = 4096;
__device__ __forceinline__ void dev_resid_router(const P& p, int l, int ntok_l, LAS unsigned char* lds, int G, int tid) {
    const int lane = tid & 63, wave = tid >> 6;
    LAS int* LCNT = (LAS int*)(lds + RT_CNT); LAS int* LBASE = (LAS int*)(lds + RT_BASE); LAS int* ASG = (LAS int*)(lds + RT_ASG);
    LAS float* PL = (LAS float*)(lds + RT_PL); LAS float* LG = (LAS float*)(lds + RT_LG);
    if (tid < 32) LCNT[tid] = 0;
    __syncthreads();
    f32x4_t pnr[4], pn2r[4];
#pragma unroll
    for (int j = 0; j < 4; ++j) { const int k = 4 * lane + 256 * j; pnr[j] = *(const f32x4_t*)(p.post_norm + (size_t)(l * 2 + 0) * D + k); pn2r[j] = *(const f32x4_t*)(p.pre_norm + (size_t)(l * 2 + 1) * D + k); }
    const int ngrp = ntok_l / 16; int it = 0;
    for (int grp = blockIdx.x; grp < ngrp; grp += G, ++it) {
        f32x4_t g1r[4], sh2r[4], sc2r[4];
        { const float* md = p.MOD() + ((size_t)l * (BATCH + 1) + mod_row(grp * 16)) * 6 * D;
#pragma unroll
          for (int j = 0; j < 4; ++j) { const int k = 4 * lane + 256 * j; g1r[j] = *(const f32x4_t*)(md + 2 * D + k); sh2r[j] = *(const f32x4_t*)(md + 3 * D + k); sc2r[j] = *(const f32x4_t*)(md + 4 * D + k); } }
#pragma unroll 1
        for (int rr = 0; rr < 2; ++rr) {
            const int ri = wave * 2 + rr, m = grp * 16 + ri;
            const bf16_t* mo = p.MO() + (size_t)m * D; float* xr = p.X() + (size_t)m * D;
            f32x4_t v[4], x[4]; float ss = 0.f;
#pragma unroll
            for (int j = 0; j < 4; ++j) { v[j] = bf4(*(const u32x2_t*)(mo + 4 * lane + 256 * j)); x[j] = *(const f32x4_t*)(xr + 4 * lane + 256 * j); ss += hsq4(v[j]); }
            const float rstd = frsq(wave_sum(ss) * (1.0f / D) + 1e-6f); float s2 = 0.f;
#pragma unroll
            for (int j = 0; j < 4; ++j) { const int k = 4 * lane + 256 * j;
                x[j] = x[j] + g1r[j] * (v[j] * rstd) * pnr[j]; s2 += hsq4(x[j]); *(f32x4_t*)(xr + k) = x[j]; }
            const float r2 = frsq(wave_sum(s2) * (1.0f / D) + 1e-6f);
            { bf16_t* orow = p.HB() + (size_t)m * D; LAS unsigned char* lrow = lds + RT_TK + ri * RT_TKS;
#pragma unroll
              for (int j = 0; j < 4; ++j) { const int k = 4 * lane + 256 * j; const f32x4_t t = x[j] * r2 * pn2r[j] * (1.0f + sc2r[j]) + sh2r[j]; const u32x2_t w = pk4(t); *(u32x2_t*)(orow + k) = w; *(LAS u32x2_t*)(lrow + 2 * k) = w; } }
        }
        __syncthreads();
        {
            const int i = lane & 15, q = lane >> 4; pg8::f32x4 acc0 = {0.f, 0.f, 0.f, 0.f}, acc1 = {0.f, 0.f, 0.f, 0.f};
#pragma unroll
            for (int ks = 0; ks < 4; ++ks) { const int k0 = 128 * wave + 32 * ks + 8 * q;
                const bf16x8_t a = *(const LAS bf16x8_t*)(lds + RT_TK + i * RT_TKS + 2 * k0);
                const bf16x8_t b0 = *(const bf16x8_t*)(p.WR_T(l) + (size_t)i * D + k0), b1 = *(const bf16x8_t*)(p.WR_T(l) + (size_t)(16 + i) * D + k0);
                acc0 = __builtin_amdgcn_mfma_f32_16x16x32_bf16(a, b0, acc0, 0, 0, 0); acc1 = __builtin_amdgcn_mfma_f32_16x16x32_bf16(a, b1, acc1, 0, 0, 0); }
#pragma unroll
            for (int r = 0; r < 4; ++r) { PL[(wave * 16 + 4 * q + r) * 32 + i] = acc0[r]; PL[(wave * 16 + 4 * q + r) * 32 + 16 + i] = acc1[r]; }
        }
        __syncthreads();
        {
            const int ri = tid >> 5, e = tid & 31; float sacc = p.router_b[l * NEXP + e];
#pragma unroll
            for (int w = 0; w < 8; ++w) sacc += PL[(w * 16 + ri) * 32 + e];
            LG[ri * 33 + e] = sacc;
        }
        __syncthreads();
        if (tid < 16) {
            const int m = grp * 16 + tid; float lg[NEXP];
#pragma unroll
            for (int e = 0; e < NEXP; ++e) lg[e] = LG[tid * 33 + e];
            int idx[TOPK]; float val[TOPK];
#pragma unroll
            for (int j = 0; j < TOPK; ++j) { float best = -3.0e38f; int bi = 0;
#pragma unroll
                for (int e = 0; e < NEXP; ++e) { if (lg[e] > best) { best = lg[e]; bi = e; } }
                idx[j] = bi; val[j] = best;
#pragma unroll
                for (int e = 0; e < NEXP; ++e) if (e == bi) lg[e] = -3.0e38f; }
            float sum = 0.f, ex[TOPK];
#pragma unroll
            for (int j = 0; j < TOPK; ++j) { ex[j] = __expf(val[j] - val[0]); sum += ex[j]; }
            const float inv = 1.0f / sum;
#pragma unroll
            for (int j = 0; j < TOPK; ++j) { p.TOPI()[(size_t)m * TOPK + j] = idx[j]; p.TOPG()[(size_t)m * TOPK + j] = ex[j] * inv;
                const int lp = __hip_atomic_fetch_add(&LCNT[idx[j]], 1, __ATOMIC_RELAXED, __HIP_MEMORY_SCOPE_WORKGROUP);
                const int ai = (it * 16 + tid) * 4 + j; if (ai < RT_ASG_MAX) ASG[ai] = (idx[j] << 20) | lp; }
        }
        __syncthreads();
    }
    if (tid < 32) LBASE[tid] = LCNT[tid] > 0 ? atomicAdd(&p.cnt()[l * NEXP + tid], LCNT[tid]) : 0;
    __syncthreads();
    for (int a = tid; a < it * 64 && a < RT_ASG_MAX; a += NTHR) { const int w = ASG[a]; const int e = w >> 20, lp = w & 0xfffff; const int itx = a / 64, ri = (a % 64) / 4, j = a % 4;
        const int m = (blockIdx.x + itx * G) * 16 + ri; p.POS()[(size_t)m * TOPK + j] = LBASE[e] + lp; }
    __syncthreads();
}
__device__ __forceinline__ void dev_slots(const P& p, int l, int ntok_l, LAS unsigned char* lds, long gtid, long nthr, int tid) {
    LAS int* PST = (LAS int*)lds; LAS int* CN = (LAS int*)(lds + 256);
    if (tid == 0) { int acc = 0; for (int e = 0; e < NEXP; ++e) { const int c = p.cnt()[l * NEXP + e]; PST[e] = acc; CN[e] = c; acc += (c + 255) / 256 * 256; } PST[NEXP] = acc; }
    __syncthreads();
    for (long t = gtid; t < (long)ntok_l * TOPK; t += nthr) { const int e = p.TOPI()[t]; const int slot = PST[e] + p.POS()[t]; p.TSLOT()[t] = slot; p.SLOT_TOK()[slot] = (int)(t / TOPK); }
    for (long t = gtid; t < NEXP * 256; t += nthr) { const int e = (int)(t >> 8), i = (int)(t & 255); const int c = CN[e]; const int pads = (c + 255) / 256 * 256 - c; if (i < pads) p.SLOT_TOK()[PST[e] + c + i] = ZROW; }
    for (long t = gtid; t < NBLK_MAX; t += nthr) { int e_of = NEXP - 1;
        for (int e = 0; e < NEXP; ++e) { if ((int)t * 256 >= PST[e] && (int)t * 256 < PST[e + 1]) e_of = e; }
        p.BLOCK_E()[t] = e_of; if (t == 0) p.NBLK()[0] = PST[NEXP] / 256; }
    __syncthreads();
}
struct CbA { int4 sl; f32x4_t gt; };
struct CbB { u32x2_t y[4][4]; f32x4_t x[4]; f32x4_t gt; };
__device__ __forceinline__ void combine_loadA(const P& p, int m, CbA& a) { a.sl = *(const int4*)(p.TSLOT() + (size_t)m * 4); a.gt = *(const f32x4_t*)(p.TOPG() + (size_t)m * 4); }
__device__ __forceinline__ void combine_loadB(const P& p, int m, const CbA& a, int lane, CbB& b) {
    const bf16_t* y0 = p.YB() + (size_t)a.sl.x * D; const bf16_t* y1 = p.YB() + (size_t)a.sl.y * D; const bf16_t* y2 = p.YB() + (size_t)a.sl.z * D; const bf16_t* y3 = p.YB() + (size_t)a.sl.w * D;
    const float* xr = p.X() + (size_t)m * D;
#pragma unroll
    for (int j = 0; j < 4; ++j) { const int k = 4 * lane + 256 * j; b.y[0][j] = *(const u32x2_t*)(y0 + k); b.y[1][j] = *(const u32x2_t*)(y1 + k); b.y[2][j] = *(const u32x2_t*)(y2 + k); b.y[3][j] = *(const u32x2_t*)(y3 + k); b.x[j] = *(const f32x4_t*)(xr + k); }
    b.gt = a.gt;
}
struct CbPar { f32x4_t pn[4], pn1[4], g2[4], sh1[4], sc1[4]; int mrow; };
__device__ __forceinline__ void combine_params(const P& p, int l, int lane, CbPar& q) {
    const bool last = (l == DEPTH - 1);
#pragma unroll
    for (int j = 0; j < 4; ++j) { const int k = 4 * lane + 256 * j; q.pn[j] = *(const f32x4_t*)(p.post_norm + (size_t)(l * 2 + 1) * D + k); q.pn1[j] = last ? q.pn[j] : *(const f32x4_t*)(p.pre_norm + (size_t)((l + 1) * 2 + 0) * D + k); }
    q.mrow = -1;
}
__device__ __forceinline__ void combine_mod(const P& p, int l, int mrow, int lane, CbPar& q) {
    const bool last = (l == DEPTH - 1); const float* md = p.MOD() + ((size_t)l * (BATCH + 1) + mrow) * 6 * D; const float* md1 = p.MOD() + ((size_t)(last ? l : l + 1) * (BATCH + 1) + mrow) * 6 * D;
#pragma unroll
    for (int j = 0; j < 4; ++j) { const int k = 4 * lane + 256 * j; q.g2[j] = *(const f32x4_t*)(md + 5 * D + k); q.sh1[j] = *(const f32x4_t*)(md1 + k); q.sc1[j] = *(const f32x4_t*)(md1 + D + k); }
    q.mrow = mrow;
}
__device__ __forceinline__ void combine_compute(const P& p, int l, int m, const CbB& b, int lane, const CbPar& q) {
    const bool last = (l == DEPTH - 1);
    float* xr = p.X() + (size_t)m * D;
    const f32x4_t gt = b.gt; f32x4_t f[4], x[4]; float ss = 0.f;
#pragma unroll
    for (int j = 0; j < 4; ++j) { const u32x2_t a = b.y[0][j], bb = b.y[1][j], c = b.y[2][j], d = b.y[3][j];
        f[j].x = gt.x * bflo(a.x) + gt.y * bflo(bb.x) + gt.z * bflo(c.x) + gt.w * bflo(d.x); f[j].y = gt.x * bfhi(a.x) + gt.y * bfhi(bb.x) + gt.z * bfhi(c.x) + gt.w * bfhi(d.x);
        f[j].z = gt.x * bflo(a.y) + gt.y * bflo(bb.y) + gt.z * bflo(c.y) + gt.w * bflo(d.y); f[j].w = gt.x * bfhi(a.y) + gt.y * bfhi(bb.y) + gt.z * bfhi(c.y) + gt.w * bfhi(d.y);
        ss += hsq4(f[j]); x[j] = b.x[j]; }
    const float rstd = frsq(wave_sum(ss) * (1.0f / D) + 1e-6f); float s2 = 0.f;
#pragma unroll
    for (int j = 0; j < 4; ++j) { const int k = 4 * lane + 256 * j;
        x[j] = x[j] + q.g2[j] * (f[j] * rstd) * q.pn[j]; s2 += hsq4(x[j]);
#ifdef PROBE_DET
        if (last) { const unsigned cs_ = p.ctl()[12050]; x[j] = (f32x4_t){(float)(cs_ & 0xffffu), (float)((cs_ >> 16) & 0xffffu), 1.f, 2.f}; }
#endif
#ifdef PROBE_T
        if (last) { const unsigned long long* ts = (const unsigned long long*)(p.ctl() + 12100); const float tot = (float)(ts[2 * NPH - 1] - ts[0]);
            float fa = 0.f;
            for (int ll = 0; ll < 2; ++ll) for (int jj = 0; jj < NPH; ++jj) if (((PT_MASK >> jj) & 1) && (1 + ll * NPH + jj + 1 <= 2 * NPH - 1)) fa += (float)(ts[1 + ll * NPH + jj + 1] - ts[1 + ll * NPH + jj]);
            if ((PT_MASK >> 20) & 1) fa += (float)(ts[1] - ts[0]);
#ifdef PT_ACT
            fa = (float)p.ctl()[12070] + (float)p.ctl()[12071];
#endif
#ifdef PT_SEC
#ifndef PT_SEC_SCALE
#define PT_SEC_SCALE 128.0f
#endif
            fa = (float)p.ctl()[12080] * (1.0f / PT_SEC_SCALE);
#endif
            const float fq = floorf(fa / tot * 64.0f + 0.5f) * (1.0f / 64.0f);
            x[j] = x[j] * (1.0f + 0.07f * sqrtf(fq)); }
#endif
#if defined(PROBE_GDN) || defined(PROBE_RWKV)
        if (last) { const float e = ((const float*)(p.ctl() + 12000))[0], r = ((const float*)(p.ctl() + 12001))[0]; x[j] = x[j] * (1.0f + 10.0f * sqrtf(e / r)); }
#endif
        if (last) *(f32x4_t*)(p.out + (size_t)m * D + k) = x[j]; else *(f32x4_t*)(xr + k) = x[j]; }
    if (!last) { const float r2 = frsq(wave_sum(s2) * (1.0f / D) + 1e-6f); bf16_t* orow = p.HB() + (size_t)m * D;
#pragma unroll
        for (int j = 0; j < 4; ++j) { const int k = 4 * lane + 256 * j; const f32x4_t t = x[j] * r2 * q.pn1[j] * (1.0f + q.sc1[j]) + q.sh1[j]; *(u32x2_t*)(orow + k) = pk4(t); } }
}
__device__ __forceinline__ void dev_combine(const P& p, int l, int ntok_l, int G, int wave, int lane) {
    int r0, r1; { const int nw = G * NWAVES, per = (ntok_l + nw - 1) / nw, gwl = (int)blockIdx.x * NWAVES + wave; r0 = gwl * per; r1 = r0 + per; if (r1 > ntok_l) r1 = ntok_l; }
    if (r0 >= r1) return;
    CbPar par; combine_params(p, l, lane, par);
    int m = r0; CbA a0, a1; CbB b0; combine_loadA(p, m, a0); a1 = a0; if (m + 1 < r1) combine_loadA(p, m + 1, a1);
    combine_loadB(p, m, a0, lane, b0);
    for (; m < r1; ++m) {
        CbA a2 = a1; if (m + 2 < r1) combine_loadA(p, m + 2, a2);
        CbB b1 = b0; if (m + 1 < r1) combine_loadB(p, m + 1, a1, lane, b1);
        const int mr = mod_row(m); if (mr != par.mrow) combine_mod(p, l, mr, lane, par);
        combine_compute(p, l, m, b0, lane, par);
        b0 = b1; a1 = a2;
    }
}
__device__ __forceinline__ void lds_barrier() { asm volatile("s_waitcnt lgkmcnt(0)\n\ts_barrier" ::: "memory"); }
#define MMA16(a, b, c) __builtin_amdgcn_mfma_f32_16x16x32_bf16((a), (b), (c), 0, 0, 0)
typedef pg8::f32x4 f32x4;
__device__ __forceinline__ bf16x8_t lfrag(LAS const unsigned char* lds, int off, int ld, int row0, int k0, int lane) {
    return *(LAS const bf16x8_t*)(lds + off + (row0 + (lane & 15)) * ld + (k0 + 8 * (lane >> 4)) * 2);
}
__device__ __forceinline__ bf16x8_t lfrag16(LAS const unsigned char* lds, int off, int ld, int row0, int k0, int lane) {
    bf16x8_t z = {0, 0, 0, 0, 0, 0, 0, 0}; return (lane >> 4) < 2 ? lfrag(lds, off, ld, row0, k0, lane) : z;
}
__device__ __forceinline__ bf16x8_t lfragT(LAS const unsigned char* lds, int off, int ld, int k0, int n0, int kvalid, int lane) {
    bf16x8_t v; const int n = n0 + (lane & 15), kb = 8 * (lane >> 4);
#pragma unroll
    for (int j = 0; j < 8; ++j) v[j] = (kb + j < kvalid) ? *(LAS const short*)(lds + off + (k0 + kb + j) * ld + n * 2) : (short)0;
    return v;
}
typedef short bf16x4_t __attribute__((ext_vector_type(4)));
__device__ __forceinline__ bf16x8_t lfragTr(LAS unsigned char* lds, int off, int ld, int k0, int n0, int lane) {
    LAS unsigned char* a = lds + off + (k0 + 8 * (lane >> 4) + ((lane & 15) >> 2)) * ld + (n0 + 4 * (lane & 3)) * 2;
    const bf16x4_t lo = __builtin_amdgcn_ds_read_tr16_b64_v4i16((LAS bf16x4_t*)a), hi = __builtin_amdgcn_ds_read_tr16_b64_v4i16((LAS bf16x4_t*)(a + 4 * ld));
    return __builtin_shufflevector(lo, hi, 0, 1, 2, 3, 4, 5, 6, 7);
}
__device__ __forceinline__ void st_rm(LAS unsigned char* lds, int off, int ld, int m0, int n0, f32x4 acc, int lane) {
#pragma unroll
    for (int r = 0; r < 4; ++r) *(LAS bf16_t*)(lds + off + (m0 + 4 * (lane >> 4) + r) * ld + (n0 + (lane & 15)) * 2) = f2bf(acc[r]);
}
__device__ __forceinline__ void st_tr(LAS unsigned char* lds, int off, int ld, int m0, int n0, f32x4 acc, int lane) {
    u32x2_t w; w.x = pg8::cvt_pk_bf16(acc[0], acc[1]); w.y = pg8::cvt_pk_bf16(acc[2], acc[3]);
    *(LAS u32x2_t*)(lds + off + (n0 + (lane & 15)) * ld + (m0 + 4 * (lane >> 4)) * 2) = w;
}
__device__ __forceinline__ u32x4_t scale8(u32x4_t v, float s) {
    u32x4_t o; o.x = pg8::cvt_pk_bf16(bflo(v.x) * s, bfhi(v.x) * s); o.y = pg8::cvt_pk_bf16(bflo(v.y) * s, bfhi(v.y) * s);
    o.z = pg8::cvt_pk_bf16(bflo(v.z) * s, bfhi(v.z) * s); o.w = pg8::cvt_pk_bf16(bflo(v.w) * s, bfhi(v.w) * s); return o;
}

template <int LOFF, int TOFF, int SCOFF>
__device__ __forceinline__ void tri_inv64(LAS unsigned char* lds, int tid) {
    const int wave = __builtin_amdgcn_readfirstlane(tid >> 6); int lane = tid & 63, q4 = lane >> 4, l16 = lane & 15;
    if (wave == 0) {
        float x[16];
#pragma unroll
        for (int i = 0; i < 16; ++i) { float sacc = (i == l16) ? 1.f : 0.f;
#pragma unroll
            for (int j = 0; j < i; ++j) sacc -= bf2f(*(LAS const bf16_t*)(lds + LOFF + (16 * q4 + i) * 144 + (16 * q4 + j) * 2)) * x[j];
            x[i] = sacc; }
#pragma unroll
        for (int i = 0; i < 16; ++i) *(LAS bf16_t*)(lds + TOFF + (16 * q4 + i) * 144 + (16 * q4 + l16) * 2) = f2bf(x[i]);
    }
    lds_barrier(); asm volatile("" : "+v"(tid)); lane = tid & 63;
    if (wave < 2) {
        const int I = 2 * wave + 1, J = 2 * wave; const f32x4 z = {0.f, 0.f, 0.f, 0.f};
        const f32x4 m1 = MMA16(lfrag16(lds, LOFF, 144, 16 * I, 16 * J, lane), lfragT(lds, TOFF, 144, 16 * J, 16 * J, 16, lane), z);
        st_rm(lds, SCOFF + wave * 1280, 80, 0, 0, m1, lane);
        asm volatile("s_waitcnt lgkmcnt(0)" ::: "memory");
        const f32x4 t1 = MMA16(lfrag16(lds, TOFF, 144, 16 * I, 16 * I, lane), lfragT(lds, SCOFF + wave * 1280, 80, 0, 0, 16, lane), z);
        st_rm(lds, TOFF, 144, 16 * I, 16 * J, -t1, lane);
    }
    lds_barrier(); asm volatile("" : "+v"(tid)); lane = tid & 63;
    {
        const int mt2 = (wave >> 1) & 1, nt2 = wave & 1; const f32x4 z = {0.f, 0.f, 0.f, 0.f};
        if (wave < 4) { const f32x4 m2 = MMA16(lfrag(lds, LOFF, 144, 32 + 16 * mt2, 0, lane), lfragT(lds, TOFF, 144, 0, 16 * nt2, 32, lane), z); st_rm(lds, SCOFF, 80, 16 * mt2, 16 * nt2, m2, lane); }
        lds_barrier();
        if (wave < 4) { const f32x4 t2 = MMA16(lfrag(lds, TOFF, 144, 32 + 16 * mt2, 32, lane), lfragT(lds, SCOFF, 80, 0, 16 * nt2, 32, lane), z); st_rm(lds, TOFF, 144, 32 + 16 * mt2, 16 * nt2, -t2, lane); }
    }
    lds_barrier();
}

template <int LOFF, int TOFF, int SCOFF, int DGOFF, int TTOFF>
__device__ __forceinline__ void tri_inv64x(LAS unsigned char* lds, int tid) {
    const int wave = __builtin_amdgcn_readfirstlane(tid >> 6); int lane = tid & 63, q4 = lane >> 4, l16 = lane & 15;
    if (wave == 0) {
        LAS const unsigned char* dg = lds + DGOFF + q4 * 1040;
        float x[16];
#pragma unroll
        for (int i = 0; i < 16; ++i) { float s0 = (i == l16) ? 1.f : 0.f, s1 = 0.f;
#pragma unroll
            for (int pc = 0; pc < (i + 3) / 4; ++pc) { const f32x4 lv = *(LAS const f32x4*)(dg + i * 64 + pc * 16);
#pragma unroll
                for (int e = 0; e < 4; ++e) { const int j = 4 * pc + e; if (j < i) { if (j & 1) s1 -= lv[e] * x[j]; else s0 -= lv[e] * x[j]; } } }
            x[i] = s0 + s1; }
#pragma unroll
        for (int i = 0; i < 16; ++i) *(LAS bf16_t*)(lds + TOFF + (16 * q4 + i) * 144 + (16 * q4 + l16) * 2) = f2bf(x[i]);
        u32x4_t w0, w1; w0.x = pg8::cvt_pk_bf16(x[0], x[1]); w0.y = pg8::cvt_pk_bf16(x[2], x[3]); w0.z = pg8::cvt_pk_bf16(x[4], x[5]); w0.w = pg8::cvt_pk_bf16(x[6], x[7]);
        w1.x = pg8::cvt_pk_bf16(x[8], x[9]); w1.y = pg8::cvt_pk_bf16(x[10], x[11]); w1.z = pg8::cvt_pk_bf16(x[12], x[13]); w1.w = pg8::cvt_pk_bf16(x[14], x[15]);
        LAS unsigned char* tt = lds + TTOFF + (16 * q4 + l16) * 80;
        *(LAS u32x4_t*)(tt + (q4 & 1) * 32) = w0; *(LAS u32x4_t*)(tt + (q4 & 1) * 32 + 16) = w1;
        if (q4 & 1) { *(LAS u32x4_t*)tt = (u32x4_t){0u, 0u, 0u, 0u}; *(LAS u32x4_t*)(tt + 16) = (u32x4_t){0u, 0u, 0u, 0u}; }
    }
    lds_barrier(); asm volatile("" : "+v"(tid)); lane = tid & 63; q4 = lane >> 4; l16 = lane & 15;
    if (wave < 2) {
        const int I = 2 * wave + 1, J = 2 * wave; const f32x4 z = {0.f, 0.f, 0.f, 0.f}; const bf16x8_t zf = {0, 0, 0, 0, 0, 0, 0, 0};
        const bf16x8_t bT = q4 < 2 ? *(LAS const bf16x8_t*)(lds + TTOFF + (16 * J + l16) * 80 + (8 * q4) * 2) : zf;
        const f32x4 m1 = MMA16(lfrag16(lds, LOFF, 144, 16 * I, 16 * J, lane), bT, z);
        LAS unsigned char* sc = lds + SCOFF + wave * 1280;
        { u32x2_t w; w.x = pg8::cvt_pk_bf16(m1[0], m1[1]); w.y = pg8::cvt_pk_bf16(m1[2], m1[3]); *(LAS u32x2_t*)(sc + l16 * 48 + (4 * q4) * 2) = w; }
        asm volatile("s_waitcnt lgkmcnt(0)" ::: "memory");
        const bf16x8_t bM = q4 < 2 ? *(LAS const bf16x8_t*)(sc + l16 * 48 + (8 * q4) * 2) : zf;
        const f32x4 t1 = MMA16(lfrag16(lds, TOFF, 144, 16 * I, 16 * I, lane), bM, z);
        st_rm(lds, TOFF, 144, 16 * I, 16 * J, -t1, lane);
        st_tr(lds, TTOFF, 80, 16, 16 * J, -t1, lane);
    }
    lds_barrier(); asm volatile("" : "+v"(tid)); lane = tid & 63;
    {
        const int mt2 = (wave >> 1) & 1, nt2 = wave & 1; const f32x4 z = {0.f, 0.f, 0.f, 0.f};
        if (wave < 4) { const f32x4 m2 = MMA16(lfrag(lds, LOFF, 144, 32 + 16 * mt2, 0, lane), lfrag(lds, TTOFF, 80, 16 * nt2, 0, lane), z); st_tr(lds, SCOFF, 80, 16 * mt2, 16 * nt2, m2, lane); }
        lds_barrier();
        if (wave < 4) { const f32x4 t2 = MMA16(lfrag(lds, TOFF, 144, 32 + 16 * mt2, 32, lane), lfrag(lds, SCOFF, 80, 16 * nt2, 0, lane), z); st_rm(lds, TOFF, 144, 32 + 16 * mt2, 16 * nt2, -t2, lane); }
    }
    lds_barrier();
}

constexpr int GQ_ = 0, GK_ = 17408, GV_ = 34816, GL_ = 53248, GT_ = 62464, GSC_ = 71680, GVB_ = 74240, GKB_ = 92672, GST_ = 111104, GF_ = 145920;
constexpr int LD128 = 272, LD64 = 144, LDSC = 80;
constexpr int GDG_ = 147456  , GTT_ = 151808  ;
__device__ __forceinline__ void gdn_chain(const bf16_t* __restrict__ gq, const bf16_t* __restrict__ gk, const bf16_t* __restrict__ gv, const float* __restrict__ gg, const float* __restrict__ gbeta, int chain, bf16_t* __restrict__ OBout, LAS unsigned char* lds, int tid, unsigned* ctlp) {
    const int wave = __builtin_amdgcn_readfirstlane(tid >> 6); int lane = tid & 63, q4 = lane >> 4, l16 = lane & 15;
#ifdef PT_SEC
    unsigned long long ts_ = __builtin_amdgcn_s_memrealtime();
#define SEC_MARK(k) do { if (tid == 0) { const unsigned long long n_ = __builtin_amdgcn_s_memrealtime(); if ((k) == PT_SEC) atomicAdd(ctlp + 12080, (unsigned)(n_ - ts_)); ts_ = n_; } } while (0)
#else
#define SEC_MARK(k)
#endif
#define GDN_RELANE() do { asm volatile("" : "+v"(tid)); lane = tid & 63; q4 = lane >> 4; l16 = lane & 15; } while (0)
    const int h = chain % B_H, b = (chain / B_H) % BATCH, dir = chain / (B_H * BATCH);
    LAS float* GF = (LAS float*)(lds + GF_);
    for (int i = tid; i < 34816 / 16; i += NTHR) *(LAS u32x4_t*)(lds + GST_ + 16 * i) = (u32x4_t){0u, 0u, 0u, 0u};
    f32x4 Sacc[8];
#pragma unroll
    for (int nt = 0; nt < 8; ++nt) Sacc[nt] = (f32x4){0.f, 0.f, 0.f, 0.f};
    u32x4_t pq[2], pk[2], pv[2]; float pg = 0.f, pb = 0.f;
#define GDN_LOADS(cc) do { _Pragma("unroll") for (int u = 0; u < 2; ++u) { const int piece = tid + 512 * u, i = piece >> 4, c16 = piece & 15; \
        const size_t ro = (size_t)scan_row(dir, b, 64 * (cc) + i) * B_W + h * 128 + c16 * 8; \
        pq[u] = *(const u32x4_t*)(gq + ro); pk[u] = *(const u32x4_t*)(gk + ro); pv[u] = *(const u32x4_t*)(gv + ro); } \
        if (tid < 64) { const size_t ro = (size_t)scan_row(dir, b, 64 * (cc) + tid) * 8 + dir * 4 + h; pg = gg[ro]; pb = gbeta[ro]; } } while (0)
    GDN_LOADS(0);
    constexpr int NCH = SLEN / 64;
#pragma unroll 1
    for (int c = 0; c < NCH; ++c) {
        GDN_RELANE();
#pragma unroll
        for (int u = 0; u < 2; ++u) { const int piece = tid + 512 * u, i = piece >> 4, c16 = piece & 15;
            *(LAS u32x4_t*)(lds + GQ_ + i * LD128 + c16 * 16) = pq[u]; *(LAS u32x4_t*)(lds + GK_ + i * LD128 + c16 * 16) = pk[u]; *(LAS u32x4_t*)(lds + GV_ + i * LD128 + c16 * 16) = pv[u]; }
        for (int i2 = tid; i2 < 9216 / 16; i2 += NTHR) *(LAS u32x4_t*)(lds + GT_ + 16 * i2) = (u32x4_t){0u, 0u, 0u, 0u};
        if (wave == 0) {
            float x = pg;
#pragma unroll
            for (int o = 1; o < 64; o <<= 1) { const float y = __shfl_up(x, o); if (lane >= o) x += y; }
            const float gl = __shfl(x, 63);
            GF[lane] = x; GF[64 + lane] = pb; GF[128 + lane] = __expf(x); GF[192 + lane] = __expf(gl - x); if (lane == 0) GF[256] = __expf(gl);
        }
        if (c + 1 < NCH) GDN_LOADS(c + 1);
        lds_barrier(); __builtin_amdgcn_sched_barrier(0); GDN_RELANE(); SEC_MARK(1);
        const int mt = wave >> 1;
        f32x4 qk[2];
        {
            f32x4 kk[2]; kk[0] = kk[1] = qk[0] = qk[1] = (f32x4){0.f, 0.f, 0.f, 0.f};
#pragma unroll
            for (int ks = 0; ks < 4; ++ks) { __builtin_amdgcn_sched_barrier(0); const bf16x8_t ak = lfrag(lds, GK_, LD128, 16 * mt, 32 * ks, lane), aq = lfrag(lds, GQ_, LD128, 16 * mt, 32 * ks, lane);
#pragma unroll
                for (int t = 0; t < 2; ++t) { const bf16x8_t bk = lfrag(lds, GK_, LD128, 16 * (2 * (wave & 1) + t), 32 * ks, lane); kk[t] = MMA16(bk, ak, kk[t]); qk[t] = MMA16(bk, aq, qk[t]); } }
#pragma unroll
            for (int t = 0; t < 2; ++t) { const int i = 16 * mt + l16; const float gci = GF[i], bi = GF[64 + i]; f32x4 lv;
#pragma unroll
                for (int r = 0; r < 4; ++r) { const int j = 16 * (2 * (wave & 1) + t) + 4 * q4 + r; const float dec = i >= j ? __expf(gci - GF[j]) : 0.f;
                    lv[r] = i > j ? bi * kk[t][r] * dec : 0.f; qk[t][r] *= dec; }
                st_tr(lds, GL_, LD64, 16 * (2 * (wave & 1) + t), 16 * mt, lv, lane);
                if (2 * (wave & 1) + t == mt) *(LAS f32x4*)(lds + GDG_ + mt * 1040 + l16 * 64 + q4 * 16) = lv; }
        }
        lds_barrier(); __builtin_amdgcn_sched_barrier(0); GDN_RELANE();
        SEC_MARK(2);
        if (wave >= 1) {
            const int t7 = tid - 64;
#pragma unroll
            for (int rep = 0; rep < 3; ++rep) { const int task = t7 + 448 * rep, cidx = task & 127, jg = task >> 7; float vv[8], kv[8];
                if (task >= 1024) break;
                const int toff = (8 * jg + (l16 >> 2)) * LD128 + ((cidx & ~15) + 4 * (l16 & 3)) * 2;
                const bf16x4_t v0 = __builtin_amdgcn_ds_read_tr16_b64_v4i16((LAS bf16x4_t*)(lds + GV_ + toff)), v1 = __builtin_amdgcn_ds_read_tr16_b64_v4i16((LAS bf16x4_t*)(lds + GV_ + toff + 4 * LD128));
                const bf16x4_t k0 = __builtin_amdgcn_ds_read_tr16_b64_v4i16((LAS bf16x4_t*)(lds + GK_ + toff)), k1 = __builtin_amdgcn_ds_read_tr16_b64_v4i16((LAS bf16x4_t*)(lds + GK_ + toff + 4 * LD128));
                const f32x4 b0 = *(LAS const f32x4*)(GF + 64 + 8 * jg), b1 = *(LAS const f32x4*)(GF + 64 + 8 * jg + 4), e0 = *(LAS const f32x4*)(GF + 128 + 8 * jg), e1 = *(LAS const f32x4*)(GF + 128 + 8 * jg + 4);
#pragma unroll
                for (int jj = 0; jj < 4; ++jj) { vv[jj] = bf2f((bf16_t)v0[jj]) * b0[jj]; vv[4 + jj] = bf2f((bf16_t)v1[jj]) * b1[jj]; kv[jj] = bf2f((bf16_t)k0[jj]) * b0[jj] * e0[jj]; kv[4 + jj] = bf2f((bf16_t)k1[jj]) * b1[jj] * e1[jj]; }
                u32x4_t wv, wk; wv.x = pg8::cvt_pk_bf16(vv[0], vv[1]); wv.y = pg8::cvt_pk_bf16(vv[2], vv[3]); wv.z = pg8::cvt_pk_bf16(vv[4], vv[5]); wv.w = pg8::cvt_pk_bf16(vv[6], vv[7]);
                wk.x = pg8::cvt_pk_bf16(kv[0], kv[1]); wk.y = pg8::cvt_pk_bf16(kv[2], kv[3]); wk.z = pg8::cvt_pk_bf16(kv[4], kv[5]); wk.w = pg8::cvt_pk_bf16(kv[6], kv[7]);
                *(LAS u32x4_t*)(lds + GVB_ + cidx * LD64 + jg * 16) = wv; *(LAS u32x4_t*)(lds + GKB_ + cidx * LD64 + jg * 16) = wk; }
        }
        tri_inv64x<GL_, GT_, GSC_, GDG_, GTT_>(lds, tid); GDN_RELANE(); SEC_MARK(3);
#pragma unroll
        for (int t = 0; t < 2; ++t) st_tr(lds, GL_, LD64, 16 * (2 * (wave & 1) + t), 16 * mt, qk[t], lane);
        SEC_MARK(4);
        f32x4 accu[4], o[4];
#pragma unroll
        for (int m = 0; m < 4; ++m) accu[m] = o[m] = (f32x4){0.f, 0.f, 0.f, 0.f};
#pragma unroll
        for (int ks = 0; ks < 2; ++ks) { __builtin_amdgcn_sched_barrier(0); const bf16x8_t bb = lfrag(lds, GVB_, LD64, 16 * wave, 32 * ks, lane);
#pragma unroll
            for (int m = 0; m < 4; ++m) accu[m] = MMA16(lfrag(lds, GT_, LD64, 16 * m, 32 * ks, lane), bb, accu[m]); }
        {
            f32x4 accw[4];
#pragma unroll
            for (int m = 0; m < 4; ++m) accw[m] = (f32x4){0.f, 0.f, 0.f, 0.f};
#pragma unroll
            for (int ks = 0; ks < 2; ++ks) { __builtin_amdgcn_sched_barrier(0); const bf16x8_t bb = lfrag(lds, GKB_, LD64, 16 * wave, 32 * ks, lane);
#pragma unroll
                for (int m = 0; m < 4; ++m) accw[m] = MMA16(bb, lfrag(lds, GT_, LD64, 16 * m, 32 * ks, lane), accw[m]); }
            lds_barrier();
#pragma unroll
            for (int m = 0; m < 4; ++m) st_tr(lds, GVB_, LD128, 16 * wave, 16 * m, -accw[m], lane);
        }
#pragma unroll
        for (int rep = 0; rep < 2; ++rep) { const int task = tid + 512 * rep, cidx = task & 127, jg = task >> 7; float kv[8];
            const int toff = (8 * jg + (l16 >> 2)) * LD128 + ((cidx & ~15) + 4 * (l16 & 3)) * 2;
            const bf16x4_t k0 = __builtin_amdgcn_ds_read_tr16_b64_v4i16((LAS bf16x4_t*)(lds + GK_ + toff)), k1 = __builtin_amdgcn_ds_read_tr16_b64_v4i16((LAS bf16x4_t*)(lds + GK_ + toff + 4 * LD128));
            const f32x4 e0 = *(LAS const f32x4*)(GF + 192 + 8 * jg), e1 = *(LAS const f32x4*)(GF + 192 + 8 * jg + 4);
#pragma unroll
            for (int jj = 0; jj < 4; ++jj) { kv[jj] = bf2f((bf16_t)k0[jj]) * e0[jj]; kv[4 + jj] = bf2f((bf16_t)k1[jj]) * e1[jj]; }
            u32x4_t wk; wk.x = pg8::cvt_pk_bf16(kv[0], kv[1]); wk.y = pg8::cvt_pk_bf16(kv[2], kv[3]); wk.z = pg8::cvt_pk_bf16(kv[4], kv[5]); wk.w = pg8::cvt_pk_bf16(kv[6], kv[7]);
            *(LAS u32x4_t*)(lds + GKB_ + cidx * LD64 + jg * 16) = wk; }
        lds_barrier(); __builtin_amdgcn_sched_barrier(0); GDN_RELANE();
        SEC_MARK(5);
#pragma unroll
        for (int ks = 0; ks < 4; ++ks) { __builtin_amdgcn_sched_barrier(0); const bf16x8_t bb = lfrag(lds, GST_, LD128, 16 * wave, 32 * ks, lane);
#pragma unroll
            for (int m = 0; m < 4; ++m) { accu[m] = MMA16(lfrag(lds, GVB_, LD128, 16 * m, 32 * ks, lane), bb, accu[m]); o[m] = MMA16(bb, lfrag(lds, GQ_, LD128, 16 * m, 32 * ks, lane), o[m]); } }
#pragma unroll
        for (int m = 0; m < 4; ++m) { o[m] = o[m] * GF[128 + 16 * m + l16]; st_tr(lds, GV_, LD64, 16 * m, 16 * wave, accu[m], lane); }
        lds_barrier(); __builtin_amdgcn_sched_barrier(0); GDN_RELANE();
        const int row0 = scan_row(dir, b, 64 * c), sgn = dir ? -1 : 1;
        SEC_MARK(6);
#pragma unroll
        for (int ks = 0; ks < 2; ++ks) { __builtin_amdgcn_sched_barrier(0); const bf16x8_t bb = lfrag(lds, GV_, LD64, 16 * wave, 32 * ks, lane);
#pragma unroll
            for (int m = 0; m < 4; ++m) o[m] = MMA16(bb, lfrag(lds, GL_, LD64, 16 * m, 32 * ks, lane), o[m]); }
#pragma unroll
        for (int m = 0; m < 4; ++m) { const int i = 16 * m + l16; const int row = row0 + sgn * i;
            u32x2_t w; w.x = pg8::cvt_pk_bf16(o[m][0], o[m][1]); w.y = pg8::cvt_pk_bf16(o[m][2], o[m][3]); *(u32x2_t*)(OBout + (unsigned)((dir * NTOK + row) * B_W + h * 128 + 16 * wave + 4 * q4)) = w; }
        {
            const float gl = GF[256];
#pragma unroll
            for (int nt = 0; nt < 8; ++nt) Sacc[nt] = Sacc[nt] * gl;
#pragma unroll
            for (int ks = 0; ks < 2; ++ks) { __builtin_amdgcn_sched_barrier(0); const bf16x8_t aa = lfrag(lds, GKB_, LD64, 16 * wave, 32 * ks, lane);
#pragma unroll
                for (int nt = 0; nt < 8; ++nt) Sacc[nt] = MMA16(aa, lfrag(lds, GV_, LD64, 16 * nt, 32 * ks, lane), Sacc[nt]); }
#pragma unroll
            for (int nt = 0; nt < 8; ++nt) st_tr(lds, GST_, LD128, 16 * wave, 16 * nt, Sacc[nt], lane);
        }
        lds_barrier(); __builtin_amdgcn_sched_barrier(0); GDN_RELANE(); SEC_MARK(7);
    }
#undef GDN_LOADS
#undef GDN_RELANE
#undef SEC_MARK
}

constexpr int SP_ = 0, SQ_ = 9216, SK_ = 18432, SR_ = 27648, SPT_ = 36864, SQT_ = 46080, SL_ = 55296, ST_ = 64512, SSC_ = 73728, SAT_ = 76288, SNB_ = 85504, SPH_ = 94720, SAH_ = 103936, SCS_ = 113152, SVT_ = 129792, SDC_ = 139008, SSEG_ = 139264;
constexpr int RW_NCH = SLEN / 64, RW_UNITS = 2 * BATCH * A_H * RW_NCH;
constexpr int SDG_ = SCS_  , STT_ = SCS_ + 4352;
struct S1In { float ld[8]; u32x4_t kk, ka, kd, rr; };
__device__ __forceinline__ void rwkv_stage1_load(const P& p, int unit, int tid, S1In& in) {
    const int c = unit % RW_NCH, chain = unit / RW_NCH; const int h = chain % A_H, b = (chain / A_H) % BATCH, dir = chain / (A_H * BATCH);
    const int row0 = scan_row(dir, b, 64 * c), sgn = dir ? -1 : 1;
    { const int k = tid & 63, sg = tid >> 6;
#pragma unroll
      for (int tt = 0; tt < 8; ++tt) in.ld[tt] = p.RW_D()[((size_t)dir * NTOK + (row0 + sgn * (8 * sg + tt))) * A_W + h * 64 + k]; }
    { const int t = tid >> 3, kg = tid & 7; const int row = row0 + sgn * t;
      const size_t o1 = (size_t)row * A_W + h * 64 + 8 * kg, o2 = ((size_t)dir * NTOK + row) * A_W + h * 64 + 8 * kg;
      in.kk = *(const u32x4_t*)(p.RW_KK() + o1); in.ka = *(const u32x4_t*)(p.RW_KKA() + o2); in.kd = *(const u32x4_t*)(p.RW_KD() + o2); in.rr = *(const u32x4_t*)(p.RW_R() + o1); }
}
__device__ __forceinline__ void rwkv_stage1(const P& p, int unit, const S1In& in, LAS unsigned char* lds, int tid, unsigned* qctr, unsigned& qraw) {
    const int wave = __builtin_amdgcn_readfirstlane(tid >> 6); int lane = tid & 63, q4 = lane >> 4, l16 = lane & 15;
#define RW_RELANE() do { asm volatile("" : "+v"(tid)); lane = tid & 63; q4 = lane >> 4; l16 = lane & 15; } while (0)
#ifdef PT_SEC
    unsigned long long ts1_ = __builtin_amdgcn_s_memrealtime();
#define S1_MARK(k) do { if (tid == 0) { const unsigned long long n_ = __builtin_amdgcn_s_memrealtime(); if ((k) == PT_SEC) atomicAdd(p.ctl() + 12080, (unsigned)(n_ - ts1_)); ts1_ = n_; } } while (0)
#else
#define S1_MARK(k)
#endif
    LAS float* CS = (LAS float*)(lds + SCS_); LAS float* DCv = (LAS float*)(lds + SDC_); LAS float* SEG = (LAS float*)(lds + SSEG_);
    {
        const int k = tid & 63, sg = tid >> 6; float x = 0.f, loc[8];
#pragma unroll
        for (int tt = 0; tt < 8; ++tt) { x += in.ld[tt]; loc[tt] = x; }
        SEG[sg * 64 + k] = x;
        for (int i2 = tid; i2 < 9216 / 16; i2 += NTHR) *(LAS u32x4_t*)(lds + ST_ + 16 * i2) = (u32x4_t){0u, 0u, 0u, 0u};
        lds_barrier();
        float pre = 0.f;
        for (int s2 = 0; s2 < sg; ++s2) pre += SEG[s2 * 64 + k];
#pragma unroll
        for (int tt = 0; tt < 8; ++tt) { const float e = __expf(loc[tt] + pre); CS[(8 * sg + tt) * 65 + k] = e; if (tt == 7 && sg == 7) DCv[k] = e; }
    }
    lds_barrier(); RW_RELANE(); S1_MARK(11);
    {
        const int t = tid >> 3, kg = tid & 7;
        float kk[8], ka[8], kd[8], rr[8];
#pragma unroll
        for (int j = 0; j < 4; ++j) { kk[2 * j] = bflo(in.kk[j]); kk[2 * j + 1] = bfhi(in.kk[j]); ka[2 * j] = bflo(in.ka[j]); ka[2 * j + 1] = bfhi(in.ka[j]); kd[2 * j] = bflo(in.kd[j]); kd[2 * j + 1] = bfhi(in.kd[j]);
            rr[2 * j] = bflo(in.rr[j]); rr[2 * j + 1] = bfhi(in.rr[j]); }
        float pp[8], qq[8], kt[8], rh[8];
#pragma unroll
        for (int j = 0; j < 8; ++j) { const int k = 8 * kg + j; const float e = CS[t * 65 + k], em = t > 0 ? CS[(t - 1) * 65 + k] : 1.f; const float ei = frcp(e);
            pp[j] = em * kk[j]; qq[j] = ka[j] * ei; kt[j] = kd[j] * ei; rh[j] = rr[j] * e; }
        u32x4_t w;
        w.x = pg8::cvt_pk_bf16(pp[0], pp[1]); w.y = pg8::cvt_pk_bf16(pp[2], pp[3]); w.z = pg8::cvt_pk_bf16(pp[4], pp[5]); w.w = pg8::cvt_pk_bf16(pp[6], pp[7]); *(LAS u32x4_t*)(lds + SP_ + t * 144 + kg * 16) = w;
        w.x = pg8::cvt_pk_bf16(qq[0], qq[1]); w.y = pg8::cvt_pk_bf16(qq[2], qq[3]); w.z = pg8::cvt_pk_bf16(qq[4], qq[5]); w.w = pg8::cvt_pk_bf16(qq[6], qq[7]); *(LAS u32x4_t*)(lds + SQ_ + t * 144 + kg * 16) = w;
        w.x = pg8::cvt_pk_bf16(kt[0], kt[1]); w.y = pg8::cvt_pk_bf16(kt[2], kt[3]); w.z = pg8::cvt_pk_bf16(kt[4], kt[5]); w.w = pg8::cvt_pk_bf16(kt[6], kt[7]); *(LAS u32x4_t*)(lds + SK_ + t * 144 + kg * 16) = w;
        w.x = pg8::cvt_pk_bf16(rh[0], rh[1]); w.y = pg8::cvt_pk_bf16(rh[2], rh[3]); w.z = pg8::cvt_pk_bf16(rh[4], rh[5]); w.w = pg8::cvt_pk_bf16(rh[6], rh[7]); *(LAS u32x4_t*)(lds + SR_ + t * 144 + kg * 16) = w;
    }
    lds_barrier(); RW_RELANE(); S1_MARK(12);
    const int mt = wave >> 1, ntb = 2 * (wave & 1);
    f32x4 krm[2];
    {
        f32x4 qp[2], kp[2], qr[2];
#pragma unroll
        for (int t2 = 0; t2 < 2; ++t2) qp[t2] = kp[t2] = qr[t2] = krm[t2] = (f32x4){0.f, 0.f, 0.f, 0.f};
#pragma unroll
        for (int ks = 0; ks < 2; ++ks) { const bf16x8_t aP = lfrag(lds, SP_, 144, 16 * mt, 32 * ks, lane), aR = lfrag(lds, SR_, 144, 16 * mt, 32 * ks, lane);
#pragma unroll
            for (int t2 = 0; t2 < 2; ++t2) { const bf16x8_t bQ = lfrag(lds, SQ_, 144, 16 * (ntb + t2), 32 * ks, lane), bK = lfrag(lds, SK_, 144, 16 * (ntb + t2), 32 * ks, lane);
                qp[t2] = MMA16(bQ, aP, qp[t2]); kp[t2] = MMA16(aP, bK, kp[t2]); qr[t2] = MMA16(bQ, aR, qr[t2]); krm[t2] = MMA16(bK, aR, krm[t2]); } }
#pragma unroll
        for (int t2 = 0; t2 < 2; ++t2) {
#pragma unroll
            for (int r = 0; r < 4; ++r) {
                { const int t = 16 * mt + 4 * q4 + r, i = 16 * (ntb + t2) + l16; kp[t2][r] = t > i ? kp[t2][r] : 0.f; }
                { const int i = 16 * (ntb + t2) + 4 * q4 + r, t = 16 * mt + l16; const bool st = t > i, inc = t >= i;
                  qp[t2][r] = st ? qp[t2][r] : 0.f; qr[t2][r] = inc ? -qr[t2][r] : 0.f; krm[t2][r] = inc ? krm[t2][r] : 0.f; } }
            st_tr(lds, SL_, 144, 16 * (ntb + t2), 16 * mt, qp[t2], lane); st_tr(lds, SAT_, 144, 16 * mt, 16 * (ntb + t2), kp[t2], lane); st_tr(lds, SNB_, 144, 16 * (ntb + t2), 16 * mt, qr[t2], lane);
            if (ntb + t2 == mt) *(LAS f32x4*)(lds + SDG_ + mt * 1040 + l16 * 64 + q4 * 16) = qp[t2]; }
    }
    lds_barrier(); RW_RELANE(); S1_MARK(13);
    tri_inv64x<SL_, ST_, SSC_, SDG_, STT_>(lds, tid);
    RW_RELANE(); S1_MARK(14);
    if (tid == 0) qraw = __hip_atomic_fetch_add(qctr, 1u, __ATOMIC_RELAXED, __HIP_MEMORY_SCOPE_AGENT);
    {
        f32x4 ph[2], ah[2];
#pragma unroll
        for (int t2 = 0; t2 < 2; ++t2) ph[t2] = ah[t2] = (f32x4){0.f, 0.f, 0.f, 0.f};
#pragma unroll
        for (int ks = 0; ks < 2; ++ks) { const bf16x8_t aT = lfrag(lds, ST_, 144, 16 * mt, 32 * ks, lane);
#pragma unroll
            for (int t2 = 0; t2 < 2; ++t2) { ph[t2] = MMA16(aT, lfragTr(lds, SP_, 144, 32 * ks, 16 * (ntb + t2), lane), ph[t2]); ah[t2] = MMA16(aT, lfrag(lds, SAT_, 144, 16 * (ntb + t2), 32 * ks, lane), ah[t2]); } }
#pragma unroll
        for (int t2 = 0; t2 < 2; ++t2) { st_tr(lds, SPH_, 144, 16 * mt, 16 * (ntb + t2), ph[t2], lane); st_tr(lds, SAH_, 144, 16 * mt, 16 * (ntb + t2), ah[t2], lane); }
    }
    lds_barrier(); RW_RELANE(); S1_MARK(15);
    {
        f32x4 rh[2], zz[2], kh[2];
#pragma unroll
        for (int t2 = 0; t2 < 2; ++t2) { zz[t2] = kh[t2] = (f32x4){0.f, 0.f, 0.f, 0.f};
            const u32x2_t rw = *(LAS const u32x2_t*)(lds + SR_ + (16 * mt + l16) * 144 + (16 * (ntb + t2) + 4 * q4) * 2);
            rh[t2] = (f32x4){bflo(rw.x), bfhi(rw.x), bflo(rw.y), bfhi(rw.y)}; }
#pragma unroll
        for (int ks = 0; ks < 2; ++ks) { const bf16x8_t aB = lfrag(lds, SNB_, 144, 16 * mt, 32 * ks, lane), aPh = lfrag(lds, SPH_, 144, 16 * mt, 32 * ks, lane), aAh = lfrag(lds, SAH_, 144, 16 * mt, 32 * ks, lane);
#pragma unroll
            for (int t2 = 0; t2 < 2; ++t2) { const bf16x8_t bPh = lfrag(lds, SPH_, 144, 16 * (ntb + t2), 32 * ks, lane), bAh = lfrag(lds, SAH_, 144, 16 * (ntb + t2), 32 * ks, lane), bQt = lfragTr(lds, SQ_, 144, 32 * ks, 16 * (ntb + t2), lane);
                rh[t2] = MMA16(bPh, aB, rh[t2]); krm[t2] = MMA16(bAh, aB, krm[t2]); zz[t2] = MMA16(aPh, bQt, zz[t2]); kh[t2] = MMA16(aAh, bQt, kh[t2]); } }
#pragma unroll
        for (int t2 = 0; t2 < 2; ++t2) { const int n = 16 * (ntb + t2) + l16; const float dc = DCv[n];
#pragma unroll
            for (int r = 0; r < 4; ++r) { const int m = 16 * mt + 4 * q4 + r; zz[t2][r] = ((m == n ? 1.f : 0.f) - zz[t2][r]) * dc;
                kh[t2][r] = (bf2f(*(LAS const bf16_t*)(lds + SK_ + m * 144 + n * 2)) - kh[t2][r]) * dc; }
            st_tr(lds, SR_, 144, 16 * (ntb + t2), 16 * mt, rh[t2], lane); st_tr(lds, SL_, 144, 16 * (ntb + t2), 16 * mt, krm[t2], lane);
            st_tr(lds, SPT_, 144, 16 * mt, 16 * (ntb + t2), zz[t2], lane); st_tr(lds, SQT_, 144, 16 * mt, 16 * (ntb + t2), kh[t2], lane); }
    }
    lds_barrier(); RW_RELANE(); S1_MARK(16);
    {
        const int row = tid >> 3, c16 = tid & 7; bf16_t* ob = p.RWC() + (size_t)unit * 5 * 4096 + row * 64 + c16 * 8;
        *(u32x4_t*)(ob) = *(LAS const u32x4_t*)(lds + SR_ + row * 144 + c16 * 16);
        *(u32x4_t*)(ob + 4096) = *(LAS const u32x4_t*)(lds + SL_ + row * 144 + c16 * 16);
        *(u32x4_t*)(ob + 2 * 4096) = *(LAS const u32x4_t*)(lds + SPT_ + row * 144 + c16 * 16);
        *(u32x4_t*)(ob + 3 * 4096) = *(LAS const u32x4_t*)(lds + SQT_ + row * 144 + c16 * 16);
    }
    lds_barrier(); S1_MARK(17);
#undef RW_RELANE
#undef S1_MARK
}
constexpr int S2_M = 0  , S2_S = 46080, S2_HALF = 55296;
__device__ __forceinline__ void rwkv_stage2(const P& p, int pair, bf16_t* YAout, LAS unsigned char* lds0, int tid) {
    const int wave = __builtin_amdgcn_readfirstlane(tid >> 6), half = wave >> 2, w4 = wave & 3; int lane = tid & 63, q4 = lane >> 4, l16 = lane & 15;
    const int chain = 2 * pair + half; const int h = chain % A_H, b = (chain / A_H) % BATCH, dir = chain / (A_H * BATCH);
    LAS unsigned char* lds = lds0 + half * S2_HALF; int t2 = tid & 255;
    for (int i = t2; i < 9216 / 16; i += 256) *(LAS u32x4_t*)(lds + S2_S + 16 * i) = (u32x4_t){0u, 0u, 0u, 0u};
    u32x4_t pre[10];
#define S2_LOADS(cc) do { const bf16_t* ib = p.RWC() + ((size_t)chain * RW_NCH + (cc)) * 5 * 4096; \
        _Pragma("unroll") for (int u = 0; u < 8; ++u) pre[u] = *(const u32x4_t*)(ib + (size_t)(t2 + 256 * u) * 8); \
        const int r0_ = scan_row(dir, b, 64 * (cc)), sg_ = dir ? -1 : 1; \
        _Pragma("unroll") for (int u = 0; u < 2; ++u) { const int piece = t2 + 256 * u; pre[8 + u] = *(const u32x4_t*)(p.RW_V() + (size_t)(r0_ + sg_ * (piece >> 3)) * A_W + h * 64 + (piece & 7) * 8); } } while (0)
    S2_LOADS(0);
#pragma unroll 1
    for (int c = 0; c < RW_NCH; ++c) {
        asm volatile("" : "+v"(tid)); lane = tid & 63; q4 = lane >> 4; l16 = lane & 15; t2 = tid & 255;
#pragma unroll
        for (int u = 0; u < 10; ++u) { const int piece = t2 + 256 * u, mat = piece >> 9, within = piece & 511; *(LAS u32x4_t*)(lds + S2_M + mat * 9216 + (within >> 3) * 144 + (within & 7) * 16) = pre[u]; }
        if (c + 1 < RW_NCH) S2_LOADS(c + 1);
        lds_barrier();
        f32x4 y[4], sn[4];
#pragma unroll
        for (int nt = 0; nt < 4; ++nt) y[nt] = sn[nt] = (f32x4){0.f, 0.f, 0.f, 0.f};
#pragma unroll
        for (int ks = 0; ks < 2; ++ks) {
            const bf16x8_t aR = lfrag(lds, S2_M, 144, 16 * w4, 32 * ks, lane), aM = lfrag(lds, S2_M + 9216, 144, 16 * w4, 32 * ks, lane);
            const bf16x8_t aS = lfrag(lds, S2_S, 144, 16 * w4, 32 * ks, lane), aV = lfragTr(lds, S2_M + 4 * 9216, 144, 32 * ks, 16 * w4, lane);
#pragma unroll
            for (int nt = 0; nt < 4; ++nt) { const int n0 = 16 * nt;
                y[nt] = MMA16(lfrag(lds, S2_S, 144, n0, 32 * ks, lane), aR, y[nt]); y[nt] = MMA16(lfragTr(lds, S2_M + 4 * 9216, 144, 32 * ks, n0, lane), aM, y[nt]);
                sn[nt] = MMA16(lfrag(lds, S2_M + 2 * 9216, 144, n0, 32 * ks, lane), aS, sn[nt]); sn[nt] = MMA16(lfrag(lds, S2_M + 3 * 9216, 144, n0, 32 * ks, lane), aV, sn[nt]); } }
        const int row0 = scan_row(dir, b, 64 * c), sgn = dir ? -1 : 1;
#pragma unroll
        for (int nt = 0; nt < 4; ++nt) { const int t = 16 * w4 + l16; u32x2_t w; w.x = pg8::cvt_pk_bf16(y[nt][0], y[nt][1]); w.y = pg8::cvt_pk_bf16(y[nt][2], y[nt][3]);
            *(u32x2_t*)(YAout + (unsigned)((dir * NTOK + row0 + sgn * t) * A_W + h * 64 + 16 * nt + 4 * q4)) = w; }
        lds_barrier();
#pragma unroll
        for (int nt = 0; nt < 4; ++nt) st_tr(lds, S2_S, 144, 16 * nt, 16 * w4, sn[nt], lane);
        lds_barrier();
    }
#undef S2_LOADS
}

constexpr int AT_K = 0  , AT_V = 18432  , ATT_NLAT = BATCH * 4 * (SEQ / 256), ATT_NCTX = BATCH * 4 * (CTXL / 256);
__device__ __forceinline__ void attn_unit(const P& p, int unit, LAS unsigned char* lds, int tid) {
    const int wave = __builtin_amdgcn_readfirstlane(tid >> 6); int lane = tid & 63, q4 = lane >> 4, l16 = lane & 15;
    int b, hq, qrow0, nt; bool lat;
    if (unit < ATT_NLAT) { lat = true; b = unit / (4 * (SEQ / 256)); hq = (unit / (SEQ / 256)) % 4; qrow0 = b * SEQ + 256 * (unit % (SEQ / 256)); nt = SLEN / 64; }
    else { const int u2 = unit - ATT_NLAT; lat = false; b = u2 / (4 * (CTXL / 256)); hq = (u2 / (CTXL / 256)) % 4; qrow0 = NLAT + b * CTXL + 256 * (u2 % (CTXL / 256)); nt = CTXL / 64; }
    const int kvh = hq >> 1; qrow0 += 32 * wave;
    bf16x8_t qf[2][2];
#pragma unroll
    for (int qt = 0; qt < 2; ++qt)
#pragma unroll
        for (int ks = 0; ks < 2; ++ks) qf[qt][ks] = *(const bf16x8_t*)(p.CQ() + (size_t)(qrow0 + 16 * qt + l16) * 256 + hq * 64 + 32 * ks + 8 * q4);
    f32x4 o[2][4]; float mrun[2], lrun[2];
#pragma unroll
    for (int qt = 0; qt < 2; ++qt) { mrun[qt] = 0.f; lrun[qt] = 0.f;
#pragma unroll
        for (int dt = 0; dt < 4; ++dt) o[qt][dt] = (f32x4){0.f, 0.f, 0.f, 0.f}; }
    u32x4_t pk, pv;
#define AT_ROWBASE(t) ((lat && (t) < SEQ / 64) ? b * SEQ + 64 * (t) : NLAT + b * CTXL + 64 * ((t) - (lat ? SEQ / 64 : 0)))
#define AT_LOAD(t) do { const size_t ro = (size_t)(AT_ROWBASE(t) + (tid >> 3)) * 128 + kvh * 64 + (tid & 7) * 8; pk = *(const u32x4_t*)(p.CK() + ro); \
        pv = *(const u32x4_t*)(p.CV() + ((size_t)(b * 2 + kvh) * 64 + (tid >> 3)) * SLEN + (lat ? 0 : SEQ) + 64 * (t) + (tid & 7) * 8); } while (0)
#define AT_STORE(buf) do { const int rw = tid >> 3, c16 = tid & 7; *(LAS u32x4_t*)(lds + AT_K + (buf) * 9216 + rw * 144 + c16 * 16) = pk; *(LAS u32x4_t*)(lds + AT_V + (buf) * 9216 + rw * 144 + c16 * 16) = pv; } while (0)
    AT_LOAD(0); AT_STORE(0);
    lds_barrier();
#pragma unroll 1
    for (int t = 0; t < nt; ++t) {
        asm volatile("" : "+v"(tid)); lane = tid & 63; q4 = lane >> 4; l16 = lane & 15;
        const int buf = t & 1;
        if (t + 1 < nt) AT_LOAD(t + 1);
        f32x4 s[2][4];
#pragma unroll
        for (int qt = 0; qt < 2; ++qt)
#pragma unroll
            for (int kt = 0; kt < 4; ++kt) s[qt][kt] = (f32x4){-mrun[qt], -mrun[qt], -mrun[qt], -mrun[qt]};
#pragma unroll
        for (int ks = 0; ks < 2; ++ks)
#pragma unroll
            for (int kt = 0; kt < 4; ++kt) { const bf16x8_t ak = lfrag(lds, AT_K + buf * 9216, 144, 16 * kt, 32 * ks, lane);
                s[0][kt] = MMA16(ak, qf[0][ks], s[0][kt]); s[1][kt] = MMA16(ak, qf[1][ks], s[1][kt]); }
        bf16x8_t pb[2][2];
#pragma unroll
        for (int qt = 0; qt < 2; ++qt) {
            float mx = s[qt][0][0];
#pragma unroll
            for (int kt = 0; kt < 4; ++kt)
#pragma unroll
                for (int r = 0; r < 4; ++r) mx = fmaxf(mx, s[qt][kt][r]);
            mx = fmaxf(mx, __shfl_xor(mx, 16)); mx = fmaxf(mx, __shfl_xor(mx, 32));
            if (__any(mx > 6.0f) || t == 0) { const float dl = (t == 0) ? mx : fmaxf(mx, 0.f), alpha = __builtin_amdgcn_exp2f(-dl); mrun[qt] += dl; lrun[qt] *= alpha;
#pragma unroll
                for (int kt = 0; kt < 4; ++kt) s[qt][kt] = s[qt][kt] - dl;
#pragma unroll
                for (int dt = 0; dt < 4; ++dt) o[qt][dt] = o[qt][dt] * alpha; }
            float ps = 0.f;
#pragma unroll
            for (int kt = 0; kt < 4; ++kt)
#pragma unroll
                for (int r = 0; r < 4; ++r) { const float e = __builtin_amdgcn_exp2f(s[qt][kt][r]); s[qt][kt][r] = e; ps += e; }
            lrun[qt] += ps;
#pragma unroll
            for (int k2 = 0; k2 < 2; ++k2) { u32x4_t w; w.x = pg8::cvt_pk_bf16(s[qt][2 * k2][0], s[qt][2 * k2][1]); w.y = pg8::cvt_pk_bf16(s[qt][2 * k2][2], s[qt][2 * k2][3]);
                w.z = pg8::cvt_pk_bf16(s[qt][2 * k2 + 1][0], s[qt][2 * k2 + 1][1]); w.w = pg8::cvt_pk_bf16(s[qt][2 * k2 + 1][2], s[qt][2 * k2 + 1][3]); pb[qt][k2] = __builtin_bit_cast(bf16x8_t, w); }
        }
#pragma unroll
        for (int k2 = 0; k2 < 2; ++k2)
#pragma unroll
            for (int dt = 0; dt < 4; ++dt) { LAS const unsigned char* vp = lds + AT_V + buf * 9216 + (16 * dt + l16) * 144 + (32 * k2 + 4 * q4) * 2;
                const u32x2_t lo = *(LAS const u32x2_t*)vp, hi = *(LAS const u32x2_t*)(vp + 32); u32x4_t w; w.x = lo.x; w.y = lo.y; w.z = hi.x; w.w = hi.y; const bf16x8_t av = __builtin_bit_cast(bf16x8_t, w);
                o[0][dt] = MMA16(av, pb[0][k2], o[0][dt]); o[1][dt] = MMA16(av, pb[1][k2], o[1][dt]); }
        if (t + 1 < nt) AT_STORE(buf ^ 1);
        lds_barrier();
    }
#pragma unroll
    for (int qt = 0; qt < 2; ++qt) { float l = lrun[qt]; l += __shfl_xor(l, 16); l += __shfl_xor(l, 32); const float inv = 1.0f / l;
        bf16_t* orow = p.MIX() + (size_t)(qrow0 + 16 * qt + l16) * D + 768 + hq * 64 + 4 * q4;
#pragma unroll
        for (int dt = 0; dt < 4; ++dt) { u32x2_t w; w.x = pg8::cvt_pk_bf16(o[qt][dt][0] * inv, o[qt][dt][1] * inv); w.y = pg8::cvt_pk_bf16(o[qt][dt][2] * inv, o[qt][dt][3] * inv); *(u32x2_t*)(orow + 16 * dt) = w; } }
#undef AT_ROWBASE
#undef AT_LOAD
#undef AT_STORE
}


__device__ __forceinline__ void wave_rows(int nrows, int nblk, int blk, int wave, int& r0, int& r1) {
    const int nw = nblk * NWAVES, per = (nrows + nw - 1) / nw, gwl = blk * NWAVES + wave; r0 = gwl * per; r1 = r0 + per; if (r1 > nrows) r1 = nrows; if (r0 > nrows) r0 = nrows;
}
__device__ __forceinline__ float sigm(float x) { return __builtin_amdgcn_rcpf(1.0f + __expf(-x)); }
struct P0Cv { u32x4_t cv[5]; };
struct P0Sm { u32x4_t lr[3]; u32x2_t aq, ak, av; float ga, gb; };
__device__ __forceinline__ void prep0_load_cv(const P& p, int m, int which, int lane, P0Cv& in) {
    int b, t, len, base; row_info(m, b, t, len, base);
#pragma unroll
    for (int j = 0; j < 5; ++j) { const int tt = t + j - 2; in.cv[j] = (tt >= 0 && tt < len) ? *(const u32x4_t*)(p.U() + (size_t)(base + tt) * INP + B_OFF + which * B_W + 8 * lane) : (u32x4_t){0u, 0u, 0u, 0u}; }
}
__device__ __forceinline__ void prep0_compute_cv(const P& p, int l, int m, int which, int lane, const P0Cv& in, const f32x4_t (&cwr)[5][2]) {
    float acc[8];
#pragma unroll
    for (int c = 0; c < 8; ++c) acc[c] = 0.f;
#pragma unroll
    for (int j = 0; j < 5; ++j) { const u32x4_t uv = in.cv[j];
        const f32x4_t w0 = cwr[j][0], w1 = cwr[j][1];
        acc[0] += bflo(uv.x) * w0.x; acc[1] += bfhi(uv.x) * w0.y; acc[2] += bflo(uv.y) * w0.z; acc[3] += bfhi(uv.y) * w0.w;
        acc[4] += bflo(uv.z) * w1.x; acc[5] += bfhi(uv.z) * w1.y; acc[6] += bflo(uv.w) * w1.z; acc[7] += bfhi(uv.w) * w1.w; }
    float ss = 0.f;
#pragma unroll
    for (int c = 0; c < 8; ++c) { acc[c] = acc[c] * sigm(acc[c]); ss += acc[c] * acc[c]; }
    float rn = 1.0f;
    if (which < 2) rn = (frsq(grp16_sum(ss) + 1e-6f)) * (which == 0 ? 0.08838834764831845f : 1.0f);
    u32x4_t w; w.x = pg8::cvt_pk_bf16(acc[0] * rn, acc[1] * rn); w.y = pg8::cvt_pk_bf16(acc[2] * rn, acc[3] * rn); w.z = pg8::cvt_pk_bf16(acc[4] * rn, acc[5] * rn); w.w = pg8::cvt_pk_bf16(acc[6] * rn, acc[7] * rn);
    *(u32x4_t*)((which == 0 ? p.GQ() : which == 1 ? p.GK() : p.GV()) + (size_t)m * B_W + 8 * lane) = w;
}
__device__ __forceinline__ void prep0_load_sm(const P& p, int m, int lane, P0Sm& in) {
    int b, t, len, base; row_info(m, b, t, len, base);
    const bf16_t* ur = p.U() + (size_t)m * INP; const bool hp = t > 0, hn = t + 1 < len;
    { const int c = 768 + 8 * (lane < 24 ? lane : 23); const u32x4_t z = {0u, 0u, 0u, 0u};
      in.lr[0] = *(const u32x4_t*)(ur + c); in.lr[1] = hp ? *(const u32x4_t*)(ur + c - INP) : z; in.lr[2] = hn ? *(const u32x4_t*)(ur + c + INP) : z; }
    in.aq = *(const u32x2_t*)(ur + C_OFF + 4 * lane); in.ak = *(const u32x2_t*)(ur + C_OFF + 256 + 4 * (lane & 31)); in.av = *(const u32x2_t*)(ur + C_OFF + 384 + 4 * (lane & 31));
    in.ga = bf2f(ur[B_OFF + 2048 + (lane & 7)]); in.gb = bf2f(ur[B_OFF + 2056 + (lane & 7)]);
}
struct P0Par { f32x4_t m0, m1, qn, kn; float dtb, alog; };
__device__ __forceinline__ void prep0_params(const P& p, int l, int lane, P0Par& q) {
    const float* mup = p.rw_mu + l * A_IN + 768 + 8 * (lane < 24 ? lane : 23); q.m0 = *(const f32x4_t*)mup; q.m1 = *(const f32x4_t*)(mup + 4);
    q.qn = *(const f32x4_t*)(p.attn_q_norm + l * 64 + 4 * (lane & 15)); q.kn = *(const f32x4_t*)(p.attn_k_norm + l * 64 + 4 * (lane & 15));
    q.dtb = p.gdn_dt_bias[(l * 2 + ((lane & 7) >> 2)) * B_H + (lane & 3)]; q.alog = p.gdn_a_log[(l * 2 + ((lane & 7) >> 2)) * B_H + (lane & 3)];
}
__device__ __forceinline__ void prep0_compute_sm(const P& p, int l, int m, int lane, const P0Sm& in, const P0Par& par) {
    const int i16 = lane & 15; int b, t, len, base; row_info(m, b, t, len, base);
    if (lane < 32) {
        u32x4_t w = {0u, 0u, 0u, 0u};
        if (lane < 24) {
            const f32x4_t m0 = par.m0, m1 = par.m1;
            float u[8], up[8], un[8], o[8];
#pragma unroll
            for (int j = 0; j < 4; ++j) { u[2 * j] = bflo(in.lr[0][j]); u[2 * j + 1] = bfhi(in.lr[0][j]); up[2 * j] = bflo(in.lr[1][j]); up[2 * j + 1] = bfhi(in.lr[1][j]); un[2 * j] = bflo(in.lr[2][j]); un[2 * j + 1] = bfhi(in.lr[2][j]); }
            const int grp = lane >> 3;
#pragma unroll
            for (int j = 0; j < 8; ++j) { const float mu = j < 4 ? m0[j & 3] : m1[j & 3]; const float v = u[j] + mu * (0.5f * (up[j] + un[j]) - u[j]);
                const float e = __expf(grp == 0 ? 2.0f * v : -v), rc = frcp(1.0f + e); o[j] = grp == 0 ? 1.0f - 2.0f * rc : (grp == 1 ? v : rc); }
            w.x = pg8::cvt_pk_bf16(o[0], o[1]); w.y = pg8::cvt_pk_bf16(o[2], o[3]); w.z = pg8::cvt_pk_bf16(o[4], o[5]); w.w = pg8::cvt_pk_bf16(o[6], o[7]);
        }
        *(u32x4_t*)(p.LRT() + (size_t)m * 256 + 8 * lane) = w;
    }
    if (lane < 8) {
        const float xs = in.ga + par.dtb; const float sp = xs > 20.f ? xs : __logf(1.0f + __expf(xs));
        p.GG()[(size_t)m * 8 + lane] = -__expf(par.alog) * sp; p.GBETA()[(size_t)m * 8 + lane] = sigm(in.gb); }
    {
        const int i = i16; f32x4_t cs = {1.f, 1.f, 1.f, 1.f}, sn = {0.f, 0.f, 0.f, 0.f};
        if (m < NLAT) { cs = *(const f32x4_t*)(p.ROPE() + (size_t)t * 128 + 4 * i); sn = *(const f32x4_t*)(p.ROPE() + (size_t)t * 128 + 64 + 4 * i); }
        const float sgn = (i & 4) ? 1.f : -1.f;
        {
            const f32x4_t x = bf4(in.aq); const float rstd = (frsq(grp16_sum(hsq4(x)) * (1.0f / 64.f) + 1e-6f)) * 0.18033688011112042f;
            const f32x4_t nw = par.qn; f32x4_t y = x * rstd * nw, o;
#pragma unroll
            for (int c = 0; c < 4; ++c) { const float pr = __shfl_xor(y[c], 4); o[c] = y[c] * cs[c] + sgn * pr * sn[c]; }
            *(u32x2_t*)(p.CQ() + (size_t)m * 256 + 4 * lane) = pk4(o);
        }
        {
            const f32x4_t x = bf4(in.ak); const float rstd = frsq(grp16_sum(hsq4(x)) * (1.0f / 64.f) + 1e-6f);
            const f32x4_t nw = par.kn; f32x4_t y = x * rstd * nw, o;
#pragma unroll
            for (int c = 0; c < 4; ++c) { const float pr = __shfl_xor(y[c], 4); o[c] = y[c] * cs[c] + sgn * pr * sn[c]; }
            if (lane < 32) { *(u32x2_t*)(p.CK() + (size_t)m * 128 + 4 * lane) = pk4(o);
                const u32x2_t vv = in.av; const int key = m < NLAT ? t : SEQ + t;
                bf16_t* vt = p.CV() + ((size_t)(b * 2 + (lane >> 4)) * 64 + 4 * (lane & 15)) * SLEN + key;
                vt[0] = (bf16_t)(vv.x & 0xffffu); vt[SLEN] = (bf16_t)(vv.x >> 16); vt[2 * SLEN] = (bf16_t)(vv.y & 0xffffu); vt[3 * SLEN] = (bf16_t)(vv.y >> 16); }
        }
    }
}
__device__ __forceinline__ u32x4_t prep0_row(const P& p, int row, int which, int lane) {
    return (row >= 0 && row < NTOK) ? *(const u32x4_t*)(p.U() + (size_t)row * INP + B_OFF + which * B_W + 8 * lane) : (u32x4_t){0u, 0u, 0u, 0u};
}
__device__ __forceinline__ void dev_prep0(const P& p, int l, int G, int wave, int lane) {
    const int per = (NTOK + G - 1) / G, t0 = (int)blockIdx.x * per, t1 = (t0 + per < NTOK) ? t0 + per : NTOK;
#ifdef PT_P0
    const unsigned long long tp0_ = __builtin_amdgcn_s_memrealtime();
#endif
    {
        const int pw = (per + NWAVES - 1) / NWAVES, r0 = t0 + wave * pw, r1 = (r0 + pw < t1) ? r0 + pw : t1;
#pragma unroll 1
        for (int which = 0; which < 3; ++which) {
            if (r0 >= r1) break;
            f32x4_t cwr[5][2];
#pragma unroll
            for (int j = 0; j < 5; ++j) { const float* cw = p.gdn_conv + ((size_t)l * 5 + j) * (3 * B_W) + which * B_W + 8 * lane; cwr[j][0] = *(const f32x4_t*)cw; cwr[j][1] = *(const f32x4_t*)(cw + 4); }
            u32x4_t w0 = prep0_row(p, r0 - 2, which, lane), w1 = prep0_row(p, r0 - 1, which, lane), w2 = prep0_row(p, r0, which, lane), w3 = prep0_row(p, r0 + 1, which, lane);
            u32x4_t n0 = prep0_row(p, r0 + 2, which, lane), n1 = prep0_row(p, r0 + 3, which, lane);
            for (int m = r0; m < r1; m += 2) {
                const u32x4_t w4 = n0, w5 = n1; n0 = prep0_row(p, m + 4, which, lane); n1 = prep0_row(p, m + 5, which, lane);
                {
                    int b, t, len, base; row_info(m, b, t, len, base); P0Cv use; use.cv[0] = w0; use.cv[1] = w1; use.cv[2] = w2; use.cv[3] = w3; use.cv[4] = w4;
#pragma unroll
                    for (int j = 0; j < 5; ++j) { const int tt = t + j - 2; if (tt < 0 || tt >= len) use.cv[j] = (u32x4_t){0u, 0u, 0u, 0u}; }
                    prep0_compute_cv(p, l, m, which, lane, use, cwr);
                }
                if (m + 1 < r1) {
                    int b, t, len, base; row_info(m + 1, b, t, len, base); P0Cv use; use.cv[0] = w1; use.cv[1] = w2; use.cv[2] = w3; use.cv[3] = w4; use.cv[4] = w5;
#pragma unroll
                    for (int j = 0; j < 5; ++j) { const int tt = t + j - 2; if (tt < 0 || tt >= len) use.cv[j] = (u32x4_t){0u, 0u, 0u, 0u}; }
                    prep0_compute_cv(p, l, m + 1, which, lane, use, cwr);
                }
                w0 = w2; w1 = w3; w2 = w4; w3 = w5;
            }
        }
    }
#ifdef PT_P0
    const unsigned long long tp1_ = __builtin_amdgcn_s_memrealtime();
#endif
    const int first = t0 + wave, ntk = first < t1 ? (t1 - first + NWAVES - 1) / NWAVES : 0;
    {
        P0Par par; prep0_params(p, l, lane, par);
        P0Sm cur; if (ntk > 0) prep0_load_sm(p, first, lane, cur);
        for (int i = 0; i < ntk; ++i) { const int m = first + i * NWAVES; P0Sm nxt = cur; if (i + 1 < ntk) prep0_load_sm(p, m + NWAVES, lane, nxt); prep0_compute_sm(p, l, m, lane, cur, par); cur = nxt; }
    }
#ifdef PT_P0
    { const unsigned long long tp2_ = __builtin_amdgcn_s_memrealtime(); const unsigned d_ = PT_P0 == 1 ? (unsigned)(tp1_ - tp0_) : (unsigned)(tp2_ - tp1_); if (lane == 0) atomicMax(p.ctl() + 12070 + l, d_); }
#endif
}
__device__ __forceinline__ void dev_build_rope(const P& p, long gtid, long nthr) {
    for (long e = gtid; e < (long)SEQ * 64; e += nthr) { const int t = (int)(e >> 6), d = (int)(e & 63); const float pos = d < 32 ? (float)(t / GRID_W) : (float)(t % GRID_W);
        const float ang = pos * exp2f(-0.8304820237218406f * (float)(d & 15)); p.ROPE()[(size_t)t * 128 + d] = cosf(ang); p.ROPE()[(size_t)t * 128 + 64 + d] = sinf(ang); }
}
struct A1In { u32x2_t u[3][3]; u32x2_t lro[5]; };
__device__ __forceinline__ void prepA1_load(const P& p, int m, int lane, A1In& in) {
    int b, t, len, base; row_info(m, b, t, len, base);
    const bf16_t* ur = p.U() + (size_t)m * INP; const bool hp = t > 0, hn = t + 1 < len; const u32x2_t z = {0u, 0u};
#pragma unroll
    for (int a = 0; a < 3; ++a) { const int c = 256 * a + 4 * lane; in.u[a][1] = *(const u32x2_t*)(ur + c); in.u[a][0] = hp ? *(const u32x2_t*)(ur + c - INP) : z; in.u[a][2] = hn ? *(const u32x2_t*)(ur + c + INP) : z; }
    const bf16_t* lo = p.LRO() + (size_t)m * 1280 + 4 * lane;
#pragma unroll
    for (int g = 0; g < 5; ++g) in.lro[g] = *(const u32x2_t*)(lo + 256 * g);
}
__device__ __forceinline__ void dev_prepA1(const P& p, int l, int gw, int ngw, int lane) {
    const int h = lane >> 4;
    const f32x4_t kkp = *(const f32x4_t*)(p.rw_k_k + l * A_W + 4 * lane), kap = *(const f32x4_t*)(p.rw_k_a + l * A_W + 4 * lane), rkp = *(const f32x4_t*)(p.rw_r_k + l * A_W + 4 * lane);
    f32x4_t mu3[3], w0p[2], a0p[2];
#pragma unroll
    for (int a = 0; a < 3; ++a) mu3[a] = *(const f32x4_t*)(p.rw_mu + l * A_IN + 256 * a + 4 * lane);
#pragma unroll
    for (int dir = 0; dir < 2; ++dir) { w0p[dir] = *(const f32x4_t*)(p.rw_w0 + (l * 2 + dir) * A_W + 4 * lane); a0p[dir] = *(const f32x4_t*)(p.rw_a0 + (l * 2 + dir) * A_W + 4 * lane); }
    int m = gw; if (m >= NTOK) return;
    A1In cur; prepA1_load(p, m, lane, cur);
    for (; m < NTOK; m += ngw) {
        A1In nxt = cur; if (m + ngw < NTOK) prepA1_load(p, m + ngw, lane, nxt);
        f32x4_t rkv[3];
#pragma unroll
        for (int a = 0; a < 3; ++a) { const f32x4_t u = bf4(cur.u[a][1]); rkv[a] = u + mu3[a] * (0.5f * (bf4(cur.u[a][0]) + bf4(cur.u[a][2])) - u); }
        const f32x4_t r = rkv[0], k = rkv[1], v = rkv[2];
        const f32x4_t kx = k * kkp; const float rn = frsq(grp16_sum(hsq4(kx)) + 1e-6f); const f32x4_t kk = kx * rn;
        f32x4_t kdsum = {0.f, 0.f, 0.f, 0.f};
#pragma unroll
        for (int dir = 0; dir < 2; ++dir) {
            const f32x4_t w = w0p[dir] + bf4(cur.lro[dir]);
            const f32x4_t a = a0p[dir] + bf4(cur.lro[2 + dir]);
            f32x4_t ld, ic;
#pragma unroll
            for (int c = 0; c < 4; ++c) { const float nw = -w[c]; const float sp = nw > 20.f ? nw : __logf(1.0f + __expf(nw)); ld[c] = -__expf(-sp - 0.5f); ic[c] = sigm(a[c]); }
            const f32x4_t kd = k * (1.0f + (ic - 1.0f) * kap); kdsum = kdsum + kd;
            const size_t o = ((size_t)dir * NTOK + m) * A_W + 4 * lane;
            *(f32x4_t*)(p.RW_D() + o) = ld; *(u32x2_t*)(p.RW_KD() + o) = pk4(kd); *(u32x2_t*)(p.RW_KKA() + o) = pk4(kk * ic);
        }
        const size_t o1 = (size_t)m * A_W + 4 * lane;
        *(u32x2_t*)(p.RW_R() + o1) = pk4(r); *(u32x2_t*)(p.RW_V() + o1) = pk4(v); *(u32x2_t*)(p.RW_KK() + o1) = pk4(kk); *(u32x2_t*)(p.RW_GATE() + o1) = cur.lro[4];
        const float bon = grp16_sum(hsum4(r * kdsum * rkp));
        if ((lane & 15) == 0) p.RW_BON()[(size_t)m * A_H + h] = bon;
        cur = nxt;
    }
}
__device__ __forceinline__ void dev_build_wlr(const P& p, int l, long gtid, long nthr) {
    for (long e = gtid; e < 1280L * 256; e += nthr) { const int n = (int)(e >> 8), k = (int)(e & 255), g = n >> 8, ch = n & 255; float v = 0.f;
        if (g < 2) { if ((k >> 5) == g) v = p.rw_w2[((size_t)(l * 2 + g) * 32 + (k & 31)) * A_W + ch]; }
        else if (g < 4) { if ((k >> 5) == g) v = p.rw_a2[((size_t)(l * 2 + (g - 2)) * 32 + (k & 31)) * A_W + ch]; }
        else { if (k >= 128 && k < 192) v = p.rw_g2[((size_t)l * 64 + (k - 128)) * A_W + ch]; }
        p.WLR_T(l)[e] = f2bf(v); }
}

constexpr int RING_BYTES = 131072, MISC_OFF = 147200, LDS_BYTES = 163840;
constexpr size_t MiB = 1u << 20;
constexpr int CW_BAR = 4096, CW_CNT = 8192;

__device__ __forceinline__ void transpose_item(const float* W, int K, int N, bf16_t* WT, LAS float* scr, int item, int lane) {
    const int nblk_k = K / 64; const int nb = item / nblk_k, kb = item % nblk_k, k0 = 64 * kb, n0 = 64 * nb;
    const int nl = 4 * (lane & 15), kq = lane >> 4;
    f32x4 v[16];
#pragma unroll
    for (int i = 0; i < 16; ++i) { const float* src = W + (size_t)(k0 + 4 * i + kq) * N + n0 + nl;
        if (n0 + nl + 3 < N) v[i] = *(const f32x4*)src;
        else { v[i] = (f32x4){0.f, 0.f, 0.f, 0.f}; if (n0 + nl < N) v[i][0] = src[0]; if (n0 + nl + 1 < N) v[i][1] = src[1]; if (n0 + nl + 2 < N) v[i][2] = src[2]; } }
#pragma unroll
    for (int i = 0; i < 16; ++i) { LAS float* d = scr + (4 * i + kq) * 65 + nl; d[0] = v[i][0]; d[1] = v[i][1]; d[2] = v[i][2]; d[3] = v[i][3]; }
    asm volatile("s_waitcnt lgkmcnt(0)" ::: "memory");
    const int c = lane & 7;
#pragma unroll
    for (int j = 0; j < 8; ++j) { const int n = (lane >> 3) + 8 * j; const LAS float* sp = scr + (8 * c) * 65 + n;
        pg8::u32x4 o; o.x = pg8::cvt_pk_bf16(sp[0 * 65], sp[1 * 65]); o.y = pg8::cvt_pk_bf16(sp[2 * 65], sp[3 * 65]); o.z = pg8::cvt_pk_bf16(sp[4 * 65], sp[5 * 65]); o.w = pg8::cvt_pk_bf16(sp[6 * 65], sp[7 * 65]);
        *(pg8::u32x4*)(WT + (size_t)(n0 + n) * K + k0 + 8 * c) = o; }
    asm volatile("s_waitcnt lgkmcnt(0)" ::: "memory");
}

struct Args { P p; int ph_lo, ph_hi; };

#define RUN_TASKS(ntasks, call) do { const long _n = (long)(ntasks); for (long task = gtid; task < _n; task += nthr) { call; } } while (0)


__device__ __forceinline__ void dev_mod(const P& p, int cg, LAS unsigned char* lds, int tid) {
    LAS float* STB = (LAS float*)lds; LAS float* PT = (LAS float*)(lds + 69632);
    const int lane = tid & 63, wave = tid >> 6; const int lyr = cg / 96, j0 = (cg % 96) * 64;
    for (int idx = tid; idx < (BATCH + 1) * D; idx += NTHR) { const int r = idx >> 10, k = idx & 1023; const float v = r < BATCH ? p.c[(size_t)r * D + k] : p.c_ctx[k]; STB[idx] = v / (1.0f + __expf(-v)); }
    __syncthreads();
    float acc[BATCH + 1];
#pragma unroll
    for (int r = 0; r <= BATCH; ++r) acc[r] = 0.f;
    const float* w = p.ada_w + ((size_t)lyr * D + 128 * wave) * 6 * D + j0 + lane;
#pragma unroll 4
    for (int k = 0; k < 128; ++k) { const float wv = w[(size_t)k * 6 * D];
#pragma unroll
        for (int r = 0; r <= BATCH; ++r) acc[r] += STB[r * D + 128 * wave + k] * wv; }
#pragma unroll
    for (int r = 0; r <= BATCH; ++r) PT[(wave * (BATCH + 1) + r) * 64 + lane] = acc[r];
    __syncthreads();
    for (int idx = tid; idx < (BATCH + 1) * 64; idx += NTHR) { const int r = idx >> 6, jj = idx & 63; float sacc = p.ada_b[(size_t)lyr * 6 * D + j0 + jj];
#pragma unroll
        for (int w2 = 0; w2 < 8; ++w2) sacc += PT[(w2 * (BATCH + 1) + r) * 64 + jj];
        p.MOD()[((size_t)lyr * (BATCH + 1) + r) * 6 * D + j0 + jj] = sacc; }
    __syncthreads();
}
constexpr int CV_I_IN = (D / 64) * (INP / 64), CV_I_OUT = (D / 64) * (D / 64), CV_I_R = (D / 64), CV_I_GU = (D / 64) * (2 * DEXP / 64), CV_I_DN = (DEXP / 64) * (D / 64);
constexpr int CV_SMALL = CV_I_IN + CV_I_OUT + CV_I_R, CV_TOTAL = CV_SMALL + NEXP * (CV_I_GU + CV_I_DN), CV_CHUNK = 8;
constexpr int CV_NCH_SMALL = (CV_SMALL + CV_CHUNK - 1) / CV_CHUNK, CV_NCH_MOE = (CV_TOTAL - CV_SMALL + CV_CHUNK - 1) / CV_CHUNK;
__device__ __forceinline__ void conv_chunk(const P& p, int l, bool moe, int chunk, LAS unsigned char* ldsp, int wave, int lane) {
    LAS float* scr = (LAS float*)(ldsp + wave * 16896);
    for (int i = 0; i < CV_CHUNK / NWAVES; ++i) {
        int r = chunk * CV_CHUNK + wave + NWAVES * i; if (moe) { r += CV_SMALL; if (r >= CV_TOTAL) break; } else if (r >= CV_SMALL) break;
        if (r < CV_I_IN) { transpose_item(p.w_in + (size_t)l * D * INW, D, INW, p.WIN_T(l), scr, r, lane); continue; } r -= CV_I_IN;
        if (r < CV_I_OUT) { transpose_item(p.w_out + (size_t)l * D * D, D, D, p.WOUT_T(l), scr, r, lane); continue; } r -= CV_I_OUT;
        if (r < CV_I_R) { transpose_item(p.router_w + (size_t)l * D * NEXP, D, NEXP, p.WR_T(l), scr, r, lane); continue; } r -= CV_I_R;
        if (r < NEXP * CV_I_GU) { const int e = r / CV_I_GU; transpose_item(p.exp_w_gu + ((size_t)l * NEXP + e) * D * 2 * DEXP, D, 2 * DEXP, p.WGU_T(l) + (size_t)e * 2 * DEXP * D, scr, r % CV_I_GU, lane); continue; } r -= NEXP * CV_I_GU;
        { const int e = r / CV_I_DN; transpose_item(p.exp_w_dn + ((size_t)l * NEXP + e) * DEXP * D, DEXP, D, p.WDN_T(l) + (size_t)e * D * DEXP, scr, r % CV_I_DN, lane); }
    }
}

__device__ __forceinline__ int q_next(unsigned* ctr, volatile LAS unsigned* slot, int tid) {
    if (tid == 0) *slot = __hip_atomic_fetch_add(ctr, 1u, __ATOMIC_RELAXED, __HIP_MEMORY_SCOPE_AGENT);
    __syncthreads(); const int v = (int)*slot; __syncthreads(); return v;
}

__device__ __forceinline__ int q_filler(unsigned* cctr, unsigned* dctr, unsigned nitems, volatile LAS unsigned* slot, int tid) {
    if (tid == 0) { const unsigned d = __hip_atomic_load(dctr, __ATOMIC_RELAXED, __HIP_MEMORY_SCOPE_AGENT); *slot = d >= nitems ? 0x7fffffffu : __hip_atomic_fetch_add(cctr, 1u, __ATOMIC_RELAXED, __HIP_MEMORY_SCOPE_AGENT); }
    __syncthreads(); const int v = (int)*slot; __syncthreads(); return v;
}

#ifndef DBG_PH
#define DBG_PH -1
#endif
#define PHON(j) (DBG_PH < 0 || DBG_PH == (j))
#define IN(k) (lo <= (k) && (k) < hi)
#define TID_NOW() (wave_s * 64 + (int)__builtin_amdgcn_mbcnt_hi(~0u, __builtin_amdgcn_mbcnt_lo(~0u, 0u)))
#define PHASE_VARS P p = args.p; asm volatile("" : "+s"(p.ws)); int tid_ = TID_NOW(); asm volatile("" : "+v"(tid_)); const int lane = tid_ & 63, wave = __builtin_amdgcn_readfirstlane(tid_ >> 6); \
    const long gtid = ((long)wave * G + blockIdx.x) * 64 + lane, nthr = (long)G * NTHR; const int gw = wave * G + blockIdx.x, ngw = G * NWAVES; (void)gw; (void)ngw; (void)gtid; (void)nthr; (void)lane;
#ifdef PROBE_T
#define SEAM(k) do { if (IN((k) + 1)) xcd_barrier(bar, TID_NOW()); if (blockIdx.x == 0 && TID_NOW() == 0) ((unsigned long long*)(args.p.ctl() + 12100))[(k) + 1] = __builtin_amdgcn_s_memrealtime(); } while (0)
#else
#define SEAM(k) do { if (IN((k) + 1)) xcd_barrier(bar, TID_NOW()); } while (0)
#endif
template <int l>
__device__ __forceinline__ void layer_body(const Args& args, const XcdBarrier& bar, LAS unsigned char* ldsp, const int G, const int wave_s, const int lo, const int hi) {
        const int pb = 1 + l * NPH;
        const bool need_ctx = l < DEPTH - 1;
        const int ntok_l = need_ctx ? NTOK : NLAT;
        if (l == 0 && PHON(0) && IN(pb + 0)) { PHASE_VARS;
            dev_norm1_l0(p, G, wave, lane);
            SEAM(pb + 0);
        }
        if (PHON(1) && IN(pb + 1)) { PHASE_VARS; (void)tid_; (void)wave;
            pg8::Gemm g{p.HB(), p.WIN_T(l), D, 0, nullptr}; pg8::StaticOrder S; S.init(NTOK, INP, G, (int)blockIdx.x);
            pg8::EpiBf16Bias E{p.U(), INP, nullptr, 0};
            pg8::gemm_phase(ldsp, g, S, E, tid_);
            SEAM(pb + 1);
        }
        if (PHON(2) && IN(pb + 2)) { PHASE_VARS; dev_prep0(p, l, G, wave, lane); SEAM(pb + 2); }
        if (PHON(3) && IN(pb + 3)) { PHASE_VARS; (void)tid_; (void)wave;
            pg8::Gemm g{p.LRT(), p.WLR_T(l), 256, 0, nullptr}; pg8::StaticOrder S; S.init(NTOK, 1280, G, (int)blockIdx.x);
            pg8::EpiBf16Bias E{p.LRO(), 1280, nullptr, 0};
            pg8::gemm_phase(ldsp, g, S, E, tid_);
            SEAM(pb + 3);
        }
        if (PHON(4) && IN(pb + 4)) { PHASE_VARS; dev_prepA1(p, l, gw, ngw, lane); SEAM(pb + 4); }
        if (PHON(5) && IN(pb + 5)) { PHASE_VARS;
            const int nchain = 2 * BATCH * B_H, nitems = nchain + RW_UNITS;
            unsigned* ctr = p.ctl() + 12200 + 64 * (2 * l); volatile LAS unsigned* slot = (volatile LAS unsigned*)(ldsp + MISC_OFF + 64);
#ifdef PROBE_GDN
            { const long nB = 2L * BATCH * B_H * 128; for (long task = gtid; task < nB; task += nthr) task_scanB(p, task); }
#endif
            unsigned long long tacc_ = 0ull, t0_ = 0ull; (void)tacc_; (void)t0_;
#ifdef PT_ACT
#define ACT_BEGIN(a) do { if (PT_ACT == (a)) t0_ = __builtin_amdgcn_s_memrealtime(); } while (0)
#define ACT_END(a) do { if (PT_ACT == (a)) tacc_ += __builtin_amdgcn_s_memrealtime() - t0_; } while (0)
#define ACT_FLUSH() do { if (tid_ == 0) atomicMax(p.ctl() + 12070 + l, (unsigned)tacc_); } while (0)
#else
#define ACT_BEGIN(a)
#define ACT_END(a)
#define ACT_FLUSH()
#endif
            int cur = q_next(ctr, slot, tid_);
            while (cur < nchain) {
                ACT_BEGIN(1); gdn_chain(p.GQ(), p.GK(), p.GV(), p.GG(), p.GBETA(), cur, p.OB(), ldsp, tid_, p.ctl()); ACT_END(1);
                if (tid_ == 0) __hip_atomic_fetch_add(ctr + 32, 1u, __ATOMIC_RELAXED, __HIP_MEMORY_SCOPE_AGENT);
                cur = q_next(ctr, slot, tid_); }
            if (cur < nitems) {
                S1In in; rwkv_stage1_load(p, cur - nchain, tid_, in);
                int nxt = q_next(ctr, slot, tid_);
                while (cur < nitems) {
#if defined(PT_SEC) && PT_SEC == 18
                    if (tid_ == 0) { const unsigned long long n_ = __builtin_amdgcn_s_memrealtime(); if (t0_) atomicAdd(p.ctl() + 12080, (unsigned)(n_ - t0_)); t0_ = n_; }
#endif
                    S1In in2; const bool have2 = nxt < nitems;
                    if (have2) rwkv_stage1_load(p, nxt - nchain, tid_, in2); else in2 = in;
                    unsigned qraw = 0u;
                    ACT_BEGIN(2); rwkv_stage1(p, cur - nchain, in, ldsp, tid_, ctr, qraw); ACT_END(2);
                    if (tid_ == 0) { __hip_atomic_fetch_add(ctr + 32, 1u, __ATOMIC_RELAXED, __HIP_MEMORY_SCOPE_AGENT); *slot = qraw; }
                    lds_barrier();
                    const int nn = (int)*slot;
                    in = in2; cur = nxt; nxt = nn;
                }
                __syncthreads();
            }
            ACT_FLUSH();
            {
                unsigned* cctr = p.ctl() + 12200 + 64 * (8 + 2 * l);
                for (int ch = q_filler(cctr, ctr + 32, (unsigned)nitems, slot, tid_); ch < CV_NCH_MOE + (l + 1 < DEPTH ? CV_NCH_SMALL : 0); ch = q_filler(cctr, ctr + 32, (unsigned)nitems, slot, tid_)) {
                    if (ch < CV_NCH_MOE) conv_chunk(p, l, true, ch, ldsp, wave, lane); else conv_chunk(p, l + 1, false, ch - CV_NCH_MOE, ldsp, wave, lane); } }
            SEAM(pb + 5);
        }
        if (PHON(6) && IN(pb + 6)) { PHASE_VARS;
            const int ngb = 0, nch = ngb + BATCH * A_H, nun = ATT_NLAT + (need_ctx ? ATT_NCTX : 0);
            unsigned* ctr = p.ctl() + 12200 + 64 * (2 * l + 1); volatile LAS unsigned* slot = (volatile LAS unsigned*)(ldsp + MISC_OFF + 64);
#ifdef PROBE_RWKV
            { const long nA = 2L * BATCH * A_H * 64; for (long task = gtid; task < nA; task += nthr) task_scanA(p, task); }
#endif
            unsigned long long tacc_ = 0ull, t0_ = 0ull; (void)tacc_; (void)t0_;
            for (int cur = q_next(ctr, slot, tid_); cur < nch + nun; cur = q_next(ctr, slot, tid_)) {
                if (cur < nch) { ACT_BEGIN(3); rwkv_stage2(p, cur - ngb,
#ifdef PROBE_RWKV
                    (bf16_t*)(p.ws + WS_TOTAL),
#else
                    p.YA(),
#endif
                    ldsp, tid_); ACT_END(3); }
                else { ACT_BEGIN(4); attn_unit(p, cur - nch, ldsp, tid_); ACT_END(4); }
                if (tid_ == 0) __hip_atomic_fetch_add(ctr + 32, 1u, __ATOMIC_RELAXED, __HIP_MEMORY_SCOPE_AGENT);
            }
            ACT_FLUSH();
            {
                unsigned* cctr = p.ctl() + 12200 + 64 * (8 + 2 * l);
                for (int ch = q_filler(cctr, ctr + 32, (unsigned)(nch + nun), slot, tid_); ch < CV_NCH_MOE + (l + 1 < DEPTH ? CV_NCH_SMALL : 0); ch = q_filler(cctr, ctr + 32, (unsigned)(nch + nun), slot, tid_)) {
                    if (ch < CV_NCH_MOE) conv_chunk(p, l, true, ch, ldsp, wave, lane); else conv_chunk(p, l + 1, false, ch - CV_NCH_MOE, ldsp, wave, lane); } }
            SEAM(pb + 6);
        }
        if (PHON(7) && IN(pb + 7)) { PHASE_VARS;
#ifdef PROBE_GDN
            { float e2 = 0.f, r2 = 0.f; const bf16_t* cand = (const bf16_t*)(p.ws + WS_TOTAL); const bf16_t* ref = p.OB();
              for (long i = gtid; i < 2L * NTOK * B_W; i += nthr) { const float d = bf2f(cand[i]) - bf2f(ref[i]); e2 += d * d; r2 += bf2f(ref[i]) * bf2f(ref[i]); }
              e2 = wave_sum(e2); r2 = wave_sum(r2); if (lane == 0) { atomicAdd((float*)(p.ctl() + 12000), e2); atomicAdd((float*)(p.ctl() + 12001), r2); } }
#endif
#ifdef PROBE_RWKV
            { float e2 = 0.f, r2 = 0.f; const bf16_t* cand = (const bf16_t*)(p.ws + WS_TOTAL); const bf16_t* ref = p.YA();
              for (long i = gtid; i < 2L * NTOK * A_W; i += nthr) { const float d = bf2f(cand[i]) - bf2f(ref[i]); e2 += d * d; r2 += bf2f(ref[i]) * bf2f(ref[i]); }
              e2 = wave_sum(e2); r2 = wave_sum(r2); if (lane == 0) { atomicAdd((float*)(p.ctl() + 12000), e2); atomicAdd((float*)(p.ctl() + 12001), r2); } }
#endif
            dev_post(p, l, ntok_l, gw, ngw, lane); SEAM(pb + 7); }
        if (PHON(8) && IN(pb + 8)) { PHASE_VARS; (void)tid_; (void)wave;
            pg8::Gemm g{p.MIX(), p.WOUT_T(l), D, 0, nullptr}; pg8::StaticOrder S; S.init(ntok_l, D, G, (int)blockIdx.x);
            pg8::EpiBf16Bias E{p.MO(), D, nullptr, 0};
            pg8::gemm_phase(ldsp, g, S, E, tid_);
            SEAM(pb + 8);
        }
        if (PHON(9) && IN(pb + 9)) { PHASE_VARS; dev_resid_router(p, l, ntok_l, ldsp, G, tid_); SEAM(pb + 9); }
        if (PHON(10) && IN(pb + 10)) { PHASE_VARS; dev_slots(p, l, ntok_l, ldsp, gtid, nthr, tid_);
            {
                unsigned* cctr = p.ctl() + 12200 + 64 * (8 + 2 * l); volatile LAS unsigned* slot = (volatile LAS unsigned*)(ldsp + MISC_OFF + 64);
                for (int ch = q_next(cctr, slot, tid_); ch < CV_NCH_MOE + (l + 1 < DEPTH ? CV_NCH_SMALL : 0); ch = q_next(cctr, slot, tid_)) {
                    if (ch < CV_NCH_MOE) conv_chunk(p, l, true, ch, ldsp, wave, lane); else conv_chunk(p, l + 1, false, ch - CV_NCH_MOE, ldsp, wave, lane); } }
            SEAM(pb + 10); }
        if (PHON(12) && IN(pb + 12)) { PHASE_VARS; (void)tid_; (void)wave;
            pg8::Gemm g{p.HB(), p.WGU_T(l), D, (size_t)2 * DEXP * D, p.SLOT_TOK()}; pg8::MoeOrder S{__builtin_amdgcn_readfirstlane(p.NBLK()[0]), 2 * DEXP / 256, G, (int)blockIdx.x, p.BLOCK_E()};
            pg8::EpiSwiglu E{p.HH(), DEXP, p.exp_b_gu + (size_t)l * NEXP * 2 * DEXP, 2 * DEXP};
            pg8::gemm_phase<true>(ldsp, g, S, E, tid_);
            SEAM(pb + 12);
        }
        if (PHON(13) && IN(pb + 13)) { PHASE_VARS; (void)tid_; (void)wave;
            pg8::Gemm g{p.HH(), p.WDN_T(l), DEXP, (size_t)D * DEXP, nullptr}; pg8::MoeOrder S{__builtin_amdgcn_readfirstlane(p.NBLK()[0]), D / 256, G, (int)blockIdx.x, p.BLOCK_E()};
            pg8::EpiBf16Bias E{p.YB(), D, p.exp_b_dn + (size_t)l * NEXP * D, D};
            pg8::gemm_phase(ldsp, g, S, E, tid_);
            SEAM(pb + 13);
        }
        if (PHON(14) && IN(pb + 14)) { PHASE_VARS; dev_combine(p, l, ntok_l, G, wave, lane);
            if (l + 1 < DEPTH) SEAM(pb + 14); }
}

__global__ void __launch_bounds__(NTHR, 2) fwd_kernel(Args args) {
    extern __shared__ __attribute__((aligned(16))) unsigned char lds[];
    const P& pk = args.p;
    LAS unsigned char* ldsp = (LAS unsigned char*)lds;
    volatile LAS unsigned* MISC = (volatile LAS unsigned*)(ldsp + MISC_OFF);
    const int G = gridDim.x;
    const int wave_s = __builtin_amdgcn_readfirstlane((int)threadIdx.x >> 6);
    { const int t0 = TID_NOW(); if (t0 < 32) MISC[t0] = 0u; }
    __syncthreads();
    XcdBarrier bar = xcd_barrier_post(pk.ctl() + CW_BAR, MISC + 8, TID_NOW());
    const int lo = args.ph_lo, hi = args.ph_hi;
#ifdef PROBE_T
    if (blockIdx.x == 0 && TID_NOW() == 0) ((unsigned long long*)(pk.ctl() + 12100))[0] = __builtin_amdgcn_s_memrealtime();
#endif

    if (PHON(100) && IN(0)) { PHASE_VARS;
        for (int cg = blockIdx.x; cg < DEPTH * 96; cg += G) dev_mod(p, cg, ldsp, tid_);
        RUN_TASKS(D, p.HB()[(size_t)ZROW * D + task] = 0);
        dev_build_rope(p, gtid, nthr);
        for (int lw = 0; lw < DEPTH; ++lw) dev_build_wlr(p, lw, gtid, nthr);
        for (int ch = blockIdx.x; ch < CV_NCH_SMALL; ch += G) conv_chunk(p, 0, false, ch, ldsp, wave, lane);
        SEAM(0);
    }
    layer_body<0>(args, bar, ldsp, G, wave_s, lo, hi);
    layer_body<1>(args, bar, ldsp, G, wave_s, lo, hi);
#undef IN
#undef SEAM
}

#ifndef N_LAUNCH_MODE
#define N_LAUNCH_MODE 1
#endif
extern "C" void kernel_launch(void* const* d_in, const int* in_sizes, int n_in, void* d_out, int out_size, void* d_ws, size_t ws_size, hipStream_t stream) {
    static int grid = 0;
    if (grid == 0) {
        int dev = 0, cus = 0;
        if (hipGetDevice(&dev) != hipSuccess || hipDeviceGetAttribute(&cus, hipDeviceAttributeMultiprocessorCount, dev) != hipSuccess) { grid = -1; return; }
        if (hipFuncSetAttribute((const void*)fwd_kernel, hipFuncAttributeMaxDynamicSharedMemorySize, LDS_BYTES) != hipSuccess) { fprintf(stderr, "hipFuncSetAttribute failed\n"); grid = -1; return; }
        int per_cu = 0;
        if (hipOccupancyMaxActiveBlocksPerMultiprocessor(&per_cu, (const void*)fwd_kernel, NTHR, LDS_BYTES) != hipSuccess || per_cu < 1) fprintf(stderr, "occupancy query: %d\n", per_cu);
        (void)hipGetLastError();
        grid = cus;
    }
    if (grid < 0) return;
    unsigned char* ws = (unsigned char*)d_ws;
    (void)hipMemsetAsync(ws, 0, CTL_BYTES, stream);
    Args a{};
    P& p = a.p;
    const float* const* in = (const float* const*)d_in;
    p.x = in[0]; p.c = in[1]; p.ctx = in[2]; p.c_ctx = in[3]; p.ada_w = in[4]; p.ada_b = in[5]; p.pre_norm = in[6]; p.post_norm = in[7]; p.w_in = in[8]; p.w_out = in[9];
    p.rw_mu = in[10]; p.rw_w0 = in[11]; p.rw_w2 = in[12]; p.rw_a0 = in[13]; p.rw_a2 = in[14]; p.rw_g2 = in[15]; p.rw_k_k = in[16]; p.rw_k_a = in[17]; p.rw_r_k = in[18]; p.rw_ln_w = in[19]; p.rw_ln_b = in[20];
    p.gdn_conv = in[21]; p.gdn_a_log = in[22]; p.gdn_dt_bias = in[23]; p.gdn_norm = in[24]; p.attn_q_norm = in[25]; p.attn_k_norm = in[26];
    p.router_w = in[27]; p.router_b = in[28]; p.exp_w_gu = in[29]; p.exp_b_gu = in[30]; p.exp_w_dn = in[31]; p.exp_b_dn = in[32];
    p.out = (float*)d_out;
    p.ws = ws; p.tokf = nullptr;
#ifdef PROBE_GDN
    if (WS_TOTAL + (size_t)2 * NTOK * B_W * 4 > ws_size) { fprintf(stderr, "probe: ws too small\n"); return; }
#endif
    if (WS_TOTAL > ws_size) { fprintf(stderr, "kernel_launch: workspace too small: need %zu have %zu\n", (size_t)WS_TOTAL, ws_size); return; }
    const int nph = 1 + DEPTH * NPH;
#if N_LAUNCH_MODE == 1
    a.ph_lo = 0; a.ph_hi = nph;
    hipLaunchKernelGGL(fwd_kernel, dim3(grid), dim3(NTHR), LDS_BYTES, stream, a);
#else
    for (int ph = 0; ph < nph; ++ph) { a.ph_lo = ph; a.ph_hi = ph + 1; hipLaunchKernelGGL(fwd_kernel, dim3(grid), dim3(NTHR), LDS_BYTES, stream, a); }
#endif
}
#endif
```
